# Optimizing an MI355X kernel written in HIP

```python
import jax, jax.numpy as jnp
from jax import lax
import numpy as np


D_MODEL = 1024
BATCH = 4
SEQ = 4096
DEPTH = 2

CHUNK = 64
N_BRANCH = 3
BRANCH_WIDTH = D_MODEL // 2
POOL_WINDOWS = (2, 4, 8, 16)
N_POOL_GROUPS = len(POOL_WINDOWS)
POOL_GROUP = BRANCH_WIDTH // N_POOL_GROUPS
CONV_K = 3
SB_HEAD_DIM = 64
SB_HEADS = BRANCH_WIDTH // SB_HEAD_DIM
Q_BLOCK = 128
RMS_EPS = 1e-6
IN_SIZES = (BRANCH_WIDTH,) * 10 + (N_BRANCH * D_MODEL,)
N_IN = sum(IN_SIZES)

kernel_name = "hybrid_pool_conv_stickbreak_block"


def _split_points():
    return [int(p) for p in np.cumsum(IN_SIZES)[:-1]]


def rms_norm(x, g):
    xf = x.astype(jnp.float32)
    y = xf * lax.rsqrt(jnp.mean(xf * xf, axis=-1, keepdims=True) + RMS_EPS)
    return (y * g.astype(jnp.float32)).astype(x.dtype)


def pool_mixer(v, w_group, scale):
    b, s, _ = v.shape
    vg = v.astype(jnp.float32).reshape(b, s, N_POOL_GROUPS, POOL_GROUP)
    csum = jnp.cumsum(vg, axis=1)
    pos = jnp.arange(s)
    outs = []
    for gi, w in enumerate(POOL_WINDOWS):
        c = csum[:, :, gi]
        lag = jnp.pad(c[:, :s - w], ((0, 0), (w, 0), (0, 0)))
        cnt = jnp.minimum(pos + 1, w).astype(jnp.float32)[None, :, None]
        outs.append((c - lag) / cnt - vg[:, :, gi])
    pooled = jnp.stack(outs, axis=2).astype(v.dtype)
    mixed = jnp.einsum('bsgc,gcd->bsgd', pooled, w_group)
    return mixed.reshape(b, s, BRANCH_WIDTH) * scale


def conv_mixer(xc, gate_b, gate_c, w, bias):
    z = gate_c * xc
    y = lax.conv_general_dilated(
        z, w[:, None, :].astype(z.dtype), window_strides=(1,), padding=[(CONV_K - 1, 0)],
        dimension_numbers=('NWC', 'WIO', 'NWC'), feature_group_count=BRANCH_WIDTH)
    return gate_b * (y + bias)


def stick_breaking_attention(q, k, v):
    b, s, _ = q.shape
    nblk = s // Q_BLOCK
    qb = q.reshape(b, nblk, Q_BLOCK, SB_HEADS, SB_HEAD_DIM).transpose(1, 0, 2, 3, 4)
    kf = k.reshape(b, s, SB_HEADS, SB_HEAD_DIM).astype(jnp.float32)
    vf = v.reshape(b, s, SB_HEADS, SB_HEAD_DIM).astype(jnp.float32)
    key_pos = jnp.arange(s)
    scale = SB_HEAD_DIM ** -0.5

    def block(args):
        qi, i = args
        logits = jnp.einsum('bqhd,bkhd->bhqk', qi.astype(jnp.float32), kf) * scale
        q_pos = i * Q_BLOCK + jnp.arange(Q_BLOCK)
        mask = key_pos[None, :] < q_pos[:, None]
        log_keep = jnp.where(mask, jax.nn.log_sigmoid(-logits), 0.0)
        later = lax.cumsum(log_keep, axis=3, reverse=True) - log_keep
        weights = jnp.where(mask, jnp.exp(jax.nn.log_sigmoid(logits) + later), 0.0)
        return jnp.einsum('bhqk,bkhd->bqhd', weights, vf)

    out = lax.map(block, (qb, jnp.arange(nblk)))
    return out.transpose(1, 0, 2, 3, 4).reshape(b, s, BRANCH_WIDTH).astype(q.dtype)


def hybrid_layer(x, g_pre, w_in, pool_w, pool_scale, conv_w, conv_b, w_branch, w_out, g_post):
    b, s, _ = x.shape
    h = rms_norm(x, g_pre)
    u = jnp.einsum('bsd,dn->bsn', h, w_in)
    (pool_v, pool_g, conv_x, conv_gb, conv_gc, conv_g,
     sb_q, sb_k, sb_v, sb_g, merge) = jnp.split(u, _split_points(), axis=-1)
    y_pool = pool_mixer(pool_v, pool_w, pool_scale) * jax.nn.silu(pool_g)
    y_conv = conv_mixer(conv_x, conv_gb, conv_gc, conv_w, conv_b) * jax.nn.silu(conv_g)
    y_sb = stick_breaking_attention(sb_q, sb_k, sb_v) * jax.nn.silu(sb_g)
    branches = jnp.stack([y_pool, y_conv, y_sb], axis=2)
    proj = jnp.einsum('bsnw,nwd->bsnd', branches, w_branch)
    gates = jax.nn.sigmoid(merge.reshape(b, s, N_BRANCH, D_MODEL))
    merged = jnp.sum(gates * proj, axis=2)
    out = jnp.einsum('bsd,de->bse', merged, w_out)
    return x + rms_norm(out, g_post)


def setup_inputs(seed: int = 0) -> dict:
    key = jax.random.key(seed)
    ks = jax.random.split(key, 10)
    f32 = jnp.float32
    x = jax.random.normal(ks[0], (BATCH, SEQ, D_MODEL), f32)
    pre_norm_g = 1.0 + 0.05 * jax.random.normal(ks[1], (DEPTH, D_MODEL), f32)
    w_in = jax.random.normal(ks[2], (DEPTH, D_MODEL, N_IN), f32) * D_MODEL ** -0.5
    pool_w = jax.random.normal(ks[3], (DEPTH, N_POOL_GROUPS, POOL_GROUP, POOL_GROUP), f32) * POOL_GROUP ** -0.5
    pool_scale = 1.0 + 0.1 * jax.random.normal(ks[4], (DEPTH, BRANCH_WIDTH), f32)
    conv_w = jax.random.normal(ks[5], (DEPTH, CONV_K, BRANCH_WIDTH), f32) * CONV_K ** -0.5
    conv_b = 0.01 * jax.random.normal(ks[6], (DEPTH, BRANCH_WIDTH), f32)
    w_branch = jax.random.normal(ks[7], (DEPTH, N_BRANCH, BRANCH_WIDTH, D_MODEL), f32) * BRANCH_WIDTH ** -0.5
    w_out = jax.random.normal(ks[8], (DEPTH, D_MODEL, D_MODEL), f32) * D_MODEL ** -0.5
    post_norm_g = 1.0 + 0.05 * jax.random.normal(ks[9], (DEPTH, D_MODEL), f32)
    return {"x": x, "pre_norm_g": pre_norm_g, "w_in": w_in, "pool_w": pool_w,
            "pool_scale": pool_scale, "conv_w": conv_w, "conv_b": conv_b,
            "w_branch": w_branch, "w_out": w_out, "post_norm_g": post_norm_g}


def reference(x, pre_norm_g, w_in, pool_w, pool_scale, conv_w, conv_b, w_branch, w_out, post_norm_g):
    for l in range(DEPTH):
        x = hybrid_layer(x, pre_norm_g[l], w_in[l], pool_w[l], pool_scale[l], conv_w[l],
                         conv_b[l], w_branch[l], w_out[l], post_norm_g[l])
    return x
```

```cpp
#include <hip/hip_runtime.h>
#include <hip/hip_cooperative_groups.h>
#include <cstdio>
#include <cstdint>
namespace cg = cooperative_groups;
#ifndef ONE_LAUNCH
#define ONE_LAUNCH 0
#endif
namespace pg8 {
#define PG8_LAS __attribute__((address_space(3)))
typedef unsigned short bf16_t;
typedef short bf16x8 __attribute__((ext_vector_type(8)));
typedef float f32x4 __attribute__((ext_vector_type(4)));
typedef unsigned u32x4 __attribute__((ext_vector_type(4)));
constexpr int BM = 256, BK = 64, HALF = 128, HTB = HALF * BK * 2  , STAGE_BYTES = 8 * HTB, NXCD = 8, WGM = 8;

__host__ __device__ __forceinline__ int lds_byte(int r, int c) { const int st = (r >> 4) * 2 + (c >> 5), rr = r & 15, cc = c & 31, ob = rr * 64 + cc * 2; return st * 1024 + (ob ^ (((ob >> 9) & 1) << 5)); }
__host__ __device__ __forceinline__ void stage_rc(int b, int& R, int& C) { const int st = b / 1024, sb = b % 1024, swz = sb ^ (((sb >> 9) & 1) << 5); R = (st >> 1) * 16 + swz / 64; C = (st & 1) * 32 + (swz % 64) / 2; }
__host__ __device__ __forceinline__ int perm32(int rho) { const int n = rho >> 4, i = rho & 15; return 8 * (i >> 2) + 4 * n + (i & 3); }

struct Unit { int pm, pn, az; };
struct Gemm { const bf16_t* A; const bf16_t* Bt; int M, N, K; size_t azs; };

struct StaticOrder {
    int nM, nN, nwg, G, c;
    __host__ __device__ void init(int M, int N, int G_, int c_) { nM = M / BM; nN = N / BM; nwg = nM * nN; G = G_; c = c_; }
    __host__ __device__ bool next(int i, Unit& u) const {
        const long L = (long)i * G + c; if (L >= nwg) return false;
        int wgid = (int)L; { const int q = nwg / NXCD, r = nwg % NXCD, xcd = wgid % NXCD, off = wgid / NXCD; wgid = (xcd < r ? xcd * (q + 1) : r * (q + 1) + (xcd - r) * q) + off; }
        const int nig = WGM * nN, gid = wgid / nig, fm = gid * WGM, gsz = (nM - fm) < WGM ? (nM - fm) : WGM;
        u.pm = fm + ((wgid % nig) % gsz); u.pn = (wgid % nig) / gsz; u.az = 0; return true;
    }
    __device__ __forceinline__ void a_ready(const Unit&) const {}
    __device__ __forceinline__ void done(const Unit&) const {}
};

__device__ __forceinline__ unsigned cvt_pk_bf16(float lo, float hi) { unsigned r; asm volatile("v_cvt_pk_bf16_f32 %0, %1, %2" : "=v"(r) : "v"(lo), "v"(hi)); return r; }
template <class Epi, class Sched, bool ALIGN_EPI = false, bool SP2 = false>
__device__ __forceinline__ void gemm_phase(PG8_LAS unsigned char* lds, const Gemm g, const Sched& S, const Epi& E) {
    const int tid = threadIdx.x, wid = __builtin_amdgcn_readfirstlane(tid >> 6), lane = tid & 63, wr = wid >> 2, wc = wid & 3, fr = lane & 15, fq = lane >> 4;
    const int K = g.K, nt = K / BK;
    unsigned voffA[2], voffB[2];
#pragma unroll
    for (int i = 0; i < 2; ++i) { int R, C; stage_rc(tid * 16 + i * 8192, R, C); const int Rb = Epi::PERM ? ((R & ~31) + perm32(R & 31)) : R;
        voffA[i] = (unsigned)(R * K + C) * 2u; voffB[i] = (unsigned)(Rb * K + C) * 2u; }
    const size_t kstep = (size_t)(BK * 2);
    const size_t hstep = (size_t)HALF * K * 2;
    const size_t tstep = 2 * hstep;
    const unsigned ldsw = (unsigned)wid * 1024u;
    const int aoff = lds_byte(wr * 64 + fr, fq * 8), boff = lds_byte(wc * 32 + fr, fq * 8);
#define PG8_SA(b, h) (((b) * 2 + (h)) * HTB)
#define PG8_SB(b, h) ((4 + (b) * 2 + (h)) * HTB)
#define PG8_STAGE(bufoff, gbase, voff) do { _Pragma("unroll") for (int _i = 0; _i < 2; ++_i) \
        __builtin_amdgcn_global_load_lds((const unsigned*)((const char*)(gbase) + (voff)[_i]), (PG8_LAS unsigned*)(lds + (bufoff) + ldsw + _i * 8192), 16, 0, 0); } while (0)
#define PG8_LDA(dst, b, h) do { _Pragma("unroll") for (int m = 0; m < 4; ++m) _Pragma("unroll") for (int k = 0; k < 2; ++k) dst[m][k] = *(const PG8_LAS bf16x8*)(lds + PG8_SA(b, h) + aoff + m * 2048 + k * 1024); } while (0)
#define PG8_LDB(dst, b, h) do { _Pragma("unroll") for (int n = 0; n < 2; ++n) _Pragma("unroll") for (int k = 0; k < 2; ++k) dst[n][k] = *(const PG8_LAS bf16x8*)(lds + PG8_SB(b, h) + boff + n * 2048 + k * 1024); } while (0)
#define PG8_MMA(ai, bj, At, Bt) do { __builtin_amdgcn_s_setprio(1); _Pragma("unroll") for (int m = 0; m < 4; ++m) _Pragma("unroll") for (int n = 0; n < 2; ++n) _Pragma("unroll") for (int k = 0; k < 2; ++k) \
        acc[ai][bj][m][n] = __builtin_amdgcn_mfma_f32_16x16x32_bf16(Bt[n][k], At[m][k], acc[ai][bj][m][n], 0, 0, 0); __builtin_amdgcn_s_setprio(0); } while (0)
#define PG8_WAIT_V(n) asm volatile("s_waitcnt vmcnt(" #n ")" ::: "memory")
#define PG8_WAIT_L(n) asm volatile("s_waitcnt lgkmcnt(" #n ")" ::: "memory")
#define PG8_BAR __builtin_amdgcn_s_barrier()
#define PG8_SCHED __builtin_amdgcn_sched_barrier(0)
    Unit cur, nxt; int ui = 0;
    if (!S.next(0, cur)) return;
    f32x4 acc[2][2][4][2];
#pragma unroll
    for (int a = 0; a < 2; ++a)
#pragma unroll
        for (int b = 0; b < 2; ++b)
#pragma unroll
            for (int m = 0; m < 4; ++m)
#pragma unroll
                for (int n = 0; n < 2; ++n) acc[a][b][m][n] = (f32x4){0.f, 0.f, 0.f, 0.f};
    bf16x8 At[4][2], B0[2][2], B1[2][2];
    const char* cA = (const char*)g.A + (size_t)cur.pm * tstep + (size_t)cur.az * g.azs; const char* cB = (const char*)g.Bt + (size_t)cur.pn * tstep;
    S.a_ready(cur);
    if constexpr (SP2) {
        PG8_STAGE(PG8_SB(0, 0), cB, voffB); PG8_STAGE(PG8_SB(0, 1), cB + hstep, voffB); PG8_STAGE(PG8_SA(0, 0), cA, voffA); PG8_STAGE(PG8_SA(0, 1), cA + hstep, voffA);
        if (wr == 1) PG8_BAR;
        PG8_WAIT_V(2); PG8_BAR;
        PG8_STAGE(PG8_SB(1, 0), cB + kstep, voffB); PG8_STAGE(PG8_SA(1, 0), cA + kstep, voffA); PG8_STAGE(PG8_SB(1, 1), cB + hstep + kstep, voffB);
        PG8_WAIT_V(6); PG8_BAR;
    } else {
        PG8_STAGE(PG8_SB(0, 0), cB, voffB); PG8_STAGE(PG8_SA(0, 0), cA, voffA); PG8_STAGE(PG8_SB(0, 1), cB + hstep, voffB); PG8_STAGE(PG8_SA(0, 1), cA + hstep, voffA);
        if (wr == 1) PG8_BAR;
        PG8_WAIT_V(4); PG8_BAR;
        PG8_STAGE(PG8_SB(1, 0), cB + kstep, voffB); PG8_STAGE(PG8_SA(1, 0), cA + kstep, voffA); PG8_STAGE(PG8_SB(1, 1), cB + hstep + kstep, voffB);
        PG8_WAIT_V(6); PG8_BAR;
    }
    for (;;) {
        const bool has_next = S.next(ui + 1, nxt);
        const char* nA = has_next ? (const char*)g.A + (size_t)nxt.pm * tstep + (size_t)nxt.az * g.azs : cA; const char* nB = has_next ? (const char*)g.Bt + (size_t)nxt.pn * tstep : cB;
        for (int t = 0; t < nt; t += 2) {
            const bool last = (t == nt - 2);
            const char* a1 = cA + (size_t)(t + 1) * kstep;
            const char* a2 = last ? nA : cA + (size_t)(t + 2) * kstep; const char* b2 = last ? nB : cB + (size_t)(t + 2) * kstep;
            const char* a3 = a2 + kstep; const char* b3 = b2 + kstep;
            if (last && has_next) S.a_ready(nxt);
            if constexpr (SP2) {
            PG8_LDB(B0, 0, 0); PG8_LDB(B1, 0, 1); PG8_SCHED; PG8_LDA(At, 0, 0); PG8_STAGE(PG8_SA(1, 1), a1 + hstep, voffA);
            PG8_WAIT_V(8); PG8_WAIT_L(0); PG8_BAR; PG8_MMA(0, 0, At, B0); PG8_MMA(0, 1, At, B1); PG8_BAR; PG8_SCHED;
            PG8_LDA(At, 0, 1); PG8_STAGE(PG8_SB(0, 0), b2, voffB); PG8_STAGE(PG8_SB(0, 1), b2 + hstep, voffB); PG8_STAGE(PG8_SA(0, 0), a2, voffA);
            PG8_WAIT_V(8); PG8_WAIT_L(0); PG8_BAR; PG8_MMA(1, 0, At, B0); PG8_MMA(1, 1, At, B1); PG8_BAR; PG8_SCHED;
            PG8_LDB(B0, 1, 0); PG8_LDB(B1, 1, 1); PG8_SCHED; PG8_LDA(At, 1, 0); PG8_STAGE(PG8_SA(0, 1), a2 + hstep, voffA);
            PG8_WAIT_V(8); PG8_WAIT_L(0); PG8_BAR; PG8_MMA(0, 0, At, B0); PG8_MMA(0, 1, At, B1); PG8_BAR; PG8_SCHED;
            PG8_LDA(At, 1, 1); PG8_STAGE(PG8_SB(1, 0), b3, voffB); PG8_STAGE(PG8_SB(1, 1), b3 + hstep, voffB); PG8_STAGE(PG8_SA(1, 0), a3, voffA);
            PG8_WAIT_V(8); PG8_WAIT_L(0); PG8_BAR; PG8_MMA(1, 0, At, B0); PG8_MMA(1, 1, At, B1); PG8_BAR; PG8_SCHED;
            } else {
            PG8_LDB(B0, 0, 0); PG8_SCHED; PG8_LDA(At, 0, 0); PG8_STAGE(PG8_SA(1, 1), a1 + hstep, voffA);
            PG8_WAIT_L(8); PG8_BAR; PG8_WAIT_L(0); PG8_MMA(0, 0, At, B0); PG8_BAR; PG8_SCHED;
            PG8_LDB(B1, 0, 1); PG8_STAGE(PG8_SB(0, 0), b2, voffB);
            PG8_BAR; PG8_WAIT_L(0); PG8_MMA(0, 1, At, B1); PG8_BAR;
            PG8_LDA(At, 0, 1); PG8_STAGE(PG8_SA(0, 0), a2, voffA);
            PG8_BAR; PG8_WAIT_L(0); PG8_MMA(1, 0, At, B0); PG8_BAR; PG8_SCHED;
            PG8_STAGE(PG8_SB(0, 1), b2 + hstep, voffB);
            PG8_WAIT_V(6); PG8_BAR; PG8_MMA(1, 1, At, B1); PG8_BAR;
            PG8_LDB(B0, 1, 0); PG8_SCHED; PG8_LDA(At, 1, 0); PG8_STAGE(PG8_SA(0, 1), a2 + hstep, voffA);
            PG8_WAIT_L(8); PG8_BAR; PG8_WAIT_L(0); PG8_MMA(0, 0, At, B0); PG8_BAR; PG8_SCHED;
            PG8_LDB(B1, 1, 1); PG8_STAGE(PG8_SB(1, 0), b3, voffB);
            PG8_BAR; PG8_WAIT_L(0); PG8_MMA(0, 1, At, B1); PG8_BAR;
            PG8_LDA(At, 1, 1); PG8_STAGE(PG8_SA(1, 0), a3, voffA);
            PG8_BAR; PG8_WAIT_L(0); PG8_MMA(1, 0, At, B0); PG8_BAR; PG8_SCHED;
            PG8_STAGE(PG8_SB(1, 1), b3 + hstep, voffB);
            PG8_WAIT_V(6); PG8_BAR; PG8_MMA(1, 1, At, B1); PG8_BAR;
            }
        }
        if constexpr (ALIGN_EPI) { if (wr == 0) PG8_BAR; }
        if constexpr (!Epi::AFTER_DRAIN) { E(acc, cur, wr, wc, fr, fq); S.done(cur); }
        if (!has_next) break;
#pragma unroll
        for (int a = 0; a < 2; ++a)
#pragma unroll
            for (int b = 0; b < 2; ++b)
#pragma unroll
                for (int m = 0; m < 4; ++m)
#pragma unroll
                    for (int n = 0; n < 2; ++n) acc[a][b][m][n] = (f32x4){0.f, 0.f, 0.f, 0.f};
        cur = nxt; cA = nA; cB = nB; ++ui;
        if constexpr (ALIGN_EPI) { if (wr == 1) PG8_BAR; }
    }
    PG8_WAIT_V(0);
    if constexpr (!ALIGN_EPI) { if (wr == 0) PG8_BAR; }
    PG8_BAR;
    if constexpr (Epi::AFTER_DRAIN) { E.fused(acc, cur, wr, wc, fr, fq, lds, wid, lane); S.done(cur); }
#undef PG8_SA
#undef PG8_SB
#undef PG8_STAGE
#undef PG8_LDA
#undef PG8_LDB
#undef PG8_MMA
#undef PG8_WAIT_V
#undef PG8_WAIT_L
#undef PG8_BAR
#undef PG8_SCHED
}
}

#define LAS __attribute__((address_space(3)))
typedef unsigned short bf16_t;
typedef short bf16x8 __attribute__((ext_vector_type(8)));
typedef short s16x4 __attribute__((ext_vector_type(4)));
typedef float f32x4 __attribute__((ext_vector_type(4)));
typedef float f32x16 __attribute__((ext_vector_type(16)));
typedef unsigned u32x4 __attribute__((ext_vector_type(4)));
typedef unsigned u32x2 __attribute__((ext_vector_type(2)));
constexpr int NB = 4, SEQ = 4096, DM = 1024, MTOK = NB * SEQ, NIN = 8192, BWID = 512, NLAYER = 2;
constexpr float RMS_EPS = 1e-6f;
constexpr size_t MiB = 1u << 20;
constexpr size_t WS_RS = 0;
constexpr size_t WS_W1 = 2 * MiB;
constexpr size_t WS_W2 = 34 * MiB;
constexpr size_t WS_W3 = 40 * MiB;
constexpr size_t WS_PW = 44 * MiB;
constexpr size_t WS_H = 45 * MiB;
constexpr size_t WS_U = 77 * MiB;
constexpr size_t ARRB = 16 * MiB;
constexpr size_t WS_MG = 205 * MiB;
constexpr size_t WS_END = 253 * MiB;
constexpr int LDS_BYTES = 147456;
constexpr int NPHASE = 1 + 5 * NLAYER;

__device__ __forceinline__ unsigned f2bf(float f) { unsigned u = __builtin_bit_cast(unsigned, f); return (u + 0x7fffu + ((u >> 16) & 1u)) >> 16; }
__device__ __forceinline__ unsigned pk2(float lo, float hi) { return f2bf(lo) | (f2bf(hi) << 16); }
__device__ __forceinline__ float bflo(unsigned u) { return __builtin_bit_cast(float, u << 16); }
__device__ __forceinline__ float bfhi(unsigned u) { return __builtin_bit_cast(float, u & 0xffff0000u); }
__device__ __forceinline__ float sigmoid_f(float x) { return __builtin_amdgcn_rcpf(1.f + __builtin_amdgcn_exp2f(-1.4426950408889634f * x)); }
__device__ __forceinline__ float silu_f(float x) { return x * sigmoid_f(x); }
__device__ __forceinline__ unsigned q8(float x) { return (unsigned)(sigmoid_f(x) * 255.f + 0.5f); }
__device__ __forceinline__ float wave_sum(float v) {
#pragma unroll
    for (int o = 1; o < 64; o <<= 1) v += __shfl_xor(v, o);
    return v;
}

using pg8::Unit;
struct EpiU {
    static constexpr bool PERM = true, AFTER_DRAIN = false;
    unsigned char* ws;
    __device__ __forceinline__ void operator()(const f32x4 (&acc)[2][2][4][2], const Unit& u, int wr, int wc, int fr, int fq) const {
        bf16_t* U = (bf16_t*)(ws + WS_U); unsigned char* MG = ws + WS_MG;
        const int pn = u.pn; const int row0 = u.pm * 256 + wr * 64 + fr;
        if (pn >= 20) {
            const int mc0 = (pn - 20) * 256 + wc * 32 + 8 * fq;
#pragma unroll
            for (int ai = 0; ai < 2; ++ai)
#pragma unroll
                for (int m = 0; m < 4; ++m) { unsigned char* rp = MG + (size_t)(row0 + ai * 128 + m * 16) * 3072 + mc0;
#pragma unroll
                    for (int bj = 0; bj < 2; ++bj) { const f32x4 v0 = acc[ai][bj][m][0], v1 = acc[ai][bj][m][1]; u32x2 w;
                        w.x = q8(v0[0]) | (q8(v0[1]) << 8) | (q8(v0[2]) << 16) | (q8(v0[3]) << 24); w.y = q8(v1[0]) | (q8(v1[1]) << 8) | (q8(v1[2]) << 16) | (q8(v1[3]) << 24);
                        *(u32x2*)(rp + bj * 128) = w; } }
        } else if (pn >= 4 && pn < 12) {
            const int ch0 = (pn - 4) * 64 + (4 * wc + fq) * 4;
            bf16_t* Z = U + 1 * (ARRB / 2); bf16_t* W = U + 6 * (ARRB / 2);
#pragma unroll
            for (int ai = 0; ai < 2; ++ai)
#pragma unroll
                for (int m = 0; m < 4; ++m) { const size_t ro = (size_t)(row0 + ai * 128 + m * 16) * 512 + ch0;
                    const f32x4 z = acc[ai][0][m][0] * acc[ai][0][m][1]; const f32x4 gb = acc[ai][1][m][0], gg = acc[ai][1][m][1];
                    u32x2 zz, ww; zz.x = pg8::cvt_pk_bf16(z[0], z[1]); zz.y = pg8::cvt_pk_bf16(z[2], z[3]);
                    ww.x = pg8::cvt_pk_bf16(gb[0] * silu_f(gg[0]), gb[1] * silu_f(gg[1])); ww.y = pg8::cvt_pk_bf16(gb[2] * silu_f(gg[2]), gb[3] * silu_f(gg[3]));
                    *(u32x2*)(Z + ro) = zz; *(u32x2*)(W + ro) = ww; }
        } else {
            const int kind = pn >> 1; int arr = 0; bool act = false;
            if (kind == 1) { arr = 5; act = true; } else if (kind == 6) arr = 2; else if (kind == 7) arr = 3; else if (kind == 8) arr = 4; else if (kind == 9) { arr = 7; act = true; }
            bf16_t* O = U + (size_t)arr * (ARRB / 2); const int col0 = (pn & 1) * 256 + wc * 32 + 8 * fq;
#pragma unroll
            for (int ai = 0; ai < 2; ++ai)
#pragma unroll
                for (int m = 0; m < 4; ++m) { bf16_t* rp = O + (size_t)(row0 + ai * 128 + m * 16) * 512 + col0;
#pragma unroll
                    for (int bj = 0; bj < 2; ++bj) { f32x4 v0 = acc[ai][bj][m][0], v1 = acc[ai][bj][m][1];
                        if (act) {
#pragma unroll
                            for (int i = 0; i < 4; ++i) { v0[i] = silu_f(v0[i]); v1[i] = silu_f(v1[i]); } }
                        u32x4 w; w.x = pg8::cvt_pk_bf16(v0[0], v0[1]); w.y = pg8::cvt_pk_bf16(v0[2], v0[3]); w.z = pg8::cvt_pk_bf16(v1[0], v1[1]); w.w = pg8::cvt_pk_bf16(v1[2], v1[3]);
                        *(u32x4*)(rp + bj * 128) = w; } }
        }
    }
};
struct EpiBranch {
    static constexpr bool PERM = true, AFTER_DRAIN = false;
    unsigned char* ws;
    __device__ __forceinline__ void operator()(const f32x4 (&acc)[2][2][4][2], const Unit& u, int wr, int wc, int fr, int fq) const {
        const unsigned char* MG = ws + WS_MG; float* part = (float*)(ws + WS_U); bf16_t* merged = (bf16_t*)(ws + WS_H);
        const int n = u.az, pn = u.pn & 3; const int row0 = u.pm * 256 + wr * 64 + fr, col0 = pn * 256 + wc * 32 + 8 * fq;
#pragma unroll
        for (int ai = 0; ai < 2; ++ai)
#pragma unroll
            for (int m = 0; m < 4; ++m) { const size_t row = (size_t)(row0 + ai * 128 + m * 16);
#pragma unroll
                for (int bj = 0; bj < 2; ++bj) { const int col = col0 + bj * 128;
                    const u32x2 gq = *(const u32x2*)(MG + row * 3072 + n * 1024 + col);
                    f32x4 g0, g1; const float k = 1.f / 255.f;
                    g0[0] = (float)(gq.x & 255u) * k; g0[1] = (float)((gq.x >> 8) & 255u) * k; g0[2] = (float)((gq.x >> 16) & 255u) * k; g0[3] = (float)(gq.x >> 24) * k;
                    g1[0] = (float)(gq.y & 255u) * k; g1[1] = (float)((gq.y >> 8) & 255u) * k; g1[2] = (float)((gq.y >> 16) & 255u) * k; g1[3] = (float)(gq.y >> 24) * k;
                    f32x4 v0 = acc[ai][bj][m][0] * g0, v1 = acc[ai][bj][m][1] * g1;
                    float* pp = part + row * 1024 + col;
                    if (n == 0) { *(f32x4*)pp = v0; *(f32x4*)(pp + 4) = v1; }
                    else { v0 += *(const f32x4*)pp; v1 += *(const f32x4*)(pp + 4);
                        if (n == 1) { *(f32x4*)pp = v0; *(f32x4*)(pp + 4) = v1; }
                        else { u32x4 w; w.x = pg8::cvt_pk_bf16(v0[0], v0[1]); w.y = pg8::cvt_pk_bf16(v0[2], v0[3]); w.z = pg8::cvt_pk_bf16(v1[0], v1[1]); w.w = pg8::cvt_pk_bf16(v1[2], v1[3]);
                            *(u32x4*)(merged + row * 1024 + col) = w; } } } }
    }
};
struct BranchOrder {
    pg8::StaticOrder base;
    __device__ void init(int G, int c) { base.init(MTOK, 1024, G, c); }
    __device__ bool next(int i, Unit& u) const { Unit t; if (!base.next(i / 3, t)) return false; const int n = i % 3; u.pm = t.pm; u.pn = n * 4 + t.pn; u.az = n; return true; }
    __device__ __forceinline__ void a_ready(const Unit&) const {}
    __device__ __forceinline__ void done(const Unit&) const {}
};
struct EpiOut {
    static constexpr bool PERM = false, AFTER_DRAIN = false;
    unsigned char* ws;
    __device__ __forceinline__ void operator()(const f32x4 (&acc)[2][2][4][2], const Unit& u, int wr, int wc, int fr, int fq) const {
        float* out = (float*)(ws + WS_U); float* rs = (float*)(ws + WS_RS);
        const int row0 = u.pm * 256 + wr * 64 + fr, col0 = u.pn * 256 + wc * 32 + 4 * fq;
#pragma unroll
        for (int ai = 0; ai < 2; ++ai)
#pragma unroll
            for (int m = 0; m < 4; ++m) { const size_t row = (size_t)(row0 + ai * 128 + m * 16); float ss = 0.f;
#pragma unroll
                for (int bj = 0; bj < 2; ++bj)
#pragma unroll
                    for (int n = 0; n < 2; ++n) { const f32x4 v = acc[ai][bj][m][n]; *(f32x4*)(out + row * 1024 + col0 + bj * 128 + n * 16) = v; ss += (v[0] * v[0] + v[1] * v[1]) + (v[2] * v[2] + v[3] * v[3]); }
                ss += __shfl_xor(ss, 16); ss += __shfl_xor(ss, 32);
                if (fq == 0) rs[row * 16 + u.pn * 4 + wc] = ss; }
    }
};
__device__ __forceinline__ int win_row(int c) {
    if (c < 1024 || c >= 3072) return c;
    const int q = (c - 1024) >> 9, ch = (c - 1024) & 511, ct = ch >> 6, grp = (ch & 63) >> 2, e = ch & 3;
    return 1024 + ct * 256 + (q & 1) * 128 + grp * 8 + (q >> 1) * 4 + e;
}
__device__ __forceinline__ void transpose_item(const float* W, int K, int N, bf16_t* WT, int row_off, bool winmap, LAS float* scr, int item, int lane) {
    const int nblk = N / 32, kb = item / nblk, nb = item % nblk, k0 = 64 * kb, n0 = 32 * nb;
#pragma unroll 8
    for (int i = 0; i < 32; ++i) { const int kk = 2 * i + (lane >> 5); scr[kk * 33 + (lane & 31)] = W[(size_t)(k0 + kk) * N + n0 + (lane & 31)]; }
    asm volatile("s_waitcnt lgkmcnt(0)" ::: "memory");
    const int c = lane & 7;
#pragma unroll
    for (int j = 0; j < 4; ++j) { const int n = (lane >> 3) + 8 * j; const LAS float* s = scr + (8 * c) * 33 + n;
        u32x4 o; o.x = pk2(s[0 * 33], s[1 * 33]); o.y = pk2(s[2 * 33], s[3 * 33]); o.z = pk2(s[4 * 33], s[5 * 33]); o.w = pk2(s[6 * 33], s[7 * 33]);
        int dst = n0 + n; if (winmap) dst = win_row(dst);
        *(u32x4*)(WT + (size_t)(row_off + dst) * K + k0 + 8 * c) = o; }
    asm volatile("s_waitcnt lgkmcnt(0)" ::: "memory");
}
__device__ __forceinline__ void rms_row_to_bf16(const float* xrow, const float* g, bf16_t* orow, int lane) {
    const f32x4* xr = (const f32x4*)xrow + lane; const f32x4* gr = (const f32x4*)g + lane;
    f32x4 v[4]; float s = 0.f;
#pragma unroll
    for (int j = 0; j < 4; ++j) { v[j] = xr[64 * j]; s += (v[j][0] * v[j][0] + v[j][1] * v[j][1]) + (v[j][2] * v[j][2] + v[j][3] * v[j][3]); }
    const float rstd = 1.f / sqrtf(wave_sum(s) * (1.f / DM) + RMS_EPS);
    u32x2* o8 = (u32x2*)orow + lane;
#pragma unroll
    for (int j = 0; j < 4; ++j) { const f32x4 gg = gr[64 * j]; u32x2 w; w.x = pk2(v[j][0] * rstd * gg[0], v[j][1] * rstd * gg[1]); w.y = pk2(v[j][2] * rstd * gg[2], v[j][3] * rstd * gg[3]); o8[64 * j] = w; }
}

__device__ __forceinline__ int crow(int r, int hi) { return (r & 3) + 8 * (r >> 2) + 4 * hi; }
constexpr int VROW = 144;
__device__ __forceinline__ void attn_item(int item, const bf16_t* Q, const bf16_t* K, const bf16_t* V, bf16_t* SG, LAS unsigned char* vl, int lane) {
    const int qg = item & 127, h = (item >> 7) & 7, b = item >> 10;
    const int r32 = lane & 31, hi = lane >> 5, t0 = qg * 32;
    const size_t tokq = (size_t)b * SEQ + t0 + r32;
    bf16x8 qf[4];
#pragma unroll
    for (int d0 = 0; d0 < 4; ++d0) qf[d0] = *(const bf16x8*)(Q + tokq * 512 + h * 64 + d0 * 16 + 8 * hi);
    f32x16 o0, o1;
#pragma unroll
    for (int r = 0; r < 16; ++r) { o0[r] = 0.f; o1[r] = 0.f; }
    float P = 1.f;
    const int i16 = lane & 15, G4 = lane >> 4;
    const int vb = (4 * (G4 >> 1) + (i16 >> 2)) * VROW + (16 * (G4 & 1) + 4 * (i16 & 3)) * 2;
    for (int s0 = t0; s0 >= 0; s0 -= 32) {
        const size_t tokk = (size_t)b * SEQ + s0;
        bf16x8 kf[4];
#pragma unroll
        for (int d0 = 0; d0 < 4; ++d0) kf[d0] = *(const bf16x8*)(K + (tokk + r32) * 512 + h * 64 + d0 * 16 + 8 * hi);
#pragma unroll
        for (int p = 0; p < 4; ++p) { const int idx = p * 64 + lane, key = idx >> 3, ch = idx & 7;
            const u32x4 v = *(const u32x4*)(V + (tokk + key) * 512 + h * 64 + ch * 8);
            *(LAS u32x4*)(vl + key * VROW + ch * 16) = v; }
        f32x16 s;
#pragma unroll
        for (int r = 0; r < 16; ++r) s[r] = 0.f;
#pragma unroll
        for (int d0 = 0; d0 < 4; ++d0) s = __builtin_amdgcn_mfma_f32_32x32x16_bf16(kf[d0], qf[d0], s, 0, 0, 0);
        const bool diag = (s0 == t0);
        float kp[16];
#pragma unroll
        for (int r = 0; r < 16; ++r) { const float e = __builtin_amdgcn_exp2f(s[r] * (0.125f * 1.4426950408889634f)); float k = __builtin_amdgcn_rcpf(1.f + e);
            if (diag && crow(r, hi) >= r32) k = 1.f; kp[r] = k; }
        float Gm[4], Go[4], T[4], R[4], C[4];
#pragma unroll
        for (int g = 0; g < 4; ++g) { Gm[g] = (kp[4 * g] * kp[4 * g + 1]) * (kp[4 * g + 2] * kp[4 * g + 3]); Go[g] = __shfl_xor(Gm[g], 32); T[g] = Gm[g] * Go[g]; }
        R[3] = P; R[2] = R[3] * T[3]; R[1] = R[2] * T[2]; R[0] = R[1] * T[1]; const float Cout = R[0] * T[0];
#pragma unroll
        for (int g = 0; g < 4; ++g) C[g] = hi ? R[g] : R[g] * Go[g];
        float w[16];
#pragma unroll
        for (int g = 0; g < 4; ++g) { const float p3 = C[g], p2 = p3 * kp[4 * g + 3], p1 = p2 * kp[4 * g + 2], p0 = p1 * kp[4 * g + 1], pe = p0 * kp[4 * g];
            w[4 * g + 3] = p3 - p2; w[4 * g + 2] = p2 - p1; w[4 * g + 1] = p1 - p0; w[4 * g] = p0 - pe; }
        bf16x8 wf[2];
#pragma unroll
        for (int st = 0; st < 2; ++st) { u32x4 t; t.x = pk2(w[8 * st], w[8 * st + 1]); t.y = pk2(w[8 * st + 2], w[8 * st + 3]); t.z = pk2(w[8 * st + 4], w[8 * st + 5]); t.w = pk2(w[8 * st + 6], w[8 * st + 7]); wf[st] = __builtin_bit_cast(bf16x8, t); }
#pragma unroll
        for (int dt = 0; dt < 2; ++dt)
#pragma unroll
            for (int st = 0; st < 2; ++st) {
                const s16x4 lo = __builtin_amdgcn_ds_read_tr16_b64_v4i16((LAS s16x4*)(vl + vb + (16 * st) * VROW + dt * 64));
                const s16x4 hh = __builtin_amdgcn_ds_read_tr16_b64_v4i16((LAS s16x4*)(vl + vb + (16 * st + 8) * VROW + dt * 64));
                const bf16x8 vf = (bf16x8){lo[0], lo[1], lo[2], lo[3], hh[0], hh[1], hh[2], hh[3]};
                if (dt == 0) o0 = __builtin_amdgcn_mfma_f32_32x32x16_bf16(vf, wf[st], o0, 0, 0, 0); else o1 = __builtin_amdgcn_mfma_f32_32x32x16_bf16(vf, wf[st], o1, 0, 0, 0); }
        P = Cout;
        if (__all(P < 1.17549435e-38f)) break;
    }
#pragma unroll
    for (int dt = 0; dt < 2; ++dt)
#pragma unroll
        for (int g = 0; g < 4; ++g) { bf16_t* p = SG + tokq * 512 + h * 64 + dt * 32 + 8 * g + 4 * hi; const u32x2 sg = *(const u32x2*)p;
            const f32x16& o = dt ? o1 : o0; u32x2 y;
            y.x = pk2(o[4 * g] * bflo(sg.x), o[4 * g + 1] * bfhi(sg.x)); y.y = pk2(o[4 * g + 2] * bflo(sg.y), o[4 * g + 3] * bfhi(sg.y));
            *(u32x2*)p = y; }
}
__device__ __forceinline__ void pool_item(int pi, const bf16_t* PV, bf16_t* SG, const bf16_t* PT, const float* scale, int lane) {
    const int tile = pi >> 2, g = ((pi & 3) + ((pi >> 2) & 1)) & 3, win = 2 << g;
    const int r32 = lane & 31, hi = lane >> 5, tok = tile * 32 + r32, t = tok & (SEQ - 1);
    const bf16_t* vp = PV + (size_t)tok * 512 + g * 128 + 8 * hi;
    const int cnt = (t + 1) < win ? (t + 1) : win;
    float sum[8][8];
#pragma unroll
    for (int s = 0; s < 8; ++s) { const u32x4 raw = *(const u32x4*)(vp + 16 * s); const float f = 1.f - (float)cnt;
        sum[s][0] = bflo(raw.x) * f; sum[s][1] = bfhi(raw.x) * f; sum[s][2] = bflo(raw.y) * f; sum[s][3] = bfhi(raw.y) * f;
        sum[s][4] = bflo(raw.z) * f; sum[s][5] = bfhi(raw.z) * f; sum[s][6] = bflo(raw.w) * f; sum[s][7] = bfhi(raw.w) * f; }
    for (int jj = 1; jj < win; ++jj) {
        if (t - jj >= 0) {
#pragma unroll
            for (int s = 0; s < 8; ++s) { const u32x4 raw = *(const u32x4*)(vp - (size_t)jj * 512 + 16 * s);
                sum[s][0] += bflo(raw.x); sum[s][1] += bfhi(raw.x); sum[s][2] += bflo(raw.y); sum[s][3] += bfhi(raw.y);
                sum[s][4] += bflo(raw.z); sum[s][5] += bfhi(raw.z); sum[s][6] += bflo(raw.w); sum[s][7] += bfhi(raw.w); } }
    }
    const float inv = 1.f / (float)cnt;
    bf16x8 pf[8];
#pragma unroll
    for (int s = 0; s < 8; ++s) { u32x4 tt; tt.x = pk2(sum[s][0] * inv, sum[s][1] * inv); tt.y = pk2(sum[s][2] * inv, sum[s][3] * inv); tt.z = pk2(sum[s][4] * inv, sum[s][5] * inv); tt.w = pk2(sum[s][6] * inv, sum[s][7] * inv); pf[s] = __builtin_bit_cast(bf16x8, tt); }
#pragma unroll
    for (int nt = 0; nt < 4; ++nt) {
        f32x16 acc;
#pragma unroll
        for (int r = 0; r < 16; ++r) acc[r] = 0.f;
        const bf16_t* ap = PT + (size_t)(g * 128 + nt * 32 + r32) * 128 + 8 * hi;
#pragma unroll
        for (int s = 0; s < 8; ++s) { const bf16x8 a = *(const bf16x8*)(ap + 16 * s); acc = __builtin_amdgcn_mfma_f32_32x32x16_bf16(a, pf[s], acc, 0, 0, 0); }
#pragma unroll
        for (int q = 0; q < 4; ++q) { const int d = g * 128 + nt * 32 + 8 * q + 4 * hi; const f32x4 sc = *(const f32x4*)(scale + d);
            bf16_t* p = SG + (size_t)tok * 512 + d; const u32x2 sg = *(const u32x2*)p; u32x2 y;
            y.x = pk2(acc[4 * q] * sc[0] * bflo(sg.x), acc[4 * q + 1] * sc[1] * bfhi(sg.x)); y.y = pk2(acc[4 * q + 2] * sc[2] * bflo(sg.y), acc[4 * q + 3] * sc[3] * bfhi(sg.y));
            *(u32x2*)p = y; }
    }
}
__device__ __forceinline__ void conv_item(int ci, const bf16_t* Z, bf16_t* Wy, const float* cw, const float* cb, int lane) {
    const int tok0 = ci * 8, t0 = tok0 & (SEQ - 1), ch = lane * 8;
    float w0[8], w1[8], w2[8], bs[8], zm2[8], zm1[8];
#pragma unroll
    for (int hf = 0; hf < 2; ++hf) { const f32x4 a = *(const f32x4*)(cw + ch + 4 * hf), b = *(const f32x4*)(cw + 512 + ch + 4 * hf), c = *(const f32x4*)(cw + 1024 + ch + 4 * hf), d = *(const f32x4*)(cb + ch + 4 * hf);
#pragma unroll
        for (int i = 0; i < 4; ++i) { w0[4 * hf + i] = a[i]; w1[4 * hf + i] = b[i]; w2[4 * hf + i] = c[i]; bs[4 * hf + i] = d[i]; } }
#pragma unroll
    for (int i = 0; i < 8; ++i) { zm2[i] = 0.f; zm1[i] = 0.f; }
    if (t0 != 0) { const u32x4 a = *(const u32x4*)(Z + (size_t)(tok0 - 2) * 512 + ch), b = *(const u32x4*)(Z + (size_t)(tok0 - 1) * 512 + ch);
        zm2[0] = bflo(a.x); zm2[1] = bfhi(a.x); zm2[2] = bflo(a.y); zm2[3] = bfhi(a.y); zm2[4] = bflo(a.z); zm2[5] = bfhi(a.z); zm2[6] = bflo(a.w); zm2[7] = bfhi(a.w);
        zm1[0] = bflo(b.x); zm1[1] = bfhi(b.x); zm1[2] = bflo(b.y); zm1[3] = bfhi(b.y); zm1[4] = bflo(b.z); zm1[5] = bfhi(b.z); zm1[6] = bflo(b.w); zm1[7] = bfhi(b.w); }
#pragma unroll
    for (int r = 0; r < 8; ++r) { const size_t off = (size_t)(tok0 + r) * 512 + ch; const u32x4 zr = *(const u32x4*)(Z + off), wr_ = *(const u32x4*)(Wy + off);
        float zc[8], wv[8], y[8];
        zc[0] = bflo(zr.x); zc[1] = bfhi(zr.x); zc[2] = bflo(zr.y); zc[3] = bfhi(zr.y); zc[4] = bflo(zr.z); zc[5] = bfhi(zr.z); zc[6] = bflo(zr.w); zc[7] = bfhi(zr.w);
        wv[0] = bflo(wr_.x); wv[1] = bfhi(wr_.x); wv[2] = bflo(wr_.y); wv[3] = bfhi(wr_.y); wv[4] = bflo(wr_.z); wv[5] = bfhi(wr_.z); wv[6] = bflo(wr_.w); wv[7] = bfhi(wr_.w);
#pragma unroll
        for (int i = 0; i < 8; ++i) { y[i] = wv[i] * (w0[i] * zm2[i] + w1[i] * zm1[i] + w2[i] * zc[i] + bs[i]); zm2[i] = zm1[i]; zm1[i] = zc[i]; }
        u32x4 o; o.x = pk2(y[0], y[1]); o.y = pk2(y[2], y[3]); o.z = pk2(y[4], y[5]); o.w = pk2(y[6], y[7]);
        *(u32x4*)(Wy + off) = o; }
}
__device__ __forceinline__ void norm_row(const float* orow, const float* rs16, const float* xin, const float* gpost, float* xout, const float* gnext, bf16_t* hrow, int lane) {
    float ss = (lane < 16) ? rs16[lane] : 0.f; ss = wave_sum(ss);
    const float rstd = 1.f / sqrtf(ss * (1.f / DM) + RMS_EPS);
    f32x4 v[4]; float s2 = 0.f;
#pragma unroll
    for (int j = 0; j < 4; ++j) { const f32x4 o = ((const f32x4*)orow)[64 * j + lane], xi = ((const f32x4*)xin)[64 * j + lane], gp = ((const f32x4*)gpost)[64 * j + lane];
        v[j] = xi + o * rstd * gp; ((f32x4*)xout)[64 * j + lane] = v[j]; s2 += (v[j][0] * v[j][0] + v[j][1] * v[j][1]) + (v[j][2] * v[j][2] + v[j][3] * v[j][3]); }
    if (gnext) { const float r2 = 1.f / sqrtf(wave_sum(s2) * (1.f / DM) + RMS_EPS);
#pragma unroll
        for (int j = 0; j < 4; ++j) { const f32x4 gg = ((const f32x4*)gnext)[64 * j + lane]; u32x2 w; w.x = pk2(v[j][0] * r2 * gg[0], v[j][1] * r2 * gg[1]); w.y = pk2(v[j][2] * r2 * gg[2], v[j][3] * r2 * gg[3]); ((u32x2*)hrow)[64 * j + lane] = w; } }
}

struct Args { const float* in[10]; float* out; unsigned char* ws; int ph_lo, ph_hi; };
#define ARGP() ({ const Args* p_ = ap0; asm volatile("" : "+s"(p_)); p_; })
template <int ph> __device__ __forceinline__ void run_phase(const Args* ap0, LAS unsigned char* lds) {
        const Args* A = ARGP();
        const int tid = threadIdx.x, lane = tid & 63, wave = __builtin_amdgcn_readfirstlane(tid >> 6);
        const int G = gridDim.x, bx = blockIdx.x;
        const int vcu = (G % 8 == 0) ? (bx % 8) * (G / 8) + bx / 8 : bx;
        const int gw = vcu * 8 + wave, NGW = G * 8;
        unsigned char* ws = A->ws;
        bf16_t* H = (bf16_t*)(ws + WS_H); bf16_t* U = (bf16_t*)(ws + WS_U);
        if constexpr (ph == 0) {
            const float* x = A->in[0]; const float* pre_g = A->in[1]; const float* w_in = A->in[2]; const float* pool_w = A->in[3]; const float* w_branch = A->in[7]; const float* w_out = A->in[8];
            bf16_t* W1 = (bf16_t*)(ws + WS_W1); bf16_t* W2 = (bf16_t*)(ws + WS_W2); bf16_t* W3 = (bf16_t*)(ws + WS_W3); bf16_t* PW = (bf16_t*)(ws + WS_PW);
            LAS float* scr = (LAS float*)(lds + wave * 16384);
            constexpr int I1 = (DM / 64) * (NIN / 32), I2 = (BWID / 64) * (DM / 32), I3 = (DM / 64) * (DM / 32), I4 = 2 * 4, PER = I1 + 3 * I2 + I3 + 4 * I4;
            for (int it = gw; it < NLAYER * PER; it += NGW) {
                const int l = it / PER; int r = it % PER;
                if (r < I1) { transpose_item(w_in + (size_t)l * DM * NIN, DM, NIN, W1 + (size_t)l * NIN * DM, 0, true, scr, r, lane); continue; } r -= I1;
                if (r < 3 * I2) { const int n = r / I2; transpose_item(w_branch + ((size_t)l * 3 + n) * BWID * DM, BWID, DM, W2 + (size_t)l * 3 * DM * BWID, n * DM, false, scr, r % I2, lane); continue; } r -= 3 * I2;
                if (r < I3) { transpose_item(w_out + (size_t)l * DM * DM, DM, DM, W3 + (size_t)l * DM * DM, 0, false, scr, r, lane); continue; } r -= I3;
                { const int g = r / I4; transpose_item(pool_w + ((size_t)l * 4 + g) * 128 * 128, 128, 128, PW + ((size_t)l * 4 + g) * 128 * 128, 0, false, scr, r % I4, lane); }
            }
            for (int m = gw; m < MTOK; m += NGW) rms_row_to_bf16(x + (size_t)m * DM, pre_g, H + (size_t)m * DM, lane);
        } else {
            constexpr int l = (ph - 1) / 5, k = (ph - 1) % 5;
            if constexpr (k == 0) {
                pg8::Gemm g{H, (bf16_t*)(ws + WS_W1) + (size_t)l * NIN * DM, MTOK, NIN, DM, 0}; pg8::StaticOrder S; S.init(MTOK, NIN, G, bx);
                EpiU E{ws};
                pg8::gemm_phase<EpiU, pg8::StaticOrder, true, true>(lds, g, S, E);
            } else if constexpr (k == 1) {
                const float* pool_scale = A->in[4]; const float* conv_w = A->in[5]; const float* conv_b = A->in[6];
                const bf16_t* PW = (const bf16_t*)(ws + WS_PW);
                const bf16_t* Q = U + 2 * (ARRB / 2); const bf16_t* Kk = U + 3 * (ARRB / 2); const bf16_t* V = U + 4 * (ARRB / 2);
                LAS unsigned char* vl = lds + wave * (32 * VROW);
                for (int it = gw; it < NB * 8 * 128; it += NGW) attn_item(it, Q, Kk, V, U + 7 * (ARRB / 2), vl, lane);
                for (int it = gw; it < (MTOK / 32) * 4; it += NGW) pool_item(it, U, U + 5 * (ARRB / 2), PW + (size_t)l * 4 * 128 * 128, pool_scale + l * BWID, lane);
                for (int it = gw; it < MTOK / 8; it += NGW) conv_item(it, U + 1 * (ARRB / 2), U + 6 * (ARRB / 2), conv_w + l * 3 * BWID, conv_b + l * BWID, lane);
            } else if constexpr (k == 2) {
                pg8::Gemm g{U + 5 * (ARRB / 2), (bf16_t*)(ws + WS_W2) + (size_t)l * 3 * DM * BWID, MTOK, DM, BWID, ARRB}; BranchOrder S; S.init(G, bx);
                EpiBranch E{ws};
                pg8::gemm_phase<EpiBranch, BranchOrder, true, true>(lds, g, S, E);
            } else if constexpr (k == 3) {
                pg8::Gemm g{H, (bf16_t*)(ws + WS_W3) + (size_t)l * DM * DM, MTOK, DM, DM, 0}; pg8::StaticOrder S; S.init(MTOK, DM, G, bx);
                EpiOut E{ws};
                pg8::gemm_phase<EpiOut, pg8::StaticOrder, true, true>(lds, g, S, E);
            } else {
                const float* x = A->in[0]; const float* pre_g = A->in[1]; const float* post_g = A->in[9]; float* out = A->out;
                const float* F32T = (const float*)(ws + WS_U); const float* RS = (const float*)(ws + WS_RS);
                const float* xin = (l == 0) ? x : out; const float* gnext = (l + 1 < NLAYER) ? pre_g + (l + 1) * DM : nullptr;
                for (int m = gw; m < MTOK; m += NGW)
                    norm_row(F32T + (size_t)m * DM, RS + (size_t)m * 16, xin + (size_t)m * DM, post_g + l * DM, out + (size_t)m * DM, gnext, H + (size_t)m * DM, lane);
            }
        }
}
__global__ void __launch_bounds__(512, 2) hybrid_fwd(Args a_) {
    extern __shared__ __attribute__((aligned(16))) unsigned char lds_raw[];
    LAS unsigned char* lds = (LAS unsigned char*)lds_raw;
    const Args* ap0 = (const Args*)__builtin_amdgcn_kernarg_segment_ptr();
    cg::grid_group grid = cg::this_grid();
    const int lo = ARGP()->ph_lo, hi = ARGP()->ph_hi;
#define PHASE(k) if (lo <= (k) && (k) < hi) { if ((k) > lo) grid.sync(); run_phase<(k)>(ap0, lds); }
    PHASE(0) PHASE(1) PHASE(2) PHASE(3) PHASE(4) PHASE(5) PHASE(6) PHASE(7) PHASE(8) PHASE(9) PHASE(10)
#undef PHASE
}

extern "C" void kernel_launch(void* const* d_in, const int* in_sizes, int n_in, void* d_out, int out_size, void* d_ws, size_t ws_size, hipStream_t stream) {
    static int grid = 0;
    if (grid == 0) {
        if (n_in != 10 || out_size != MTOK * DM || ws_size < WS_END) { fprintf(stderr, "kernel_launch: unexpected shapes / workspace (n_in %d out %d ws %zu)\n", n_in, out_size, ws_size); grid = -1; return; }
        int dev = 0, cus = 0, per_cu = 0;
        (void)hipGetDevice(&dev); (void)hipDeviceGetAttribute(&cus, hipDeviceAttributeMultiprocessorCount, dev);
        (void)hipFuncSetAttribute((const void*)hybrid_fwd, hipFuncAttributeMaxDynamicSharedMemorySize, LDS_BYTES);
        (void)hipOccupancyMaxActiveBlocksPerMultiprocessor(&per_cu, (const void*)hybrid_fwd, 512, LDS_BYTES);
        (void)hipGetLastError();
        if (per_cu < 1) { fprintf(stderr, "kernel_launch: occupancy query says %d blocks/CU\n", per_cu); per_cu = 1; }
        grid = cus;
    }
    if (grid < 0) return;
    Args a{};
    for (int i = 0; i < 10; ++i) a.in[i] = (const float*)d_in[i];
    a.out = (float*)d_out; a.ws = (unsigned char*)d_ws;
#if ONE_LAUNCH
    a.ph_lo = 0; a.ph_hi = NPHASE;
    void* args[] = {&a};
    hipError_t e = hipLaunchCooperativeKernel((const void*)hybrid_fwd, dim3(grid), dim3(512), args, LDS_BYTES, stream);
    if (e != hipSuccess) fprintf(stderr, "cooperative launch failed: %s (grid %d)\n", hipGetErrorString(e), grid);
#else
    for (int ph = 0; ph < NPHASE; ++ph) { a.ph_lo = ph; a.ph_hi = ph + 1; hipLaunchKernelGGL(hybrid_fwd, dim3(grid), dim3(512), LDS_BYTES, stream, a); }
#endif
}
```

```cpp
#include <hip/hip_runtime.h>
#include <hip/hip_cooperative_groups.h>
#include <cstdio>
#include <cstdint>
namespace cg = cooperative_groups;
#ifndef ONE_LAUNCH
#define ONE_LAUNCH 1
#endif
namespace pg8 {
#define PG8_LAS __attribute__((address_space(3)))
typedef unsigned short bf16_t;
typedef short bf16x8 __attribute__((ext_vector_type(8)));
typedef float f32x4 __attribute__((ext_vector_type(4)));
typedef unsigned u32x4 __attribute__((ext_vector_type(4)));
constexpr int BM = 256, BK = 64, HALF = 128, HTB = HALF * BK * 2  , STAGE_BYTES = 8 * HTB, NXCD = 8, WGM = 8;

__host__ __device__ __forceinline__ int lds_byte(int r, int c) { const int st = (r >> 4) * 2 + (c >> 5), rr = r & 15, cc = c & 31, ob = rr * 64 + cc * 2; return st * 1024 + (ob ^ (((ob >> 9) & 1) << 5)); }
__host__ __device__ __forceinline__ void stage_rc(int b, int& R, int& C) { const int st = b / 1024, sb = b % 1024, swz = sb ^ (((sb >> 9) & 1) << 5); R = (st >> 1) * 16 + swz / 64; C = (st & 1) * 32 + (swz % 64) / 2; }
__host__ __device__ __forceinline__ int perm32(int rho) { const int n = rho >> 4, i = rho & 15; return 8 * (i >> 2) + 4 * n + (i & 3); }

struct Unit { int pm, pn, az; };
struct Gemm { const bf16_t* A; const bf16_t* Bt; int M, N, K; size_t azs; };

struct StaticOrder {
    int nM, nN, nwg, G, c;
    __host__ __device__ void init(int M, int N, int G_, int c_) { nM = M / BM; nN = N / BM; nwg = nM * nN; G = G_; c = c_; }
    __host__ __device__ bool next(int i, Unit& u) const {
        const long L = (long)i * G + c; if (L >= nwg) return false;
        int wgid = (int)L; { const int q = nwg / NXCD, r = nwg % NXCD, xcd = wgid % NXCD, off = wgid / NXCD; wgid = (xcd < r ? xcd * (q + 1) : r * (q + 1) + (xcd - r) * q) + off; }
        const int nig = WGM * nN, gid = wgid / nig, fm = gid * WGM, gsz = (nM - fm) < WGM ? (nM - fm) : WGM;
        u.pm = fm + ((wgid % nig) % gsz); u.pn = (wgid % nig) / gsz; u.az = 0; return true;
    }
    __device__ __forceinline__ void a_ready(const Unit&) const {}
    __device__ __forceinline__ void done(const Unit&) const {}
};

__device__ __forceinline__ unsigned cvt_pk_bf16(float lo, float hi) { unsigned r; asm volatile("v_cvt_pk_bf16_f32 %0, %1, %2" : "=v"(r) : "v"(lo), "v"(hi)); return r; }
template <class Epi, class Sched, bool ALIGN_EPI = false, bool SP2 = false>
__device__ __forceinline__ void gemm_phase(PG8_LAS unsigned char* lds, const Gemm g, const Sched& S, const Epi& E) {
    const int tid = threadIdx.x, wid = __builtin_amdgcn_readfirstlane(tid >> 6), lane = tid & 63, wr = wid >> 2, wc = wid & 3, fr = lane & 15, fq = lane >> 4;
    const int K = g.K, nt = K / BK;
    unsigned voffA[2], voffB[2];
#pragma unroll
    for (int i = 0; i < 2; ++i) { int R, C; stage_rc(tid * 16 + i * 8192, R, C); const int Rb = Epi::PERM ? ((R & ~31) + perm32(R & 31)) : R;
        voffA[i] = (unsigned)(R * K + C) * 2u; voffB[i] = (unsigned)(Rb * K + C) * 2u; }
    const size_t kstep = (size_t)(BK * 2);
    const size_t hstep = (size_t)HALF * K * 2;
    const size_t tstep = 2 * hstep;
    const unsigned ldsw = (unsigned)wid * 1024u;
    const int aoff = lds_byte(wr * 64 + fr, fq * 8), boff = lds_byte(wc * 32 + fr, fq * 8);
#define PG8_SA(b, h) (((b) * 2 + (h)) * HTB)
#define PG8_SB(b, h) ((4 + (b) * 2 + (h)) * HTB)
#define PG8_STAGE(bufoff, gbase, voff) do { _Pragma("unroll") for (int _i = 0; _i < 2; ++_i) \
        __builtin_amdgcn_global_load_lds((const unsigned*)((const char*)(gbase) + (voff)[_i]), (PG8_LAS unsigned*)(lds + (bufoff) + ldsw + _i * 8192), 16, 0, 0); } while (0)
#define PG8_LDA(dst, b, h) do { _Pragma("unroll") for (int m = 0; m < 4; ++m) _Pragma("unroll") for (int k = 0; k < 2; ++k) dst[m][k] = *(const PG8_LAS bf16x8*)(lds + PG8_SA(b, h) + aoff + m * 2048 + k * 1024); } while (0)
#define PG8_LDB(dst, b, h) do { _Pragma("unroll") for (int n = 0; n < 2; ++n) _Pragma("unroll") for (int k = 0; k < 2; ++k) dst[n][k] = *(const PG8_LAS bf16x8*)(lds + PG8_SB(b, h) + boff + n * 2048 + k * 1024); } while (0)
#define PG8_MMA(ai, bj, At, Bt) do { __builtin_amdgcn_s_setprio(1); _Pragma("unroll") for (int m = 0; m < 4; ++m) _Pragma("unroll") for (int n = 0; n < 2; ++n) _Pragma("unroll") for (int k = 0; k < 2; ++k) \
        acc[ai][bj][m][n] = __builtin_amdgcn_mfma_f32_16x16x32_bf16(Bt[n][k], At[m][k], acc[ai][bj][m][n], 0, 0, 0); __builtin_amdgcn_s_setprio(0); } while (0)
#define PG8_WAIT_V(n) asm volatile("s_waitcnt vmcnt(" #n ")" ::: "memory")
#define PG8_WAIT_L(n) asm volatile("s_waitcnt lgkmcnt(" #n ")" ::: "memory")
#define PG8_BAR __builtin_amdgcn_s_barrier()
#define PG8_SCHED __builtin_amdgcn_sched_barrier(0)
    Unit cur, nxt; int ui = 0;
    if (!S.next(0, cur)) return;
    f32x4 acc[2][2][4][2];
#pragma unroll
    for (int a = 0; a < 2; ++a)
#pragma unroll
        for (int b = 0; b < 2; ++b)
#pragma unroll
            for (int m = 0; m < 4; ++m)
#pragma unroll
                for (int n = 0; n < 2; ++n) acc[a][b][m][n] = (f32x4){0.f, 0.f, 0.f, 0.f};
    bf16x8 At[4][2], B0[2][2], B1[2][2];
    const char* cA = (const char*)g.A + (size_t)cur.pm * tstep + (size_t)cur.az * g.azs; const char* cB = (const char*)g.Bt + (size_t)cur.pn * tstep;
    S.a_ready(cur);
    if constexpr (SP2) {
        PG8_STAGE(PG8_SB(0, 0), cB, voffB); PG8_STAGE(PG8_SB(0, 1), cB + hstep, voffB); PG8_STAGE(PG8_SA(0, 0), cA, voffA); PG8_STAGE(PG8_SA(0, 1), cA + hstep, voffA);
        if (wr == 1) PG8_BAR;
        PG8_WAIT_V(2); PG8_BAR;
        PG8_STAGE(PG8_SB(1, 0), cB + kstep, voffB); PG8_STAGE(PG8_SA(1, 0), cA + kstep, voffA); PG8_STAGE(PG8_SB(1, 1), cB + hstep + kstep, voffB);
        PG8_WAIT_V(6); PG8_BAR;
    } else {
        PG8_STAGE(PG8_SB(0, 0), cB, voffB); PG8_STAGE(PG8_SA(0, 0), cA, voffA); PG8_STAGE(PG8_SB(0, 1), cB + hstep, voffB); PG8_STAGE(PG8_SA(0, 1), cA + hstep, voffA);
        if (wr == 1) PG8_BAR;
        PG8_WAIT_V(4); PG8_BAR;
        PG8_STAGE(PG8_SB(1, 0), cB + kstep, voffB); PG8_STAGE(PG8_SA(1, 0), cA + kstep, voffA); PG8_STAGE(PG8_SB(1, 1), cB + hstep + kstep, voffB);
        PG8_WAIT_V(6); PG8_BAR;
    }
    for (;;) {
        const bool has_next = S.next(ui + 1, nxt);
        const char* nA = has_next ? (const char*)g.A + (size_t)nxt.pm * tstep + (size_t)nxt.az * g.azs : cA; const char* nB = has_next ? (const char*)g.Bt + (size_t)nxt.pn * tstep : cB;
        for (int t = 0; t < nt; t += 2) {
            const bool last = (t == nt - 2);
            const char* a1 = cA + (size_t)(t + 1) * kstep;
            const char* a2 = last ? nA : cA + (size_t)(t + 2) * kstep; const char* b2 = last ? nB : cB + (size_t)(t + 2) * kstep;
            const char* a3 = a2 + kstep; const char* b3 = b2 + kstep;
            if (last && has_next) S.a_ready(nxt);
            if constexpr (SP2) {
            PG8_LDB(B0, 0, 0); PG8_LDB(B1, 0, 1); PG8_SCHED; PG8_LDA(At, 0, 0); PG8_STAGE(PG8_SA(1, 1), a1 + hstep, voffA);
            PG8_WAIT_V(8); PG8_WAIT_L(0); PG8_BAR; PG8_MMA(0, 0, At, B0); PG8_MMA(0, 1, At, B1); PG8_BAR; PG8_SCHED;
            PG8_LDA(At, 0, 1); PG8_STAGE(PG8_SB(0, 0), b2, voffB); PG8_STAGE(PG8_SB(0, 1), b2 + hstep, voffB); PG8_STAGE(PG8_SA(0, 0), a2, voffA);
            PG8_WAIT_V(8); PG8_WAIT_L(0); PG8_BAR; PG8_MMA(1, 0, At, B0); PG8_MMA(1, 1, At, B1); PG8_BAR; PG8_SCHED;
            PG8_LDB(B0, 1, 0); PG8_LDB(B1, 1, 1); PG8_SCHED; PG8_LDA(At, 1, 0); PG8_STAGE(PG8_SA(0, 1), a2 + hstep, voffA);
            PG8_WAIT_V(8); PG8_WAIT_L(0); PG8_BAR; PG8_MMA(0, 0, At, B0); PG8_MMA(0, 1, At, B1); PG8_BAR; PG8_SCHED;
            PG8_LDA(At, 1, 1); PG8_STAGE(PG8_SB(1, 0), b3, voffB); PG8_STAGE(PG8_SB(1, 1), b3 + hstep, voffB); PG8_STAGE(PG8_SA(1, 0), a3, voffA);
            PG8_WAIT_V(8); PG8_WAIT_L(0); PG8_BAR; PG8_MMA(1, 0, At, B0); PG8_MMA(1, 1, At, B1); PG8_BAR; PG8_SCHED;
            } else {
            PG8_LDB(B0, 0, 0); PG8_SCHED; PG8_LDA(At, 0, 0); PG8_STAGE(PG8_SA(1, 1), a1 + hstep, voffA);
            PG8_WAIT_L(8); PG8_BAR; PG8_WAIT_L(0); PG8_MMA(0, 0, At, B0); PG8_BAR; PG8_SCHED;
            PG8_LDB(B1, 0, 1); PG8_STAGE(PG8_SB(0, 0), b2, voffB);
            PG8_BAR; PG8_WAIT_L(0); PG8_MMA(0, 1, At, B1); PG8_BAR;
            PG8_LDA(At, 0, 1); PG8_STAGE(PG8_SA(0, 0), a2, voffA);
            PG8_BAR; PG8_WAIT_L(0); PG8_MMA(1, 0, At, B0); PG8_BAR; PG8_SCHED;
            PG8_STAGE(PG8_SB(0, 1), b2 + hstep, voffB);
            PG8_WAIT_V(6); PG8_BAR; PG8_MMA(1, 1, At, B1); PG8_BAR;
            PG8_LDB(B0, 1, 0); PG8_SCHED; PG8_LDA(At, 1, 0); PG8_STAGE(PG8_SA(0, 1), a2 + hstep, voffA);
            PG8_WAIT_L(8); PG8_BAR; PG8_WAIT_L(0); PG8_MMA(0, 0, At, B0); PG8_BAR; PG8_SCHED;
            PG8_LDB(B1, 1, 1); PG8_STAGE(PG8_SB(1, 0), b3, voffB);
            PG8_BAR; PG8_WAIT_L(0); PG8_MMA(0, 1, At, B1); PG8_BAR;
            PG8_LDA(At, 1, 1); PG8_STAGE(PG8_SA(1, 0), a3, voffA);
            PG8_BAR; PG8_WAIT_L(0); PG8_MMA(1, 0, At, B0); PG8_BAR; PG8_SCHED;
            PG8_STAGE(PG8_SB(1, 1), b3 + hstep, voffB);
            PG8_WAIT_V(6); PG8_BAR; PG8_MMA(1, 1, At, B1); PG8_BAR;
            }
        }
        if constexpr (ALIGN_EPI) { if (wr == 0) PG8_BAR; }
        if constexpr (!Epi::AFTER_DRAIN) { E(acc, cur, wr, wc, fr, fq); S.done(cur); }
        if (!has_next) break;
#pragma unroll
        for (int a = 0; a < 2; ++a)
#pragma unroll
            for (int b = 0; b < 2; ++b)
#pragma unroll
                for (int m = 0; m < 4; ++m)
#pragma unroll
                    for (int n = 0; n < 2; ++n) acc[a][b][m][n] = (f32x4){0.f, 0.f, 0.f, 0.f};
        cur = nxt; cA = nA; cB = nB; ++ui;
        if constexpr (ALIGN_EPI) { if (wr == 1) PG8_BAR; }
    }
    PG8_WAIT_V(0);
    if constexpr (!ALIGN_EPI) { if (wr == 0) PG8_BAR; }
    PG8_BAR;
    if constexpr (Epi::AFTER_DRAIN) { E.fused(acc, cur, wr, wc, fr, fq, lds, wid, lane); S.done(cur); }
#undef PG8_SA
#undef PG8_SB
#undef PG8_STAGE
#undef PG8_LDA
#undef PG8_LDB
#undef PG8_MMA
#undef PG8_WAIT_V
#undef PG8_WAIT_L
#undef PG8_BAR
#undef PG8_SCHED
}
}

#define LAS __attribute__((address_space(3)))
typedef unsigned short bf16_t;
typedef short bf16x8 __attribute__((ext_vector_type(8)));
typedef short s16x4 __attribute__((ext_vector_type(4)));
typedef float f32x4 __attribute__((ext_vector_type(4)));
typedef float f32x16 __attribute__((ext_vector_type(16)));
typedef unsigned u32x4 __attribute__((ext_vector_type(4)));
typedef unsigned u32x2 __attribute__((ext_vector_type(2)));
constexpr int NB = 4, SEQ = 4096, DM = 1024, MTOK = NB * SEQ, NIN = 8192, BWID = 512, NLAYER = 2;
constexpr float RMS_EPS = 1e-6f;
constexpr size_t MiB = 1u << 20;
constexpr size_t WS_RS = 0;
constexpr size_t WS_W1 = 2 * MiB;
constexpr size_t WS_W2 = 34 * MiB;
constexpr size_t WS_W3 = 40 * MiB;
constexpr size_t WS_PW = 44 * MiB;
constexpr size_t WS_H = 45 * MiB;
constexpr size_t WS_U = 77 * MiB;
constexpr size_t ARRB = 16 * MiB;
constexpr size_t WS_MG = 205 * MiB;
constexpr size_t WS_END = 253 * MiB;
constexpr int LDS_BYTES = 147456;
constexpr int NPHASE = 1 + 5 * NLAYER;

__device__ __forceinline__ unsigned f2bf(float f) { unsigned u = __builtin_bit_cast(unsigned, f); return (u + 0x7fffu + ((u >> 16) & 1u)) >> 16; }
__device__ __forceinline__ unsigned pk2(float lo, float hi) { return f2bf(lo) | (f2bf(hi) << 16); }
__device__ __forceinline__ float bflo(unsigned u) { return __builtin_bit_cast(float, u << 16); }
__device__ __forceinline__ float bfhi(unsigned u) { return __builtin_bit_cast(float, u & 0xffff0000u); }
__device__ __forceinline__ float sigmoid_f(float x) { return __builtin_amdgcn_rcpf(1.f + __builtin_amdgcn_exp2f(-1.4426950408889634f * x)); }
__device__ __forceinline__ float silu_f(float x) { return x * sigmoid_f(x); }
__device__ __forceinline__ unsigned q8(float x) { return (unsigned)(sigmoid_f(x) * 255.f + 0.5f); }
__device__ __forceinline__ float wave_sum(float v) {
#pragma unroll
    for (int o = 1; o < 64; o <<= 1) v += __shfl_xor(v, o);
    return v;
}

using pg8::Unit;
struct EpiU {
    static constexpr bool PERM = true, AFTER_DRAIN = false;
    unsigned char* ws;
    __device__ __forceinline__ void operator()(const f32x4 (&acc)[2][2][4][2], const Unit& u, int wr, int wc, int fr, int fq) const {
        bf16_t* U = (bf16_t*)(ws + WS_U); unsigned char* MG = ws + WS_MG;
        const int pn = u.pn; const int row0 = u.pm * 256 + wr * 64 + fr;
        if (pn >= 20) {
            const int mc0 = (pn - 20) * 256 + wc * 32 + 8 * fq;
#pragma unroll
            for (int ai = 0; ai < 2; ++ai)
#pragma unroll
                for (int m = 0; m < 4; ++m) { unsigned char* rp = MG + (size_t)(row0 + ai * 128 + m * 16) * 3072 + mc0;
#pragma unroll
                    for (int bj = 0; bj < 2; ++bj) { const f32x4 v0 = acc[ai][bj][m][0], v1 = acc[ai][bj][m][1]; u32x2 w;
                        w.x = q8(v0[0]) | (q8(v0[1]) << 8) | (q8(v0[2]) << 16) | (q8(v0[3]) << 24); w.y = q8(v1[0]) | (q8(v1[1]) << 8) | (q8(v1[2]) << 16) | (q8(v1[3]) << 24);
                        *(u32x2*)(rp + bj * 128) = w; } }
        } else if (pn >= 4 && pn < 12) {
            const int ch0 = (pn - 4) * 64 + (4 * wc + fq) * 4;
            bf16_t* Z = U + 1 * (ARRB / 2); bf16_t* W = U + 6 * (ARRB / 2);
#pragma unroll
            for (int ai = 0; ai < 2; ++ai)
#pragma unroll
                for (int m = 0; m < 4; ++m) { const size_t ro = (size_t)(row0 + ai * 128 + m * 16) * 512 + ch0;
                    const f32x4 z = acc[ai][0][m][0] * acc[ai][0][m][1]; const f32x4 gb = acc[ai][1][m][0], gg = acc[ai][1][m][1];
                    u32x2 zz, ww; zz.x = pg8::cvt_pk_bf16(z[0], z[1]); zz.y = pg8::cvt_pk_bf16(z[2], z[3]);
                    ww.x = pg8::cvt_pk_bf16(gb[0] * silu_f(gg[0]), gb[1] * silu_f(gg[1])); ww.y = pg8::cvt_pk_bf16(gb[2] * silu_f(gg[2]), gb[3] * silu_f(gg[3]));
                    *(u32x2*)(Z + ro) = zz; *(u32x2*)(W + ro) = ww; }
        } else {
            const int kind = pn >> 1; int arr = 0; bool act = false;
            if (kind == 1) { arr = 5; act = true; } else if (kind == 6) arr = 2; else if (kind == 7) arr = 3; else if (kind == 8) arr = 4; else if (kind == 9) { arr = 7; act = true; }
            bf16_t* O = U + (size_t)arr * (ARRB / 2); const int col0 = (pn & 1) * 256 + wc * 32 + 8 * fq;
#pragma unroll
            for (int ai = 0; ai < 2; ++ai)
#pragma unroll
                for (int m = 0; m < 4; ++m) { bf16_t* rp = O + (size_t)(row0 + ai * 128 + m * 16) * 512 + col0;
#pragma unroll
                    for (int bj = 0; bj < 2; ++bj) { f32x4 v0 = acc[ai][bj][m][0], v1 = acc[ai][bj][m][1];
                        if (act) {
#pragma unroll
                            for (int i = 0; i < 4; ++i) { v0[i] = silu_f(v0[i]); v1[i] = silu_f(v1[i]); } }
                        u32x4 w; w.x = pg8::cvt_pk_bf16(v0[0], v0[1]); w.y = pg8::cvt_pk_bf16(v0[2], v0[3]); w.z = pg8::cvt_pk_bf16(v1[0], v1[1]); w.w = pg8::cvt_pk_bf16(v1[2], v1[3]);
                        *(u32x4*)(rp + bj * 128) = w; } }
        }
    }
};
struct EpiBranch {
    static constexpr bool PERM = true, AFTER_DRAIN = false;
    unsigned char* ws;
    __device__ __forceinline__ void operator()(const f32x4 (&acc)[2][2][4][2], const Unit& u, int wr, int wc, int fr, int fq) const {
        const unsigned char* MG = ws + WS_MG; float* part = (float*)(ws + WS_U); bf16_t* merged = (bf16_t*)(ws + WS_H);
        const int n = u.az, pn = u.pn & 3; const int row0 = u.pm * 256 + wr * 64 + fr, col0 = pn * 256 + wc * 32 + 8 * fq;
#pragma unroll
        for (int ai = 0; ai < 2; ++ai)
#pragma unroll
            for (int m = 0; m < 4; ++m) { const size_t row = (size_t)(row0 + ai * 128 + m * 16);
#pragma unroll
                for (int bj = 0; bj < 2; ++bj) { const int col = col0 + bj * 128;
                    const u32x2 gq = *(const u32x2*)(MG + row * 3072 + n * 1024 + col);
                    f32x4 g0, g1; const float k = 1.f / 255.f;
                    g0[0] = (float)(gq.x & 255u) * k; g0[1] = (float)((gq.x >> 8) & 255u) * k; g0[2] = (float)((gq.x >> 16) & 255u) * k; g0[3] = (float)(gq.x >> 24) * k;
                    g1[0] = (float)(gq.y & 255u) * k; g1[1] = (float)((gq.y >> 8) & 255u) * k; g1[2] = (float)((gq.y >> 16) & 255u) * k; g1[3] = (float)(gq.y >> 24) * k;
                    f32x4 v0 = acc[ai][bj][m][0] * g0, v1 = acc[ai][bj][m][1] * g1;
                    float* pp = part + row * 1024 + col;
                    if (n == 0) { *(f32x4*)pp = v0; *(f32x4*)(pp + 4) = v1; }
                    else { v0 += *(const f32x4*)pp; v1 += *(const f32x4*)(pp + 4);
                        if (n == 1) { *(f32x4*)pp = v0; *(f32x4*)(pp + 4) = v1; }
                        else { u32x4 w; w.x = pg8::cvt_pk_bf16(v0[0], v0[1]); w.y = pg8::cvt_pk_bf16(v0[2], v0[3]); w.z = pg8::cvt_pk_bf16(v1[0], v1[1]); w.w = pg8::cvt_pk_bf16(v1[2], v1[3]);
                            *(u32x4*)(merged + row * 1024 + col) = w; } } } }
    }
};
struct BranchOrder {
    pg8::StaticOrder base;
    __device__ void init(int G, int c) { base.init(MTOK, 1024, G, c); }
    __device__ bool next(int i, Unit& u) const { Unit t; if (!base.next(i / 3, t)) return false; const int n = i % 3; u.pm = t.pm; u.pn = n * 4 + t.pn; u.az = n; return true; }
    __device__ __forceinline__ void a_ready(const Unit&) const {}
    __device__ __forceinline__ void done(const Unit&) const {}
};
struct EpiOut {
    static constexpr bool PERM = false, AFTER_DRAIN = false;
    unsigned char* ws;
    __device__ __forceinline__ void operator()(const f32x4 (&acc)[2][2][4][2], const Unit& u, int wr, int wc, int fr, int fq) const {
        float* out = (float*)(ws + WS_U); float* rs = (float*)(ws + WS_RS);
        const int row0 = u.pm * 256 + wr * 64 + fr, col0 = u.pn * 256 + wc * 32 + 4 * fq;
#pragma unroll
        for (int ai = 0; ai < 2; ++ai)
#pragma unroll
            for (int m = 0; m < 4; ++m) { const size_t row = (size_t)(row0 + ai * 128 + m * 16); float ss = 0.f;
#pragma unroll
                for (int bj = 0; bj < 2; ++bj)
#pragma unroll
                    for (int n = 0; n < 2; ++n) { const f32x4 v = acc[ai][bj][m][n]; *(f32x4*)(out + row * 1024 + col0 + bj * 128 + n * 16) = v; ss += (v[0] * v[0] + v[1] * v[1]) + (v[2] * v[2] + v[3] * v[3]); }
                ss += __shfl_xor(ss, 16); ss += __shfl_xor(ss, 32);
                if (fq == 0) rs[row * 16 + u.pn * 4 + wc] = ss; }
    }
};
__device__ __forceinline__ int win_row(int c) {
    if (c < 1024 || c >= 3072) return c;
    const int q = (c - 1024) >> 9, ch = (c - 1024) & 511, ct = ch >> 6, grp = (ch & 63) >> 2, e = ch & 3;
    return 1024 + ct * 256 + (q & 1) * 128 + grp * 8 + (q >> 1) * 4 + e;
}
__device__ __forceinline__ void transpose_item(const float* W, int K, int N, bf16_t* WT, int row_off, bool winmap, LAS float* scr, int item, int lane) {
    const int nblk = N / 32, kb = item / nblk, nb = item % nblk, k0 = 64 * kb, n0 = 32 * nb;
#pragma unroll 8
    for (int i = 0; i < 32; ++i) { const int kk = 2 * i + (lane >> 5); scr[kk * 33 + (lane & 31)] = W[(size_t)(k0 + kk) * N + n0 + (lane & 31)]; }
    asm volatile("s_waitcnt lgkmcnt(0)" ::: "memory");
    const int c = lane & 7;
#pragma unroll
    for (int j = 0; j < 4; ++j) { const int n = (lane >> 3) + 8 * j; const LAS float* s = scr + (8 * c) * 33 + n;
        u32x4 o; o.x = pk2(s[0 * 33], s[1 * 33]); o.y = pk2(s[2 * 33], s[3 * 33]); o.z = pk2(s[4 * 33], s[5 * 33]); o.w = pk2(s[6 * 33], s[7 * 33]);
        int dst = n0 + n; if (winmap) dst = win_row(dst);
        *(u32x4*)(WT + (size_t)(row_off + dst) * K + k0 + 8 * c) = o; }
    asm volatile("s_waitcnt lgkmcnt(0)" ::: "memory");
}
__device__ __forceinline__ void rms_row_to_bf16(const float* xrow, const float* g, bf16_t* orow, int lane) {
    const f32x4* xr = (const f32x4*)xrow + lane; const f32x4* gr = (const f32x4*)g + lane;
    f32x4 v[4]; float s = 0.f;
#pragma unroll
    for (int j = 0; j < 4; ++j) { v[j] = xr[64 * j]; s += (v[j][0] * v[j][0] + v[j][1] * v[j][1]) + (v[j][2] * v[j][2] + v[j][3] * v[j][3]); }
    const float rstd = 1.f / sqrtf(wave_sum(s) * (1.f / DM) + RMS_EPS);
    u32x2* o8 = (u32x2*)orow + lane;
#pragma unroll
    for (int j = 0; j < 4; ++j) { const f32x4 gg = gr[64 * j]; u32x2 w; w.x = pk2(v[j][0] * rstd * gg[0], v[j][1] * rstd * gg[1]); w.y = pk2(v[j][2] * rstd * gg[2], v[j][3] * rstd * gg[3]); o8[64 * j] = w; }
}

__device__ __forceinline__ int crow(int r, int hi) { return (r & 3) + 8 * (r >> 2) + 4 * hi; }
constexpr int VROW = 144;
__device__ __forceinline__ void attn_item(int item, const bf16_t* Q, const bf16_t* K, const bf16_t* V, bf16_t* SG, LAS unsigned char* vl, int lane) {
    const int qg = item & 127, h = (item >> 7) & 7, b = item >> 10;
    const int r32 = lane & 31, hi = lane >> 5, t0 = qg * 32;
    const size_t tokq = (size_t)b * SEQ + t0 + r32;
    bf16x8 qf[4];
#pragma unroll
    for (int d0 = 0; d0 < 4; ++d0) qf[d0] = *(const bf16x8*)(Q + tokq * 512 + h * 64 + d0 * 16 + 8 * hi);
    f32x16 o0, o1;
#pragma unroll
    for (int r = 0; r < 16; ++r) { o0[r] = 0.f; o1[r] = 0.f; }
    float P = 1.f;
    const int i16 = lane & 15, G4 = lane >> 4;
    const int vb = (4 * (G4 >> 1) + (i16 >> 2)) * VROW + (16 * (G4 & 1) + 4 * (i16 & 3)) * 2;
    for (int s0 = t0; s0 >= 0; s0 -= 32) {
        const size_t tokk = (size_t)b * SEQ + s0;
        bf16x8 kf[4];
#pragma unroll
        for (int d0 = 0; d0 < 4; ++d0) kf[d0] = *(const bf16x8*)(K + (tokk + r32) * 512 + h * 64 + d0 * 16 + 8 * hi);
#pragma unroll
        for (int p = 0; p < 4; ++p) { const int idx = p * 64 + lane, key = idx >> 3, ch = idx & 7;
            const u32x4 v = *(const u32x4*)(V + (tokk + key) * 512 + h * 64 + ch * 8);
            *(LAS u32x4*)(vl + key * VROW + ch * 16) = v; }
        f32x16 s;
#pragma unroll
        for (int r = 0; r < 16; ++r) s[r] = 0.f;
#pragma unroll
        for (int d0 = 0; d0 < 4; ++d0) s = __builtin_amdgcn_mfma_f32_32x32x16_bf16(kf[d0], qf[d0], s, 0, 0, 0);
        const bool diag = (s0 == t0);
        float kp[16];
#pragma unroll
        for (int r = 0; r < 16; ++r) { const float e = __builtin_amdgcn_exp2f(s[r] * (0.125f * 1.4426950408889634f)); float k = __builtin_amdgcn_rcpf(1.f + e);
            if (diag && crow(r, hi) >= r32) k = 1.f; kp[r] = k; }
        float Gm[4], Go[4], T[4], R[4], C[4];
#pragma unroll
        for (int g = 0; g < 4; ++g) { Gm[g] = (kp[4 * g] * kp[4 * g + 1]) * (kp[4 * g + 2] * kp[4 * g + 3]); Go[g] = __shfl_xor(Gm[g], 32); T[g] = Gm[g] * Go[g]; }
        R[3] = P; R[2] = R[3] * T[3]; R[1] = R[2] * T[2]; R[0] = R[1] * T[1]; const float Cout = R[0] * T[0];
#pragma unroll
        for (int g = 0; g < 4; ++g) C[g] = hi ? R[g] : R[g] * Go[g];
        float w[16];
#pragma unroll
        for (int g = 0; g < 4; ++g) { const float p3 = C[g], p2 = p3 * kp[4 * g + 3], p1 = p2 * kp[4 * g + 2], p0 = p1 * kp[4 * g + 1], pe = p0 * kp[4 * g];
            w[4 * g + 3] = p3 - p2; w[4 * g + 2] = p2 - p1; w[4 * g + 1] = p1 - p0; w[4 * g] = p0 - pe; }
        bf16x8 wf[2];
#pragma unroll
        for (int st = 0; st < 2; ++st) { u32x4 t; t.x = pk2(w[8 * st], w[8 * st + 1]); t.y = pk2(w[8 * st + 2], w[8 * st + 3]); t.z = pk2(w[8 * st + 4], w[8 * st + 5]); t.w = pk2(w[8 * st + 6], w[8 * st + 7]); wf[st] = __builtin_bit_cast(bf16x8, t); }
#pragma unroll
        for (int dt = 0; dt < 2; ++dt)
#pragma unroll
            for (int st = 0; st < 2; ++st) {
                const s16x4 lo = __builtin_amdgcn_ds_read_tr16_b64_v4i16((LAS s16x4*)(vl + vb + (16 * st) * VROW + dt * 64));
                const s16x4 hh = __builtin_amdgcn_ds_read_tr16_b64_v4i16((LAS s16x4*)(vl + vb + (16 * st + 8) * VROW + dt * 64));
                const bf16x8 vf = (bf16x8){lo[0], lo[1], lo[2], lo[3], hh[0], hh[1], hh[2], hh[3]};
                if (dt == 0) o0 = __builtin_amdgcn_mfma_f32_32x32x16_bf16(vf, wf[st], o0, 0, 0, 0); else o1 = __builtin_amdgcn_mfma_f32_32x32x16_bf16(vf, wf[st], o1, 0, 0, 0); }
        P = Cout;
        if (__all(P < 1.17549435e-38f)) break;
    }
#pragma unroll
    for (int dt = 0; dt < 2; ++dt)
#pragma unroll
        for (int g = 0; g < 4; ++g) { bf16_t* p = SG + tokq * 512 + h * 64 + dt * 32 + 8 * g + 4 * hi; const u32x2 sg = *(const u32x2*)p;
            const f32x16& o = dt ? o1 : o0; u32x2 y;
            y.x = pk2(o[4 * g] * bflo(sg.x), o[4 * g + 1] * bfhi(sg.x)); y.y = pk2(o[4 * g + 2] * bflo(sg.y), o[4 * g + 3] * bfhi(sg.y));
            *(u32x2*)p = y; }
}
__device__ __forceinline__ void pool_item(int pi, const bf16_t* PV, bf16_t* SG, const bf16_t* PT, const float* scale, int lane) {
    const int tile = pi >> 2, g = ((pi & 3) + ((pi >> 2) & 1)) & 3, win = 2 << g;
    const int r32 = lane & 31, hi = lane >> 5, tok = tile * 32 + r32, t = tok & (SEQ - 1);
    const bf16_t* vp = PV + (size_t)tok * 512 + g * 128 + 8 * hi;
    const int cnt = (t + 1) < win ? (t + 1) : win;
    float sum[8][8];
#pragma unroll
    for (int s = 0; s < 8; ++s) { const u32x4 raw = *(const u32x4*)(vp + 16 * s); const float f = 1.f - (float)cnt;
        sum[s][0] = bflo(raw.x) * f; sum[s][1] = bfhi(raw.x) * f; sum[s][2] = bflo(raw.y) * f; sum[s][3] = bfhi(raw.y) * f;
        sum[s][4] = bflo(raw.z) * f; sum[s][5] = bfhi(raw.z) * f; sum[s][6] = bflo(raw.w) * f; sum[s][7] = bfhi(raw.w) * f; }
    for (int jj = 1; jj < win; ++jj) {
        if (t - jj >= 0) {
#pragma unroll
            for (int s = 0; s < 8; ++s) { const u32x4 raw = *(const u32x4*)(vp - (size_t)jj * 512 + 16 * s);
                sum[s][0] += bflo(raw.x); sum[s][1] += bfhi(raw.x); sum[s][2] += bflo(raw.y); sum[s][3] += bfhi(raw.y);
                sum[s][4] += bflo(raw.z); sum[s][5] += bfhi(raw.z); sum[s][6] += bflo(raw.w); sum[s][7] += bfhi(raw.w); } }
    }
    const float inv = 1.f / (float)cnt;
    bf16x8 pf[8];
#pragma unroll
    for (int s = 0; s < 8; ++s) { u32x4 tt; tt.x = pk2(sum[s][0] * inv, sum[s][1] * inv); tt.y = pk2(sum[s][2] * inv, sum[s][3] * inv); tt.z = pk2(sum[s][4] * inv, sum[s][5] * inv); tt.w = pk2(sum[s][6] * inv, sum[s][7] * inv); pf[s] = __builtin_bit_cast(bf16x8, tt); }
#pragma unroll
    for (int nt = 0; nt < 4; ++nt) {
        f32x16 acc;
#pragma unroll
        for (int r = 0; r < 16; ++r) acc[r] = 0.f;
        const bf16_t* ap = PT + (size_t)(g * 128 + nt * 32 + r32) * 128 + 8 * hi;
#pragma unroll
        for (int s = 0; s < 8; ++s) { const bf16x8 a = *(const bf16x8*)(ap + 16 * s); acc = __builtin_amdgcn_mfma_f32_32x32x16_bf16(a, pf[s], acc, 0, 0, 0); }
#pragma unroll
        for (int q = 0; q < 4; ++q) { const int d = g * 128 + nt * 32 + 8 * q + 4 * hi; const f32x4 sc = *(const f32x4*)(scale + d);
            bf16_t* p = SG + (size_t)tok * 512 + d; const u32x2 sg = *(const u32x2*)p; u32x2 y;
            y.x = pk2(acc[4 * q] * sc[0] * bflo(sg.x), acc[4 * q + 1] * sc[1] * bfhi(sg.x)); y.y = pk2(acc[4 * q + 2] * sc[2] * bflo(sg.y), acc[4 * q + 3] * sc[3] * bfhi(sg.y));
            *(u32x2*)p = y; }
    }
}
__device__ __forceinline__ void conv_item(int ci, const bf16_t* Z, bf16_t* Wy, const float* cw, const float* cb, int lane) {
    const int tok0 = ci * 8, t0 = tok0 & (SEQ - 1), ch = lane * 8;
    float w0[8], w1[8], w2[8], bs[8], zm2[8], zm1[8];
#pragma unroll
    for (int hf = 0; hf < 2; ++hf) { const f32x4 a = *(const f32x4*)(cw + ch + 4 * hf), b = *(const f32x4*)(cw + 512 + ch + 4 * hf), c = *(const f32x4*)(cw + 1024 + ch + 4 * hf), d = *(const f32x4*)(cb + ch + 4 * hf);
#pragma unroll
        for (int i = 0; i < 4; ++i) { w0[4 * hf + i] = a[i]; w1[4 * hf + i] = b[i]; w2[4 * hf + i] = c[i]; bs[4 * hf + i] = d[i]; } }
#pragma unroll
    for (int i = 0; i < 8; ++i) { zm2[i] = 0.f; zm1[i] = 0.f; }
    if (t0 != 0) { const u32x4 a = *(const u32x4*)(Z + (size_t)(tok0 - 2) * 512 + ch), b = *(const u32x4*)(Z + (size_t)(tok0 - 1) * 512 + ch);
        zm2[0] = bflo(a.x); zm2[1] = bfhi(a.x); zm2[2] = bflo(a.y); zm2[3] = bfhi(a.y); zm2[4] = bflo(a.z); zm2[5] = bfhi(a.z); zm2[6] = bflo(a.w); zm2[7] = bfhi(a.w);
        zm1[0] = bflo(b.x); zm1[1] = bfhi(b.x); zm1[2] = bflo(b.y); zm1[3] = bfhi(b.y); zm1[4] = bflo(b.z); zm1[5] = bfhi(b.z); zm1[6] = bflo(b.w); zm1[7] = bfhi(b.w); }
#pragma unroll
    for (int r = 0; r < 8; ++r) { const size_t off = (size_t)(tok0 + r) * 512 + ch; const u32x4 zr = *(const u32x4*)(Z + off), wr_ = *(const u32x4*)(Wy + off);
        float zc[8], wv[8], y[8];
        zc[0] = bflo(zr.x); zc[1] = bfhi(zr.x); zc[2] = bflo(zr.y); zc[3] = bfhi(zr.y); zc[4] = bflo(zr.z); zc[5] = bfhi(zr.z); zc[6] = bflo(zr.w); zc[7] = bfhi(zr.w);
        wv[0] = bflo(wr_.x); wv[1] = bfhi(wr_.x); wv[2] = bflo(wr_.y); wv[3] = bfhi(wr_.y); wv[4] = bflo(wr_.z); wv[5] = bfhi(wr_.z); wv[6] = bflo(wr_.w); wv[7] = bfhi(wr_.w);
#pragma unroll
        for (int i = 0; i < 8; ++i) { y[i] = wv[i] * (w0[i] * zm2[i] + w1[i] * zm1[i] + w2[i] * zc[i] + bs[i]); zm2[i] = zm1[i]; zm1[i] = zc[i]; }
        u32x4 o; o.x = pk2(y[0], y[1]); o.y = pk2(y[2], y[3]); o.z = pk2(y[4], y[5]); o.w = pk2(y[6], y[7]);
        *(u32x4*)(Wy + off) = o; }
}
__device__ __forceinline__ void norm_row(const float* orow, const float* rs16, const float* xin, const float* gpost, float* xout, const float* gnext, bf16_t* hrow, int lane) {
    float ss = (lane < 16) ? rs16[lane] : 0.f; ss = wave_sum(ss);
    const float rstd = 1.f / sqrtf(ss * (1.f / DM) + RMS_EPS);
    f32x4 v[4]; float s2 = 0.f;
#pragma unroll
    for (int j = 0; j < 4; ++j) { const f32x4 o = ((const f32x4*)orow)[64 * j + lane], xi = ((const f32x4*)xin)[64 * j + lane], gp = ((const f32x4*)gpost)[64 * j + lane];
        v[j] = xi + o * rstd * gp; ((f32x4*)xout)[64 * j + lane] = v[j]; s2 += (v[j][0] * v[j][0] + v[j][1] * v[j][1]) + (v[j][2] * v[j][2] + v[j][3] * v[j][3]); }
    if (gnext) { const float r2 = 1.f / sqrtf(wave_sum(s2) * (1.f / DM) + RMS_EPS);
#pragma unroll
        for (int j = 0; j < 4; ++j) { const f32x4 gg = ((const f32x4*)gnext)[64 * j + lane]; u32x2 w; w.x = pk2(v[j][0] * r2 * gg[0], v[j][1] * r2 * gg[1]); w.y = pk2(v[j][2] * r2 * gg[2], v[j][3] * r2 * gg[3]); ((u32x2*)hrow)[64 * j + lane] = w; } }
}

struct Args { const float* in[10]; float* out; unsigned char* ws; int ph_lo, ph_hi; };
#define ARGP() ({ const Args* p_ = ap0; asm volatile("" : "+s"(p_)); p_; })
template <int ph> __device__ __forceinline__ void run_phase(const Args* ap0, LAS unsigned char* lds) {
        const Args* A = ARGP();
        const int tid = threadIdx.x, lane = tid & 63, wave = __builtin_amdgcn_readfirstlane(tid >> 6);
        const int G = gridDim.x, bx = blockIdx.x;
        const int vcu = (G % 8 == 0) ? (bx % 8) * (G / 8) + bx / 8 : bx;
        const int gw = vcu * 8 + wave, NGW = G * 8;
        unsigned char* ws = A->ws;
        bf16_t* H = (bf16_t*)(ws + WS_H); bf16_t* U = (bf16_t*)(ws + WS_U);
        if constexpr (ph == 0) {
            const float* x = A->in[0]; const float* pre_g = A->in[1]; const float* w_in = A->in[2]; const float* pool_w = A->in[3]; const float* w_branch = A->in[7]; const float* w_out = A->in[8];
            bf16_t* W1 = (bf16_t*)(ws + WS_W1); bf16_t* W2 = (bf16_t*)(ws + WS_W2); bf16_t* W3 = (bf16_t*)(ws + WS_W3); bf16_t* PW = (bf16_t*)(ws + WS_PW);
            LAS float* scr = (LAS float*)(lds + wave * 16384);
            constexpr int I1 = (DM / 64) * (NIN / 32), I2 = (BWID / 64) * (DM / 32), I3 = (DM / 64) * (DM / 32), I4 = 2 * 4, PER = I1 + 3 * I2 + I3 + 4 * I4;
            for (int it = gw; it < NLAYER * PER; it += NGW) {
                const int l = it / PER; int r = it % PER;
                if (r < I1) { transpose_item(w_in + (size_t)l * DM * NIN, DM, NIN, W1 + (size_t)l * NIN * DM, 0, true, scr, r, lane); continue; } r -= I1;
                if (r < 3 * I2) { const int n = r / I2; transpose_item(w_branch + ((size_t)l * 3 + n) * BWID * DM, BWID, DM, W2 + (size_t)l * 3 * DM * BWID, n * DM, false, scr, r % I2, lane); continue; } r -= 3 * I2;
                if (r < I3) { transpose_item(w_out + (size_t)l * DM * DM, DM, DM, W3 + (size_t)l * DM * DM, 0, false, scr, r, lane); continue; } r -= I3;
                { const int g = r / I4; transpose_item(pool_w + ((size_t)l * 4 + g) * 128 * 128, 128, 128, PW + ((size_t)l * 4 + g) * 128 * 128, 0, false, scr, r % I4, lane); }
            }
            for (int m = gw; m < MTOK; m += NGW) rms_row_to_bf16(x + (size_t)m * DM, pre_g, H + (size_t)m * DM, lane);
        } else {
            constexpr int l = (ph - 1) / 5, k = (ph - 1) % 5;
            if constexpr (k == 0) {
                pg8::Gemm g{H, (bf16_t*)(ws + WS_W1) + (size_t)l * NIN * DM, MTOK, NIN, DM, 0}; pg8::StaticOrder S; S.init(MTOK, NIN, G, bx);
                EpiU E{ws};
                pg8::gemm_phase<EpiU, pg8::StaticOrder, true, true>(lds, g, S, E);
            } else if constexpr (k == 1) {
                const float* pool_scale = A->in[4]; const float* conv_w = A->in[5]; const float* conv_b = A->in[6];
                const bf16_t* PW = (const bf16_t*)(ws + WS_PW);
                const bf16_t* Q = U + 2 * (ARRB / 2); const bf16_t* Kk = U + 3 * (ARRB / 2); const bf16_t* V = U + 4 * (ARRB / 2);
                LAS unsigned char* vl = lds + wave * (32 * VROW);
                for (int it = gw; it < NB * 8 * 128; it += NGW) attn_item(it, Q, Kk, V, U + 7 * (ARRB / 2), vl, lane);
                for (int it = gw; it < (MTOK / 32) * 4; it += NGW) pool_item(it, U, U + 5 * (ARRB / 2), PW + (size_t)l * 4 * 128 * 128, pool_scale + l * BWID, lane);
                for (int it = gw; it < MTOK / 8; it += NGW) conv_item(it, U + 1 * (ARRB / 2), U + 6 * (ARRB / 2), conv_w + l * 3 * BWID, conv_b + l * BWID, lane);
            } else if constexpr (k == 2) {
                pg8::Gemm g{U + 5 * (ARRB / 2), (bf16_t*)(ws + WS_W2) + (size_t)l * 3 * DM * BWID, MTOK, DM, BWID, ARRB}; BranchOrder S; S.init(G, bx);
                EpiBranch E{ws};
                pg8::gemm_phase<EpiBranch, BranchOrder, true, true>(lds, g, S, E);
            } else if constexpr (k == 3) {
                pg8::Gemm g{H, (bf16_t*)(ws + WS_W3) + (size_t)l * DM * DM, MTOK, DM, DM, 0}; pg8::StaticOrder S; S.init(MTOK, DM, G, bx);
                EpiOut E{ws};
                pg8::gemm_phase<EpiOut, pg8::StaticOrder, true, true>(lds, g, S, E);
            } else {
                const float* x = A->in[0]; const float* pre_g = A->in[1]; const float* post_g = A->in[9]; float* out = A->out;
                const float* F32T = (const float*)(ws + WS_U); const float* RS = (const float*)(ws + WS_RS);
                const float* xin = (l == 0) ? x : out; const float* gnext = (l + 1 < NLAYER) ? pre_g + (l + 1) * DM : nullptr;
                for (int m = gw; m < MTOK; m += NGW)
                    norm_row(F32T + (size_t)m * DM, RS + (size_t)m * 16, xin + (size_t)m * DM, post_g + l * DM, out + (size_t)m * DM, gnext, H + (size_t)m * DM, lane);
            }
        }
}
__global__ void __launch_bounds__(512, 2) hybrid_fwd(Args a_) {
    extern __shared__ __attribute__((aligned(16))) unsigned char lds_raw[];
    LAS unsigned char* lds = (LAS unsigned char*)lds_raw;
    const Args* ap0 = (const Args*)__builtin_amdgcn_kernarg_segment_ptr();
    cg::grid_group grid = cg::this_grid();
    const int lo = ARGP()->ph_lo, hi = ARGP()->ph_hi;
#define PHASE(k) if (lo <= (k) && (k) < hi) { if ((k) > lo) grid.sync(); run_phase<(k)>(ap0, lds); }
    PHASE(0) PHASE(1) PHASE(2) PHASE(3) PHASE(4) PHASE(5) PHASE(6) PHASE(7) PHASE(8) PHASE(9) PHASE(10)
#undef PHASE
}

extern "C" void kernel_launch(void* const* d_in, const int* in_sizes, int n_in, void* d_out, int out_size, void* d_ws, size_t ws_size, hipStream_t stream) {
    static int grid = 0;
    if (grid == 0) {
        if (n_in != 10 || out_size != MTOK * DM || ws_size < WS_END) { fprintf(stderr, "kernel_launch: unexpected shapes / workspace (n_in %d out %d ws %zu)\n", n_in, out_size, ws_size); grid = -1; return; }
        int dev = 0, cus = 0, per_cu = 0;
        (void)hipGetDevice(&dev); (void)hipDeviceGetAttribute(&cus, hipDeviceAttributeMultiprocessorCount, dev);
        (void)hipFuncSetAttribute((const void*)hybrid_fwd, hipFuncAttributeMaxDynamicSharedMemorySize, LDS_BYTES);
        (void)hipOccupancyMaxActiveBlocksPerMultiprocessor(&per_cu, (const void*)hybrid_fwd, 512, LDS_BYTES);
        (void)hipGetLastError();
        if (per_cu < 1) { fprintf(stderr, "kernel_launch: occupancy query says %d blocks/CU\n", per_cu); per_cu = 1; }
        grid = cus;
    }
    if (grid < 0) return;
    Args a{};
    for (int i = 0; i < 10; ++i) a.in[i] = (const float*)d_in[i];
    a.out = (float*)d_out; a.ws = (unsigned char*)d_ws;
#if ONE_LAUNCH
    a.ph_lo = 0; a.ph_hi = NPHASE;
    void* args[] = {&a};
    hipError_t e = hipLaunchCooperativeKernel((const void*)hybrid_fwd, dim3(grid), dim3(512), args, LDS_BYTES, stream);
    if (e != hipSuccess) fprintf(stderr, "cooperative launch failed: %s (grid %d)\n", hipGetErrorString(e), grid);
#else
    for (int ph = 0; ph < NPHASE; ++ph) { a.ph_lo = ph; a.ph_hi = ph + 1; hipLaunchKernelGGL(hybrid_fwd, dim3(grid), dim3(512), LDS_BYTES, stream, a); }
#endif
}
```

```cpp
#include <hip/hip_runtime.h>
#include <hip/hip_cooperative_groups.h>
#include <cstdio>
#include <cstdint>
namespace cg = cooperative_groups;
#ifndef ONE_LAUNCH
#define ONE_LAUNCH 1
#endif
#ifndef DUP_MASK
#define DUP_MASK 0
#endif
namespace pg8 {
#define PG8_LAS __attribute__((address_space(3)))
typedef unsigned short bf16_t;
typedef short bf16x8 __attribute__((ext_vector_type(8)));
typedef float f32x4 __attribute__((ext_vector_type(4)));
typedef unsigned u32x4 __attribute__((ext_vector_type(4)));
constexpr int BM = 256, BK = 64, HALF = 128, HTB = HALF * BK * 2  , STAGE_BYTES = 8 * HTB, NXCD = 8, WGM = 8;

__host__ __device__ __forceinline__ int lds_byte(int r, int c) { const int st = (r >> 4) * 2 + (c >> 5), rr = r & 15, cc = c & 31, ob = rr * 64 + cc * 2; return st * 1024 + (ob ^ (((ob >> 9) & 1) << 5)); }
__host__ __device__ __forceinline__ void stage_rc(int b, int& R, int& C) { const int st = b / 1024, sb = b % 1024, swz = sb ^ (((sb >> 9) & 1) << 5); R = (st >> 1) * 16 + swz / 64; C = (st & 1) * 32 + (swz % 64) / 2; }
__host__ __device__ __forceinline__ int perm32(int rho) { const int n = rho >> 4, i = rho & 15; return 8 * (i >> 2) + 4 * n + (i & 3); }

struct Unit { int pm, pn, az; };
struct Gemm { const bf16_t* A; const bf16_t* Bt; int M, N, K; size_t azs; };

struct StaticOrder {
    int nM, nN, nwg, G, c;
    __host__ __device__ void init(int M, int N, int G_, int c_) { nM = M / BM; nN = N / BM; nwg = nM * nN; G = G_; c = c_; }
    __host__ __device__ bool next(int i, Unit& u) const {
        const long L = (long)i * G + c; if (L >= nwg) return false;
        int wgid = (int)L; { const int q = nwg / NXCD, r = nwg % NXCD, xcd = wgid % NXCD, off = wgid / NXCD; wgid = (xcd < r ? xcd * (q + 1) : r * (q + 1) + (xcd - r) * q) + off; }
        const int nig = WGM * nN, gid = wgid / nig, fm = gid * WGM, gsz = (nM - fm) < WGM ? (nM - fm) : WGM;
        u.pm = fm + ((wgid % nig) % gsz); u.pn = (wgid % nig) / gsz; u.az = 0; return true;
    }
    __device__ __forceinline__ void a_ready(const Unit&) const {}
    __device__ __forceinline__ void done(const Unit&) const {}
};

__device__ __forceinline__ unsigned cvt_pk_bf16(float lo, float hi) { unsigned r; asm volatile("v_cvt_pk_bf16_f32 %0, %1, %2" : "=v"(r) : "v"(lo), "v"(hi)); return r; }
template <class Epi, class Sched, bool ALIGN_EPI = false, bool SP2 = false>
__device__ __forceinline__ void gemm_phase(PG8_LAS unsigned char* lds, const Gemm g, const Sched& S, const Epi& E) {
    const int tid = threadIdx.x, wid = __builtin_amdgcn_readfirstlane(tid >> 6), lane = tid & 63, wr = wid >> 2, wc = wid & 3, fr = lane & 15, fq = lane >> 4;
    const int K = g.K, nt = K / BK;
    unsigned voffA[2], voffB[2];
#pragma unroll
    for (int i = 0; i < 2; ++i) { int R, C; stage_rc(tid * 16 + i * 8192, R, C); const int Rb = Epi::PERM ? ((R & ~31) + perm32(R & 31)) : R;
        voffA[i] = (unsigned)(R * K + C) * 2u; voffB[i] = (unsigned)(Rb * K + C) * 2u; }
    const size_t kstep = (size_t)(BK * 2);
    const size_t hstep = (size_t)HALF * K * 2;
    const size_t tstep = 2 * hstep;
    const unsigned ldsw = (unsigned)wid * 1024u;
    const int aoff = lds_byte(wr * 64 + fr, fq * 8), boff = lds_byte(wc * 32 + fr, fq * 8);
#define PG8_SA(b, h) (((b) * 2 + (h)) * HTB)
#define PG8_SB(b, h) ((4 + (b) * 2 + (h)) * HTB)
#define PG8_STAGE(bufoff, gbase, voff) do { _Pragma("unroll") for (int _i = 0; _i < 2; ++_i) \
        __builtin_amdgcn_global_load_lds((const unsigned*)((const char*)(gbase) + (voff)[_i]), (PG8_LAS unsigned*)(lds + (bufoff) + ldsw + _i * 8192), 16, 0, 0); } while (0)
#define PG8_LDA(dst, b, h) do { _Pragma("unroll") for (int m = 0; m < 4; ++m) _Pragma("unroll") for (int k = 0; k < 2; ++k) dst[m][k] = *(const PG8_LAS bf16x8*)(lds + PG8_SA(b, h) + aoff + m * 2048 + k * 1024); } while (0)
#define PG8_LDB(dst, b, h) do { _Pragma("unroll") for (int n = 0; n < 2; ++n) _Pragma("unroll") for (int k = 0; k < 2; ++k) dst[n][k] = *(const PG8_LAS bf16x8*)(lds + PG8_SB(b, h) + boff + n * 2048 + k * 1024); } while (0)
#define PG8_MMA(ai, bj, At, Bt) do { __builtin_amdgcn_s_setprio(1); _Pragma("unroll") for (int m = 0; m < 4; ++m) _Pragma("unroll") for (int n = 0; n < 2; ++n) _Pragma("unroll") for (int k = 0; k < 2; ++k) \
        acc[ai][bj][m][n] = __builtin_amdgcn_mfma_f32_16x16x32_bf16(Bt[n][k], At[m][k], acc[ai][bj][m][n], 0, 0, 0); __builtin_amdgcn_s_setprio(0); } while (0)
#define PG8_WAIT_V(n) asm volatile("s_waitcnt vmcnt(" #n ")" ::: "memory")
#define PG8_WAIT_L(n) asm volatile("s_waitcnt lgkmcnt(" #n ")" ::: "memory")
#define PG8_BAR __builtin_amdgcn_s_barrier()
#define PG8_SCHED __builtin_amdgcn_sched_barrier(0)
    Unit cur, nxt; int ui = 0;
    if (!S.next(0, cur)) return;
    f32x4 acc[2][2][4][2];
#pragma unroll
    for (int a = 0; a < 2; ++a)
#pragma unroll
        for (int b = 0; b < 2; ++b)
#pragma unroll
            for (int m = 0; m < 4; ++m)
#pragma unroll
                for (int n = 0; n < 2; ++n) acc[a][b][m][n] = (f32x4){0.f, 0.f, 0.f, 0.f};
    bf16x8 At[4][2], B0[2][2], B1[2][2];
    const char* cA = (const char*)g.A + (size_t)cur.pm * tstep + (size_t)cur.az * g.azs; const char* cB = (const char*)g.Bt + (size_t)cur.pn * tstep;
    S.a_ready(cur);
    if constexpr (SP2) {
        PG8_STAGE(PG8_SB(0, 0), cB, voffB); PG8_STAGE(PG8_SB(0, 1), cB + hstep, voffB); PG8_STAGE(PG8_SA(0, 0), cA, voffA); PG8_STAGE(PG8_SA(0, 1), cA + hstep, voffA);
        if (wr == 1) PG8_BAR;
        PG8_WAIT_V(2); PG8_BAR;
        PG8_STAGE(PG8_SB(1, 0), cB + kstep, voffB); PG8_STAGE(PG8_SA(1, 0), cA + kstep, voffA); PG8_STAGE(PG8_SB(1, 1), cB + hstep + kstep, voffB);
        PG8_WAIT_V(6); PG8_BAR;
    } else {
        PG8_STAGE(PG8_SB(0, 0), cB, voffB); PG8_STAGE(PG8_SA(0, 0), cA, voffA); PG8_STAGE(PG8_SB(0, 1), cB + hstep, voffB); PG8_STAGE(PG8_SA(0, 1), cA + hstep, voffA);
        if (wr == 1) PG8_BAR;
        PG8_WAIT_V(4); PG8_BAR;
        PG8_STAGE(PG8_SB(1, 0), cB + kstep, voffB); PG8_STAGE(PG8_SA(1, 0), cA + kstep, voffA); PG8_STAGE(PG8_SB(1, 1), cB + hstep + kstep, voffB);
        PG8_WAIT_V(6); PG8_BAR;
    }
    for (;;) {
        const bool has_next = S.next(ui + 1, nxt);
        const char* nA = has_next ? (const char*)g.A + (size_t)nxt.pm * tstep + (size_t)nxt.az * g.azs : cA; const char* nB = has_next ? (const char*)g.Bt + (size_t)nxt.pn * tstep : cB;
        for (int t = 0; t < nt; t += 2) {
            if constexpr (Epi::MIDK) { if (t == 8 || t == 16) E.mid(acc, cur, t >> 3, wr, wc, fr, fq); }
            const bool last = (t == nt - 2);
            const char* a1 = cA + (size_t)(t + 1) * kstep;
            const char* a2 = last ? nA : cA + (size_t)(t + 2) * kstep; const char* b2 = last ? nB : cB + (size_t)(t + 2) * kstep;
            const char* a3 = a2 + kstep; const char* b3 = b2 + kstep;
            if (last && has_next) S.a_ready(nxt);
            if constexpr (SP2) {
            PG8_LDB(B0, 0, 0); PG8_LDB(B1, 0, 1); PG8_SCHED; PG8_LDA(At, 0, 0); PG8_STAGE(PG8_SA(1, 1), a1 + hstep, voffA);
            PG8_WAIT_V(8); PG8_WAIT_L(0); PG8_BAR; PG8_MMA(0, 0, At, B0); PG8_MMA(0, 1, At, B1); PG8_BAR; PG8_SCHED;
            PG8_LDA(At, 0, 1); PG8_STAGE(PG8_SB(0, 0), b2, voffB); PG8_STAGE(PG8_SB(0, 1), b2 + hstep, voffB); PG8_STAGE(PG8_SA(0, 0), a2, voffA);
            PG8_WAIT_V(8); PG8_WAIT_L(0); PG8_BAR; PG8_MMA(1, 0, At, B0); PG8_MMA(1, 1, At, B1); PG8_BAR; PG8_SCHED;
            PG8_LDB(B0, 1, 0); PG8_LDB(B1, 1, 1); PG8_SCHED; PG8_LDA(At, 1, 0); PG8_STAGE(PG8_SA(0, 1), a2 + hstep, voffA);
            PG8_WAIT_V(8); PG8_WAIT_L(0); PG8_BAR; PG8_MMA(0, 0, At, B0); PG8_MMA(0, 1, At, B1); PG8_BAR; PG8_SCHED;
            PG8_LDA(At, 1, 1); PG8_STAGE(PG8_SB(1, 0), b3, voffB); PG8_STAGE(PG8_SB(1, 1), b3 + hstep, voffB); PG8_STAGE(PG8_SA(1, 0), a3, voffA);
            PG8_WAIT_V(8); PG8_WAIT_L(0); PG8_BAR; PG8_MMA(1, 0, At, B0); PG8_MMA(1, 1, At, B1); PG8_BAR; PG8_SCHED;
            } else {
            PG8_LDB(B0, 0, 0); PG8_SCHED; PG8_LDA(At, 0, 0); PG8_STAGE(PG8_SA(1, 1), a1 + hstep, voffA);
            PG8_WAIT_L(8); PG8_BAR; PG8_WAIT_L(0); PG8_MMA(0, 0, At, B0); PG8_BAR; PG8_SCHED;
            PG8_LDB(B1, 0, 1); PG8_STAGE(PG8_SB(0, 0), b2, voffB);
            PG8_BAR; PG8_WAIT_L(0); PG8_MMA(0, 1, At, B1); PG8_BAR;
            PG8_LDA(At, 0, 1); PG8_STAGE(PG8_SA(0, 0), a2, voffA);
            PG8_BAR; PG8_WAIT_L(0); PG8_MMA(1, 0, At, B0); PG8_BAR; PG8_SCHED;
            PG8_STAGE(PG8_SB(0, 1), b2 + hstep, voffB);
            PG8_WAIT_V(6); PG8_BAR; PG8_MMA(1, 1, At, B1); PG8_BAR;
            PG8_LDB(B0, 1, 0); PG8_SCHED; PG8_LDA(At, 1, 0); PG8_STAGE(PG8_SA(0, 1), a2 + hstep, voffA);
            PG8_WAIT_L(8); PG8_BAR; PG8_WAIT_L(0); PG8_MMA(0, 0, At, B0); PG8_BAR; PG8_SCHED;
            PG8_LDB(B1, 1, 1); PG8_STAGE(PG8_SB(1, 0), b3, voffB);
            PG8_BAR; PG8_WAIT_L(0); PG8_MMA(0, 1, At, B1); PG8_BAR;
            PG8_LDA(At, 1, 1); PG8_STAGE(PG8_SA(1, 0), a3, voffA);
            PG8_BAR; PG8_WAIT_L(0); PG8_MMA(1, 0, At, B0); PG8_BAR; PG8_SCHED;
            PG8_STAGE(PG8_SB(1, 1), b3 + hstep, voffB);
            PG8_WAIT_V(6); PG8_BAR; PG8_MMA(1, 1, At, B1); PG8_BAR;
            }
        }
        if constexpr (ALIGN_EPI) { if (wr == 0) PG8_BAR; }
        if constexpr (!Epi::AFTER_DRAIN) { E(acc, cur, wr, wc, fr, fq); S.done(cur); }
        if (!has_next) break;
#pragma unroll
        for (int a = 0; a < 2; ++a)
#pragma unroll
            for (int b = 0; b < 2; ++b)
#pragma unroll
                for (int m = 0; m < 4; ++m)
#pragma unroll
                    for (int n = 0; n < 2; ++n) acc[a][b][m][n] = (f32x4){0.f, 0.f, 0.f, 0.f};
        cur = nxt; cA = nA; cB = nB; ++ui;
        if constexpr (ALIGN_EPI) { if (wr == 1) PG8_BAR; }
    }
    PG8_WAIT_V(0);
    if constexpr (!ALIGN_EPI) { if (wr == 0) PG8_BAR; }
    PG8_BAR;
    if constexpr (Epi::AFTER_DRAIN) { E.fused(acc, cur, wr, wc, fr, fq, lds, wid, lane); S.done(cur); }
#undef PG8_SA
#undef PG8_SB
#undef PG8_STAGE
#undef PG8_LDA
#undef PG8_LDB
#undef PG8_MMA
#undef PG8_WAIT_V
#undef PG8_WAIT_L
#undef PG8_BAR
#undef PG8_SCHED
}
}

#define LAS __attribute__((address_space(3)))
typedef unsigned short bf16_t;
typedef short bf16x8 __attribute__((ext_vector_type(8)));
typedef short s16x4 __attribute__((ext_vector_type(4)));
typedef float f32x4 __attribute__((ext_vector_type(4)));
typedef float f32x16 __attribute__((ext_vector_type(16)));
typedef unsigned u32x4 __attribute__((ext_vector_type(4)));
typedef unsigned u32x2 __attribute__((ext_vector_type(2)));
constexpr int NB = 4, SEQ = 4096, DM = 1024, MTOK = NB * SEQ, NIN = 8192, BWID = 512, NLAYER = 2;
constexpr float RMS_EPS = 1e-6f;
constexpr size_t MiB = 1u << 20;
constexpr size_t WS_RS = 0;
constexpr size_t WS_W1 = 2 * MiB;
constexpr size_t WS_W2 = 34 * MiB;
constexpr size_t WS_W3 = 40 * MiB;
constexpr size_t WS_PW = 44 * MiB;
constexpr size_t WS_H = 45 * MiB;
constexpr size_t WS_U = 77 * MiB;
constexpr size_t ARRB = 16 * MiB;
constexpr size_t WS_MG = 205 * MiB;
constexpr size_t WS_END = 253 * MiB;
constexpr int LDS_BYTES = 147456;
constexpr int NPHASE = 1 + 5 * NLAYER;

__device__ __forceinline__ unsigned f2bf(float f) { unsigned u = __builtin_bit_cast(unsigned, f); return (u + 0x7fffu + ((u >> 16) & 1u)) >> 16; }
__device__ __forceinline__ unsigned pk2(float lo, float hi) { return f2bf(lo) | (f2bf(hi) << 16); }
__device__ __forceinline__ float bflo(unsigned u) { return __builtin_bit_cast(float, u << 16); }
__device__ __forceinline__ float bfhi(unsigned u) { return __builtin_bit_cast(float, u & 0xffff0000u); }
__device__ __forceinline__ float sigmoid_f(float x) { return __builtin_amdgcn_rcpf(1.f + __builtin_amdgcn_exp2f(-1.4426950408889634f * x)); }
__device__ __forceinline__ float silu_f(float x) { return x * sigmoid_f(x); }
__device__ __forceinline__ unsigned q8(float x) { const unsigned q = (unsigned)(sigmoid_f(x) * 255.f + 0.5f); return q < 1u ? 1u : q; }
__device__ __forceinline__ float wave_sum(float v) {
#pragma unroll
    for (int o = 1; o < 64; o <<= 1) v += __shfl_xor(v, o);
    return v;
}

using pg8::Unit;
struct EpiU {
    static constexpr bool PERM = true, AFTER_DRAIN = false, MIDK = false;
    unsigned char* ws;
    __device__ __forceinline__ void operator()(const f32x4 (&acc)[2][2][4][2], const Unit& u, int wr, int wc, int fr, int fq) const {
        bf16_t* U = (bf16_t*)(ws + WS_U); unsigned char* MG = ws + WS_MG;
        const int pn = u.pn; const int row0 = u.pm * 256 + wr * 64 + fr;
        if (pn >= 20) {
            const int mc0 = (pn - 20) * 256 + wc * 32 + 8 * fq;
#pragma unroll
            for (int ai = 0; ai < 2; ++ai)
#pragma unroll
                for (int m = 0; m < 4; ++m) { unsigned char* rp = MG + (size_t)(row0 + ai * 128 + m * 16) * 3072 + mc0;
#pragma unroll
                    for (int bj = 0; bj < 2; ++bj) { const f32x4 v0 = acc[ai][bj][m][0], v1 = acc[ai][bj][m][1]; u32x2 w;
                        w.x = q8(v0[0]) | (q8(v0[1]) << 8) | (q8(v0[2]) << 16) | (q8(v0[3]) << 24); w.y = q8(v1[0]) | (q8(v1[1]) << 8) | (q8(v1[2]) << 16) | (q8(v1[3]) << 24);
                        *(u32x2*)(rp + bj * 128) = w; } }
        } else if (pn >= 4 && pn < 12) {
            const int ch0 = (pn - 4) * 64 + (4 * wc + fq) * 4;
            bf16_t* Z = U + 1 * (ARRB / 2); bf16_t* W = U + 5 * (ARRB / 2) + 512;
#pragma unroll
            for (int ai = 0; ai < 2; ++ai)
#pragma unroll
                for (int m = 0; m < 4; ++m) { const size_t rr = (size_t)(row0 + ai * 128 + m * 16); const size_t ro = rr * 512 + ch0, rw = rr * 1536 + ch0;
                    const f32x4 z = acc[ai][0][m][0] * acc[ai][0][m][1]; const f32x4 gb = acc[ai][1][m][0], gg = acc[ai][1][m][1];
                    u32x2 zz, ww; zz.x = pg8::cvt_pk_bf16(z[0], z[1]); zz.y = pg8::cvt_pk_bf16(z[2], z[3]);
                    ww.x = pg8::cvt_pk_bf16(gb[0] * silu_f(gg[0]), gb[1] * silu_f(gg[1])); ww.y = pg8::cvt_pk_bf16(gb[2] * silu_f(gg[2]), gb[3] * silu_f(gg[3]));
                    *(u32x2*)(Z + ro) = zz; *(u32x2*)(W + rw) = ww; }
        } else {
            const int kind = pn >> 1; int arr = 0, pitch = 512, coff = 0; bool act = false;
            if (kind == 1) { arr = 5; act = true; pitch = 1536; } else if (kind == 6) arr = 2; else if (kind == 7) arr = 3; else if (kind == 8) arr = 4; else if (kind == 9) { arr = 5; act = true; pitch = 1536; coff = 1024; }
            bf16_t* O = U + (size_t)arr * (ARRB / 2) + coff; const int col0 = (pn & 1) * 256 + wc * 32 + 8 * fq;
#pragma unroll
            for (int ai = 0; ai < 2; ++ai)
#pragma unroll
                for (int m = 0; m < 4; ++m) { bf16_t* rp = O + (size_t)(row0 + ai * 128 + m * 16) * pitch + col0;
#pragma unroll
                    for (int bj = 0; bj < 2; ++bj) { f32x4 v0 = acc[ai][bj][m][0], v1 = acc[ai][bj][m][1];
                        if (act) {
#pragma unroll
                            for (int i = 0; i < 4; ++i) { v0[i] = silu_f(v0[i]); v1[i] = silu_f(v1[i]); } }
                        u32x4 w; w.x = pg8::cvt_pk_bf16(v0[0], v0[1]); w.y = pg8::cvt_pk_bf16(v0[2], v0[3]); w.z = pg8::cvt_pk_bf16(v1[0], v1[1]); w.w = pg8::cvt_pk_bf16(v1[2], v1[3]);
                        *(u32x4*)(rp + bj * 128) = w; } }
        }
    }
};
struct EpiBranch {
    static constexpr bool PERM = true, AFTER_DRAIN = false, MIDK = true;
    unsigned char* ws;
    __device__ __forceinline__ void mid(f32x4 (&acc)[2][2][4][2], const Unit& u, int seg, int wr, int wc, int fr, int fq) const {
        int tid_ = threadIdx.x; asm volatile("" : "+v"(tid_));
        const int wid_ = tid_ >> 6, wr_ = wid_ >> 2, wc_ = wid_ & 3, fr_ = tid_ & 15, fq_ = (tid_ & 63) >> 4;
        const unsigned char* MG = ws + WS_MG + (seg - 1) * 1024; const int row0 = u.pm * 256 + wr_ * 64 + fr_, col0 = u.pn * 256 + wc_ * 32 + 8 * fq_;
#pragma unroll
        for (int ai = 0; ai < 2; ++ai)
#pragma unroll
            for (int m = 0; m < 4; ++m) { const unsigned char* rp = MG + (size_t)(row0 + ai * 128 + m * 16) * 3072 + col0;
#pragma unroll
                for (int bj = 0; bj < 2; ++bj) { const u32x2 qa = *(const u32x2*)(rp + bj * 128), qb = *(const u32x2*)(rp + bj * 128 + 1024);
                    f32x4 r0, r1;
                    r0[0] = (float)(qa.x & 255u) * __builtin_amdgcn_rcpf((float)(qb.x & 255u)); r0[1] = (float)((qa.x >> 8) & 255u) * __builtin_amdgcn_rcpf((float)((qb.x >> 8) & 255u));
                    r0[2] = (float)((qa.x >> 16) & 255u) * __builtin_amdgcn_rcpf((float)((qb.x >> 16) & 255u)); r0[3] = (float)(qa.x >> 24) * __builtin_amdgcn_rcpf((float)(qb.x >> 24));
                    r1[0] = (float)(qa.y & 255u) * __builtin_amdgcn_rcpf((float)(qb.y & 255u)); r1[1] = (float)((qa.y >> 8) & 255u) * __builtin_amdgcn_rcpf((float)((qb.y >> 8) & 255u));
                    r1[2] = (float)((qa.y >> 16) & 255u) * __builtin_amdgcn_rcpf((float)((qb.y >> 16) & 255u)); r1[3] = (float)(qa.y >> 24) * __builtin_amdgcn_rcpf((float)(qb.y >> 24));
                    acc[ai][bj][m][0] *= r0; acc[ai][bj][m][1] *= r1; }
                if (m == 3) asm volatile("" ::: "memory"); }
    }
    __device__ __forceinline__ void operator()(const f32x4 (&acc)[2][2][4][2], const Unit& u, int wr, int wc, int fr, int fq) const {
        const unsigned char* MG = ws + WS_MG + 2 * 1024; bf16_t* merged = (bf16_t*)(ws + WS_H);
        const int row0 = u.pm * 256 + wr * 64 + fr, col0 = u.pn * 256 + wc * 32 + 8 * fq;
#pragma unroll
        for (int ai = 0; ai < 2; ++ai)
#pragma unroll
            for (int m = 0; m < 4; ++m) { const size_t row = (size_t)(row0 + ai * 128 + m * 16);
#pragma unroll
                for (int bj = 0; bj < 2; ++bj) { const int col = col0 + bj * 128;
                    const u32x2 gq = *(const u32x2*)(MG + row * 3072 + col);
                    f32x4 g0, g1; const float k = 1.f / 255.f;
                    g0[0] = (float)(gq.x & 255u) * k; g0[1] = (float)((gq.x >> 8) & 255u) * k; g0[2] = (float)((gq.x >> 16) & 255u) * k; g0[3] = (float)(gq.x >> 24) * k;
                    g1[0] = (float)(gq.y & 255u) * k; g1[1] = (float)((gq.y >> 8) & 255u) * k; g1[2] = (float)((gq.y >> 16) & 255u) * k; g1[3] = (float)(gq.y >> 24) * k;
                    const f32x4 v0 = acc[ai][bj][m][0] * g0, v1 = acc[ai][bj][m][1] * g1;
                    u32x4 w; w.x = pg8::cvt_pk_bf16(v0[0], v0[1]); w.y = pg8::cvt_pk_bf16(v0[2], v0[3]); w.z = pg8::cvt_pk_bf16(v1[0], v1[1]); w.w = pg8::cvt_pk_bf16(v1[2], v1[3]);
                    *(u32x4*)(merged + row * 1024 + col) = w; } }
    }
};
struct EpiOut {
    static constexpr bool PERM = false, AFTER_DRAIN = false, MIDK = false;
    unsigned char* ws;
    __device__ __forceinline__ void operator()(const f32x4 (&acc)[2][2][4][2], const Unit& u, int wr, int wc, int fr, int fq) const {
        float* out = (float*)(ws + WS_U); float* rs = (float*)(ws + WS_RS);
        const int row0 = u.pm * 256 + wr * 64 + fr, col0 = u.pn * 256 + wc * 32 + 4 * fq;
#pragma unroll
        for (int ai = 0; ai < 2; ++ai)
#pragma unroll
            for (int m = 0; m < 4; ++m) { const size_t row = (size_t)(row0 + ai * 128 + m * 16); float ss = 0.f;
#pragma unroll
                for (int bj = 0; bj < 2; ++bj)
#pragma unroll
                    for (int n = 0; n < 2; ++n) { const f32x4 v = acc[ai][bj][m][n]; *(f32x4*)(out + row * 1024 + col0 + bj * 128 + n * 16) = v; ss += (v[0] * v[0] + v[1] * v[1]) + (v[2] * v[2] + v[3] * v[3]); }
                ss += __shfl_xor(ss, 16); ss += __shfl_xor(ss, 32);
                if (fq == 0) rs[row * 16 + u.pn * 4 + wc] = ss; }
    }
};
__device__ __forceinline__ int win_row(int c) {
    if (c < 1024 || c >= 3072) return c;
    const int q = (c - 1024) >> 9, ch = (c - 1024) & 511, ct = ch >> 6, grp = (ch & 63) >> 2, e = ch & 3;
    return 1024 + ct * 256 + (q & 1) * 128 + grp * 8 + (q >> 1) * 4 + e;
}
__device__ __forceinline__ void transpose_item(const float* W, int N, bf16_t* WT, int ldt, int koff, int row_off, bool winmap, LAS float* scr, int item, int lane) {
    const int nblk = N / 64, kb = item / nblk, nb = item % nblk, k0 = 64 * kb, n0 = 64 * nb;
    const int kq = lane >> 4, nq = lane & 15;
    f32x4 v[16];
#pragma unroll
    for (int i = 0; i < 16; ++i) v[i] = *(const f32x4*)(W + (size_t)(k0 + 4 * i + kq) * N + n0 + 4 * nq);
#pragma unroll
    for (int i = 0; i < 16; ++i) { LAS float* s = scr + (4 * i + kq) * 65 + 4 * nq; s[0] = v[i][0]; s[1] = v[i][1]; s[2] = v[i][2]; s[3] = v[i][3]; }
    asm volatile("s_waitcnt lgkmcnt(0)" ::: "memory");
    const int c = lane & 7;
#pragma unroll
    for (int j = 0; j < 8; ++j) { const int n = (lane >> 3) + 8 * j; const LAS float* s = scr + (8 * c) * 65 + n;
        u32x4 o; o.x = pk2(s[0 * 65], s[1 * 65]); o.y = pk2(s[2 * 65], s[3 * 65]); o.z = pk2(s[4 * 65], s[5 * 65]); o.w = pk2(s[6 * 65], s[7 * 65]);
        int dst = n0 + n; if (winmap) dst = win_row(dst);
        *(u32x4*)(WT + (size_t)(row_off + dst) * ldt + koff + k0 + 8 * c) = o; }
    asm volatile("s_waitcnt lgkmcnt(0)" ::: "memory");
}
template <int R> __device__ __forceinline__ void rms_rows_to_bf16(const float* x, const float* g, bf16_t* H, int m0, int mstride, int lane) {
    f32x4 v[R][4];
#pragma unroll
    for (int r = 0; r < R; ++r)
#pragma unroll
        for (int j = 0; j < 4; ++j) v[r][j] = ((const f32x4*)(x + (size_t)(m0 + r * mstride) * DM))[64 * j + lane];
    f32x4 gg[4];
#pragma unroll
    for (int j = 0; j < 4; ++j) gg[j] = ((const f32x4*)g)[64 * j + lane];
#pragma unroll
    for (int r = 0; r < R; ++r) { float s = 0.f;
#pragma unroll
        for (int j = 0; j < 4; ++j) s += (v[r][j][0] * v[r][j][0] + v[r][j][1] * v[r][j][1]) + (v[r][j][2] * v[r][j][2] + v[r][j][3] * v[r][j][3]);
        const float rstd = 1.f / sqrtf(wave_sum(s) * (1.f / DM) + RMS_EPS);
        u32x2* o8 = (u32x2*)(H + (size_t)(m0 + r * mstride) * DM) + lane;
#pragma unroll
        for (int j = 0; j < 4; ++j) { u32x2 w; w.x = pk2(v[r][j][0] * rstd * gg[j][0], v[r][j][1] * rstd * gg[j][1]); w.y = pk2(v[r][j][2] * rstd * gg[j][2], v[r][j][3] * rstd * gg[j][3]); o8[64 * j] = w; } }
}

__device__ __forceinline__ int crow(int r, int hi) { return (r & 3) + 8 * (r >> 2) + 4 * hi; }
constexpr int VROW = 144;
__device__ __forceinline__ void attn_item(int item, const bf16_t* Q, const bf16_t* K, const bf16_t* V, bf16_t* SG, LAS unsigned char* vl, int lane) {
    const int qg = item & 127, h = (item >> 7) & 7, b = item >> 10;
    const int r32 = lane & 31, hi = lane >> 5, t0 = qg * 32;
    const size_t tokq = (size_t)b * SEQ + t0 + r32;
    bf16x8 qf[4];
#pragma unroll
    for (int d0 = 0; d0 < 4; ++d0) qf[d0] = *(const bf16x8*)(Q + tokq * 512 + h * 64 + d0 * 16 + 8 * hi);
    f32x16 o0, o1;
#pragma unroll
    for (int r = 0; r < 16; ++r) { o0[r] = 0.f; o1[r] = 0.f; }
    float P = 1.f;
    const int i16 = lane & 15, G4 = lane >> 4;
    const int vb = (4 * (G4 >> 1) + (i16 >> 2)) * VROW + (16 * (G4 & 1) + 4 * (i16 & 3)) * 2;
    for (int s0 = t0; s0 >= 0; s0 -= 32) {
        const size_t tokk = (size_t)b * SEQ + s0;
        bf16x8 kf[4];
#pragma unroll
        for (int d0 = 0; d0 < 4; ++d0) kf[d0] = *(const bf16x8*)(K + (tokk + r32) * 512 + h * 64 + d0 * 16 + 8 * hi);
#pragma unroll
        for (int p = 0; p < 4; ++p) { const int idx = p * 64 + lane, key = idx >> 3, ch = idx & 7;
            const u32x4 v = *(const u32x4*)(V + (tokk + key) * 512 + h * 64 + ch * 8);
            *(LAS u32x4*)(vl + key * VROW + ch * 16) = v; }
        f32x16 s;
#pragma unroll
        for (int r = 0; r < 16; ++r) s[r] = 0.f;
#pragma unroll
        for (int d0 = 0; d0 < 4; ++d0) s = __builtin_amdgcn_mfma_f32_32x32x16_bf16(kf[d0], qf[d0], s, 0, 0, 0);
        const bool diag = (s0 == t0);
        float kp[16];
#pragma unroll
        for (int r = 0; r < 16; ++r) { const float e = __builtin_amdgcn_exp2f(s[r] * (0.125f * 1.4426950408889634f)); float k = __builtin_amdgcn_rcpf(1.f + e);
            if (diag && crow(r, hi) >= r32) k = 1.f; kp[r] = k; }
        float Gm[4], Go[4], T[4], R[4], C[4];
#pragma unroll
        for (int g = 0; g < 4; ++g) { Gm[g] = (kp[4 * g] * kp[4 * g + 1]) * (kp[4 * g + 2] * kp[4 * g + 3]); Go[g] = __shfl_xor(Gm[g], 32); T[g] = Gm[g] * Go[g]; }
        R[3] = P; R[2] = R[3] * T[3]; R[1] = R[2] * T[2]; R[0] = R[1] * T[1]; const float Cout = R[0] * T[0];
#pragma unroll
        for (int g = 0; g < 4; ++g) C[g] = hi ? R[g] : R[g] * Go[g];
        float w[16];
#pragma unroll
        for (int g = 0; g < 4; ++g) { const float p3 = C[g], p2 = p3 * kp[4 * g + 3], p1 = p2 * kp[4 * g + 2], p0 = p1 * kp[4 * g + 1], pe = p0 * kp[4 * g];
            w[4 * g + 3] = p3 - p2; w[4 * g + 2] = p2 - p1; w[4 * g + 1] = p1 - p0; w[4 * g] = p0 - pe; }
        bf16x8 wf[2];
#pragma unroll
        for (int st = 0; st < 2; ++st) { u32x4 t; t.x = pk2(w[8 * st], w[8 * st + 1]); t.y = pk2(w[8 * st + 2], w[8 * st + 3]); t.z = pk2(w[8 * st + 4], w[8 * st + 5]); t.w = pk2(w[8 * st + 6], w[8 * st + 7]); wf[st] = __builtin_bit_cast(bf16x8, t); }
#pragma unroll
        for (int dt = 0; dt < 2; ++dt)
#pragma unroll
            for (int st = 0; st < 2; ++st) {
                const s16x4 lo = __builtin_amdgcn_ds_read_tr16_b64_v4i16((LAS s16x4*)(vl + vb + (16 * st) * VROW + dt * 64));
                const s16x4 hh = __builtin_amdgcn_ds_read_tr16_b64_v4i16((LAS s16x4*)(vl + vb + (16 * st + 8) * VROW + dt * 64));
                const bf16x8 vf = (bf16x8){lo[0], lo[1], lo[2], lo[3], hh[0], hh[1], hh[2], hh[3]};
                if (dt == 0) o0 = __builtin_amdgcn_mfma_f32_32x32x16_bf16(vf, wf[st], o0, 0, 0, 0); else o1 = __builtin_amdgcn_mfma_f32_32x32x16_bf16(vf, wf[st], o1, 0, 0, 0); }
        P = Cout;
        if (__all(P < 1.17549435e-38f)) break;
    }
#pragma unroll
    for (int dt = 0; dt < 2; ++dt)
#pragma unroll
        for (int g = 0; g < 4; ++g) { bf16_t* p = SG + tokq * 1536 + h * 64 + dt * 32 + 8 * g + 4 * hi; const u32x2 sg = *(const u32x2*)p;
            const f32x16& o = dt ? o1 : o0; u32x2 y;
            y.x = pk2(o[4 * g] * bflo(sg.x), o[4 * g + 1] * bfhi(sg.x)); y.y = pk2(o[4 * g + 2] * bflo(sg.y), o[4 * g + 3] * bfhi(sg.y));
            *(u32x2*)p = y; }
}
__device__ __forceinline__ void pool_item(int pi, const bf16_t* PV, bf16_t* SG, const bf16_t* PT, const float* scale, int lane) {
    const int tile = pi >> 2, g = ((pi & 3) + ((pi >> 2) & 1)) & 3, win = 2 << g;
    const int r32 = lane & 31, hi = lane >> 5, tok = tile * 32 + r32, t = tok & (SEQ - 1);
    const bf16_t* vp = PV + (size_t)tok * 512 + g * 128 + 8 * hi;
    const int cnt = (t + 1) < win ? (t + 1) : win;
    float sum[8][8];
#pragma unroll
    for (int s = 0; s < 8; ++s) { const u32x4 raw = *(const u32x4*)(vp + 16 * s); const float f = 1.f - (float)cnt;
        sum[s][0] = bflo(raw.x) * f; sum[s][1] = bfhi(raw.x) * f; sum[s][2] = bflo(raw.y) * f; sum[s][3] = bfhi(raw.y) * f;
        sum[s][4] = bflo(raw.z) * f; sum[s][5] = bfhi(raw.z) * f; sum[s][6] = bflo(raw.w) * f; sum[s][7] = bfhi(raw.w) * f; }
    for (int jj = 1; jj < win; ++jj) {
        if (t - jj >= 0) {
#pragma unroll
            for (int s = 0; s < 8; ++s) { const u32x4 raw = *(const u32x4*)(vp - (size_t)jj * 512 + 16 * s);
                sum[s][0] += bflo(raw.x); sum[s][1] += bfhi(raw.x); sum[s][2] += bflo(raw.y); sum[s][3] += bfhi(raw.y);
                sum[s][4] += bflo(raw.z); sum[s][5] += bfhi(raw.z); sum[s][6] += bflo(raw.w); sum[s][7] += bfhi(raw.w); } }
    }
    const float inv = 1.f / (float)cnt;
    bf16x8 pf[8];
#pragma unroll
    for (int s = 0; s < 8; ++s) { u32x4 tt; tt.x = pk2(sum[s][0] * inv, sum[s][1] * inv); tt.y = pk2(sum[s][2] * inv, sum[s][3] * inv); tt.z = pk2(sum[s][4] * inv, sum[s][5] * inv); tt.w = pk2(sum[s][6] * inv, sum[s][7] * inv); pf[s] = __builtin_bit_cast(bf16x8, tt); }
#pragma unroll
    for (int nt = 0; nt < 4; ++nt) {
        f32x16 acc;
#pragma unroll
        for (int r = 0; r < 16; ++r) acc[r] = 0.f;
        const bf16_t* ap = PT + (size_t)(g * 128 + nt * 32 + r32) * 128 + 8 * hi;
#pragma unroll
        for (int s = 0; s < 8; ++s) { const bf16x8 a = *(const bf16x8*)(ap + 16 * s); acc = __builtin_amdgcn_mfma_f32_32x32x16_bf16(a, pf[s], acc, 0, 0, 0); }
#pragma unroll
        for (int q = 0; q < 4; ++q) { const int d = g * 128 + nt * 32 + 8 * q + 4 * hi; const f32x4 sc = *(const f32x4*)(scale + d);
            bf16_t* p = SG + (size_t)tok * 1536 + d; const u32x2 sg = *(const u32x2*)p; u32x2 y;
            y.x = pk2(acc[4 * q] * sc[0] * bflo(sg.x), acc[4 * q + 1] * sc[1] * bfhi(sg.x)); y.y = pk2(acc[4 * q + 2] * sc[2] * bflo(sg.y), acc[4 * q + 3] * sc[3] * bfhi(sg.y));
            *(u32x2*)p = y; }
    }
}
__device__ __forceinline__ void conv_item(int ci, const bf16_t* Z, bf16_t* Wy, const float* cw, const float* cb, int lane) {
    const int tok0 = ci * 8, t0 = tok0 & (SEQ - 1), ch = lane * 8;
    float w0[8], w1[8], w2[8], bs[8], zm2[8], zm1[8];
#pragma unroll
    for (int hf = 0; hf < 2; ++hf) { const f32x4 a = *(const f32x4*)(cw + ch + 4 * hf), b = *(const f32x4*)(cw + 512 + ch + 4 * hf), c = *(const f32x4*)(cw + 1024 + ch + 4 * hf), d = *(const f32x4*)(cb + ch + 4 * hf);
#pragma unroll
        for (int i = 0; i < 4; ++i) { w0[4 * hf + i] = a[i]; w1[4 * hf + i] = b[i]; w2[4 * hf + i] = c[i]; bs[4 * hf + i] = d[i]; } }
#pragma unroll
    for (int i = 0; i < 8; ++i) { zm2[i] = 0.f; zm1[i] = 0.f; }
    if (t0 != 0) { const u32x4 a = *(const u32x4*)(Z + (size_t)(tok0 - 2) * 512 + ch), b = *(const u32x4*)(Z + (size_t)(tok0 - 1) * 512 + ch);
        zm2[0] = bflo(a.x); zm2[1] = bfhi(a.x); zm2[2] = bflo(a.y); zm2[3] = bfhi(a.y); zm2[4] = bflo(a.z); zm2[5] = bfhi(a.z); zm2[6] = bflo(a.w); zm2[7] = bfhi(a.w);
        zm1[0] = bflo(b.x); zm1[1] = bfhi(b.x); zm1[2] = bflo(b.y); zm1[3] = bfhi(b.y); zm1[4] = bflo(b.z); zm1[5] = bfhi(b.z); zm1[6] = bflo(b.w); zm1[7] = bfhi(b.w); }
#pragma unroll
    for (int r = 0; r < 8; ++r) { const size_t off = (size_t)(tok0 + r) * 512 + ch, offw = (size_t)(tok0 + r) * 1536 + ch; const u32x4 zr = *(const u32x4*)(Z + off), wr_ = *(const u32x4*)(Wy + offw);
        float zc[8], wv[8], y[8];
        zc[0] = bflo(zr.x); zc[1] = bfhi(zr.x); zc[2] = bflo(zr.y); zc[3] = bfhi(zr.y); zc[4] = bflo(zr.z); zc[5] = bfhi(zr.z); zc[6] = bflo(zr.w); zc[7] = bfhi(zr.w);
        wv[0] = bflo(wr_.x); wv[1] = bfhi(wr_.x); wv[2] = bflo(wr_.y); wv[3] = bfhi(wr_.y); wv[4] = bflo(wr_.z); wv[5] = bfhi(wr_.z); wv[6] = bflo(wr_.w); wv[7] = bfhi(wr_.w);
#pragma unroll
        for (int i = 0; i < 8; ++i) { y[i] = wv[i] * (w0[i] * zm2[i] + w1[i] * zm1[i] + w2[i] * zc[i] + bs[i]); zm2[i] = zm1[i]; zm1[i] = zc[i]; }
        u32x4 o; o.x = pk2(y[0], y[1]); o.y = pk2(y[2], y[3]); o.z = pk2(y[4], y[5]); o.w = pk2(y[6], y[7]);
        *(u32x4*)(Wy + offw) = o; }
}
template <int R> __device__ __forceinline__ void norm_rows(const float* F32T, const float* RS, const float* xin, const float* gpost, float* xout, const float* gnext, bf16_t* H, int m0, int mstride, int lane) {
    f32x4 o[R][4], xi[R][4]; float ss[R];
#pragma unroll
    for (int r = 0; r < R; ++r) { const size_t row = (size_t)(m0 + r * mstride); ss[r] = (lane < 16) ? RS[row * 16 + lane] : 0.f;
#pragma unroll
        for (int j = 0; j < 4; ++j) { o[r][j] = ((const f32x4*)(F32T + row * DM))[64 * j + lane]; xi[r][j] = ((const f32x4*)(xin + row * DM))[64 * j + lane]; } }
    f32x4 gp[4];
#pragma unroll
    for (int j = 0; j < 4; ++j) gp[j] = ((const f32x4*)gpost)[64 * j + lane];
#pragma unroll
    for (int r = 0; r < R; ++r) { const size_t row = (size_t)(m0 + r * mstride);
        const float rstd = 1.f / sqrtf(wave_sum(ss[r]) * (1.f / DM) + RMS_EPS); float s2 = 0.f;
#pragma unroll
        for (int j = 0; j < 4; ++j) { const f32x4 v = xi[r][j] + o[r][j] * rstd * gp[j]; xi[r][j] = v; ((f32x4*)(xout + row * DM))[64 * j + lane] = v; s2 += (v[0] * v[0] + v[1] * v[1]) + (v[2] * v[2] + v[3] * v[3]); }
        if (gnext) { const float r2 = 1.f / sqrtf(wave_sum(s2) * (1.f / DM) + RMS_EPS);
#pragma unroll
            for (int j = 0; j < 4; ++j) { const f32x4 gg = ((const f32x4*)gnext)[64 * j + lane]; const f32x4 v = xi[r][j]; u32x2 w; w.x = pk2(v[0] * r2 * gg[0], v[1] * r2 * gg[1]); w.y = pk2(v[2] * r2 * gg[2], v[3] * r2 * gg[3]); ((u32x2*)(H + row * DM))[64 * j + lane] = w; } } }
}

struct Args { const float* in[10]; float* out; unsigned char* ws; int ph_lo, ph_hi; };
#define ARGP() ({ const Args* p_ = ap0; asm volatile("" : "+s"(p_)); p_; })
template <int ph> __device__ __forceinline__ void run_phase(const Args* ap0, LAS unsigned char* lds) {
        const Args* A = ARGP();
        const int tid = threadIdx.x, lane = tid & 63, wave = __builtin_amdgcn_readfirstlane(tid >> 6);
        const int G = gridDim.x, bx = blockIdx.x;
        const int vcu = (G % 8 == 0) ? (bx % 8) * (G / 8) + bx / 8 : bx;
        const int gw = vcu * 8 + wave, NGW = G * 8;
        unsigned char* ws = A->ws;
        bf16_t* H = (bf16_t*)(ws + WS_H); bf16_t* U = (bf16_t*)(ws + WS_U);
        if constexpr (ph == 0) {
            const float* x = A->in[0]; const float* pre_g = A->in[1]; const float* w_in = A->in[2]; const float* pool_w = A->in[3]; const float* w_branch = A->in[7]; const float* w_out = A->in[8];
            bf16_t* W1 = (bf16_t*)(ws + WS_W1); bf16_t* W2 = (bf16_t*)(ws + WS_W2); bf16_t* W3 = (bf16_t*)(ws + WS_W3); bf16_t* PW = (bf16_t*)(ws + WS_PW);
            LAS float* scr = (LAS float*)(lds + wave * 17408);
            constexpr int I1 = (DM / 64) * (NIN / 64), I2 = (BWID / 64) * (DM / 64), I3 = (DM / 64) * (DM / 64), I4 = 2 * 2, PER = I1 + 3 * I2 + I3 + 4 * I4;
            for (int it = gw; it < NLAYER * PER; it += NGW) {
                const int l = it / PER; int r = it % PER;
                if (r < I1) { transpose_item(w_in + (size_t)l * DM * NIN, NIN, W1 + (size_t)l * NIN * DM, DM, 0, 0, true, scr, r, lane); continue; } r -= I1;
                if (r < 3 * I2) { const int n = r / I2; transpose_item(w_branch + ((size_t)l * 3 + n) * BWID * DM, DM, W2 + (size_t)l * 3 * DM * BWID, 3 * BWID, n * BWID, 0, false, scr, r % I2, lane); continue; } r -= 3 * I2;
                if (r < I3) { transpose_item(w_out + (size_t)l * DM * DM, DM, W3 + (size_t)l * DM * DM, DM, 0, 0, false, scr, r, lane); continue; } r -= I3;
                { const int g = r / I4; transpose_item(pool_w + ((size_t)l * 4 + g) * 128 * 128, 128, PW + ((size_t)l * 4 + g) * 128 * 128, 128, 0, 0, false, scr, r % I4, lane); }
            }
            for (int m = gw; m < MTOK; m += 2 * NGW) rms_rows_to_bf16<2>(x, pre_g, H, m, NGW, lane);
        } else {
            constexpr int l = (ph - 1) / 5, k = (ph - 1) % 5;
            if constexpr (k == 0) {
                pg8::Gemm g{H, (bf16_t*)(ws + WS_W1) + (size_t)l * NIN * DM, MTOK, NIN, DM, 0}; pg8::StaticOrder S; S.init(MTOK, NIN, G, bx);
                EpiU E{ws};
                pg8::gemm_phase<EpiU, pg8::StaticOrder, true, true>(lds, g, S, E);
            } else if constexpr (k == 1) {
                const float* pool_scale = A->in[4]; const float* conv_w = A->in[5]; const float* conv_b = A->in[6];
                const bf16_t* PW = (const bf16_t*)(ws + WS_PW);
                const bf16_t* Q = U + 2 * (ARRB / 2); const bf16_t* Kk = U + 3 * (ARRB / 2); const bf16_t* V = U + 4 * (ARRB / 2);
                LAS unsigned char* vl = lds + wave * (32 * VROW);
                for (int it = gw; it < NB * 8 * 128; it += NGW) attn_item(it, Q, Kk, V, U + 5 * (ARRB / 2) + 1024, vl, lane);
                for (int it = gw; it < (MTOK / 32) * 4; it += NGW) pool_item(it, U, U + 5 * (ARRB / 2), PW + (size_t)l * 4 * 128 * 128, pool_scale + l * BWID, lane);
                for (int it = gw; it < MTOK / 8; it += NGW) conv_item(it, U + 1 * (ARRB / 2), U + 5 * (ARRB / 2) + 512, conv_w + l * 3 * BWID, conv_b + l * BWID, lane);
            } else if constexpr (k == 2) {
                pg8::Gemm g{U + 5 * (ARRB / 2), (bf16_t*)(ws + WS_W2) + (size_t)l * 3 * DM * BWID, MTOK, DM, 3 * BWID, 0}; pg8::StaticOrder S; S.init(MTOK, DM, G, bx);
                EpiBranch E{ws};
                pg8::gemm_phase<EpiBranch, pg8::StaticOrder, true, true>(lds, g, S, E);
            } else if constexpr (k == 3) {
                pg8::Gemm g{H, (bf16_t*)(ws + WS_W3) + (size_t)l * DM * DM, MTOK, DM, DM, 0}; pg8::StaticOrder S; S.init(MTOK, DM, G, bx);
                EpiOut E{ws};
                pg8::gemm_phase<EpiOut, pg8::StaticOrder, true, true>(lds, g, S, E);
            } else {
                const float* x = A->in[0]; const float* pre_g = A->in[1]; const float* post_g = A->in[9]; float* out = A->out;
                const float* F32T = (const float*)(ws + WS_U); const float* RS = (const float*)(ws + WS_RS);
                const float* xin = (l == 0) ? x : out; const float* gnext = (l + 1 < NLAYER) ? pre_g + (l + 1) * DM : nullptr;
                for (int m = gw; m < MTOK; m += 2 * NGW) norm_rows<2>(F32T, RS, xin, post_g + l * DM, out, gnext, H, m, NGW, lane);
            }
        }
}
__global__ void __launch_bounds__(512, 2) hybrid_fwd(Args a_) {
    extern __shared__ __attribute__((aligned(16))) unsigned char lds_raw[];
    LAS unsigned char* lds = (LAS unsigned char*)lds_raw;
    const Args* ap0 = (const Args*)__builtin_amdgcn_kernarg_segment_ptr();
    cg::grid_group grid = cg::this_grid();
    const int lo = ARGP()->ph_lo, hi = ARGP()->ph_hi;
#define PHASE(k) if (lo <= (k) && (k) < hi) { if ((k) > lo) grid.sync(); run_phase<(k)>(ap0, lds); }
    PHASE(0) PHASE(1) PHASE(2) PHASE(3) PHASE(4) PHASE(5) PHASE(6) PHASE(7) PHASE(8) PHASE(9) PHASE(10)
#undef PHASE
}

extern "C" void kernel_launch(void* const* d_in, const int* in_sizes, int n_in, void* d_out, int out_size, void* d_ws, size_t ws_size, hipStream_t stream) {
    static int grid = 0;
    if (grid == 0) {
        if (n_in != 10 || out_size != MTOK * DM || ws_size < WS_END) { fprintf(stderr, "kernel_launch: unexpected shapes / workspace (n_in %d out %d ws %zu)\n", n_in, out_size, ws_size); grid = -1; return; }
        int dev = 0, cus = 0, per_cu = 0;
        (void)hipGetDevice(&dev); (void)hipDeviceGetAttribute(&cus, hipDeviceAttributeMultiprocessorCount, dev);
        (void)hipFuncSetAttribute((const void*)hybrid_fwd, hipFuncAttributeMaxDynamicSharedMemorySize, LDS_BYTES);
        (void)hipOccupancyMaxActiveBlocksPerMultiprocessor(&per_cu, (const void*)hybrid_fwd, 512, LDS_BYTES);
        (void)hipGetLastError();
        if (per_cu < 1) { fprintf(stderr, "kernel_launch: occupancy query says %d blocks/CU\n", per_cu); per_cu = 1; }
        grid = cus;
    }
    if (grid < 0) return;
    Args a{};
    for (int i = 0; i < 10; ++i) a.in[i] = (const float*)d_in[i];
    a.out = (float*)d_out; a.ws = (unsigned char*)d_ws;
#if ONE_LAUNCH
    a.ph_lo = 0; a.ph_hi = NPHASE;
    void* args[] = {&a};
    hipError_t e = hipLaunchCooperativeKernel((const void*)hybrid_fwd, dim3(grid), dim3(512), args, LDS_BYTES, stream);
    if (e != hipSuccess) fprintf(stderr, "cooperative launch failed: %s (grid %d)\n", hipGetErrorString(e), grid);
#else
    for (int ph = 0; ph < NPHASE; ++ph) { a.ph_lo = ph; a.ph_hi = ph + 1; for (int rep = 0; rep < 1 + ((DUP_MASK >> ph) & 1); ++rep) hipLaunchKernelGGL(hybrid_fwd, dim3(grid), dim3(512), LDS_BYTES, stream, a); }
#endif
}
```

```cpp
#include <hip/hip_runtime.h>
#include <hip/hip_cooperative_groups.h>
#include <cstdio>
#include <cstdint>
namespace cg = cooperative_groups;
#ifndef ONE_LAUNCH
#define ONE_LAUNCH 1
#endif
#ifndef DUP_MASK
#define DUP_MASK 0
#endif
namespace pg8 {
#define PG8_LAS __attribute__((address_space(3)))
typedef unsigned short bf16_t;
typedef short bf16x8 __attribute__((ext_vector_type(8)));
typedef float f32x4 __attribute__((ext_vector_type(4)));
typedef unsigned u32x4 __attribute__((ext_vector_type(4)));
constexpr int BM = 256, BK = 64, HALF = 128, HTB = HALF * BK * 2  , STAGE_BYTES = 8 * HTB, NXCD = 8, WGM = 8;

__host__ __device__ __forceinline__ int lds_byte(int r, int c) { const int st = (r >> 4) * 2 + (c >> 5), rr = r & 15, cc = c & 31, ob = rr * 64 + cc * 2; return st * 1024 + (ob ^ (((ob >> 9) & 1) << 5)); }
__host__ __device__ __forceinline__ void stage_rc(int b, int& R, int& C) { const int st = b / 1024, sb = b % 1024, swz = sb ^ (((sb >> 9) & 1) << 5); R = (st >> 1) * 16 + swz / 64; C = (st & 1) * 32 + (swz % 64) / 2; }
__host__ __device__ __forceinline__ int perm32(int rho) { const int n = rho >> 4, i = rho & 15; return 8 * (i >> 2) + 4 * n + (i & 3); }

struct Unit { int pm, pn, az; };
struct Gemm { const bf16_t* A; const bf16_t* Bt; int M, N, K; size_t azs; };

struct StaticOrder {
    int nM, nN, nwg, G, c;
    __host__ __device__ void init(int M, int N, int G_, int c_) { nM = M / BM; nN = N / BM; nwg = nM * nN; G = G_; c = c_; }
    __host__ __device__ bool next(int i, Unit& u) const {
        const long L = (long)i * G + c; if (L >= nwg) return false;
        int wgid = (int)L; { const int q = nwg / NXCD, r = nwg % NXCD, xcd = wgid % NXCD, off = wgid / NXCD; wgid = (xcd < r ? xcd * (q + 1) : r * (q + 1) + (xcd - r) * q) + off; }
        const int nig = WGM * nN, gid = wgid / nig, fm = gid * WGM, gsz = (nM - fm) < WGM ? (nM - fm) : WGM;
        u.pm = fm + ((wgid % nig) % gsz); u.pn = (wgid % nig) / gsz; u.az = 0; return true;
    }
    __device__ __forceinline__ void a_ready(const Unit&) const {}
    __device__ __forceinline__ void done(const Unit&) const {}
};

__device__ __forceinline__ unsigned cvt_pk_bf16(float lo, float hi) { unsigned r; asm volatile("v_cvt_pk_bf16_f32 %0, %1, %2" : "=v"(r) : "v"(lo), "v"(hi)); return r; }
template <class Epi, class Sched, bool ALIGN_EPI = false, bool SP2 = false>
__device__ __forceinline__ void gemm_phase(PG8_LAS unsigned char* lds, const Gemm g, const Sched& S, const Epi& E) {
    const int tid = threadIdx.x, wid = __builtin_amdgcn_readfirstlane(tid >> 6), lane = tid & 63, wr = wid >> 2, wc = wid & 3, fr = lane & 15, fq = lane >> 4;
    const int K = g.K, nt = K / BK;
    unsigned voffA[2], voffB[2];
#pragma unroll
    for (int i = 0; i < 2; ++i) { int R, C; stage_rc(tid * 16 + i * 8192, R, C); const int Rb = Epi::PERM ? ((R & ~31) + perm32(R & 31)) : R;
        voffA[i] = (unsigned)(R * K + C) * 2u; voffB[i] = (unsigned)(Rb * K + C) * 2u; }
    const size_t kstep = (size_t)(BK * 2);
    const size_t hstep = (size_t)HALF * K * 2;
    const size_t tstep = 2 * hstep;
    const unsigned ldsw = (unsigned)wid * 1024u;
    const int aoff = lds_byte(wr * 64 + fr, fq * 8), boff = lds_byte(wc * 32 + fr, fq * 8);
#define PG8_SA(b, h) (((b) * 2 + (h)) * HTB)
#define PG8_SB(b, h) ((4 + (b) * 2 + (h)) * HTB)
#define PG8_STAGE(bufoff, gbase, voff) do { _Pragma("unroll") for (int _i = 0; _i < 2; ++_i) \
        __builtin_amdgcn_global_load_lds((const unsigned*)((const char*)(gbase) + (voff)[_i]), (PG8_LAS unsigned*)(lds + (bufoff) + ldsw + _i * 8192), 16, 0, 0); } while (0)
#define PG8_LDA(dst, b, h) do { _Pragma("unroll") for (int m = 0; m < 4; ++m) _Pragma("unroll") for (int k = 0; k < 2; ++k) dst[m][k] = *(const PG8_LAS bf16x8*)(lds + PG8_SA(b, h) + aoff + m * 2048 + k * 1024); } while (0)
#define PG8_LDB(dst, b, h) do { _Pragma("unroll") for (int n = 0; n < 2; ++n) _Pragma("unroll") for (int k = 0; k < 2; ++k) dst[n][k] = *(const PG8_LAS bf16x8*)(lds + PG8_SB(b, h) + boff + n * 2048 + k * 1024); } while (0)
#define PG8_MMA(ai, bj, At, Bt) do { __builtin_amdgcn_s_setprio(1); _Pragma("unroll") for (int m = 0; m < 4; ++m) _Pragma("unroll") for (int n = 0; n < 2; ++n) _Pragma("unroll") for (int k = 0; k < 2; ++k) \
        acc[ai][bj][m][n] = __builtin_amdgcn_mfma_f32_16x16x32_bf16(Bt[n][k], At[m][k], acc[ai][bj][m][n], 0, 0, 0); __builtin_amdgcn_s_setprio(0); } while (0)
#define PG8_WAIT_V(n) asm volatile("s_waitcnt vmcnt(" #n ")" ::: "memory")
#define PG8_WAIT_L(n) asm volatile("s_waitcnt lgkmcnt(" #n ")" ::: "memory")
#define PG8_BAR __builtin_amdgcn_s_barrier()
#define PG8_SCHED __builtin_amdgcn_sched_barrier(0)
    Unit cur, nxt; int ui = 0;
    if (!S.next(0, cur)) return;
    f32x4 acc[2][2][4][2];
#pragma unroll
    for (int a = 0; a < 2; ++a)
#pragma unroll
        for (int b = 0; b < 2; ++b)
#pragma unroll
            for (int m = 0; m < 4; ++m)
#pragma unroll
                for (int n = 0; n < 2; ++n) acc[a][b][m][n] = (f32x4){0.f, 0.f, 0.f, 0.f};
    bf16x8 At[4][2], B0[2][2], B1[2][2];
    const char* cA = (const char*)g.A + (size_t)cur.pm * tstep + (size_t)cur.az * g.azs; const char* cB = (const char*)g.Bt + (size_t)cur.pn * tstep;
    S.a_ready(cur);
    if constexpr (SP2) {
        PG8_STAGE(PG8_SB(0, 0), cB, voffB); PG8_STAGE(PG8_SB(0, 1), cB + hstep, voffB); PG8_STAGE(PG8_SA(0, 0), cA, voffA); PG8_STAGE(PG8_SA(0, 1), cA + hstep, voffA);
        if (wr == 1) PG8_BAR;
        PG8_WAIT_V(2); PG8_BAR;
        PG8_STAGE(PG8_SB(1, 0), cB + kstep, voffB); PG8_STAGE(PG8_SA(1, 0), cA + kstep, voffA); PG8_STAGE(PG8_SB(1, 1), cB + hstep + kstep, voffB);
        PG8_WAIT_V(6); PG8_BAR;
    } else {
        PG8_STAGE(PG8_SB(0, 0), cB, voffB); PG8_STAGE(PG8_SA(0, 0), cA, voffA); PG8_STAGE(PG8_SB(0, 1), cB + hstep, voffB); PG8_STAGE(PG8_SA(0, 1), cA + hstep, voffA);
        if (wr == 1) PG8_BAR;
        PG8_WAIT_V(4); PG8_BAR;
        PG8_STAGE(PG8_SB(1, 0), cB + kstep, voffB); PG8_STAGE(PG8_SA(1, 0), cA + kstep, voffA); PG8_STAGE(PG8_SB(1, 1), cB + hstep + kstep, voffB);
        PG8_WAIT_V(6); PG8_BAR;
    }
    for (;;) {
        const bool has_next = S.next(ui + 1, nxt);
        const char* nA = has_next ? (const char*)g.A + (size_t)nxt.pm * tstep + (size_t)nxt.az * g.azs : cA; const char* nB = has_next ? (const char*)g.Bt + (size_t)nxt.pn * tstep : cB;
        for (int t = 0; t < nt; t += 2) {
            if constexpr (Epi::MIDK) { if (t == 8 || t == 16) E.mid(acc, cur, t >> 3, wr, wc, fr, fq); }
            const bool last = (t == nt - 2);
            const char* a1 = cA + (size_t)(t + 1) * kstep;
            const char* a2 = last ? nA : cA + (size_t)(t + 2) * kstep; const char* b2 = last ? nB : cB + (size_t)(t + 2) * kstep;
            const char* a3 = a2 + kstep; const char* b3 = b2 + kstep;
            if (last && has_next) S.a_ready(nxt);
            if constexpr (SP2) {
            PG8_LDB(B0, 0, 0); PG8_LDB(B1, 0, 1); PG8_SCHED; PG8_LDA(At, 0, 0); PG8_STAGE(PG8_SA(1, 1), a1 + hstep, voffA);
            PG8_WAIT_V(8); PG8_WAIT_L(0); PG8_BAR; PG8_MMA(0, 0, At, B0); PG8_MMA(0, 1, At, B1); PG8_BAR; PG8_SCHED;
            PG8_LDA(At, 0, 1); PG8_STAGE(PG8_SB(0, 0), b2, voffB); PG8_STAGE(PG8_SB(0, 1), b2 + hstep, voffB); PG8_STAGE(PG8_SA(0, 0), a2, voffA);
            PG8_WAIT_V(8); PG8_WAIT_L(0); PG8_BAR; PG8_MMA(1, 0, At, B0); PG8_MMA(1, 1, At, B1); PG8_BAR; PG8_SCHED;
            PG8_LDB(B0, 1, 0); PG8_LDB(B1, 1, 1); PG8_SCHED; PG8_LDA(At, 1, 0); PG8_STAGE(PG8_SA(0, 1), a2 + hstep, voffA);
            PG8_WAIT_V(8); PG8_WAIT_L(0); PG8_BAR; PG8_MMA(0, 0, At, B0); PG8_MMA(0, 1, At, B1); PG8_BAR; PG8_SCHED;
            PG8_LDA(At, 1, 1); PG8_STAGE(PG8_SB(1, 0), b3, voffB); PG8_STAGE(PG8_SB(1, 1), b3 + hstep, voffB); PG8_STAGE(PG8_SA(1, 0), a3, voffA);
            PG8_WAIT_V(8); PG8_WAIT_L(0); PG8_BAR; PG8_MMA(1, 0, At, B0); PG8_MMA(1, 1, At, B1); PG8_BAR; PG8_SCHED;
            } else {
            PG8_LDB(B0, 0, 0); PG8_SCHED; PG8_LDA(At, 0, 0); PG8_STAGE(PG8_SA(1, 1), a1 + hstep, voffA);
            PG8_WAIT_L(8); PG8_BAR; PG8_WAIT_L(0); PG8_MMA(0, 0, At, B0); PG8_BAR; PG8_SCHED;
            PG8_LDB(B1, 0, 1); PG8_STAGE(PG8_SB(0, 0), b2, voffB);
            PG8_BAR; PG8_WAIT_L(0); PG8_MMA(0, 1, At, B1); PG8_BAR;
            PG8_LDA(At, 0, 1); PG8_STAGE(PG8_SA(0, 0), a2, voffA);
            PG8_BAR; PG8_WAIT_L(0); PG8_MMA(1, 0, At, B0); PG8_BAR; PG8_SCHED;
            PG8_STAGE(PG8_SB(0, 1), b2 + hstep, voffB);
            PG8_WAIT_V(6); PG8_BAR; PG8_MMA(1, 1, At, B1); PG8_BAR;
            PG8_LDB(B0, 1, 0); PG8_SCHED; PG8_LDA(At, 1, 0); PG8_STAGE(PG8_SA(0, 1), a2 + hstep, voffA);
            PG8_WAIT_L(8); PG8_BAR; PG8_WAIT_L(0); PG8_MMA(0, 0, At, B0); PG8_BAR; PG8_SCHED;
            PG8_LDB(B1, 1, 1); PG8_STAGE(PG8_SB(1, 0), b3, voffB);
            PG8_BAR; PG8_WAIT_L(0); PG8_MMA(0, 1, At, B1); PG8_BAR;
            PG8_LDA(At, 1, 1); PG8_STAGE(PG8_SA(1, 0), a3, voffA);
            PG8_BAR; PG8_WAIT_L(0); PG8_MMA(1, 0, At, B0); PG8_BAR; PG8_SCHED;
            PG8_STAGE(PG8_SB(1, 1), b3 + hstep, voffB);
            PG8_WAIT_V(6); PG8_BAR; PG8_MMA(1, 1, At, B1); PG8_BAR;
            }
        }
        if constexpr (ALIGN_EPI) { if (wr == 0) PG8_BAR; }
        if constexpr (!Epi::AFTER_DRAIN) { E(acc, cur, wr, wc, fr, fq); S.done(cur); }
        if (!has_next) break;
#pragma unroll
        for (int a = 0; a < 2; ++a)
#pragma unroll
            for (int b = 0; b < 2; ++b)
#pragma unroll
                for (int m = 0; m < 4; ++m)
#pragma unroll
                    for (int n = 0; n < 2; ++n) acc[a][b][m][n] = (f32x4){0.f, 0.f, 0.f, 0.f};
        cur = nxt; cA = nA; cB = nB; ++ui;
        if constexpr (ALIGN_EPI) { if (wr == 1) PG8_BAR; }
    }
    PG8_WAIT_V(0);
    if constexpr (!ALIGN_EPI) { if (wr == 0) PG8_BAR; }
    PG8_BAR;
    if constexpr (Epi::AFTER_DRAIN) { E.fused(acc, cur, wr, wc, fr, fq, lds, wid, lane); S.done(cur); }
#undef PG8_SA
#undef PG8_SB
#undef PG8_STAGE
#undef PG8_LDA
#undef PG8_LDB
#undef PG8_MMA
#undef PG8_WAIT_V
#undef PG8_WAIT_L
#undef PG8_BAR
#undef PG8_SCHED
}
}

#define LAS __attribute__((address_space(3)))
typedef unsigned short bf16_t;
typedef short bf16x8 __attribute__((ext_vector_type(8)));
typedef short s16x4 __attribute__((ext_vector_type(4)));
typedef float f32x4 __attribute__((ext_vector_type(4)));
typedef float f32x16 __attribute__((ext_vector_type(16)));
typedef unsigned u32x4 __attribute__((ext_vector_type(4)));
typedef unsigned u32x2 __attribute__((ext_vector_type(2)));
constexpr int NB = 4, SEQ = 4096, DM = 1024, MTOK = NB * SEQ, NIN = 8192, BWID = 512, NLAYER = 2;
constexpr float RMS_EPS = 1e-6f;
constexpr size_t MiB = 1u << 20;
constexpr size_t WS_RS = 0;
constexpr size_t WS_W1 = 2 * MiB;
constexpr size_t WS_W2 = 34 * MiB;
constexpr size_t WS_W3 = 40 * MiB;
constexpr size_t WS_PW = 44 * MiB;
constexpr size_t WS_H = 45 * MiB;
constexpr size_t WS_U = 77 * MiB;
constexpr size_t ARRB = 16 * MiB;
constexpr size_t WS_MG = 205 * MiB;
constexpr size_t WS_END = 253 * MiB;
constexpr int LDS_BYTES = 147456;
constexpr int NPHASE = 1 + 5 * NLAYER;

__device__ __forceinline__ unsigned f2bf(float f) { unsigned u = __builtin_bit_cast(unsigned, f); return (u + 0x7fffu + ((u >> 16) & 1u)) >> 16; }
__device__ __forceinline__ unsigned pk2(float lo, float hi) { return f2bf(lo) | (f2bf(hi) << 16); }
__device__ __forceinline__ float bflo(unsigned u) { return __builtin_bit_cast(float, u << 16); }
__device__ __forceinline__ float bfhi(unsigned u) { return __builtin_bit_cast(float, u & 0xffff0000u); }
__device__ __forceinline__ float sigmoid_f(float x) { return __builtin_amdgcn_rcpf(1.f + __builtin_amdgcn_exp2f(-1.4426950408889634f * x)); }
__device__ __forceinline__ float silu_f(float x) { return x * sigmoid_f(x); }
__device__ __forceinline__ unsigned q8(float x) { const unsigned q = (unsigned)(sigmoid_f(x) * 255.f + 0.5f); return q < 1u ? 1u : q; }
__device__ __forceinline__ float wave_sum(float v) {
#pragma unroll
    for (int o = 1; o < 64; o <<= 1) v += __shfl_xor(v, o);
    return v;
}

constexpr size_t WS_CTL = 1 * MiB; constexpr size_t CTL_BYTES = 16384;
#define XB_TMO      128
#define XB_XCNT(j)  (256  + 64 * (j))
#define XB_XSUB(j)  (1280 + 64 * (j))
#define XB_XGEN(j)  (2304 + 64 * (j))
#define XB_TOP      3328
#define XB_TOPGEN   3392
#define XCD_BAR_WORDS 3456
#define XB_SPIN_CAP (1u << 18)

__device__ __forceinline__ unsigned xb_ld(unsigned* p)              { return __hip_atomic_load(p, __ATOMIC_RELAXED, __HIP_MEMORY_SCOPE_AGENT); }
__device__ __forceinline__ unsigned xb_add(unsigned* p, unsigned v) { return __hip_atomic_fetch_add(p, v, __ATOMIC_RELAXED, __HIP_MEMORY_SCOPE_AGENT); }
__device__ __forceinline__ unsigned xb_xcc_id() { return (unsigned)__builtin_amdgcn_s_getreg((3 << 11) | 20) & 0xFu; }
#define XB_SPIN(cond, bar) do { unsigned _sp = 0; while (cond) { __builtin_amdgcn_s_sleep(1); \
    if ((++_sp & 255u) == 0u) { if (xb_ld(&(bar)[XB_TMO])) break; if (_sp > XB_SPIN_CAP) { atomicAdd(&(bar)[XB_TMO], 1u); break; } } } } while (0)

struct XcdBarrier {
    unsigned* bar; unsigned x;
    volatile LAS unsigned* st;
};

__device__ __forceinline__ XcdBarrier xcd_barrier_post(unsigned* bar, volatile LAS unsigned* st) {
    XcdBarrier b; b.bar = bar; b.x = xb_xcc_id(); b.st = st;
    if (threadIdx.x == 0) (void)xb_add(&bar[XB_XCNT(b.x)], 1u);
    return b;
}
__device__ __forceinline__ void xcd_barrier_complete(unsigned* bar, unsigned x, unsigned& nloc, unsigned& nx) {
    const unsigned G = gridDim.x * gridDim.y * gridDim.z;
    unsigned sum, cnt, mine, sp = 0u;
    for (;;) {
        sum = 0u; cnt = 0u; mine = 0u;
#pragma unroll
        for (unsigned j = 0; j < 16; ++j) { const unsigned c = xb_ld(&bar[XB_XCNT(j)]); sum += c; cnt += (c > 0u) ? 1u : 0u; mine = (j == x) ? c : mine; }
        if (sum == G) break;
        __builtin_amdgcn_s_sleep(1);
        if ((++sp & 255u) == 0u) { if (xb_ld(&bar[XB_TMO])) break; if (sp > XB_SPIN_CAP) { atomicAdd(&bar[XB_TMO], 1u); break; } }
    }
    nloc = mine > 0u ? mine : 1u; nx = cnt > 0u ? cnt : 1u;
}

__device__ __forceinline__ void xcd_barrier(const XcdBarrier& b) {
    asm volatile("s_waitcnt vmcnt(0)" ::: "memory");
    __syncthreads();
    if (threadIdx.x == 0) {
        unsigned* bar = b.bar;
        __builtin_amdgcn_s_waitcnt(0);
        unsigned nloc = b.st[0], nx = b.st[1];
        if (nloc == 0u) { xcd_barrier_complete(bar, b.x, nloc, nx); b.st[0] = nloc; b.st[1] = nx; }
        const unsigned old = xb_add(&bar[XB_XSUB(b.x)], 1u);
        const unsigned gen = old / nloc;
        if (old + 1u == (gen + 1u) * nloc) {
            __builtin_amdgcn_fence(__ATOMIC_RELEASE, "agent");
            asm volatile("s_waitcnt vmcnt(0)" ::: "memory");
            const unsigned og = xb_add(&bar[XB_TOP], 1u);
            const unsigned tg = og / nx;
            if (og + 1u == (tg + 1u) * nx) xb_add(&bar[XB_TOPGEN], 1u);
            else XB_SPIN(xb_ld(&bar[XB_TOPGEN]) == tg, bar);
            __builtin_amdgcn_fence(__ATOMIC_ACQUIRE, "agent");
            xb_add(&bar[XB_XGEN(b.x)], 1u);
            asm volatile("s_waitcnt vmcnt(0)" ::: "memory");
        } else {
            XB_SPIN(xb_ld(&bar[XB_XGEN(b.x)]) == gen, bar);
            __builtin_amdgcn_fence(__ATOMIC_ACQUIRE, "agent");
            asm volatile("s_waitcnt vmcnt(0)" ::: "memory");
        }
    }
    __syncthreads();
}


using pg8::Unit;
struct EpiU {
    static constexpr bool PERM = true, AFTER_DRAIN = false, MIDK = false;
    unsigned char* ws;
    __device__ __forceinline__ void operator()(const f32x4 (&acc)[2][2][4][2], const Unit& u, int wr, int wc, int fr, int fq) const {
        bf16_t* U = (bf16_t*)(ws + WS_U); unsigned char* MG = ws + WS_MG;
        const int pn = u.pn; const int row0 = u.pm * 256 + wr * 64 + fr;
        if (pn >= 20) {
            const int mc0 = (pn - 20) * 256 + wc * 32 + 8 * fq;
#pragma unroll
            for (int ai = 0; ai < 2; ++ai)
#pragma unroll
                for (int m = 0; m < 4; ++m) { unsigned char* rp = MG + (size_t)(row0 + ai * 128 + m * 16) * 3072 + mc0;
#pragma unroll
                    for (int bj = 0; bj < 2; ++bj) { const f32x4 v0 = acc[ai][bj][m][0], v1 = acc[ai][bj][m][1]; u32x2 w;
                        w.x = q8(v0[0]) | (q8(v0[1]) << 8) | (q8(v0[2]) << 16) | (q8(v0[3]) << 24); w.y = q8(v1[0]) | (q8(v1[1]) << 8) | (q8(v1[2]) << 16) | (q8(v1[3]) << 24);
                        *(u32x2*)(rp + bj * 128) = w; } }
        } else if (pn >= 4 && pn < 12) {
            const int ch0 = (pn - 4) * 64 + (4 * wc + fq) * 4;
            bf16_t* Z = U + 1 * (ARRB / 2); bf16_t* W = U + 5 * (ARRB / 2) + 512;
#pragma unroll
            for (int ai = 0; ai < 2; ++ai)
#pragma unroll
                for (int m = 0; m < 4; ++m) { const size_t rr = (size_t)(row0 + ai * 128 + m * 16); const size_t ro = rr * 512 + ch0, rw = rr * 1536 + ch0;
                    const f32x4 z = acc[ai][0][m][0] * acc[ai][0][m][1]; const f32x4 gb = acc[ai][1][m][0], gg = acc[ai][1][m][1];
                    u32x2 zz, ww; zz.x = pg8::cvt_pk_bf16(z[0], z[1]); zz.y = pg8::cvt_pk_bf16(z[2], z[3]);
                    ww.x = pg8::cvt_pk_bf16(gb[0] * silu_f(gg[0]), gb[1] * silu_f(gg[1])); ww.y = pg8::cvt_pk_bf16(gb[2] * silu_f(gg[2]), gb[3] * silu_f(gg[3]));
                    *(u32x2*)(Z + ro) = zz; *(u32x2*)(W + rw) = ww; }
        } else {
            const int kind = pn >> 1; int arr = 0, pitch = 512, coff = 0; bool act = false;
            if (kind == 1) { arr = 5; act = true; pitch = 1536; } else if (kind == 6) arr = 2; else if (kind == 7) arr = 3; else if (kind == 8) arr = 4; else if (kind == 9) { arr = 5; act = true; pitch = 1536; coff = 1024; }
            bf16_t* O = U + (size_t)arr * (ARRB / 2) + coff; const int col0 = (pn & 1) * 256 + wc * 32 + 8 * fq;
#pragma unroll
            for (int ai = 0; ai < 2; ++ai)
#pragma unroll
                for (int m = 0; m < 4; ++m) { bf16_t* rp = O + (size_t)(row0 + ai * 128 + m * 16) * pitch + col0;
#pragma unroll
                    for (int bj = 0; bj < 2; ++bj) { f32x4 v0 = acc[ai][bj][m][0], v1 = acc[ai][bj][m][1];
                        if (act) {
#pragma unroll
                            for (int i = 0; i < 4; ++i) { v0[i] = silu_f(v0[i]); v1[i] = silu_f(v1[i]); } }
                        u32x4 w; w.x = pg8::cvt_pk_bf16(v0[0], v0[1]); w.y = pg8::cvt_pk_bf16(v0[2], v0[3]); w.z = pg8::cvt_pk_bf16(v1[0], v1[1]); w.w = pg8::cvt_pk_bf16(v1[2], v1[3]);
                        *(u32x4*)(rp + bj * 128) = w; } }
        }
    }
};
struct EpiBranch {
    static constexpr bool PERM = true, AFTER_DRAIN = false, MIDK = true;
    unsigned char* ws;
    __device__ __forceinline__ void mid(f32x4 (&acc)[2][2][4][2], const Unit& u, int seg, int wr, int wc, int fr, int fq) const {
        int tid_ = threadIdx.x; asm volatile("" : "+v"(tid_));
        const int wid_ = tid_ >> 6, wr_ = wid_ >> 2, wc_ = wid_ & 3, fr_ = tid_ & 15, fq_ = (tid_ & 63) >> 4;
        const unsigned char* MG = ws + WS_MG + (seg - 1) * 1024; const int row0 = u.pm * 256 + wr_ * 64 + fr_, col0 = u.pn * 256 + wc_ * 32 + 8 * fq_;
#pragma unroll
        for (int ai = 0; ai < 2; ++ai)
#pragma unroll
            for (int m = 0; m < 4; ++m) { const unsigned char* rp = MG + (size_t)(row0 + ai * 128 + m * 16) * 3072 + col0;
#pragma unroll
                for (int bj = 0; bj < 2; ++bj) { const u32x2 qa = *(const u32x2*)(rp + bj * 128), qb = *(const u32x2*)(rp + bj * 128 + 1024);
                    f32x4 r0, r1;
                    r0[0] = (float)(qa.x & 255u) * __builtin_amdgcn_rcpf((float)(qb.x & 255u)); r0[1] = (float)((qa.x >> 8) & 255u) * __builtin_amdgcn_rcpf((float)((qb.x >> 8) & 255u));
                    r0[2] = (float)((qa.x >> 16) & 255u) * __builtin_amdgcn_rcpf((float)((qb.x >> 16) & 255u)); r0[3] = (float)(qa.x >> 24) * __builtin_amdgcn_rcpf((float)(qb.x >> 24));
                    r1[0] = (float)(qa.y & 255u) * __builtin_amdgcn_rcpf((float)(qb.y & 255u)); r1[1] = (float)((qa.y >> 8) & 255u) * __builtin_amdgcn_rcpf((float)((qb.y >> 8) & 255u));
                    r1[2] = (float)((qa.y >> 16) & 255u) * __builtin_amdgcn_rcpf((float)((qb.y >> 16) & 255u)); r1[3] = (float)(qa.y >> 24) * __builtin_amdgcn_rcpf((float)(qb.y >> 24));
                    acc[ai][bj][m][0] *= r0; acc[ai][bj][m][1] *= r1; }
                if (m == 3) asm volatile("" ::: "memory"); }
    }
    __device__ __forceinline__ void operator()(const f32x4 (&acc)[2][2][4][2], const Unit& u, int wr, int wc, int fr, int fq) const {
        const unsigned char* MG = ws + WS_MG + 2 * 1024; bf16_t* merged = (bf16_t*)(ws + WS_H);
        const int row0 = u.pm * 256 + wr * 64 + fr, col0 = u.pn * 256 + wc * 32 + 8 * fq;
#pragma unroll
        for (int ai = 0; ai < 2; ++ai)
#pragma unroll
            for (int m = 0; m < 4; ++m) { const size_t row = (size_t)(row0 + ai * 128 + m * 16);
#pragma unroll
                for (int bj = 0; bj < 2; ++bj) { const int col = col0 + bj * 128;
                    const u32x2 gq = *(const u32x2*)(MG + row * 3072 + col);
                    f32x4 g0, g1; const float k = 1.f / 255.f;
                    g0[0] = (float)(gq.x & 255u) * k; g0[1] = (float)((gq.x >> 8) & 255u) * k; g0[2] = (float)((gq.x >> 16) & 255u) * k; g0[3] = (float)(gq.x >> 24) * k;
                    g1[0] = (float)(gq.y & 255u) * k; g1[1] = (float)((gq.y >> 8) & 255u) * k; g1[2] = (float)((gq.y >> 16) & 255u) * k; g1[3] = (float)(gq.y >> 24) * k;
                    const f32x4 v0 = acc[ai][bj][m][0] * g0, v1 = acc[ai][bj][m][1] * g1;
                    u32x4 w; w.x = pg8::cvt_pk_bf16(v0[0], v0[1]); w.y = pg8::cvt_pk_bf16(v0[2], v0[3]); w.z = pg8::cvt_pk_bf16(v1[0], v1[1]); w.w = pg8::cvt_pk_bf16(v1[2], v1[3]);
                    *(u32x4*)(merged + row * 1024 + col) = w; } }
    }
};
struct EpiOut {
    static constexpr bool PERM = false, AFTER_DRAIN = false, MIDK = false;
    unsigned char* ws;
    __device__ __forceinline__ void operator()(const f32x4 (&acc)[2][2][4][2], const Unit& u, int wr, int wc, int fr, int fq) const {
        float* out = (float*)(ws + WS_U); float* rs = (float*)(ws + WS_RS);
        const int row0 = u.pm * 256 + wr * 64 + fr, col0 = u.pn * 256 + wc * 32 + 4 * fq;
#pragma unroll
        for (int ai = 0; ai < 2; ++ai)
#pragma unroll
            for (int m = 0; m < 4; ++m) { const size_t row = (size_t)(row0 + ai * 128 + m * 16); float ss = 0.f;
#pragma unroll
                for (int bj = 0; bj < 2; ++bj)
#pragma unroll
                    for (int n = 0; n < 2; ++n) { const f32x4 v = acc[ai][bj][m][n]; *(f32x4*)(out + row * 1024 + col0 + bj * 128 + n * 16) = v; ss += (v[0] * v[0] + v[1] * v[1]) + (v[2] * v[2] + v[3] * v[3]); }
                ss += __shfl_xor(ss, 16); ss += __shfl_xor(ss, 32);
                if (fq == 0) rs[row * 16 + u.pn * 4 + wc] = ss; }
    }
};
__device__ __forceinline__ int win_row(int c) {
    if (c < 1024 || c >= 3072) return c;
    const int q = (c - 1024) >> 9, ch = (c - 1024) & 511, ct = ch >> 6, grp = (ch & 63) >> 2, e = ch & 3;
    return 1024 + ct * 256 + (q & 1) * 128 + grp * 8 + (q >> 1) * 4 + e;
}
__device__ __forceinline__ void transpose_item(const float* W, int N, bf16_t* WT, int ldt, int koff, int row_off, bool winmap, LAS float* scr, int item, int lane) {
    const int nblk = N / 64, kb = item / nblk, nb = item % nblk, k0 = 64 * kb, n0 = 64 * nb;
    const int kq = lane >> 4, nq = lane & 15;
    f32x4 v[16];
#pragma unroll
    for (int i = 0; i < 16; ++i) v[i] = *(const f32x4*)(W + (size_t)(k0 + 4 * i + kq) * N + n0 + 4 * nq);
#pragma unroll
    for (int i = 0; i < 16; ++i) { LAS float* s = scr + (4 * i + kq) * 65 + 4 * nq; s[0] = v[i][0]; s[1] = v[i][1]; s[2] = v[i][2]; s[3] = v[i][3]; }
    asm volatile("s_waitcnt lgkmcnt(0)" ::: "memory");
    const int c = lane & 7;
#pragma unroll
    for (int j = 0; j < 8; ++j) { const int n = (lane >> 3) + 8 * j; const LAS float* s = scr + (8 * c) * 65 + n;
        u32x4 o; o.x = pk2(s[0 * 65], s[1 * 65]); o.y = pk2(s[2 * 65], s[3 * 65]); o.z = pk2(s[4 * 65], s[5 * 65]); o.w = pk2(s[6 * 65], s[7 * 65]);
        int dst = n0 + n; if (winmap) dst = win_row(dst);
        *(u32x4*)(WT + (size_t)(row_off + dst) * ldt + koff + k0 + 8 * c) = o; }
    asm volatile("s_waitcnt lgkmcnt(0)" ::: "memory");
}
template <int R> __device__ __forceinline__ void rms_rows_to_bf16(const float* x, const float* g, bf16_t* H, int m0, int mstride, int lane) {
    f32x4 v[R][4];
#pragma unroll
    for (int r = 0; r < R; ++r)
#pragma unroll
        for (int j = 0; j < 4; ++j) v[r][j] = ((const f32x4*)(x + (size_t)(m0 + r * mstride) * DM))[64 * j + lane];
    f32x4 gg[4];
#pragma unroll
    for (int j = 0; j < 4; ++j) gg[j] = ((const f32x4*)g)[64 * j + lane];
#pragma unroll
    for (int r = 0; r < R; ++r) { float s = 0.f;
#pragma unroll
        for (int j = 0; j < 4; ++j) s += (v[r][j][0] * v[r][j][0] + v[r][j][1] * v[r][j][1]) + (v[r][j][2] * v[r][j][2] + v[r][j][3] * v[r][j][3]);
        const float rstd = 1.f / sqrtf(wave_sum(s) * (1.f / DM) + RMS_EPS);
        u32x2* o8 = (u32x2*)(H + (size_t)(m0 + r * mstride) * DM) + lane;
#pragma unroll
        for (int j = 0; j < 4; ++j) { u32x2 w; w.x = pk2(v[r][j][0] * rstd * gg[j][0], v[r][j][1] * rstd * gg[j][1]); w.y = pk2(v[r][j][2] * rstd * gg[j][2], v[r][j][3] * rstd * gg[j][3]); o8[64 * j] = w; } }
}

__device__ __forceinline__ int crow(int r, int hi) { return (r & 3) + 8 * (r >> 2) + 4 * hi; }
constexpr int VROW = 144;
__device__ __forceinline__ void attn_item(int item, const bf16_t* Q, const bf16_t* K, const bf16_t* V, bf16_t* SG, LAS unsigned char* vl, int lane) {
    const int qg = item & 127, h = (item >> 7) & 7, b = item >> 10;
    const int r32 = lane & 31, hi = lane >> 5, t0 = qg * 32;
    const size_t tokq = (size_t)b * SEQ + t0 + r32;
    bf16x8 qf[4];
#pragma unroll
    for (int d0 = 0; d0 < 4; ++d0) qf[d0] = *(const bf16x8*)(Q + tokq * 512 + h * 64 + d0 * 16 + 8 * hi);
    f32x16 o0, o1;
#pragma unroll
    for (int r = 0; r < 16; ++r) { o0[r] = 0.f; o1[r] = 0.f; }
    float P = 1.f;
    const int i16 = lane & 15, G4 = lane >> 4;
    const int vb = (4 * (G4 >> 1) + (i16 >> 2)) * VROW + (16 * (G4 & 1) + 4 * (i16 & 3)) * 2;
    for (int s0 = t0; s0 >= 0; s0 -= 32) {
        const size_t tokk = (size_t)b * SEQ + s0;
        bf16x8 kf[4];
#pragma unroll
        for (int d0 = 0; d0 < 4; ++d0) kf[d0] = *(const bf16x8*)(K + (tokk + r32) * 512 + h * 64 + d0 * 16 + 8 * hi);
#pragma unroll
        for (int p = 0; p < 4; ++p) { const int idx = p * 64 + lane, key = idx >> 3, ch = idx & 7;
            const u32x4 v = *(const u32x4*)(V + (tokk + key) * 512 + h * 64 + ch * 8);
            *(LAS u32x4*)(vl + key * VROW + ch * 16) = v; }
        f32x16 s;
#pragma unroll
        for (int r = 0; r < 16; ++r) s[r] = 0.f;
#pragma unroll
        for (int d0 = 0; d0 < 4; ++d0) s = __builtin_amdgcn_mfma_f32_32x32x16_bf16(kf[d0], qf[d0], s, 0, 0, 0);
        const bool diag = (s0 == t0);
        float kp[16];
#pragma unroll
        for (int r = 0; r < 16; ++r) { const float e = __builtin_amdgcn_exp2f(s[r] * (0.125f * 1.4426950408889634f)); float k = __builtin_amdgcn_rcpf(1.f + e);
            if (diag && crow(r, hi) >= r32) k = 1.f; kp[r] = k; }
        float Gm[4], Go[4], T[4], R[4], C[4];
#pragma unroll
        for (int g = 0; g < 4; ++g) { Gm[g] = (kp[4 * g] * kp[4 * g + 1]) * (kp[4 * g + 2] * kp[4 * g + 3]); Go[g] = __shfl_xor(Gm[g], 32); T[g] = Gm[g] * Go[g]; }
        R[3] = P; R[2] = R[3] * T[3]; R[1] = R[2] * T[2]; R[0] = R[1] * T[1]; const float Cout = R[0] * T[0];
#pragma unroll
        for (int g = 0; g < 4; ++g) C[g] = hi ? R[g] : R[g] * Go[g];
        float w[16];
#pragma unroll
        for (int g = 0; g < 4; ++g) { const float p3 = C[g], p2 = p3 * kp[4 * g + 3], p1 = p2 * kp[4 * g + 2], p0 = p1 * kp[4 * g + 1], pe = p0 * kp[4 * g];
            w[4 * g + 3] = p3 - p2; w[4 * g + 2] = p2 - p1; w[4 * g + 1] = p1 - p0; w[4 * g] = p0 - pe; }
        bf16x8 wf[2];
#pragma unroll
        for (int st = 0; st < 2; ++st) { u32x4 t; t.x = pk2(w[8 * st], w[8 * st + 1]); t.y = pk2(w[8 * st + 2], w[8 * st + 3]); t.z = pk2(w[8 * st + 4], w[8 * st + 5]); t.w = pk2(w[8 * st + 6], w[8 * st + 7]); wf[st] = __builtin_bit_cast(bf16x8, t); }
#pragma unroll
        for (int dt = 0; dt < 2; ++dt)
#pragma unroll
            for (int st = 0; st < 2; ++st) {
                const s16x4 lo = __builtin_amdgcn_ds_read_tr16_b64_v4i16((LAS s16x4*)(vl + vb + (16 * st) * VROW + dt * 64));
                const s16x4 hh = __builtin_amdgcn_ds_read_tr16_b64_v4i16((LAS s16x4*)(vl + vb + (16 * st + 8) * VROW + dt * 64));
                const bf16x8 vf = (bf16x8){lo[0], lo[1], lo[2], lo[3], hh[0], hh[1], hh[2], hh[3]};
                if (dt == 0) o0 = __builtin_amdgcn_mfma_f32_32x32x16_bf16(vf, wf[st], o0, 0, 0, 0); else o1 = __builtin_amdgcn_mfma_f32_32x32x16_bf16(vf, wf[st], o1, 0, 0, 0); }
        P = Cout;
        if (__all(P < 1.17549435e-38f)) break;
    }
#pragma unroll
    for (int dt = 0; dt < 2; ++dt)
#pragma unroll
        for (int g = 0; g < 4; ++g) { bf16_t* p = SG + tokq * 1536 + h * 64 + dt * 32 + 8 * g + 4 * hi; const u32x2 sg = *(const u32x2*)p;
            const f32x16& o = dt ? o1 : o0; u32x2 y;
            y.x = pk2(o[4 * g] * bflo(sg.x), o[4 * g + 1] * bfhi(sg.x)); y.y = pk2(o[4 * g + 2] * bflo(sg.y), o[4 * g + 3] * bfhi(sg.y));
            *(u32x2*)p = y; }
}
__device__ __forceinline__ void pool_item(int pi, const bf16_t* PV, bf16_t* SG, const bf16_t* PT, const float* scale, int lane) {
    const int tile = pi >> 2, g = ((pi & 3) + ((pi >> 2) & 1)) & 3, win = 2 << g;
    const int r32 = lane & 31, hi = lane >> 5, tok = tile * 32 + r32, t = tok & (SEQ - 1);
    const bf16_t* vp = PV + (size_t)tok * 512 + g * 128 + 8 * hi;
    const int cnt = (t + 1) < win ? (t + 1) : win;
    float sum[8][8];
#pragma unroll
    for (int s = 0; s < 8; ++s) { const u32x4 raw = *(const u32x4*)(vp + 16 * s); const float f = 1.f - (float)cnt;
        sum[s][0] = bflo(raw.x) * f; sum[s][1] = bfhi(raw.x) * f; sum[s][2] = bflo(raw.y) * f; sum[s][3] = bfhi(raw.y) * f;
        sum[s][4] = bflo(raw.z) * f; sum[s][5] = bfhi(raw.z) * f; sum[s][6] = bflo(raw.w) * f; sum[s][7] = bfhi(raw.w) * f; }
    for (int jj = 1; jj < win; ++jj) {
        if (t - jj >= 0) {
#pragma unroll
            for (int s = 0; s < 8; ++s) { const u32x4 raw = *(const u32x4*)(vp - (size_t)jj * 512 + 16 * s);
                sum[s][0] += bflo(raw.x); sum[s][1] += bfhi(raw.x); sum[s][2] += bflo(raw.y); sum[s][3] += bfhi(raw.y);
                sum[s][4] += bflo(raw.z); sum[s][5] += bfhi(raw.z); sum[s][6] += bflo(raw.w); sum[s][7] += bfhi(raw.w); } }
    }
    const float inv = 1.f / (float)cnt;
    bf16x8 pf[8];
#pragma unroll
    for (int s = 0; s < 8; ++s) { u32x4 tt; tt.x = pk2(sum[s][0] * inv, sum[s][1] * inv); tt.y = pk2(sum[s][2] * inv, sum[s][3] * inv); tt.z = pk2(sum[s][4] * inv, sum[s][5] * inv); tt.w = pk2(sum[s][6] * inv, sum[s][7] * inv); pf[s] = __builtin_bit_cast(bf16x8, tt); }
#pragma unroll
    for (int nt = 0; nt < 4; ++nt) {
        f32x16 acc;
#pragma unroll
        for (int r = 0; r < 16; ++r) acc[r] = 0.f;
        const bf16_t* ap = PT + (size_t)(g * 128 + nt * 32 + r32) * 128 + 8 * hi;
#pragma unroll
        for (int s = 0; s < 8; ++s) { const bf16x8 a = *(const bf16x8*)(ap + 16 * s); acc = __builtin_amdgcn_mfma_f32_32x32x16_bf16(a, pf[s], acc, 0, 0, 0); }
#pragma unroll
        for (int q = 0; q < 4; ++q) { const int d = g * 128 + nt * 32 + 8 * q + 4 * hi; const f32x4 sc = *(const f32x4*)(scale + d);
            bf16_t* p = SG + (size_t)tok * 1536 + d; const u32x2 sg = *(const u32x2*)p; u32x2 y;
            y.x = pk2(acc[4 * q] * sc[0] * bflo(sg.x), acc[4 * q + 1] * sc[1] * bfhi(sg.x)); y.y = pk2(acc[4 * q + 2] * sc[2] * bflo(sg.y), acc[4 * q + 3] * sc[3] * bfhi(sg.y));
            *(u32x2*)p = y; }
    }
}
__device__ __forceinline__ void conv_item(int ci, const bf16_t* Z, bf16_t* Wy, const float* cw, const float* cb, int lane) {
    const int tok0 = ci * 8, t0 = tok0 & (SEQ - 1), ch = lane * 8;
    float w0[8], w1[8], w2[8], bs[8], zm2[8], zm1[8];
#pragma unroll
    for (int hf = 0; hf < 2; ++hf) { const f32x4 a = *(const f32x4*)(cw + ch + 4 * hf), b = *(const f32x4*)(cw + 512 + ch + 4 * hf), c = *(const f32x4*)(cw + 1024 + ch + 4 * hf), d = *(const f32x4*)(cb + ch + 4 * hf);
#pragma unroll
        for (int i = 0; i < 4; ++i) { w0[4 * hf + i] = a[i]; w1[4 * hf + i] = b[i]; w2[4 * hf + i] = c[i]; bs[4 * hf + i] = d[i]; } }
#pragma unroll
    for (int i = 0; i < 8; ++i) { zm2[i] = 0.f; zm1[i] = 0.f; }
    if (t0 != 0) { const u32x4 a = *(const u32x4*)(Z + (size_t)(tok0 - 2) * 512 + ch), b = *(const u32x4*)(Z + (size_t)(tok0 - 1) * 512 + ch);
        zm2[0] = bflo(a.x); zm2[1] = bfhi(a.x); zm2[2] = bflo(a.y); zm2[3] = bfhi(a.y); zm2[4] = bflo(a.z); zm2[5] = bfhi(a.z); zm2[6] = bflo(a.w); zm2[7] = bfhi(a.w);
        zm1[0] = bflo(b.x); zm1[1] = bfhi(b.x); zm1[2] = bflo(b.y); zm1[3] = bfhi(b.y); zm1[4] = bflo(b.z); zm1[5] = bfhi(b.z); zm1[6] = bflo(b.w); zm1[7] = bfhi(b.w); }
#pragma unroll
    for (int r = 0; r < 8; ++r) { const size_t off = (size_t)(tok0 + r) * 512 + ch, offw = (size_t)(tok0 + r) * 1536 + ch; const u32x4 zr = *(const u32x4*)(Z + off), wr_ = *(const u32x4*)(Wy + offw);
        float zc[8], wv[8], y[8];
        zc[0] = bflo(zr.x); zc[1] = bfhi(zr.x); zc[2] = bflo(zr.y); zc[3] = bfhi(zr.y); zc[4] = bflo(zr.z); zc[5] = bfhi(zr.z); zc[6] = bflo(zr.w); zc[7] = bfhi(zr.w);
        wv[0] = bflo(wr_.x); wv[1] = bfhi(wr_.x); wv[2] = bflo(wr_.y); wv[3] = bfhi(wr_.y); wv[4] = bflo(wr_.z); wv[5] = bfhi(wr_.z); wv[6] = bflo(wr_.w); wv[7] = bfhi(wr_.w);
#pragma unroll
        for (int i = 0; i < 8; ++i) { y[i] = wv[i] * (w0[i] * zm2[i] + w1[i] * zm1[i] + w2[i] * zc[i] + bs[i]); zm2[i] = zm1[i]; zm1[i] = zc[i]; }
        u32x4 o; o.x = pk2(y[0], y[1]); o.y = pk2(y[2], y[3]); o.z = pk2(y[4], y[5]); o.w = pk2(y[6], y[7]);
        *(u32x4*)(Wy + offw) = o; }
}
template <int R> __device__ __forceinline__ void norm_rows(const float* F32T, const float* RS, const float* xin, const float* gpost, float* xout, const float* gnext, bf16_t* H, int m0, int mstride, int lane) {
    f32x4 o[R][4], xi[R][4]; float ss[R];
#pragma unroll
    for (int r = 0; r < R; ++r) { const size_t row = (size_t)(m0 + r * mstride); ss[r] = (lane < 16) ? RS[row * 16 + lane] : 0.f;
#pragma unroll
        for (int j = 0; j < 4; ++j) { o[r][j] = ((const f32x4*)(F32T + row * DM))[64 * j + lane]; xi[r][j] = ((const f32x4*)(xin + row * DM))[64 * j + lane]; } }
    f32x4 gp[4];
#pragma unroll
    for (int j = 0; j < 4; ++j) gp[j] = ((const f32x4*)gpost)[64 * j + lane];
#pragma unroll
    for (int r = 0; r < R; ++r) { const size_t row = (size_t)(m0 + r * mstride);
        const float rstd = 1.f / sqrtf(wave_sum(ss[r]) * (1.f / DM) + RMS_EPS); float s2 = 0.f;
#pragma unroll
        for (int j = 0; j < 4; ++j) { const f32x4 v = xi[r][j] + o[r][j] * rstd * gp[j]; xi[r][j] = v; ((f32x4*)(xout + row * DM))[64 * j + lane] = v; s2 += (v[0] * v[0] + v[1] * v[1]) + (v[2] * v[2] + v[3] * v[3]); }
        if (gnext) { const float r2 = 1.f / sqrtf(wave_sum(s2) * (1.f / DM) + RMS_EPS);
#pragma unroll
            for (int j = 0; j < 4; ++j) { const f32x4 gg = ((const f32x4*)gnext)[64 * j + lane]; const f32x4 v = xi[r][j]; u32x2 w; w.x = pk2(v[0] * r2 * gg[0], v[1] * r2 * gg[1]); w.y = pk2(v[2] * r2 * gg[2], v[3] * r2 * gg[3]); ((u32x2*)(H + row * DM))[64 * j + lane] = w; } } }
}

struct Args { const float* in[10]; float* out; unsigned char* ws; int ph_lo, ph_hi; };
#define ARGP() ({ const Args* p_ = ap0; asm volatile("" : "+s"(p_)); p_; })
template <int ph> __device__ __forceinline__ void run_phase(const Args* ap0, LAS unsigned char* lds) {
        const Args* A = ARGP();
        const int tid = threadIdx.x, lane = tid & 63, wave = __builtin_amdgcn_readfirstlane(tid >> 6);
        const int G = gridDim.x, bx = blockIdx.x;
        const int vcu = (G % 8 == 0) ? (bx % 8) * (G / 8) + bx / 8 : bx;
        const int gw = vcu * 8 + wave, NGW = G * 8;
        unsigned char* ws = A->ws;
        bf16_t* H = (bf16_t*)(ws + WS_H); bf16_t* U = (bf16_t*)(ws + WS_U);
        if constexpr (ph == 0) {
            const float* x = A->in[0]; const float* pre_g = A->in[1]; const float* w_in = A->in[2]; const float* pool_w = A->in[3]; const float* w_branch = A->in[7]; const float* w_out = A->in[8];
            bf16_t* W1 = (bf16_t*)(ws + WS_W1); bf16_t* W2 = (bf16_t*)(ws + WS_W2); bf16_t* W3 = (bf16_t*)(ws + WS_W3); bf16_t* PW = (bf16_t*)(ws + WS_PW);
            LAS float* scr = (LAS float*)(lds + wave * 17408);
            constexpr int I1 = (DM / 64) * (NIN / 64), I2 = (BWID / 64) * (DM / 64), I3 = (DM / 64) * (DM / 64), I4 = 2 * 2, PER = I1 + 3 * I2 + I3 + 4 * I4;
            for (int it = gw; it < NLAYER * PER; it += NGW) {
                const int l = it / PER; int r = it % PER;
                if (r < I1) { transpose_item(w_in + (size_t)l * DM * NIN, NIN, W1 + (size_t)l * NIN * DM, DM, 0, 0, true, scr, r, lane); continue; } r -= I1;
                if (r < 3 * I2) { const int n = r / I2; transpose_item(w_branch + ((size_t)l * 3 + n) * BWID * DM, DM, W2 + (size_t)l * 3 * DM * BWID, 3 * BWID, n * BWID, 0, false, scr, r % I2, lane); continue; } r -= 3 * I2;
                if (r < I3) { transpose_item(w_out + (size_t)l * DM * DM, DM, W3 + (size_t)l * DM * DM, DM, 0, 0, false, scr, r, lane); continue; } r -= I3;
                { const int g = r / I4; transpose_item(pool_w + ((size_t)l * 4 + g) * 128 * 128, 128, PW + ((size_t)l * 4 + g) * 128 * 128, 128, 0, 0, false, scr, r % I4, lane); }
            }
            for (int m = gw; m < MTOK; m += 2 * NGW) rms_rows_to_bf16<2>(x, pre_g, H, m, NGW, lane);
        } else {
            constexpr int l = (ph - 1) / 5, k = (ph - 1) % 5;
            if constexpr (k == 0) {
                pg8::Gemm g{H, (bf16_t*)(ws + WS_W1) + (size_t)l * NIN * DM, MTOK, NIN, DM, 0}; pg8::StaticOrder S; S.init(MTOK, NIN, G, bx);
                EpiU E{ws};
                pg8::gemm_phase<EpiU, pg8::StaticOrder, true, true>(lds, g, S, E);
            } else if constexpr (k == 1) {
                const float* pool_scale = A->in[4]; const float* conv_w = A->in[5]; const float* conv_b = A->in[6];
                const bf16_t* PW = (const bf16_t*)(ws + WS_PW);
                const bf16_t* Q = U + 2 * (ARRB / 2); const bf16_t* Kk = U + 3 * (ARRB / 2); const bf16_t* V = U + 4 * (ARRB / 2);
                LAS unsigned char* vl = lds + wave * (32 * VROW);
                for (int it = gw; it < NB * 8 * 128; it += NGW) attn_item(it, Q, Kk, V, U + 5 * (ARRB / 2) + 1024, vl, lane);
                for (int it = gw; it < (MTOK / 32) * 4; it += NGW) pool_item(it, U, U + 5 * (ARRB / 2), PW + (size_t)l * 4 * 128 * 128, pool_scale + l * BWID, lane);
                for (int it = gw; it < MTOK / 8; it += NGW) conv_item(it, U + 1 * (ARRB / 2), U + 5 * (ARRB / 2) + 512, conv_w + l * 3 * BWID, conv_b + l * BWID, lane);
            } else if constexpr (k == 2) {
                pg8::Gemm g{U + 5 * (ARRB / 2), (bf16_t*)(ws + WS_W2) + (size_t)l * 3 * DM * BWID, MTOK, DM, 3 * BWID, 0}; pg8::StaticOrder S; S.init(MTOK, DM, G, bx);
                EpiBranch E{ws};
                pg8::gemm_phase<EpiBranch, pg8::StaticOrder, true, true>(lds, g, S, E);
            } else if constexpr (k == 3) {
                pg8::Gemm g{H, (bf16_t*)(ws + WS_W3) + (size_t)l * DM * DM, MTOK, DM, DM, 0}; pg8::StaticOrder S; S.init(MTOK, DM, G, bx);
                EpiOut E{ws};
                pg8::gemm_phase<EpiOut, pg8::StaticOrder, true, true>(lds, g, S, E);
            } else {
                const float* x = A->in[0]; const float* pre_g = A->in[1]; const float* post_g = A->in[9]; float* out = A->out;
                const float* F32T = (const float*)(ws + WS_U); const float* RS = (const float*)(ws + WS_RS);
                const float* xin = (l == 0) ? x : out; const float* gnext = (l + 1 < NLAYER) ? pre_g + (l + 1) * DM : nullptr;
                for (int m = gw; m < MTOK; m += 2 * NGW) norm_rows<2>(F32T, RS, xin, post_g + l * DM, out, gnext, H, m, NGW, lane);
            }
        }
}
__global__ void __launch_bounds__(512, 2) hybrid_fwd(Args a_) {
    extern __shared__ __attribute__((aligned(16))) unsigned char lds_raw[];
    LAS unsigned char* lds = (LAS unsigned char*)lds_raw;
    const Args* ap0 = (const Args*)__builtin_amdgcn_kernarg_segment_ptr();
    cg::grid_group grid = cg::this_grid();
    if (threadIdx.x < 64) ((LAS unsigned*)(lds + 147200))[threadIdx.x] = 0u;
    __syncthreads();
    (void)xcd_barrier_post((unsigned*)(ARGP()->ws + WS_CTL), (volatile LAS unsigned*)(lds + 147200 + 32));
#define SEAM_BAR() do { XcdBarrier b_; b_.bar = (unsigned*)(ARGP()->ws + WS_CTL); b_.x = xb_xcc_id(); b_.st = (volatile LAS unsigned*)(lds + 147200 + 32); xcd_barrier(b_); } while (0)
    const int lo = ARGP()->ph_lo, hi = ARGP()->ph_hi;
#define PHASE(k) if (lo <= (k) && (k) < hi) { if ((k) > lo) { if ((k) == 1) grid.sync(); else SEAM_BAR(); } run_phase<(k)>(ap0, lds); }
    PHASE(0) PHASE(1) PHASE(2) PHASE(3) PHASE(4) PHASE(5) PHASE(6) PHASE(7) PHASE(8) PHASE(9) PHASE(10)
#undef PHASE
}

extern "C" void kernel_launch(void* const* d_in, const int* in_sizes, int n_in, void* d_out, int out_size, void* d_ws, size_t ws_size, hipStream_t stream) {
    static int grid = 0;
    if (grid == 0) {
        if (n_in != 10 || out_size != MTOK * DM || ws_size < WS_END) { fprintf(stderr, "kernel_launch: unexpected shapes / workspace (n_in %d out %d ws %zu)\n", n_in, out_size, ws_size); grid = -1; return; }
        int dev = 0, cus = 0, per_cu = 0;
        (void)hipGetDevice(&dev); (void)hipDeviceGetAttribute(&cus, hipDeviceAttributeMultiprocessorCount, dev);
        (void)hipFuncSetAttribute((const void*)hybrid_fwd, hipFuncAttributeMaxDynamicSharedMemorySize, LDS_BYTES);
        (void)hipOccupancyMaxActiveBlocksPerMultiprocessor(&per_cu, (const void*)hybrid_fwd, 512, LDS_BYTES);
        (void)hipGetLastError();
        if (per_cu < 1) { fprintf(stderr, "kernel_launch: occupancy query says %d blocks/CU\n", per_cu); per_cu = 1; }
        grid = cus;
    }
    if (grid < 0) return;
    if (hipMemsetAsync((char*)d_ws + WS_CTL, 0, CTL_BYTES, stream) != hipSuccess) { fprintf(stderr, "kernel_launch: memset of the barrier words failed\n"); return; }
    Args a{};
    for (int i = 0; i < 10; ++i) a.in[i] = (const float*)d_in[i];
    a.out = (float*)d_out; a.ws = (unsigned char*)d_ws;
#if ONE_LAUNCH
    a.ph_lo = 0; a.ph_hi = NPHASE;
    void* args[] = {&a};
    hipError_t e = hipLaunchCooperativeKernel((const void*)hybrid_fwd, dim3(grid), dim3(512), args, LDS_BYTES, stream);
    if (e != hipSuccess) fprintf(stderr, "cooperative launch failed: %s (grid %d)\n", hipGetErrorString(e), grid);
#else
    for (int ph = 0; ph < NPHASE; ++ph) { a.ph_lo = ph; a.ph_hi = ph + 1; for (int rep = 0; rep < 1 + ((DUP_MASK >> ph) & 1); ++rep) hipLaunchKernelGGL(hybrid_fwd, dim3(grid), dim3(512), LDS_BYTES, stream, a); }
#endif
}
```

```cpp
#include <hip/hip_runtime.h>
#include <hip/hip_cooperative_groups.h>
#include <cstdio>
#include <cstdint>
namespace cg = cooperative_groups;
#ifndef ONE_LAUNCH
#define ONE_LAUNCH 1
#endif
#ifndef DUP_MASK
#define DUP_MASK 0
#endif
namespace pg8 {
#define PG8_LAS __attribute__((address_space(3)))
typedef unsigned short bf16_t;
typedef short bf16x8 __attribute__((ext_vector_type(8)));
typedef float f32x4 __attribute__((ext_vector_type(4)));
typedef unsigned u32x4 __attribute__((ext_vector_type(4)));
constexpr int BM = 256, BK = 64, HALF = 128, HTB = HALF * BK * 2  , STAGE_BYTES = 8 * HTB, NXCD = 8, WGM = 8;

__host__ __device__ __forceinline__ int lds_byte(int r, int c) { const int st = (r >> 4) * 2 + (c >> 5), rr = r & 15, cc = c & 31, ob = rr * 64 + cc * 2; return st * 1024 + (ob ^ (((ob >> 9) & 1) << 5)); }
__host__ __device__ __forceinline__ void stage_rc(int b, int& R, int& C) { const int st = b / 1024, sb = b % 1024, swz = sb ^ (((sb >> 9) & 1) << 5); R = (st >> 1) * 16 + swz / 64; C = (st & 1) * 32 + (swz % 64) / 2; }
__host__ __device__ __forceinline__ int perm32(int rho) { const int n = rho >> 4, i = rho & 15; return 8 * (i >> 2) + 4 * n + (i & 3); }

struct Unit { int pm, pn, az; };
struct Gemm { const bf16_t* A; const bf16_t* Bt; int M, N, K; size_t azs; };

struct StaticOrder {
    int nM, nN, nwg, G, c;
    __host__ __device__ void init(int M, int N, int G_, int c_) { nM = M / BM; nN = N / BM; nwg = nM * nN; G = G_; c = c_; }
    __host__ __device__ bool next(int i, Unit& u) const {
        const long L = (long)i * G + c; if (L >= nwg) return false;
        int wgid = (int)L; { const int q = nwg / NXCD, r = nwg % NXCD, xcd = wgid % NXCD, off = wgid / NXCD; wgid = (xcd < r ? xcd * (q + 1) : r * (q + 1) + (xcd - r) * q) + off; }
        const int nig = WGM * nN, gid = wgid / nig, fm = gid * WGM, gsz = (nM - fm) < WGM ? (nM - fm) : WGM;
        u.pm = fm + ((wgid % nig) % gsz); u.pn = (wgid % nig) / gsz; u.az = 0; return true;
    }
    __device__ __forceinline__ void a_ready(const Unit&) const {}
    __device__ __forceinline__ void done(const Unit&) const {}
};

__device__ __forceinline__ unsigned cvt_pk_bf16(float lo, float hi) { unsigned r; asm volatile("v_cvt_pk_bf16_f32 %0, %1, %2" : "=v"(r) : "v"(lo), "v"(hi)); return r; }
template <class Epi, class Sched, bool ALIGN_EPI = false, bool SP2 = false>
__device__ __forceinline__ void gemm_phase(PG8_LAS unsigned char* lds, const Gemm g, const Sched& S, const Epi& E) {
    const int tid = threadIdx.x, wid = __builtin_amdgcn_readfirstlane(tid >> 6), lane = tid & 63, wr = wid >> 2, wc = wid & 3, fr = lane & 15, fq = lane >> 4;
    const int K = g.K, nt = K / BK;
    unsigned voffA[2], voffB[2];
#pragma unroll
    for (int i = 0; i < 2; ++i) { int R, C; stage_rc(tid * 16 + i * 8192, R, C); const int Rb = Epi::PERM ? ((R & ~31) + perm32(R & 31)) : R;
        voffA[i] = (unsigned)(R * K + C) * 2u; voffB[i] = (unsigned)(Rb * K + C) * 2u; }
    const size_t kstep = (size_t)(BK * 2);
    const size_t hstep = (size_t)HALF * K * 2;
    const size_t tstep = 2 * hstep;
    const unsigned ldsw = (unsigned)wid * 1024u;
    const int aoff = lds_byte(wr * 64 + fr, fq * 8), boff = lds_byte(wc * 32 + fr, fq * 8);
#define PG8_SA(b, h) (((b) * 2 + (h)) * HTB)
#define PG8_SB(b, h) ((4 + (b) * 2 + (h)) * HTB)
#define PG8_STAGE(bufoff, gbase, voff) do { _Pragma("unroll") for (int _i = 0; _i < 2; ++_i) \
        __builtin_amdgcn_global_load_lds((const unsigned*)((const char*)(gbase) + (voff)[_i]), (PG8_LAS unsigned*)(lds + (bufoff) + ldsw + _i * 8192), 16, 0, 0); } while (0)
#define PG8_LDA(dst, b, h) do { _Pragma("unroll") for (int m = 0; m < 4; ++m) _Pragma("unroll") for (int k = 0; k < 2; ++k) dst[m][k] = *(const PG8_LAS bf16x8*)(lds + PG8_SA(b, h) + aoff + m * 2048 + k * 1024); } while (0)
#define PG8_LDB(dst, b, h) do { _Pragma("unroll") for (int n = 0; n < 2; ++n) _Pragma("unroll") for (int k = 0; k < 2; ++k) dst[n][k] = *(const PG8_LAS bf16x8*)(lds + PG8_SB(b, h) + boff + n * 2048 + k * 1024); } while (0)
#define PG8_MMA(ai, bj, At, Bt) do { __builtin_amdgcn_s_setprio(1); _Pragma("unroll") for (int m = 0; m < 4; ++m) _Pragma("unroll") for (int n = 0; n < 2; ++n) _Pragma("unroll") for (int k = 0; k < 2; ++k) \
        acc[ai][bj][m][n] = __builtin_amdgcn_mfma_f32_16x16x32_bf16(Bt[n][k], At[m][k], acc[ai][bj][m][n], 0, 0, 0); __builtin_amdgcn_s_setprio(0); } while (0)
#define PG8_WAIT_V(n) asm volatile("s_waitcnt vmcnt(" #n ")" ::: "memory")
#define PG8_WAIT_L(n) asm volatile("s_waitcnt lgkmcnt(" #n ")" ::: "memory")
#define PG8_BAR __builtin_amdgcn_s_barrier()
#define PG8_SCHED __builtin_amdgcn_sched_barrier(0)
    Unit cur, nxt; int ui = 0;
    if (!S.next(0, cur)) return;
    f32x4 acc[2][2][4][2];
#pragma unroll
    for (int a = 0; a < 2; ++a)
#pragma unroll
        for (int b = 0; b < 2; ++b)
#pragma unroll
            for (int m = 0; m < 4; ++m)
#pragma unroll
                for (int n = 0; n < 2; ++n) acc[a][b][m][n] = (f32x4){0.f, 0.f, 0.f, 0.f};
    bf16x8 At[4][2], B0[2][2], B1[2][2];
    const char* cA = (const char*)g.A + (size_t)cur.pm * tstep + (size_t)cur.az * g.azs; const char* cB = (const char*)g.Bt + (size_t)cur.pn * tstep;
    S.a_ready(cur);
    if constexpr (SP2) {
        PG8_STAGE(PG8_SB(0, 0), cB, voffB); PG8_STAGE(PG8_SB(0, 1), cB + hstep, voffB); PG8_STAGE(PG8_SA(0, 0), cA, voffA); PG8_STAGE(PG8_SA(0, 1), cA + hstep, voffA);
        if (wr == 1) PG8_BAR;
        PG8_WAIT_V(2); PG8_BAR;
        PG8_STAGE(PG8_SB(1, 0), cB + kstep, voffB); PG8_STAGE(PG8_SA(1, 0), cA + kstep, voffA); PG8_STAGE(PG8_SB(1, 1), cB + hstep + kstep, voffB);
        PG8_WAIT_V(6); PG8_BAR;
    } else {
        PG8_STAGE(PG8_SB(0, 0), cB, voffB); PG8_STAGE(PG8_SA(0, 0), cA, voffA); PG8_STAGE(PG8_SB(0, 1), cB + hstep, voffB); PG8_STAGE(PG8_SA(0, 1), cA + hstep, voffA);
        if (wr == 1) PG8_BAR;
        PG8_WAIT_V(4); PG8_BAR;
        PG8_STAGE(PG8_SB(1, 0), cB + kstep, voffB); PG8_STAGE(PG8_SA(1, 0), cA + kstep, voffA); PG8_STAGE(PG8_SB(1, 1), cB + hstep + kstep, voffB);
        PG8_WAIT_V(6); PG8_BAR;
    }
    for (;;) {
        const bool has_next = S.next(ui + 1, nxt);
        const char* nA = has_next ? (const char*)g.A + (size_t)nxt.pm * tstep + (size_t)nxt.az * g.azs : cA; const char* nB = has_next ? (const char*)g.Bt + (size_t)nxt.pn * tstep : cB;
        for (int t = 0; t < nt; t += 2) {
            if constexpr (Epi::MIDK) { if (t == 8 || t == 16) E.mid(acc, cur, t >> 3, wr, wc, fr, fq); }
            const bool last = (t == nt - 2);
            const char* a1 = cA + (size_t)(t + 1) * kstep;
            const char* a2 = last ? nA : cA + (size_t)(t + 2) * kstep; const char* b2 = last ? nB : cB + (size_t)(t + 2) * kstep;
            const char* a3 = a2 + kstep; const char* b3 = b2 + kstep;
            if (last && has_next) S.a_ready(nxt);
            if constexpr (SP2) {
            PG8_LDB(B0, 0, 0); PG8_LDB(B1, 0, 1); PG8_SCHED; PG8_LDA(At, 0, 0); PG8_STAGE(PG8_SA(1, 1), a1 + hstep, voffA);
            PG8_WAIT_V(8); PG8_WAIT_L(0); PG8_BAR; PG8_MMA(0, 0, At, B0); PG8_MMA(0, 1, At, B1); PG8_BAR; PG8_SCHED;
            PG8_LDA(At, 0, 1); PG8_STAGE(PG8_SB(0, 0), b2, voffB); PG8_STAGE(PG8_SB(0, 1), b2 + hstep, voffB); PG8_STAGE(PG8_SA(0, 0), a2, voffA);
            PG8_WAIT_V(8); PG8_WAIT_L(0); PG8_BAR; PG8_MMA(1, 0, At, B0); PG8_MMA(1, 1, At, B1); PG8_BAR; PG8_SCHED;
            PG8_LDB(B0, 1, 0); PG8_LDB(B1, 1, 1); PG8_SCHED; PG8_LDA(At, 1, 0); PG8_STAGE(PG8_SA(0, 1), a2 + hstep, voffA);
            PG8_WAIT_V(8); PG8_WAIT_L(0); PG8_BAR; PG8_MMA(0, 0, At, B0); PG8_MMA(0, 1, At, B1); PG8_BAR; PG8_SCHED;
            PG8_LDA(At, 1, 1); PG8_STAGE(PG8_SB(1, 0), b3, voffB); PG8_STAGE(PG8_SB(1, 1), b3 + hstep, voffB); PG8_STAGE(PG8_SA(1, 0), a3, voffA);
            PG8_WAIT_V(8); PG8_WAIT_L(0); PG8_BAR; PG8_MMA(1, 0, At, B0); PG8_MMA(1, 1, At, B1); PG8_BAR; PG8_SCHED;
            } else {
            PG8_LDB(B0, 0, 0); PG8_SCHED; PG8_LDA(At, 0, 0); PG8_STAGE(PG8_SA(1, 1), a1 + hstep, voffA);
            PG8_WAIT_L(8); PG8_BAR; PG8_WAIT_L(0); PG8_MMA(0, 0, At, B0); PG8_BAR; PG8_SCHED;
            PG8_LDB(B1, 0, 1); PG8_STAGE(PG8_SB(0, 0), b2, voffB);
            PG8_BAR; PG8_WAIT_L(0); PG8_MMA(0, 1, At, B1); PG8_BAR;
            PG8_LDA(At, 0, 1); PG8_STAGE(PG8_SA(0, 0), a2, voffA);
            PG8_BAR; PG8_WAIT_L(0); PG8_MMA(1, 0, At, B0); PG8_BAR; PG8_SCHED;
            PG8_STAGE(PG8_SB(0, 1), b2 + hstep, voffB);
            PG8_WAIT_V(6); PG8_BAR; PG8_MMA(1, 1, At, B1); PG8_BAR;
            PG8_LDB(B0, 1, 0); PG8_SCHED; PG8_LDA(At, 1, 0); PG8_STAGE(PG8_SA(0, 1), a2 + hstep, voffA);
            PG8_WAIT_L(8); PG8_BAR; PG8_WAIT_L(0); PG8_MMA(0, 0, At, B0); PG8_BAR; PG8_SCHED;
            PG8_LDB(B1, 1, 1); PG8_STAGE(PG8_SB(1, 0), b3, voffB);
            PG8_BAR; PG8_WAIT_L(0); PG8_MMA(0, 1, At, B1); PG8_BAR;
            PG8_LDA(At, 1, 1); PG8_STAGE(PG8_SA(1, 0), a3, voffA);
            PG8_BAR; PG8_WAIT_L(0); PG8_MMA(1, 0, At, B0); PG8_BAR; PG8_SCHED;
            PG8_STAGE(PG8_SB(1, 1), b3 + hstep, voffB);
            PG8_WAIT_V(6); PG8_BAR; PG8_MMA(1, 1, At, B1); PG8_BAR;
            }
        }
        if constexpr (ALIGN_EPI) { if (wr == 0) PG8_BAR; }
        if constexpr (!Epi::AFTER_DRAIN) { E(acc, cur, wr, wc, fr, fq); S.done(cur); }
        if (!has_next) break;
#pragma unroll
        for (int a = 0; a < 2; ++a)
#pragma unroll
            for (int b = 0; b < 2; ++b)
#pragma unroll
                for (int m = 0; m < 4; ++m)
#pragma unroll
                    for (int n = 0; n < 2; ++n) acc[a][b][m][n] = (f32x4){0.f, 0.f, 0.f, 0.f};
        cur = nxt; cA = nA; cB = nB; ++ui;
        if constexpr (ALIGN_EPI) { if (wr == 1) PG8_BAR; }
    }
    PG8_WAIT_V(0);
    if constexpr (!ALIGN_EPI) { if (wr == 0) PG8_BAR; }
    PG8_BAR;
    if constexpr (Epi::AFTER_DRAIN) { E.fused(acc, cur, wr, wc, fr, fq, lds, wid, lane); S.done(cur); }
#undef PG8_SA
#undef PG8_SB
#undef PG8_STAGE
#undef PG8_LDA
#undef PG8_LDB
#undef PG8_MMA
#undef PG8_WAIT_V
#undef PG8_WAIT_L
#undef PG8_BAR
#undef PG8_SCHED
}
}

#define LAS __attribute__((address_space(3)))
typedef unsigned short bf16_t;
typedef short bf16x8 __attribute__((ext_vector_type(8)));
typedef short s16x4 __attribute__((ext_vector_type(4)));
typedef float f32x4 __attribute__((ext_vector_type(4)));
typedef float f32x16 __attribute__((ext_vector_type(16)));
typedef unsigned u32x4 __attribute__((ext_vector_type(4)));
typedef unsigned u32x2 __attribute__((ext_vector_type(2)));
constexpr int NB = 4, SEQ = 4096, DM = 1024, MTOK = NB * SEQ, NIN = 8192, BWID = 512, NLAYER = 2;
constexpr float RMS_EPS = 1e-6f;
constexpr size_t MiB = 1u << 20;
constexpr size_t WS_RS = 0;
constexpr size_t WS_W1 = 2 * MiB;
constexpr size_t WS_W2 = 34 * MiB;
constexpr size_t WS_W3 = 40 * MiB;
constexpr size_t WS_PW = 44 * MiB;
constexpr size_t WS_H = 45 * MiB;
constexpr size_t WS_U = 77 * MiB;
constexpr size_t ARRB = 16 * MiB;
constexpr size_t WS_MG = 205 * MiB;
constexpr size_t WS_END = 253 * MiB;
constexpr int LDS_BYTES = 147456;
constexpr int NPHASE = 1 + 5 * NLAYER;

__device__ __forceinline__ unsigned f2bf(float f) { unsigned u = __builtin_bit_cast(unsigned, f); return (u + 0x7fffu + ((u >> 16) & 1u)) >> 16; }
__device__ __forceinline__ unsigned pk2(float lo, float hi) { return f2bf(lo) | (f2bf(hi) << 16); }
__device__ __forceinline__ float bflo(unsigned u) { return __builtin_bit_cast(float, u << 16); }
__device__ __forceinline__ float bfhi(unsigned u) { return __builtin_bit_cast(float, u & 0xffff0000u); }
__device__ __forceinline__ float sigmoid_f(float x) { return __builtin_amdgcn_rcpf(1.f + __builtin_amdgcn_exp2f(-1.4426950408889634f * x)); }
__device__ __forceinline__ float silu_f(float x) { return x * sigmoid_f(x); }
__device__ __forceinline__ unsigned q8(float x) { const unsigned q = (unsigned)(sigmoid_f(x) * 255.f + 0.5f); return q < 1u ? 1u : q; }
__device__ __forceinline__ float wave_sum(float v) {
#pragma unroll
    for (int o = 1; o < 64; o <<= 1) v += __shfl_xor(v, o);
    return v;
}

constexpr size_t WS_CTL = 1 * MiB; constexpr size_t CTL_BYTES = 16384;
#define XB_TMO      128
#define XB_XCNT(j)  (256  + 64 * (j))
#define XB_XSUB(j)  (1280 + 64 * (j))
#define XB_XGEN(j)  (2304 + 64 * (j))
#define XB_TOP      3328
#define XB_TOPGEN   3392
#define XCD_BAR_WORDS 3456
#define XB_SPIN_CAP (1u << 18)

__device__ __forceinline__ unsigned xb_ld(unsigned* p)              { return __hip_atomic_load(p, __ATOMIC_RELAXED, __HIP_MEMORY_SCOPE_AGENT); }
__device__ __forceinline__ unsigned xb_add(unsigned* p, unsigned v) { return __hip_atomic_fetch_add(p, v, __ATOMIC_RELAXED, __HIP_MEMORY_SCOPE_AGENT); }
__device__ __forceinline__ unsigned xb_xcc_id() { return (unsigned)__builtin_amdgcn_s_getreg((3 << 11) | 20) & 0xFu; }
#define XB_SPIN(cond, bar) do { unsigned _sp = 0; while (cond) { __builtin_amdgcn_s_sleep(1); \
    if ((++_sp & 255u) == 0u) { if (xb_ld(&(bar)[XB_TMO])) break; if (_sp > XB_SPIN_CAP) { atomicAdd(&(bar)[XB_TMO], 1u); break; } } } } while (0)

struct XcdBarrier {
    unsigned* bar; unsigned x;
    volatile LAS unsigned* st;
};

__device__ __forceinline__ XcdBarrier xcd_barrier_post(unsigned* bar, volatile LAS unsigned* st) {
    XcdBarrier b; b.bar = bar; b.x = xb_xcc_id(); b.st = st;
    if (threadIdx.x == 0) (void)xb_add(&bar[XB_XCNT(b.x)], 1u);
    return b;
}
__device__ __forceinline__ void xcd_barrier_complete(unsigned* bar, unsigned x, unsigned& nloc, unsigned& nx) {
    const unsigned G = gridDim.x * gridDim.y * gridDim.z;
    unsigned sum, cnt, mine, sp = 0u;
    for (;;) {
        sum = 0u; cnt = 0u; mine = 0u;
#pragma unroll
        for (unsigned j = 0; j < 16; ++j) { const unsigned c = xb_ld(&bar[XB_XCNT(j)]); sum += c; cnt += (c > 0u) ? 1u : 0u; mine = (j == x) ? c : mine; }
        if (sum == G) break;
        __builtin_amdgcn_s_sleep(1);
        if ((++sp & 255u) == 0u) { if (xb_ld(&bar[XB_TMO])) break; if (sp > XB_SPIN_CAP) { atomicAdd(&bar[XB_TMO], 1u); break; } }
    }
    nloc = mine > 0u ? mine : 1u; nx = cnt > 0u ? cnt : 1u;
}

__device__ __forceinline__ void xcd_barrier(const XcdBarrier& b) {
    asm volatile("s_waitcnt vmcnt(0)" ::: "memory");
    __syncthreads();
    if (threadIdx.x == 0) {
        unsigned* bar = b.bar;
        __builtin_amdgcn_s_waitcnt(0);
        unsigned nloc = b.st[0], nx = b.st[1];
        if (nloc == 0u) { xcd_barrier_complete(bar, b.x, nloc, nx); b.st[0] = nloc; b.st[1] = nx; }
        const unsigned old = xb_add(&bar[XB_XSUB(b.x)], 1u);
        const unsigned gen = old / nloc;
        if (old + 1u == (gen + 1u) * nloc) {
            __builtin_amdgcn_fence(__ATOMIC_RELEASE, "agent");
            asm volatile("s_waitcnt vmcnt(0)" ::: "memory");
            const unsigned og = xb_add(&bar[XB_TOP], 1u);
            const unsigned tg = og / nx;
            if (og + 1u == (tg + 1u) * nx) xb_add(&bar[XB_TOPGEN], 1u);
            else XB_SPIN(xb_ld(&bar[XB_TOPGEN]) == tg, bar);
            __builtin_amdgcn_fence(__ATOMIC_ACQUIRE, "agent");
            xb_add(&bar[XB_XGEN(b.x)], 1u);
            asm volatile("s_waitcnt vmcnt(0)" ::: "memory");
        } else {
            XB_SPIN(xb_ld(&bar[XB_XGEN(b.x)]) == gen, bar);
            __builtin_amdgcn_fence(__ATOMIC_ACQUIRE, "agent");
            asm volatile("s_waitcnt vmcnt(0)" ::: "memory");
        }
    }
    __syncthreads();
}


using pg8::Unit;
struct EpiU {
    static constexpr bool PERM = true, AFTER_DRAIN = false, MIDK = false;
    unsigned char* ws;
    __device__ __forceinline__ void operator()(const f32x4 (&acc)[2][2][4][2], const Unit& u, int wr, int wc, int fr, int fq) const {
        bf16_t* U = (bf16_t*)(ws + WS_U); unsigned char* MG = ws + WS_MG;
        const int pn = u.pn; const int row0 = u.pm * 256 + wr * 64 + fr;
        if (pn >= 20) {
            const int mc0 = (pn - 20) * 256 + wc * 32 + 8 * fq;
#pragma unroll
            for (int ai = 0; ai < 2; ++ai)
#pragma unroll
                for (int m = 0; m < 4; ++m) { unsigned char* rp = MG + (size_t)(row0 + ai * 128 + m * 16) * 3072 + mc0;
#pragma unroll
                    for (int bj = 0; bj < 2; ++bj) { const f32x4 v0 = acc[ai][bj][m][0], v1 = acc[ai][bj][m][1]; u32x2 w;
                        w.x = q8(v0[0]) | (q8(v0[1]) << 8) | (q8(v0[2]) << 16) | (q8(v0[3]) << 24); w.y = q8(v1[0]) | (q8(v1[1]) << 8) | (q8(v1[2]) << 16) | (q8(v1[3]) << 24);
                        *(u32x2*)(rp + bj * 128) = w; } }
        } else if (pn >= 4 && pn < 12) {
            const int ch0 = (pn - 4) * 64 + (4 * wc + fq) * 4;
            bf16_t* Z = U + 1 * (ARRB / 2); bf16_t* W = U + 5 * (ARRB / 2) + 512;
#pragma unroll
            for (int ai = 0; ai < 2; ++ai)
#pragma unroll
                for (int m = 0; m < 4; ++m) { const size_t rr = (size_t)(row0 + ai * 128 + m * 16); const size_t ro = rr * 512 + ch0, rw = rr * 1536 + ch0;
                    const f32x4 z = acc[ai][0][m][0] * acc[ai][0][m][1]; const f32x4 gb = acc[ai][1][m][0], gg = acc[ai][1][m][1];
                    u32x2 zz, ww; zz.x = pg8::cvt_pk_bf16(z[0], z[1]); zz.y = pg8::cvt_pk_bf16(z[2], z[3]);
                    ww.x = pg8::cvt_pk_bf16(gb[0] * silu_f(gg[0]), gb[1] * silu_f(gg[1])); ww.y = pg8::cvt_pk_bf16(gb[2] * silu_f(gg[2]), gb[3] * silu_f(gg[3]));
                    *(u32x2*)(Z + ro) = zz; *(u32x2*)(W + rw) = ww; }
        } else {
            const int kind = pn >> 1; int arr = 0, pitch = 512, coff = 0; bool act = false;
            if (kind == 1) { arr = 5; act = true; pitch = 1536; } else if (kind == 6) arr = 2; else if (kind == 7) arr = 3; else if (kind == 8) arr = 4; else if (kind == 9) { arr = 5; act = true; pitch = 1536; coff = 1024; }
            bf16_t* O = U + (size_t)arr * (ARRB / 2) + coff; const int col0 = (pn & 1) * 256 + wc * 32 + 8 * fq;
#pragma unroll
            for (int ai = 0; ai < 2; ++ai)
#pragma unroll
                for (int m = 0; m < 4; ++m) { bf16_t* rp = O + (size_t)(row0 + ai * 128 + m * 16) * pitch + col0;
#pragma unroll
                    for (int bj = 0; bj < 2; ++bj) { f32x4 v0 = acc[ai][bj][m][0], v1 = acc[ai][bj][m][1];
                        if (act) {
#pragma unroll
                            for (int i = 0; i < 4; ++i) { v0[i] = silu_f(v0[i]); v1[i] = silu_f(v1[i]); } }
                        u32x4 w; w.x = pg8::cvt_pk_bf16(v0[0], v0[1]); w.y = pg8::cvt_pk_bf16(v0[2], v0[3]); w.z = pg8::cvt_pk_bf16(v1[0], v1[1]); w.w = pg8::cvt_pk_bf16(v1[2], v1[3]);
                        *(u32x4*)(rp + bj * 128) = w; } }
        }
    }
};
struct EpiBranch {
    static constexpr bool PERM = true, AFTER_DRAIN = false, MIDK = true;
    unsigned char* ws;
    __device__ __forceinline__ void mid(f32x4 (&acc)[2][2][4][2], const Unit& u, int seg, int wr, int wc, int fr, int fq) const {
        int tid_ = threadIdx.x; asm volatile("" : "+v"(tid_));
        const int wid_ = tid_ >> 6, wr_ = wid_ >> 2, wc_ = wid_ & 3, fr_ = tid_ & 15, fq_ = (tid_ & 63) >> 4;
        const unsigned char* MG = ws + WS_MG + (seg - 1) * 1024; const int row0 = u.pm * 256 + wr_ * 64 + fr_, col0 = u.pn * 256 + wc_ * 32 + 8 * fq_;
#pragma unroll
        for (int ai = 0; ai < 2; ++ai)
#pragma unroll
            for (int m = 0; m < 4; ++m) { const unsigned char* rp = MG + (size_t)(row0 + ai * 128 + m * 16) * 3072 + col0;
#pragma unroll
                for (int bj = 0; bj < 2; ++bj) { const u32x2 qa = *(const u32x2*)(rp + bj * 128), qb = *(const u32x2*)(rp + bj * 128 + 1024);
                    f32x4 r0, r1;
                    r0[0] = (float)(qa.x & 255u) * __builtin_amdgcn_rcpf((float)(qb.x & 255u)); r0[1] = (float)((qa.x >> 8) & 255u) * __builtin_amdgcn_rcpf((float)((qb.x >> 8) & 255u));
                    r0[2] = (float)((qa.x >> 16) & 255u) * __builtin_amdgcn_rcpf((float)((qb.x >> 16) & 255u)); r0[3] = (float)(qa.x >> 24) * __builtin_amdgcn_rcpf((float)(qb.x >> 24));
                    r1[0] = (float)(qa.y & 255u) * __builtin_amdgcn_rcpf((float)(qb.y & 255u)); r1[1] = (float)((qa.y >> 8) & 255u) * __builtin_amdgcn_rcpf((float)((qb.y >> 8) & 255u));
                    r1[2] = (float)((qa.y >> 16) & 255u) * __builtin_amdgcn_rcpf((float)((qb.y >> 16) & 255u)); r1[3] = (float)(qa.y >> 24) * __builtin_amdgcn_rcpf((float)(qb.y >> 24));
                    acc[ai][bj][m][0] *= r0; acc[ai][bj][m][1] *= r1; }
                if (m == 3) asm volatile("" ::: "memory"); }
    }
    __device__ __forceinline__ void operator()(const f32x4 (&acc)[2][2][4][2], const Unit& u, int wr, int wc, int fr, int fq) const {
        const unsigned char* MG = ws + WS_MG + 2 * 1024; bf16_t* merged = (bf16_t*)(ws + WS_H);
        const int row0 = u.pm * 256 + wr * 64 + fr, col0 = u.pn * 256 + wc * 32 + 8 * fq;
#pragma unroll
        for (int ai = 0; ai < 2; ++ai)
#pragma unroll
            for (int m = 0; m < 4; ++m) { const size_t row = (size_t)(row0 + ai * 128 + m * 16);
#pragma unroll
                for (int bj = 0; bj < 2; ++bj) { const int col = col0 + bj * 128;
                    const u32x2 gq = *(const u32x2*)(MG + row * 3072 + col);
                    f32x4 g0, g1; const float k = 1.f / 255.f;
                    g0[0] = (float)(gq.x & 255u) * k; g0[1] = (float)((gq.x >> 8) & 255u) * k; g0[2] = (float)((gq.x >> 16) & 255u) * k; g0[3] = (float)(gq.x >> 24) * k;
                    g1[0] = (float)(gq.y & 255u) * k; g1[1] = (float)((gq.y >> 8) & 255u) * k; g1[2] = (float)((gq.y >> 16) & 255u) * k; g1[3] = (float)(gq.y >> 24) * k;
                    const f32x4 v0 = acc[ai][bj][m][0] * g0, v1 = acc[ai][bj][m][1] * g1;
                    u32x4 w; w.x = pg8::cvt_pk_bf16(v0[0], v0[1]); w.y = pg8::cvt_pk_bf16(v0[2], v0[3]); w.z = pg8::cvt_pk_bf16(v1[0], v1[1]); w.w = pg8::cvt_pk_bf16(v1[2], v1[3]);
                    *(u32x4*)(merged + row * 1024 + col) = w; } }
    }
};
struct EpiOut {
    static constexpr bool PERM = false, AFTER_DRAIN = false, MIDK = false;
    unsigned char* ws;
    __device__ __forceinline__ void operator()(const f32x4 (&acc)[2][2][4][2], const Unit& u, int wr, int wc, int fr, int fq) const {
        float* out = (float*)(ws + WS_U); float* rs = (float*)(ws + WS_RS);
        const int row0 = u.pm * 256 + wr * 64 + fr, col0 = u.pn * 256 + wc * 32 + 4 * fq;
#pragma unroll
        for (int ai = 0; ai < 2; ++ai)
#pragma unroll
            for (int m = 0; m < 4; ++m) { const size_t row = (size_t)(row0 + ai * 128 + m * 16); float ss = 0.f;
#pragma unroll
                for (int bj = 0; bj < 2; ++bj)
#pragma unroll
                    for (int n = 0; n < 2; ++n) { const f32x4 v = acc[ai][bj][m][n]; *(f32x4*)(out + row * 1024 + col0 + bj * 128 + n * 16) = v; ss += (v[0] * v[0] + v[1] * v[1]) + (v[2] * v[2] + v[3] * v[3]); }
                ss += __shfl_xor(ss, 16); ss += __shfl_xor(ss, 32);
                if (fq == 0) rs[row * 16 + u.pn * 4 + wc] = ss; }
    }
};
__device__ __forceinline__ int win_row(int c) {
    if (c < 1024 || c >= 3072) return c;
    const int q = (c - 1024) >> 9, ch = (c - 1024) & 511, ct = ch >> 6, grp = (ch & 63) >> 2, e = ch & 3;
    return 1024 + ct * 256 + (q & 1) * 128 + grp * 8 + (q >> 1) * 4 + e;
}
__device__ __forceinline__ void transpose_item(const float* W, int N, bf16_t* WT, int ldt, int koff, int row_off, bool winmap, LAS float* scr, int item, int lane) {
    const int nblk = N / 64, kb = item / nblk, nb = item % nblk, k0 = 64 * kb, n0 = 64 * nb;
    const int kq = lane >> 4, nq = lane & 15;
    f32x4 v[16];
#pragma unroll
    for (int i = 0; i < 16; ++i) v[i] = *(const f32x4*)(W + (size_t)(k0 + 4 * i + kq) * N + n0 + 4 * nq);
#pragma unroll
    for (int i = 0; i < 16; ++i) { LAS float* s = scr + (4 * i + kq) * 65 + 4 * nq; s[0] = v[i][0]; s[1] = v[i][1]; s[2] = v[i][2]; s[3] = v[i][3]; }
    asm volatile("s_waitcnt lgkmcnt(0)" ::: "memory");
    const int c = lane & 7;
#pragma unroll
    for (int j = 0; j < 8; ++j) { const int n = (lane >> 3) + 8 * j; const LAS float* s = scr + (8 * c) * 65 + n;
        u32x4 o; o.x = pk2(s[0 * 65], s[1 * 65]); o.y = pk2(s[2 * 65], s[3 * 65]); o.z = pk2(s[4 * 65], s[5 * 65]); o.w = pk2(s[6 * 65], s[7 * 65]);
        int dst = n0 + n; if (winmap) dst = win_row(dst);
        *(u32x4*)(WT + (size_t)(row_off + dst) * ldt + koff + k0 + 8 * c) = o; }
    asm volatile("s_waitcnt lgkmcnt(0)" ::: "memory");
}
template <int R> __device__ __forceinline__ void rms_rows_to_bf16(const float* x, const float* g, bf16_t* H, int m0, int mstride, int lane) {
    f32x4 v[R][4];
#pragma unroll
    for (int r = 0; r < R; ++r)
#pragma unroll
        for (int j = 0; j < 4; ++j) v[r][j] = ((const f32x4*)(x + (size_t)(m0 + r * mstride) * DM))[64 * j + lane];
    f32x4 gg[4];
#pragma unroll
    for (int j = 0; j < 4; ++j) gg[j] = ((const f32x4*)g)[64 * j + lane];
#pragma unroll
    for (int r = 0; r < R; ++r) { float s = 0.f;
#pragma unroll
        for (int j = 0; j < 4; ++j) s += (v[r][j][0] * v[r][j][0] + v[r][j][1] * v[r][j][1]) + (v[r][j][2] * v[r][j][2] + v[r][j][3] * v[r][j][3]);
        const float rstd = 1.f / sqrtf(wave_sum(s) * (1.f / DM) + RMS_EPS);
        u32x2* o8 = (u32x2*)(H + (size_t)(m0 + r * mstride) * DM) + lane;
#pragma unroll
        for (int j = 0; j < 4; ++j) { u32x2 w; w.x = pk2(v[r][j][0] * rstd * gg[j][0], v[r][j][1] * rstd * gg[j][1]); w.y = pk2(v[r][j][2] * rstd * gg[j][2], v[r][j][3] * rstd * gg[j][3]); o8[64 * j] = w; } }
}

__device__ __forceinline__ int crow(int r, int hi) { return (r & 3) + 8 * (r >> 2) + 4 * hi; }
constexpr int VROW = 144;
__device__ __forceinline__ void attn_item(int item, const bf16_t* Q, const bf16_t* K, const bf16_t* V, bf16_t* SG, LAS unsigned char* vl, int lane) {
    const int qg = item & 127, h = (item >> 7) & 7, b = item >> 10;
    const int r32 = lane & 31, hi = lane >> 5, t0 = qg * 32;
    const size_t tokq = (size_t)b * SEQ + t0 + r32;
    bf16x8 qf[4];
#pragma unroll
    for (int d0 = 0; d0 < 4; ++d0) qf[d0] = *(const bf16x8*)(Q + tokq * 512 + h * 64 + d0 * 16 + 8 * hi);
    f32x16 o0, o1;
#pragma unroll
    for (int r = 0; r < 16; ++r) { o0[r] = 0.f; o1[r] = 0.f; }
    float P = 1.f;
    const int i16 = lane & 15, G4 = lane >> 4;
    const int vb = (4 * (G4 >> 1) + (i16 >> 2)) * VROW + (16 * (G4 & 1) + 4 * (i16 & 3)) * 2;
    for (int s0 = t0; s0 >= 0; s0 -= 32) {
        const size_t tokk = (size_t)b * SEQ + s0;
        bf16x8 kf[4];
#pragma unroll
        for (int d0 = 0; d0 < 4; ++d0) kf[d0] = *(const bf16x8*)(K + (tokk + r32) * 512 + h * 64 + d0 * 16 + 8 * hi);
#pragma unroll
        for (int p = 0; p < 4; ++p) { const int idx = p * 64 + lane, key = idx >> 3, ch = idx & 7;
            const u32x4 v = *(const u32x4*)(V + (tokk + key) * 512 + h * 64 + ch * 8);
            *(LAS u32x4*)(vl + key * VROW + ch * 16) = v; }
        f32x16 s;
#pragma unroll
        for (int r = 0; r < 16; ++r) s[r] = 0.f;
#pragma unroll
        for (int d0 = 0; d0 < 4; ++d0) s = __builtin_amdgcn_mfma_f32_32x32x16_bf16(kf[d0], qf[d0], s, 0, 0, 0);
        const bool diag = (s0 == t0);
        float kp[16];
#pragma unroll
        for (int r = 0; r < 16; ++r) { const float e = __builtin_amdgcn_exp2f(s[r] * (0.125f * 1.4426950408889634f)); float k = __builtin_amdgcn_rcpf(1.f + e);
            if (diag && crow(r, hi) >= r32) k = 1.f; kp[r] = k; }
        float Gm[4], Go[4], T[4], R[4], C[4];
#pragma unroll
        for (int g = 0; g < 4; ++g) { Gm[g] = (kp[4 * g] * kp[4 * g + 1]) * (kp[4 * g + 2] * kp[4 * g + 3]); Go[g] = __shfl_xor(Gm[g], 32); T[g] = Gm[g] * Go[g]; }
        R[3] = P; R[2] = R[3] * T[3]; R[1] = R[2] * T[2]; R[0] = R[1] * T[1]; const float Cout = R[0] * T[0];
#pragma unroll
        for (int g = 0; g < 4; ++g) C[g] = hi ? R[g] : R[g] * Go[g];
        float w[16];
#pragma unroll
        for (int g = 0; g < 4; ++g) { const float p3 = C[g], p2 = p3 * kp[4 * g + 3], p1 = p2 * kp[4 * g + 2], p0 = p1 * kp[4 * g + 1], pe = p0 * kp[4 * g];
            w[4 * g + 3] = p3 - p2; w[4 * g + 2] = p2 - p1; w[4 * g + 1] = p1 - p0; w[4 * g] = p0 - pe; }
        bf16x8 wf[2];
#pragma unroll
        for (int st = 0; st < 2; ++st) { u32x4 t; t.x = pk2(w[8 * st], w[8 * st + 1]); t.y = pk2(w[8 * st + 2], w[8 * st + 3]); t.z = pk2(w[8 * st + 4], w[8 * st + 5]); t.w = pk2(w[8 * st + 6], w[8 * st + 7]); wf[st] = __builtin_bit_cast(bf16x8, t); }
#pragma unroll
        for (int dt = 0; dt < 2; ++dt)
#pragma unroll
            for (int st = 0; st < 2; ++st) {
                const s16x4 lo = __builtin_amdgcn_ds_read_tr16_b64_v4i16((LAS s16x4*)(vl + vb + (16 * st) * VROW + dt * 64));
                const s16x4 hh = __builtin_amdgcn_ds_read_tr16_b64_v4i16((LAS s16x4*)(vl + vb + (16 * st + 8) * VROW + dt * 64));
                const bf16x8 vf = (bf16x8){lo[0], lo[1], lo[2], lo[3], hh[0], hh[1], hh[2], hh[3]};
                if (dt == 0) o0 = __builtin_amdgcn_mfma_f32_32x32x16_bf16(vf, wf[st], o0, 0, 0, 0); else o1 = __builtin_amdgcn_mfma_f32_32x32x16_bf16(vf, wf[st], o1, 0, 0, 0); }
        P = Cout;
        if (__all(P < 1.17549435e-38f)) break;
    }
#pragma unroll
    for (int dt = 0; dt < 2; ++dt)
#pragma unroll
        for (int g = 0; g < 4; ++g) { bf16_t* p = SG + tokq * 1536 + h * 64 + dt * 32 + 8 * g + 4 * hi; const u32x2 sg = *(const u32x2*)p;
            const f32x16& o = dt ? o1 : o0; u32x2 y;
            y.x = pk2(o[4 * g] * bflo(sg.x), o[4 * g + 1] * bfhi(sg.x)); y.y = pk2(o[4 * g + 2] * bflo(sg.y), o[4 * g + 3] * bfhi(sg.y));
            *(u32x2*)p = y; }
}
__device__ __forceinline__ void pool_item(int pi, const bf16_t* PV, bf16_t* SG, const bf16_t* PT, const float* scale, int lane) {
    const int tile = pi >> 2, g = ((pi & 3) + ((pi >> 2) & 1)) & 3, win = 2 << g;
    const int r32 = lane & 31, hi = lane >> 5, tok = tile * 32 + r32, t = tok & (SEQ - 1);
    const bf16_t* vp = PV + (size_t)tok * 512 + g * 128 + 8 * hi;
    const int cnt = (t + 1) < win ? (t + 1) : win;
    float sum[8][8];
#pragma unroll
    for (int s = 0; s < 8; ++s) { const u32x4 raw = *(const u32x4*)(vp + 16 * s); const float f = 1.f - (float)cnt;
        sum[s][0] = bflo(raw.x) * f; sum[s][1] = bfhi(raw.x) * f; sum[s][2] = bflo(raw.y) * f; sum[s][3] = bfhi(raw.y) * f;
        sum[s][4] = bflo(raw.z) * f; sum[s][5] = bfhi(raw.z) * f; sum[s][6] = bflo(raw.w) * f; sum[s][7] = bfhi(raw.w) * f; }
    for (int jj = 1; jj < win; ++jj) {
        if (t - jj >= 0) {
#pragma unroll
            for (int s = 0; s < 8; ++s) { const u32x4 raw = *(const u32x4*)(vp - (size_t)jj * 512 + 16 * s);
                sum[s][0] += bflo(raw.x); sum[s][1] += bfhi(raw.x); sum[s][2] += bflo(raw.y); sum[s][3] += bfhi(raw.y);
                sum[s][4] += bflo(raw.z); sum[s][5] += bfhi(raw.z); sum[s][6] += bflo(raw.w); sum[s][7] += bfhi(raw.w); } }
    }
    const float inv = 1.f / (float)cnt;
    bf16x8 pf[8];
#pragma unroll
    for (int s = 0; s < 8; ++s) { u32x4 tt; tt.x = pk2(sum[s][0] * inv, sum[s][1] * inv); tt.y = pk2(sum[s][2] * inv, sum[s][3] * inv); tt.z = pk2(sum[s][4] * inv, sum[s][5] * inv); tt.w = pk2(sum[s][6] * inv, sum[s][7] * inv); pf[s] = __builtin_bit_cast(bf16x8, tt); }
#pragma unroll
    for (int nt = 0; nt < 4; ++nt) {
        f32x16 acc;
#pragma unroll
        for (int r = 0; r < 16; ++r) acc[r] = 0.f;
        const bf16_t* ap = PT + (size_t)(g * 128 + nt * 32 + r32) * 128 + 8 * hi;
#pragma unroll
        for (int s = 0; s < 8; ++s) { const bf16x8 a = *(const bf16x8*)(ap + 16 * s); acc = __builtin_amdgcn_mfma_f32_32x32x16_bf16(a, pf[s], acc, 0, 0, 0); }
#pragma unroll
        for (int q = 0; q < 4; ++q) { const int d = g * 128 + nt * 32 + 8 * q + 4 * hi; const f32x4 sc = *(const f32x4*)(scale + d);
            bf16_t* p = SG + (size_t)tok * 1536 + d; const u32x2 sg = *(const u32x2*)p; u32x2 y;
            y.x = pk2(acc[4 * q] * sc[0] * bflo(sg.x), acc[4 * q + 1] * sc[1] * bfhi(sg.x)); y.y = pk2(acc[4 * q + 2] * sc[2] * bflo(sg.y), acc[4 * q + 3] * sc[3] * bfhi(sg.y));
            *(u32x2*)p = y; }
    }
}
__device__ __forceinline__ void conv_item(int ci, const bf16_t* Z, bf16_t* Wy, const float* cw, const float* cb, int lane) {
    const int tok0 = ci * 8, t0 = tok0 & (SEQ - 1), ch = lane * 8;
    float w0[8], w1[8], w2[8], bs[8], zm2[8], zm1[8];
#pragma unroll
    for (int hf = 0; hf < 2; ++hf) { const f32x4 a = *(const f32x4*)(cw + ch + 4 * hf), b = *(const f32x4*)(cw + 512 + ch + 4 * hf), c = *(const f32x4*)(cw + 1024 + ch + 4 * hf), d = *(const f32x4*)(cb + ch + 4 * hf);
#pragma unroll
        for (int i = 0; i < 4; ++i) { w0[4 * hf + i] = a[i]; w1[4 * hf + i] = b[i]; w2[4 * hf + i] = c[i]; bs[4 * hf + i] = d[i]; } }
#pragma unroll
    for (int i = 0; i < 8; ++i) { zm2[i] = 0.f; zm1[i] = 0.f; }
    if (t0 != 0) { const u32x4 a = *(const u32x4*)(Z + (size_t)(tok0 - 2) * 512 + ch), b = *(const u32x4*)(Z + (size_t)(tok0 - 1) * 512 + ch);
        zm2[0] = bflo(a.x); zm2[1] = bfhi(a.x); zm2[2] = bflo(a.y); zm2[3] = bfhi(a.y); zm2[4] = bflo(a.z); zm2[5] = bfhi(a.z); zm2[6] = bflo(a.w); zm2[7] = bfhi(a.w);
        zm1[0] = bflo(b.x); zm1[1] = bfhi(b.x); zm1[2] = bflo(b.y); zm1[3] = bfhi(b.y); zm1[4] = bflo(b.z); zm1[5] = bfhi(b.z); zm1[6] = bflo(b.w); zm1[7] = bfhi(b.w); }
#pragma unroll
    for (int r = 0; r < 8; ++r) { const size_t off = (size_t)(tok0 + r) * 512 + ch, offw = (size_t)(tok0 + r) * 1536 + ch; const u32x4 zr = *(const u32x4*)(Z + off), wr_ = *(const u32x4*)(Wy + offw);
        float zc[8], wv[8], y[8];
        zc[0] = bflo(zr.x); zc[1] = bfhi(zr.x); zc[2] = bflo(zr.y); zc[3] = bfhi(zr.y); zc[4] = bflo(zr.z); zc[5] = bfhi(zr.z); zc[6] = bflo(zr.w); zc[7] = bfhi(zr.w);
        wv[0] = bflo(wr_.x); wv[1] = bfhi(wr_.x); wv[2] = bflo(wr_.y); wv[3] = bfhi(wr_.y); wv[4] = bflo(wr_.z); wv[5] = bfhi(wr_.z); wv[6] = bflo(wr_.w); wv[7] = bfhi(wr_.w);
#pragma unroll
        for (int i = 0; i < 8; ++i) { y[i] = wv[i] * (w0[i] * zm2[i] + w1[i] * zm1[i] + w2[i] * zc[i] + bs[i]); zm2[i] = zm1[i]; zm1[i] = zc[i]; }
        u32x4 o; o.x = pk2(y[0], y[1]); o.y = pk2(y[2], y[3]); o.z = pk2(y[4], y[5]); o.w = pk2(y[6], y[7]);
        *(u32x4*)(Wy + offw) = o; }
}
template <int R> __device__ __forceinline__ void norm_rows(const float* F32T, const float* RS, const float* xin, const float* gpost, float* xout, const float* gnext, bf16_t* H, int m0, int mstride, int lane) {
    f32x4 o[R][4], xi[R][4]; float ss[R];
#pragma unroll
    for (int r = 0; r < R; ++r) { const size_t row = (size_t)(m0 + r * mstride); ss[r] = (lane < 16) ? RS[row * 16 + lane] : 0.f;
#pragma unroll
        for (int j = 0; j < 4; ++j) { o[r][j] = ((const f32x4*)(F32T + row * DM))[64 * j + lane]; xi[r][j] = ((const f32x4*)(xin + row * DM))[64 * j + lane]; } }
    f32x4 gp[4];
#pragma unroll
    for (int j = 0; j < 4; ++j) gp[j] = ((const f32x4*)gpost)[64 * j + lane];
#pragma unroll
    for (int r = 0; r < R; ++r) { const size_t row = (size_t)(m0 + r * mstride);
        const float rstd = 1.f / sqrtf(wave_sum(ss[r]) * (1.f / DM) + RMS_EPS); float s2 = 0.f;
#pragma unroll
        for (int j = 0; j < 4; ++j) { const f32x4 v = xi[r][j] + o[r][j] * rstd * gp[j]; xi[r][j] = v; ((f32x4*)(xout + row * DM))[64 * j + lane] = v; s2 += (v[0] * v[0] + v[1] * v[1]) + (v[2] * v[2] + v[3] * v[3]); }
        if (gnext) { const float r2 = 1.f / sqrtf(wave_sum(s2) * (1.f / DM) + RMS_EPS);
#pragma unroll
            for (int j = 0; j < 4; ++j) { const f32x4 gg = ((const f32x4*)gnext)[64 * j + lane]; const f32x4 v = xi[r][j]; u32x2 w; w.x = pk2(v[0] * r2 * gg[0], v[1] * r2 * gg[1]); w.y = pk2(v[2] * r2 * gg[2], v[3] * r2 * gg[3]); ((u32x2*)(H + row * DM))[64 * j + lane] = w; } } }
}

struct Args { const float* in[10]; float* out; unsigned char* ws; int ph_lo, ph_hi; };
#define ARGP() ({ const Args* p_ = ap0; asm volatile("" : "+s"(p_)); p_; })
template <int ph> __device__ __forceinline__ void run_phase(const Args* ap0, LAS unsigned char* lds) {
        const Args* A = ARGP();
        const int tid = threadIdx.x, lane = tid & 63, wave = __builtin_amdgcn_readfirstlane(tid >> 6);
        const int G = gridDim.x, bx = blockIdx.x;
        const int vcu = (G % 8 == 0) ? (bx % 8) * (G / 8) + bx / 8 : bx;
        const int gw = vcu * 8 + wave, NGW = G * 8;
        unsigned char* ws = A->ws;
        bf16_t* H = (bf16_t*)(ws + WS_H); bf16_t* U = (bf16_t*)(ws + WS_U);
        if constexpr (ph == 0) {
            const float* x = A->in[0]; const float* pre_g = A->in[1]; const float* w_in = A->in[2]; const float* pool_w = A->in[3]; const float* w_branch = A->in[7]; const float* w_out = A->in[8];
            bf16_t* W1 = (bf16_t*)(ws + WS_W1); bf16_t* W2 = (bf16_t*)(ws + WS_W2); bf16_t* W3 = (bf16_t*)(ws + WS_W3); bf16_t* PW = (bf16_t*)(ws + WS_PW);
            LAS float* scr = (LAS float*)(lds + wave * 17408);
            constexpr int I1 = (DM / 64) * (NIN / 64), I2 = (BWID / 64) * (DM / 64), I3 = (DM / 64) * (DM / 64), I4 = 2 * 2, PER = I1 + 3 * I2 + I3 + 4 * I4;
            for (int it = gw; it < NLAYER * PER; it += NGW) {
                const int l = it / PER; int r = it % PER;
                if (r < I1) { transpose_item(w_in + (size_t)l * DM * NIN, NIN, W1 + (size_t)l * NIN * DM, DM, 0, 0, true, scr, r, lane); continue; } r -= I1;
                if (r < 3 * I2) { const int n = r / I2; transpose_item(w_branch + ((size_t)l * 3 + n) * BWID * DM, DM, W2 + (size_t)l * 3 * DM * BWID, 3 * BWID, n * BWID, 0, false, scr, r % I2, lane); continue; } r -= 3 * I2;
                if (r < I3) { transpose_item(w_out + (size_t)l * DM * DM, DM, W3 + (size_t)l * DM * DM, DM, 0, 0, false, scr, r, lane); continue; } r -= I3;
                { const int g = r / I4; transpose_item(pool_w + ((size_t)l * 4 + g) * 128 * 128, 128, PW + ((size_t)l * 4 + g) * 128 * 128, 128, 0, 0, false, scr, r % I4, lane); }
            }
            for (int m = gw; m < MTOK; m += 2 * NGW) rms_rows_to_bf16<2>(x, pre_g, H, m, NGW, lane);
        } else {
            constexpr int l = (ph - 1) / 5, k = (ph - 1) % 5;
            if constexpr (k == 0) {
                pg8::Gemm g{H, (bf16_t*)(ws + WS_W1) + (size_t)l * NIN * DM, MTOK, NIN, DM, 0}; pg8::StaticOrder S; S.init(MTOK, NIN, G, bx);
                EpiU E{ws};
                pg8::gemm_phase<EpiU, pg8::StaticOrder, true, true>(lds, g, S, E);
            } else if constexpr (k == 1) {
                const float* pool_scale = A->in[4]; const float* conv_w = A->in[5]; const float* conv_b = A->in[6];
                const bf16_t* PW = (const bf16_t*)(ws + WS_PW);
                const bf16_t* Q = U + 2 * (ARRB / 2); const bf16_t* Kk = U + 3 * (ARRB / 2); const bf16_t* V = U + 4 * (ARRB / 2);
                LAS unsigned char* vl = lds + wave * (32 * VROW);
                for (int it = gw; it < NB * 8 * 128; it += NGW) attn_item(it, Q, Kk, V, U + 5 * (ARRB / 2) + 1024, vl, lane);
                for (int it = gw; it < (MTOK / 32) * 4; it += NGW) pool_item(it, U, U + 5 * (ARRB / 2), PW + (size_t)l * 4 * 128 * 128, pool_scale + l * BWID, lane);
                for (int it = gw; it < MTOK / 8; it += NGW) conv_item(it, U + 1 * (ARRB / 2), U + 5 * (ARRB / 2) + 512, conv_w + l * 3 * BWID, conv_b + l * BWID, lane);
            } else if constexpr (k == 2) {
                pg8::Gemm g{U + 5 * (ARRB / 2), (bf16_t*)(ws + WS_W2) + (size_t)l * 3 * DM * BWID, MTOK, DM, 3 * BWID, 0}; pg8::StaticOrder S; S.init(MTOK, DM, G, bx);
                EpiBranch E{ws};
                pg8::gemm_phase<EpiBranch, pg8::StaticOrder, true, true>(lds, g, S, E);
            } else if constexpr (k == 3) {
                pg8::Gemm g{H, (bf16_t*)(ws + WS_W3) + (size_t)l * DM * DM, MTOK, DM, DM, 0}; pg8::StaticOrder S; S.init(MTOK, DM, G, bx);
                EpiOut E{ws};
                pg8::gemm_phase<EpiOut, pg8::StaticOrder, true, true>(lds, g, S, E);
            } else {
                const float* x = A->in[0]; const float* pre_g = A->in[1]; const float* post_g = A->in[9]; float* out = A->out;
                const float* F32T = (const float*)(ws + WS_U); const float* RS = (const float*)(ws + WS_RS);
                const float* xin = (l == 0) ? x : out; const float* gnext = (l + 1 < NLAYER) ? pre_g + (l + 1) * DM : nullptr;
                for (int m = gw; m < MTOK; m += 2 * NGW) norm_rows<2>(F32T, RS, xin, post_g + l * DM, out, gnext, H, m, NGW, lane);
            }
        }
}
__global__ void __launch_bounds__(512, 2) hybrid_fwd(Args a_) {
    extern __shared__ __attribute__((aligned(16))) unsigned char lds_raw[];
    LAS unsigned char* lds = (LAS unsigned char*)lds_raw;
    const Args* ap0 = (const Args*)__builtin_amdgcn_kernarg_segment_ptr();
    cg::grid_group grid = cg::this_grid();
    if (threadIdx.x < 64) ((LAS unsigned*)(lds + 147200))[threadIdx.x] = 0u;
    __syncthreads();
    (void)xcd_barrier_post((unsigned*)(ARGP()->ws + WS_CTL), (volatile LAS unsigned*)(lds + 147200 + 32));
#define SEAM_BAR() do { XcdBarrier b_; b_.bar = (unsigned*)(ARGP()->ws + WS_CTL); b_.x = xb_xcc_id(); b_.st = (volatile LAS unsigned*)(lds + 147200 + 32); xcd_barrier(b_); } while (0)
    const int lo = ARGP()->ph_lo, hi = ARGP()->ph_hi;
#define PHASE(k) if (lo <= (k) && (k) < hi) { if ((k) > lo) { if ((k) == 1 && lo < 0) grid.sync(); else SEAM_BAR(); } run_phase<(k)>(ap0, lds); }
    PHASE(0) PHASE(1) PHASE(2) PHASE(3) PHASE(4) PHASE(5) PHASE(6) PHASE(7) PHASE(8) PHASE(9) PHASE(10)
#undef PHASE
}

extern "C" void kernel_launch(void* const* d_in, const int* in_sizes, int n_in, void* d_out, int out_size, void* d_ws, size_t ws_size, hipStream_t stream) {
    static int grid = 0;
    if (grid == 0) {
        if (n_in != 10 || out_size != MTOK * DM || ws_size < WS_END) { fprintf(stderr, "kernel_launch: unexpected shapes / workspace (n_in %d out %d ws %zu)\n", n_in, out_size, ws_size); grid = -1; return; }
        int dev = 0, cus = 0, per_cu = 0;
        (void)hipGetDevice(&dev); (void)hipDeviceGetAttribute(&cus, hipDeviceAttributeMultiprocessorCount, dev);
        (void)hipFuncSetAttribute((const void*)hybrid_fwd, hipFuncAttributeMaxDynamicSharedMemorySize, LDS_BYTES);
        (void)hipOccupancyMaxActiveBlocksPerMultiprocessor(&per_cu, (const void*)hybrid_fwd, 512, LDS_BYTES);
        (void)hipGetLastError();
        if (per_cu < 1) { fprintf(stderr, "kernel_launch: occupancy query says %d blocks/CU\n", per_cu); per_cu = 1; }
        grid = cus;
    }
    if (grid < 0) return;
    if (hipMemsetAsync((char*)d_ws + WS_CTL, 0, CTL_BYTES, stream) != hipSuccess) { fprintf(stderr, "kernel_launch: memset of the barrier words failed\n"); return; }
    Args a{};
    for (int i = 0; i < 10; ++i) a.in[i] = (const float*)d_in[i];
    a.out = (float*)d_out; a.ws = (unsigned char*)d_ws;
#if ONE_LAUNCH
    a.ph_lo = 0; a.ph_hi = NPHASE;
    void* args[] = {&a};
    hipError_t e = hipLaunchCooperativeKernel((const void*)hybrid_fwd, dim3(grid), dim3(512), args, LDS_BYTES, stream);
    if (e != hipSuccess) fprintf(stderr, "cooperative launch failed: %s (grid %d)\n", hipGetErrorString(e), grid);
#else
    for (int ph = 0; ph < NPHASE; ++ph) { a.ph_lo = ph; a.ph_hi = ph + 1; for (int rep = 0; rep < 1 + ((DUP_MASK >> ph) & 1); ++rep) hipLaunchKernelGGL(hybrid_fwd, dim3(grid), dim3(512), LDS_BYTES, stream, a); }
#endif
}
```

```cpp
#include <hip/hip_runtime.h>
#include <hip/hip_cooperative_groups.h>
#include <cstdio>
#include <cstdint>
namespace cg = cooperative_groups;
#ifndef ONE_LAUNCH
#define ONE_LAUNCH 1
#endif
#ifndef DUP_MASK
#define DUP_MASK 0
#endif
namespace pg8 {
#define PG8_LAS __attribute__((address_space(3)))
typedef unsigned short bf16_t;
typedef short bf16x8 __attribute__((ext_vector_type(8)));
typedef float f32x4 __attribute__((ext_vector_type(4)));
typedef unsigned u32x4 __attribute__((ext_vector_type(4)));
constexpr int BM = 256, BK = 64, HALF = 128, HTB = HALF * BK * 2  , STAGE_BYTES = 8 * HTB, NXCD = 8, WGM = 8;

__host__ __device__ __forceinline__ int lds_byte(int r, int c) { const int st = (r >> 4) * 2 + (c >> 5), rr = r & 15, cc = c & 31, ob = rr * 64 + cc * 2; return st * 1024 + (ob ^ (((ob >> 9) & 1) << 5)); }
__host__ __device__ __forceinline__ void stage_rc(int b, int& R, int& C) { const int st = b / 1024, sb = b % 1024, swz = sb ^ (((sb >> 9) & 1) << 5); R = (st >> 1) * 16 + swz / 64; C = (st & 1) * 32 + (swz % 64) / 2; }
__host__ __device__ __forceinline__ int perm32(int rho) { const int n = rho >> 4, i = rho & 15; return 8 * (i >> 2) + 4 * n + (i & 3); }

struct Unit { int pm, pn, az; };
struct Gemm { const bf16_t* A; const bf16_t* Bt; int M, N, K; size_t azs; };

struct StaticOrder {
    int nM, nN, nwg, G, c;
    __host__ __device__ void init(int M, int N, int G_, int c_) { nM = M / BM; nN = N / BM; nwg = nM * nN; G = G_; c = c_; }
    __host__ __device__ bool next(int i, Unit& u) const {
        const long L = (long)i * G + c; if (L >= nwg) return false;
        int wgid = (int)L; { const int q = nwg / NXCD, r = nwg % NXCD, xcd = wgid % NXCD, off = wgid / NXCD; wgid = (xcd < r ? xcd * (q + 1) : r * (q + 1) + (xcd - r) * q) + off; }
        const int nig = WGM * nN, gid = wgid / nig, fm = gid * WGM, gsz = (nM - fm) < WGM ? (nM - fm) : WGM;
        u.pm = fm + ((wgid % nig) % gsz); u.pn = (wgid % nig) / gsz; u.az = 0; return true;
    }
    __device__ __forceinline__ void a_ready(const Unit&) const {}
    __device__ __forceinline__ void done(const Unit&) const {}
};

__device__ __forceinline__ unsigned cvt_pk_bf16(float lo, float hi) { unsigned r; asm volatile("v_cvt_pk_bf16_f32 %0, %1, %2" : "=v"(r) : "v"(lo), "v"(hi)); return r; }
template <class Epi, class Sched, bool ALIGN_EPI = false, bool SP2 = false>
__device__ __forceinline__ void gemm_phase(PG8_LAS unsigned char* lds, const Gemm g, const Sched& S, const Epi& E) {
    const int tid = threadIdx.x, wid = __builtin_amdgcn_readfirstlane(tid >> 6), lane = tid & 63, wr = wid >> 2, wc = wid & 3, fr = lane & 15, fq = lane >> 4;
    const int K = g.K, nt = K / BK;
    unsigned voffA[2], voffB[2];
#pragma unroll
    for (int i = 0; i < 2; ++i) { int R, C; stage_rc(tid * 16 + i * 8192, R, C); const int Rb = Epi::PERM ? ((R & ~31) + perm32(R & 31)) : R;
        voffA[i] = (unsigned)(R * K + C) * 2u; voffB[i] = (unsigned)(Rb * K + C) * 2u; }
    const size_t kstep = (size_t)(BK * 2);
    const size_t hstep = (size_t)HALF * K * 2;
    const size_t tstep = 2 * hstep;
    const unsigned ldsw = (unsigned)wid * 1024u;
    const int aoff = lds_byte(wr * 64 + fr, fq * 8), boff = lds_byte(wc * 32 + fr, fq * 8);
#define PG8_SA(b, h) (((b) * 2 + (h)) * HTB)
#define PG8_SB(b, h) ((4 + (b) * 2 + (h)) * HTB)
#define PG8_STAGE(bufoff, gbase, voff) do { _Pragma("unroll") for (int _i = 0; _i < 2; ++_i) \
        __builtin_amdgcn_global_load_lds((const unsigned*)((const char*)(gbase) + (voff)[_i]), (PG8_LAS unsigned*)(lds + (bufoff) + ldsw + _i * 8192), 16, 0, 0); } while (0)
#define PG8_LDA(dst, b, h) do { _Pragma("unroll") for (int m = 0; m < 4; ++m) _Pragma("unroll") for (int k = 0; k < 2; ++k) dst[m][k] = *(const PG8_LAS bf16x8*)(lds + PG8_SA(b, h) + aoff + m * 2048 + k * 1024); } while (0)
#define PG8_LDB(dst, b, h) do { _Pragma("unroll") for (int n = 0; n < 2; ++n) _Pragma("unroll") for (int k = 0; k < 2; ++k) dst[n][k] = *(const PG8_LAS bf16x8*)(lds + PG8_SB(b, h) + boff + n * 2048 + k * 1024); } while (0)
#define PG8_MMA(ai, bj, At, Bt) do { __builtin_amdgcn_s_setprio(1); _Pragma("unroll") for (int m = 0; m < 4; ++m) _Pragma("unroll") for (int n = 0; n < 2; ++n) _Pragma("unroll") for (int k = 0; k < 2; ++k) \
        acc[ai][bj][m][n] = __builtin_amdgcn_mfma_f32_16x16x32_bf16(Bt[n][k], At[m][k], acc[ai][bj][m][n], 0, 0, 0); __builtin_amdgcn_s_setprio(0); } while (0)
#define PG8_WAIT_V(n) asm volatile("s_waitcnt vmcnt(" #n ")" ::: "memory")
#define PG8_WAIT_L(n) asm volatile("s_waitcnt lgkmcnt(" #n ")" ::: "memory")
#define PG8_BAR __builtin_amdgcn_s_barrier()
#define PG8_SCHED __builtin_amdgcn_sched_barrier(0)
    Unit cur, nxt; int ui = 0;
    if (!S.next(0, cur)) return;
    f32x4 acc[2][2][4][2];
#pragma unroll
    for (int a = 0; a < 2; ++a)
#pragma unroll
        for (int b = 0; b < 2; ++b)
#pragma unroll
            for (int m = 0; m < 4; ++m)
#pragma unroll
                for (int n = 0; n < 2; ++n) acc[a][b][m][n] = (f32x4){0.f, 0.f, 0.f, 0.f};
    bf16x8 At[4][2], B0[2][2], B1[2][2];
    const char* cA = (const char*)g.A + (size_t)cur.pm * tstep + (size_t)cur.az * g.azs; const char* cB = (const char*)g.Bt + (size_t)cur.pn * tstep;
    S.a_ready(cur);
    if constexpr (SP2) {
        PG8_STAGE(PG8_SB(0, 0), cB, voffB); PG8_STAGE(PG8_SB(0, 1), cB + hstep, voffB); PG8_STAGE(PG8_SA(0, 0), cA, voffA); PG8_STAGE(PG8_SA(0, 1), cA + hstep, voffA);
        if (wr == 1) PG8_BAR;
        PG8_WAIT_V(2); PG8_BAR;
        PG8_STAGE(PG8_SB(1, 0), cB + kstep, voffB); PG8_STAGE(PG8_SA(1, 0), cA + kstep, voffA); PG8_STAGE(PG8_SB(1, 1), cB + hstep + kstep, voffB);
        PG8_WAIT_V(6); PG8_BAR;
    } else {
        PG8_STAGE(PG8_SB(0, 0), cB, voffB); PG8_STAGE(PG8_SA(0, 0), cA, voffA); PG8_STAGE(PG8_SB(0, 1), cB + hstep, voffB); PG8_STAGE(PG8_SA(0, 1), cA + hstep, voffA);
        if (wr == 1) PG8_BAR;
        PG8_WAIT_V(4); PG8_BAR;
        PG8_STAGE(PG8_SB(1, 0), cB + kstep, voffB); PG8_STAGE(PG8_SA(1, 0), cA + kstep, voffA); PG8_STAGE(PG8_SB(1, 1), cB + hstep + kstep, voffB);
        PG8_WAIT_V(6); PG8_BAR;
    }
    for (;;) {
        const bool has_next = S.next(ui + 1, nxt);
        const char* nA = has_next ? (const char*)g.A + (size_t)nxt.pm * tstep + (size_t)nxt.az * g.azs : cA; const char* nB = has_next ? (const char*)g.Bt + (size_t)nxt.pn * tstep : cB;
        for (int t = 0; t < nt; t += 2) {
            if constexpr (Epi::MIDK) { if (t == 8 || t == 16) E.mid(acc, cur, t >> 3, wr, wc, fr, fq); }
            const bool last = (t == nt - 2);
            const char* a1 = cA + (size_t)(t + 1) * kstep;
            const char* a2 = last ? nA : cA + (size_t)(t + 2) * kstep; const char* b2 = last ? nB : cB + (size_t)(t + 2) * kstep;
            const char* a3 = a2 + kstep; const char* b3 = b2 + kstep;
            if (last && has_next) S.a_ready(nxt);
            if constexpr (SP2) {
            PG8_LDB(B0, 0, 0); PG8_LDB(B1, 0, 1); PG8_SCHED; PG8_LDA(At, 0, 0); PG8_STAGE(PG8_SA(1, 1), a1 + hstep, voffA);
            PG8_WAIT_V(8); PG8_WAIT_L(0); PG8_BAR; PG8_MMA(0, 0, At, B0); PG8_MMA(0, 1, At, B1); PG8_BAR; PG8_SCHED;
            PG8_LDA(At, 0, 1); PG8_STAGE(PG8_SB(0, 0), b2, voffB); PG8_STAGE(PG8_SB(0, 1), b2 + hstep, voffB); PG8_STAGE(PG8_SA(0, 0), a2, voffA);
            PG8_WAIT_V(8); PG8_WAIT_L(0); PG8_BAR; PG8_MMA(1, 0, At, B0); PG8_MMA(1, 1, At, B1); PG8_BAR; PG8_SCHED;
            PG8_LDB(B0, 1, 0); PG8_LDB(B1, 1, 1); PG8_SCHED; PG8_LDA(At, 1, 0); PG8_STAGE(PG8_SA(0, 1), a2 + hstep, voffA);
            PG8_WAIT_V(8); PG8_WAIT_L(0); PG8_BAR; PG8_MMA(0, 0, At, B0); PG8_MMA(0, 1, At, B1); PG8_BAR; PG8_SCHED;
            PG8_LDA(At, 1, 1); PG8_STAGE(PG8_SB(1, 0), b3, voffB); PG8_STAGE(PG8_SB(1, 1), b3 + hstep, voffB); PG8_STAGE(PG8_SA(1, 0), a3, voffA);
            PG8_WAIT_V(8); PG8_WAIT_L(0); PG8_BAR; PG8_MMA(1, 0, At, B0); PG8_MMA(1, 1, At, B1); PG8_BAR; PG8_SCHED;
            } else {
            PG8_LDB(B0, 0, 0); PG8_SCHED; PG8_LDA(At, 0, 0); PG8_STAGE(PG8_SA(1, 1), a1 + hstep, voffA);
            PG8_WAIT_L(8); PG8_BAR; PG8_WAIT_L(0); PG8_MMA(0, 0, At, B0); PG8_BAR; PG8_SCHED;
            PG8_LDB(B1, 0, 1); PG8_STAGE(PG8_SB(0, 0), b2, voffB);
            PG8_BAR; PG8_WAIT_L(0); PG8_MMA(0, 1, At, B1); PG8_BAR;
            PG8_LDA(At, 0, 1); PG8_STAGE(PG8_SA(0, 0), a2, voffA);
            PG8_BAR; PG8_WAIT_L(0); PG8_MMA(1, 0, At, B0); PG8_BAR; PG8_SCHED;
            PG8_STAGE(PG8_SB(0, 1), b2 + hstep, voffB);
            PG8_WAIT_V(6); PG8_BAR; PG8_MMA(1, 1, At, B1); PG8_BAR;
            PG8_LDB(B0, 1, 0); PG8_SCHED; PG8_LDA(At, 1, 0); PG8_STAGE(PG8_SA(0, 1), a2 + hstep, voffA);
            PG8_WAIT_L(8); PG8_BAR; PG8_WAIT_L(0); PG8_MMA(0, 0, At, B0); PG8_BAR; PG8_SCHED;
            PG8_LDB(B1, 1, 1); PG8_STAGE(PG8_SB(1, 0), b3, voffB);
            PG8_BAR; PG8_WAIT_L(0); PG8_MMA(0, 1, At, B1); PG8_BAR;
            PG8_LDA(At, 1, 1); PG8_STAGE(PG8_SA(1, 0), a3, voffA);
            PG8_BAR; PG8_WAIT_L(0); PG8_MMA(1, 0, At, B0); PG8_BAR; PG8_SCHED;
            PG8_STAGE(PG8_SB(1, 1), b3 + hstep, voffB);
            PG8_WAIT_V(6); PG8_BAR; PG8_MMA(1, 1, At, B1); PG8_BAR;
            }
        }
        if constexpr (ALIGN_EPI) { if (wr == 0) PG8_BAR; }
        if constexpr (!Epi::AFTER_DRAIN) { E(acc, cur, wr, wc, fr, fq); S.done(cur); }
        if (!has_next) break;
#pragma unroll
        for (int a = 0; a < 2; ++a)
#pragma unroll
            for (int b = 0; b < 2; ++b)
#pragma unroll
                for (int m = 0; m < 4; ++m)
#pragma unroll
                    for (int n = 0; n < 2; ++n) acc[a][b][m][n] = (f32x4){0.f, 0.f, 0.f, 0.f};
        cur = nxt; cA = nA; cB = nB; ++ui;
        if constexpr (ALIGN_EPI) { if (wr == 1) PG8_BAR; }
    }
    PG8_WAIT_V(0);
    if constexpr (!ALIGN_EPI) { if (wr == 0) PG8_BAR; }
    PG8_BAR;
    if constexpr (Epi::AFTER_DRAIN) { E.fused(acc, cur, wr, wc, fr, fq, lds, wid, lane); S.done(cur); }
#undef PG8_SA
#undef PG8_SB
#undef PG8_STAGE
#undef PG8_LDA
#undef PG8_LDB
#undef PG8_MMA
#undef PG8_WAIT_V
#undef PG8_WAIT_L
#undef PG8_BAR
#undef PG8_SCHED
}
}

#define LAS __attribute__((address_space(3)))
typedef unsigned short bf16_t;
typedef short bf16x8 __attribute__((ext_vector_type(8)));
typedef short s16x4 __attribute__((ext_vector_type(4)));
typedef float f32x4 __attribute__((ext_vector_type(4)));
typedef float f32x16 __attribute__((ext_vector_type(16)));
typedef unsigned u32x4 __attribute__((ext_vector_type(4)));
typedef unsigned u32x2 __attribute__((ext_vector_type(2)));
constexpr int NB = 4, SEQ = 4096, DM = 1024, MTOK = NB * SEQ, NIN = 8192, BWID = 512, NLAYER = 2;
constexpr float RMS_EPS = 1e-6f;
constexpr size_t MiB = 1u << 20;
constexpr size_t WS_RS = 0;
constexpr size_t WS_W1 = 2 * MiB;
constexpr size_t WS_W2 = 34 * MiB;
constexpr size_t WS_W3 = 40 * MiB;
constexpr size_t WS_PW = 44 * MiB;
constexpr size_t WS_H = 45 * MiB;
constexpr size_t WS_U = 77 * MiB;
constexpr size_t ARRB = 16 * MiB;
constexpr size_t WS_MG = 205 * MiB;
constexpr size_t WS_END = 253 * MiB;
constexpr int LDS_BYTES = 147456;
constexpr int NPHASE = 1 + 5 * NLAYER;

__device__ __forceinline__ unsigned f2bf(float f) { unsigned u = __builtin_bit_cast(unsigned, f); return (u + 0x7fffu + ((u >> 16) & 1u)) >> 16; }
__device__ __forceinline__ unsigned pk2(float lo, float hi) { return f2bf(lo) | (f2bf(hi) << 16); }
__device__ __forceinline__ float bflo(unsigned u) { return __builtin_bit_cast(float, u << 16); }
__device__ __forceinline__ float bfhi(unsigned u) { return __builtin_bit_cast(float, u & 0xffff0000u); }
__device__ __forceinline__ float sigmoid_f(float x) { return __builtin_amdgcn_rcpf(1.f + __builtin_amdgcn_exp2f(-1.4426950408889634f * x)); }
__device__ __forceinline__ float silu_f(float x) { return x * sigmoid_f(x); }
__device__ __forceinline__ unsigned q8(float x) { const unsigned q = (unsigned)(sigmoid_f(x) * 255.f + 0.5f); return q < 1u ? 1u : q; }
__device__ __forceinline__ float wave_sum(float v) {
#pragma unroll
    for (int o = 1; o < 64; o <<= 1) v += __shfl_xor(v, o);
    return v;
}

constexpr size_t WS_CTL = 1 * MiB; constexpr size_t CTL_BYTES = 65536;
constexpr size_t CTL_CNT = 16384;
#define XB_TMO      128
#define XB_XCNT(j)  (256  + 64 * (j))
#define XB_XSUB(j)  (1280 + 64 * (j))
#define XB_XGEN(j)  (2304 + 64 * (j))
#define XB_TOP      3328
#define XB_TOPGEN   3392
#define XCD_BAR_WORDS 3456
#define XB_SPIN_CAP (1u << 18)

__device__ __forceinline__ unsigned xb_ld(unsigned* p)              { return __hip_atomic_load(p, __ATOMIC_RELAXED, __HIP_MEMORY_SCOPE_AGENT); }
__device__ __forceinline__ unsigned xb_add(unsigned* p, unsigned v) { return __hip_atomic_fetch_add(p, v, __ATOMIC_RELAXED, __HIP_MEMORY_SCOPE_AGENT); }
__device__ __forceinline__ unsigned xb_xcc_id() { return (unsigned)__builtin_amdgcn_s_getreg((3 << 11) | 20) & 0xFu; }
#define XB_SPIN(cond, bar) do { unsigned _sp = 0; while (cond) { __builtin_amdgcn_s_sleep(1); \
    if ((++_sp & 255u) == 0u) { if (xb_ld(&(bar)[XB_TMO])) break; if (_sp > XB_SPIN_CAP) { atomicAdd(&(bar)[XB_TMO], 1u); break; } } } } while (0)

struct XcdBarrier {
    unsigned* bar; unsigned x;
    volatile LAS unsigned* st;
};

__device__ __forceinline__ XcdBarrier xcd_barrier_post(unsigned* bar, volatile LAS unsigned* st) {
    XcdBarrier b; b.bar = bar; b.x = xb_xcc_id(); b.st = st;
    if (threadIdx.x == 0) (void)xb_add(&bar[XB_XCNT(b.x)], 1u);
    return b;
}
__device__ __forceinline__ void xcd_barrier_complete(unsigned* bar, unsigned x, unsigned& nloc, unsigned& nx) {
    const unsigned G = gridDim.x * gridDim.y * gridDim.z;
    unsigned sum, cnt, mine, sp = 0u;
    for (;;) {
        sum = 0u; cnt = 0u; mine = 0u;
#pragma unroll
        for (unsigned j = 0; j < 16; ++j) { const unsigned c = xb_ld(&bar[XB_XCNT(j)]); sum += c; cnt += (c > 0u) ? 1u : 0u; mine = (j == x) ? c : mine; }
        if (sum == G) break;
        __builtin_amdgcn_s_sleep(1);
        if ((++sp & 255u) == 0u) { if (xb_ld(&bar[XB_TMO])) break; if (sp > XB_SPIN_CAP) { atomicAdd(&bar[XB_TMO], 1u); break; } }
    }
    nloc = mine > 0u ? mine : 1u; nx = cnt > 0u ? cnt : 1u;
}

__device__ __forceinline__ void xcd_barrier(const XcdBarrier& b) {
    asm volatile("s_waitcnt vmcnt(0)" ::: "memory");
    __syncthreads();
    if (threadIdx.x == 0) {
        unsigned* bar = b.bar;
        __builtin_amdgcn_s_waitcnt(0);
        unsigned nloc = b.st[0], nx = b.st[1];
        if (nloc == 0u) { xcd_barrier_complete(bar, b.x, nloc, nx); b.st[0] = nloc; b.st[1] = nx; }
        const unsigned old = xb_add(&bar[XB_XSUB(b.x)], 1u);
        const unsigned gen = old / nloc;
        if (old + 1u == (gen + 1u) * nloc) {
            __builtin_amdgcn_fence(__ATOMIC_RELEASE, "agent");
            asm volatile("s_waitcnt vmcnt(0)" ::: "memory");
            const unsigned og = xb_add(&bar[XB_TOP], 1u);
            const unsigned tg = og / nx;
            if (og + 1u == (tg + 1u) * nx) xb_add(&bar[XB_TOPGEN], 1u);
            else XB_SPIN(xb_ld(&bar[XB_TOPGEN]) == tg, bar);
            __builtin_amdgcn_fence(__ATOMIC_ACQUIRE, "agent");
            xb_add(&bar[XB_XGEN(b.x)], 1u);
            asm volatile("s_waitcnt vmcnt(0)" ::: "memory");
        } else {
            XB_SPIN(xb_ld(&bar[XB_XGEN(b.x)]) == gen, bar);
            __builtin_amdgcn_fence(__ATOMIC_ACQUIRE, "agent");
            asm volatile("s_waitcnt vmcnt(0)" ::: "memory");
        }
    }
    __syncthreads();
}


using pg8::Unit;
struct EpiU {
    static constexpr bool PERM = true, AFTER_DRAIN = false, MIDK = false;
    unsigned char* ws;
    __device__ __forceinline__ void operator()(const f32x4 (&acc)[2][2][4][2], const Unit& u, int wr, int wc, int fr, int fq) const {
        bf16_t* U = (bf16_t*)(ws + WS_U); unsigned char* MG = ws + WS_MG;
        const int pn = u.pn; const int row0 = u.pm * 256 + wr * 64 + fr;
        if (pn >= 20) {
            const int mc0 = (pn - 20) * 256 + wc * 32 + 8 * fq;
#pragma unroll
            for (int ai = 0; ai < 2; ++ai)
#pragma unroll
                for (int m = 0; m < 4; ++m) { unsigned char* rp = MG + (size_t)(row0 + ai * 128 + m * 16) * 3072 + mc0;
#pragma unroll
                    for (int bj = 0; bj < 2; ++bj) { const f32x4 v0 = acc[ai][bj][m][0], v1 = acc[ai][bj][m][1]; u32x2 w;
                        w.x = q8(v0[0]) | (q8(v0[1]) << 8) | (q8(v0[2]) << 16) | (q8(v0[3]) << 24); w.y = q8(v1[0]) | (q8(v1[1]) << 8) | (q8(v1[2]) << 16) | (q8(v1[3]) << 24);
                        *(u32x2*)(rp + bj * 128) = w; } }
        } else if (pn >= 4 && pn < 12) {
            const int ch0 = (pn - 4) * 64 + (4 * wc + fq) * 4;
            bf16_t* Z = U + 1 * (ARRB / 2); bf16_t* W = U + 5 * (ARRB / 2) + 512;
#pragma unroll
            for (int ai = 0; ai < 2; ++ai)
#pragma unroll
                for (int m = 0; m < 4; ++m) { const size_t rr = (size_t)(row0 + ai * 128 + m * 16); const size_t ro = rr * 512 + ch0, rw = rr * 1536 + ch0;
                    const f32x4 z = acc[ai][0][m][0] * acc[ai][0][m][1]; const f32x4 gb = acc[ai][1][m][0], gg = acc[ai][1][m][1];
                    u32x2 zz, ww; zz.x = pg8::cvt_pk_bf16(z[0], z[1]); zz.y = pg8::cvt_pk_bf16(z[2], z[3]);
                    ww.x = pg8::cvt_pk_bf16(gb[0] * silu_f(gg[0]), gb[1] * silu_f(gg[1])); ww.y = pg8::cvt_pk_bf16(gb[2] * silu_f(gg[2]), gb[3] * silu_f(gg[3]));
                    *(u32x2*)(Z + ro) = zz; *(u32x2*)(W + rw) = ww; }
        } else {
            const int kind = pn >> 1; int arr = 0, pitch = 512, coff = 0; bool act = false;
            if (kind == 1) { arr = 5; act = true; pitch = 1536; } else if (kind == 6) arr = 2; else if (kind == 7) arr = 3; else if (kind == 8) arr = 4; else if (kind == 9) { arr = 5; act = true; pitch = 1536; coff = 1024; }
            bf16_t* O = U + (size_t)arr * (ARRB / 2) + coff; const int col0 = (pn & 1) * 256 + wc * 32 + 8 * fq;
#pragma unroll
            for (int ai = 0; ai < 2; ++ai)
#pragma unroll
                for (int m = 0; m < 4; ++m) { bf16_t* rp = O + (size_t)(row0 + ai * 128 + m * 16) * pitch + col0;
#pragma unroll
                    for (int bj = 0; bj < 2; ++bj) { f32x4 v0 = acc[ai][bj][m][0], v1 = acc[ai][bj][m][1];
                        if (act) {
#pragma unroll
                            for (int i = 0; i < 4; ++i) { v0[i] = silu_f(v0[i]); v1[i] = silu_f(v1[i]); } }
                        u32x4 w; w.x = pg8::cvt_pk_bf16(v0[0], v0[1]); w.y = pg8::cvt_pk_bf16(v0[2], v0[3]); w.z = pg8::cvt_pk_bf16(v1[0], v1[1]); w.w = pg8::cvt_pk_bf16(v1[2], v1[3]);
                        *(u32x4*)(rp + bj * 128) = w; } }
        }
    }
};
struct EpiBranch {
    static constexpr bool PERM = true, AFTER_DRAIN = false, MIDK = true;
    unsigned char* ws;
    __device__ __forceinline__ void mid(f32x4 (&acc)[2][2][4][2], const Unit& u, int seg, int wr, int wc, int fr, int fq) const {
        int tid_ = threadIdx.x; asm volatile("" : "+v"(tid_));
        const int wid_ = tid_ >> 6, wr_ = wid_ >> 2, wc_ = wid_ & 3, fr_ = tid_ & 15, fq_ = (tid_ & 63) >> 4;
        const unsigned char* MG = ws + WS_MG + (seg - 1) * 1024; const int row0 = u.pm * 256 + wr_ * 64 + fr_, col0 = u.pn * 256 + wc_ * 32 + 8 * fq_;
#pragma unroll
        for (int ai = 0; ai < 2; ++ai)
#pragma unroll
            for (int m = 0; m < 4; ++m) { const unsigned char* rp = MG + (size_t)(row0 + ai * 128 + m * 16) * 3072 + col0;
#pragma unroll
                for (int bj = 0; bj < 2; ++bj) { const u32x2 qa = *(const u32x2*)(rp + bj * 128), qb = *(const u32x2*)(rp + bj * 128 + 1024);
                    f32x4 r0, r1;
                    r0[0] = (float)(qa.x & 255u) * __builtin_amdgcn_rcpf((float)(qb.x & 255u)); r0[1] = (float)((qa.x >> 8) & 255u) * __builtin_amdgcn_rcpf((float)((qb.x >> 8) & 255u));
                    r0[2] = (float)((qa.x >> 16) & 255u) * __builtin_amdgcn_rcpf((float)((qb.x >> 16) & 255u)); r0[3] = (float)(qa.x >> 24) * __builtin_amdgcn_rcpf((float)(qb.x >> 24));
                    r1[0] = (float)(qa.y & 255u) * __builtin_amdgcn_rcpf((float)(qb.y & 255u)); r1[1] = (float)((qa.y >> 8) & 255u) * __builtin_amdgcn_rcpf((float)((qb.y >> 8) & 255u));
                    r1[2] = (float)((qa.y >> 16) & 255u) * __builtin_amdgcn_rcpf((float)((qb.y >> 16) & 255u)); r1[3] = (float)(qa.y >> 24) * __builtin_amdgcn_rcpf((float)(qb.y >> 24));
                    acc[ai][bj][m][0] *= r0; acc[ai][bj][m][1] *= r1; }
                if (m == 3) asm volatile("" ::: "memory"); }
    }
    __device__ __forceinline__ void operator()(const f32x4 (&acc)[2][2][4][2], const Unit& u, int wr, int wc, int fr, int fq) const {
        const unsigned char* MG = ws + WS_MG + 2 * 1024; bf16_t* merged = (bf16_t*)(ws + WS_H);
        const int row0 = u.pm * 256 + wr * 64 + fr, col0 = u.pn * 256 + wc * 32 + 8 * fq;
#pragma unroll
        for (int ai = 0; ai < 2; ++ai)
#pragma unroll
            for (int m = 0; m < 4; ++m) { const size_t row = (size_t)(row0 + ai * 128 + m * 16);
#pragma unroll
                for (int bj = 0; bj < 2; ++bj) { const int col = col0 + bj * 128;
                    const u32x2 gq = *(const u32x2*)(MG + row * 3072 + col);
                    f32x4 g0, g1; const float k = 1.f / 255.f;
                    g0[0] = (float)(gq.x & 255u) * k; g0[1] = (float)((gq.x >> 8) & 255u) * k; g0[2] = (float)((gq.x >> 16) & 255u) * k; g0[3] = (float)(gq.x >> 24) * k;
                    g1[0] = (float)(gq.y & 255u) * k; g1[1] = (float)((gq.y >> 8) & 255u) * k; g1[2] = (float)((gq.y >> 16) & 255u) * k; g1[3] = (float)(gq.y >> 24) * k;
                    const f32x4 v0 = acc[ai][bj][m][0] * g0, v1 = acc[ai][bj][m][1] * g1;
                    u32x4 w; w.x = pg8::cvt_pk_bf16(v0[0], v0[1]); w.y = pg8::cvt_pk_bf16(v0[2], v0[3]); w.z = pg8::cvt_pk_bf16(v1[0], v1[1]); w.w = pg8::cvt_pk_bf16(v1[2], v1[3]);
                    *(u32x4*)(merged + row * 1024 + col) = w; } }
    }
};
struct EpiOut {
    static constexpr bool PERM = false, AFTER_DRAIN = false, MIDK = false;
    unsigned char* ws;
    __device__ __forceinline__ void operator()(const f32x4 (&acc)[2][2][4][2], const Unit& u, int wr, int wc, int fr, int fq) const {
        float* out = (float*)(ws + WS_U); float* rs = (float*)(ws + WS_RS);
        const int row0 = u.pm * 256 + wr * 64 + fr, col0 = u.pn * 256 + wc * 32 + 4 * fq;
#pragma unroll
        for (int ai = 0; ai < 2; ++ai)
#pragma unroll
            for (int m = 0; m < 4; ++m) { const size_t row = (size_t)(row0 + ai * 128 + m * 16); float ss = 0.f;
#pragma unroll
                for (int bj = 0; bj < 2; ++bj)
#pragma unroll
                    for (int n = 0; n < 2; ++n) { const f32x4 v = acc[ai][bj][m][n]; *(f32x4*)(out + row * 1024 + col0 + bj * 128 + n * 16) = v; ss += (v[0] * v[0] + v[1] * v[1]) + (v[2] * v[2] + v[3] * v[3]); }
                ss += __shfl_xor(ss, 16); ss += __shfl_xor(ss, 32);
                if (fq == 0) rs[row * 16 + u.pn * 4 + wc] = ss; }
    }
};

struct RmsPanel {
    float* xbuf;
    unsigned* cnt;
    __device__ __forceinline__ void run(const f32x4 (&v)[2][2][4][2], const Unit& u, int wr, int wc, int fr, int fq, LAS unsigned char* lds, int wid, int lane) const {
        LAS float* P = (LAS float*)lds; LAS float* S = (LAS float*)(lds + 8192);
#pragma unroll
        for (int ai = 0; ai < 2; ++ai)
#pragma unroll
            for (int m = 0; m < 4; ++m) { float s = 0.f;
#pragma unroll
                for (int bj = 0; bj < 2; ++bj)
#pragma unroll
                    for (int n = 0; n < 2; ++n) { const f32x4 x = v[ai][bj][m][n]; s += (x[0] * x[0] + x[1] * x[1]) + (x[2] * x[2] + x[3] * x[3]); }
                s += __shfl_xor(s, 16); s += __shfl_xor(s, 32);
                if (fq == 0) P[(ai * 128 + wr * 64 + m * 16 + fr) * 4 + wc] = s; }
        asm volatile("s_waitcnt lgkmcnt(0)" ::: "memory"); __builtin_amdgcn_s_barrier(); asm volatile("" ::: "memory");
        const int row = wid * 32 + (lane & 31);
        if (lane < 32) { const float t = (P[row * 4 + 0] + P[row * 4 + 1]) + (P[row * 4 + 2] + P[row * 4 + 3]);
            __hip_atomic_store(xbuf + (size_t)(u.pm * 256 + row) * 4 + u.pn, t, __ATOMIC_RELAXED, __HIP_MEMORY_SCOPE_AGENT); }
        asm volatile("s_waitcnt vmcnt(0)" ::: "memory");
        if (lane == 0) __hip_atomic_fetch_add(cnt + 64 * u.pm, 1u, __ATOMIC_RELAXED, __HIP_MEMORY_SCOPE_AGENT);
        if (wid == 0) {
            unsigned sp = 0;
            while ((unsigned)__builtin_amdgcn_readfirstlane(__hip_atomic_load(cnt + 64 * u.pm, __ATOMIC_RELAXED, __HIP_MEMORY_SCOPE_AGENT)) < 32u) { __builtin_amdgcn_s_sleep(2); if (++sp > (1u << 22)) break; }
            __builtin_amdgcn_fence(__ATOMIC_ACQUIRE, "agent");
        }
        asm volatile("s_waitcnt vmcnt(0) lgkmcnt(0)" ::: "memory"); __builtin_amdgcn_s_barrier(); asm volatile("" ::: "memory");
        if (lane < 32) { const float* slot = xbuf + (size_t)(u.pm * 256 + row) * 4; float t = 0.f;
#pragma unroll
            for (int k = 0; k < 4; ++k) t += __hip_atomic_load(slot + k, __ATOMIC_RELAXED, __HIP_MEMORY_SCOPE_AGENT);
            S[row] = 1.0f / sqrtf(t * (1.f / DM) + RMS_EPS); }
        asm volatile("s_waitcnt lgkmcnt(0)" ::: "memory"); __builtin_amdgcn_s_barrier(); asm volatile("" ::: "memory");
    }
};
struct EpiNorm1 {
    static constexpr bool PERM = false, AFTER_DRAIN = true, MIDK = false;
    const float* base; float* out; const float* gpost; RmsPanel st;
    __device__ __forceinline__ void operator()(const f32x4 (&)[2][2][4][2], const Unit&, int, int, int, int) const {}
    __device__ __forceinline__ void fused(f32x4 (&acc)[2][2][4][2], const Unit& u, int wr, int wc, int fr, int fq, LAS unsigned char* lds, int wid, int lane) const {
        const LAS float* S = (const LAS float*)(lds + 8192);
        const int col0 = u.pn * 256 + wc * 32 + 4 * fq;
        st.run(acc, u, wr, wc, fr, fq, lds, wid, lane);
#pragma unroll
        for (int ai = 0; ai < 2; ++ai)
#pragma unroll
            for (int m = 0; m < 4; ++m) { const int r = ai * 128 + wr * 64 + m * 16 + fr; const float rs = S[r]; const size_t off = (size_t)(u.pm * 256 + r) * DM + col0;
#pragma unroll
                for (int bj = 0; bj < 2; ++bj)
#pragma unroll
                    for (int n = 0; n < 2; ++n) { const f32x4 bs = *(const f32x4*)(base + off + bj * 128 + n * 16); const f32x4 gp = *(const f32x4*)(gpost + col0 + bj * 128 + n * 16);
                        *(f32x4*)(out + off + bj * 128 + n * 16) = bs + acc[ai][bj][m][n] * rs * gp; }
                if (m & 1) asm volatile("" ::: "memory"); }
    }
};
struct EpiNorm2 {
    static constexpr bool PERM = false, AFTER_DRAIN = true, MIDK = false;
    const float* base; float* out; bf16_t* hn; const float* gpost; const float* gnext; RmsPanel st1, st2;
    __device__ __forceinline__ void operator()(const f32x4 (&)[2][2][4][2], const Unit&, int, int, int, int) const {}
    __device__ __forceinline__ void fused(f32x4 (&acc)[2][2][4][2], const Unit& u, int wr, int wc, int fr, int fq, LAS unsigned char* lds, int wid, int lane) const {
        const LAS float* S = (const LAS float*)(lds + 8192);
        const int col0 = u.pn * 256 + wc * 32 + 4 * fq;
        st1.run(acc, u, wr, wc, fr, fq, lds, wid, lane);
#pragma unroll
        for (int ai = 0; ai < 2; ++ai)
#pragma unroll
            for (int m = 0; m < 4; ++m) { const int r = ai * 128 + wr * 64 + m * 16 + fr; const float rs = S[r]; const size_t off = (size_t)(u.pm * 256 + r) * DM + col0;
#pragma unroll
                for (int bj = 0; bj < 2; ++bj)
#pragma unroll
                    for (int n = 0; n < 2; ++n) { const f32x4 bs = *(const f32x4*)(base + off + bj * 128 + n * 16); const f32x4 gp = *(const f32x4*)(gpost + col0 + bj * 128 + n * 16);
                        const f32x4 x1 = bs + acc[ai][bj][m][n] * rs * gp; acc[ai][bj][m][n] = x1; *(f32x4*)(out + off + bj * 128 + n * 16) = x1; }
                asm volatile("" : "+v"(acc[ai][0][m][0]), "+v"(acc[ai][0][m][1]), "+v"(acc[ai][1][m][0]), "+v"(acc[ai][1][m][1]));
                if (m & 1) asm volatile("" ::: "memory"); }
        st2.run(acc, u, wr, wc, fr, fq, lds, wid, lane);
#pragma unroll
        for (int ai = 0; ai < 2; ++ai)
#pragma unroll
            for (int m = 0; m < 4; ++m) { const int r = ai * 128 + wr * 64 + m * 16 + fr; const float rs = S[r]; const size_t off = (size_t)(u.pm * 256 + r) * DM + col0;
#pragma unroll
                for (int bj = 0; bj < 2; ++bj)
#pragma unroll
                    for (int n = 0; n < 2; ++n) { const f32x4 gn = *(const f32x4*)(gnext + col0 + bj * 128 + n * 16); const f32x4 o = acc[ai][bj][m][n] * rs * gn;
                        u32x2 w; w.x = pg8::cvt_pk_bf16(o[0], o[1]); w.y = pg8::cvt_pk_bf16(o[2], o[3]); *(u32x2*)(hn + off + bj * 128 + n * 16) = w; }
                asm volatile("" ::: "memory"); }
    }
};
__device__ __forceinline__ int win_row(int c) {
    if (c < 1024 || c >= 3072) return c;
    const int q = (c - 1024) >> 9, ch = (c - 1024) & 511, ct = ch >> 6, grp = (ch & 63) >> 2, e = ch & 3;
    return 1024 + ct * 256 + (q & 1) * 128 + grp * 8 + (q >> 1) * 4 + e;
}
__device__ __forceinline__ void transpose_item(const float* W, int N, bf16_t* WT, int ldt, int koff, int row_off, bool winmap, LAS float* scr, int item, int lane) {
    const int nblk = N / 64, kb = item / nblk, nb = item % nblk, k0 = 64 * kb, n0 = 64 * nb;
    const int kq = lane >> 4, nq = lane & 15;
    f32x4 v[16];
#pragma unroll
    for (int i = 0; i < 16; ++i) v[i] = *(const f32x4*)(W + (size_t)(k0 + 4 * i + kq) * N + n0 + 4 * nq);
#pragma unroll
    for (int i = 0; i < 16; ++i) { LAS float* s = scr + (4 * i + kq) * 65 + 4 * nq; s[0] = v[i][0]; s[1] = v[i][1]; s[2] = v[i][2]; s[3] = v[i][3]; }
    asm volatile("s_waitcnt lgkmcnt(0)" ::: "memory");
    const int c = lane & 7;
#pragma unroll
    for (int j = 0; j < 8; ++j) { const int n = (lane >> 3) + 8 * j; const LAS float* s = scr + (8 * c) * 65 + n;
        u32x4 o; o.x = pk2(s[0 * 65], s[1 * 65]); o.y = pk2(s[2 * 65], s[3 * 65]); o.z = pk2(s[4 * 65], s[5 * 65]); o.w = pk2(s[6 * 65], s[7 * 65]);
        int dst = n0 + n; if (winmap) dst = win_row(dst);
        *(u32x4*)(WT + (size_t)(row_off + dst) * ldt + koff + k0 + 8 * c) = o; }
    asm volatile("s_waitcnt lgkmcnt(0)" ::: "memory");
}
template <int R> __device__ __forceinline__ void rms_rows_to_bf16(const float* x, const float* g, bf16_t* H, int m0, int mstride, int lane) {
    f32x4 v[R][4];
#pragma unroll
    for (int r = 0; r < R; ++r)
#pragma unroll
        for (int j = 0; j < 4; ++j) v[r][j] = ((const f32x4*)(x + (size_t)(m0 + r * mstride) * DM))[64 * j + lane];
    f32x4 gg[4];
#pragma unroll
    for (int j = 0; j < 4; ++j) gg[j] = ((const f32x4*)g)[64 * j + lane];
#pragma unroll
    for (int r = 0; r < R; ++r) { float s = 0.f;
#pragma unroll
        for (int j = 0; j < 4; ++j) s += (v[r][j][0] * v[r][j][0] + v[r][j][1] * v[r][j][1]) + (v[r][j][2] * v[r][j][2] + v[r][j][3] * v[r][j][3]);
        const float rstd = 1.f / sqrtf(wave_sum(s) * (1.f / DM) + RMS_EPS);
        u32x2* o8 = (u32x2*)(H + (size_t)(m0 + r * mstride) * DM) + lane;
#pragma unroll
        for (int j = 0; j < 4; ++j) { u32x2 w; w.x = pk2(v[r][j][0] * rstd * gg[j][0], v[r][j][1] * rstd * gg[j][1]); w.y = pk2(v[r][j][2] * rstd * gg[j][2], v[r][j][3] * rstd * gg[j][3]); o8[64 * j] = w; } }
}

__device__ __forceinline__ int crow(int r, int hi) { return (r & 3) + 8 * (r >> 2) + 4 * hi; }
constexpr int VROW = 144;
__device__ __forceinline__ void attn_item(int item, const bf16_t* Q, const bf16_t* K, const bf16_t* V, bf16_t* SG, LAS unsigned char* vl, int lane) {
    const int qg = item & 127, h = (item >> 7) & 7, b = item >> 10;
    const int r32 = lane & 31, hi = lane >> 5, t0 = qg * 32;
    const size_t tokq = (size_t)b * SEQ + t0 + r32;
    bf16x8 qf[4];
#pragma unroll
    for (int d0 = 0; d0 < 4; ++d0) qf[d0] = *(const bf16x8*)(Q + tokq * 512 + h * 64 + d0 * 16 + 8 * hi);
    f32x16 o0, o1;
#pragma unroll
    for (int r = 0; r < 16; ++r) { o0[r] = 0.f; o1[r] = 0.f; }
    float P = 1.f;
    const int i16 = lane & 15, G4 = lane >> 4;
    const int vb = (4 * (G4 >> 1) + (i16 >> 2)) * VROW + (16 * (G4 & 1) + 4 * (i16 & 3)) * 2;
    for (int s0 = t0; s0 >= 0; s0 -= 32) {
        const size_t tokk = (size_t)b * SEQ + s0;
        bf16x8 kf[4];
#pragma unroll
        for (int d0 = 0; d0 < 4; ++d0) kf[d0] = *(const bf16x8*)(K + (tokk + r32) * 512 + h * 64 + d0 * 16 + 8 * hi);
#pragma unroll
        for (int p = 0; p < 4; ++p) { const int idx = p * 64 + lane, key = idx >> 3, ch = idx & 7;
            const u32x4 v = *(const u32x4*)(V + (tokk + key) * 512 + h * 64 + ch * 8);
            *(LAS u32x4*)(vl + key * VROW + ch * 16) = v; }
        f32x16 s;
#pragma unroll
        for (int r = 0; r < 16; ++r) s[r] = 0.f;
#pragma unroll
        for (int d0 = 0; d0 < 4; ++d0) s = __builtin_amdgcn_mfma_f32_32x32x16_bf16(kf[d0], qf[d0], s, 0, 0, 0);
        const bool diag = (s0 == t0);
        float kp[16];
#pragma unroll
        for (int r = 0; r < 16; ++r) { const float e = __builtin_amdgcn_exp2f(s[r] * (0.125f * 1.4426950408889634f)); float k = __builtin_amdgcn_rcpf(1.f + e);
            if (diag && crow(r, hi) >= r32) k = 1.f; kp[r] = k; }
        float Gm[4], Go[4], T[4], R[4], C[4];
#pragma unroll
        for (int g = 0; g < 4; ++g) { Gm[g] = (kp[4 * g] * kp[4 * g + 1]) * (kp[4 * g + 2] * kp[4 * g + 3]); Go[g] = __shfl_xor(Gm[g], 32); T[g] = Gm[g] * Go[g]; }
        R[3] = P; R[2] = R[3] * T[3]; R[1] = R[2] * T[2]; R[0] = R[1] * T[1]; const float Cout = R[0] * T[0];
#pragma unroll
        for (int g = 0; g < 4; ++g) C[g] = hi ? R[g] : R[g] * Go[g];
        float w[16];
#pragma unroll
        for (int g = 0; g < 4; ++g) { const float p3 = C[g], p2 = p3 * kp[4 * g + 3], p1 = p2 * kp[4 * g + 2], p0 = p1 * kp[4 * g + 1], pe = p0 * kp[4 * g];
            w[4 * g + 3] = p3 - p2; w[4 * g + 2] = p2 - p1; w[4 * g + 1] = p1 - p0; w[4 * g] = p0 - pe; }
        bf16x8 wf[2];
#pragma unroll
        for (int st = 0; st < 2; ++st) { u32x4 t; t.x = pk2(w[8 * st], w[8 * st + 1]); t.y = pk2(w[8 * st + 2], w[8 * st + 3]); t.z = pk2(w[8 * st + 4], w[8 * st + 5]); t.w = pk2(w[8 * st + 6], w[8 * st + 7]); wf[st] = __builtin_bit_cast(bf16x8, t); }
#pragma unroll
        for (int dt = 0; dt < 2; ++dt)
#pragma unroll
            for (int st = 0; st < 2; ++st) {
                const s16x4 lo = __builtin_amdgcn_ds_read_tr16_b64_v4i16((LAS s16x4*)(vl + vb + (16 * st) * VROW + dt * 64));
                const s16x4 hh = __builtin_amdgcn_ds_read_tr16_b64_v4i16((LAS s16x4*)(vl + vb + (16 * st + 8) * VROW + dt * 64));
                const bf16x8 vf = (bf16x8){lo[0], lo[1], lo[2], lo[3], hh[0], hh[1], hh[2], hh[3]};
                if (dt == 0) o0 = __builtin_amdgcn_mfma_f32_32x32x16_bf16(vf, wf[st], o0, 0, 0, 0); else o1 = __builtin_amdgcn_mfma_f32_32x32x16_bf16(vf, wf[st], o1, 0, 0, 0); }
        P = Cout;
        if (__all(P < 1.17549435e-38f)) break;
    }
#pragma unroll
    for (int dt = 0; dt < 2; ++dt)
#pragma unroll
        for (int g = 0; g < 4; ++g) { bf16_t* p = SG + tokq * 1536 + h * 64 + dt * 32 + 8 * g + 4 * hi; const u32x2 sg = *(const u32x2*)p;
            const f32x16& o = dt ? o1 : o0; u32x2 y;
            y.x = pk2(o[4 * g] * bflo(sg.x), o[4 * g + 1] * bfhi(sg.x)); y.y = pk2(o[4 * g + 2] * bflo(sg.y), o[4 * g + 3] * bfhi(sg.y));
            *(u32x2*)p = y; }
}
__device__ __forceinline__ void pool_item(int pi, const bf16_t* PV, bf16_t* SG, const bf16_t* PT, const float* scale, int lane) {
    const int tile = pi >> 2, g = ((pi & 3) + ((pi >> 2) & 1)) & 3, win = 2 << g;
    const int r32 = lane & 31, hi = lane >> 5, tok = tile * 32 + r32, t = tok & (SEQ - 1);
    const bf16_t* vp = PV + (size_t)tok * 512 + g * 128 + 8 * hi;
    const int cnt = (t + 1) < win ? (t + 1) : win;
    float sum[8][8];
#pragma unroll
    for (int s = 0; s < 8; ++s) { const u32x4 raw = *(const u32x4*)(vp + 16 * s); const float f = 1.f - (float)cnt;
        sum[s][0] = bflo(raw.x) * f; sum[s][1] = bfhi(raw.x) * f; sum[s][2] = bflo(raw.y) * f; sum[s][3] = bfhi(raw.y) * f;
        sum[s][4] = bflo(raw.z) * f; sum[s][5] = bfhi(raw.z) * f; sum[s][6] = bflo(raw.w) * f; sum[s][7] = bfhi(raw.w) * f; }
    for (int jj = 1; jj < win; ++jj) {
        if (t - jj >= 0) {
#pragma unroll
            for (int s = 0; s < 8; ++s) { const u32x4 raw = *(const u32x4*)(vp - (size_t)jj * 512 + 16 * s);
                sum[s][0] += bflo(raw.x); sum[s][1] += bfhi(raw.x); sum[s][2] += bflo(raw.y); sum[s][3] += bfhi(raw.y);
                sum[s][4] += bflo(raw.z); sum[s][5] += bfhi(raw.z); sum[s][6] += bflo(raw.w); sum[s][7] += bfhi(raw.w); } }
    }
    const float inv = 1.f / (float)cnt;
    bf16x8 pf[8];
#pragma unroll
    for (int s = 0; s < 8; ++s) { u32x4 tt; tt.x = pk2(sum[s][0] * inv, sum[s][1] * inv); tt.y = pk2(sum[s][2] * inv, sum[s][3] * inv); tt.z = pk2(sum[s][4] * inv, sum[s][5] * inv); tt.w = pk2(sum[s][6] * inv, sum[s][7] * inv); pf[s] = __builtin_bit_cast(bf16x8, tt); }
#pragma unroll
    for (int nt = 0; nt < 4; ++nt) {
        f32x16 acc;
#pragma unroll
        for (int r = 0; r < 16; ++r) acc[r] = 0.f;
        const bf16_t* ap = PT + (size_t)(g * 128 + nt * 32 + r32) * 128 + 8 * hi;
#pragma unroll
        for (int s = 0; s < 8; ++s) { const bf16x8 a = *(const bf16x8*)(ap + 16 * s); acc = __builtin_amdgcn_mfma_f32_32x32x16_bf16(a, pf[s], acc, 0, 0, 0); }
#pragma unroll
        for (int q = 0; q < 4; ++q) { const int d = g * 128 + nt * 32 + 8 * q + 4 * hi; const f32x4 sc = *(const f32x4*)(scale + d);
            bf16_t* p = SG + (size_t)tok * 1536 + d; const u32x2 sg = *(const u32x2*)p; u32x2 y;
            y.x = pk2(acc[4 * q] * sc[0] * bflo(sg.x), acc[4 * q + 1] * sc[1] * bfhi(sg.x)); y.y = pk2(acc[4 * q + 2] * sc[2] * bflo(sg.y), acc[4 * q + 3] * sc[3] * bfhi(sg.y));
            *(u32x2*)p = y; }
    }
}
__device__ __forceinline__ void conv_item(int ci, const bf16_t* Z, bf16_t* Wy, const float* cw, const float* cb, int lane) {
    const int tok0 = ci * 8, t0 = tok0 & (SEQ - 1), ch = lane * 8;
    float w0[8], w1[8], w2[8], bs[8], zm2[8], zm1[8];
#pragma unroll
    for (int hf = 0; hf < 2; ++hf) { const f32x4 a = *(const f32x4*)(cw + ch + 4 * hf), b = *(const f32x4*)(cw + 512 + ch + 4 * hf), c = *(const f32x4*)(cw + 1024 + ch + 4 * hf), d = *(const f32x4*)(cb + ch + 4 * hf);
#pragma unroll
        for (int i = 0; i < 4; ++i) { w0[4 * hf + i] = a[i]; w1[4 * hf + i] = b[i]; w2[4 * hf + i] = c[i]; bs[4 * hf + i] = d[i]; } }
#pragma unroll
    for (int i = 0; i < 8; ++i) { zm2[i] = 0.f; zm1[i] = 0.f; }
    if (t0 != 0) { const u32x4 a = *(const u32x4*)(Z + (size_t)(tok0 - 2) * 512 + ch), b = *(const u32x4*)(Z + (size_t)(tok0 - 1) * 512 + ch);
        zm2[0] = bflo(a.x); zm2[1] = bfhi(a.x); zm2[2] = bflo(a.y); zm2[3] = bfhi(a.y); zm2[4] = bflo(a.z); zm2[5] = bfhi(a.z); zm2[6] = bflo(a.w); zm2[7] = bfhi(a.w);
        zm1[0] = bflo(b.x); zm1[1] = bfhi(b.x); zm1[2] = bflo(b.y); zm1[3] = bfhi(b.y); zm1[4] = bflo(b.z); zm1[5] = bfhi(b.z); zm1[6] = bflo(b.w); zm1[7] = bfhi(b.w); }
#pragma unroll
    for (int r = 0; r < 8; ++r) { const size_t off = (size_t)(tok0 + r) * 512 + ch, offw = (size_t)(tok0 + r) * 1536 + ch; const u32x4 zr = *(const u32x4*)(Z + off), wr_ = *(const u32x4*)(Wy + offw);
        float zc[8], wv[8], y[8];
        zc[0] = bflo(zr.x); zc[1] = bfhi(zr.x); zc[2] = bflo(zr.y); zc[3] = bfhi(zr.y); zc[4] = bflo(zr.z); zc[5] = bfhi(zr.z); zc[6] = bflo(zr.w); zc[7] = bfhi(zr.w);
        wv[0] = bflo(wr_.x); wv[1] = bfhi(wr_.x); wv[2] = bflo(wr_.y); wv[3] = bfhi(wr_.y); wv[4] = bflo(wr_.z); wv[5] = bfhi(wr_.z); wv[6] = bflo(wr_.w); wv[7] = bfhi(wr_.w);
#pragma unroll
        for (int i = 0; i < 8; ++i) { y[i] = wv[i] * (w0[i] * zm2[i] + w1[i] * zm1[i] + w2[i] * zc[i] + bs[i]); zm2[i] = zm1[i]; zm1[i] = zc[i]; }
        u32x4 o; o.x = pk2(y[0], y[1]); o.y = pk2(y[2], y[3]); o.z = pk2(y[4], y[5]); o.w = pk2(y[6], y[7]);
        *(u32x4*)(Wy + offw) = o; }
}
template <int R> __device__ __forceinline__ void norm_rows(const float* F32T, const float* RS, const float* xin, const float* gpost, float* xout, const float* gnext, bf16_t* H, int m0, int mstride, int lane) {
    f32x4 o[R][4], xi[R][4]; float ss[R];
#pragma unroll
    for (int r = 0; r < R; ++r) { const size_t row = (size_t)(m0 + r * mstride); ss[r] = (lane < 16) ? RS[row * 16 + lane] : 0.f;
#pragma unroll
        for (int j = 0; j < 4; ++j) { o[r][j] = ((const f32x4*)(F32T + row * DM))[64 * j + lane]; xi[r][j] = ((const f32x4*)(xin + row * DM))[64 * j + lane]; } }
    f32x4 gp[4];
#pragma unroll
    for (int j = 0; j < 4; ++j) gp[j] = ((const f32x4*)gpost)[64 * j + lane];
#pragma unroll
    for (int r = 0; r < R; ++r) { const size_t row = (size_t)(m0 + r * mstride);
        const float rstd = 1.f / sqrtf(wave_sum(ss[r]) * (1.f / DM) + RMS_EPS); float s2 = 0.f;
#pragma unroll
        for (int j = 0; j < 4; ++j) { const f32x4 v = xi[r][j] + o[r][j] * rstd * gp[j]; xi[r][j] = v; ((f32x4*)(xout + row * DM))[64 * j + lane] = v; s2 += (v[0] * v[0] + v[1] * v[1]) + (v[2] * v[2] + v[3] * v[3]); }
        if (gnext) { const float r2 = 1.f / sqrtf(wave_sum(s2) * (1.f / DM) + RMS_EPS);
#pragma unroll
            for (int j = 0; j < 4; ++j) { const f32x4 gg = ((const f32x4*)gnext)[64 * j + lane]; const f32x4 v = xi[r][j]; u32x2 w; w.x = pk2(v[0] * r2 * gg[0], v[1] * r2 * gg[1]); w.y = pk2(v[2] * r2 * gg[2], v[3] * r2 * gg[3]); ((u32x2*)(H + row * DM))[64 * j + lane] = w; } } }
}

struct Args { const float* in[10]; float* out; unsigned char* ws; int ph_lo, ph_hi; };
#define ARGP() ({ const Args* p_ = ap0; asm volatile("" : "+s"(p_)); p_; })
template <int ph> __device__ __forceinline__ void run_phase(const Args* ap0, LAS unsigned char* lds) {
        const Args* A = ARGP();
        const int tid = threadIdx.x, lane = tid & 63, wave = __builtin_amdgcn_readfirstlane(tid >> 6);
        const int G = gridDim.x, bx = blockIdx.x;
        const int vcu = (G % 8 == 0) ? (bx % 8) * (G / 8) + bx / 8 : bx;
        const int gw = vcu * 8 + wave, NGW = G * 8;
        unsigned char* ws = A->ws;
        bf16_t* H = (bf16_t*)(ws + WS_H); bf16_t* U = (bf16_t*)(ws + WS_U);
        if constexpr (ph == 0) {
            const float* x = A->in[0]; const float* pre_g = A->in[1]; const float* w_in = A->in[2]; const float* pool_w = A->in[3]; const float* w_branch = A->in[7]; const float* w_out = A->in[8];
            bf16_t* W1 = (bf16_t*)(ws + WS_W1); bf16_t* W2 = (bf16_t*)(ws + WS_W2); bf16_t* W3 = (bf16_t*)(ws + WS_W3); bf16_t* PW = (bf16_t*)(ws + WS_PW);
            LAS float* scr = (LAS float*)(lds + wave * 17408);
            constexpr int I1 = (DM / 64) * (NIN / 64), I2 = (BWID / 64) * (DM / 64), I3 = (DM / 64) * (DM / 64), I4 = 2 * 2, PER = I1 + 3 * I2 + I3 + 4 * I4;
            for (int it = gw; it < NLAYER * PER; it += NGW) {
                const int l = it / PER; int r = it % PER;
                if (r < I1) { transpose_item(w_in + (size_t)l * DM * NIN, NIN, W1 + (size_t)l * NIN * DM, DM, 0, 0, true, scr, r, lane); continue; } r -= I1;
                if (r < 3 * I2) { const int n = r / I2; transpose_item(w_branch + ((size_t)l * 3 + n) * BWID * DM, DM, W2 + (size_t)l * 3 * DM * BWID, 3 * BWID, n * BWID, 0, false, scr, r % I2, lane); continue; } r -= 3 * I2;
                if (r < I3) { transpose_item(w_out + (size_t)l * DM * DM, DM, W3 + (size_t)l * DM * DM, DM, 0, 0, false, scr, r, lane); continue; } r -= I3;
                { const int g = r / I4; transpose_item(pool_w + ((size_t)l * 4 + g) * 128 * 128, 128, PW + ((size_t)l * 4 + g) * 128 * 128, 128, 0, 0, false, scr, r % I4, lane); }
            }
            for (int m = gw; m < MTOK; m += 2 * NGW) rms_rows_to_bf16<2>(x, pre_g, H, m, NGW, lane);
        } else {
            constexpr int l = (ph - 1) / 5, k = (ph - 1) % 5;
            if constexpr (k == 0) {
                pg8::Gemm g{H, (bf16_t*)(ws + WS_W1) + (size_t)l * NIN * DM, MTOK, NIN, DM, 0}; pg8::StaticOrder S; S.init(MTOK, NIN, G, bx);
                EpiU E{ws};
                pg8::gemm_phase<EpiU, pg8::StaticOrder, true, true>(lds, g, S, E);
            } else if constexpr (k == 1) {
                const float* pool_scale = A->in[4]; const float* conv_w = A->in[5]; const float* conv_b = A->in[6];
                const bf16_t* PW = (const bf16_t*)(ws + WS_PW);
                const bf16_t* Q = U + 2 * (ARRB / 2); const bf16_t* Kk = U + 3 * (ARRB / 2); const bf16_t* V = U + 4 * (ARRB / 2);
                LAS unsigned char* vl = lds + wave * (32 * VROW);
                for (int it = gw; it < NB * 8 * 128; it += NGW) attn_item(it, Q, Kk, V, U + 5 * (ARRB / 2) + 1024, vl, lane);
                for (int it = gw; it < (MTOK / 32) * 4; it += NGW) pool_item(it, U, U + 5 * (ARRB / 2), PW + (size_t)l * 4 * 128 * 128, pool_scale + l * BWID, lane);
                for (int it = gw; it < MTOK / 8; it += NGW) conv_item(it, U + 1 * (ARRB / 2), U + 5 * (ARRB / 2) + 512, conv_w + l * 3 * BWID, conv_b + l * BWID, lane);
            } else if constexpr (k == 2) {
                pg8::Gemm g{U + 5 * (ARRB / 2), (bf16_t*)(ws + WS_W2) + (size_t)l * 3 * DM * BWID, MTOK, DM, 3 * BWID, 0}; pg8::StaticOrder S; S.init(MTOK, DM, G, bx);
                EpiBranch E{ws};
                pg8::gemm_phase<EpiBranch, pg8::StaticOrder, true, true>(lds, g, S, E);
            } else if constexpr (k == 3) {
                pg8::Gemm g{H, (bf16_t*)(ws + WS_W3) + (size_t)l * DM * DM, MTOK, DM, DM, 0}; pg8::StaticOrder S; S.init(MTOK, DM, G, bx);
                if (G == 256) {
                    const float* x = A->in[0]; const float* pre_g = A->in[1]; const float* post_g = A->in[9]; float* out = A->out;
                    float* xb = (float*)(ws + WS_RS); unsigned* cn = (unsigned*)(ws + WS_CTL + CTL_CNT);
                    if constexpr (l + 1 < NLAYER) {
                        EpiNorm2 E{x, out, H, post_g + l * DM, pre_g + (l + 1) * DM, RmsPanel{xb, cn}, RmsPanel{xb + (size_t)MTOK * 4, cn + 64 * 64}};
                        pg8::gemm_phase<EpiNorm2, pg8::StaticOrder, false, true>(lds, g, S, E);
                    } else {
                        EpiNorm1 E{out, out, post_g + l * DM, RmsPanel{xb + (size_t)2 * MTOK * 4, cn + 2 * 64 * 64}};
                        pg8::gemm_phase<EpiNorm1, pg8::StaticOrder, false, true>(lds, g, S, E);
                    }
                } else {
                    EpiOut E{ws};
                    pg8::gemm_phase<EpiOut, pg8::StaticOrder, true, true>(lds, g, S, E);
                }
            } else {
                const float* x = A->in[0]; const float* pre_g = A->in[1]; const float* post_g = A->in[9]; float* out = A->out;
                const float* F32T = (const float*)(ws + WS_U); const float* RS = (const float*)(ws + WS_RS);
                const float* xin = (l == 0) ? x : out; const float* gnext = (l + 1 < NLAYER) ? pre_g + (l + 1) * DM : nullptr;
                if (G != 256) for (int m = gw; m < MTOK; m += 2 * NGW) norm_rows<2>(F32T, RS, xin, post_g + l * DM, out, gnext, H, m, NGW, lane);
            }
        }
}
__global__ void __launch_bounds__(512, 2) hybrid_fwd(Args a_) {
    extern __shared__ __attribute__((aligned(16))) unsigned char lds_raw[];
    LAS unsigned char* lds = (LAS unsigned char*)lds_raw;
    const Args* ap0 = (const Args*)__builtin_amdgcn_kernarg_segment_ptr();
    cg::grid_group grid = cg::this_grid();
    if (threadIdx.x < 64) ((LAS unsigned*)(lds + 147200))[threadIdx.x] = 0u;
    __syncthreads();
    (void)xcd_barrier_post((unsigned*)(ARGP()->ws + WS_CTL), (volatile LAS unsigned*)(lds + 147200 + 32));
#define SEAM_BAR() do { XcdBarrier b_; b_.bar = (unsigned*)(ARGP()->ws + WS_CTL); b_.x = xb_xcc_id(); b_.st = (volatile LAS unsigned*)(lds + 147200 + 32); xcd_barrier(b_); } while (0)
    const int lo = ARGP()->ph_lo, hi = ARGP()->ph_hi;
#define PHASE(k) if (lo <= (k) && (k) < hi && !(((k) == 5 || (k) == 10) && gridDim.x == 256)) { if ((k) > lo) { if ((k) == 1 && lo < 0) grid.sync(); else SEAM_BAR(); } run_phase<(k)>(ap0, lds); }
    PHASE(0) PHASE(1) PHASE(2) PHASE(3) PHASE(4) PHASE(5) PHASE(6) PHASE(7) PHASE(8) PHASE(9) PHASE(10)
#undef PHASE
}

extern "C" void kernel_launch(void* const* d_in, const int* in_sizes, int n_in, void* d_out, int out_size, void* d_ws, size_t ws_size, hipStream_t stream) {
    static int grid = 0;
    if (grid == 0) {
        if (n_in != 10 || out_size != MTOK * DM || ws_size < WS_END) { fprintf(stderr, "kernel_launch: unexpected shapes / workspace (n_in %d out %d ws %zu)\n", n_in, out_size, ws_size); grid = -1; return; }
        int dev = 0, cus = 0, per_cu = 0;
        (void)hipGetDevice(&dev); (void)hipDeviceGetAttribute(&cus, hipDeviceAttributeMultiprocessorCount, dev);
        (void)hipFuncSetAttribute((const void*)hybrid_fwd, hipFuncAttributeMaxDynamicSharedMemorySize, LDS_BYTES);
        (void)hipOccupancyMaxActiveBlocksPerMultiprocessor(&per_cu, (const void*)hybrid_fwd, 512, LDS_BYTES);
        (void)hipGetLastError();
        if (per_cu < 1) { fprintf(stderr, "kernel_launch: occupancy query says %d blocks/CU\n", per_cu); per_cu = 1; }
        grid = cus;
    }
    if (grid < 0) return;
    if (hipMemsetAsync((char*)d_ws + WS_CTL, 0, CTL_BYTES, stream) != hipSuccess) { fprintf(stderr, "kernel_launch: memset of the barrier words failed\n"); return; }
    Args a{};
    for (int i = 0; i < 10; ++i) a.in[i] = (const float*)d_in[i];
    a.out = (float*)d_out; a.ws = (unsigned char*)d_ws;
#if ONE_LAUNCH
    a.ph_lo = 0; a.ph_hi = NPHASE;
    void* args[] = {&a};
    hipError_t e = hipLaunchCooperativeKernel((const void*)hybrid_fwd, dim3(grid), dim3(512), args, LDS_BYTES, stream);
    if (e != hipSuccess) fprintf(stderr, "cooperative launch failed: %s (grid %d)\n", hipGetErrorString(e), grid);
#else
    for (int ph = 0; ph < NPHASE; ++ph) { a.ph_lo = ph; a.ph_hi = ph + 1; for (int rep = 0; rep < 1 + ((DUP_MASK >> ph) & 1); ++rep) hipLaunchKernelGGL(hybrid_fwd, dim3(grid), dim3(512), LDS_BYTES, stream, a); }
#endif
}
```

```cpp
#include <hip/hip_runtime.h>
#include <hip/hip_cooperative_groups.h>
#include <cstdio>
#include <cstdint>
namespace cg = cooperative_groups;
#ifndef ONE_LAUNCH
#define ONE_LAUNCH 1
#endif
#ifndef DUP_MASK
#define DUP_MASK 0
#endif
#ifndef MIX_PROBE
#define MIX_PROBE 0
#endif
namespace pg8 {
#define PG8_LAS __attribute__((address_space(3)))
typedef unsigned short bf16_t;
typedef short bf16x8 __attribute__((ext_vector_type(8)));
typedef float f32x4 __attribute__((ext_vector_type(4)));
typedef unsigned u32x4 __attribute__((ext_vector_type(4)));
constexpr int BM = 256, BK = 64, HALF = 128, HTB = HALF * BK * 2  , STAGE_BYTES = 8 * HTB, NXCD = 8, WGM = 8;

__host__ __device__ __forceinline__ int lds_byte(int r, int c) { const int st = (r >> 4) * 2 + (c >> 5), rr = r & 15, cc = c & 31, ob = rr * 64 + cc * 2; return st * 1024 + (ob ^ (((ob >> 9) & 1) << 5)); }
__host__ __device__ __forceinline__ void stage_rc(int b, int& R, int& C) { const int st = b / 1024, sb = b % 1024, swz = sb ^ (((sb >> 9) & 1) << 5); R = (st >> 1) * 16 + swz / 64; C = (st & 1) * 32 + (swz % 64) / 2; }
__host__ __device__ __forceinline__ int perm32(int rho) { const int n = rho >> 4, i = rho & 15; return 8 * (i >> 2) + 4 * n + (i & 3); }

struct Unit { int pm, pn, az; };
struct Gemm { const bf16_t* A; const bf16_t* Bt; int M, N, K; size_t azs; };

struct StaticOrder {
    int nM, nN, nwg, G, c;
    __host__ __device__ void init(int M, int N, int G_, int c_) { nM = M / BM; nN = N / BM; nwg = nM * nN; G = G_; c = c_; }
    __host__ __device__ bool next(int i, Unit& u) const {
        const long L = (long)i * G + c; if (L >= nwg) return false;
        int wgid = (int)L; { const int q = nwg / NXCD, r = nwg % NXCD, xcd = wgid % NXCD, off = wgid / NXCD; wgid = (xcd < r ? xcd * (q + 1) : r * (q + 1) + (xcd - r) * q) + off; }
        const int nig = WGM * nN, gid = wgid / nig, fm = gid * WGM, gsz = (nM - fm) < WGM ? (nM - fm) : WGM;
        u.pm = fm + ((wgid % nig) % gsz); u.pn = (wgid % nig) / gsz; u.az = 0; return true;
    }
    __device__ __forceinline__ void a_ready(const Unit&) const {}
    __device__ __forceinline__ void done(const Unit&) const {}
};

__device__ __forceinline__ unsigned cvt_pk_bf16(float lo, float hi) { unsigned r; asm volatile("v_cvt_pk_bf16_f32 %0, %1, %2" : "=v"(r) : "v"(lo), "v"(hi)); return r; }
template <class Epi, class Sched, bool ALIGN_EPI = false, bool SP2 = false>
__device__ __forceinline__ void gemm_phase(PG8_LAS unsigned char* lds, const Gemm g, const Sched& S, const Epi& E) {
    const int tid = threadIdx.x, wid = __builtin_amdgcn_readfirstlane(tid >> 6), lane = tid & 63, wr = wid >> 2, wc = wid & 3, fr = lane & 15, fq = lane >> 4;
    const int K = g.K, nt = K / BK;
    unsigned voffA[2], voffB[2];
#pragma unroll
    for (int i = 0; i < 2; ++i) { int R, C; stage_rc(tid * 16 + i * 8192, R, C); const int Rb = Epi::PERM ? ((R & ~31) + perm32(R & 31)) : R;
        voffA[i] = (unsigned)(R * K + C) * 2u; voffB[i] = (unsigned)(Rb * K + C) * 2u; }
    const size_t kstep = (size_t)(BK * 2);
    const size_t hstep = (size_t)HALF * K * 2;
    const size_t tstep = 2 * hstep;
    const unsigned ldsw = (unsigned)wid * 1024u;
    const int aoff = lds_byte(wr * 64 + fr, fq * 8), boff = lds_byte(wc * 32 + fr, fq * 8);
#define PG8_SA(b, h) (((b) * 2 + (h)) * HTB)
#define PG8_SB(b, h) ((4 + (b) * 2 + (h)) * HTB)
#define PG8_STAGE(bufoff, gbase, voff) do { _Pragma("unroll") for (int _i = 0; _i < 2; ++_i) \
        __builtin_amdgcn_global_load_lds((const unsigned*)((const char*)(gbase) + (voff)[_i]), (PG8_LAS unsigned*)(lds + (bufoff) + ldsw + _i * 8192), 16, 0, 0); } while (0)
#define PG8_LDA(dst, b, h) do { _Pragma("unroll") for (int m = 0; m < 4; ++m) _Pragma("unroll") for (int k = 0; k < 2; ++k) dst[m][k] = *(const PG8_LAS bf16x8*)(lds + PG8_SA(b, h) + aoff + m * 2048 + k * 1024); } while (0)
#define PG8_LDB(dst, b, h) do { _Pragma("unroll") for (int n = 0; n < 2; ++n) _Pragma("unroll") for (int k = 0; k < 2; ++k) dst[n][k] = *(const PG8_LAS bf16x8*)(lds + PG8_SB(b, h) + boff + n * 2048 + k * 1024); } while (0)
#define PG8_MMA(ai, bj, At, Bt) do { __builtin_amdgcn_s_setprio(1); _Pragma("unroll") for (int m = 0; m < 4; ++m) _Pragma("unroll") for (int n = 0; n < 2; ++n) _Pragma("unroll") for (int k = 0; k < 2; ++k) \
        acc[ai][bj][m][n] = __builtin_amdgcn_mfma_f32_16x16x32_bf16(Bt[n][k], At[m][k], acc[ai][bj][m][n], 0, 0, 0); __builtin_amdgcn_s_setprio(0); } while (0)
#define PG8_WAIT_V(n) asm volatile("s_waitcnt vmcnt(" #n ")" ::: "memory")
#define PG8_WAIT_L(n) asm volatile("s_waitcnt lgkmcnt(" #n ")" ::: "memory")
#define PG8_BAR __builtin_amdgcn_s_barrier()
#define PG8_SCHED __builtin_amdgcn_sched_barrier(0)
    Unit cur, nxt; int ui = 0;
    if (!S.next(0, cur)) return;
    f32x4 acc[2][2][4][2];
#pragma unroll
    for (int a = 0; a < 2; ++a)
#pragma unroll
        for (int b = 0; b < 2; ++b)
#pragma unroll
            for (int m = 0; m < 4; ++m)
#pragma unroll
                for (int n = 0; n < 2; ++n) acc[a][b][m][n] = (f32x4){0.f, 0.f, 0.f, 0.f};
    bf16x8 At[4][2], B0[2][2], B1[2][2];
    const char* cA = (const char*)g.A + (size_t)cur.pm * tstep + (size_t)cur.az * g.azs; const char* cB = (const char*)g.Bt + (size_t)cur.pn * tstep;
    S.a_ready(cur);
    if constexpr (SP2) {
        PG8_STAGE(PG8_SB(0, 0), cB, voffB); PG8_STAGE(PG8_SB(0, 1), cB + hstep, voffB); PG8_STAGE(PG8_SA(0, 0), cA, voffA); PG8_STAGE(PG8_SA(0, 1), cA + hstep, voffA);
        if (wr == 1) PG8_BAR;
        PG8_WAIT_V(2); PG8_BAR;
        PG8_STAGE(PG8_SB(1, 0), cB + kstep, voffB); PG8_STAGE(PG8_SA(1, 0), cA + kstep, voffA); PG8_STAGE(PG8_SB(1, 1), cB + hstep + kstep, voffB);
        PG8_WAIT_V(6); PG8_BAR;
    } else {
        PG8_STAGE(PG8_SB(0, 0), cB, voffB); PG8_STAGE(PG8_SA(0, 0), cA, voffA); PG8_STAGE(PG8_SB(0, 1), cB + hstep, voffB); PG8_STAGE(PG8_SA(0, 1), cA + hstep, voffA);
        if (wr == 1) PG8_BAR;
        PG8_WAIT_V(4); PG8_BAR;
        PG8_STAGE(PG8_SB(1, 0), cB + kstep, voffB); PG8_STAGE(PG8_SA(1, 0), cA + kstep, voffA); PG8_STAGE(PG8_SB(1, 1), cB + hstep + kstep, voffB);
        PG8_WAIT_V(6); PG8_BAR;
    }
    for (;;) {
        const bool has_next = S.next(ui + 1, nxt);
        const char* nA = has_next ? (const char*)g.A + (size_t)nxt.pm * tstep + (size_t)nxt.az * g.azs : cA; const char* nB = has_next ? (const char*)g.Bt + (size_t)nxt.pn * tstep : cB;
        for (int t = 0; t < nt; t += 2) {
            if constexpr (Epi::MIDK) { if (t == 8 || t == 16) E.mid(acc, cur, t >> 3, wr, wc, fr, fq); }
            const bool last = (t == nt - 2);
            const char* a1 = cA + (size_t)(t + 1) * kstep;
            const char* a2 = last ? nA : cA + (size_t)(t + 2) * kstep; const char* b2 = last ? nB : cB + (size_t)(t + 2) * kstep;
            const char* a3 = a2 + kstep; const char* b3 = b2 + kstep;
            if (last && has_next) S.a_ready(nxt);
            if constexpr (SP2) {
            PG8_LDB(B0, 0, 0); PG8_LDB(B1, 0, 1); PG8_SCHED; PG8_LDA(At, 0, 0); PG8_STAGE(PG8_SA(1, 1), a1 + hstep, voffA);
            PG8_WAIT_V(8); PG8_WAIT_L(0); PG8_BAR; PG8_MMA(0, 0, At, B0); PG8_MMA(0, 1, At, B1); PG8_BAR; PG8_SCHED;
            PG8_LDA(At, 0, 1); PG8_STAGE(PG8_SB(0, 0), b2, voffB); PG8_STAGE(PG8_SB(0, 1), b2 + hstep, voffB); PG8_STAGE(PG8_SA(0, 0), a2, voffA);
            PG8_WAIT_V(8); PG8_WAIT_L(0); PG8_BAR; PG8_MMA(1, 0, At, B0); PG8_MMA(1, 1, At, B1); PG8_BAR; PG8_SCHED;
            PG8_LDB(B0, 1, 0); PG8_LDB(B1, 1, 1); PG8_SCHED; PG8_LDA(At, 1, 0); PG8_STAGE(PG8_SA(0, 1), a2 + hstep, voffA);
            PG8_WAIT_V(8); PG8_WAIT_L(0); PG8_BAR; PG8_MMA(0, 0, At, B0); PG8_MMA(0, 1, At, B1); PG8_BAR; PG8_SCHED;
            PG8_LDA(At, 1, 1); PG8_STAGE(PG8_SB(1, 0), b3, voffB); PG8_STAGE(PG8_SB(1, 1), b3 + hstep, voffB); PG8_STAGE(PG8_SA(1, 0), a3, voffA);
            PG8_WAIT_V(8); PG8_WAIT_L(0); PG8_BAR; PG8_MMA(1, 0, At, B0); PG8_MMA(1, 1, At, B1); PG8_BAR; PG8_SCHED;
            } else {
            PG8_LDB(B0, 0, 0); PG8_SCHED; PG8_LDA(At, 0, 0); PG8_STAGE(PG8_SA(1, 1), a1 + hstep, voffA);
            PG8_WAIT_L(8); PG8_BAR; PG8_WAIT_L(0); PG8_MMA(0, 0, At, B0); PG8_BAR; PG8_SCHED;
            PG8_LDB(B1, 0, 1); PG8_STAGE(PG8_SB(0, 0), b2, voffB);
            PG8_BAR; PG8_WAIT_L(0); PG8_MMA(0, 1, At, B1); PG8_BAR;
            PG8_LDA(At, 0, 1); PG8_STAGE(PG8_SA(0, 0), a2, voffA);
            PG8_BAR; PG8_WAIT_L(0); PG8_MMA(1, 0, At, B0); PG8_BAR; PG8_SCHED;
            PG8_STAGE(PG8_SB(0, 1), b2 + hstep, voffB);
            PG8_WAIT_V(6); PG8_BAR; PG8_MMA(1, 1, At, B1); PG8_BAR;
            PG8_LDB(B0, 1, 0); PG8_SCHED; PG8_LDA(At, 1, 0); PG8_STAGE(PG8_SA(0, 1), a2 + hstep, voffA);
            PG8_WAIT_L(8); PG8_BAR; PG8_WAIT_L(0); PG8_MMA(0, 0, At, B0); PG8_BAR; PG8_SCHED;
            PG8_LDB(B1, 1, 1); PG8_STAGE(PG8_SB(1, 0), b3, voffB);
            PG8_BAR; PG8_WAIT_L(0); PG8_MMA(0, 1, At, B1); PG8_BAR;
            PG8_LDA(At, 1, 1); PG8_STAGE(PG8_SA(1, 0), a3, voffA);
            PG8_BAR; PG8_WAIT_L(0); PG8_MMA(1, 0, At, B0); PG8_BAR; PG8_SCHED;
            PG8_STAGE(PG8_SB(1, 1), b3 + hstep, voffB);
            PG8_WAIT_V(6); PG8_BAR; PG8_MMA(1, 1, At, B1); PG8_BAR;
            }
        }
        if constexpr (ALIGN_EPI) { if (wr == 0) PG8_BAR; }
        if constexpr (!Epi::AFTER_DRAIN) { E(acc, cur, wr, wc, fr, fq); S.done(cur); }
        if (!has_next) break;
#pragma unroll
        for (int a = 0; a < 2; ++a)
#pragma unroll
            for (int b = 0; b < 2; ++b)
#pragma unroll
                for (int m = 0; m < 4; ++m)
#pragma unroll
                    for (int n = 0; n < 2; ++n) acc[a][b][m][n] = (f32x4){0.f, 0.f, 0.f, 0.f};
        cur = nxt; cA = nA; cB = nB; ++ui;
        if constexpr (ALIGN_EPI) { if (wr == 1) PG8_BAR; }
    }
    PG8_WAIT_V(0);
    if constexpr (!ALIGN_EPI) { if (wr == 0) PG8_BAR; }
    PG8_BAR;
    if constexpr (Epi::AFTER_DRAIN) { E.fused(acc, cur, wr, wc, fr, fq, lds, wid, lane); S.done(cur); }
#undef PG8_SA
#undef PG8_SB
#undef PG8_STAGE
#undef PG8_LDA
#undef PG8_LDB
#undef PG8_MMA
#undef PG8_WAIT_V
#undef PG8_WAIT_L
#undef PG8_BAR
#undef PG8_SCHED
}
}

#define LAS __attribute__((address_space(3)))
typedef unsigned short bf16_t;
typedef short bf16x8 __attribute__((ext_vector_type(8)));
typedef short s16x4 __attribute__((ext_vector_type(4)));
typedef float f32x4 __attribute__((ext_vector_type(4)));
typedef float f32x16 __attribute__((ext_vector_type(16)));
typedef unsigned u32x4 __attribute__((ext_vector_type(4)));
typedef unsigned u32x2 __attribute__((ext_vector_type(2)));
constexpr int NB = 4, SEQ = 4096, DM = 1024, MTOK = NB * SEQ, NIN = 8192, BWID = 512, NLAYER = 2;
constexpr float RMS_EPS = 1e-6f;
constexpr size_t MiB = 1u << 20;
constexpr size_t WS_RS = 0;
constexpr size_t WS_W1 = 2 * MiB;
constexpr size_t WS_W2 = 34 * MiB;
constexpr size_t WS_W3 = 40 * MiB;
constexpr size_t WS_PW = 44 * MiB;
constexpr size_t WS_H = 45 * MiB;
constexpr size_t WS_U = 77 * MiB;
constexpr size_t ARRB = 16 * MiB;
constexpr size_t WS_MG = 205 * MiB;
constexpr size_t WS_END = 253 * MiB;
constexpr int LDS_BYTES = 147456;
constexpr int NPHASE = 1 + 5 * NLAYER;

__device__ __forceinline__ unsigned f2bf(float f) { unsigned u = __builtin_bit_cast(unsigned, f); return (u + 0x7fffu + ((u >> 16) & 1u)) >> 16; }
__device__ __forceinline__ unsigned pk2(float lo, float hi) { return f2bf(lo) | (f2bf(hi) << 16); }
__device__ __forceinline__ float bflo(unsigned u) { return __builtin_bit_cast(float, u << 16); }
__device__ __forceinline__ float bfhi(unsigned u) { return __builtin_bit_cast(float, u & 0xffff0000u); }
__device__ __forceinline__ float sigmoid_f(float x) { return __builtin_amdgcn_rcpf(1.f + __builtin_amdgcn_exp2f(-1.4426950408889634f * x)); }
__device__ __forceinline__ float silu_f(float x) { return x * sigmoid_f(x); }
__device__ __forceinline__ unsigned q8(float x) { const unsigned q = (unsigned)(sigmoid_f(x) * 255.f + 0.5f); return q < 1u ? 1u : q; }
__device__ __forceinline__ float wave_sum(float v) {
#pragma unroll
    for (int o = 1; o < 64; o <<= 1) v += __shfl_xor(v, o);
    return v;
}

constexpr size_t WS_CTL = 1 * MiB; constexpr size_t CTL_BYTES = 65536;
constexpr size_t CTL_CNT = 16384;
#define XB_TMO      128
#define XB_XCNT(j)  (256  + 64 * (j))
#define XB_XSUB(j)  (1280 + 64 * (j))
#define XB_XGEN(j)  (2304 + 64 * (j))
#define XB_TOP      3328
#define XB_TOPGEN   3392
#define XCD_BAR_WORDS 3456
#define XB_SPIN_CAP (1u << 18)

__device__ __forceinline__ unsigned xb_ld(unsigned* p)              { return __hip_atomic_load(p, __ATOMIC_RELAXED, __HIP_MEMORY_SCOPE_AGENT); }
__device__ __forceinline__ unsigned xb_add(unsigned* p, unsigned v) { return __hip_atomic_fetch_add(p, v, __ATOMIC_RELAXED, __HIP_MEMORY_SCOPE_AGENT); }
__device__ __forceinline__ unsigned xb_xcc_id() { return (unsigned)__builtin_amdgcn_s_getreg((3 << 11) | 20) & 0xFu; }
#define XB_SPIN(cond, bar) do { unsigned _sp = 0; while (cond) { __builtin_amdgcn_s_sleep(1); \
    if ((++_sp & 255u) == 0u) { if (xb_ld(&(bar)[XB_TMO])) break; if (_sp > XB_SPIN_CAP) { atomicAdd(&(bar)[XB_TMO], 1u); break; } } } } while (0)

struct XcdBarrier {
    unsigned* bar; unsigned x;
    volatile LAS unsigned* st;
};

__device__ __forceinline__ XcdBarrier xcd_barrier_post(unsigned* bar, volatile LAS unsigned* st) {
    XcdBarrier b; b.bar = bar; b.x = xb_xcc_id(); b.st = st;
    if (threadIdx.x == 0) (void)xb_add(&bar[XB_XCNT(b.x)], 1u);
    return b;
}
__device__ __forceinline__ void xcd_barrier_complete(unsigned* bar, unsigned x, unsigned& nloc, unsigned& nx) {
    const unsigned G = gridDim.x * gridDim.y * gridDim.z;
    unsigned sum, cnt, mine, sp = 0u;
    for (;;) {
        sum = 0u; cnt = 0u; mine = 0u;
#pragma unroll
        for (unsigned j = 0; j < 16; ++j) { const unsigned c = xb_ld(&bar[XB_XCNT(j)]); sum += c; cnt += (c > 0u) ? 1u : 0u; mine = (j == x) ? c : mine; }
        if (sum == G) break;
        __builtin_amdgcn_s_sleep(1);
        if ((++sp & 255u) == 0u) { if (xb_ld(&bar[XB_TMO])) break; if (sp > XB_SPIN_CAP) { atomicAdd(&bar[XB_TMO], 1u); break; } }
    }
    nloc = mine > 0u ? mine : 1u; nx = cnt > 0u ? cnt : 1u;
}

__device__ __forceinline__ void xcd_barrier(const XcdBarrier& b) {
    asm volatile("s_waitcnt vmcnt(0)" ::: "memory");
    __syncthreads();
    if (threadIdx.x == 0) {
        unsigned* bar = b.bar;
        __builtin_amdgcn_s_waitcnt(0);
        unsigned nloc = b.st[0], nx = b.st[1];
        if (nloc == 0u) { xcd_barrier_complete(bar, b.x, nloc, nx); b.st[0] = nloc; b.st[1] = nx; }
        const unsigned old = xb_add(&bar[XB_XSUB(b.x)], 1u);
        const unsigned gen = old / nloc;
        if (old + 1u == (gen + 1u) * nloc) {
            __builtin_amdgcn_fence(__ATOMIC_RELEASE, "agent");
            asm volatile("s_waitcnt vmcnt(0)" ::: "memory");
            const unsigned og = xb_add(&bar[XB_TOP], 1u);
            const unsigned tg = og / nx;
            if (og + 1u == (tg + 1u) * nx) xb_add(&bar[XB_TOPGEN], 1u);
            else XB_SPIN(xb_ld(&bar[XB_TOPGEN]) == tg, bar);
            __builtin_amdgcn_fence(__ATOMIC_ACQUIRE, "agent");
            xb_add(&bar[XB_XGEN(b.x)], 1u);
            asm volatile("s_waitcnt vmcnt(0)" ::: "memory");
        } else {
            XB_SPIN(xb_ld(&bar[XB_XGEN(b.x)]) == gen, bar);
            __builtin_amdgcn_fence(__ATOMIC_ACQUIRE, "agent");
            asm volatile("s_waitcnt vmcnt(0)" ::: "memory");
        }
    }
    __syncthreads();
}


using pg8::Unit;
struct EpiU {
    static constexpr bool PERM = true, AFTER_DRAIN = false, MIDK = false;
    unsigned char* ws;
    __device__ __forceinline__ void operator()(const f32x4 (&acc)[2][2][4][2], const Unit& u, int wr, int wc, int fr, int fq) const {
        bf16_t* U = (bf16_t*)(ws + WS_U); unsigned char* MG = ws + WS_MG;
        const int pn = u.pn; const int row0 = u.pm * 256 + wr * 64 + fr;
        if (pn >= 20) {
            const int mc0 = (pn - 20) * 256 + wc * 32 + 8 * fq;
#pragma unroll
            for (int ai = 0; ai < 2; ++ai)
#pragma unroll
                for (int m = 0; m < 4; ++m) { unsigned char* rp = MG + (size_t)(row0 + ai * 128 + m * 16) * 3072 + mc0;
#pragma unroll
                    for (int bj = 0; bj < 2; ++bj) { const f32x4 v0 = acc[ai][bj][m][0], v1 = acc[ai][bj][m][1]; u32x2 w;
                        w.x = q8(v0[0]) | (q8(v0[1]) << 8) | (q8(v0[2]) << 16) | (q8(v0[3]) << 24); w.y = q8(v1[0]) | (q8(v1[1]) << 8) | (q8(v1[2]) << 16) | (q8(v1[3]) << 24);
                        *(u32x2*)(rp + bj * 128) = w; } }
        } else if (pn >= 4 && pn < 12) {
            const int ch0 = (pn - 4) * 64 + (4 * wc + fq) * 4;
            bf16_t* Z = U + 1 * (ARRB / 2); bf16_t* W = U + 5 * (ARRB / 2) + 512;
#pragma unroll
            for (int ai = 0; ai < 2; ++ai)
#pragma unroll
                for (int m = 0; m < 4; ++m) { const size_t rr = (size_t)(row0 + ai * 128 + m * 16); const size_t ro = rr * 512 + ch0, rw = rr * 1536 + ch0;
                    const f32x4 z = acc[ai][0][m][0] * acc[ai][0][m][1]; const f32x4 gb = acc[ai][1][m][0], gg = acc[ai][1][m][1];
                    u32x2 zz, ww; zz.x = pg8::cvt_pk_bf16(z[0], z[1]); zz.y = pg8::cvt_pk_bf16(z[2], z[3]);
                    ww.x = pg8::cvt_pk_bf16(gb[0] * silu_f(gg[0]), gb[1] * silu_f(gg[1])); ww.y = pg8::cvt_pk_bf16(gb[2] * silu_f(gg[2]), gb[3] * silu_f(gg[3]));
                    *(u32x2*)(Z + ro) = zz; *(u32x2*)(W + rw) = ww; }
        } else {
            const int kind = pn >> 1; int arr = 0, pitch = 512, coff = 0; bool act = false;
            if (kind == 1) { arr = 5; act = true; pitch = 1536; } else if (kind == 6) arr = 2; else if (kind == 7) arr = 3; else if (kind == 8) arr = 4; else if (kind == 9) { arr = 5; act = true; pitch = 1536; coff = 1024; }
            bf16_t* O = U + (size_t)arr * (ARRB / 2) + coff; const int col0 = (pn & 1) * 256 + wc * 32 + 8 * fq;
#pragma unroll
            for (int ai = 0; ai < 2; ++ai)
#pragma unroll
                for (int m = 0; m < 4; ++m) { bf16_t* rp = O + (size_t)(row0 + ai * 128 + m * 16) * pitch + col0;
#pragma unroll
                    for (int bj = 0; bj < 2; ++bj) { f32x4 v0 = acc[ai][bj][m][0], v1 = acc[ai][bj][m][1];
                        if (act) {
#pragma unroll
                            for (int i = 0; i < 4; ++i) { v0[i] = silu_f(v0[i]); v1[i] = silu_f(v1[i]); } }
                        u32x4 w; w.x = pg8::cvt_pk_bf16(v0[0], v0[1]); w.y = pg8::cvt_pk_bf16(v0[2], v0[3]); w.z = pg8::cvt_pk_bf16(v1[0], v1[1]); w.w = pg8::cvt_pk_bf16(v1[2], v1[3]);
                        *(u32x4*)(rp + bj * 128) = w; } }
        }
    }
};
struct EpiBranch {
    static constexpr bool PERM = true, AFTER_DRAIN = false, MIDK = true;
    unsigned char* ws;
    __device__ __forceinline__ void mid(f32x4 (&acc)[2][2][4][2], const Unit& u, int seg, int wr, int wc, int fr, int fq) const {
        int tid_ = threadIdx.x; asm volatile("" : "+v"(tid_));
        const int wid_ = tid_ >> 6, wr_ = wid_ >> 2, wc_ = wid_ & 3, fr_ = tid_ & 15, fq_ = (tid_ & 63) >> 4;
        const unsigned char* MG = ws + WS_MG + (seg - 1) * 1024; const int row0 = u.pm * 256 + wr_ * 64 + fr_, col0 = u.pn * 256 + wc_ * 32 + 8 * fq_;
#pragma unroll
        for (int ai = 0; ai < 2; ++ai)
#pragma unroll
            for (int m = 0; m < 4; ++m) { const unsigned char* rp = MG + (size_t)(row0 + ai * 128 + m * 16) * 3072 + col0;
#pragma unroll
                for (int bj = 0; bj < 2; ++bj) { const u32x2 qa = *(const u32x2*)(rp + bj * 128), qb = *(const u32x2*)(rp + bj * 128 + 1024);
                    f32x4 r0, r1;
                    r0[0] = (float)(qa.x & 255u) * __builtin_amdgcn_rcpf((float)(qb.x & 255u)); r0[1] = (float)((qa.x >> 8) & 255u) * __builtin_amdgcn_rcpf((float)((qb.x >> 8) & 255u));
                    r0[2] = (float)((qa.x >> 16) & 255u) * __builtin_amdgcn_rcpf((float)((qb.x >> 16) & 255u)); r0[3] = (float)(qa.x >> 24) * __builtin_amdgcn_rcpf((float)(qb.x >> 24));
                    r1[0] = (float)(qa.y & 255u) * __builtin_amdgcn_rcpf((float)(qb.y & 255u)); r1[1] = (float)((qa.y >> 8) & 255u) * __builtin_amdgcn_rcpf((float)((qb.y >> 8) & 255u));
                    r1[2] = (float)((qa.y >> 16) & 255u) * __builtin_amdgcn_rcpf((float)((qb.y >> 16) & 255u)); r1[3] = (float)(qa.y >> 24) * __builtin_amdgcn_rcpf((float)(qb.y >> 24));
                    acc[ai][bj][m][0] *= r0; acc[ai][bj][m][1] *= r1; }
                if (m == 3) asm volatile("" ::: "memory"); }
    }
    __device__ __forceinline__ void operator()(const f32x4 (&acc)[2][2][4][2], const Unit& u, int wr, int wc, int fr, int fq) const {
        const unsigned char* MG = ws + WS_MG + 2 * 1024; bf16_t* merged = (bf16_t*)(ws + WS_H);
        const int row0 = u.pm * 256 + wr * 64 + fr, col0 = u.pn * 256 + wc * 32 + 8 * fq;
#pragma unroll
        for (int ai = 0; ai < 2; ++ai)
#pragma unroll
            for (int m = 0; m < 4; ++m) { const size_t row = (size_t)(row0 + ai * 128 + m * 16);
#pragma unroll
                for (int bj = 0; bj < 2; ++bj) { const int col = col0 + bj * 128;
                    const u32x2 gq = *(const u32x2*)(MG + row * 3072 + col);
                    f32x4 g0, g1; const float k = 1.f / 255.f;
                    g0[0] = (float)(gq.x & 255u) * k; g0[1] = (float)((gq.x >> 8) & 255u) * k; g0[2] = (float)((gq.x >> 16) & 255u) * k; g0[3] = (float)(gq.x >> 24) * k;
                    g1[0] = (float)(gq.y & 255u) * k; g1[1] = (float)((gq.y >> 8) & 255u) * k; g1[2] = (float)((gq.y >> 16) & 255u) * k; g1[3] = (float)(gq.y >> 24) * k;
                    const f32x4 v0 = acc[ai][bj][m][0] * g0, v1 = acc[ai][bj][m][1] * g1;
                    u32x4 w; w.x = pg8::cvt_pk_bf16(v0[0], v0[1]); w.y = pg8::cvt_pk_bf16(v0[2], v0[3]); w.z = pg8::cvt_pk_bf16(v1[0], v1[1]); w.w = pg8::cvt_pk_bf16(v1[2], v1[3]);
                    *(u32x4*)(merged + row * 1024 + col) = w; } }
    }
};
struct EpiOut {
    static constexpr bool PERM = false, AFTER_DRAIN = false, MIDK = false;
    unsigned char* ws;
    __device__ __forceinline__ void operator()(const f32x4 (&acc)[2][2][4][2], const Unit& u, int wr, int wc, int fr, int fq) const {
        float* out = (float*)(ws + WS_U); float* rs = (float*)(ws + WS_RS);
        const int row0 = u.pm * 256 + wr * 64 + fr, col0 = u.pn * 256 + wc * 32 + 4 * fq;
#pragma unroll
        for (int ai = 0; ai < 2; ++ai)
#pragma unroll
            for (int m = 0; m < 4; ++m) { const size_t row = (size_t)(row0 + ai * 128 + m * 16); float ss = 0.f;
#pragma unroll
                for (int bj = 0; bj < 2; ++bj)
#pragma unroll
                    for (int n = 0; n < 2; ++n) { const f32x4 v = acc[ai][bj][m][n]; *(f32x4*)(out + row * 1024 + col0 + bj * 128 + n * 16) = v; ss += (v[0] * v[0] + v[1] * v[1]) + (v[2] * v[2] + v[3] * v[3]); }
                ss += __shfl_xor(ss, 16); ss += __shfl_xor(ss, 32);
                if (fq == 0) rs[row * 16 + u.pn * 4 + wc] = ss; }
    }
};

struct RmsPanel {
    float* xbuf;
    unsigned* cnt;
    __device__ __forceinline__ void run(const f32x4 (&v)[2][2][4][2], const Unit& u, int wr, int wc, int fr, int fq, LAS unsigned char* lds, int wid, int lane) const {
        LAS float* P = (LAS float*)lds; LAS float* S = (LAS float*)(lds + 8192);
#pragma unroll
        for (int ai = 0; ai < 2; ++ai)
#pragma unroll
            for (int m = 0; m < 4; ++m) { float s = 0.f;
#pragma unroll
                for (int bj = 0; bj < 2; ++bj)
#pragma unroll
                    for (int n = 0; n < 2; ++n) { const f32x4 x = v[ai][bj][m][n]; s += (x[0] * x[0] + x[1] * x[1]) + (x[2] * x[2] + x[3] * x[3]); }
                s += __shfl_xor(s, 16); s += __shfl_xor(s, 32);
                if (fq == 0) P[(ai * 128 + wr * 64 + m * 16 + fr) * 4 + wc] = s; }
        asm volatile("s_waitcnt lgkmcnt(0)" ::: "memory"); __builtin_amdgcn_s_barrier(); asm volatile("" ::: "memory");
        const int row = wid * 32 + (lane & 31);
        if (lane < 32) { const float t = (P[row * 4 + 0] + P[row * 4 + 1]) + (P[row * 4 + 2] + P[row * 4 + 3]);
            __hip_atomic_store(xbuf + (size_t)(u.pm * 256 + row) * 4 + u.pn, t, __ATOMIC_RELAXED, __HIP_MEMORY_SCOPE_AGENT); }
        asm volatile("s_waitcnt vmcnt(0)" ::: "memory");
        if (lane == 0) __hip_atomic_fetch_add(cnt + 64 * u.pm, 1u, __ATOMIC_RELAXED, __HIP_MEMORY_SCOPE_AGENT);
        if (wid == 0) {
            unsigned sp = 0;
            while ((unsigned)__builtin_amdgcn_readfirstlane(__hip_atomic_load(cnt + 64 * u.pm, __ATOMIC_RELAXED, __HIP_MEMORY_SCOPE_AGENT)) < 32u) { __builtin_amdgcn_s_sleep(2); if (++sp > (1u << 22)) break; }
            __builtin_amdgcn_fence(__ATOMIC_ACQUIRE, "agent");
        }
        asm volatile("s_waitcnt vmcnt(0) lgkmcnt(0)" ::: "memory"); __builtin_amdgcn_s_barrier(); asm volatile("" ::: "memory");
        if (lane < 32) { const float* slot = xbuf + (size_t)(u.pm * 256 + row) * 4; float t = 0.f;
#pragma unroll
            for (int k = 0; k < 4; ++k) t += __hip_atomic_load(slot + k, __ATOMIC_RELAXED, __HIP_MEMORY_SCOPE_AGENT);
            S[row] = 1.0f / sqrtf(t * (1.f / DM) + RMS_EPS); }
        asm volatile("s_waitcnt lgkmcnt(0)" ::: "memory"); __builtin_amdgcn_s_barrier(); asm volatile("" ::: "memory");
    }
};
struct EpiNorm1 {
    static constexpr bool PERM = false, AFTER_DRAIN = true, MIDK = false;
    const float* base; float* out; const float* gpost; RmsPanel st;
    __device__ __forceinline__ void operator()(const f32x4 (&)[2][2][4][2], const Unit&, int, int, int, int) const {}
    __device__ __forceinline__ void fused(f32x4 (&acc)[2][2][4][2], const Unit& u, int wr, int wc, int fr, int fq, LAS unsigned char* lds, int wid, int lane) const {
        const LAS float* S = (const LAS float*)(lds + 8192);
        const int col0 = u.pn * 256 + wc * 32 + 4 * fq;
        st.run(acc, u, wr, wc, fr, fq, lds, wid, lane);
#pragma unroll
        for (int ai = 0; ai < 2; ++ai)
#pragma unroll
            for (int m = 0; m < 4; ++m) { const int r = ai * 128 + wr * 64 + m * 16 + fr; const float rs = S[r]; const size_t off = (size_t)(u.pm * 256 + r) * DM + col0;
#pragma unroll
                for (int bj = 0; bj < 2; ++bj)
#pragma unroll
                    for (int n = 0; n < 2; ++n) { const f32x4 bs = *(const f32x4*)(base + off + bj * 128 + n * 16); const f32x4 gp = *(const f32x4*)(gpost + col0 + bj * 128 + n * 16);
                        *(f32x4*)(out + off + bj * 128 + n * 16) = bs + acc[ai][bj][m][n] * rs * gp; }
                if (m & 1) asm volatile("" ::: "memory"); }
    }
};
struct EpiNorm2 {
    static constexpr bool PERM = false, AFTER_DRAIN = true, MIDK = false;
    const float* base; float* out; bf16_t* hn; const float* gpost; const float* gnext; RmsPanel st1, st2;
    __device__ __forceinline__ void operator()(const f32x4 (&)[2][2][4][2], const Unit&, int, int, int, int) const {}
    __device__ __forceinline__ void fused(f32x4 (&acc)[2][2][4][2], const Unit& u, int wr, int wc, int fr, int fq, LAS unsigned char* lds, int wid, int lane) const {
        const LAS float* S = (const LAS float*)(lds + 8192);
        const int col0 = u.pn * 256 + wc * 32 + 4 * fq;
        st1.run(acc, u, wr, wc, fr, fq, lds, wid, lane);
#pragma unroll
        for (int ai = 0; ai < 2; ++ai)
#pragma unroll
            for (int m = 0; m < 4; ++m) { const int r = ai * 128 + wr * 64 + m * 16 + fr; const float rs = S[r]; const size_t off = (size_t)(u.pm * 256 + r) * DM + col0;
#pragma unroll
                for (int bj = 0; bj < 2; ++bj)
#pragma unroll
                    for (int n = 0; n < 2; ++n) { const f32x4 bs = *(const f32x4*)(base + off + bj * 128 + n * 16); const f32x4 gp = *(const f32x4*)(gpost + col0 + bj * 128 + n * 16);
                        const f32x4 x1 = bs + acc[ai][bj][m][n] * rs * gp; acc[ai][bj][m][n] = x1; *(f32x4*)(out + off + bj * 128 + n * 16) = x1; }
                asm volatile("" : "+v"(acc[ai][0][m][0]), "+v"(acc[ai][0][m][1]), "+v"(acc[ai][1][m][0]), "+v"(acc[ai][1][m][1]));
                if (m & 1) asm volatile("" ::: "memory"); }
        st2.run(acc, u, wr, wc, fr, fq, lds, wid, lane);
#pragma unroll
        for (int ai = 0; ai < 2; ++ai)
#pragma unroll
            for (int m = 0; m < 4; ++m) { const int r = ai * 128 + wr * 64 + m * 16 + fr; const float rs = S[r]; const size_t off = (size_t)(u.pm * 256 + r) * DM + col0;
#pragma unroll
                for (int bj = 0; bj < 2; ++bj)
#pragma unroll
                    for (int n = 0; n < 2; ++n) { const f32x4 gn = *(const f32x4*)(gnext + col0 + bj * 128 + n * 16); const f32x4 o = acc[ai][bj][m][n] * rs * gn;
                        u32x2 w; w.x = pg8::cvt_pk_bf16(o[0], o[1]); w.y = pg8::cvt_pk_bf16(o[2], o[3]); *(u32x2*)(hn + off + bj * 128 + n * 16) = w; }
                asm volatile("" ::: "memory"); }
    }
};
__device__ __forceinline__ int win_row(int c) {
    if (c < 1024 || c >= 3072) return c;
    const int q = (c - 1024) >> 9, ch = (c - 1024) & 511, ct = ch >> 6, grp = (ch & 63) >> 2, e = ch & 3;
    return 1024 + ct * 256 + (q & 1) * 128 + grp * 8 + (q >> 1) * 4 + e;
}
__device__ __forceinline__ void transpose_item(const float* W, int N, bf16_t* WT, int ldt, int koff, int row_off, bool winmap, LAS float* scr, int item, int lane) {
    const int nblk = N / 64, kb = item / nblk, nb = item % nblk, k0 = 64 * kb, n0 = 64 * nb;
    const int kq = lane >> 4, nq = lane & 15;
    f32x4 v[16];
#pragma unroll
    for (int i = 0; i < 16; ++i) v[i] = *(const f32x4*)(W + (size_t)(k0 + 4 * i + kq) * N + n0 + 4 * nq);
#pragma unroll
    for (int i = 0; i < 16; ++i) { LAS float* s = scr + (4 * i + kq) * 65 + 4 * nq; s[0] = v[i][0]; s[1] = v[i][1]; s[2] = v[i][2]; s[3] = v[i][3]; }
    asm volatile("s_waitcnt lgkmcnt(0)" ::: "memory");
    const int c = lane & 7;
#pragma unroll
    for (int j = 0; j < 8; ++j) { const int n = (lane >> 3) + 8 * j; const LAS float* s = scr + (8 * c) * 65 + n;
        u32x4 o; o.x = pg8::cvt_pk_bf16(s[0 * 65], s[1 * 65]); o.y = pg8::cvt_pk_bf16(s[2 * 65], s[3 * 65]); o.z = pg8::cvt_pk_bf16(s[4 * 65], s[5 * 65]); o.w = pg8::cvt_pk_bf16(s[6 * 65], s[7 * 65]);
        int dst = n0 + n; if (winmap) dst = win_row(dst);
        *(u32x4*)(WT + (size_t)(row_off + dst) * ldt + koff + k0 + 8 * c) = o; }
    asm volatile("s_waitcnt lgkmcnt(0)" ::: "memory");
}
template <int R> __device__ __forceinline__ void rms_rows_to_bf16(const float* x, const float* g, bf16_t* H, int m0, int mstride, int lane) {
    f32x4 v[R][4];
#pragma unroll
    for (int r = 0; r < R; ++r)
#pragma unroll
        for (int j = 0; j < 4; ++j) v[r][j] = ((const f32x4*)(x + (size_t)(m0 + r * mstride) * DM))[64 * j + lane];
    f32x4 gg[4];
#pragma unroll
    for (int j = 0; j < 4; ++j) gg[j] = ((const f32x4*)g)[64 * j + lane];
#pragma unroll
    for (int r = 0; r < R; ++r) { float s = 0.f;
#pragma unroll
        for (int j = 0; j < 4; ++j) s += (v[r][j][0] * v[r][j][0] + v[r][j][1] * v[r][j][1]) + (v[r][j][2] * v[r][j][2] + v[r][j][3] * v[r][j][3]);
        const float rstd = 1.f / sqrtf(wave_sum(s) * (1.f / DM) + RMS_EPS);
        u32x2* o8 = (u32x2*)(H + (size_t)(m0 + r * mstride) * DM) + lane;
#pragma unroll
        for (int j = 0; j < 4; ++j) { u32x2 w; w.x = pg8::cvt_pk_bf16(v[r][j][0] * rstd * gg[j][0], v[r][j][1] * rstd * gg[j][1]); w.y = pg8::cvt_pk_bf16(v[r][j][2] * rstd * gg[j][2], v[r][j][3] * rstd * gg[j][3]); o8[64 * j] = w; } }
}

__device__ __forceinline__ int crow(int r, int hi) { return (r & 3) + 8 * (r >> 2) + 4 * hi; }
constexpr int VROW = 144;
__device__ __forceinline__ void attn_item(int item, const bf16_t* Q, const bf16_t* K, const bf16_t* V, const bf16_t* SG, bf16_t* YO, LAS unsigned char* vl, int lane) {
    const int qg = item & 127, h = (item >> 7) & 7, b = item >> 10;
    const int r32 = lane & 31, hi = lane >> 5, t0 = qg * 32;
    const size_t tokq = (size_t)b * SEQ + t0 + r32;
    bf16x8 qf[4];
#pragma unroll
    for (int d0 = 0; d0 < 4; ++d0) qf[d0] = *(const bf16x8*)(Q + tokq * 512 + h * 64 + d0 * 16 + 8 * hi);
    f32x16 o0, o1;
#pragma unroll
    for (int r = 0; r < 16; ++r) { o0[r] = 0.f; o1[r] = 0.f; }
    float P = 1.f;
    const int i16 = lane & 15, G4 = lane >> 4;
    const int vb = (4 * (G4 >> 1) + (i16 >> 2)) * VROW + (16 * (G4 & 1) + 4 * (i16 & 3)) * 2;
#define ATT_LOAD(KF, VR, S0) do { const size_t tk_ = (size_t)b * SEQ + ((S0) > 0 ? (S0) : 0); \
        _Pragma("unroll") for (int d0 = 0; d0 < 4; ++d0) KF[d0] = *(const bf16x8*)(K + (tk_ + r32) * 512 + h * 64 + d0 * 16 + 8 * hi); \
        _Pragma("unroll") for (int p = 0; p < 4; ++p) { const int idx = p * 64 + lane; VR[p] = *(const u32x4*)(V + (tk_ + (idx >> 3)) * 512 + h * 64 + (idx & 7) * 8); } } while (0)
    bf16x8 kf[4], kn[4]; u32x4 vr[4], vn[4];
    ATT_LOAD(kf, vr, t0); ATT_LOAD(kn, vn, t0 - 32);
    u32x2 sgv[8];
#pragma unroll
    for (int i = 0; i < 8; ++i) sgv[i] = *(const u32x2*)(SG + tokq * 1536 + h * 64 + (i >> 2) * 32 + 8 * (i & 3) + 4 * hi);
    for (int s0 = t0; s0 >= 0; s0 -= 32) {
        bf16x8 k2[4]; u32x4 v2[4];
        ATT_LOAD(k2, v2, s0 - 64);
#pragma unroll
        for (int p = 0; p < 4; ++p) { const int idx = p * 64 + lane, key = idx >> 3, ch = idx & 7; *(LAS u32x4*)(vl + key * VROW + ch * 16) = vr[p]; }
        f32x16 s;
#pragma unroll
        for (int r = 0; r < 16; ++r) s[r] = 0.f;
#pragma unroll
        for (int d0 = 0; d0 < 4; ++d0) s = __builtin_amdgcn_mfma_f32_32x32x16_bf16(kf[d0], qf[d0], s, 0, 0, 0);
        const bool diag = (s0 == t0);
        float kp[16];
#pragma unroll
        for (int r = 0; r < 16; ++r) { const float e = __builtin_amdgcn_exp2f(s[r] * (0.125f * 1.4426950408889634f)); float k = __builtin_amdgcn_rcpf(1.f + e);
            if (diag && crow(r, hi) >= r32) k = 1.f; kp[r] = k; }
        float Gm[4], Go[4], T[4], R[4], C[4];
#pragma unroll
        for (int g = 0; g < 4; ++g) { Gm[g] = (kp[4 * g] * kp[4 * g + 1]) * (kp[4 * g + 2] * kp[4 * g + 3]); Go[g] = __shfl_xor(Gm[g], 32); T[g] = Gm[g] * Go[g]; }
        R[3] = P; R[2] = R[3] * T[3]; R[1] = R[2] * T[2]; R[0] = R[1] * T[1]; const float Cout = R[0] * T[0];
#pragma unroll
        for (int g = 0; g < 4; ++g) C[g] = hi ? R[g] : R[g] * Go[g];
        float w[16];
#pragma unroll
        for (int g = 0; g < 4; ++g) { const float p3 = C[g], p2 = p3 * kp[4 * g + 3], p1 = p2 * kp[4 * g + 2], p0 = p1 * kp[4 * g + 1], pe = p0 * kp[4 * g];
            w[4 * g + 3] = p3 - p2; w[4 * g + 2] = p2 - p1; w[4 * g + 1] = p1 - p0; w[4 * g] = p0 - pe; }
        bf16x8 wf[2];
#pragma unroll
        for (int st = 0; st < 2; ++st) { u32x4 t; t.x = pg8::cvt_pk_bf16(w[8 * st], w[8 * st + 1]); t.y = pg8::cvt_pk_bf16(w[8 * st + 2], w[8 * st + 3]); t.z = pg8::cvt_pk_bf16(w[8 * st + 4], w[8 * st + 5]); t.w = pg8::cvt_pk_bf16(w[8 * st + 6], w[8 * st + 7]); wf[st] = __builtin_bit_cast(bf16x8, t); }
#pragma unroll
        for (int dt = 0; dt < 2; ++dt)
#pragma unroll
            for (int st = 0; st < 2; ++st) {
                const s16x4 lo = __builtin_amdgcn_ds_read_tr16_b64_v4i16((LAS s16x4*)(vl + vb + (16 * st) * VROW + dt * 64));
                const s16x4 hh = __builtin_amdgcn_ds_read_tr16_b64_v4i16((LAS s16x4*)(vl + vb + (16 * st + 8) * VROW + dt * 64));
                const bf16x8 vf = (bf16x8){lo[0], lo[1], lo[2], lo[3], hh[0], hh[1], hh[2], hh[3]};
                if (dt == 0) o0 = __builtin_amdgcn_mfma_f32_32x32x16_bf16(vf, wf[st], o0, 0, 0, 0); else o1 = __builtin_amdgcn_mfma_f32_32x32x16_bf16(vf, wf[st], o1, 0, 0, 0); }
        P = Cout;
        if (__all(P < 1.17549435e-38f)) break;
#pragma unroll
        for (int i = 0; i < 4; ++i) { kf[i] = kn[i]; vr[i] = vn[i]; kn[i] = k2[i]; vn[i] = v2[i]; }
    }
#undef ATT_LOAD
#pragma unroll
    for (int dt = 0; dt < 2; ++dt)
#pragma unroll
        for (int g = 0; g < 4; ++g) { const size_t po = tokq * 1536 + h * 64 + dt * 32 + 8 * g + 4 * hi; const u32x2 sg = sgv[dt * 4 + g];
            const f32x16& o = dt ? o1 : o0; u32x2 y;
            y.x = pg8::cvt_pk_bf16(o[4 * g] * bflo(sg.x), o[4 * g + 1] * bfhi(sg.x)); y.y = pg8::cvt_pk_bf16(o[4 * g + 2] * bflo(sg.y), o[4 * g + 3] * bfhi(sg.y));
            *(u32x2*)(YO + po) = y; }
}
constexpr int PROW = 272;
__device__ __forceinline__ void pool_item(int pi, const bf16_t* PV, const bf16_t* SG, bf16_t* YO, const bf16_t* PT, const float* scale, LAS unsigned char* sl, int lane) {
    const int tile = pi >> 2, g = ((pi & 3) + ((pi >> 2) & 1)) & 3, win = 2 << g;
    const int r32 = lane & 31, hi = lane >> 5, tok0 = tile * 32, t0 = tok0 & (SEQ - 1), tok = tok0 + r32;
    u32x4 sv[12];
#pragma unroll
    for (int p = 0; p < 12; ++p) { const int idx = p * 64 + lane, row = idx >> 4, ch = idx & 15; const bool ok = (t0 + row - 16) >= 0;
        sv[p] = *(const u32x4*)(PV + (size_t)(ok ? tok0 + row - 16 : tok0) * 512 + g * 128 + ch * 8); if (!ok) sv[p] = (u32x4){0u, 0u, 0u, 0u}; }
#pragma unroll
    for (int p = 0; p < 12; ++p) { const int idx = p * 64 + lane, row = idx >> 4, ch = idx & 15; *(LAS u32x4*)(sl + row * PROW + ch * 16) = sv[p]; }
    const int t = t0 + r32, cnt = (t + 1) < win ? (t + 1) : win;
    bf16x8 bfr[3];
#pragma unroll
    for (int ks = 0; ks < 3; ++ks) { float wv[8];
#pragma unroll
        for (int j = 0; j < 8; ++j) { const int rel = (16 + r32) - (16 * ks + 8 * hi + j); wv[j] = (rel == 0) ? (float)(1 - cnt) : ((rel > 0 && rel < cnt) ? 1.f : 0.f); }
        u32x4 tt; tt.x = pg8::cvt_pk_bf16(wv[0], wv[1]); tt.y = pg8::cvt_pk_bf16(wv[2], wv[3]); tt.z = pg8::cvt_pk_bf16(wv[4], wv[5]); tt.w = pg8::cvt_pk_bf16(wv[6], wv[7]); bfr[ks] = __builtin_bit_cast(bf16x8, tt); }
    const int i16 = lane & 15, G4 = lane >> 4;
    const int vb = (8 * (G4 >> 1) + (i16 >> 2)) * PROW + (16 * (G4 & 1) + 4 * (i16 & 3)) * 2;
    const float inv = __builtin_amdgcn_rcpf((float)cnt);
    bf16x8 pf[8];
#pragma unroll
    for (int ct = 0; ct < 4; ++ct) {
        f32x16 acc;
#pragma unroll
        for (int r = 0; r < 16; ++r) acc[r] = 0.f;
#pragma unroll
        for (int ks = 0; ks < 3; ++ks) {
            const s16x4 lo = __builtin_amdgcn_ds_read_tr16_b64_v4i16((LAS s16x4*)(sl + vb + (16 * ks) * PROW + ct * 64));
            const s16x4 hh = __builtin_amdgcn_ds_read_tr16_b64_v4i16((LAS s16x4*)(sl + vb + (16 * ks + 4) * PROW + ct * 64));
            const bf16x8 a = (bf16x8){lo[0], lo[1], lo[2], lo[3], hh[0], hh[1], hh[2], hh[3]};
            acc = __builtin_amdgcn_mfma_f32_32x32x16_bf16(a, bfr[ks], acc, 0, 0, 0); }
#pragma unroll
        for (int s = 0; s < 2; ++s) { u32x4 tt; tt.x = pg8::cvt_pk_bf16(acc[8 * s] * inv, acc[8 * s + 1] * inv); tt.y = pg8::cvt_pk_bf16(acc[8 * s + 2] * inv, acc[8 * s + 3] * inv);
            tt.z = pg8::cvt_pk_bf16(acc[8 * s + 4] * inv, acc[8 * s + 5] * inv); tt.w = pg8::cvt_pk_bf16(acc[8 * s + 6] * inv, acc[8 * s + 7] * inv); pf[2 * ct + s] = __builtin_bit_cast(bf16x8, tt); }
    }
#pragma unroll
    for (int nt = 0; nt < 4; ++nt) {
        f32x16 acc;
#pragma unroll
        for (int r = 0; r < 16; ++r) acc[r] = 0.f;
        const bf16_t* ap = PT + (size_t)(g * 128 + nt * 32 + r32) * 128 + 4 * hi;
#pragma unroll
        for (int ks = 0; ks < 8; ++ks) {
            const u32x2 a0 = *(const u32x2*)(ap + 16 * ks), a1 = *(const u32x2*)(ap + 16 * ks + 8);
            const u32x4 av = (u32x4){a0.x, a0.y, a1.x, a1.y};
            acc = __builtin_amdgcn_mfma_f32_32x32x16_bf16(__builtin_bit_cast(bf16x8, av), pf[ks], acc, 0, 0, 0); }
#pragma unroll
        for (int q = 0; q < 4; ++q) { const int dd = g * 128 + nt * 32 + 8 * q + 4 * hi; const f32x4 sc = *(const f32x4*)(scale + dd);
            const size_t po = (size_t)tok * 1536 + dd; const u32x2 sg = *(const u32x2*)(SG + po); u32x2 y;
            y.x = pg8::cvt_pk_bf16(acc[4 * q] * sc[0] * bflo(sg.x), acc[4 * q + 1] * sc[1] * bfhi(sg.x)); y.y = pg8::cvt_pk_bf16(acc[4 * q + 2] * sc[2] * bflo(sg.y), acc[4 * q + 3] * sc[3] * bfhi(sg.y));
            *(u32x2*)(YO + po) = y; }
    }
}
__device__ __forceinline__ void conv_item(int ci, const bf16_t* Z, const bf16_t* Wy, bf16_t* YO, const float* cw, const float* cb, int lane) {
    const int tok0 = ci * 8, t0 = tok0 & (SEQ - 1), ch = lane * 8;
    float w0[8], w1[8], w2[8], bs[8], zm2[8], zm1[8];
#pragma unroll
    for (int hf = 0; hf < 2; ++hf) { const f32x4 a = *(const f32x4*)(cw + ch + 4 * hf), b = *(const f32x4*)(cw + 512 + ch + 4 * hf), c = *(const f32x4*)(cw + 1024 + ch + 4 * hf), d = *(const f32x4*)(cb + ch + 4 * hf);
#pragma unroll
        for (int i = 0; i < 4; ++i) { w0[4 * hf + i] = a[i]; w1[4 * hf + i] = b[i]; w2[4 * hf + i] = c[i]; bs[4 * hf + i] = d[i]; } }
#pragma unroll
    for (int i = 0; i < 8; ++i) { zm2[i] = 0.f; zm1[i] = 0.f; }
    if (t0 != 0) { const u32x4 a = *(const u32x4*)(Z + (size_t)(tok0 - 2) * 512 + ch), b = *(const u32x4*)(Z + (size_t)(tok0 - 1) * 512 + ch);
        zm2[0] = bflo(a.x); zm2[1] = bfhi(a.x); zm2[2] = bflo(a.y); zm2[3] = bfhi(a.y); zm2[4] = bflo(a.z); zm2[5] = bfhi(a.z); zm2[6] = bflo(a.w); zm2[7] = bfhi(a.w);
        zm1[0] = bflo(b.x); zm1[1] = bfhi(b.x); zm1[2] = bflo(b.y); zm1[3] = bfhi(b.y); zm1[4] = bflo(b.z); zm1[5] = bfhi(b.z); zm1[6] = bflo(b.w); zm1[7] = bfhi(b.w); }
    u32x4 zr[8], wr_[8];
#pragma unroll
    for (int r = 0; r < 8; ++r) { zr[r] = *(const u32x4*)(Z + (size_t)(tok0 + r) * 512 + ch); wr_[r] = *(const u32x4*)(Wy + (size_t)(tok0 + r) * 1536 + ch); }
#pragma unroll
    for (int r = 0; r < 8; ++r) {
        float zc[8], wv[8], y[8];
        zc[0] = bflo(zr[r].x); zc[1] = bfhi(zr[r].x); zc[2] = bflo(zr[r].y); zc[3] = bfhi(zr[r].y); zc[4] = bflo(zr[r].z); zc[5] = bfhi(zr[r].z); zc[6] = bflo(zr[r].w); zc[7] = bfhi(zr[r].w);
        wv[0] = bflo(wr_[r].x); wv[1] = bfhi(wr_[r].x); wv[2] = bflo(wr_[r].y); wv[3] = bfhi(wr_[r].y); wv[4] = bflo(wr_[r].z); wv[5] = bfhi(wr_[r].z); wv[6] = bflo(wr_[r].w); wv[7] = bfhi(wr_[r].w);
#pragma unroll
        for (int i = 0; i < 8; ++i) { y[i] = wv[i] * (w0[i] * zm2[i] + w1[i] * zm1[i] + w2[i] * zc[i] + bs[i]); zm2[i] = zm1[i]; zm1[i] = zc[i]; }
        u32x4 o; o.x = pg8::cvt_pk_bf16(y[0], y[1]); o.y = pg8::cvt_pk_bf16(y[2], y[3]); o.z = pg8::cvt_pk_bf16(y[4], y[5]); o.w = pg8::cvt_pk_bf16(y[6], y[7]);
        *(u32x4*)(YO + (size_t)(tok0 + r) * 1536 + ch) = o; }
}
template <int R> __device__ __forceinline__ void norm_rows(const float* F32T, const float* RS, const float* xin, const float* gpost, float* xout, const float* gnext, bf16_t* H, int m0, int mstride, int lane) {
    f32x4 o[R][4], xi[R][4]; float ss[R];
#pragma unroll
    for (int r = 0; r < R; ++r) { const size_t row = (size_t)(m0 + r * mstride); ss[r] = (lane < 16) ? RS[row * 16 + lane] : 0.f;
#pragma unroll
        for (int j = 0; j < 4; ++j) { o[r][j] = ((const f32x4*)(F32T + row * DM))[64 * j + lane]; xi[r][j] = ((const f32x4*)(xin + row * DM))[64 * j + lane]; } }
    f32x4 gp[4];
#pragma unroll
    for (int j = 0; j < 4; ++j) gp[j] = ((const f32x4*)gpost)[64 * j + lane];
#pragma unroll
    for (int r = 0; r < R; ++r) { const size_t row = (size_t)(m0 + r * mstride);
        const float rstd = 1.f / sqrtf(wave_sum(ss[r]) * (1.f / DM) + RMS_EPS); float s2 = 0.f;
#pragma unroll
        for (int j = 0; j < 4; ++j) { const f32x4 v = xi[r][j] + o[r][j] * rstd * gp[j]; xi[r][j] = v; ((f32x4*)(xout + row * DM))[64 * j + lane] = v; s2 += (v[0] * v[0] + v[1] * v[1]) + (v[2] * v[2] + v[3] * v[3]); }
        if (gnext) { const float r2 = 1.f / sqrtf(wave_sum(s2) * (1.f / DM) + RMS_EPS);
#pragma unroll
            for (int j = 0; j < 4; ++j) { const f32x4 gg = ((const f32x4*)gnext)[64 * j + lane]; const f32x4 v = xi[r][j]; u32x2 w; w.x = pg8::cvt_pk_bf16(v[0] * r2 * gg[0], v[1] * r2 * gg[1]); w.y = pg8::cvt_pk_bf16(v[2] * r2 * gg[2], v[3] * r2 * gg[3]); ((u32x2*)(H + row * DM))[64 * j + lane] = w; } } }
}

struct Args { const float* in[10]; float* out; unsigned char* ws; int ph_lo, ph_hi; };
template <class T> __device__ __forceinline__ T* as_global(T* p) { return p; }
template <int ph> __device__ __forceinline__ void run_phase(const Args& a_, LAS unsigned char* lds) {
        const Args* A = &a_;
        const int tid = threadIdx.x, lane = tid & 63, wave = __builtin_amdgcn_readfirstlane(tid >> 6);
        const int G = gridDim.x, bx = blockIdx.x;
        const int vcu = (G % 8 == 0) ? (bx % 8) * (G / 8) + bx / 8 : bx;
        const int gw = vcu * 8 + wave, NGW = G * 8;
        unsigned char* ws = as_global(A->ws);
        bf16_t* H = (bf16_t*)(ws + WS_H); bf16_t* U = (bf16_t*)(ws + WS_U);
        if constexpr (ph == 0) {
            const float* x = as_global(A->in[0]); const float* pre_g = as_global(A->in[1]); const float* w_in = as_global(A->in[2]); const float* pool_w = as_global(A->in[3]); const float* w_branch = as_global(A->in[7]); const float* w_out = as_global(A->in[8]);
            bf16_t* W1 = (bf16_t*)(ws + WS_W1); bf16_t* W2 = (bf16_t*)(ws + WS_W2); bf16_t* W3 = (bf16_t*)(ws + WS_W3); bf16_t* PW = (bf16_t*)(ws + WS_PW);
            LAS float* scr = (LAS float*)(lds + wave * 17408);
            constexpr int I1 = (DM / 64) * (NIN / 64), I2 = (BWID / 64) * (DM / 64), I3 = (DM / 64) * (DM / 64), I4 = 2 * 2, PER = I1 + 3 * I2 + I3 + 4 * I4;
            for (int it = gw; it < NLAYER * PER; it += NGW) {
                const int l = it / PER; int r = it % PER;
                if (r < I1) { transpose_item(w_in + (size_t)l * DM * NIN, NIN, W1 + (size_t)l * NIN * DM, DM, 0, 0, true, scr, r, lane); continue; } r -= I1;
                if (r < 3 * I2) { const int n = r / I2; transpose_item(w_branch + ((size_t)l * 3 + n) * BWID * DM, DM, W2 + (size_t)l * 3 * DM * BWID, 3 * BWID, n * BWID, 0, false, scr, r % I2, lane); continue; } r -= 3 * I2;
                if (r < I3) { transpose_item(w_out + (size_t)l * DM * DM, DM, W3 + (size_t)l * DM * DM, DM, 0, 0, false, scr, r, lane); continue; } r -= I3;
                { const int g = r / I4; transpose_item(pool_w + ((size_t)l * 4 + g) * 128 * 128, 128, PW + ((size_t)l * 4 + g) * 128 * 128, 128, 0, 0, false, scr, r % I4, lane); }
            }
            for (int m = gw; m < MTOK; m += 2 * NGW) rms_rows_to_bf16<2>(x, pre_g, H, m, NGW, lane);
        } else {
            constexpr int l = (ph - 1) / 5, k = (ph - 1) % 5;
            if constexpr (k == 0) {
                pg8::Gemm g{H, (bf16_t*)(ws + WS_W1) + (size_t)l * NIN * DM, MTOK, NIN, DM, 0}; pg8::StaticOrder S; S.init(MTOK, NIN, G, bx);
                EpiU E{ws};
                pg8::gemm_phase<EpiU, pg8::StaticOrder, true, true>(lds, g, S, E);
            } else if constexpr (k == 1) {
                const float* pool_scale = as_global(A->in[4]); const float* conv_w = as_global(A->in[5]); const float* conv_b = as_global(A->in[6]);
                const bf16_t* PW = (const bf16_t*)(ws + WS_PW);
                const bf16_t* Q = U + 2 * (ARRB / 2); const bf16_t* Kk = U + 3 * (ARRB / 2); const bf16_t* V = U + 4 * (ARRB / 2);
                LAS unsigned char* vl = lds + wave * (32 * VROW);
                bf16_t* G3 = U + 5 * (ARRB / 2);
                bf16_t* YO = G3;
#if MIX_PROBE
                if (l == 0 && A->ph_hi < 0) YO = (bf16_t*)as_global(A->out);
#endif
                int pm_ = 7;
#if MIX_PROBE
                if (l == 0 && A->ph_hi < 0) pm_ = MIX_PROBE;
#endif
                if (pm_ & 1) for (int it = gw; it < NB * 8 * 128; it += NGW) attn_item(it, Q, Kk, V, G3 + 1024, YO + 1024, vl, lane);
                if (pm_ & 2) for (int it = gw; it < (MTOK / 32) * 4; it += NGW) pool_item(it, U, G3, YO, PW + (size_t)l * 4 * 128 * 128, pool_scale + l * BWID, lds + 36864 + wave * (48 * PROW), lane);
                if (pm_ & 4) for (int it = gw; it < MTOK / 8; it += NGW) conv_item(it, U + 1 * (ARRB / 2), G3 + 512, YO + 512, conv_w + l * 3 * BWID, conv_b + l * BWID, lane);
            } else if constexpr (k == 2) {
                pg8::Gemm g{U + 5 * (ARRB / 2), (bf16_t*)(ws + WS_W2) + (size_t)l * 3 * DM * BWID, MTOK, DM, 3 * BWID, 0}; pg8::StaticOrder S; S.init(MTOK, DM, G, bx);
                EpiBranch E{ws};
                pg8::gemm_phase<EpiBranch, pg8::StaticOrder, true, true>(lds, g, S, E);
            } else if constexpr (k == 3) {
                pg8::Gemm g{H, (bf16_t*)(ws + WS_W3) + (size_t)l * DM * DM, MTOK, DM, DM, 0}; pg8::StaticOrder S; S.init(MTOK, DM, G, bx);
                if (G == 256) {
                    const float* x = as_global(A->in[0]); const float* pre_g = as_global(A->in[1]); const float* post_g = as_global(A->in[9]); float* out = as_global(A->out);
                    float* xb = (float*)(ws + WS_RS); unsigned* cn = (unsigned*)(ws + WS_CTL + CTL_CNT);
                    if constexpr (l + 1 < NLAYER) {
                        EpiNorm2 E{x, out, H, post_g + l * DM, pre_g + (l + 1) * DM, RmsPanel{xb, cn}, RmsPanel{xb + (size_t)MTOK * 4, cn + 64 * 64}};
                        pg8::gemm_phase<EpiNorm2, pg8::StaticOrder, false, true>(lds, g, S, E);
                    } else {
                        EpiNorm1 E{out, out, post_g + l * DM, RmsPanel{xb + (size_t)2 * MTOK * 4, cn + 2 * 64 * 64}};
                        pg8::gemm_phase<EpiNorm1, pg8::StaticOrder, false, true>(lds, g, S, E);
                    }
                } else {
                    EpiOut E{ws};
                    pg8::gemm_phase<EpiOut, pg8::StaticOrder, true, true>(lds, g, S, E);
                }
            } else {
                const float* x = as_global(A->in[0]); const float* pre_g = as_global(A->in[1]); const float* post_g = as_global(A->in[9]); float* out = as_global(A->out);
                const float* F32T = (const float*)(ws + WS_U); const float* RS = (const float*)(ws + WS_RS);
                const float* xin = (l == 0) ? x : out; const float* gnext = (l + 1 < NLAYER) ? pre_g + (l + 1) * DM : nullptr;
                if (G != 256) for (int m = gw; m < MTOK; m += 2 * NGW) norm_rows<2>(F32T, RS, xin, post_g + l * DM, out, gnext, H, m, NGW, lane);
            }
        }
}
__global__ void __launch_bounds__(512, 2) hybrid_fwd(Args a_) {
    extern __shared__ __attribute__((aligned(16))) unsigned char lds_raw[];
    LAS unsigned char* lds = (LAS unsigned char*)lds_raw;
    cg::grid_group grid = cg::this_grid();
    if (threadIdx.x < 64) ((LAS unsigned*)(lds + 147200))[threadIdx.x] = 0u;
    __syncthreads();
    (void)xcd_barrier_post((unsigned*)(a_.ws + WS_CTL), (volatile LAS unsigned*)(lds + 147200 + 32));
#define SEAM_BAR() do { XcdBarrier b_; b_.bar = (unsigned*)(a_.ws + WS_CTL); b_.x = xb_xcc_id(); b_.st = (volatile LAS unsigned*)(lds + 147200 + 32); xcd_barrier(b_); } while (0)
    const int lo = a_.ph_lo, hi = a_.ph_hi < 0 ? -a_.ph_hi : a_.ph_hi;
#define PHASE(k) if (lo <= (k) && (k) < hi && !(((k) == 5 || (k) == 10) && gridDim.x == 256)) { if ((k) > lo) { if ((k) == 1 && lo < 0) grid.sync(); else SEAM_BAR(); } run_phase<(k)>(a_, lds); }
    PHASE(0) PHASE(1) PHASE(2) PHASE(3) PHASE(4) PHASE(5) PHASE(6) PHASE(7) PHASE(8) PHASE(9) PHASE(10)
#undef PHASE
}

extern "C" void kernel_launch(void* const* d_in, const int* in_sizes, int n_in, void* d_out, int out_size, void* d_ws, size_t ws_size, hipStream_t stream) {
    static int grid = 0;
    if (grid == 0) {
        if (n_in != 10 || out_size != MTOK * DM || ws_size < WS_END) { fprintf(stderr, "kernel_launch: unexpected shapes / workspace (n_in %d out %d ws %zu)\n", n_in, out_size, ws_size); grid = -1; return; }
        int dev = 0, cus = 0, per_cu = 0;
        (void)hipGetDevice(&dev); (void)hipDeviceGetAttribute(&cus, hipDeviceAttributeMultiprocessorCount, dev);
        (void)hipFuncSetAttribute((const void*)hybrid_fwd, hipFuncAttributeMaxDynamicSharedMemorySize, LDS_BYTES);
        (void)hipOccupancyMaxActiveBlocksPerMultiprocessor(&per_cu, (const void*)hybrid_fwd, 512, LDS_BYTES);
        (void)hipGetLastError();
        if (per_cu < 1) { fprintf(stderr, "kernel_launch: occupancy query says %d blocks/CU\n", per_cu); per_cu = 1; }
        grid = cus;
    }
    if (grid < 0) return;
    if (hipMemsetAsync((char*)d_ws + WS_CTL, 0, CTL_BYTES, stream) != hipSuccess) { fprintf(stderr, "kernel_launch: memset of the barrier words failed\n"); return; }
    Args a{};
    for (int i = 0; i < 10; ++i) a.in[i] = (const float*)d_in[i];
    a.out = (float*)d_out; a.ws = (unsigned char*)d_ws;
#if ONE_LAUNCH
    a.ph_lo = 0; a.ph_hi = NPHASE;
    void* args[] = {&a};
    hipError_t e = hipLaunchCooperativeKernel((const void*)hybrid_fwd, dim3(grid), dim3(512), args, LDS_BYTES, stream);
    if (e != hipSuccess) fprintf(stderr, "cooperative launch failed: %s (grid %d)\n", hipGetErrorString(e), grid);
#else
    for (int ph = 0; ph < NPHASE; ++ph) { a.ph_lo = ph; a.ph_hi = ph + 1;
#if MIX_PROBE
        if (ph == 2) { a.ph_hi = -(ph + 1); hipLaunchKernelGGL(hybrid_fwd, dim3(grid), dim3(512), LDS_BYTES, stream, a); a.ph_hi = ph + 1; }
#endif
        for (int rep = 0; rep < 1 + ((DUP_MASK >> ph) & 1); ++rep) hipLaunchKernelGGL(hybrid_fwd, dim3(grid), dim3(512), LDS_BYTES, stream, a); }
#endif
}
```

```cpp
#include <hip/hip_runtime.h>
#include <hip/hip_cooperative_groups.h>
#include <cstdio>
#include <cstdint>
namespace cg = cooperative_groups;
#ifndef ONE_LAUNCH
#define ONE_LAUNCH 1
#endif
#ifndef DUP_MASK
#define DUP_MASK 0
#endif
#ifndef MIX_PROBE
#define MIX_PROBE 0
#endif
#ifndef TP_A
#define TP_A -1
#define TP_B -1
#endif
#ifndef TP_SCALE
#define TP_SCALE 1
#endif
#ifndef TP_BLK
#define TP_BLK 0
#endif
namespace pg8 {
#define PG8_LAS __attribute__((address_space(3)))
typedef unsigned short bf16_t;
typedef short bf16x8 __attribute__((ext_vector_type(8)));
typedef float f32x4 __attribute__((ext_vector_type(4)));
typedef unsigned u32x4 __attribute__((ext_vector_type(4)));
constexpr int BM = 256, BK = 64, HALF = 128, HTB = HALF * BK * 2  , STAGE_BYTES = 8 * HTB, NXCD = 8, WGM = 8;

__host__ __device__ __forceinline__ int lds_byte(int r, int c) { const int st = (r >> 4) * 2 + (c >> 5), rr = r & 15, cc = c & 31, ob = rr * 64 + cc * 2; return st * 1024 + (ob ^ (((ob >> 9) & 1) << 5)); }
__host__ __device__ __forceinline__ void stage_rc(int b, int& R, int& C) { const int st = b / 1024, sb = b % 1024, swz = sb ^ (((sb >> 9) & 1) << 5); R = (st >> 1) * 16 + swz / 64; C = (st & 1) * 32 + (swz % 64) / 2; }
__host__ __device__ __forceinline__ int perm32(int rho) { const int n = rho >> 4, i = rho & 15; return 8 * (i >> 2) + 4 * n + (i & 3); }

struct Unit { int pm, pn, az; };
struct Gemm { const bf16_t* A; const bf16_t* Bt; int M, N, K; size_t azs; };

struct StaticOrder {
    int nM, nN, nwg, G, c;
    __host__ __device__ void init(int M, int N, int G_, int c_) { nM = M / BM; nN = N / BM; nwg = nM * nN; G = G_; c = c_; }
    __host__ __device__ bool next(int i, Unit& u) const {
        const long L = (long)i * G + c; if (L >= nwg) return false;
        int wgid = (int)L; { const int q = nwg / NXCD, r = nwg % NXCD, xcd = wgid % NXCD, off = wgid / NXCD; wgid = (xcd < r ? xcd * (q + 1) : r * (q + 1) + (xcd - r) * q) + off; }
        const int nig = WGM * nN, gid = wgid / nig, fm = gid * WGM, gsz = (nM - fm) < WGM ? (nM - fm) : WGM;
        u.pm = fm + ((wgid % nig) % gsz); u.pn = (wgid % nig) / gsz; u.az = 0; return true;
    }
    __device__ __forceinline__ void a_ready(const Unit&) const {}
    __device__ __forceinline__ void done(const Unit&) const {}
};

__device__ __forceinline__ unsigned cvt_pk_bf16(float lo, float hi) { unsigned r; asm volatile("v_cvt_pk_bf16_f32 %0, %1, %2" : "=v"(r) : "v"(lo), "v"(hi)); return r; }
template <class Epi, class Sched, bool ALIGN_EPI = false, bool SP2 = false>
__device__ __forceinline__ void gemm_phase(PG8_LAS unsigned char* lds, const Gemm g, const Sched& S, const Epi& E) {
    const int tid = threadIdx.x, wid = __builtin_amdgcn_readfirstlane(tid >> 6), lane = tid & 63, wr = wid >> 2, wc = wid & 3, fr = lane & 15, fq = lane >> 4;
    const int K = g.K, nt = K / BK;
    unsigned voffA[2], voffB[2];
#pragma unroll
    for (int i = 0; i < 2; ++i) { int R, C; stage_rc(tid * 16 + i * 8192, R, C); const int Rb = Epi::PERM ? ((R & ~31) + perm32(R & 31)) : R;
        voffA[i] = (unsigned)(R * K + C) * 2u; voffB[i] = (unsigned)(Rb * K + C) * 2u; }
    const size_t kstep = (size_t)(BK * 2);
    const size_t hstep = (size_t)HALF * K * 2;
    const size_t tstep = 2 * hstep;
    const unsigned ldsw = (unsigned)wid * 1024u;
    const int aoff = lds_byte(wr * 64 + fr, fq * 8), boff = lds_byte(wc * 32 + fr, fq * 8);
#define PG8_SA(b, h) (((b) * 2 + (h)) * HTB)
#define PG8_SB(b, h) ((4 + (b) * 2 + (h)) * HTB)
#define PG8_STAGE(bufoff, gbase, voff) do { _Pragma("unroll") for (int _i = 0; _i < 2; ++_i) \
        __builtin_amdgcn_global_load_lds((const unsigned*)((const char*)(gbase) + (voff)[_i]), (PG8_LAS unsigned*)(lds + (bufoff) + ldsw + _i * 8192), 16, 0, 0); } while (0)
#define PG8_LDA(dst, b, h) do { _Pragma("unroll") for (int m = 0; m < 4; ++m) _Pragma("unroll") for (int k = 0; k < 2; ++k) dst[m][k] = *(const PG8_LAS bf16x8*)(lds + PG8_SA(b, h) + aoff + m * 2048 + k * 1024); } while (0)
#define PG8_LDB(dst, b, h) do { _Pragma("unroll") for (int n = 0; n < 2; ++n) _Pragma("unroll") for (int k = 0; k < 2; ++k) dst[n][k] = *(const PG8_LAS bf16x8*)(lds + PG8_SB(b, h) + boff + n * 2048 + k * 1024); } while (0)
#define PG8_MMA(ai, bj, At, Bt) do { __builtin_amdgcn_s_setprio(1); _Pragma("unroll") for (int m = 0; m < 4; ++m) _Pragma("unroll") for (int n = 0; n < 2; ++n) _Pragma("unroll") for (int k = 0; k < 2; ++k) \
        acc[ai][bj][m][n] = __builtin_amdgcn_mfma_f32_16x16x32_bf16(Bt[n][k], At[m][k], acc[ai][bj][m][n], 0, 0, 0); __builtin_amdgcn_s_setprio(0); } while (0)
#define PG8_WAIT_V(n) asm volatile("s_waitcnt vmcnt(" #n ")" ::: "memory")
#define PG8_WAIT_L(n) asm volatile("s_waitcnt lgkmcnt(" #n ")" ::: "memory")
#define PG8_BAR __builtin_amdgcn_s_barrier()
#define PG8_SCHED __builtin_amdgcn_sched_barrier(0)
    Unit cur, nxt; int ui = 0;
    if (!S.next(0, cur)) return;
    f32x4 acc[2][2][4][2];
#pragma unroll
    for (int a = 0; a < 2; ++a)
#pragma unroll
        for (int b = 0; b < 2; ++b)
#pragma unroll
            for (int m = 0; m < 4; ++m)
#pragma unroll
                for (int n = 0; n < 2; ++n) acc[a][b][m][n] = (f32x4){0.f, 0.f, 0.f, 0.f};
    bf16x8 At[4][2], B0[2][2], B1[2][2];
    const char* cA = (const char*)g.A + (size_t)cur.pm * tstep + (size_t)cur.az * g.azs; const char* cB = (const char*)g.Bt + (size_t)cur.pn * tstep;
    S.a_ready(cur);
    if constexpr (SP2) {
        PG8_STAGE(PG8_SB(0, 0), cB, voffB); PG8_STAGE(PG8_SB(0, 1), cB + hstep, voffB); PG8_STAGE(PG8_SA(0, 0), cA, voffA); PG8_STAGE(PG8_SA(0, 1), cA + hstep, voffA);
        if (wr == 1) PG8_BAR;
        PG8_WAIT_V(2); PG8_BAR;
        PG8_STAGE(PG8_SB(1, 0), cB + kstep, voffB); PG8_STAGE(PG8_SA(1, 0), cA + kstep, voffA); PG8_STAGE(PG8_SB(1, 1), cB + hstep + kstep, voffB);
        PG8_WAIT_V(6); PG8_BAR;
    } else {
        PG8_STAGE(PG8_SB(0, 0), cB, voffB); PG8_STAGE(PG8_SA(0, 0), cA, voffA); PG8_STAGE(PG8_SB(0, 1), cB + hstep, voffB); PG8_STAGE(PG8_SA(0, 1), cA + hstep, voffA);
        if (wr == 1) PG8_BAR;
        PG8_WAIT_V(4); PG8_BAR;
        PG8_STAGE(PG8_SB(1, 0), cB + kstep, voffB); PG8_STAGE(PG8_SA(1, 0), cA + kstep, voffA); PG8_STAGE(PG8_SB(1, 1), cB + hstep + kstep, voffB);
        PG8_WAIT_V(6); PG8_BAR;
    }
    for (;;) {
        const bool has_next = S.next(ui + 1, nxt);
        const char* nA = has_next ? (const char*)g.A + (size_t)nxt.pm * tstep + (size_t)nxt.az * g.azs : cA; const char* nB = has_next ? (const char*)g.Bt + (size_t)nxt.pn * tstep : cB;
        for (int t = 0; t < nt; t += 2) {
            if constexpr (Epi::MIDK) { if (t == 8 || t == 16) E.mid(acc, cur, t >> 3, wr, wc, fr, fq); }
            const bool last = (t == nt - 2);
            const char* a1 = cA + (size_t)(t + 1) * kstep;
            const char* a2 = last ? nA : cA + (size_t)(t + 2) * kstep; const char* b2 = last ? nB : cB + (size_t)(t + 2) * kstep;
            const char* a3 = a2 + kstep; const char* b3 = b2 + kstep;
            if (last && has_next) S.a_ready(nxt);
            if constexpr (SP2) {
            PG8_LDB(B0, 0, 0); PG8_LDB(B1, 0, 1); PG8_SCHED; PG8_LDA(At, 0, 0); PG8_STAGE(PG8_SA(1, 1), a1 + hstep, voffA);
            PG8_WAIT_V(8); PG8_WAIT_L(0); PG8_BAR; PG8_MMA(0, 0, At, B0); PG8_MMA(0, 1, At, B1); PG8_BAR; PG8_SCHED;
            PG8_LDA(At, 0, 1); PG8_STAGE(PG8_SB(0, 0), b2, voffB); PG8_STAGE(PG8_SB(0, 1), b2 + hstep, voffB); PG8_STAGE(PG8_SA(0, 0), a2, voffA);
            PG8_WAIT_V(8); PG8_WAIT_L(0); PG8_BAR; PG8_MMA(1, 0, At, B0); PG8_MMA(1, 1, At, B1); PG8_BAR; PG8_SCHED;
            PG8_LDB(B0, 1, 0); PG8_LDB(B1, 1, 1); PG8_SCHED; PG8_LDA(At, 1, 0); PG8_STAGE(PG8_SA(0, 1), a2 + hstep, voffA);
            PG8_WAIT_V(8); PG8_WAIT_L(0); PG8_BAR; PG8_MMA(0, 0, At, B0); PG8_MMA(0, 1, At, B1); PG8_BAR; PG8_SCHED;
            PG8_LDA(At, 1, 1); PG8_STAGE(PG8_SB(1, 0), b3, voffB); PG8_STAGE(PG8_SB(1, 1), b3 + hstep, voffB); PG8_STAGE(PG8_SA(1, 0), a3, voffA);
            PG8_WAIT_V(8); PG8_WAIT_L(0); PG8_BAR; PG8_MMA(1, 0, At, B0); PG8_MMA(1, 1, At, B1); PG8_BAR; PG8_SCHED;
            } else {
            PG8_LDB(B0, 0, 0); PG8_SCHED; PG8_LDA(At, 0, 0); PG8_STAGE(PG8_SA(1, 1), a1 + hstep, voffA);
            PG8_WAIT_L(8); PG8_BAR; PG8_WAIT_L(0); PG8_MMA(0, 0, At, B0); PG8_BAR; PG8_SCHED;
            PG8_LDB(B1, 0, 1); PG8_STAGE(PG8_SB(0, 0), b2, voffB);
            PG8_BAR; PG8_WAIT_L(0); PG8_MMA(0, 1, At, B1); PG8_BAR;
            PG8_LDA(At, 0, 1); PG8_STAGE(PG8_SA(0, 0), a2, voffA);
            PG8_BAR; PG8_WAIT_L(0); PG8_MMA(1, 0, At, B0); PG8_BAR; PG8_SCHED;
            PG8_STAGE(PG8_SB(0, 1), b2 + hstep, voffB);
            PG8_WAIT_V(6); PG8_BAR; PG8_MMA(1, 1, At, B1); PG8_BAR;
            PG8_LDB(B0, 1, 0); PG8_SCHED; PG8_LDA(At, 1, 0); PG8_STAGE(PG8_SA(0, 1), a2 + hstep, voffA);
            PG8_WAIT_L(8); PG8_BAR; PG8_WAIT_L(0); PG8_MMA(0, 0, At, B0); PG8_BAR; PG8_SCHED;
            PG8_LDB(B1, 1, 1); PG8_STAGE(PG8_SB(1, 0), b3, voffB);
            PG8_BAR; PG8_WAIT_L(0); PG8_MMA(0, 1, At, B1); PG8_BAR;
            PG8_LDA(At, 1, 1); PG8_STAGE(PG8_SA(1, 0), a3, voffA);
            PG8_BAR; PG8_WAIT_L(0); PG8_MMA(1, 0, At, B0); PG8_BAR; PG8_SCHED;
            PG8_STAGE(PG8_SB(1, 1), b3 + hstep, voffB);
            PG8_WAIT_V(6); PG8_BAR; PG8_MMA(1, 1, At, B1); PG8_BAR;
            }
        }
        if constexpr (ALIGN_EPI) { if (wr == 0) PG8_BAR; }
        if constexpr (!Epi::AFTER_DRAIN) { E(acc, cur, wr, wc, fr, fq); S.done(cur); }
        if (!has_next) break;
#pragma unroll
        for (int a = 0; a < 2; ++a)
#pragma unroll
            for (int b = 0; b < 2; ++b)
#pragma unroll
                for (int m = 0; m < 4; ++m)
#pragma unroll
                    for (int n = 0; n < 2; ++n) acc[a][b][m][n] = (f32x4){0.f, 0.f, 0.f, 0.f};
        cur = nxt; cA = nA; cB = nB; ++ui;
        if constexpr (ALIGN_EPI) { if (wr == 1) PG8_BAR; }
    }
    PG8_WAIT_V(0);
    if constexpr (!ALIGN_EPI) { if (wr == 0) PG8_BAR; }
    PG8_BAR;
    if constexpr (Epi::AFTER_DRAIN) { E.fused(acc, cur, wr, wc, fr, fq, lds, wid, lane); S.done(cur); }
#undef PG8_SA
#undef PG8_SB
#undef PG8_STAGE
#undef PG8_LDA
#undef PG8_LDB
#undef PG8_MMA
#undef PG8_WAIT_V
#undef PG8_WAIT_L
#undef PG8_BAR
#undef PG8_SCHED
}
}

#define LAS __attribute__((address_space(3)))
typedef unsigned short bf16_t;
typedef short bf16x8 __attribute__((ext_vector_type(8)));
typedef short s16x4 __attribute__((ext_vector_type(4)));
typedef float f32x4 __attribute__((ext_vector_type(4)));
typedef float f32x16 __attribute__((ext_vector_type(16)));
typedef unsigned u32x4 __attribute__((ext_vector_type(4)));
typedef unsigned u32x2 __attribute__((ext_vector_type(2)));
constexpr int NB = 4, SEQ = 4096, DM = 1024, MTOK = NB * SEQ, NIN = 8192, BWID = 512, NLAYER = 2;
constexpr float RMS_EPS = 1e-6f;
constexpr size_t MiB = 1u << 20;
constexpr size_t WS_RS = 0;
constexpr size_t WS_W1 = 2 * MiB;
constexpr size_t WS_W2 = 34 * MiB;
constexpr size_t WS_W3 = 40 * MiB;
constexpr size_t WS_PW = 44 * MiB;
constexpr size_t WS_H = 45 * MiB;
constexpr size_t WS_U = 77 * MiB;
constexpr size_t ARRB = 16 * MiB;
constexpr size_t WS_MG = 205 * MiB;
constexpr size_t WS_END = 253 * MiB;
constexpr int LDS_BYTES = 147456;
constexpr int NPHASE = 1 + 5 * NLAYER;

__device__ __forceinline__ unsigned f2bf(float f) { unsigned u = __builtin_bit_cast(unsigned, f); return (u + 0x7fffu + ((u >> 16) & 1u)) >> 16; }
__device__ __forceinline__ unsigned pk2(float lo, float hi) { return f2bf(lo) | (f2bf(hi) << 16); }
__device__ __forceinline__ float bflo(unsigned u) { return __builtin_bit_cast(float, u << 16); }
__device__ __forceinline__ float bfhi(unsigned u) { return __builtin_bit_cast(float, u & 0xffff0000u); }
__device__ __forceinline__ float sigmoid_f(float x) { return __builtin_amdgcn_rcpf(1.f + __builtin_amdgcn_exp2f(-1.4426950408889634f * x)); }
__device__ __forceinline__ float silu_f(float x) { return x * sigmoid_f(x); }
__device__ __forceinline__ unsigned q8(float x) { const unsigned q = (unsigned)(sigmoid_f(x) * 255.f + 0.5f); return q < 1u ? 1u : q; }
__device__ __forceinline__ float wave_sum(float v) {
#pragma unroll
    for (int o = 1; o < 64; o <<= 1) v += __shfl_xor(v, o);
    return v;
}

constexpr size_t WS_CTL = 1 * MiB; constexpr size_t CTL_BYTES = 65536;
constexpr size_t CTL_CNT = 16384;
#define XB_TMO      128
#define XB_XCNT(j)  (256  + 64 * (j))
#define XB_XSUB(j)  (1280 + 64 * (j))
#define XB_XGEN(j)  (2304 + 64 * (j))
#define XB_TOP      3328
#define XB_TOPGEN   3392
#define XCD_BAR_WORDS 3456
#define XB_SPIN_CAP (1u << 18)

__device__ __forceinline__ unsigned xb_ld(unsigned* p)              { return __hip_atomic_load(p, __ATOMIC_RELAXED, __HIP_MEMORY_SCOPE_AGENT); }
__device__ __forceinline__ unsigned xb_add(unsigned* p, unsigned v) { return __hip_atomic_fetch_add(p, v, __ATOMIC_RELAXED, __HIP_MEMORY_SCOPE_AGENT); }
__device__ __forceinline__ unsigned xb_xcc_id() { return (unsigned)__builtin_amdgcn_s_getreg((3 << 11) | 20) & 0xFu; }
#define XB_SPIN(cond, bar) do { unsigned _sp = 0; while (cond) { __builtin_amdgcn_s_sleep(1); \
    if ((++_sp & 255u) == 0u) { if (xb_ld(&(bar)[XB_TMO])) break; if (_sp > XB_SPIN_CAP) { atomicAdd(&(bar)[XB_TMO], 1u); break; } } } } while (0)

struct XcdBarrier {
    unsigned* bar; unsigned x;
    volatile LAS unsigned* st;
};

__device__ __forceinline__ XcdBarrier xcd_barrier_post(unsigned* bar, volatile LAS unsigned* st) {
    XcdBarrier b; b.bar = bar; b.x = xb_xcc_id(); b.st = st;
    if (threadIdx.x == 0) (void)xb_add(&bar[XB_XCNT(b.x)], 1u);
    return b;
}
__device__ __forceinline__ void xcd_barrier_complete(unsigned* bar, unsigned x, unsigned& nloc, unsigned& nx) {
    const unsigned G = gridDim.x * gridDim.y * gridDim.z;
    unsigned sum, cnt, mine, sp = 0u;
    for (;;) {
        sum = 0u; cnt = 0u; mine = 0u;
#pragma unroll
        for (unsigned j = 0; j < 16; ++j) { const unsigned c = xb_ld(&bar[XB_XCNT(j)]); sum += c; cnt += (c > 0u) ? 1u : 0u; mine = (j == x) ? c : mine; }
        if (sum == G) break;
        __builtin_amdgcn_s_sleep(1);
        if ((++sp & 255u) == 0u) { if (xb_ld(&bar[XB_TMO])) break; if (sp > XB_SPIN_CAP) { atomicAdd(&bar[XB_TMO], 1u); break; } }
    }
    nloc = mine > 0u ? mine : 1u; nx = cnt > 0u ? cnt : 1u;
}

__device__ __forceinline__ void xcd_barrier(const XcdBarrier& b) {
    asm volatile("s_waitcnt vmcnt(0)" ::: "memory");
    __syncthreads();
    if (threadIdx.x == 0) {
        unsigned* bar = b.bar;
        __builtin_amdgcn_s_waitcnt(0);
        unsigned nloc = b.st[0], nx = b.st[1];
        if (nloc == 0u) { xcd_barrier_complete(bar, b.x, nloc, nx); b.st[0] = nloc; b.st[1] = nx; }
        const unsigned old = xb_add(&bar[XB_XSUB(b.x)], 1u);
        const unsigned gen = old / nloc;
        if (old + 1u == (gen + 1u) * nloc) {
            __builtin_amdgcn_fence(__ATOMIC_RELEASE, "agent");
            asm volatile("s_waitcnt vmcnt(0)" ::: "memory");
            const unsigned og = xb_add(&bar[XB_TOP], 1u);
            const unsigned tg = og / nx;
            if (og + 1u == (tg + 1u) * nx) xb_add(&bar[XB_TOPGEN], 1u);
            else XB_SPIN(xb_ld(&bar[XB_TOPGEN]) == tg, bar);
            __builtin_amdgcn_fence(__ATOMIC_ACQUIRE, "agent");
            asm volatile("s_waitcnt vmcnt(0)" ::: "memory");
        } else {
            XB_SPIN(xb_ld(&bar[XB_TOPGEN]) == gen, bar);
            __builtin_amdgcn_fence(__ATOMIC_ACQUIRE, "agent");
            asm volatile("s_waitcnt vmcnt(0)" ::: "memory");
        }
    }
    __syncthreads();
}


using pg8::Unit;
struct EpiU {
    static constexpr bool PERM = true, AFTER_DRAIN = false, MIDK = false;
    unsigned char* ws;
    __device__ __forceinline__ void operator()(const f32x4 (&acc)[2][2][4][2], const Unit& u, int wr, int wc, int fr, int fq) const {
        bf16_t* U = (bf16_t*)(ws + WS_U); unsigned char* MG = ws + WS_MG;
        const int pn = u.pn; const int row0 = u.pm * 256 + wr * 64 + fr;
        if (pn >= 20) {
            const int mc0 = (pn - 20) * 256 + wc * 32 + 8 * fq;
#pragma unroll
            for (int ai = 0; ai < 2; ++ai)
#pragma unroll
                for (int m = 0; m < 4; ++m) { unsigned char* rp = MG + (size_t)(row0 + ai * 128 + m * 16) * 3072 + mc0;
#pragma unroll
                    for (int bj = 0; bj < 2; ++bj) { const f32x4 v0 = acc[ai][bj][m][0], v1 = acc[ai][bj][m][1]; u32x2 w;
                        w.x = q8(v0[0]) | (q8(v0[1]) << 8) | (q8(v0[2]) << 16) | (q8(v0[3]) << 24); w.y = q8(v1[0]) | (q8(v1[1]) << 8) | (q8(v1[2]) << 16) | (q8(v1[3]) << 24);
                        *(u32x2*)(rp + bj * 128) = w; } }
        } else if (pn >= 4 && pn < 12) {
            const int ch0 = (pn - 4) * 64 + (4 * wc + fq) * 4;
            bf16_t* Z = U + 1 * (ARRB / 2); bf16_t* W = U + 5 * (ARRB / 2) + 512;
#pragma unroll
            for (int ai = 0; ai < 2; ++ai)
#pragma unroll
                for (int m = 0; m < 4; ++m) { const size_t rr = (size_t)(row0 + ai * 128 + m * 16); const size_t ro = rr * 512 + ch0, rw = rr * 1536 + ch0;
                    const f32x4 z = acc[ai][0][m][0] * acc[ai][0][m][1]; const f32x4 gb = acc[ai][1][m][0], gg = acc[ai][1][m][1];
                    u32x2 zz, ww; zz.x = pg8::cvt_pk_bf16(z[0], z[1]); zz.y = pg8::cvt_pk_bf16(z[2], z[3]);
                    ww.x = pg8::cvt_pk_bf16(gb[0] * silu_f(gg[0]), gb[1] * silu_f(gg[1])); ww.y = pg8::cvt_pk_bf16(gb[2] * silu_f(gg[2]), gb[3] * silu_f(gg[3]));
                    *(u32x2*)(Z + ro) = zz; *(u32x2*)(W + rw) = ww; }
        } else {
            const int kind = pn >> 1; int arr = 0, pitch = 512, coff = 0; bool act = false;
            if (kind == 1) { arr = 5; act = true; pitch = 1536; } else if (kind == 6) arr = 2; else if (kind == 7) arr = 3; else if (kind == 8) arr = 4; else if (kind == 9) { arr = 5; act = true; pitch = 1536; coff = 1024; }
            bf16_t* O = U + (size_t)arr * (ARRB / 2) + coff; const int col0 = (pn & 1) * 256 + wc * 32 + 8 * fq;
#pragma unroll
            for (int ai = 0; ai < 2; ++ai)
#pragma unroll
                for (int m = 0; m < 4; ++m) { bf16_t* rp = O + (size_t)(row0 + ai * 128 + m * 16) * pitch + col0;
#pragma unroll
                    for (int bj = 0; bj < 2; ++bj) { f32x4 v0 = acc[ai][bj][m][0], v1 = acc[ai][bj][m][1];
                        if (act) {
#pragma unroll
                            for (int i = 0; i < 4; ++i) { v0[i] = silu_f(v0[i]); v1[i] = silu_f(v1[i]); } }
                        u32x4 w; w.x = pg8::cvt_pk_bf16(v0[0], v0[1]); w.y = pg8::cvt_pk_bf16(v0[2], v0[3]); w.z = pg8::cvt_pk_bf16(v1[0], v1[1]); w.w = pg8::cvt_pk_bf16(v1[2], v1[3]);
                        *(u32x4*)(rp + bj * 128) = w; } }
        }
    }
};
struct EpiBranch {
    static constexpr bool PERM = true, AFTER_DRAIN = false, MIDK = true;
    unsigned char* ws;
    __device__ __forceinline__ void mid(f32x4 (&acc)[2][2][4][2], const Unit& u, int seg, int wr, int wc, int fr, int fq) const {
        int tid_ = threadIdx.x; asm volatile("" : "+v"(tid_));
        const int wid_ = tid_ >> 6, wr_ = wid_ >> 2, wc_ = wid_ & 3, fr_ = tid_ & 15, fq_ = (tid_ & 63) >> 4;
        const unsigned char* MG = ws + WS_MG + (seg - 1) * 1024; const int row0 = u.pm * 256 + wr_ * 64 + fr_, col0 = u.pn * 256 + wc_ * 32 + 8 * fq_;
#pragma unroll
        for (int ai = 0; ai < 2; ++ai)
#pragma unroll
            for (int m = 0; m < 4; ++m) { const unsigned char* rp = MG + (size_t)(row0 + ai * 128 + m * 16) * 3072 + col0;
#pragma unroll
                for (int bj = 0; bj < 2; ++bj) { const u32x2 qa = *(const u32x2*)(rp + bj * 128), qb = *(const u32x2*)(rp + bj * 128 + 1024);
                    f32x4 r0, r1;
                    r0[0] = (float)(qa.x & 255u) * __builtin_amdgcn_rcpf((float)(qb.x & 255u)); r0[1] = (float)((qa.x >> 8) & 255u) * __builtin_amdgcn_rcpf((float)((qb.x >> 8) & 255u));
                    r0[2] = (float)((qa.x >> 16) & 255u) * __builtin_amdgcn_rcpf((float)((qb.x >> 16) & 255u)); r0[3] = (float)(qa.x >> 24) * __builtin_amdgcn_rcpf((float)(qb.x >> 24));
                    r1[0] = (float)(qa.y & 255u) * __builtin_amdgcn_rcpf((float)(qb.y & 255u)); r1[1] = (float)((qa.y >> 8) & 255u) * __builtin_amdgcn_rcpf((float)((qb.y >> 8) & 255u));
                    r1[2] = (float)((qa.y >> 16) & 255u) * __builtin_amdgcn_rcpf((float)((qb.y >> 16) & 255u)); r1[3] = (float)(qa.y >> 24) * __builtin_amdgcn_rcpf((float)(qb.y >> 24));
                    acc[ai][bj][m][0] *= r0; acc[ai][bj][m][1] *= r1; }
                if (m == 3) asm volatile("" ::: "memory"); }
    }
    __device__ __forceinline__ void operator()(const f32x4 (&acc)[2][2][4][2], const Unit& u, int wr, int wc, int fr, int fq) const {
        const unsigned char* MG = ws + WS_MG + 2 * 1024; bf16_t* merged = (bf16_t*)(ws + WS_H);
        const int row0 = u.pm * 256 + wr * 64 + fr, col0 = u.pn * 256 + wc * 32 + 8 * fq;
        u32x2 gq[2][4][2];
#pragma unroll
        for (int ai = 0; ai < 2; ++ai)
#pragma unroll
            for (int m = 0; m < 4; ++m)
#pragma unroll
                for (int bj = 0; bj < 2; ++bj) gq[ai][m][bj] = *(const u32x2*)(MG + (size_t)(row0 + ai * 128 + m * 16) * 3072 + col0 + bj * 128);
#pragma unroll
        for (int ai = 0; ai < 2; ++ai)
#pragma unroll
            for (int m = 0; m < 4; ++m) { const size_t row = (size_t)(row0 + ai * 128 + m * 16);
#pragma unroll
                for (int bj = 0; bj < 2; ++bj) { const int col = col0 + bj * 128; const u32x2 g = gq[ai][m][bj];
                    f32x4 g0, g1; const float k = 1.f / 255.f;
                    g0[0] = (float)(g.x & 255u) * k; g0[1] = (float)((g.x >> 8) & 255u) * k; g0[2] = (float)((g.x >> 16) & 255u) * k; g0[3] = (float)(g.x >> 24) * k;
                    g1[0] = (float)(g.y & 255u) * k; g1[1] = (float)((g.y >> 8) & 255u) * k; g1[2] = (float)((g.y >> 16) & 255u) * k; g1[3] = (float)(g.y >> 24) * k;
                    const f32x4 v0 = acc[ai][bj][m][0] * g0, v1 = acc[ai][bj][m][1] * g1;
                    u32x4 w; w.x = pg8::cvt_pk_bf16(v0[0], v0[1]); w.y = pg8::cvt_pk_bf16(v0[2], v0[3]); w.z = pg8::cvt_pk_bf16(v1[0], v1[1]); w.w = pg8::cvt_pk_bf16(v1[2], v1[3]);
                    *(u32x4*)(merged + row * 1024 + col) = w; } }
    }
};
struct EpiOut {
    static constexpr bool PERM = false, AFTER_DRAIN = false, MIDK = false;
    unsigned char* ws;
    __device__ __forceinline__ void operator()(const f32x4 (&acc)[2][2][4][2], const Unit& u, int wr, int wc, int fr, int fq) const {
        float* out = (float*)(ws + WS_U); float* rs = (float*)(ws + WS_RS);
        const int row0 = u.pm * 256 + wr * 64 + fr, col0 = u.pn * 256 + wc * 32 + 4 * fq;
#pragma unroll
        for (int ai = 0; ai < 2; ++ai)
#pragma unroll
            for (int m = 0; m < 4; ++m) { const size_t row = (size_t)(row0 + ai * 128 + m * 16); float ss = 0.f;
#pragma unroll
                for (int bj = 0; bj < 2; ++bj)
#pragma unroll
                    for (int n = 0; n < 2; ++n) { const f32x4 v = acc[ai][bj][m][n]; *(f32x4*)(out + row * 1024 + col0 + bj * 128 + n * 16) = v; ss += (v[0] * v[0] + v[1] * v[1]) + (v[2] * v[2] + v[3] * v[3]); }
                ss += __shfl_xor(ss, 16); ss += __shfl_xor(ss, 32);
                if (fq == 0) rs[row * 16 + u.pn * 4 + wc] = ss; }
    }
};

struct RmsPanel {
    float* xbuf;
    unsigned* cnt;
    __device__ __forceinline__ void run(const f32x4 (&v)[2][2][4][2], const Unit& u, int wr, int wc, int fr, int fq, LAS unsigned char* lds, int wid, int lane) const {
        LAS float* P = (LAS float*)lds; LAS float* S = (LAS float*)(lds + 8192);
#pragma unroll
        for (int ai = 0; ai < 2; ++ai)
#pragma unroll
            for (int m = 0; m < 4; ++m) { float s = 0.f;
#pragma unroll
                for (int bj = 0; bj < 2; ++bj)
#pragma unroll
                    for (int n = 0; n < 2; ++n) { const f32x4 x = v[ai][bj][m][n]; s += (x[0] * x[0] + x[1] * x[1]) + (x[2] * x[2] + x[3] * x[3]); }
                s += __shfl_xor(s, 16); s += __shfl_xor(s, 32);
                if (fq == 0) P[(ai * 128 + wr * 64 + m * 16 + fr) * 4 + wc] = s; }
        asm volatile("s_waitcnt lgkmcnt(0)" ::: "memory"); __builtin_amdgcn_s_barrier(); asm volatile("" ::: "memory");
        const int row = wid * 32 + (lane & 31);
        if (lane < 32) { const float t = (P[row * 4 + 0] + P[row * 4 + 1]) + (P[row * 4 + 2] + P[row * 4 + 3]);
            __hip_atomic_store(xbuf + (size_t)(u.pm * 256 + row) * 4 + u.pn, t, __ATOMIC_RELAXED, __HIP_MEMORY_SCOPE_AGENT); }
        asm volatile("s_waitcnt vmcnt(0)" ::: "memory");
        if (lane == 0) __hip_atomic_fetch_add(cnt + 64 * u.pm, 1u, __ATOMIC_RELAXED, __HIP_MEMORY_SCOPE_AGENT);
        if (wid == 0) {
            unsigned sp = 0;
            while ((unsigned)__builtin_amdgcn_readfirstlane(__hip_atomic_load(cnt + 64 * u.pm, __ATOMIC_RELAXED, __HIP_MEMORY_SCOPE_AGENT)) < 32u) { __builtin_amdgcn_s_sleep(2); if (++sp > (1u << 22)) break; }
            __builtin_amdgcn_fence(__ATOMIC_ACQUIRE, "agent");
        }
        asm volatile("s_waitcnt vmcnt(0) lgkmcnt(0)" ::: "memory"); __builtin_amdgcn_s_barrier(); asm volatile("" ::: "memory");
        if (lane < 32) { const float* slot = xbuf + (size_t)(u.pm * 256 + row) * 4; float t = 0.f;
#pragma unroll
            for (int k = 0; k < 4; ++k) t += __hip_atomic_load(slot + k, __ATOMIC_RELAXED, __HIP_MEMORY_SCOPE_AGENT);
            S[row] = 1.0f / sqrtf(t * (1.f / DM) + RMS_EPS); }
        asm volatile("s_waitcnt lgkmcnt(0)" ::: "memory"); __builtin_amdgcn_s_barrier(); asm volatile("" ::: "memory");
    }
};
struct EpiNorm1 {
    static constexpr bool PERM = false, AFTER_DRAIN = true, MIDK = false;
    float* out; const float* gpost; RmsPanel st;
    __device__ __forceinline__ void operator()(const f32x4 (&)[2][2][4][2], const Unit&, int, int, int, int) const {}
    __device__ __forceinline__ void fused(f32x4 (&acc)[2][2][4][2], const Unit& u, int wr, int wc, int fr, int fq, LAS unsigned char* lds, int wid, int lane) const {
        const LAS float* S = (const LAS float*)(lds + 8192);
        const int col0 = u.pn * 256 + wc * 32 + 4 * fq, jl0 = wc * 32 + 4 * fq;
        f32x4 gp[2][2]; u32x2 pre[2][4][2][2];
#pragma unroll
        for (int bj = 0; bj < 2; ++bj)
#pragma unroll
            for (int n = 0; n < 2; ++n) gp[bj][n] = *(const f32x4*)(gpost + col0 + bj * 128 + n * 16);
#pragma unroll
        for (int ai = 0; ai < 2; ++ai)
#pragma unroll
            for (int m = 0; m < 4; ++m) { const unsigned char* ob = (const unsigned char*)out + (size_t)(u.pm * 256 + ai * 128 + wr * 64 + m * 16 + fr) * 4096 + u.pn * 1024;
#pragma unroll
                for (int bj = 0; bj < 2; ++bj)
#pragma unroll
                    for (int n = 0; n < 2; ++n) pre[ai][m][bj][n] = *(const u32x2*)(ob + 2 * (jl0 + bj * 128 + n * 16)); }
        st.run(acc, u, wr, wc, fr, fq, lds, wid, lane);
#pragma unroll
        for (int ai = 0; ai < 2; ++ai)
#pragma unroll
            for (int m = 0; m < 4; ++m) { const int r = ai * 128 + wr * 64 + m * 16 + fr; const float rs = S[r]; const size_t off = (size_t)(u.pm * 256 + r) * DM + col0;
#pragma unroll
                for (int bj = 0; bj < 2; ++bj)
#pragma unroll
                    for (int n = 0; n < 2; ++n) { const u32x2 p = pre[ai][m][bj][n]; const f32x4 bs = (f32x4){bflo(p.x), bfhi(p.x), bflo(p.y), bfhi(p.y)};
                        *(f32x4*)(out + off + bj * 128 + n * 16) = bs + acc[ai][bj][m][n] * rs * gp[bj][n]; } }
    }
};
struct EpiNorm2 {
    static constexpr bool PERM = false, AFTER_DRAIN = true, MIDK = false;
    const float* base; float* out; bf16_t* hn; const float* gpost; const float* gnext; RmsPanel st1, st2;
    __device__ __forceinline__ void operator()(const f32x4 (&)[2][2][4][2], const Unit&, int, int, int, int) const {}
    __device__ __forceinline__ void fused(f32x4 (&acc)[2][2][4][2], const Unit& u, int wr, int wc, int fr, int fq, LAS unsigned char* lds, int wid, int lane) const {
        const LAS float* S = (const LAS float*)(lds + 8192);
        const int col0 = u.pn * 256 + wc * 32 + 4 * fq;
        f32x4 gp[2][2], pre[4][2][2];
#pragma unroll
        for (int bj = 0; bj < 2; ++bj)
#pragma unroll
            for (int n = 0; n < 2; ++n) gp[bj][n] = *(const f32x4*)(gpost + col0 + bj * 128 + n * 16);
#pragma unroll
        for (int m = 0; m < 4; ++m)
#pragma unroll
            for (int bj = 0; bj < 2; ++bj)
#pragma unroll
                for (int n = 0; n < 2; ++n) pre[m][bj][n] = *(const f32x4*)(base + (size_t)(u.pm * 256 + wr * 64 + m * 16 + fr) * DM + col0 + bj * 128 + n * 16);
        st1.run(acc, u, wr, wc, fr, fq, lds, wid, lane);
#pragma unroll
        for (int ai = 0; ai < 2; ++ai) {
            if (ai == 1) {
#pragma unroll
                for (int m = 0; m < 4; ++m)
#pragma unroll
                    for (int bj = 0; bj < 2; ++bj)
#pragma unroll
                        for (int n = 0; n < 2; ++n) pre[m][bj][n] = *(const f32x4*)(base + (size_t)(u.pm * 256 + 128 + wr * 64 + m * 16 + fr) * DM + col0 + bj * 128 + n * 16);
            }
#pragma unroll
            for (int m = 0; m < 4; ++m) { const int r = ai * 128 + wr * 64 + m * 16 + fr; const float rs = S[r]; const size_t off = (size_t)(u.pm * 256 + r) * DM + col0;
#pragma unroll
                for (int bj = 0; bj < 2; ++bj)
#pragma unroll
                    for (int n = 0; n < 2; ++n) { const f32x4 x1 = pre[m][bj][n] + acc[ai][bj][m][n] * rs * gp[bj][n]; acc[ai][bj][m][n] = x1;
                        u32x2 w; w.x = pg8::cvt_pk_bf16(x1[0], x1[1]); w.y = pg8::cvt_pk_bf16(x1[2], x1[3]);
                        *(u32x2*)((unsigned char*)out + (size_t)(u.pm * 256 + r) * 4096 + u.pn * 1024 + 2 * (wc * 32 + 4 * fq + bj * 128 + n * 16)) = w; } }
        }
#pragma unroll
        for (int bj = 0; bj < 2; ++bj)
#pragma unroll
            for (int n = 0; n < 2; ++n) gp[bj][n] = *(const f32x4*)(gnext + col0 + bj * 128 + n * 16);
        st2.run(acc, u, wr, wc, fr, fq, lds, wid, lane);
#pragma unroll
        for (int ai = 0; ai < 2; ++ai)
#pragma unroll
            for (int m = 0; m < 4; ++m) { const int r = ai * 128 + wr * 64 + m * 16 + fr; const float rs = S[r]; const size_t off = (size_t)(u.pm * 256 + r) * DM + col0;
#pragma unroll
                for (int bj = 0; bj < 2; ++bj)
#pragma unroll
                    for (int n = 0; n < 2; ++n) { const f32x4 o = acc[ai][bj][m][n] * rs * gp[bj][n];
                        u32x2 w; w.x = pg8::cvt_pk_bf16(o[0], o[1]); w.y = pg8::cvt_pk_bf16(o[2], o[3]); *(u32x2*)(hn + off + bj * 128 + n * 16) = w; } }
    }
};
__device__ __forceinline__ int win_row(int c) {
    if (c < 1024 || c >= 3072) return c;
    const int q = (c - 1024) >> 9, ch = (c - 1024) & 511, ct = ch >> 6, grp = (ch & 63) >> 2, e = ch & 3;
    return 1024 + ct * 256 + (q & 1) * 128 + grp * 8 + (q >> 1) * 4 + e;
}
__device__ __forceinline__ void transpose_item(const float* W, int N, bf16_t* WT, int ldt, int koff, int row_off, bool winmap, LAS float* scr, int item, int lane, const float* rscale = nullptr) {
    const int nblk = N / 64, kb = item / nblk, nb = item % nblk, k0 = 64 * kb, n0 = 64 * nb;
    const int kq = lane >> 4, nq = lane & 15;
    f32x4 v[16];
#pragma unroll
    for (int i = 0; i < 16; ++i) v[i] = *(const f32x4*)(W + (size_t)(k0 + 4 * i + kq) * N + n0 + 4 * nq);
#pragma unroll
    for (int i = 0; i < 16; ++i) { LAS float* s = scr + (4 * i + kq) * 65 + 4 * nq; s[0] = v[i][0]; s[1] = v[i][1]; s[2] = v[i][2]; s[3] = v[i][3]; }
    asm volatile("s_waitcnt lgkmcnt(0)" ::: "memory");
    const int c = lane & 7;
#pragma unroll
    for (int j = 0; j < 8; ++j) { const int n = (lane >> 3) + 8 * j;
        const LAS float* s = scr + (rscale ? (16 * (c >> 1) + 4 * (c & 1)) : 8 * c) * 65 + n; const int hs = rscale ? 8 * 65 : 4 * 65; const float f = rscale ? rscale[n0 + n] : 1.f;
        u32x4 o; o.x = pg8::cvt_pk_bf16(s[0 * 65] * f, s[1 * 65] * f); o.y = pg8::cvt_pk_bf16(s[2 * 65] * f, s[3 * 65] * f); o.z = pg8::cvt_pk_bf16(s[hs] * f, s[hs + 65] * f); o.w = pg8::cvt_pk_bf16(s[hs + 2 * 65] * f, s[hs + 3 * 65] * f);
        int dst = n0 + n; if (winmap) dst = win_row(dst);
        *(u32x4*)(WT + (size_t)(row_off + dst) * ldt + koff + k0 + 8 * c) = o; }
    asm volatile("s_waitcnt lgkmcnt(0)" ::: "memory");
}
template <int R> __device__ __forceinline__ void rms_rows_to_bf16(const float* x, const float* g, bf16_t* H, int m0, int mstride, int lane) {
    f32x4 v[R][4];
#pragma unroll
    for (int r = 0; r < R; ++r)
#pragma unroll
        for (int j = 0; j < 4; ++j) v[r][j] = ((const f32x4*)(x + (size_t)(m0 + r * mstride) * DM))[64 * j + lane];
    f32x4 gg[4];
#pragma unroll
    for (int j = 0; j < 4; ++j) gg[j] = ((const f32x4*)g)[64 * j + lane];
#pragma unroll
    for (int r = 0; r < R; ++r) { float s = 0.f;
#pragma unroll
        for (int j = 0; j < 4; ++j) s += (v[r][j][0] * v[r][j][0] + v[r][j][1] * v[r][j][1]) + (v[r][j][2] * v[r][j][2] + v[r][j][3] * v[r][j][3]);
        const float rstd = 1.f / sqrtf(wave_sum(s) * (1.f / DM) + RMS_EPS);
        u32x2* o8 = (u32x2*)(H + (size_t)(m0 + r * mstride) * DM) + lane;
#pragma unroll
        for (int j = 0; j < 4; ++j) { u32x2 w; w.x = pg8::cvt_pk_bf16(v[r][j][0] * rstd * gg[j][0], v[r][j][1] * rstd * gg[j][1]); w.y = pg8::cvt_pk_bf16(v[r][j][2] * rstd * gg[j][2], v[r][j][3] * rstd * gg[j][3]); o8[64 * j] = w; } }
}

__device__ __forceinline__ int crow(int r, int hi) { return (r & 3) + 8 * (r >> 2) + 4 * hi; }
constexpr int VROW = 144;
__device__ __forceinline__ void attn_item(int item, const bf16_t* Q, const bf16_t* K, const bf16_t* V, const bf16_t* SG, bf16_t* YO, LAS unsigned char* vl, int lane) {
    const int qg = item & 127, h = (item >> 7) & 7, b = item >> 10;
    const int r32 = lane & 31, hi = lane >> 5, t0 = qg * 32;
    const size_t tokq = (size_t)b * SEQ + t0 + r32;
    bf16x8 qf[4];
#pragma unroll
    for (int d0 = 0; d0 < 4; ++d0) qf[d0] = *(const bf16x8*)(Q + tokq * 512 + h * 64 + d0 * 16 + 8 * hi);
    f32x16 o0, o1;
#pragma unroll
    for (int r = 0; r < 16; ++r) { o0[r] = 0.f; o1[r] = 0.f; }
    float P = 1.f;
    const int i16 = lane & 15, G4 = lane >> 4;
    const int vb = (4 * (G4 >> 1) + (i16 >> 2)) * VROW + (16 * (G4 & 1) + 4 * (i16 & 3)) * 2;
#define ATT_LOAD(KF, VR, S0) do { const size_t tk_ = (size_t)b * SEQ + ((S0) > 0 ? (S0) : 0); \
        _Pragma("unroll") for (int d0 = 0; d0 < 4; ++d0) KF[d0] = *(const bf16x8*)(K + (tk_ + r32) * 512 + h * 64 + d0 * 16 + 8 * hi); \
        _Pragma("unroll") for (int p = 0; p < 4; ++p) { const int idx = p * 64 + lane; VR[p] = *(const u32x4*)(V + (tk_ + (idx >> 3)) * 512 + h * 64 + (idx & 7) * 8); } } while (0)
    bf16x8 kf[4], kn[4]; u32x4 vr[4], vn[4];
    ATT_LOAD(kf, vr, t0); ATT_LOAD(kn, vn, t0 - 32);
    u32x2 sgv[8];
#pragma unroll
    for (int i = 0; i < 8; ++i) sgv[i] = *(const u32x2*)(SG + tokq * 1536 + h * 64 + (i >> 2) * 32 + 8 * (i & 3) + 4 * hi);
    for (int s0 = t0; s0 >= 0; s0 -= 32) {
        bf16x8 k2[4]; u32x4 v2[4];
        ATT_LOAD(k2, v2, s0 - 64);
#pragma unroll
        for (int p = 0; p < 4; ++p) { const int idx = p * 64 + lane, key = idx >> 3, ch = idx & 7; *(LAS u32x4*)(vl + key * VROW + ch * 16) = vr[p]; }
        f32x16 s;
#pragma unroll
        for (int r = 0; r < 16; ++r) s[r] = 0.f;
#pragma unroll
        for (int d0 = 0; d0 < 4; ++d0) s = __builtin_amdgcn_mfma_f32_32x32x16_bf16(kf[d0], qf[d0], s, 0, 0, 0);
        const bool diag = (s0 == t0);
        float kp[16];
#pragma unroll
        for (int r = 0; r < 16; ++r) { const float e = __builtin_amdgcn_exp2f(s[r] * (0.125f * 1.4426950408889634f)); float k = __builtin_amdgcn_rcpf(1.f + e);
            if (diag && crow(r, hi) >= r32) k = 1.f; kp[r] = k; }
        float Gm[4], Go[4], T[4], R[4], C[4];
#pragma unroll
        for (int g = 0; g < 4; ++g) { Gm[g] = (kp[4 * g] * kp[4 * g + 1]) * (kp[4 * g + 2] * kp[4 * g + 3]); Go[g] = __shfl_xor(Gm[g], 32); T[g] = Gm[g] * Go[g]; }
        R[3] = P; R[2] = R[3] * T[3]; R[1] = R[2] * T[2]; R[0] = R[1] * T[1]; const float Cout = R[0] * T[0];
#pragma unroll
        for (int g = 0; g < 4; ++g) C[g] = hi ? R[g] : R[g] * Go[g];
        float w[16];
#pragma unroll
        for (int g = 0; g < 4; ++g) { const float p3 = C[g], p2 = p3 * kp[4 * g + 3], p1 = p2 * kp[4 * g + 2], p0 = p1 * kp[4 * g + 1], pe = p0 * kp[4 * g];
            w[4 * g + 3] = p3 - p2; w[4 * g + 2] = p2 - p1; w[4 * g + 1] = p1 - p0; w[4 * g] = p0 - pe; }
        bf16x8 wf[2];
#pragma unroll
        for (int st = 0; st < 2; ++st) { u32x4 t; t.x = pg8::cvt_pk_bf16(w[8 * st], w[8 * st + 1]); t.y = pg8::cvt_pk_bf16(w[8 * st + 2], w[8 * st + 3]); t.z = pg8::cvt_pk_bf16(w[8 * st + 4], w[8 * st + 5]); t.w = pg8::cvt_pk_bf16(w[8 * st + 6], w[8 * st + 7]); wf[st] = __builtin_bit_cast(bf16x8, t); }
#pragma unroll
        for (int dt = 0; dt < 2; ++dt)
#pragma unroll
            for (int st = 0; st < 2; ++st) {
                const s16x4 lo = __builtin_amdgcn_ds_read_tr16_b64_v4i16((LAS s16x4*)(vl + vb + (16 * st) * VROW + dt * 64));
                const s16x4 hh = __builtin_amdgcn_ds_read_tr16_b64_v4i16((LAS s16x4*)(vl + vb + (16 * st + 8) * VROW + dt * 64));
                const bf16x8 vf = (bf16x8){lo[0], lo[1], lo[2], lo[3], hh[0], hh[1], hh[2], hh[3]};
                if (dt == 0) o0 = __builtin_amdgcn_mfma_f32_32x32x16_bf16(vf, wf[st], o0, 0, 0, 0); else o1 = __builtin_amdgcn_mfma_f32_32x32x16_bf16(vf, wf[st], o1, 0, 0, 0); }
        P = Cout;
        if (__all(P < 1.17549435e-38f)) break;
#pragma unroll
        for (int i = 0; i < 4; ++i) { kf[i] = kn[i]; vr[i] = vn[i]; kn[i] = k2[i]; vn[i] = v2[i]; }
    }
#undef ATT_LOAD
#pragma unroll
    for (int dt = 0; dt < 2; ++dt)
#pragma unroll
        for (int g = 0; g < 4; ++g) { const size_t po = tokq * 1536 + h * 64 + dt * 32 + 8 * g + 4 * hi; const u32x2 sg = sgv[dt * 4 + g];
            const f32x16& o = dt ? o1 : o0; u32x2 y;
            y.x = pg8::cvt_pk_bf16(o[4 * g] * bflo(sg.x), o[4 * g + 1] * bfhi(sg.x)); y.y = pg8::cvt_pk_bf16(o[4 * g + 2] * bflo(sg.y), o[4 * g + 3] * bfhi(sg.y));
            *(u32x2*)(YO + po) = y; }
}
constexpr int PROW = 272;
__device__ __forceinline__ void pool_item(int pi, const bf16_t* PV, const bf16_t* SG, bf16_t* YO, const bf16_t* PT, const float* scale, LAS unsigned char* sl, int lane) {
    const int tile = pi >> 2, g = ((pi & 3) + ((pi >> 2) & 1)) & 3, win = 2 << g;
    const int r32 = lane & 31, hi = lane >> 5, tok0 = tile * 32, t0 = tok0 & (SEQ - 1), tok = tok0 + r32;
    u32x4 sv[12];
#pragma unroll
    for (int p = 0; p < 12; ++p) { const int idx = p * 64 + lane, row = idx >> 4, ch = idx & 15; const bool ok = (t0 + row - 16) >= 0;
        sv[p] = *(const u32x4*)(PV + (size_t)(ok ? tok0 + row - 16 : tok0) * 512 + g * 128 + ch * 8); if (!ok) sv[p] = (u32x4){0u, 0u, 0u, 0u}; }
#pragma unroll
    for (int p = 0; p < 12; ++p) { const int idx = p * 64 + lane, row = idx >> 4, ch = idx & 15; *(LAS u32x4*)(sl + row * PROW + ch * 16) = sv[p]; }
    const int t = t0 + r32, cnt = (t + 1) < win ? (t + 1) : win;
    bf16x8 bfr[3];
#pragma unroll
    for (int ks = 0; ks < 3; ++ks) { float wv[8];
#pragma unroll
        for (int j = 0; j < 8; ++j) { const int rel = (16 + r32) - (16 * ks + 8 * hi + j); wv[j] = (rel == 0) ? (float)(1 - cnt) : ((rel > 0 && rel < cnt) ? 1.f : 0.f); }
        u32x4 tt; tt.x = pg8::cvt_pk_bf16(wv[0], wv[1]); tt.y = pg8::cvt_pk_bf16(wv[2], wv[3]); tt.z = pg8::cvt_pk_bf16(wv[4], wv[5]); tt.w = pg8::cvt_pk_bf16(wv[6], wv[7]); bfr[ks] = __builtin_bit_cast(bf16x8, tt); }
    u32x2 sgv[16];
#pragma unroll
    for (int i = 0; i < 16; ++i) { const int dd = g * 128 + (i >> 2) * 32 + 8 * (i & 3) + 4 * hi; sgv[i] = *(const u32x2*)(SG + (size_t)tok * 1536 + dd); }
    bf16x8 ptf[4][8];
#pragma unroll
    for (int nt = 0; nt < 4; ++nt)
#pragma unroll
        for (int ks = 0; ks < 8; ++ks) ptf[nt][ks] = *(const bf16x8*)(PT + (size_t)(g * 128 + nt * 32 + r32) * 128 + 16 * ks + 8 * hi);
    const int i16 = lane & 15, G4 = lane >> 4;
    const int vb = (8 * (G4 >> 1) + (i16 >> 2)) * PROW + (16 * (G4 & 1) + 4 * (i16 & 3)) * 2;
    const float inv = __builtin_amdgcn_rcpf((float)cnt);
    bf16x8 pf[8];
#pragma unroll
    for (int ct = 0; ct < 4; ++ct) {
        f32x16 acc;
#pragma unroll
        for (int r = 0; r < 16; ++r) acc[r] = 0.f;
#pragma unroll
        for (int ks = 0; ks < 3; ++ks) {
            const s16x4 lo = __builtin_amdgcn_ds_read_tr16_b64_v4i16((LAS s16x4*)(sl + vb + (16 * ks) * PROW + ct * 64));
            const s16x4 hh = __builtin_amdgcn_ds_read_tr16_b64_v4i16((LAS s16x4*)(sl + vb + (16 * ks + 4) * PROW + ct * 64));
            const bf16x8 a = (bf16x8){lo[0], lo[1], lo[2], lo[3], hh[0], hh[1], hh[2], hh[3]};
            acc = __builtin_amdgcn_mfma_f32_32x32x16_bf16(a, bfr[ks], acc, 0, 0, 0); }
#pragma unroll
        for (int s = 0; s < 2; ++s) { u32x4 tt; tt.x = pg8::cvt_pk_bf16(acc[8 * s] * inv, acc[8 * s + 1] * inv); tt.y = pg8::cvt_pk_bf16(acc[8 * s + 2] * inv, acc[8 * s + 3] * inv);
            tt.z = pg8::cvt_pk_bf16(acc[8 * s + 4] * inv, acc[8 * s + 5] * inv); tt.w = pg8::cvt_pk_bf16(acc[8 * s + 6] * inv, acc[8 * s + 7] * inv); pf[2 * ct + s] = __builtin_bit_cast(bf16x8, tt); }
    }
#pragma unroll
    for (int nt = 0; nt < 4; ++nt) {
        f32x16 acc;
#pragma unroll
        for (int r = 0; r < 16; ++r) acc[r] = 0.f;
#pragma unroll
        for (int ks = 0; ks < 8; ++ks) acc = __builtin_amdgcn_mfma_f32_32x32x16_bf16(ptf[nt][ks], pf[ks], acc, 0, 0, 0);
#pragma unroll
        for (int q = 0; q < 4; ++q) { const int dd = g * 128 + nt * 32 + 8 * q + 4 * hi;
            const size_t po = (size_t)tok * 1536 + dd; const u32x2 sg = sgv[nt * 4 + q]; u32x2 y;
            y.x = pg8::cvt_pk_bf16(acc[4 * q] * bflo(sg.x), acc[4 * q + 1] * bfhi(sg.x)); y.y = pg8::cvt_pk_bf16(acc[4 * q + 2] * bflo(sg.y), acc[4 * q + 3] * bfhi(sg.y));
            *(u32x2*)(YO + po) = y; }
    }
}
__device__ __forceinline__ void conv_item(int ci, const bf16_t* Z, const bf16_t* Wy, bf16_t* YO, const float* cw, const float* cb, int lane) {
    const int tok0 = ci * 8, t0 = tok0 & (SEQ - 1), ch = lane * 8;
    float w0[8], w1[8], w2[8], bs[8], zm2[8], zm1[8];
#pragma unroll
    for (int hf = 0; hf < 2; ++hf) { const f32x4 a = *(const f32x4*)(cw + ch + 4 * hf), b = *(const f32x4*)(cw + 512 + ch + 4 * hf), c = *(const f32x4*)(cw + 1024 + ch + 4 * hf), d = *(const f32x4*)(cb + ch + 4 * hf);
#pragma unroll
        for (int i = 0; i < 4; ++i) { w0[4 * hf + i] = a[i]; w1[4 * hf + i] = b[i]; w2[4 * hf + i] = c[i]; bs[4 * hf + i] = d[i]; } }
#pragma unroll
    for (int i = 0; i < 8; ++i) { zm2[i] = 0.f; zm1[i] = 0.f; }
    if (t0 != 0) { const u32x4 a = *(const u32x4*)(Z + (size_t)(tok0 - 2) * 512 + ch), b = *(const u32x4*)(Z + (size_t)(tok0 - 1) * 512 + ch);
        zm2[0] = bflo(a.x); zm2[1] = bfhi(a.x); zm2[2] = bflo(a.y); zm2[3] = bfhi(a.y); zm2[4] = bflo(a.z); zm2[5] = bfhi(a.z); zm2[6] = bflo(a.w); zm2[7] = bfhi(a.w);
        zm1[0] = bflo(b.x); zm1[1] = bfhi(b.x); zm1[2] = bflo(b.y); zm1[3] = bfhi(b.y); zm1[4] = bflo(b.z); zm1[5] = bfhi(b.z); zm1[6] = bflo(b.w); zm1[7] = bfhi(b.w); }
    u32x4 zr[8], wr_[8];
#pragma unroll
    for (int r = 0; r < 8; ++r) { zr[r] = *(const u32x4*)(Z + (size_t)(tok0 + r) * 512 + ch); wr_[r] = *(const u32x4*)(Wy + (size_t)(tok0 + r) * 1536 + ch); }
#pragma unroll
    for (int r = 0; r < 8; ++r) {
        float zc[8], wv[8], y[8];
        zc[0] = bflo(zr[r].x); zc[1] = bfhi(zr[r].x); zc[2] = bflo(zr[r].y); zc[3] = bfhi(zr[r].y); zc[4] = bflo(zr[r].z); zc[5] = bfhi(zr[r].z); zc[6] = bflo(zr[r].w); zc[7] = bfhi(zr[r].w);
        wv[0] = bflo(wr_[r].x); wv[1] = bfhi(wr_[r].x); wv[2] = bflo(wr_[r].y); wv[3] = bfhi(wr_[r].y); wv[4] = bflo(wr_[r].z); wv[5] = bfhi(wr_[r].z); wv[6] = bflo(wr_[r].w); wv[7] = bfhi(wr_[r].w);
#pragma unroll
        for (int i = 0; i < 8; ++i) { y[i] = wv[i] * (w0[i] * zm2[i] + w1[i] * zm1[i] + w2[i] * zc[i] + bs[i]); zm2[i] = zm1[i]; zm1[i] = zc[i]; }
        u32x4 o; o.x = pg8::cvt_pk_bf16(y[0], y[1]); o.y = pg8::cvt_pk_bf16(y[2], y[3]); o.z = pg8::cvt_pk_bf16(y[4], y[5]); o.w = pg8::cvt_pk_bf16(y[6], y[7]);
        *(u32x4*)(YO + (size_t)(tok0 + r) * 1536 + ch) = o; }
}
template <int R> __device__ __forceinline__ void norm_rows(const float* F32T, const float* RS, const float* xin, const float* gpost, float* xout, const float* gnext, bf16_t* H, int m0, int mstride, int lane) {
    f32x4 o[R][4], xi[R][4]; float ss[R];
#pragma unroll
    for (int r = 0; r < R; ++r) { const size_t row = (size_t)(m0 + r * mstride); ss[r] = (lane < 16) ? RS[row * 16 + lane] : 0.f;
#pragma unroll
        for (int j = 0; j < 4; ++j) { o[r][j] = ((const f32x4*)(F32T + row * DM))[64 * j + lane]; xi[r][j] = ((const f32x4*)(xin + row * DM))[64 * j + lane]; } }
    f32x4 gp[4];
#pragma unroll
    for (int j = 0; j < 4; ++j) gp[j] = ((const f32x4*)gpost)[64 * j + lane];
#pragma unroll
    for (int r = 0; r < R; ++r) { const size_t row = (size_t)(m0 + r * mstride);
        const float rstd = 1.f / sqrtf(wave_sum(ss[r]) * (1.f / DM) + RMS_EPS); float s2 = 0.f;
#pragma unroll
        for (int j = 0; j < 4; ++j) { const f32x4 v = xi[r][j] + o[r][j] * rstd * gp[j]; xi[r][j] = v; ((f32x4*)(xout + row * DM))[64 * j + lane] = v; s2 += (v[0] * v[0] + v[1] * v[1]) + (v[2] * v[2] + v[3] * v[3]); }
        if (gnext) { const float r2 = 1.f / sqrtf(wave_sum(s2) * (1.f / DM) + RMS_EPS);
#pragma unroll
            for (int j = 0; j < 4; ++j) { const f32x4 gg = ((const f32x4*)gnext)[64 * j + lane]; const f32x4 v = xi[r][j]; u32x2 w; w.x = pg8::cvt_pk_bf16(v[0] * r2 * gg[0], v[1] * r2 * gg[1]); w.y = pg8::cvt_pk_bf16(v[2] * r2 * gg[2], v[3] * r2 * gg[3]); ((u32x2*)(H + row * DM))[64 * j + lane] = w; } } }
}

struct Args { const float* in[10]; float* out; unsigned char* ws; int ph_lo, ph_hi; };
template <class T> __device__ __forceinline__ T* as_global(T* p) { return p; }
#if TP_A >= 0
#define TSTAMP(k) do { if (blockIdx.x == TP_BLK && threadIdx.x == 0) ((volatile LAS unsigned long long*)(lds + 147264))[(k)] = __builtin_amdgcn_s_memrealtime(); } while (0)
#else
#define TSTAMP(k) do { } while (0)
#endif
template <int ph> __device__ __forceinline__ void run_phase(const Args& a_, LAS unsigned char* lds) {
        const Args* A = &a_;
        const int tid = threadIdx.x, lane = tid & 63, wave = __builtin_amdgcn_readfirstlane(tid >> 6);
        const int G = gridDim.x, bx = blockIdx.x;
        const int vcu = (G % 8 == 0) ? (bx % 8) * (G / 8) + bx / 8 : bx;
        const int gw = vcu * 8 + wave, NGW = G * 8;
        unsigned char* ws = as_global(A->ws);
        bf16_t* H = (bf16_t*)(ws + WS_H); bf16_t* U = (bf16_t*)(ws + WS_U);
        if constexpr (ph == 0) {
            const float* x = as_global(A->in[0]); const float* pre_g = as_global(A->in[1]); const float* w_in = as_global(A->in[2]); const float* pool_w = as_global(A->in[3]); const float* pool_scale = as_global(A->in[4]); const float* w_branch = as_global(A->in[7]); const float* w_out = as_global(A->in[8]);
            bf16_t* W1 = (bf16_t*)(ws + WS_W1); bf16_t* W2 = (bf16_t*)(ws + WS_W2); bf16_t* W3 = (bf16_t*)(ws + WS_W3); bf16_t* PW = (bf16_t*)(ws + WS_PW);
            LAS float* scr = (LAS float*)(lds + wave * 17408);
            constexpr int I1 = (DM / 64) * (NIN / 64), I2 = (BWID / 64) * (DM / 64), I3 = (DM / 64) * (DM / 64), I4 = 2 * 2, PER = I1 + 3 * I2 + I3 + 4 * I4;
            for (int it = gw; it < NLAYER * PER; it += NGW) {
                const int l = it / PER; int r = it % PER;
                if (r < I1) { transpose_item(w_in + (size_t)l * DM * NIN, NIN, W1 + (size_t)l * NIN * DM, DM, 0, 0, true, scr, r, lane); continue; } r -= I1;
                if (r < 3 * I2) { const int n = r / I2; transpose_item(w_branch + ((size_t)l * 3 + n) * BWID * DM, DM, W2 + (size_t)l * 3 * DM * BWID, 3 * BWID, n * BWID, 0, false, scr, r % I2, lane); continue; } r -= 3 * I2;
                if (r < I3) { transpose_item(w_out + (size_t)l * DM * DM, DM, W3 + (size_t)l * DM * DM, DM, 0, 0, false, scr, r, lane); continue; } r -= I3;
                { const int g = r / I4; transpose_item(pool_w + ((size_t)l * 4 + g) * 128 * 128, 128, PW + ((size_t)l * 4 + g) * 128 * 128, 128, 0, 0, false, scr, r % I4, lane, pool_scale + l * BWID + g * 128); }
            }
            for (int m = gw; m < MTOK; m += 2 * NGW) rms_rows_to_bf16<2>(x, pre_g, H, m, NGW, lane);
        } else {
            constexpr int l = (ph - 1) / 5, k = (ph - 1) % 5;
            if constexpr (k == 0) {
                pg8::Gemm g{H, (bf16_t*)(ws + WS_W1) + (size_t)l * NIN * DM, MTOK, NIN, DM, 0}; pg8::StaticOrder S; S.init(MTOK, NIN, G, bx);
                EpiU E{ws};
                pg8::gemm_phase<EpiU, pg8::StaticOrder, true, true>(lds, g, S, E);
            } else if constexpr (k == 1) {
                const float* pool_scale = as_global(A->in[4]); const float* conv_w = as_global(A->in[5]); const float* conv_b = as_global(A->in[6]);
                const bf16_t* PW = (const bf16_t*)(ws + WS_PW);
                const bf16_t* Q = U + 2 * (ARRB / 2); const bf16_t* Kk = U + 3 * (ARRB / 2); const bf16_t* V = U + 4 * (ARRB / 2);
                LAS unsigned char* vl = lds + wave * (32 * VROW);
                bf16_t* G3 = U + 5 * (ARRB / 2);
                bf16_t* YO = G3;
#if MIX_PROBE
                if (l == 0 && A->ph_hi < 0) YO = (bf16_t*)as_global(A->out);
#endif
                int pm_ = 7;
#if MIX_PROBE
                if (l == 0 && A->ph_hi < 0) pm_ = MIX_PROBE;
#endif
                if (l == 0) TSTAMP(12);
                volatile LAS unsigned* wq = (volatile LAS unsigned*)(lds + 147216);
                if (tid < 3) wq[tid] = 0u;
                __syncthreads();
#define WQ_GRAB(Q_) ({ unsigned v_ = 0u; if (lane == 0) v_ = __hip_atomic_fetch_add((LAS unsigned*)(Q_), 1u, __ATOMIC_RELAXED, __HIP_MEMORY_SCOPE_WORKGROUP); (unsigned)__builtin_amdgcn_readfirstlane((int)v_); })
#define WQ_ITEM(J_) ((int)(vcu * 8 + ((J_) & 7u) + ((J_) >> 3) * (unsigned)NGW))
                for (;;) { const unsigned j = WQ_GRAB(wq); const int it = WQ_ITEM(j); if (it >= NB * 8 * 128) break; attn_item(it, Q, Kk, V, G3 + 1024, YO + 1024, vl, lane); }
                if (l == 0) TSTAMP(13);
                for (;;) { const unsigned j = WQ_GRAB(wq + 1); const int it = WQ_ITEM(j); if (it >= (MTOK / 32) * 4) break; pool_item(it, U, G3, YO, PW + (size_t)l * 4 * 128 * 128, pool_scale + l * BWID, lds + 36864 + wave * (48 * PROW), lane); }
                if (l == 0) TSTAMP(14);
                for (;;) { const unsigned j = WQ_GRAB(wq + 2); const int it = WQ_ITEM(j); if (it >= MTOK / 8) break; conv_item(it, U + 1 * (ARRB / 2), G3 + 512, YO + 512, conv_w + l * 3 * BWID, conv_b + l * BWID, lane); }
#undef WQ_GRAB
#undef WQ_ITEM
                if (l == 0) TSTAMP(15);
#if TP_A >= 0
                if (l == 0) { __syncthreads(); TSTAMP(5); }
#endif
            } else if constexpr (k == 2) {
                pg8::Gemm g{U + 5 * (ARRB / 2), (bf16_t*)(ws + WS_W2) + (size_t)l * 3 * DM * BWID, MTOK, DM, 3 * BWID, 0}; pg8::StaticOrder S; S.init(MTOK, DM, G, bx);
                EpiBranch E{ws};
                pg8::gemm_phase<EpiBranch, pg8::StaticOrder, true, true>(lds, g, S, E);
            } else if constexpr (k == 3) {
                pg8::Gemm g{H, (bf16_t*)(ws + WS_W3) + (size_t)l * DM * DM, MTOK, DM, DM, 0}; pg8::StaticOrder S; S.init(MTOK, DM, G, bx);
                if (G == 256) {
                    const float* x = as_global(A->in[0]); const float* pre_g = as_global(A->in[1]); const float* post_g = as_global(A->in[9]); float* out = as_global(A->out);
                    float* xb = (float*)(ws + WS_RS); unsigned* cn = (unsigned*)(ws + WS_CTL + CTL_CNT);
                    if constexpr (l + 1 < NLAYER) {
                        EpiNorm2 E{x, out, H, post_g + l * DM, pre_g + (l + 1) * DM, RmsPanel{xb, cn}, RmsPanel{xb + (size_t)MTOK * 4, cn + 64 * 64}};
                        pg8::gemm_phase<EpiNorm2, pg8::StaticOrder, false, true>(lds, g, S, E);
                    } else {
                        EpiNorm1 E{out, post_g + l * DM, RmsPanel{xb + (size_t)2 * MTOK * 4, cn + 2 * 64 * 64}};
                        pg8::gemm_phase<EpiNorm1, pg8::StaticOrder, false, true>(lds, g, S, E);
                    }
                } else {
                    EpiOut E{ws};
                    pg8::gemm_phase<EpiOut, pg8::StaticOrder, true, true>(lds, g, S, E);
                }
            } else {
                const float* x = as_global(A->in[0]); const float* pre_g = as_global(A->in[1]); const float* post_g = as_global(A->in[9]); float* out = as_global(A->out);
                const float* F32T = (const float*)(ws + WS_U); const float* RS = (const float*)(ws + WS_RS);
                const float* xin = (l == 0) ? x : out; const float* gnext = (l + 1 < NLAYER) ? pre_g + (l + 1) * DM : nullptr;
                if (G != 256) for (int m = gw; m < MTOK; m += 2 * NGW) norm_rows<2>(F32T, RS, xin, post_g + l * DM, out, gnext, H, m, NGW, lane);
            }
        }
}
__global__ void __launch_bounds__(512, 2) hybrid_fwd(Args a_) {
    extern __shared__ __attribute__((aligned(16))) unsigned char lds_raw[];
    LAS unsigned char* lds = (LAS unsigned char*)lds_raw;
    cg::grid_group grid = cg::this_grid();
    if (threadIdx.x < 64) ((LAS unsigned*)(lds + 147200))[threadIdx.x] = 0u;
    __syncthreads();
    (void)xcd_barrier_post((unsigned*)(a_.ws + WS_CTL), (volatile LAS unsigned*)(lds + 147200 + 32));
#define SEAM_BAR() do { XcdBarrier b_; b_.bar = (unsigned*)(a_.ws + WS_CTL); b_.x = xb_xcc_id(); b_.st = (volatile LAS unsigned*)(lds + 147200 + 32); xcd_barrier(b_); } while (0)
    const int lo = a_.ph_lo, hi = a_.ph_hi < 0 ? -a_.ph_hi : a_.ph_hi;
#define PHASE(k) if (lo <= (k) && (k) < hi && !(((k) == 5 || (k) == 10) && gridDim.x == 256)) { if ((k) > lo) { if ((k) == 1 && lo < 0) grid.sync(); else SEAM_BAR(); } TSTAMP(k); run_phase<(k)>(a_, lds); }
    PHASE(0) PHASE(1) PHASE(2) PHASE(3) PHASE(4) PHASE(5) PHASE(6) PHASE(7) PHASE(8) PHASE(9) PHASE(10)
#undef PHASE
#if TP_A >= 0
    SEAM_BAR(); TSTAMP(11);
    if (blockIdx.x == TP_BLK && threadIdx.x == 0) { volatile LAS unsigned long long* ts = (volatile LAS unsigned long long*)(lds + 147264); a_.out[0] += (float)(ts[TP_B] - ts[TP_A]) * (0.00005f * TP_SCALE); }
#endif
}

extern "C" void kernel_launch(void* const* d_in, const int* in_sizes, int n_in, void* d_out, int out_size, void* d_ws, size_t ws_size, hipStream_t stream) {
    static int grid = 0;
    if (grid == 0) {
        if (n_in != 10 || out_size != MTOK * DM || ws_size < WS_END) { fprintf(stderr, "kernel_launch: unexpected shapes / workspace (n_in %d out %d ws %zu)\n", n_in, out_size, ws_size); grid = -1; return; }
        int dev = 0, cus = 0, per_cu = 0;
        (void)hipGetDevice(&dev); (void)hipDeviceGetAttribute(&cus, hipDeviceAttributeMultiprocessorCount, dev);
        (void)hipFuncSetAttribute((const void*)hybrid_fwd, hipFuncAttributeMaxDynamicSharedMemorySize, LDS_BYTES);
        (void)hipOccupancyMaxActiveBlocksPerMultiprocessor(&per_cu, (const void*)hybrid_fwd, 512, LDS_BYTES);
        (void)hipGetLastError();
        if (per_cu < 1) { fprintf(stderr, "kernel_launch: occupancy query says %d blocks/CU\n", per_cu); per_cu = 1; }
        grid = cus;
    }
    if (grid < 0) return;
    if (hipMemsetAsync((char*)d_ws + WS_CTL, 0, CTL_BYTES, stream) != hipSuccess) { fprintf(stderr, "kernel_launch: memset of the barrier words failed\n"); return; }
    Args a{};
    for (int i = 0; i < 10; ++i) a.in[i] = (const float*)d_in[i];
    a.out = (float*)d_out; a.ws = (unsigned char*)d_ws;
#if ONE_LAUNCH
    a.ph_lo = 0; a.ph_hi = NPHASE;
    void* args[] = {&a};
    hipError_t e = hipLaunchCooperativeKernel((const void*)hybrid_fwd, dim3(grid), dim3(512), args, LDS_BYTES, stream);
    if (e != hipSuccess) fprintf(stderr, "cooperative launch failed: %s (grid %d)\n", hipGetErrorString(e), grid);
#else
    for (int ph = 0; ph < NPHASE; ++ph) { a.ph_lo = ph; a.ph_hi = ph + 1;
#if MIX_PROBE
        if (ph == 2) { a.ph_hi = -(ph + 1); hipLaunchKernelGGL(hybrid_fwd, dim3(grid), dim3(512), LDS_BYTES, stream, a); a.ph_hi = ph + 1; }
#endif
        for (int rep = 0; rep < 1 + ((DUP_MASK >> ph) & 1); ++rep) hipLaunchKernelGGL(hybrid_fwd, dim3(grid), dim3(512), LDS_BYTES, stream, a); }
#endif
}
```

```cpp
#include <hip/hip_runtime.h>
#include <hip/hip_cooperative_groups.h>
#include <cstdio>
#include <cstdint>
namespace cg = cooperative_groups;
#ifndef ONE_LAUNCH
#define ONE_LAUNCH 1
#endif
#ifndef DUP_MASK
#define DUP_MASK 0
#endif
#ifndef MIX_PROBE
#define MIX_PROBE 0
#endif
#ifndef TP_A
#define TP_A -1
#define TP_B -1
#endif
#ifndef TP_SCALE
#define TP_SCALE 1
#endif
#ifndef TP_BLK
#define TP_BLK 0
#endif
namespace pg8 {
#define PG8_LAS __attribute__((address_space(3)))
typedef unsigned short bf16_t;
typedef short bf16x8 __attribute__((ext_vector_type(8)));
typedef float f32x4 __attribute__((ext_vector_type(4)));
typedef unsigned u32x4 __attribute__((ext_vector_type(4)));
constexpr int BM = 256, BK = 64, HALF = 128, HTB = HALF * BK * 2  , STAGE_BYTES = 8 * HTB, NXCD = 8, WGM = 8;

__host__ __device__ __forceinline__ int lds_byte(int r, int c) { const int st = (r >> 4) * 2 + (c >> 5), rr = r & 15, cc = c & 31, ob = rr * 64 + cc * 2; return st * 1024 + (ob ^ (((ob >> 9) & 1) << 5)); }
__host__ __device__ __forceinline__ void stage_rc(int b, int& R, int& C) { const int st = b / 1024, sb = b % 1024, swz = sb ^ (((sb >> 9) & 1) << 5); R = (st >> 1) * 16 + swz / 64; C = (st & 1) * 32 + (swz % 64) / 2; }
__host__ __device__ __forceinline__ int perm32(int rho) { const int n = rho >> 4, i = rho & 15; return 8 * (i >> 2) + 4 * n + (i & 3); }

struct Unit { int pm, pn, az; };
struct Gemm { const bf16_t* A; const bf16_t* Bt; int M, N, K; size_t azs; };

struct StaticOrder {
    int nM, nN, nwg, G, c;
    __host__ __device__ void init(int M, int N, int G_, int c_) { nM = M / BM; nN = N / BM; nwg = nM * nN; G = G_; c = c_; }
    __host__ __device__ bool next(int i, Unit& u) const {
        const long L = (long)i * G + c; if (L >= nwg) return false;
        int wgid = (int)L; { const int q = nwg / NXCD, r = nwg % NXCD, xcd = wgid % NXCD, off = wgid / NXCD; wgid = (xcd < r ? xcd * (q + 1) : r * (q + 1) + (xcd - r) * q) + off; }
        const int nig = WGM * nN, gid = wgid / nig, fm = gid * WGM, gsz = (nM - fm) < WGM ? (nM - fm) : WGM;
        u.pm = fm + ((wgid % nig) % gsz); u.pn = (wgid % nig) / gsz; u.az = 0; return true;
    }
    __device__ __forceinline__ void a_ready(const Unit&) const {}
    __device__ __forceinline__ void done(const Unit&) const {}
};

__device__ __forceinline__ unsigned cvt_pk_bf16(float lo, float hi) { unsigned r; asm volatile("v_cvt_pk_bf16_f32 %0, %1, %2" : "=v"(r) : "v"(lo), "v"(hi)); return r; }
template <class Epi, class Sched, bool ALIGN_EPI = false, bool SP2 = false>
__device__ __forceinline__ void gemm_phase(PG8_LAS unsigned char* lds, const Gemm g, const Sched& S, const Epi& E) {
    const int tid = threadIdx.x, wid = __builtin_amdgcn_readfirstlane(tid >> 6), lane = tid & 63, wr = wid >> 2, wc = wid & 3, fr = lane & 15, fq = lane >> 4;
    const int K = g.K, nt = K / BK;
    unsigned voffA[2], voffB[2];
#pragma unroll
    for (int i = 0; i < 2; ++i) { int R, C; stage_rc(tid * 16 + i * 8192, R, C); const int Rb = Epi::PERM ? ((R & ~31) + perm32(R & 31)) : R;
        voffA[i] = (unsigned)(R * K + C) * 2u; voffB[i] = (unsigned)(Rb * K + C) * 2u; }
    const size_t kstep = (size_t)(BK * 2);
    const size_t hstep = (size_t)HALF * K * 2;
    const size_t tstep = 2 * hstep;
    const unsigned ldsw = (unsigned)wid * 1024u;
    const int aoff = lds_byte(wr * 64 + fr, fq * 8), boff = lds_byte(wc * 32 + fr, fq * 8);
#define PG8_SA(b, h) (((b) * 2 + (h)) * HTB)
#define PG8_SB(b, h) ((4 + (b) * 2 + (h)) * HTB)
#define PG8_STAGE(bufoff, gbase, voff) do { _Pragma("unroll") for (int _i = 0; _i < 2; ++_i) \
        __builtin_amdgcn_global_load_lds((const unsigned*)((const char*)(gbase) + (voff)[_i]), (PG8_LAS unsigned*)(lds + (bufoff) + ldsw + _i * 8192), 16, 0, 0); } while (0)
#define PG8_LDA(dst, b, h) do { _Pragma("unroll") for (int m = 0; m < 4; ++m) _Pragma("unroll") for (int k = 0; k < 2; ++k) dst[m][k] = *(const PG8_LAS bf16x8*)(lds + PG8_SA(b, h) + aoff + m * 2048 + k * 1024); } while (0)
#define PG8_LDB(dst, b, h) do { _Pragma("unroll") for (int n = 0; n < 2; ++n) _Pragma("unroll") for (int k = 0; k < 2; ++k) dst[n][k] = *(const PG8_LAS bf16x8*)(lds + PG8_SB(b, h) + boff + n * 2048 + k * 1024); } while (0)
#define PG8_MMA(ai, bj, At, Bt) do { __builtin_amdgcn_s_setprio(1); _Pragma("unroll") for (int m = 0; m < 4; ++m) _Pragma("unroll") for (int n = 0; n < 2; ++n) _Pragma("unroll") for (int k = 0; k < 2; ++k) \
        acc[ai][bj][m][n] = __builtin_amdgcn_mfma_f32_16x16x32_bf16(Bt[n][k], At[m][k], acc[ai][bj][m][n], 0, 0, 0); __builtin_amdgcn_s_setprio(0); } while (0)
#define PG8_WAIT_V(n) asm volatile("s_waitcnt vmcnt(" #n ")" ::: "memory")
#define PG8_WAIT_L(n) asm volatile("s_waitcnt lgkmcnt(" #n ")" ::: "memory")
#define PG8_BAR __builtin_amdgcn_s_barrier()
#define PG8_SCHED __builtin_amdgcn_sched_barrier(0)
    Unit cur, nxt; int ui = 0;
    if (!S.next(0, cur)) return;
    f32x4 acc[2][2][4][2];
#pragma unroll
    for (int a = 0; a < 2; ++a)
#pragma unroll
        for (int b = 0; b < 2; ++b)
#pragma unroll
            for (int m = 0; m < 4; ++m)
#pragma unroll
                for (int n = 0; n < 2; ++n) acc[a][b][m][n] = (f32x4){0.f, 0.f, 0.f, 0.f};
    bf16x8 At[4][2], B0[2][2], B1[2][2];
    const char* cA = (const char*)g.A + (size_t)cur.pm * tstep + (size_t)cur.az * g.azs; const char* cB = (const char*)g.Bt + (size_t)cur.pn * tstep;
    S.a_ready(cur);
    if constexpr (SP2) {
        PG8_STAGE(PG8_SB(0, 0), cB, voffB); PG8_STAGE(PG8_SB(0, 1), cB + hstep, voffB); PG8_STAGE(PG8_SA(0, 0), cA, voffA); PG8_STAGE(PG8_SA(0, 1), cA + hstep, voffA);
        if (wr == 1) PG8_BAR;
        PG8_WAIT_V(2); PG8_BAR;
        PG8_STAGE(PG8_SB(1, 0), cB + kstep, voffB); PG8_STAGE(PG8_SA(1, 0), cA + kstep, voffA); PG8_STAGE(PG8_SB(1, 1), cB + hstep + kstep, voffB);
        PG8_WAIT_V(6); PG8_BAR;
    } else {
        PG8_STAGE(PG8_SB(0, 0), cB, voffB); PG8_STAGE(PG8_SA(0, 0), cA, voffA); PG8_STAGE(PG8_SB(0, 1), cB + hstep, voffB); PG8_STAGE(PG8_SA(0, 1), cA + hstep, voffA);
        if (wr == 1) PG8_BAR;
        PG8_WAIT_V(4); PG8_BAR;
        PG8_STAGE(PG8_SB(1, 0), cB + kstep, voffB); PG8_STAGE(PG8_SA(1, 0), cA + kstep, voffA); PG8_STAGE(PG8_SB(1, 1), cB + hstep + kstep, voffB);
        PG8_WAIT_V(6); PG8_BAR;
    }
    for (;;) {
        const bool has_next = S.next(ui + 1, nxt);
        const char* nA = has_next ? (const char*)g.A + (size_t)nxt.pm * tstep + (size_t)nxt.az * g.azs : cA; const char* nB = has_next ? (const char*)g.Bt + (size_t)nxt.pn * tstep : cB;
        for (int t = 0; t < nt; t += 2) {
            if constexpr (Epi::MIDK) { if (t == 8 || t == 16) E.mid(acc, cur, t >> 3, wr, wc, fr, fq); }
            const bool last = (t == nt - 2);
            const char* a1 = cA + (size_t)(t + 1) * kstep;
            const char* a2 = last ? nA : cA + (size_t)(t + 2) * kstep; const char* b2 = last ? nB : cB + (size_t)(t + 2) * kstep;
            const char* a3 = a2 + kstep; const char* b3 = b2 + kstep;
            if (last && has_next) S.a_ready(nxt);
            if constexpr (SP2) {
            PG8_LDB(B0, 0, 0); PG8_LDB(B1, 0, 1); PG8_SCHED; PG8_LDA(At, 0, 0); PG8_STAGE(PG8_SA(1, 1), a1 + hstep, voffA);
            PG8_WAIT_V(8); PG8_WAIT_L(0); PG8_BAR; PG8_MMA(0, 0, At, B0); PG8_MMA(0, 1, At, B1); PG8_BAR; PG8_SCHED;
            PG8_LDA(At, 0, 1); PG8_STAGE(PG8_SB(0, 0), b2, voffB); PG8_STAGE(PG8_SB(0, 1), b2 + hstep, voffB); PG8_STAGE(PG8_SA(0, 0), a2, voffA);
            PG8_WAIT_V(8); PG8_WAIT_L(0); PG8_BAR; PG8_MMA(1, 0, At, B0); PG8_MMA(1, 1, At, B1); PG8_BAR; PG8_SCHED;
            PG8_LDB(B0, 1, 0); PG8_LDB(B1, 1, 1); PG8_SCHED; PG8_LDA(At, 1, 0); PG8_STAGE(PG8_SA(0, 1), a2 + hstep, voffA);
            PG8_WAIT_V(8); PG8_WAIT_L(0); PG8_BAR; PG8_MMA(0, 0, At, B0); PG8_MMA(0, 1, At, B1); PG8_BAR; PG8_SCHED;
            PG8_LDA(At, 1, 1); PG8_STAGE(PG8_SB(1, 0), b3, voffB); PG8_STAGE(PG8_SB(1, 1), b3 + hstep, voffB); PG8_STAGE(PG8_SA(1, 0), a3, voffA);
            PG8_WAIT_V(8); PG8_WAIT_L(0); PG8_BAR; PG8_MMA(1, 0, At, B0); PG8_MMA(1, 1, At, B1); PG8_BAR; PG8_SCHED;
            } else {
            PG8_LDB(B0, 0, 0); PG8_SCHED; PG8_LDA(At, 0, 0); PG8_STAGE(PG8_SA(1, 1), a1 + hstep, voffA);
            PG8_WAIT_L(8); PG8_BAR; PG8_WAIT_L(0); PG8_MMA(0, 0, At, B0); PG8_BAR; PG8_SCHED;
            PG8_LDB(B1, 0, 1); PG8_STAGE(PG8_SB(0, 0), b2, voffB);
            PG8_BAR; PG8_WAIT_L(0); PG8_MMA(0, 1, At, B1); PG8_BAR;
            PG8_LDA(At, 0, 1); PG8_STAGE(PG8_SA(0, 0), a2, voffA);
            PG8_BAR; PG8_WAIT_L(0); PG8_MMA(1, 0, At, B0); PG8_BAR; PG8_SCHED;
            PG8_STAGE(PG8_SB(0, 1), b2 + hstep, voffB);
            PG8_WAIT_V(6); PG8_BAR; PG8_MMA(1, 1, At, B1); PG8_BAR;
            PG8_LDB(B0, 1, 0); PG8_SCHED; PG8_LDA(At, 1, 0); PG8_STAGE(PG8_SA(0, 1), a2 + hstep, voffA);
            PG8_WAIT_L(8); PG8_BAR; PG8_WAIT_L(0); PG8_MMA(0, 0, At, B0); PG8_BAR; PG8_SCHED;
            PG8_LDB(B1, 1, 1); PG8_STAGE(PG8_SB(1, 0), b3, voffB);
            PG8_BAR; PG8_WAIT_L(0); PG8_MMA(0, 1, At, B1); PG8_BAR;
            PG8_LDA(At, 1, 1); PG8_STAGE(PG8_SA(1, 0), a3, voffA);
            PG8_BAR; PG8_WAIT_L(0); PG8_MMA(1, 0, At, B0); PG8_BAR; PG8_SCHED;
            PG8_STAGE(PG8_SB(1, 1), b3 + hstep, voffB);
            PG8_WAIT_V(6); PG8_BAR; PG8_MMA(1, 1, At, B1); PG8_BAR;
            }
        }
        if constexpr (ALIGN_EPI) { if (wr == 0) PG8_BAR; }
        if constexpr (!Epi::AFTER_DRAIN) { E(acc, cur, wr, wc, fr, fq); S.done(cur); }
        if (!has_next) break;
#pragma unroll
        for (int a = 0; a < 2; ++a)
#pragma unroll
            for (int b = 0; b < 2; ++b)
#pragma unroll
                for (int m = 0; m < 4; ++m)
#pragma unroll
                    for (int n = 0; n < 2; ++n) acc[a][b][m][n] = (f32x4){0.f, 0.f, 0.f, 0.f};
        cur = nxt; cA = nA; cB = nB; ++ui;
        if constexpr (ALIGN_EPI) { if (wr == 1) PG8_BAR; }
    }
    PG8_WAIT_V(0);
    if constexpr (!ALIGN_EPI) { if (wr == 0) PG8_BAR; }
    PG8_BAR;
    if constexpr (Epi::AFTER_DRAIN) { E.fused(acc, cur, wr, wc, fr, fq, lds, wid, lane); S.done(cur); }
#undef PG8_SA
#undef PG8_SB
#undef PG8_STAGE
#undef PG8_LDA
#undef PG8_LDB
#undef PG8_MMA
#undef PG8_WAIT_V
#undef PG8_WAIT_L
#undef PG8_BAR
#undef PG8_SCHED
}
}

#define LAS __attribute__((address_space(3)))
typedef unsigned short bf16_t;
typedef short bf16x8 __attribute__((ext_vector_type(8)));
typedef short s16x4 __attribute__((ext_vector_type(4)));
typedef float f32x4 __attribute__((ext_vector_type(4)));
typedef float f32x16 __attribute__((ext_vector_type(16)));
typedef unsigned u32x4 __attribute__((ext_vector_type(4)));
typedef unsigned u32x2 __attribute__((ext_vector_type(2)));
constexpr int NB = 4, SEQ = 4096, DM = 1024, MTOK = NB * SEQ, NIN = 8192, BWID = 512, NLAYER = 2;
constexpr float RMS_EPS = 1e-6f;
constexpr size_t MiB = 1u << 20;
constexpr size_t WS_RS = 0;
constexpr size_t WS_W1 = 2 * MiB;
constexpr size_t WS_W2 = 34 * MiB;
constexpr size_t WS_W3 = 40 * MiB;
constexpr size_t WS_PW = 44 * MiB;
constexpr size_t WS_H = 45 * MiB;
constexpr size_t WS_U = 77 * MiB;
constexpr size_t ARRB = 16 * MiB;
constexpr size_t WS_MG = 205 * MiB;
constexpr size_t WS_END = 253 * MiB;
constexpr int LDS_BYTES = 147456;
constexpr int NPHASE = 1 + 5 * NLAYER;

__device__ __forceinline__ unsigned f2bf(float f) { unsigned u = __builtin_bit_cast(unsigned, f); return (u + 0x7fffu + ((u >> 16) & 1u)) >> 16; }
__device__ __forceinline__ unsigned pk2(float lo, float hi) { return f2bf(lo) | (f2bf(hi) << 16); }
__device__ __forceinline__ float bflo(unsigned u) { return __builtin_bit_cast(float, u << 16); }
__device__ __forceinline__ float bfhi(unsigned u) { return __builtin_bit_cast(float, u & 0xffff0000u); }
__device__ __forceinline__ float sigmoid_f(float x) { return __builtin_amdgcn_rcpf(1.f + __builtin_amdgcn_exp2f(-1.4426950408889634f * x)); }
__device__ __forceinline__ float silu_f(float x) { return x * sigmoid_f(x); }
__device__ __forceinline__ unsigned q8(float x) { const unsigned q = (unsigned)(sigmoid_f(x) * 255.f + 0.5f); return q < 1u ? 1u : q; }
__device__ __forceinline__ float wave_sum(float v) {
#pragma unroll
    for (int o = 1; o < 64; o <<= 1) v += __shfl_xor(v, o);
    return v;
}

constexpr size_t WS_CTL = 1 * MiB; constexpr size_t CTL_BYTES = 65536;
constexpr size_t CTL_CNT = 16384;
#define XB_TMO      128
#define XB_XCNT(j)  (256  + 64 * (j))
#define XB_XSUB(j)  (1280 + 64 * (j))
#define XB_XGEN(j)  (2304 + 64 * (j))
#define XB_TOP      3328
#define XB_TOPGEN   3392
#define XCD_BAR_WORDS 3456
#define XB_SPIN_CAP (1u << 18)

__device__ __forceinline__ unsigned xb_ld(unsigned* p)              { return __hip_atomic_load(p, __ATOMIC_RELAXED, __HIP_MEMORY_SCOPE_AGENT); }
__device__ __forceinline__ unsigned xb_add(unsigned* p, unsigned v) { return __hip_atomic_fetch_add(p, v, __ATOMIC_RELAXED, __HIP_MEMORY_SCOPE_AGENT); }
__device__ __forceinline__ unsigned xb_xcc_id() { return (unsigned)__builtin_amdgcn_s_getreg((3 << 11) | 20) & 0xFu; }
#define XB_SPIN(cond, bar) do { unsigned _sp = 0; while (cond) { __builtin_amdgcn_s_sleep(1); \
    if ((++_sp & 255u) == 0u) { if (xb_ld(&(bar)[XB_TMO])) break; if (_sp > XB_SPIN_CAP) { atomicAdd(&(bar)[XB_TMO], 1u); break; } } } } while (0)

struct XcdBarrier {
    unsigned* bar; unsigned x;
    volatile LAS unsigned* st;
};

__device__ __forceinline__ XcdBarrier xcd_barrier_post(unsigned* bar, volatile LAS unsigned* st) {
    XcdBarrier b; b.bar = bar; b.x = xb_xcc_id(); b.st = st;
    if (threadIdx.x == 0) (void)xb_add(&bar[XB_XCNT(b.x)], 1u);
    return b;
}
__device__ __forceinline__ void xcd_barrier_complete(unsigned* bar, unsigned x, unsigned& nloc, unsigned& nx) {
    const unsigned G = gridDim.x * gridDim.y * gridDim.z;
    unsigned sum, cnt, mine, sp = 0u;
    for (;;) {
        sum = 0u; cnt = 0u; mine = 0u;
#pragma unroll
        for (unsigned j = 0; j < 16; ++j) { const unsigned c = xb_ld(&bar[XB_XCNT(j)]); sum += c; cnt += (c > 0u) ? 1u : 0u; mine = (j == x) ? c : mine; }
        if (sum == G) break;
        __builtin_amdgcn_s_sleep(1);
        if ((++sp & 255u) == 0u) { if (xb_ld(&bar[XB_TMO])) break; if (sp > XB_SPIN_CAP) { atomicAdd(&bar[XB_TMO], 1u); break; } }
    }
    nloc = mine > 0u ? mine : 1u; nx = cnt > 0u ? cnt : 1u;
}

__device__ __forceinline__ void xcd_barrier(const XcdBarrier& b) {
    asm volatile("s_waitcnt vmcnt(0)" ::: "memory");
    __syncthreads();
    if (threadIdx.x == 0) {
        unsigned* bar = b.bar;
        __builtin_amdgcn_s_waitcnt(0);
        unsigned nloc = b.st[0], nx = b.st[1];
        if (nloc == 0u) { xcd_barrier_complete(bar, b.x, nloc, nx); b.st[0] = nloc; b.st[1] = nx; }
        const unsigned old = xb_add(&bar[XB_XSUB(b.x)], 1u);
        const unsigned gen = old / nloc;
        if (old + 1u == (gen + 1u) * nloc) {
            __builtin_amdgcn_fence(__ATOMIC_RELEASE, "agent");
            asm volatile("s_waitcnt vmcnt(0)" ::: "memory");
            const unsigned og = xb_add(&bar[XB_TOP], 1u);
            const unsigned tg = og / nx;
            if (og + 1u == (tg + 1u) * nx) xb_add(&bar[XB_TOPGEN], 1u);
            else XB_SPIN(xb_ld(&bar[XB_TOPGEN]) == tg, bar);
            __builtin_amdgcn_fence(__ATOMIC_ACQUIRE, "agent");
            xb_add(&bar[XB_XGEN(b.x)], 1u);
            asm volatile("s_waitcnt vmcnt(0)" ::: "memory");
        } else {
            XB_SPIN(xb_ld(&bar[XB_XGEN(b.x)]) == gen, bar);
            __builtin_amdgcn_fence(__ATOMIC_ACQUIRE, "agent");
            asm volatile("s_waitcnt vmcnt(0)" ::: "memory");
        }
    }
    __syncthreads();
}


using pg8::Unit;
struct EpiU {
    static constexpr bool PERM = true, AFTER_DRAIN = false, MIDK = false;
    unsigned char* ws;
    __device__ __forceinline__ void operator()(const f32x4 (&acc)[2][2][4][2], const Unit& u, int wr, int wc, int fr, int fq) const {
        bf16_t* U = (bf16_t*)(ws + WS_U); unsigned char* MG = ws + WS_MG;
        const int pn = u.pn; const int row0 = u.pm * 256 + wr * 64 + fr;
        if (pn >= 20) {
            const int mc0 = (pn - 20) * 256 + wc * 32 + 8 * fq;
#pragma unroll
            for (int ai = 0; ai < 2; ++ai)
#pragma unroll
                for (int m = 0; m < 4; ++m) { unsigned char* rp = MG + (size_t)(row0 + ai * 128 + m * 16) * 3072 + mc0;
#pragma unroll
                    for (int bj = 0; bj < 2; ++bj) { const f32x4 v0 = acc[ai][bj][m][0], v1 = acc[ai][bj][m][1]; u32x2 w;
                        w.x = q8(v0[0]) | (q8(v0[1]) << 8) | (q8(v0[2]) << 16) | (q8(v0[3]) << 24); w.y = q8(v1[0]) | (q8(v1[1]) << 8) | (q8(v1[2]) << 16) | (q8(v1[3]) << 24);
                        *(u32x2*)(rp + bj * 128) = w; } }
        } else if (pn >= 4 && pn < 12) {
            const int ch0 = (pn - 4) * 64 + (4 * wc + fq) * 4;
            bf16_t* Z = U + 1 * (ARRB / 2); bf16_t* W = U + 5 * (ARRB / 2) + 512;
#pragma unroll
            for (int ai = 0; ai < 2; ++ai)
#pragma unroll
                for (int m = 0; m < 4; ++m) { const size_t rr = (size_t)(row0 + ai * 128 + m * 16); const size_t ro = rr * 512 + ch0, rw = rr * 1536 + ch0;
                    const f32x4 z = acc[ai][0][m][0] * acc[ai][0][m][1]; const f32x4 gb = acc[ai][1][m][0], gg = acc[ai][1][m][1];
                    u32x2 zz, ww; zz.x = pg8::cvt_pk_bf16(z[0], z[1]); zz.y = pg8::cvt_pk_bf16(z[2], z[3]);
                    ww.x = pg8::cvt_pk_bf16(gb[0] * silu_f(gg[0]), gb[1] * silu_f(gg[1])); ww.y = pg8::cvt_pk_bf16(gb[2] * silu_f(gg[2]), gb[3] * silu_f(gg[3]));
                    *(u32x2*)(Z + ro) = zz; *(u32x2*)(W + rw) = ww; }
        } else {
            const int kind = pn >> 1; int arr = 0, pitch = 512, coff = 0; bool act = false;
            if (kind == 1) { arr = 5; act = true; pitch = 1536; } else if (kind == 6) arr = 2; else if (kind == 7) arr = 3; else if (kind == 8) arr = 4; else if (kind == 9) { arr = 5; act = true; pitch = 1536; coff = 1024; }
            bf16_t* O = U + (size_t)arr * (ARRB / 2) + coff; const int col0 = (pn & 1) * 256 + wc * 32 + 8 * fq;
#pragma unroll
            for (int ai = 0; ai < 2; ++ai)
#pragma unroll
                for (int m = 0; m < 4; ++m) { bf16_t* rp = O + (size_t)(row0 + ai * 128 + m * 16) * pitch + col0;
#pragma unroll
                    for (int bj = 0; bj < 2; ++bj) { f32x4 v0 = acc[ai][bj][m][0], v1 = acc[ai][bj][m][1];
                        if (act) {
#pragma unroll
                            for (int i = 0; i < 4; ++i) { v0[i] = silu_f(v0[i]); v1[i] = silu_f(v1[i]); } }
                        u32x4 w; w.x = pg8::cvt_pk_bf16(v0[0], v0[1]); w.y = pg8::cvt_pk_bf16(v0[2], v0[3]); w.z = pg8::cvt_pk_bf16(v1[0], v1[1]); w.w = pg8::cvt_pk_bf16(v1[2], v1[3]);
                        *(u32x4*)(rp + bj * 128) = w; } }
        }
    }
};
struct EpiBranch {
    static constexpr bool PERM = true, AFTER_DRAIN = false, MIDK = true;
    unsigned char* ws;
    __device__ __forceinline__ void mid(f32x4 (&acc)[2][2][4][2], const Unit& u, int seg, int wr, int wc, int fr, int fq) const {
        int tid_ = threadIdx.x; asm volatile("" : "+v"(tid_));
        const int wid_ = tid_ >> 6, wr_ = wid_ >> 2, wc_ = wid_ & 3, fr_ = tid_ & 15, fq_ = (tid_ & 63) >> 4;
        const unsigned char* MG = ws + WS_MG + (seg - 1) * 1024; const int row0 = u.pm * 256 + wr_ * 64 + fr_, col0 = u.pn * 256 + wc_ * 32 + 8 * fq_;
#pragma unroll
        for (int ai = 0; ai < 2; ++ai)
#pragma unroll
            for (int m = 0; m < 4; ++m) { const unsigned char* rp = MG + (size_t)(row0 + ai * 128 + m * 16) * 3072 + col0;
#pragma unroll
                for (int bj = 0; bj < 2; ++bj) { const u32x2 qa = *(const u32x2*)(rp + bj * 128), qb = *(const u32x2*)(rp + bj * 128 + 1024);
                    f32x4 r0, r1;
                    r0[0] = (float)(qa.x & 255u) * __builtin_amdgcn_rcpf((float)(qb.x & 255u)); r0[1] = (float)((qa.x >> 8) & 255u) * __builtin_amdgcn_rcpf((float)((qb.x >> 8) & 255u));
                    r0[2] = (float)((qa.x >> 16) & 255u) * __builtin_amdgcn_rcpf((float)((qb.x >> 16) & 255u)); r0[3] = (float)(qa.x >> 24) * __builtin_amdgcn_rcpf((float)(qb.x >> 24));
                    r1[0] = (float)(qa.y & 255u) * __builtin_amdgcn_rcpf((float)(qb.y & 255u)); r1[1] = (float)((qa.y >> 8) & 255u) * __builtin_amdgcn_rcpf((float)((qb.y >> 8) & 255u));
                    r1[2] = (float)((qa.y >> 16) & 255u) * __builtin_amdgcn_rcpf((float)((qb.y >> 16) & 255u)); r1[3] = (float)(qa.y >> 24) * __builtin_amdgcn_rcpf((float)(qb.y >> 24));
                    acc[ai][bj][m][0] *= r0; acc[ai][bj][m][1] *= r1; }
                if (m == 3) asm volatile("" ::: "memory"); }
    }
    __device__ __forceinline__ void operator()(const f32x4 (&acc)[2][2][4][2], const Unit& u, int wr, int wc, int fr, int fq) const {
        const unsigned char* MG = ws + WS_MG + 2 * 1024; bf16_t* merged = (bf16_t*)(ws + WS_H);
        const int row0 = u.pm * 256 + wr * 64 + fr, col0 = u.pn * 256 + wc * 32 + 8 * fq;
        u32x2 gq[2][4][2];
#pragma unroll
        for (int ai = 0; ai < 2; ++ai)
#pragma unroll
            for (int m = 0; m < 4; ++m)
#pragma unroll
                for (int bj = 0; bj < 2; ++bj) gq[ai][m][bj] = *(const u32x2*)(MG + (size_t)(row0 + ai * 128 + m * 16) * 3072 + col0 + bj * 128);
#pragma unroll
        for (int ai = 0; ai < 2; ++ai)
#pragma unroll
            for (int m = 0; m < 4; ++m) { const size_t row = (size_t)(row0 + ai * 128 + m * 16);
#pragma unroll
                for (int bj = 0; bj < 2; ++bj) { const int col = col0 + bj * 128; const u32x2 g = gq[ai][m][bj];
                    f32x4 g0, g1; const float k = 1.f / 255.f;
                    g0[0] = (float)(g.x & 255u) * k; g0[1] = (float)((g.x >> 8) & 255u) * k; g0[2] = (float)((g.x >> 16) & 255u) * k; g0[3] = (float)(g.x >> 24) * k;
                    g1[0] = (float)(g.y & 255u) * k; g1[1] = (float)((g.y >> 8) & 255u) * k; g1[2] = (float)((g.y >> 16) & 255u) * k; g1[3] = (float)(g.y >> 24) * k;
                    const f32x4 v0 = acc[ai][bj][m][0] * g0, v1 = acc[ai][bj][m][1] * g1;
                    u32x4 w; w.x = pg8::cvt_pk_bf16(v0[0], v0[1]); w.y = pg8::cvt_pk_bf16(v0[2], v0[3]); w.z = pg8::cvt_pk_bf16(v1[0], v1[1]); w.w = pg8::cvt_pk_bf16(v1[2], v1[3]);
                    *(u32x4*)(merged + row * 1024 + col) = w; } }
    }
};
struct EpiOut {
    static constexpr bool PERM = false, AFTER_DRAIN = false, MIDK = false;
    unsigned char* ws;
    __device__ __forceinline__ void operator()(const f32x4 (&acc)[2][2][4][2], const Unit& u, int wr, int wc, int fr, int fq) const {
        float* out = (float*)(ws + WS_U); float* rs = (float*)(ws + WS_RS);
        const int row0 = u.pm * 256 + wr * 64 + fr, col0 = u.pn * 256 + wc * 32 + 4 * fq;
#pragma unroll
        for (int ai = 0; ai < 2; ++ai)
#pragma unroll
            for (int m = 0; m < 4; ++m) { const size_t row = (size_t)(row0 + ai * 128 + m * 16); float ss = 0.f;
#pragma unroll
                for (int bj = 0; bj < 2; ++bj)
#pragma unroll
                    for (int n = 0; n < 2; ++n) { const f32x4 v = acc[ai][bj][m][n]; *(f32x4*)(out + row * 1024 + col0 + bj * 128 + n * 16) = v; ss += (v[0] * v[0] + v[1] * v[1]) + (v[2] * v[2] + v[3] * v[3]); }
                ss += __shfl_xor(ss, 16); ss += __shfl_xor(ss, 32);
                if (fq == 0) rs[row * 16 + u.pn * 4 + wc] = ss; }
    }
};

struct RmsPanel {
    float* xbuf;
    unsigned* cnt;
    __device__ __forceinline__ void run(const f32x4 (&v)[2][2][4][2], const Unit& u, int wr, int wc, int fr, int fq, LAS unsigned char* lds, int wid, int lane) const {
        LAS float* P = (LAS float*)lds; LAS float* S = (LAS float*)(lds + 8192);
#pragma unroll
        for (int ai = 0; ai < 2; ++ai)
#pragma unroll
            for (int m = 0; m < 4; ++m) { float s = 0.f;
#pragma unroll
                for (int bj = 0; bj < 2; ++bj)
#pragma unroll
                    for (int n = 0; n < 2; ++n) { const f32x4 x = v[ai][bj][m][n]; s += (x[0] * x[0] + x[1] * x[1]) + (x[2] * x[2] + x[3] * x[3]); }
                s += __shfl_xor(s, 16); s += __shfl_xor(s, 32);
                if (fq == 0) P[(ai * 128 + wr * 64 + m * 16 + fr) * 4 + wc] = s; }
        asm volatile("s_waitcnt lgkmcnt(0)" ::: "memory"); __builtin_amdgcn_s_barrier(); asm volatile("" ::: "memory");
        const int row = wid * 32 + (lane & 31);
        if (lane < 32) { const float t = (P[row * 4 + 0] + P[row * 4 + 1]) + (P[row * 4 + 2] + P[row * 4 + 3]);
            __hip_atomic_store(xbuf + (size_t)(u.pm * 256 + row) * 4 + u.pn, t, __ATOMIC_RELAXED, __HIP_MEMORY_SCOPE_AGENT); }
        asm volatile("s_waitcnt vmcnt(0)" ::: "memory");
        if (lane == 0) __hip_atomic_fetch_add(cnt + 64 * u.pm, 1u, __ATOMIC_RELAXED, __HIP_MEMORY_SCOPE_AGENT);
        if (wid == 0) {
            unsigned sp = 0;
            while ((unsigned)__builtin_amdgcn_readfirstlane(__hip_atomic_load(cnt + 64 * u.pm, __ATOMIC_RELAXED, __HIP_MEMORY_SCOPE_AGENT)) < 32u) { __builtin_amdgcn_s_sleep(2); if (++sp > (1u << 22)) break; }
            __builtin_amdgcn_fence(__ATOMIC_ACQUIRE, "agent");
        }
        asm volatile("s_waitcnt vmcnt(0) lgkmcnt(0)" ::: "memory"); __builtin_amdgcn_s_barrier(); asm volatile("" ::: "memory");
        if (lane < 32) { const float* slot = xbuf + (size_t)(u.pm * 256 + row) * 4; float t = 0.f;
#pragma unroll
            for (int k = 0; k < 4; ++k) t += __hip_atomic_load(slot + k, __ATOMIC_RELAXED, __HIP_MEMORY_SCOPE_AGENT);
            S[row] = 1.0f / sqrtf(t * (1.f / DM) + RMS_EPS); }
        asm volatile("s_waitcnt lgkmcnt(0)" ::: "memory"); __builtin_amdgcn_s_barrier(); asm volatile("" ::: "memory");
    }
};
struct EpiNorm1 {
    static constexpr bool PERM = false, AFTER_DRAIN = true, MIDK = false;
    float* out; const float* gpost; RmsPanel st;
    __device__ __forceinline__ void operator()(const f32x4 (&)[2][2][4][2], const Unit&, int, int, int, int) const {}
    __device__ __forceinline__ void fused(f32x4 (&acc)[2][2][4][2], const Unit& u, int wr, int wc, int fr, int fq, LAS unsigned char* lds, int wid, int lane) const {
        const LAS float* S = (const LAS float*)(lds + 8192);
        const int col0 = u.pn * 256 + wc * 32 + 4 * fq, jl0 = wc * 32 + 4 * fq;
        f32x4 gp[2][2]; u32x2 pre[2][4][2][2];
#pragma unroll
        for (int bj = 0; bj < 2; ++bj)
#pragma unroll
            for (int n = 0; n < 2; ++n) gp[bj][n] = *(const f32x4*)(gpost + col0 + bj * 128 + n * 16);
#pragma unroll
        for (int ai = 0; ai < 2; ++ai)
#pragma unroll
            for (int m = 0; m < 4; ++m) { const unsigned char* ob = (const unsigned char*)out + (size_t)(u.pm * 256 + ai * 128 + wr * 64 + m * 16 + fr) * 4096 + u.pn * 1024;
#pragma unroll
                for (int bj = 0; bj < 2; ++bj)
#pragma unroll
                    for (int n = 0; n < 2; ++n) pre[ai][m][bj][n] = *(const u32x2*)(ob + 2 * (jl0 + bj * 128 + n * 16)); }
        st.run(acc, u, wr, wc, fr, fq, lds, wid, lane);
#pragma unroll
        for (int ai = 0; ai < 2; ++ai)
#pragma unroll
            for (int m = 0; m < 4; ++m) { const int r = ai * 128 + wr * 64 + m * 16 + fr; const float rs = S[r]; const size_t off = (size_t)(u.pm * 256 + r) * DM + col0;
#pragma unroll
                for (int bj = 0; bj < 2; ++bj)
#pragma unroll
                    for (int n = 0; n < 2; ++n) { const u32x2 p = pre[ai][m][bj][n]; const f32x4 bs = (f32x4){bflo(p.x), bfhi(p.x), bflo(p.y), bfhi(p.y)};
                        *(f32x4*)(out + off + bj * 128 + n * 16) = bs + acc[ai][bj][m][n] * rs * gp[bj][n]; } }
    }
};
struct EpiNorm2 {
    static constexpr bool PERM = false, AFTER_DRAIN = true, MIDK = false;
    const float* base; float* out; bf16_t* hn; const float* gpost; const float* gnext; RmsPanel st1, st2;
    __device__ __forceinline__ void operator()(const f32x4 (&)[2][2][4][2], const Unit&, int, int, int, int) const {}
    __device__ __forceinline__ void fused(f32x4 (&acc)[2][2][4][2], const Unit& u, int wr, int wc, int fr, int fq, LAS unsigned char* lds, int wid, int lane) const {
        const LAS float* S = (const LAS float*)(lds + 8192);
        const int col0 = u.pn * 256 + wc * 32 + 4 * fq;
        f32x4 gp[2][2], pre[4][2][2];
#pragma unroll
        for (int bj = 0; bj < 2; ++bj)
#pragma unroll
            for (int n = 0; n < 2; ++n) gp[bj][n] = *(const f32x4*)(gpost + col0 + bj * 128 + n * 16);
#pragma unroll
        for (int m = 0; m < 4; ++m)
#pragma unroll
            for (int bj = 0; bj < 2; ++bj)
#pragma unroll
                for (int n = 0; n < 2; ++n) pre[m][bj][n] = *(const f32x4*)(base + (size_t)(u.pm * 256 + wr * 64 + m * 16 + fr) * DM + col0 + bj * 128 + n * 16);
        st1.run(acc, u, wr, wc, fr, fq, lds, wid, lane);
#pragma unroll
        for (int ai = 0; ai < 2; ++ai) {
            if (ai == 1) {
#pragma unroll
                for (int m = 0; m < 4; ++m)
#pragma unroll
                    for (int bj = 0; bj < 2; ++bj)
#pragma unroll
                        for (int n = 0; n < 2; ++n) pre[m][bj][n] = *(const f32x4*)(base + (size_t)(u.pm * 256 + 128 + wr * 64 + m * 16 + fr) * DM + col0 + bj * 128 + n * 16);
            }
#pragma unroll
            for (int m = 0; m < 4; ++m) { const int r = ai * 128 + wr * 64 + m * 16 + fr; const float rs = S[r]; const size_t off = (size_t)(u.pm * 256 + r) * DM + col0;
#pragma unroll
                for (int bj = 0; bj < 2; ++bj)
#pragma unroll
                    for (int n = 0; n < 2; ++n) { const f32x4 x1 = pre[m][bj][n] + acc[ai][bj][m][n] * rs * gp[bj][n]; acc[ai][bj][m][n] = x1;
                        u32x2 w; w.x = pg8::cvt_pk_bf16(x1[0], x1[1]); w.y = pg8::cvt_pk_bf16(x1[2], x1[3]);
                        *(u32x2*)((unsigned char*)out + (size_t)(u.pm * 256 + r) * 4096 + u.pn * 1024 + 2 * (wc * 32 + 4 * fq + bj * 128 + n * 16)) = w; } }
        }
#pragma unroll
        for (int bj = 0; bj < 2; ++bj)
#pragma unroll
            for (int n = 0; n < 2; ++n) gp[bj][n] = *(const f32x4*)(gnext + col0 + bj * 128 + n * 16);
        st2.run(acc, u, wr, wc, fr, fq, lds, wid, lane);
#pragma unroll
        for (int ai = 0; ai < 2; ++ai)
#pragma unroll
            for (int m = 0; m < 4; ++m) { const int r = ai * 128 + wr * 64 + m * 16 + fr; const float rs = S[r]; const size_t off = (size_t)(u.pm * 256 + r) * DM + col0;
#pragma unroll
                for (int bj = 0; bj < 2; ++bj)
#pragma unroll
                    for (int n = 0; n < 2; ++n) { const f32x4 o = acc[ai][bj][m][n] * rs * gp[bj][n];
                        u32x2 w; w.x = pg8::cvt_pk_bf16(o[0], o[1]); w.y = pg8::cvt_pk_bf16(o[2], o[3]); *(u32x2*)(hn + off + bj * 128 + n * 16) = w; } }
    }
};
__device__ __forceinline__ int win_row(int c) {
    if (c < 1024 || c >= 3072) return c;
    const int q = (c - 1024) >> 9, ch = (c - 1024) & 511, ct = ch >> 6, grp = (ch & 63) >> 2, e = ch & 3;
    return 1024 + ct * 256 + (q & 1) * 128 + grp * 8 + (q >> 1) * 4 + e;
}
__device__ __forceinline__ void transpose_item(const float* W, int N, bf16_t* WT, int ldt, int koff, int row_off, bool winmap, LAS float* scr, int item, int lane, const float* rscale = nullptr) {
    const int nblk = N / 64, kb = item / nblk, nb = item % nblk, k0 = 64 * kb, n0 = 64 * nb;
    const int kq = lane >> 4, nq = lane & 15;
    f32x4 v[16];
#pragma unroll
    for (int i = 0; i < 16; ++i) v[i] = *(const f32x4*)(W + (size_t)(k0 + 4 * i + kq) * N + n0 + 4 * nq);
#pragma unroll
    for (int i = 0; i < 16; ++i) { LAS float* s = scr + (4 * i + kq) * 65 + 4 * nq; s[0] = v[i][0]; s[1] = v[i][1]; s[2] = v[i][2]; s[3] = v[i][3]; }
    asm volatile("s_waitcnt lgkmcnt(0)" ::: "memory");
    const int c = lane & 7;
#pragma unroll
    for (int j = 0; j < 8; ++j) { const int n = (lane >> 3) + 8 * j;
        const LAS float* s = scr + (rscale ? (16 * (c >> 1) + 4 * (c & 1)) : 8 * c) * 65 + n; const int hs = rscale ? 8 * 65 : 4 * 65; const float f = rscale ? rscale[n0 + n] : 1.f;
        u32x4 o; o.x = pg8::cvt_pk_bf16(s[0 * 65] * f, s[1 * 65] * f); o.y = pg8::cvt_pk_bf16(s[2 * 65] * f, s[3 * 65] * f); o.z = pg8::cvt_pk_bf16(s[hs] * f, s[hs + 65] * f); o.w = pg8::cvt_pk_bf16(s[hs + 2 * 65] * f, s[hs + 3 * 65] * f);
        int dst = n0 + n; if (winmap) dst = win_row(dst);
        *(u32x4*)(WT + (size_t)(row_off + dst) * ldt + koff + k0 + 8 * c) = o; }
    asm volatile("s_waitcnt lgkmcnt(0)" ::: "memory");
}
template <int R> __device__ __forceinline__ void rms_rows_to_bf16(const float* x, const float* g, bf16_t* H, int m0, int mstride, int lane) {
    f32x4 v[R][4];
#pragma unroll
    for (int r = 0; r < R; ++r)
#pragma unroll
        for (int j = 0; j < 4; ++j) v[r][j] = ((const f32x4*)(x + (size_t)(m0 + r * mstride) * DM))[64 * j + lane];
    f32x4 gg[4];
#pragma unroll
    for (int j = 0; j < 4; ++j) gg[j] = ((const f32x4*)g)[64 * j + lane];
#pragma unroll
    for (int r = 0; r < R; ++r) { float s = 0.f;
#pragma unroll
        for (int j = 0; j < 4; ++j) s += (v[r][j][0] * v[r][j][0] + v[r][j][1] * v[r][j][1]) + (v[r][j][2] * v[r][j][2] + v[r][j][3] * v[r][j][3]);
        const float rstd = 1.f / sqrtf(wave_sum(s) * (1.f / DM) + RMS_EPS);
        u32x2* o8 = (u32x2*)(H + (size_t)(m0 + r * mstride) * DM) + lane;
#pragma unroll
        for (int j = 0; j < 4; ++j) { u32x2 w; w.x = pg8::cvt_pk_bf16(v[r][j][0] * rstd * gg[j][0], v[r][j][1] * rstd * gg[j][1]); w.y = pg8::cvt_pk_bf16(v[r][j][2] * rstd * gg[j][2], v[r][j][3] * rstd * gg[j][3]); o8[64 * j] = w; } }
}

__device__ __forceinline__ int crow(int r, int hi) { return (r & 3) + 8 * (r >> 2) + 4 * hi; }
constexpr int VROW = 144;
__device__ __forceinline__ void attn_item(int item, const bf16_t* Q, const bf16_t* K, const bf16_t* V, const bf16_t* SG, bf16_t* YO, LAS unsigned char* vl, int lane) {
    const int qg = item & 127, h = (item >> 7) & 7, b = item >> 10;
    const int r32 = lane & 31, hi = lane >> 5, t0 = qg * 32;
    const size_t tokq = (size_t)b * SEQ + t0 + r32;
    bf16x8 qf[4];
#pragma unroll
    for (int d0 = 0; d0 < 4; ++d0) qf[d0] = *(const bf16x8*)(Q + tokq * 512 + h * 64 + d0 * 16 + 8 * hi);
    f32x16 o0, o1;
#pragma unroll
    for (int r = 0; r < 16; ++r) { o0[r] = 0.f; o1[r] = 0.f; }
    float P = 1.f;
    const int i16 = lane & 15, G4 = lane >> 4;
    const int vb = (4 * (G4 >> 1) + (i16 >> 2)) * VROW + (16 * (G4 & 1) + 4 * (i16 & 3)) * 2;
#define ATT_LOAD(KF, VR, S0) do { const size_t tk_ = (size_t)b * SEQ + ((S0) > 0 ? (S0) : 0); \
        _Pragma("unroll") for (int d0 = 0; d0 < 4; ++d0) KF[d0] = *(const bf16x8*)(K + (tk_ + r32) * 512 + h * 64 + d0 * 16 + 8 * hi); \
        _Pragma("unroll") for (int p = 0; p < 4; ++p) { const int idx = p * 64 + lane; VR[p] = *(const u32x4*)(V + (tk_ + (idx >> 3)) * 512 + h * 64 + (idx & 7) * 8); } } while (0)
    bf16x8 kf[4], kn[4]; u32x4 vr[4], vn[4];
    ATT_LOAD(kf, vr, t0); ATT_LOAD(kn, vn, t0 - 32);
    u32x2 sgv[8];
#pragma unroll
    for (int i = 0; i < 8; ++i) sgv[i] = *(const u32x2*)(SG + tokq * 1536 + h * 64 + (i >> 2) * 32 + 8 * (i & 3) + 4 * hi);
    for (int s0 = t0; s0 >= 0; s0 -= 32) {
#pragma unroll
        for (int p = 0; p < 4; ++p) { const int idx = p * 64 + lane, key = idx >> 3, ch = idx & 7; *(LAS u32x4*)(vl + key * VROW + ch * 16) = vr[p]; }
        f32x16 s;
#pragma unroll
        for (int r = 0; r < 16; ++r) s[r] = 0.f;
#pragma unroll
        for (int d0 = 0; d0 < 4; ++d0) s = __builtin_amdgcn_mfma_f32_32x32x16_bf16(kf[d0], qf[d0], s, 0, 0, 0);
        const bool diag = (s0 == t0);
        float kp[16];
#pragma unroll
        for (int r = 0; r < 16; ++r) { const float e = __builtin_amdgcn_exp2f(s[r] * (0.125f * 1.4426950408889634f)); float k = __builtin_amdgcn_rcpf(1.f + e);
            if (diag && crow(r, hi) >= r32) k = 1.f; kp[r] = k; }
        float Gm[4], Go[4], T[4], R[4], C[4];
#pragma unroll
        for (int g = 0; g < 4; ++g) { Gm[g] = (kp[4 * g] * kp[4 * g + 1]) * (kp[4 * g + 2] * kp[4 * g + 3]); Go[g] = __shfl_xor(Gm[g], 32); T[g] = Gm[g] * Go[g]; }
        R[3] = P; R[2] = R[3] * T[3]; R[1] = R[2] * T[2]; R[0] = R[1] * T[1]; const float Cout = R[0] * T[0];
#pragma unroll
        for (int g = 0; g < 4; ++g) C[g] = hi ? R[g] : R[g] * Go[g];
        float w[16];
#pragma unroll
        for (int g = 0; g < 4; ++g) { const float p3 = C[g], p2 = p3 * kp[4 * g + 3], p1 = p2 * kp[4 * g + 2], p0 = p1 * kp[4 * g + 1], pe = p0 * kp[4 * g];
            w[4 * g + 3] = p3 - p2; w[4 * g + 2] = p2 - p1; w[4 * g + 1] = p1 - p0; w[4 * g] = p0 - pe; }
        bf16x8 wf[2];
#pragma unroll
        for (int st = 0; st < 2; ++st) { u32x4 t; t.x = pg8::cvt_pk_bf16(w[8 * st], w[8 * st + 1]); t.y = pg8::cvt_pk_bf16(w[8 * st + 2], w[8 * st + 3]); t.z = pg8::cvt_pk_bf16(w[8 * st + 4], w[8 * st + 5]); t.w = pg8::cvt_pk_bf16(w[8 * st + 6], w[8 * st + 7]); wf[st] = __builtin_bit_cast(bf16x8, t); }
#pragma unroll
        for (int dt = 0; dt < 2; ++dt)
#pragma unroll
            for (int st = 0; st < 2; ++st) {
                const s16x4 lo = __builtin_amdgcn_ds_read_tr16_b64_v4i16((LAS s16x4*)(vl + vb + (16 * st) * VROW + dt * 64));
                const s16x4 hh = __builtin_amdgcn_ds_read_tr16_b64_v4i16((LAS s16x4*)(vl + vb + (16 * st + 8) * VROW + dt * 64));
                const bf16x8 vf = (bf16x8){lo[0], lo[1], lo[2], lo[3], hh[0], hh[1], hh[2], hh[3]};
                if (dt == 0) o0 = __builtin_amdgcn_mfma_f32_32x32x16_bf16(vf, wf[st], o0, 0, 0, 0); else o1 = __builtin_amdgcn_mfma_f32_32x32x16_bf16(vf, wf[st], o1, 0, 0, 0); }
        P = Cout;
        if (__all(P < 1.17549435e-38f)) break;
#pragma unroll
        for (int i = 0; i < 4; ++i) { kf[i] = kn[i]; vr[i] = vn[i]; }
        ATT_LOAD(kn, vn, s0 - 64);
    }
#undef ATT_LOAD
#pragma unroll
    for (int dt = 0; dt < 2; ++dt)
#pragma unroll
        for (int g = 0; g < 4; ++g) { const size_t po = tokq * 1536 + h * 64 + dt * 32 + 8 * g + 4 * hi; const u32x2 sg = sgv[dt * 4 + g];
            const f32x16& o = dt ? o1 : o0; u32x2 y;
            y.x = pg8::cvt_pk_bf16(o[4 * g] * bflo(sg.x), o[4 * g + 1] * bfhi(sg.x)); y.y = pg8::cvt_pk_bf16(o[4 * g + 2] * bflo(sg.y), o[4 * g + 3] * bfhi(sg.y));
            *(u32x2*)(YO + po) = y; }
}
constexpr int PROW = 272;
__device__ __forceinline__ void pool_item(int pi, const bf16_t* PV, const bf16_t* SG, bf16_t* YO, const bf16_t* PT, const float* scale, LAS unsigned char* sl, int lane) {
    const int tile = pi >> 2, g = ((pi & 3) + ((pi >> 2) & 1)) & 3, win = 2 << g;
    const int r32 = lane & 31, hi = lane >> 5, tok0 = tile * 32, t0 = tok0 & (SEQ - 1), tok = tok0 + r32;
    u32x4 sv[12];
#pragma unroll
    for (int p = 0; p < 12; ++p) { const int idx = p * 64 + lane, row = idx >> 4, ch = idx & 15; const bool ok = (t0 + row - 16) >= 0;
        sv[p] = *(const u32x4*)(PV + (size_t)(ok ? tok0 + row - 16 : tok0) * 512 + g * 128 + ch * 8); if (!ok) sv[p] = (u32x4){0u, 0u, 0u, 0u}; }
#pragma unroll
    for (int p = 0; p < 12; ++p) { const int idx = p * 64 + lane, row = idx >> 4, ch = idx & 15; *(LAS u32x4*)(sl + row * PROW + ch * 16) = sv[p]; }
    const int t = t0 + r32, cnt = (t + 1) < win ? (t + 1) : win;
    bf16x8 bfr[3];
#pragma unroll
    for (int ks = 0; ks < 3; ++ks) { float wv[8];
#pragma unroll
        for (int j = 0; j < 8; ++j) { const int rel = (16 + r32) - (16 * ks + 8 * hi + j); wv[j] = (rel == 0) ? (float)(1 - cnt) : ((rel > 0 && rel < cnt) ? 1.f : 0.f); }
        u32x4 tt; tt.x = pg8::cvt_pk_bf16(wv[0], wv[1]); tt.y = pg8::cvt_pk_bf16(wv[2], wv[3]); tt.z = pg8::cvt_pk_bf16(wv[4], wv[5]); tt.w = pg8::cvt_pk_bf16(wv[6], wv[7]); bfr[ks] = __builtin_bit_cast(bf16x8, tt); }
    u32x2 sgv[16];
#pragma unroll
    for (int i = 0; i < 16; ++i) { const int dd = g * 128 + (i >> 2) * 32 + 8 * (i & 3) + 4 * hi; sgv[i] = *(const u32x2*)(SG + (size_t)tok * 1536 + dd); }
    bf16x8 ptf[4][8];
#pragma unroll
    for (int nt = 0; nt < 4; ++nt)
#pragma unroll
        for (int ks = 0; ks < 8; ++ks) ptf[nt][ks] = *(const bf16x8*)(PT + (size_t)(g * 128 + nt * 32 + r32) * 128 + 16 * ks + 8 * hi);
    const int i16 = lane & 15, G4 = lane >> 4;
    const int vb = (8 * (G4 >> 1) + (i16 >> 2)) * PROW + (16 * (G4 & 1) + 4 * (i16 & 3)) * 2;
    const float inv = __builtin_amdgcn_rcpf((float)cnt);
    bf16x8 pf[8];
#pragma unroll
    for (int ct = 0; ct < 4; ++ct) {
        f32x16 acc;
#pragma unroll
        for (int r = 0; r < 16; ++r) acc[r] = 0.f;
#pragma unroll
        for (int ks = 0; ks < 3; ++ks) {
            const s16x4 lo = __builtin_amdgcn_ds_read_tr16_b64_v4i16((LAS s16x4*)(sl + vb + (16 * ks) * PROW + ct * 64));
            const s16x4 hh = __builtin_amdgcn_ds_read_tr16_b64_v4i16((LAS s16x4*)(sl + vb + (16 * ks + 4) * PROW + ct * 64));
            const bf16x8 a = (bf16x8){lo[0], lo[1], lo[2], lo[3], hh[0], hh[1], hh[2], hh[3]};
            acc = __builtin_amdgcn_mfma_f32_32x32x16_bf16(a, bfr[ks], acc, 0, 0, 0); }
#pragma unroll
        for (int s = 0; s < 2; ++s) { u32x4 tt; tt.x = pg8::cvt_pk_bf16(acc[8 * s] * inv, acc[8 * s + 1] * inv); tt.y = pg8::cvt_pk_bf16(acc[8 * s + 2] * inv, acc[8 * s + 3] * inv);
            tt.z = pg8::cvt_pk_bf16(acc[8 * s + 4] * inv, acc[8 * s + 5] * inv); tt.w = pg8::cvt_pk_bf16(acc[8 * s + 6] * inv, acc[8 * s + 7] * inv); pf[2 * ct + s] = __builtin_bit_cast(bf16x8, tt); }
    }
#pragma unroll
    for (int nt = 0; nt < 4; ++nt) {
        f32x16 acc;
#pragma unroll
        for (int r = 0; r < 16; ++r) acc[r] = 0.f;
#pragma unroll
        for (int ks = 0; ks < 8; ++ks) acc = __builtin_amdgcn_mfma_f32_32x32x16_bf16(ptf[nt][ks], pf[ks], acc, 0, 0, 0);
#pragma unroll
        for (int q = 0; q < 4; ++q) { const int dd = g * 128 + nt * 32 + 8 * q + 4 * hi;
            const size_t po = (size_t)tok * 1536 + dd; const u32x2 sg = sgv[nt * 4 + q]; u32x2 y;
            y.x = pg8::cvt_pk_bf16(acc[4 * q] * bflo(sg.x), acc[4 * q + 1] * bfhi(sg.x)); y.y = pg8::cvt_pk_bf16(acc[4 * q + 2] * bflo(sg.y), acc[4 * q + 3] * bfhi(sg.y));
            *(u32x2*)(YO + po) = y; }
    }
}
__device__ __forceinline__ void conv_item(int ci, const bf16_t* Z, const bf16_t* Wy, bf16_t* YO, const float* cw, const float* cb, int lane) {
    const int tok0 = ci * 8, t0 = tok0 & (SEQ - 1), ch = lane * 8;
    float w0[8], w1[8], w2[8], bs[8], zm2[8], zm1[8];
#pragma unroll
    for (int hf = 0; hf < 2; ++hf) { const f32x4 a = *(const f32x4*)(cw + ch + 4 * hf), b = *(const f32x4*)(cw + 512 + ch + 4 * hf), c = *(const f32x4*)(cw + 1024 + ch + 4 * hf), d = *(const f32x4*)(cb + ch + 4 * hf);
#pragma unroll
        for (int i = 0; i < 4; ++i) { w0[4 * hf + i] = a[i]; w1[4 * hf + i] = b[i]; w2[4 * hf + i] = c[i]; bs[4 * hf + i] = d[i]; } }
#pragma unroll
    for (int i = 0; i < 8; ++i) { zm2[i] = 0.f; zm1[i] = 0.f; }
    if (t0 != 0) { const u32x4 a = *(const u32x4*)(Z + (size_t)(tok0 - 2) * 512 + ch), b = *(const u32x4*)(Z + (size_t)(tok0 - 1) * 512 + ch);
        zm2[0] = bflo(a.x); zm2[1] = bfhi(a.x); zm2[2] = bflo(a.y); zm2[3] = bfhi(a.y); zm2[4] = bflo(a.z); zm2[5] = bfhi(a.z); zm2[6] = bflo(a.w); zm2[7] = bfhi(a.w);
        zm1[0] = bflo(b.x); zm1[1] = bfhi(b.x); zm1[2] = bflo(b.y); zm1[3] = bfhi(b.y); zm1[4] = bflo(b.z); zm1[5] = bfhi(b.z); zm1[6] = bflo(b.w); zm1[7] = bfhi(b.w); }
    u32x4 zr[8], wr_[8];
#pragma unroll
    for (int r = 0; r < 8; ++r) { zr[r] = *(const u32x4*)(Z + (size_t)(tok0 + r) * 512 + ch); wr_[r] = *(const u32x4*)(Wy + (size_t)(tok0 + r) * 1536 + ch); }
#pragma unroll
    for (int r = 0; r < 8; ++r) {
        float zc[8], wv[8], y[8];
        zc[0] = bflo(zr[r].x); zc[1] = bfhi(zr[r].x); zc[2] = bflo(zr[r].y); zc[3] = bfhi(zr[r].y); zc[4] = bflo(zr[r].z); zc[5] = bfhi(zr[r].z); zc[6] = bflo(zr[r].w); zc[7] = bfhi(zr[r].w);
        wv[0] = bflo(wr_[r].x); wv[1] = bfhi(wr_[r].x); wv[2] = bflo(wr_[r].y); wv[3] = bfhi(wr_[r].y); wv[4] = bflo(wr_[r].z); wv[5] = bfhi(wr_[r].z); wv[6] = bflo(wr_[r].w); wv[7] = bfhi(wr_[r].w);
#pragma unroll
        for (int i = 0; i < 8; ++i) { y[i] = wv[i] * (w0[i] * zm2[i] + w1[i] * zm1[i] + w2[i] * zc[i] + bs[i]); zm2[i] = zm1[i]; zm1[i] = zc[i]; }
        u32x4 o; o.x = pg8::cvt_pk_bf16(y[0], y[1]); o.y = pg8::cvt_pk_bf16(y[2], y[3]); o.z = pg8::cvt_pk_bf16(y[4], y[5]); o.w = pg8::cvt_pk_bf16(y[6], y[7]);
        *(u32x4*)(YO + (size_t)(tok0 + r) * 1536 + ch) = o; }
}
template <int R> __device__ __forceinline__ void norm_rows(const float* F32T, const float* RS, const float* xin, const float* gpost, float* xout, const float* gnext, bf16_t* H, int m0, int mstride, int lane) {
    f32x4 o[R][4], xi[R][4]; float ss[R];
#pragma unroll
    for (int r = 0; r < R; ++r) { const size_t row = (size_t)(m0 + r * mstride); ss[r] = (lane < 16) ? RS[row * 16 + lane] : 0.f;
#pragma unroll
        for (int j = 0; j < 4; ++j) { o[r][j] = ((const f32x4*)(F32T + row * DM))[64 * j + lane]; xi[r][j] = ((const f32x4*)(xin + row * DM))[64 * j + lane]; } }
    f32x4 gp[4];
#pragma unroll
    for (int j = 0; j < 4; ++j) gp[j] = ((const f32x4*)gpost)[64 * j + lane];
#pragma unroll
    for (int r = 0; r < R; ++r) { const size_t row = (size_t)(m0 + r * mstride);
        const float rstd = 1.f / sqrtf(wave_sum(ss[r]) * (1.f / DM) + RMS_EPS); float s2 = 0.f;
#pragma unroll
        for (int j = 0; j < 4; ++j) { const f32x4 v = xi[r][j] + o[r][j] * rstd * gp[j]; xi[r][j] = v; ((f32x4*)(xout + row * DM))[64 * j + lane] = v; s2 += (v[0] * v[0] + v[1] * v[1]) + (v[2] * v[2] + v[3] * v[3]); }
        if (gnext) { const float r2 = 1.f / sqrtf(wave_sum(s2) * (1.f / DM) + RMS_EPS);
#pragma unroll
            for (int j = 0; j < 4; ++j) { const f32x4 gg = ((const f32x4*)gnext)[64 * j + lane]; const f32x4 v = xi[r][j]; u32x2 w; w.x = pg8::cvt_pk_bf16(v[0] * r2 * gg[0], v[1] * r2 * gg[1]); w.y = pg8::cvt_pk_bf16(v[2] * r2 * gg[2], v[3] * r2 * gg[3]); ((u32x2*)(H + row * DM))[64 * j + lane] = w; } } }
}

struct Args { const float* in[10]; float* out; unsigned char* ws; int ph_lo, ph_hi; };
template <class T> __device__ __forceinline__ T* as_global(T* p) { return p; }
#if TP_A >= 0
#define TSTAMP(k) do { if (blockIdx.x == TP_BLK && threadIdx.x == 0) ((volatile LAS unsigned long long*)(lds + 147264))[(k)] = __builtin_amdgcn_s_memrealtime(); } while (0)
#else
#define TSTAMP(k) do { } while (0)
#endif
template <int ph> __device__ __forceinline__ void run_phase(const Args& a_, LAS unsigned char* lds) {
        const Args* A = &a_;
        const int tid = threadIdx.x, lane = tid & 63, wave = __builtin_amdgcn_readfirstlane(tid >> 6);
        const int G = gridDim.x, bx = blockIdx.x;
        const int vcu = (G % 8 == 0) ? (bx % 8) * (G / 8) + bx / 8 : bx;
        const int gw = vcu * 8 + wave, NGW = G * 8;
        unsigned char* ws = as_global(A->ws);
        bf16_t* H = (bf16_t*)(ws + WS_H); bf16_t* U = (bf16_t*)(ws + WS_U);
        if constexpr (ph == 0) {
            const float* x = as_global(A->in[0]); const float* pre_g = as_global(A->in[1]); const float* w_in = as_global(A->in[2]); const float* pool_w = as_global(A->in[3]); const float* pool_scale = as_global(A->in[4]); const float* w_branch = as_global(A->in[7]); const float* w_out = as_global(A->in[8]);
            bf16_t* W1 = (bf16_t*)(ws + WS_W1); bf16_t* W2 = (bf16_t*)(ws + WS_W2); bf16_t* W3 = (bf16_t*)(ws + WS_W3); bf16_t* PW = (bf16_t*)(ws + WS_PW);
            LAS float* scr = (LAS float*)(lds + wave * 17408);
            constexpr int I1 = (DM / 64) * (NIN / 64), I2 = (BWID / 64) * (DM / 64), I3 = (DM / 64) * (DM / 64), I4 = 2 * 2, PER = I1 + 3 * I2 + I3 + 4 * I4;
            for (int it = gw; it < NLAYER * PER; it += NGW) {
                const int l = it / PER; int r = it % PER;
                if (r < I1) { transpose_item(w_in + (size_t)l * DM * NIN, NIN, W1 + (size_t)l * NIN * DM, DM, 0, 0, true, scr, r, lane); continue; } r -= I1;
                if (r < 3 * I2) { const int n = r / I2; transpose_item(w_branch + ((size_t)l * 3 + n) * BWID * DM, DM, W2 + (size_t)l * 3 * DM * BWID, 3 * BWID, n * BWID, 0, false, scr, r % I2, lane); continue; } r -= 3 * I2;
                if (r < I3) { transpose_item(w_out + (size_t)l * DM * DM, DM, W3 + (size_t)l * DM * DM, DM, 0, 0, false, scr, r, lane); continue; } r -= I3;
                { const int g = r / I4; transpose_item(pool_w + ((size_t)l * 4 + g) * 128 * 128, 128, PW + ((size_t)l * 4 + g) * 128 * 128, 128, 0, 0, false, scr, r % I4, lane, pool_scale + l * BWID + g * 128); }
            }
            for (int m = gw; m < MTOK; m += 2 * NGW) rms_rows_to_bf16<2>(x, pre_g, H, m, NGW, lane);
        } else {
            constexpr int l = (ph - 1) / 5, k = (ph - 1) % 5;
            if constexpr (k == 0) {
                pg8::Gemm g{H, (bf16_t*)(ws + WS_W1) + (size_t)l * NIN * DM, MTOK, NIN, DM, 0}; pg8::StaticOrder S; S.init(MTOK, NIN, G, bx);
                EpiU E{ws};
                pg8::gemm_phase<EpiU, pg8::StaticOrder, true, true>(lds, g, S, E);
            } else if constexpr (k == 1) {
                const float* pool_scale = as_global(A->in[4]); const float* conv_w = as_global(A->in[5]); const float* conv_b = as_global(A->in[6]);
                const bf16_t* PW = (const bf16_t*)(ws + WS_PW);
                const bf16_t* Q = U + 2 * (ARRB / 2); const bf16_t* Kk = U + 3 * (ARRB / 2); const bf16_t* V = U + 4 * (ARRB / 2);
                LAS unsigned char* vl = lds + wave * (32 * VROW);
                bf16_t* G3 = U + 5 * (ARRB / 2);
                bf16_t* YO = G3;
#if MIX_PROBE
                if (l == 0 && A->ph_hi < 0) YO = (bf16_t*)as_global(A->out);
#endif
                int pm_ = 7;
#if MIX_PROBE
                if (l == 0 && A->ph_hi < 0) pm_ = MIX_PROBE;
#endif
                if (l == 0) TSTAMP(12);
                volatile LAS unsigned* wq = (volatile LAS unsigned*)(lds + 147216);
                if (tid < 3) wq[tid] = 0u;
                __syncthreads();
#define WQ_GRAB(Q_) ({ unsigned v_ = 0u; if (lane == 0) v_ = __hip_atomic_fetch_add((LAS unsigned*)(Q_), 1u, __ATOMIC_RELAXED, __HIP_MEMORY_SCOPE_WORKGROUP); (unsigned)__builtin_amdgcn_readfirstlane((int)v_); })
#define WQ_ITEM(J_) ((int)(vcu * 8 + ((J_) & 7u) + ((J_) >> 3) * (unsigned)NGW))
                for (;;) { const unsigned j = WQ_GRAB(wq); const int it = WQ_ITEM(j); if (it >= NB * 8 * 128) break; attn_item(it, Q, Kk, V, G3 + 1024, YO + 1024, vl, lane); }
                if (l == 0) TSTAMP(13);
                for (;;) { const unsigned j = WQ_GRAB(wq + 1); const int it = WQ_ITEM(j); if (it >= (MTOK / 32) * 4) break; pool_item(it, U, G3, YO, PW + (size_t)l * 4 * 128 * 128, pool_scale + l * BWID, lds + 36864 + wave * (48 * PROW), lane); }
                if (l == 0) TSTAMP(14);
                for (;;) { const unsigned j = WQ_GRAB(wq + 2); const int it = WQ_ITEM(j); if (it >= MTOK / 8) break; conv_item(it, U + 1 * (ARRB / 2), G3 + 512, YO + 512, conv_w + l * 3 * BWID, conv_b + l * BWID, lane); }
#undef WQ_GRAB
#undef WQ_ITEM
                if (l == 0) TSTAMP(15);
#if TP_A >= 0
                if (l == 0) { __syncthreads(); TSTAMP(5); }
#endif
            } else if constexpr (k == 2) {
                pg8::Gemm g{U + 5 * (ARRB / 2), (bf16_t*)(ws + WS_W2) + (size_t)l * 3 * DM * BWID, MTOK, DM, 3 * BWID, 0}; pg8::StaticOrder S; S.init(MTOK, DM, G, bx);
                EpiBranch E{ws};
                pg8::gemm_phase<EpiBranch, pg8::StaticOrder, true, true>(lds, g, S, E);
            } else if constexpr (k == 3) {
                pg8::Gemm g{H, (bf16_t*)(ws + WS_W3) + (size_t)l * DM * DM, MTOK, DM, DM, 0}; pg8::StaticOrder S; S.init(MTOK, DM, G, bx);
                if (G == 256) {
                    const float* x = as_global(A->in[0]); const float* pre_g = as_global(A->in[1]); const float* post_g = as_global(A->in[9]); float* out = as_global(A->out);
                    float* xb = (float*)(ws + WS_RS); unsigned* cn = (unsigned*)(ws + WS_CTL + CTL_CNT);
                    if constexpr (l + 1 < NLAYER) {
                        EpiNorm2 E{x, out, H, post_g + l * DM, pre_g + (l + 1) * DM, RmsPanel{xb, cn}, RmsPanel{xb + (size_t)MTOK * 4, cn + 64 * 64}};
                        pg8::gemm_phase<EpiNorm2, pg8::StaticOrder, false, true>(lds, g, S, E);
                    } else {
                        EpiNorm1 E{out, post_g + l * DM, RmsPanel{xb + (size_t)2 * MTOK * 4, cn + 2 * 64 * 64}};
                        pg8::gemm_phase<EpiNorm1, pg8::StaticOrder, false, true>(lds, g, S, E);
                    }
                } else {
                    EpiOut E{ws};
                    pg8::gemm_phase<EpiOut, pg8::StaticOrder, true, true>(lds, g, S, E);
                }
            } else {
                const float* x = as_global(A->in[0]); const float* pre_g = as_global(A->in[1]); const float* post_g = as_global(A->in[9]); float* out = as_global(A->out);
                const float* F32T = (const float*)(ws + WS_U); const float* RS = (const float*)(ws + WS_RS);
                const float* xin = (l == 0) ? x : out; const float* gnext = (l + 1 < NLAYER) ? pre_g + (l + 1) * DM : nullptr;
                if (G != 256) for (int m = gw; m < MTOK; m += 2 * NGW) norm_rows<2>(F32T, RS, xin, post_g + l * DM, out, gnext, H, m, NGW, lane);
            }
        }
}
__global__ void __launch_bounds__(512, 2) hybrid_fwd(Args a_) {
    extern __shared__ __attribute__((aligned(16))) unsigned char lds_raw[];
    LAS unsigned char* lds = (LAS unsigned char*)lds_raw;
    cg::grid_group grid = cg::this_grid();
    if (threadIdx.x < 64) ((LAS unsigned*)(lds + 147200))[threadIdx.x] = 0u;
    __syncthreads();
    (void)xcd_barrier_post((unsigned*)(a_.ws + WS_CTL), (volatile LAS unsigned*)(lds + 147200 + 32));
#define SEAM_BAR() do { XcdBarrier b_; b_.bar = (unsigned*)(a_.ws + WS_CTL); b_.x = xb_xcc_id(); b_.st = (volatile LAS unsigned*)(lds + 147200 + 32); xcd_barrier(b_); } while (0)
    const int lo = a_.ph_lo, hi = a_.ph_hi < 0 ? -a_.ph_hi : a_.ph_hi;
#define PHASE(k) if (lo <= (k) && (k) < hi && !(((k) == 5 || (k) == 10) && gridDim.x == 256)) { if ((k) > lo) { if ((k) == 1 && lo < 0) grid.sync(); else SEAM_BAR(); } TSTAMP(k); run_phase<(k)>(a_, lds); }
    PHASE(0) PHASE(1) PHASE(2) PHASE(3) PHASE(4) PHASE(5) PHASE(6) PHASE(7) PHASE(8) PHASE(9) PHASE(10)
#undef PHASE
#if TP_A >= 0
    SEAM_BAR(); TSTAMP(11);
    if (blockIdx.x == TP_BLK && threadIdx.x == 0) { volatile LAS unsigned long long* ts = (volatile LAS unsigned long long*)(lds + 147264); a_.out[0] += (float)(ts[TP_B] - ts[TP_A]) * (0.00005f * TP_SCALE); }
#endif
}

extern "C" void kernel_launch(void* const* d_in, const int* in_sizes, int n_in, void* d_out, int out_size, void* d_ws, size_t ws_size, hipStream_t stream) {
    static int grid = 0;
    if (grid == 0) {
        if (n_in != 10 || out_size != MTOK * DM || ws_size < WS_END) { fprintf(stderr, "kernel_launch: unexpected shapes / workspace (n_in %d out %d ws %zu)\n", n_in, out_size, ws_size); grid = -1; return; }
        int dev = 0, cus = 0, per_cu = 0;
        (void)hipGetDevice(&dev); (void)hipDeviceGetAttribute(&cus, hipDeviceAttributeMultiprocessorCount, dev);
        (void)hipFuncSetAttribute((const void*)hybrid_fwd, hipFuncAttributeMaxDynamicSharedMemorySize, LDS_BYTES);
        (void)hipOccupancyMaxActiveBlocksPerMultiprocessor(&per_cu, (const void*)hybrid_fwd, 512, LDS_BYTES);
        (void)hipGetLastError();
        if (per_cu < 1) { fprintf(stderr, "kernel_launch: occupancy query says %d blocks/CU\n", per_cu); per_cu = 1; }
        grid = cus;
    }
    if (grid < 0) return;
    if (hipMemsetAsync((char*)d_ws + WS_CTL, 0, CTL_BYTES, stream) != hipSuccess) { fprintf(stderr, "kernel_launch: memset of the barrier words failed\n"); return; }
    Args a{};
    for (int i = 0; i < 10; ++i) a.in[i] = (const float*)d_in[i];
    a.out = (float*)d_out; a.ws = (unsigned char*)d_ws;
#if ONE_LAUNCH
    a.ph_lo = 0; a.ph_hi = NPHASE;
    void* args[] = {&a};
    hipError_t e = hipLaunchCooperativeKernel((const void*)hybrid_fwd, dim3(grid), dim3(512), args, LDS_BYTES, stream);
    if (e != hipSuccess) fprintf(stderr, "cooperative launch failed: %s (grid %d)\n", hipGetErrorString(e), grid);
#else
    for (int ph = 0; ph < NPHASE; ++ph) { a.ph_lo = ph; a.ph_hi = ph + 1;
#if MIX_PROBE
        if (ph == 2) { a.ph_hi = -(ph + 1); hipLaunchKernelGGL(hybrid_fwd, dim3(grid), dim3(512), LDS_BYTES, stream, a); a.ph_hi = ph + 1; }
#endif
        for (int rep = 0; rep < 1 + ((DUP_MASK >> ph) & 1); ++rep) hipLaunchKernelGGL(hybrid_fwd, dim3(grid), dim3(512), LDS_BYTES, stream, a); }
#endif
}
```

```cpp
#include <hip/hip_runtime.h>
#include <hip/hip_cooperative_groups.h>
#include <cstdio>
#include <cstdint>
namespace cg = cooperative_groups;
#ifndef ONE_LAUNCH
#define ONE_LAUNCH 1
#endif
#ifndef DUP_MASK
#define DUP_MASK 0
#endif
#ifndef MIX_PROBE
#define MIX_PROBE 0
#endif
#ifndef TP_A
#define TP_A -1
#define TP_B -1
#endif
#ifndef TP_SCALE
#define TP_SCALE 1
#endif
#ifndef TP_BLK
#define TP_BLK 0
#endif
namespace pg8 {
#define PG8_LAS __attribute__((address_space(3)))
typedef unsigned short bf16_t;
typedef short bf16x8 __attribute__((ext_vector_type(8)));
typedef float f32x4 __attribute__((ext_vector_type(4)));
typedef unsigned u32x4 __attribute__((ext_vector_type(4)));
constexpr int BM = 256, BK = 64, HALF = 128, HTB = HALF * BK * 2  , STAGE_BYTES = 8 * HTB, NXCD = 8, WGM = 8;

__host__ __device__ __forceinline__ int lds_byte(int r, int c) { const int st = (r >> 4) * 2 + (c >> 5), rr = r & 15, cc = c & 31, ob = rr * 64 + cc * 2; return st * 1024 + (ob ^ (((ob >> 9) & 1) << 5)); }
__host__ __device__ __forceinline__ void stage_rc(int b, int& R, int& C) { const int st = b / 1024, sb = b % 1024, swz = sb ^ (((sb >> 9) & 1) << 5); R = (st >> 1) * 16 + swz / 64; C = (st & 1) * 32 + (swz % 64) / 2; }
__host__ __device__ __forceinline__ int perm32(int rho) { const int n = rho >> 4, i = rho & 15; return 8 * (i >> 2) + 4 * n + (i & 3); }

struct Unit { int pm, pn, az; };
struct Gemm { const bf16_t* A; const bf16_t* Bt; int M, N, K; size_t azs; };

struct StaticOrder {
    int nM, nN, nwg, G, c;
    __host__ __device__ void init(int M, int N, int G_, int c_) { nM = M / BM; nN = N / BM; nwg = nM * nN; G = G_; c = c_; }
    __host__ __device__ bool next(int i, Unit& u) const {
        const long L = (long)i * G + c; if (L >= nwg) return false;
        int wgid = (int)L; { const int q = nwg / NXCD, r = nwg % NXCD, xcd = wgid % NXCD, off = wgid / NXCD; wgid = (xcd < r ? xcd * (q + 1) : r * (q + 1) + (xcd - r) * q) + off; }
        const int nig = WGM * nN, gid = wgid / nig, fm = gid * WGM, gsz = (nM - fm) < WGM ? (nM - fm) : WGM;
        u.pm = fm + ((wgid % nig) % gsz); u.pn = (wgid % nig) / gsz; u.az = 0; return true;
    }
    __device__ __forceinline__ void a_ready(const Unit&) const {}
    __device__ __forceinline__ void done(const Unit&) const {}
};

__device__ __forceinline__ unsigned cvt_pk_bf16(float lo, float hi) { unsigned r; asm volatile("v_cvt_pk_bf16_f32 %0, %1, %2" : "=v"(r) : "v"(lo), "v"(hi)); return r; }
template <class Epi, class Sched, bool ALIGN_EPI = false, bool SP2 = false>
__device__ __forceinline__ void gemm_phase(PG8_LAS unsigned char* lds, const Gemm g, const Sched& S, const Epi& E) {
    const int tid = threadIdx.x, wid = __builtin_amdgcn_readfirstlane(tid >> 6), lane = tid & 63, wr = wid >> 2, wc = wid & 3, fr = lane & 15, fq = lane >> 4;
    const int K = g.K, nt = K / BK;
    unsigned voffA[2], voffB[2];
#pragma unroll
    for (int i = 0; i < 2; ++i) { int R, C; stage_rc(tid * 16 + i * 8192, R, C); const int Rb = Epi::PERM ? ((R & ~31) + perm32(R & 31)) : R;
        voffA[i] = (unsigned)(R * K + C) * 2u; voffB[i] = (unsigned)(Rb * K + C) * 2u; }
    const size_t kstep = (size_t)(BK * 2);
    const size_t hstep = (size_t)HALF * K * 2;
    const size_t tstep = 2 * hstep;
    const unsigned ldsw = (unsigned)wid * 1024u;
    const int aoff = lds_byte(wr * 64 + fr, fq * 8), boff = lds_byte(wc * 32 + fr, fq * 8);
#define PG8_SA(b, h) (((b) * 2 + (h)) * HTB)
#define PG8_SB(b, h) ((4 + (b) * 2 + (h)) * HTB)
#define PG8_STAGE(bufoff, gbase, voff) do { _Pragma("unroll") for (int _i = 0; _i < 2; ++_i) \
        __builtin_amdgcn_global_load_lds((const unsigned*)((const char*)(gbase) + (voff)[_i]), (PG8_LAS unsigned*)(lds + (bufoff) + ldsw + _i * 8192), 16, 0, 0); } while (0)
#define PG8_LDA(dst, b, h) do { _Pragma("unroll") for (int m = 0; m < 4; ++m) _Pragma("unroll") for (int k = 0; k < 2; ++k) dst[m][k] = *(const PG8_LAS bf16x8*)(lds + PG8_SA(b, h) + aoff + m * 2048 + k * 1024); } while (0)
#define PG8_LDB(dst, b, h) do { _Pragma("unroll") for (int n = 0; n < 2; ++n) _Pragma("unroll") for (int k = 0; k < 2; ++k) dst[n][k] = *(const PG8_LAS bf16x8*)(lds + PG8_SB(b, h) + boff + n * 2048 + k * 1024); } while (0)
#define PG8_MMA(ai, bj, At, Bt) do { __builtin_amdgcn_s_setprio(1); _Pragma("unroll") for (int m = 0; m < 4; ++m) _Pragma("unroll") for (int n = 0; n < 2; ++n) _Pragma("unroll") for (int k = 0; k < 2; ++k) \
        acc[ai][bj][m][n] = __builtin_amdgcn_mfma_f32_16x16x32_bf16(Bt[n][k], At[m][k], acc[ai][bj][m][n], 0, 0, 0); __builtin_amdgcn_s_setprio(0); } while (0)
#define PG8_WAIT_V(n) asm volatile("s_waitcnt vmcnt(" #n ")" ::: "memory")
#define PG8_WAIT_L(n) asm volatile("s_waitcnt lgkmcnt(" #n ")" ::: "memory")
#define PG8_BAR __builtin_amdgcn_s_barrier()
#define PG8_SCHED __builtin_amdgcn_sched_barrier(0)
    Unit cur, nxt; int ui = 0;
    if (!S.next(0, cur)) return;
    f32x4 acc[2][2][4][2];
#pragma unroll
    for (int a = 0; a < 2; ++a)
#pragma unroll
        for (int b = 0; b < 2; ++b)
#pragma unroll
            for (int m = 0; m < 4; ++m)
#pragma unroll
                for (int n = 0; n < 2; ++n) acc[a][b][m][n] = (f32x4){0.f, 0.f, 0.f, 0.f};
    bf16x8 At[4][2], B0[2][2], B1[2][2];
    const char* cA = (const char*)g.A + (size_t)cur.pm * tstep + (size_t)cur.az * g.azs; const char* cB = (const char*)g.Bt + (size_t)cur.pn * tstep;
    S.a_ready(cur);
    if constexpr (SP2) {
        PG8_STAGE(PG8_SB(0, 0), cB, voffB); PG8_STAGE(PG8_SB(0, 1), cB + hstep, voffB); PG8_STAGE(PG8_SA(0, 0), cA, voffA); PG8_STAGE(PG8_SA(0, 1), cA + hstep, voffA);
        if (wr == 1) PG8_BAR;
        PG8_WAIT_V(2); PG8_BAR;
        PG8_STAGE(PG8_SB(1, 0), cB + kstep, voffB); PG8_STAGE(PG8_SA(1, 0), cA + kstep, voffA); PG8_STAGE(PG8_SB(1, 1), cB + hstep + kstep, voffB);
        PG8_WAIT_V(6); PG8_BAR;
    } else {
        PG8_STAGE(PG8_SB(0, 0), cB, voffB); PG8_STAGE(PG8_SA(0, 0), cA, voffA); PG8_STAGE(PG8_SB(0, 1), cB + hstep, voffB); PG8_STAGE(PG8_SA(0, 1), cA + hstep, voffA);
        if (wr == 1) PG8_BAR;
        PG8_WAIT_V(4); PG8_BAR;
        PG8_STAGE(PG8_SB(1, 0), cB + kstep, voffB); PG8_STAGE(PG8_SA(1, 0), cA + kstep, voffA); PG8_STAGE(PG8_SB(1, 1), cB + hstep + kstep, voffB);
        PG8_WAIT_V(6); PG8_BAR;
    }
    for (;;) {
        const bool has_next = S.next(ui + 1, nxt);
        const char* nA = has_next ? (const char*)g.A + (size_t)nxt.pm * tstep + (size_t)nxt.az * g.azs : cA; const char* nB = has_next ? (const char*)g.Bt + (size_t)nxt.pn * tstep : cB;
        for (int t = 0; t < nt; t += 2) {
            if constexpr (Epi::MIDK) { if (t == 8 || t == 16) E.mid(acc, cur, t >> 3, wr, wc, fr, fq); }
            const bool last = (t == nt - 2);
            const char* a1 = cA + (size_t)(t + 1) * kstep;
            const char* a2 = last ? nA : cA + (size_t)(t + 2) * kstep; const char* b2 = last ? nB : cB + (size_t)(t + 2) * kstep;
            const char* a3 = a2 + kstep; const char* b3 = b2 + kstep;
            if (last && has_next) S.a_ready(nxt);
            if constexpr (SP2) {
            PG8_LDB(B0, 0, 0); PG8_LDB(B1, 0, 1); PG8_SCHED; PG8_LDA(At, 0, 0); PG8_STAGE(PG8_SA(1, 1), a1 + hstep, voffA);
            PG8_WAIT_V(8); PG8_WAIT_L(0); PG8_BAR; PG8_MMA(0, 0, At, B0); PG8_MMA(0, 1, At, B1); PG8_BAR; PG8_SCHED;
            PG8_LDA(At, 0, 1); PG8_STAGE(PG8_SB(0, 0), b2, voffB); PG8_STAGE(PG8_SB(0, 1), b2 + hstep, voffB); PG8_STAGE(PG8_SA(0, 0), a2, voffA);
            PG8_WAIT_V(8); PG8_WAIT_L(0); PG8_BAR; PG8_MMA(1, 0, At, B0); PG8_MMA(1, 1, At, B1); PG8_BAR; PG8_SCHED;
            PG8_LDB(B0, 1, 0); PG8_LDB(B1, 1, 1); PG8_SCHED; PG8_LDA(At, 1, 0); PG8_STAGE(PG8_SA(0, 1), a2 + hstep, voffA);
            PG8_WAIT_V(8); PG8_WAIT_L(0); PG8_BAR; PG8_MMA(0, 0, At, B0); PG8_MMA(0, 1, At, B1); PG8_BAR; PG8_SCHED;
            PG8_LDA(At, 1, 1); PG8_STAGE(PG8_SB(1, 0), b3, voffB); PG8_STAGE(PG8_SB(1, 1), b3 + hstep, voffB); PG8_STAGE(PG8_SA(1, 0), a3, voffA);
            PG8_WAIT_V(8); PG8_WAIT_L(0); PG8_BAR; PG8_MMA(1, 0, At, B0); PG8_MMA(1, 1, At, B1); PG8_BAR; PG8_SCHED;
            } else {
            PG8_LDB(B0, 0, 0); PG8_SCHED; PG8_LDA(At, 0, 0); PG8_STAGE(PG8_SA(1, 1), a1 + hstep, voffA);
            PG8_WAIT_L(8); PG8_BAR; PG8_WAIT_L(0); PG8_MMA(0, 0, At, B0); PG8_BAR; PG8_SCHED;
            PG8_LDB(B1, 0, 1); PG8_STAGE(PG8_SB(0, 0), b2, voffB);
            PG8_BAR; PG8_WAIT_L(0); PG8_MMA(0, 1, At, B1); PG8_BAR;
            PG8_LDA(At, 0, 1); PG8_STAGE(PG8_SA(0, 0), a2, voffA);
            PG8_BAR; PG8_WAIT_L(0); PG8_MMA(1, 0, At, B0); PG8_BAR; PG8_SCHED;
            PG8_STAGE(PG8_SB(0, 1), b2 + hstep, voffB);
            PG8_WAIT_V(6); PG8_BAR; PG8_MMA(1, 1, At, B1); PG8_BAR;
            PG8_LDB(B0, 1, 0); PG8_SCHED; PG8_LDA(At, 1, 0); PG8_STAGE(PG8_SA(0, 1), a2 + hstep, voffA);
            PG8_WAIT_L(8); PG8_BAR; PG8_WAIT_L(0); PG8_MMA(0, 0, At, B0); PG8_BAR; PG8_SCHED;
            PG8_LDB(B1, 1, 1); PG8_STAGE(PG8_SB(1, 0), b3, voffB);
            PG8_BAR; PG8_WAIT_L(0); PG8_MMA(0, 1, At, B1); PG8_BAR;
            PG8_LDA(At, 1, 1); PG8_STAGE(PG8_SA(1, 0), a3, voffA);
            PG8_BAR; PG8_WAIT_L(0); PG8_MMA(1, 0, At, B0); PG8_BAR; PG8_SCHED;
            PG8_STAGE(PG8_SB(1, 1), b3 + hstep, voffB);
            PG8_WAIT_V(6); PG8_BAR; PG8_MMA(1, 1, At, B1); PG8_BAR;
            }
        }
        if constexpr (ALIGN_EPI) { if (wr == 0) PG8_BAR; }
        if constexpr (!Epi::AFTER_DRAIN) { E(acc, cur, wr, wc, fr, fq); S.done(cur); }
        if (!has_next) break;
#pragma unroll
        for (int a = 0; a < 2; ++a)
#pragma unroll
            for (int b = 0; b < 2; ++b)
#pragma unroll
                for (int m = 0; m < 4; ++m)
#pragma unroll
                    for (int n = 0; n < 2; ++n) acc[a][b][m][n] = (f32x4){0.f, 0.f, 0.f, 0.f};
        cur = nxt; cA = nA; cB = nB; ++ui;
        if constexpr (ALIGN_EPI) { if (wr == 1) PG8_BAR; }
    }
    PG8_WAIT_V(0);
    if constexpr (!ALIGN_EPI) { if (wr == 0) PG8_BAR; }
    PG8_BAR;
    if constexpr (Epi::AFTER_DRAIN) { E.fused(acc, cur, wr, wc, fr, fq, lds, wid, lane); S.done(cur); }
#undef PG8_SA
#undef PG8_SB
#undef PG8_STAGE
#undef PG8_LDA
#undef PG8_LDB
#undef PG8_MMA
#undef PG8_WAIT_V
#undef PG8_WAIT_L
#undef PG8_BAR
#undef PG8_SCHED
}
}

#define LAS __attribute__((address_space(3)))
typedef unsigned short bf16_t;
typedef short bf16x8 __attribute__((ext_vector_type(8)));
typedef short s16x4 __attribute__((ext_vector_type(4)));
typedef float f32x4 __attribute__((ext_vector_type(4)));
typedef float f32x16 __attribute__((ext_vector_type(16)));
typedef unsigned u32x4 __attribute__((ext_vector_type(4)));
typedef unsigned u32x2 __attribute__((ext_vector_type(2)));
constexpr int NB = 4, SEQ = 4096, DM = 1024, MTOK = NB * SEQ, NIN = 8192, BWID = 512, NLAYER = 2;
constexpr float RMS_EPS = 1e-6f;
constexpr size_t MiB = 1u << 20;
constexpr size_t WS_RS = 0;
constexpr size_t WS_W1 = 2 * MiB;
constexpr size_t WS_W2 = 34 * MiB;
constexpr size_t WS_W3 = 40 * MiB;
constexpr size_t WS_PW = 44 * MiB;
constexpr size_t WS_H = 45 * MiB;
constexpr size_t WS_U = 77 * MiB;
constexpr size_t ARRB = 16 * MiB;
constexpr size_t WS_MG = 205 * MiB;
constexpr size_t WS_END = 253 * MiB;
constexpr int LDS_BYTES = 147456;
constexpr int NPHASE = 1 + 5 * NLAYER;

__device__ __forceinline__ unsigned f2bf(float f) { unsigned u = __builtin_bit_cast(unsigned, f); return (u + 0x7fffu + ((u >> 16) & 1u)) >> 16; }
__device__ __forceinline__ unsigned pk2(float lo, float hi) { return f2bf(lo) | (f2bf(hi) << 16); }
__device__ __forceinline__ float bflo(unsigned u) { return __builtin_bit_cast(float, u << 16); }
__device__ __forceinline__ float bfhi(unsigned u) { return __builtin_bit_cast(float, u & 0xffff0000u); }
__device__ __forceinline__ float sigmoid_f(float x) { return __builtin_amdgcn_rcpf(1.f + __builtin_amdgcn_exp2f(-1.4426950408889634f * x)); }
__device__ __forceinline__ float silu_f(float x) { return x * sigmoid_f(x); }
__device__ __forceinline__ unsigned q8(float x) { const unsigned q = (unsigned)(sigmoid_f(x) * 255.f + 0.5f); return q < 1u ? 1u : q; }
__device__ __forceinline__ float wave_sum(float v) {
#pragma unroll
    for (int o = 1; o < 64; o <<= 1) v += __shfl_xor(v, o);
    return v;
}

constexpr size_t WS_CTL = 1 * MiB; constexpr size_t CTL_BYTES = 65536;
constexpr size_t CTL_CNT = 16384;
#define XB_TMO      128
#define XB_XCNT(j)  (256  + 64 * (j))
#define XB_XSUB(j)  (1280 + 64 * (j))
#define XB_XGEN(j)  (2304 + 64 * (j))
#define XB_TOP      3328
#define XB_TOPGEN   3392
#define XCD_BAR_WORDS 3456
#define XB_SPIN_CAP (1u << 18)

__device__ __forceinline__ unsigned xb_ld(unsigned* p)              { return __hip_atomic_load(p, __ATOMIC_RELAXED, __HIP_MEMORY_SCOPE_AGENT); }
__device__ __forceinline__ unsigned xb_add(unsigned* p, unsigned v) { return __hip_atomic_fetch_add(p, v, __ATOMIC_RELAXED, __HIP_MEMORY_SCOPE_AGENT); }
__device__ __forceinline__ unsigned xb_xcc_id() { return (unsigned)__builtin_amdgcn_s_getreg((3 << 11) | 20) & 0xFu; }
#define XB_SPIN(cond, bar) do { unsigned _sp = 0; while (cond) { __builtin_amdgcn_s_sleep(1); \
    if ((++_sp & 255u) == 0u) { if (xb_ld(&(bar)[XB_TMO])) break; if (_sp > XB_SPIN_CAP) { atomicAdd(&(bar)[XB_TMO], 1u); break; } } } } while (0)

struct XcdBarrier {
    unsigned* bar; unsigned x;
    volatile LAS unsigned* st;
};

__device__ __forceinline__ XcdBarrier xcd_barrier_post(unsigned* bar, volatile LAS unsigned* st) {
    XcdBarrier b; b.bar = bar; b.x = xb_xcc_id(); b.st = st;
    if (threadIdx.x == 0) (void)xb_add(&bar[XB_XCNT(b.x)], 1u);
    return b;
}
__device__ __forceinline__ void xcd_barrier_complete(unsigned* bar, unsigned x, unsigned& nloc, unsigned& nx) {
    const unsigned G = gridDim.x * gridDim.y * gridDim.z;
    unsigned sum, cnt, mine, sp = 0u;
    for (;;) {
        sum = 0u; cnt = 0u; mine = 0u;
#pragma unroll
        for (unsigned j = 0; j < 16; ++j) { const unsigned c = xb_ld(&bar[XB_XCNT(j)]); sum += c; cnt += (c > 0u) ? 1u : 0u; mine = (j == x) ? c : mine; }
        if (sum == G) break;
        __builtin_amdgcn_s_sleep(1);
        if ((++sp & 255u) == 0u) { if (xb_ld(&bar[XB_TMO])) break; if (sp > XB_SPIN_CAP) { atomicAdd(&bar[XB_TMO], 1u); break; } }
    }
    nloc = mine > 0u ? mine : 1u; nx = cnt > 0u ? cnt : 1u;
}

__device__ __forceinline__ void xcd_barrier(const XcdBarrier& b) {
    asm volatile("s_waitcnt vmcnt(0)" ::: "memory");
    __syncthreads();
    if (threadIdx.x == 0) {
        unsigned* bar = b.bar;
        __builtin_amdgcn_s_waitcnt(0);
        unsigned nloc = b.st[0], nx = b.st[1];
        if (nloc == 0u) { xcd_barrier_complete(bar, b.x, nloc, nx); b.st[0] = nloc; b.st[1] = nx; }
        const unsigned old = xb_add(&bar[XB_XSUB(b.x)], 1u);
        const unsigned gen = old / nloc;
        if (old + 1u == (gen + 1u) * nloc) {
            __builtin_amdgcn_fence(__ATOMIC_RELEASE, "agent");
            asm volatile("s_waitcnt vmcnt(0)" ::: "memory");
            const unsigned og = xb_add(&bar[XB_TOP], 1u);
            const unsigned tg = og / nx;
            if (og + 1u == (tg + 1u) * nx) xb_add(&bar[XB_TOPGEN], 1u);
            else XB_SPIN(xb_ld(&bar[XB_TOPGEN]) == tg, bar);
            __builtin_amdgcn_fence(__ATOMIC_ACQUIRE, "agent");
            xb_add(&bar[XB_XGEN(b.x)], 1u);
            asm volatile("s_waitcnt vmcnt(0)" ::: "memory");
        } else {
            XB_SPIN(xb_ld(&bar[XB_XGEN(b.x)]) == gen, bar);
            __builtin_amdgcn_fence(__ATOMIC_ACQUIRE, "agent");
            asm volatile("s_waitcnt vmcnt(0)" ::: "memory");
        }
    }
    __syncthreads();
}


using pg8::Unit;
struct EpiU {
    static constexpr bool PERM = true, AFTER_DRAIN = false, MIDK = false;
    unsigned char* ws;
    __device__ __forceinline__ void operator()(const f32x4 (&acc)[2][2][4][2], const Unit& u, int wr, int wc, int fr, int fq) const {
        bf16_t* U = (bf16_t*)(ws + WS_U); unsigned char* MG = ws + WS_MG;
        const int pn = u.pn; const int row0 = u.pm * 256 + wr * 64 + fr;
        if (pn >= 20) {
            const int mc0 = (pn - 20) * 256 + wc * 32 + 8 * fq;
#pragma unroll
            for (int ai = 0; ai < 2; ++ai)
#pragma unroll
                for (int m = 0; m < 4; ++m) { unsigned char* rp = MG + (size_t)(row0 + ai * 128 + m * 16) * 3072 + mc0;
#pragma unroll
                    for (int bj = 0; bj < 2; ++bj) { const f32x4 v0 = acc[ai][bj][m][0], v1 = acc[ai][bj][m][1]; u32x2 w;
                        w.x = q8(v0[0]) | (q8(v0[1]) << 8) | (q8(v0[2]) << 16) | (q8(v0[3]) << 24); w.y = q8(v1[0]) | (q8(v1[1]) << 8) | (q8(v1[2]) << 16) | (q8(v1[3]) << 24);
                        *(u32x2*)(rp + bj * 128) = w; } }
        } else if (pn >= 4 && pn < 12) {
            const int ch0 = (pn - 4) * 64 + (4 * wc + fq) * 4;
            bf16_t* Z = U + 1 * (ARRB / 2); bf16_t* W = U + 5 * (ARRB / 2) + 512;
#pragma unroll
            for (int ai = 0; ai < 2; ++ai)
#pragma unroll
                for (int m = 0; m < 4; ++m) { const size_t rr = (size_t)(row0 + ai * 128 + m * 16); const size_t ro = rr * 512 + ch0, rw = rr * 1536 + ch0;
                    const f32x4 z = acc[ai][0][m][0] * acc[ai][0][m][1]; const f32x4 gb = acc[ai][1][m][0], gg = acc[ai][1][m][1];
                    u32x2 zz, ww; zz.x = pg8::cvt_pk_bf16(z[0], z[1]); zz.y = pg8::cvt_pk_bf16(z[2], z[3]);
                    ww.x = pg8::cvt_pk_bf16(gb[0] * silu_f(gg[0]), gb[1] * silu_f(gg[1])); ww.y = pg8::cvt_pk_bf16(gb[2] * silu_f(gg[2]), gb[3] * silu_f(gg[3]));
                    *(u32x2*)(Z + ro) = zz; *(u32x2*)(W + rw) = ww; }
        } else {
            const int kind = pn >> 1; int arr = 0, pitch = 512, coff = 0; bool act = false;
            if (kind == 1) { arr = 5; act = true; pitch = 1536; } else if (kind == 6) arr = 2; else if (kind == 7) arr = 3; else if (kind == 8) arr = 4; else if (kind == 9) { arr = 5; act = true; pitch = 1536; coff = 1024; }
            bf16_t* O = U + (size_t)arr * (ARRB / 2) + coff; const int col0 = (pn & 1) * 256 + wc * 32 + 8 * fq;
#pragma unroll
            for (int ai = 0; ai < 2; ++ai)
#pragma unroll
                for (int m = 0; m < 4; ++m) { bf16_t* rp = O + (size_t)(row0 + ai * 128 + m * 16) * pitch + col0;
#pragma unroll
                    for (int bj = 0; bj < 2; ++bj) { f32x4 v0 = acc[ai][bj][m][0], v1 = acc[ai][bj][m][1];
                        if (act) {
#pragma unroll
                            for (int i = 0; i < 4; ++i) { v0[i] = silu_f(v0[i]); v1[i] = silu_f(v1[i]); } }
                        u32x4 w; w.x = pg8::cvt_pk_bf16(v0[0], v0[1]); w.y = pg8::cvt_pk_bf16(v0[2], v0[3]); w.z = pg8::cvt_pk_bf16(v1[0], v1[1]); w.w = pg8::cvt_pk_bf16(v1[2], v1[3]);
                        *(u32x4*)(rp + bj * 128) = w; } }
        }
    }
};
struct EpiBranch {
    static constexpr bool PERM = true, AFTER_DRAIN = false, MIDK = true;
    unsigned char* ws;
    __device__ __forceinline__ void mid(f32x4 (&acc)[2][2][4][2], const Unit& u, int seg, int wr, int wc, int fr, int fq) const {
        int tid_ = threadIdx.x; asm volatile("" : "+v"(tid_));
        const int wid_ = tid_ >> 6, wr_ = wid_ >> 2, wc_ = wid_ & 3, fr_ = tid_ & 15, fq_ = (tid_ & 63) >> 4;
        const unsigned char* MG = ws + WS_MG + (seg - 1) * 1024; const int row0 = u.pm * 256 + wr_ * 64 + fr_, col0 = u.pn * 256 + wc_ * 32 + 8 * fq_;
#pragma unroll
        for (int ai = 0; ai < 2; ++ai)
#pragma unroll
            for (int m = 0; m < 4; ++m) { const unsigned char* rp = MG + (size_t)(row0 + ai * 128 + m * 16) * 3072 + col0;
#pragma unroll
                for (int bj = 0; bj < 2; ++bj) { const u32x2 qa = *(const u32x2*)(rp + bj * 128), qb = *(const u32x2*)(rp + bj * 128 + 1024);
                    f32x4 r0, r1;
                    r0[0] = (float)(qa.x & 255u) * __builtin_amdgcn_rcpf((float)(qb.x & 255u)); r0[1] = (float)((qa.x >> 8) & 255u) * __builtin_amdgcn_rcpf((float)((qb.x >> 8) & 255u));
                    r0[2] = (float)((qa.x >> 16) & 255u) * __builtin_amdgcn_rcpf((float)((qb.x >> 16) & 255u)); r0[3] = (float)(qa.x >> 24) * __builtin_amdgcn_rcpf((float)(qb.x >> 24));
                    r1[0] = (float)(qa.y & 255u) * __builtin_amdgcn_rcpf((float)(qb.y & 255u)); r1[1] = (float)((qa.y >> 8) & 255u) * __builtin_amdgcn_rcpf((float)((qb.y >> 8) & 255u));
                    r1[2] = (float)((qa.y >> 16) & 255u) * __builtin_amdgcn_rcpf((float)((qb.y >> 16) & 255u)); r1[3] = (float)(qa.y >> 24) * __builtin_amdgcn_rcpf((float)(qb.y >> 24));
                    acc[ai][bj][m][0] *= r0; acc[ai][bj][m][1] *= r1; }
                if (m == 3) asm volatile("" ::: "memory"); }
    }
    __device__ __forceinline__ void operator()(const f32x4 (&acc)[2][2][4][2], const Unit& u, int wr, int wc, int fr, int fq) const {
        const unsigned char* MG = ws + WS_MG + 2 * 1024; bf16_t* merged = (bf16_t*)(ws + WS_H);
        const int row0 = u.pm * 256 + wr * 64 + fr, col0 = u.pn * 256 + wc * 32 + 8 * fq;
        u32x2 gq[2][4][2];
#pragma unroll
        for (int ai = 0; ai < 2; ++ai)
#pragma unroll
            for (int m = 0; m < 4; ++m)
#pragma unroll
                for (int bj = 0; bj < 2; ++bj) gq[ai][m][bj] = *(const u32x2*)(MG + (size_t)(row0 + ai * 128 + m * 16) * 3072 + col0 + bj * 128);
#pragma unroll
        for (int ai = 0; ai < 2; ++ai)
#pragma unroll
            for (int m = 0; m < 4; ++m) { const size_t row = (size_t)(row0 + ai * 128 + m * 16);
#pragma unroll
                for (int bj = 0; bj < 2; ++bj) { const int col = col0 + bj * 128; const u32x2 g = gq[ai][m][bj];
                    f32x4 g0, g1; const float k = 1.f / 255.f;
                    g0[0] = (float)(g.x & 255u) * k; g0[1] = (float)((g.x >> 8) & 255u) * k; g0[2] = (float)((g.x >> 16) & 255u) * k; g0[3] = (float)(g.x >> 24) * k;
                    g1[0] = (float)(g.y & 255u) * k; g1[1] = (float)((g.y >> 8) & 255u) * k; g1[2] = (float)((g.y >> 16) & 255u) * k; g1[3] = (float)(g.y >> 24) * k;
                    const f32x4 v0 = acc[ai][bj][m][0] * g0, v1 = acc[ai][bj][m][1] * g1;
                    u32x4 w; w.x = pg8::cvt_pk_bf16(v0[0], v0[1]); w.y = pg8::cvt_pk_bf16(v0[2], v0[3]); w.z = pg8::cvt_pk_bf16(v1[0], v1[1]); w.w = pg8::cvt_pk_bf16(v1[2], v1[3]);
                    *(u32x4*)(merged + row * 1024 + col) = w; } }
    }
};
struct EpiOut {
    static constexpr bool PERM = false, AFTER_DRAIN = false, MIDK = false;
    unsigned char* ws;
    __device__ __forceinline__ void operator()(const f32x4 (&acc)[2][2][4][2], const Unit& u, int wr, int wc, int fr, int fq) const {
        float* out = (float*)(ws + WS_U); float* rs = (float*)(ws + WS_RS);
        const int row0 = u.pm * 256 + wr * 64 + fr, col0 = u.pn * 256 + wc * 32 + 4 * fq;
#pragma unroll
        for (int ai = 0; ai < 2; ++ai)
#pragma unroll
            for (int m = 0; m < 4; ++m) { const size_t row = (size_t)(row0 + ai * 128 + m * 16); float ss = 0.f;
#pragma unroll
                for (int bj = 0; bj < 2; ++bj)
#pragma unroll
                    for (int n = 0; n < 2; ++n) { const f32x4 v = acc[ai][bj][m][n]; *(f32x4*)(out + row * 1024 + col0 + bj * 128 + n * 16) = v; ss += (v[0] * v[0] + v[1] * v[1]) + (v[2] * v[2] + v[3] * v[3]); }
                ss += __shfl_xor(ss, 16); ss += __shfl_xor(ss, 32);
                if (fq == 0) rs[row * 16 + u.pn * 4 + wc] = ss; }
    }
};

struct RmsPanel {
    float* xbuf;
    unsigned* cnt;
    __device__ __forceinline__ void run(const f32x4 (&v)[2][2][4][2], const Unit& u, int wr, int wc, int fr, int fq, LAS unsigned char* lds, int wid, int lane) const {
        LAS float* P = (LAS float*)lds; LAS float* S = (LAS float*)(lds + 8192);
#pragma unroll
        for (int ai = 0; ai < 2; ++ai)
#pragma unroll
            for (int m = 0; m < 4; ++m) { float s = 0.f;
#pragma unroll
                for (int bj = 0; bj < 2; ++bj)
#pragma unroll
                    for (int n = 0; n < 2; ++n) { const f32x4 x = v[ai][bj][m][n]; s += (x[0] * x[0] + x[1] * x[1]) + (x[2] * x[2] + x[3] * x[3]); }
                s += __shfl_xor(s, 16); s += __shfl_xor(s, 32);
                if (fq == 0) P[(ai * 128 + wr * 64 + m * 16 + fr) * 4 + wc] = s; }
        asm volatile("s_waitcnt lgkmcnt(0)" ::: "memory"); __builtin_amdgcn_s_barrier(); asm volatile("" ::: "memory");
        const int row = wid * 32 + (lane & 31);
        if (lane < 32) { const float t = (P[row * 4 + 0] + P[row * 4 + 1]) + (P[row * 4 + 2] + P[row * 4 + 3]);
            __hip_atomic_store(xbuf + (size_t)(u.pm * 256 + row) * 4 + u.pn, t, __ATOMIC_RELAXED, __HIP_MEMORY_SCOPE_AGENT); }
        asm volatile("s_waitcnt vmcnt(0)" ::: "memory");
        if (lane == 0) __hip_atomic_fetch_add(cnt + 64 * u.pm, 1u, __ATOMIC_RELAXED, __HIP_MEMORY_SCOPE_AGENT);
        if (wid == 0) {
            unsigned sp = 0;
            while ((unsigned)__builtin_amdgcn_readfirstlane(__hip_atomic_load(cnt + 64 * u.pm, __ATOMIC_RELAXED, __HIP_MEMORY_SCOPE_AGENT)) < 32u) { __builtin_amdgcn_s_sleep(2); if (++sp > (1u << 22)) break; }
            __builtin_amdgcn_fence(__ATOMIC_ACQUIRE, "agent");
        }
        asm volatile("s_waitcnt vmcnt(0) lgkmcnt(0)" ::: "memory"); __builtin_amdgcn_s_barrier(); asm volatile("" ::: "memory");
        if (lane < 32) { const float* slot = xbuf + (size_t)(u.pm * 256 + row) * 4; float t = 0.f;
#pragma unroll
            for (int k = 0; k < 4; ++k) t += __hip_atomic_load(slot + k, __ATOMIC_RELAXED, __HIP_MEMORY_SCOPE_AGENT);
            S[row] = 1.0f / sqrtf(t * (1.f / DM) + RMS_EPS); }
        asm volatile("s_waitcnt lgkmcnt(0)" ::: "memory"); __builtin_amdgcn_s_barrier(); asm volatile("" ::: "memory");
    }
};
struct EpiNorm1 {
    static constexpr bool PERM = false, AFTER_DRAIN = true, MIDK = false;
    float* out; const float* gpost; RmsPanel st;
    __device__ __forceinline__ void operator()(const f32x4 (&)[2][2][4][2], const Unit&, int, int, int, int) const {}
    __device__ __forceinline__ void fused(f32x4 (&acc)[2][2][4][2], const Unit& u, int wr, int wc, int fr, int fq, LAS unsigned char* lds, int wid, int lane) const {
        const LAS float* S = (const LAS float*)(lds + 8192);
        const int col0 = u.pn * 256 + wc * 32 + 4 * fq, jl0 = wc * 32 + 4 * fq;
        f32x4 gp[2][2]; u32x2 pre[2][4][2][2];
#pragma unroll
        for (int bj = 0; bj < 2; ++bj)
#pragma unroll
            for (int n = 0; n < 2; ++n) gp[bj][n] = *(const f32x4*)(gpost + col0 + bj * 128 + n * 16);
#pragma unroll
        for (int ai = 0; ai < 2; ++ai)
#pragma unroll
            for (int m = 0; m < 4; ++m) { const unsigned char* ob = (const unsigned char*)out + (size_t)(u.pm * 256 + ai * 128 + wr * 64 + m * 16 + fr) * 4096 + u.pn * 1024;
#pragma unroll
                for (int bj = 0; bj < 2; ++bj)
#pragma unroll
                    for (int n = 0; n < 2; ++n) pre[ai][m][bj][n] = *(const u32x2*)(ob + 2 * (jl0 + bj * 128 + n * 16)); }
        st.run(acc, u, wr, wc, fr, fq, lds, wid, lane);
#pragma unroll
        for (int ai = 0; ai < 2; ++ai)
#pragma unroll
            for (int m = 0; m < 4; ++m) { const int r = ai * 128 + wr * 64 + m * 16 + fr; const float rs = S[r]; const size_t off = (size_t)(u.pm * 256 + r) * DM + col0;
#pragma unroll
                for (int bj = 0; bj < 2; ++bj)
#pragma unroll
                    for (int n = 0; n < 2; ++n) { const u32x2 p = pre[ai][m][bj][n]; const f32x4 bs = (f32x4){bflo(p.x), bfhi(p.x), bflo(p.y), bfhi(p.y)};
                        *(f32x4*)(out + off + bj * 128 + n * 16) = bs + acc[ai][bj][m][n] * rs * gp[bj][n]; } }
    }
};
struct EpiNorm2 {
    static constexpr bool PERM = false, AFTER_DRAIN = true, MIDK = false;
    const float* base; float* out; bf16_t* hn; const float* gpost; const float* gnext; RmsPanel st1, st2;
    __device__ __forceinline__ void operator()(const f32x4 (&)[2][2][4][2], const Unit&, int, int, int, int) const {}
    __device__ __forceinline__ void fused(f32x4 (&acc)[2][2][4][2], const Unit& u, int wr, int wc, int fr, int fq, LAS unsigned char* lds, int wid, int lane) const {
        const LAS float* S = (const LAS float*)(lds + 8192);
        const int col0 = u.pn * 256 + wc * 32 + 4 * fq;
        f32x4 gp[2][2], pre[4][2][2];
#pragma unroll
        for (int bj = 0; bj < 2; ++bj)
#pragma unroll
            for (int n = 0; n < 2; ++n) gp[bj][n] = *(const f32x4*)(gpost + col0 + bj * 128 + n * 16);
#pragma unroll
        for (int m = 0; m < 4; ++m)
#pragma unroll
            for (int bj = 0; bj < 2; ++bj)
#pragma unroll
                for (int n = 0; n < 2; ++n) pre[m][bj][n] = *(const f32x4*)(base + (size_t)(u.pm * 256 + wr * 64 + m * 16 + fr) * DM + col0 + bj * 128 + n * 16);
        st1.run(acc, u, wr, wc, fr, fq, lds, wid, lane);
#pragma unroll
        for (int ai = 0; ai < 2; ++ai) {
            if (ai == 1) {
#pragma unroll
                for (int m = 0; m < 4; ++m)
#pragma unroll
                    for (int bj = 0; bj < 2; ++bj)
#pragma unroll
                        for (int n = 0; n < 2; ++n) pre[m][bj][n] = *(const f32x4*)(base + (size_t)(u.pm * 256 + 128 + wr * 64 + m * 16 + fr) * DM + col0 + bj * 128 + n * 16);
            }
#pragma unroll
            for (int m = 0; m < 4; ++m) { const int r = ai * 128 + wr * 64 + m * 16 + fr; const float rs = S[r]; const size_t off = (size_t)(u.pm * 256 + r) * DM + col0;
#pragma unroll
                for (int bj = 0; bj < 2; ++bj)
#pragma unroll
                    for (int n = 0; n < 2; ++n) { const f32x4 x1 = pre[m][bj][n] + acc[ai][bj][m][n] * rs * gp[bj][n]; acc[ai][bj][m][n] = x1;
                        u32x2 w; w.x = pg8::cvt_pk_bf16(x1[0], x1[1]); w.y = pg8::cvt_pk_bf16(x1[2], x1[3]);
                        *(u32x2*)((unsigned char*)out + (size_t)(u.pm * 256 + r) * 4096 + u.pn * 1024 + 2 * (wc * 32 + 4 * fq + bj * 128 + n * 16)) = w; } }
        }
#pragma unroll
        for (int bj = 0; bj < 2; ++bj)
#pragma unroll
            for (int n = 0; n < 2; ++n) gp[bj][n] = *(const f32x4*)(gnext + col0 + bj * 128 + n * 16);
        st2.run(acc, u, wr, wc, fr, fq, lds, wid, lane);
#pragma unroll
        for (int ai = 0; ai < 2; ++ai)
#pragma unroll
            for (int m = 0; m < 4; ++m) { const int r = ai * 128 + wr * 64 + m * 16 + fr; const float rs = S[r]; const size_t off = (size_t)(u.pm * 256 + r) * DM + col0;
#pragma unroll
                for (int bj = 0; bj < 2; ++bj)
#pragma unroll
                    for (int n = 0; n < 2; ++n) { const f32x4 o = acc[ai][bj][m][n] * rs * gp[bj][n];
                        u32x2 w; w.x = pg8::cvt_pk_bf16(o[0], o[1]); w.y = pg8::cvt_pk_bf16(o[2], o[3]); *(u32x2*)(hn + off + bj * 128 + n * 16) = w; } }
    }
};
__device__ __forceinline__ int win_row(int c) {
    if (c < 1024 || c >= 3072) return c;
    const int q = (c - 1024) >> 9, ch = (c - 1024) & 511, ct = ch >> 6, grp = (ch & 63) >> 2, e = ch & 3;
    return 1024 + ct * 256 + (q & 1) * 128 + grp * 8 + (q >> 1) * 4 + e;
}
__device__ __forceinline__ void transpose_item(const float* W, int N, bf16_t* WT, int ldt, int koff, int row_off, bool winmap, LAS float* scr, int item, int lane, const float* rscale = nullptr) {
    const int nblk = N / 64, kb = item / nblk, nb = item % nblk, k0 = 64 * kb, n0 = 64 * nb;
    const int kq = lane >> 4, nq = lane & 15;
    f32x4 v[16];
#pragma unroll
    for (int i = 0; i < 16; ++i) v[i] = *(const f32x4*)(W + (size_t)(k0 + 4 * i + kq) * N + n0 + 4 * nq);
#pragma unroll
    for (int i = 0; i < 16; ++i) { LAS float* s = scr + (4 * i + kq) * 65 + 4 * nq; s[0] = v[i][0]; s[1] = v[i][1]; s[2] = v[i][2]; s[3] = v[i][3]; }
    asm volatile("s_waitcnt lgkmcnt(0)" ::: "memory");
    const int c = lane & 7;
#pragma unroll
    for (int j = 0; j < 8; ++j) { const int n = (lane >> 3) + 8 * j;
        const LAS float* s = scr + (rscale ? (16 * (c >> 1) + 4 * (c & 1)) : 8 * c) * 65 + n; const int hs = rscale ? 8 * 65 : 4 * 65; const float f = rscale ? rscale[n0 + n] : 1.f;
        u32x4 o; o.x = pg8::cvt_pk_bf16(s[0 * 65] * f, s[1 * 65] * f); o.y = pg8::cvt_pk_bf16(s[2 * 65] * f, s[3 * 65] * f); o.z = pg8::cvt_pk_bf16(s[hs] * f, s[hs + 65] * f); o.w = pg8::cvt_pk_bf16(s[hs + 2 * 65] * f, s[hs + 3 * 65] * f);
        int dst = n0 + n; if (winmap) dst = win_row(dst);
        *(u32x4*)(WT + (size_t)(row_off + dst) * ldt + koff + k0 + 8 * c) = o; }
    asm volatile("s_waitcnt lgkmcnt(0)" ::: "memory");
}
template <int R> __device__ __forceinline__ void rms_rows_to_bf16(const float* x, const float* g, bf16_t* H, int m0, int mstride, int lane) {
    f32x4 v[R][4];
#pragma unroll
    for (int r = 0; r < R; ++r)
#pragma unroll
        for (int j = 0; j < 4; ++j) v[r][j] = ((const f32x4*)(x + (size_t)(m0 + r * mstride) * DM))[64 * j + lane];
    f32x4 gg[4];
#pragma unroll
    for (int j = 0; j < 4; ++j) gg[j] = ((const f32x4*)g)[64 * j + lane];
#pragma unroll
    for (int r = 0; r < R; ++r) { float s = 0.f;
#pragma unroll
        for (int j = 0; j < 4; ++j) s += (v[r][j][0] * v[r][j][0] + v[r][j][1] * v[r][j][1]) + (v[r][j][2] * v[r][j][2] + v[r][j][3] * v[r][j][3]);
        const float rstd = 1.f / sqrtf(wave_sum(s) * (1.f / DM) + RMS_EPS);
        u32x2* o8 = (u32x2*)(H + (size_t)(m0 + r * mstride) * DM) + lane;
#pragma unroll
        for (int j = 0; j < 4; ++j) { u32x2 w; w.x = pg8::cvt_pk_bf16(v[r][j][0] * rstd * gg[j][0], v[r][j][1] * rstd * gg[j][1]); w.y = pg8::cvt_pk_bf16(v[r][j][2] * rstd * gg[j][2], v[r][j][3] * rstd * gg[j][3]); o8[64 * j] = w; } }
}

__device__ __forceinline__ int crow(int r, int hi) { return (r & 3) + 8 * (r >> 2) + 4 * hi; }
constexpr int VROW = 144;
__device__ __forceinline__ void attn_item(int item, const bf16_t* Q, const bf16_t* K, const bf16_t* V, const bf16_t* SG, bf16_t* YO, LAS unsigned char* vl, LAS unsigned char* kl, int lane) {
    const int qg = item & 127, h = (item >> 7) & 7, b = item >> 10;
    const int r32 = lane & 31, hi = lane >> 5, t0 = qg * 32;
    const size_t tokq = (size_t)b * SEQ + t0 + r32;
    bf16x8 qf[4];
#pragma unroll
    for (int d0 = 0; d0 < 4; ++d0) qf[d0] = *(const bf16x8*)(Q + tokq * 512 + h * 64 + d0 * 16 + 8 * hi);
    f32x16 o0, o1;
#pragma unroll
    for (int r = 0; r < 16; ++r) { o0[r] = 0.f; o1[r] = 0.f; }
    float P = 1.f;
    const int i16 = lane & 15, G4 = lane >> 4;
    const int vb = (4 * (G4 >> 1) + (i16 >> 2)) * VROW + (16 * (G4 & 1) + 4 * (i16 & 3)) * 2;
#define ATT_LOAD(KF, VR, S0) do { const size_t tk_ = (size_t)b * SEQ + ((S0) > 0 ? (S0) : 0); \
        _Pragma("unroll") for (int p = 0; p < 4; ++p) { const int idx = p * 64 + lane; KF[p] = *(const u32x4*)(K + (tk_ + (idx >> 3)) * 512 + h * 64 + (idx & 7) * 8); \
                                                         VR[p] = *(const u32x4*)(V + (tk_ + (idx >> 3)) * 512 + h * 64 + (idx & 7) * 8); } } while (0)
    u32x4 kf[4], kn[4]; u32x4 vr[4], vn[4];
    ATT_LOAD(kf, vr, t0); ATT_LOAD(kn, vn, t0 - 32);
    u32x2 sgv[8];
#pragma unroll
    for (int i = 0; i < 8; ++i) sgv[i] = *(const u32x2*)(SG + tokq * 1536 + h * 64 + (i >> 2) * 32 + 8 * (i & 3) + 4 * hi);
    for (int s0 = t0; s0 >= 0; s0 -= 32) {
#pragma unroll
        for (int p = 0; p < 4; ++p) { const int idx = p * 64 + lane, key = idx >> 3, ch = idx & 7; *(LAS u32x4*)(vl + key * VROW + ch * 16) = vr[p]; *(LAS u32x4*)(kl + key * VROW + ch * 16) = kf[p]; }
        f32x16 s;
#pragma unroll
        for (int r = 0; r < 16; ++r) s[r] = 0.f;
#pragma unroll
        for (int d0 = 0; d0 < 4; ++d0) s = __builtin_amdgcn_mfma_f32_32x32x16_bf16(*(const LAS bf16x8*)(kl + r32 * VROW + d0 * 32 + hi * 16), qf[d0], s, 0, 0, 0);
        const bool diag = (s0 == t0);
        float kp[16];
#pragma unroll
        for (int r = 0; r < 16; ++r) { const float e = __builtin_amdgcn_exp2f(s[r] * (0.125f * 1.4426950408889634f)); float k = __builtin_amdgcn_rcpf(1.f + e);
            if (diag && crow(r, hi) >= r32) k = 1.f; kp[r] = k; }
        float Gm[4], Go[4], T[4], R[4], C[4];
#pragma unroll
        for (int g = 0; g < 4; ++g) { Gm[g] = (kp[4 * g] * kp[4 * g + 1]) * (kp[4 * g + 2] * kp[4 * g + 3]); Go[g] = __shfl_xor(Gm[g], 32); T[g] = Gm[g] * Go[g]; }
        R[3] = P; R[2] = R[3] * T[3]; R[1] = R[2] * T[2]; R[0] = R[1] * T[1]; const float Cout = R[0] * T[0];
#pragma unroll
        for (int g = 0; g < 4; ++g) C[g] = hi ? R[g] : R[g] * Go[g];
        float w[16];
#pragma unroll
        for (int g = 0; g < 4; ++g) { const float p3 = C[g], p2 = p3 * kp[4 * g + 3], p1 = p2 * kp[4 * g + 2], p0 = p1 * kp[4 * g + 1], pe = p0 * kp[4 * g];
            w[4 * g + 3] = p3 - p2; w[4 * g + 2] = p2 - p1; w[4 * g + 1] = p1 - p0; w[4 * g] = p0 - pe; }
        bf16x8 wf[2];
#pragma unroll
        for (int st = 0; st < 2; ++st) { u32x4 t; t.x = pg8::cvt_pk_bf16(w[8 * st], w[8 * st + 1]); t.y = pg8::cvt_pk_bf16(w[8 * st + 2], w[8 * st + 3]); t.z = pg8::cvt_pk_bf16(w[8 * st + 4], w[8 * st + 5]); t.w = pg8::cvt_pk_bf16(w[8 * st + 6], w[8 * st + 7]); wf[st] = __builtin_bit_cast(bf16x8, t); }
#pragma unroll
        for (int dt = 0; dt < 2; ++dt)
#pragma unroll
            for (int st = 0; st < 2; ++st) {
                const s16x4 lo = __builtin_amdgcn_ds_read_tr16_b64_v4i16((LAS s16x4*)(vl + vb + (16 * st) * VROW + dt * 64));
                const s16x4 hh = __builtin_amdgcn_ds_read_tr16_b64_v4i16((LAS s16x4*)(vl + vb + (16 * st + 8) * VROW + dt * 64));
                const bf16x8 vf = (bf16x8){lo[0], lo[1], lo[2], lo[3], hh[0], hh[1], hh[2], hh[3]};
                if (dt == 0) o0 = __builtin_amdgcn_mfma_f32_32x32x16_bf16(vf, wf[st], o0, 0, 0, 0); else o1 = __builtin_amdgcn_mfma_f32_32x32x16_bf16(vf, wf[st], o1, 0, 0, 0); }
        P = Cout;
        if (__all(P < 1.17549435e-38f)) break;
#pragma unroll
        for (int i = 0; i < 4; ++i) { kf[i] = kn[i]; vr[i] = vn[i]; }
        ATT_LOAD(kn, vn, s0 - 64);
    }
#undef ATT_LOAD
#pragma unroll
    for (int dt = 0; dt < 2; ++dt)
#pragma unroll
        for (int g = 0; g < 4; ++g) { const size_t po = tokq * 1536 + h * 64 + dt * 32 + 8 * g + 4 * hi; const u32x2 sg = sgv[dt * 4 + g];
            const f32x16& o = dt ? o1 : o0; u32x2 y;
            y.x = pg8::cvt_pk_bf16(o[4 * g] * bflo(sg.x), o[4 * g + 1] * bfhi(sg.x)); y.y = pg8::cvt_pk_bf16(o[4 * g + 2] * bflo(sg.y), o[4 * g + 3] * bfhi(sg.y));
            *(u32x2*)(YO + po) = y; }
}
constexpr int PROW = 272;
__device__ __forceinline__ void pool_item(int pi, const bf16_t* PV, const bf16_t* SG, bf16_t* YO, const bf16_t* PT, const float* scale, LAS unsigned char* sl, int lane) {
    const int tile = pi >> 2, g = ((pi & 3) + ((pi >> 2) & 1)) & 3, win = 2 << g;
    const int r32 = lane & 31, hi = lane >> 5, tok0 = tile * 32, t0 = tok0 & (SEQ - 1), tok = tok0 + r32;
    u32x4 sv[12];
#pragma unroll
    for (int p = 0; p < 12; ++p) { const int idx = p * 64 + lane, row = idx >> 4, ch = idx & 15; const bool ok = (t0 + row - 16) >= 0;
        sv[p] = *(const u32x4*)(PV + (size_t)(ok ? tok0 + row - 16 : tok0) * 512 + g * 128 + ch * 8); if (!ok) sv[p] = (u32x4){0u, 0u, 0u, 0u}; }
#pragma unroll
    for (int p = 0; p < 12; ++p) { const int idx = p * 64 + lane, row = idx >> 4, ch = idx & 15; *(LAS u32x4*)(sl + row * PROW + ch * 16) = sv[p]; }
    const int t = t0 + r32, cnt = (t + 1) < win ? (t + 1) : win;
    bf16x8 bfr[3];
#pragma unroll
    for (int ks = 0; ks < 3; ++ks) { float wv[8];
#pragma unroll
        for (int j = 0; j < 8; ++j) { const int rel = (16 + r32) - (16 * ks + 8 * hi + j); wv[j] = (rel == 0) ? (float)(1 - cnt) : ((rel > 0 && rel < cnt) ? 1.f : 0.f); }
        u32x4 tt; tt.x = pg8::cvt_pk_bf16(wv[0], wv[1]); tt.y = pg8::cvt_pk_bf16(wv[2], wv[3]); tt.z = pg8::cvt_pk_bf16(wv[4], wv[5]); tt.w = pg8::cvt_pk_bf16(wv[6], wv[7]); bfr[ks] = __builtin_bit_cast(bf16x8, tt); }
    u32x2 sgv[16];
#pragma unroll
    for (int i = 0; i < 16; ++i) { const int dd = g * 128 + (i >> 2) * 32 + 8 * (i & 3) + 4 * hi; sgv[i] = *(const u32x2*)(SG + (size_t)tok * 1536 + dd); }
    bf16x8 ptf[4][8];
#pragma unroll
    for (int nt = 0; nt < 4; ++nt)
#pragma unroll
        for (int ks = 0; ks < 8; ++ks) ptf[nt][ks] = *(const bf16x8*)(PT + (size_t)(g * 128 + nt * 32 + r32) * 128 + 16 * ks + 8 * hi);
    const int i16 = lane & 15, G4 = lane >> 4;
    const int vb = (8 * (G4 >> 1) + (i16 >> 2)) * PROW + (16 * (G4 & 1) + 4 * (i16 & 3)) * 2;
    const float inv = __builtin_amdgcn_rcpf((float)cnt);
    bf16x8 pf[8];
#pragma unroll
    for (int ct = 0; ct < 4; ++ct) {
        f32x16 acc;
#pragma unroll
        for (int r = 0; r < 16; ++r) acc[r] = 0.f;
#pragma unroll
        for (int ks = 0; ks < 3; ++ks) {
            const s16x4 lo = __builtin_amdgcn_ds_read_tr16_b64_v4i16((LAS s16x4*)(sl + vb + (16 * ks) * PROW + ct * 64));
            const s16x4 hh = __builtin_amdgcn_ds_read_tr16_b64_v4i16((LAS s16x4*)(sl + vb + (16 * ks + 4) * PROW + ct * 64));
            const bf16x8 a = (bf16x8){lo[0], lo[1], lo[2], lo[3], hh[0], hh[1], hh[2], hh[3]};
            acc = __builtin_amdgcn_mfma_f32_32x32x16_bf16(a, bfr[ks], acc, 0, 0, 0); }
#pragma unroll
        for (int s = 0; s < 2; ++s) { u32x4 tt; tt.x = pg8::cvt_pk_bf16(acc[8 * s] * inv, acc[8 * s + 1] * inv); tt.y = pg8::cvt_pk_bf16(acc[8 * s + 2] * inv, acc[8 * s + 3] * inv);
            tt.z = pg8::cvt_pk_bf16(acc[8 * s + 4] * inv, acc[8 * s + 5] * inv); tt.w = pg8::cvt_pk_bf16(acc[8 * s + 6] * inv, acc[8 * s + 7] * inv); pf[2 * ct + s] = __builtin_bit_cast(bf16x8, tt); }
    }
#pragma unroll
    for (int nt = 0; nt < 4; ++nt) {
        f32x16 acc;
#pragma unroll
        for (int r = 0; r < 16; ++r) acc[r] = 0.f;
#pragma unroll
        for (int ks = 0; ks < 8; ++ks) acc = __builtin_amdgcn_mfma_f32_32x32x16_bf16(ptf[nt][ks], pf[ks], acc, 0, 0, 0);
#pragma unroll
        for (int q = 0; q < 4; ++q) { const int dd = g * 128 + nt * 32 + 8 * q + 4 * hi;
            const size_t po = (size_t)tok * 1536 + dd; const u32x2 sg = sgv[nt * 4 + q]; u32x2 y;
            y.x = pg8::cvt_pk_bf16(acc[4 * q] * bflo(sg.x), acc[4 * q + 1] * bfhi(sg.x)); y.y = pg8::cvt_pk_bf16(acc[4 * q + 2] * bflo(sg.y), acc[4 * q + 3] * bfhi(sg.y));
            *(u32x2*)(YO + po) = y; }
    }
}
__device__ __forceinline__ void conv_item(int ci, const bf16_t* Z, const bf16_t* Wy, bf16_t* YO, const float* cw, const float* cb, int lane) {
    const int tok0 = ci * 8, t0 = tok0 & (SEQ - 1), ch = lane * 8;
    float w0[8], w1[8], w2[8], bs[8], zm2[8], zm1[8];
#pragma unroll
    for (int hf = 0; hf < 2; ++hf) { const f32x4 a = *(const f32x4*)(cw + ch + 4 * hf), b = *(const f32x4*)(cw + 512 + ch + 4 * hf), c = *(const f32x4*)(cw + 1024 + ch + 4 * hf), d = *(const f32x4*)(cb + ch + 4 * hf);
#pragma unroll
        for (int i = 0; i < 4; ++i) { w0[4 * hf + i] = a[i]; w1[4 * hf + i] = b[i]; w2[4 * hf + i] = c[i]; bs[4 * hf + i] = d[i]; } }
#pragma unroll
    for (int i = 0; i < 8; ++i) { zm2[i] = 0.f; zm1[i] = 0.f; }
    if (t0 != 0) { const u32x4 a = *(const u32x4*)(Z + (size_t)(tok0 - 2) * 512 + ch), b = *(const u32x4*)(Z + (size_t)(tok0 - 1) * 512 + ch);
        zm2[0] = bflo(a.x); zm2[1] = bfhi(a.x); zm2[2] = bflo(a.y); zm2[3] = bfhi(a.y); zm2[4] = bflo(a.z); zm2[5] = bfhi(a.z); zm2[6] = bflo(a.w); zm2[7] = bfhi(a.w);
        zm1[0] = bflo(b.x); zm1[1] = bfhi(b.x); zm1[2] = bflo(b.y); zm1[3] = bfhi(b.y); zm1[4] = bflo(b.z); zm1[5] = bfhi(b.z); zm1[6] = bflo(b.w); zm1[7] = bfhi(b.w); }
    u32x4 zr[8], wr_[8];
#pragma unroll
    for (int r = 0; r < 8; ++r) { zr[r] = *(const u32x4*)(Z + (size_t)(tok0 + r) * 512 + ch); wr_[r] = *(const u32x4*)(Wy + (size_t)(tok0 + r) * 1536 + ch); }
#pragma unroll
    for (int r = 0; r < 8; ++r) {
        float zc[8], wv[8], y[8];
        zc[0] = bflo(zr[r].x); zc[1] = bfhi(zr[r].x); zc[2] = bflo(zr[r].y); zc[3] = bfhi(zr[r].y); zc[4] = bflo(zr[r].z); zc[5] = bfhi(zr[r].z); zc[6] = bflo(zr[r].w); zc[7] = bfhi(zr[r].w);
        wv[0] = bflo(wr_[r].x); wv[1] = bfhi(wr_[r].x); wv[2] = bflo(wr_[r].y); wv[3] = bfhi(wr_[r].y); wv[4] = bflo(wr_[r].z); wv[5] = bfhi(wr_[r].z); wv[6] = bflo(wr_[r].w); wv[7] = bfhi(wr_[r].w);
#pragma unroll
        for (int i = 0; i < 8; ++i) { y[i] = wv[i] * (w0[i] * zm2[i] + w1[i] * zm1[i] + w2[i] * zc[i] + bs[i]); zm2[i] = zm1[i]; zm1[i] = zc[i]; }
        u32x4 o; o.x = pg8::cvt_pk_bf16(y[0], y[1]); o.y = pg8::cvt_pk_bf16(y[2], y[3]); o.z = pg8::cvt_pk_bf16(y[4], y[5]); o.w = pg8::cvt_pk_bf16(y[6], y[7]);
        *(u32x4*)(YO + (size_t)(tok0 + r) * 1536 + ch) = o; }
}
template <int R> __device__ __forceinline__ void norm_rows(const float* F32T, const float* RS, const float* xin, const float* gpost, float* xout, const float* gnext, bf16_t* H, int m0, int mstride, int lane) {
    f32x4 o[R][4], xi[R][4]; float ss[R];
#pragma unroll
    for (int r = 0; r < R; ++r) { const size_t row = (size_t)(m0 + r * mstride); ss[r] = (lane < 16) ? RS[row * 16 + lane] : 0.f;
#pragma unroll
        for (int j = 0; j < 4; ++j) { o[r][j] = ((const f32x4*)(F32T + row * DM))[64 * j + lane]; xi[r][j] = ((const f32x4*)(xin + row * DM))[64 * j + lane]; } }
    f32x4 gp[4];
#pragma unroll
    for (int j = 0; j < 4; ++j) gp[j] = ((const f32x4*)gpost)[64 * j + lane];
#pragma unroll
    for (int r = 0; r < R; ++r) { const size_t row = (size_t)(m0 + r * mstride);
        const float rstd = 1.f / sqrtf(wave_sum(ss[r]) * (1.f / DM) + RMS_EPS); float s2 = 0.f;
#pragma unroll
        for (int j = 0; j < 4; ++j) { const f32x4 v = xi[r][j] + o[r][j] * rstd * gp[j]; xi[r][j] = v; ((f32x4*)(xout + row * DM))[64 * j + lane] = v; s2 += (v[0] * v[0] + v[1] * v[1]) + (v[2] * v[2] + v[3] * v[3]); }
        if (gnext) { const float r2 = 1.f / sqrtf(wave_sum(s2) * (1.f / DM) + RMS_EPS);
#pragma unroll
            for (int j = 0; j < 4; ++j) { const f32x4 gg = ((const f32x4*)gnext)[64 * j + lane]; const f32x4 v = xi[r][j]; u32x2 w; w.x = pg8::cvt_pk_bf16(v[0] * r2 * gg[0], v[1] * r2 * gg[1]); w.y = pg8::cvt_pk_bf16(v[2] * r2 * gg[2], v[3] * r2 * gg[3]); ((u32x2*)(H + row * DM))[64 * j + lane] = w; } } }
}

struct Args { const float* in[10]; float* out; unsigned char* ws; int ph_lo, ph_hi; };
template <class T> __device__ __forceinline__ T* as_global(T* p) { return p; }
#if TP_A >= 0
#define TSTAMP(k) do { if (blockIdx.x == TP_BLK && threadIdx.x == 0) ((volatile LAS unsigned long long*)(lds + 147264))[(k)] = __builtin_amdgcn_s_memrealtime(); } while (0)
#else
#define TSTAMP(k) do { } while (0)
#endif
template <int ph> __device__ __forceinline__ void run_phase(const Args& a_, LAS unsigned char* lds) {
        const Args* A = &a_;
        const int tid = threadIdx.x, lane = tid & 63, wave = __builtin_amdgcn_readfirstlane(tid >> 6);
        const int G = gridDim.x, bx = blockIdx.x;
        const int vcu = (G % 8 == 0) ? (bx % 8) * (G / 8) + bx / 8 : bx;
        const int gw = vcu * 8 + wave, NGW = G * 8;
        unsigned char* ws = as_global(A->ws);
        bf16_t* H = (bf16_t*)(ws + WS_H); bf16_t* U = (bf16_t*)(ws + WS_U);
        if constexpr (ph == 0) {
            const float* x = as_global(A->in[0]); const float* pre_g = as_global(A->in[1]); const float* w_in = as_global(A->in[2]); const float* pool_w = as_global(A->in[3]); const float* pool_scale = as_global(A->in[4]); const float* w_branch = as_global(A->in[7]); const float* w_out = as_global(A->in[8]);
            bf16_t* W1 = (bf16_t*)(ws + WS_W1); bf16_t* W2 = (bf16_t*)(ws + WS_W2); bf16_t* W3 = (bf16_t*)(ws + WS_W3); bf16_t* PW = (bf16_t*)(ws + WS_PW);
            LAS float* scr = (LAS float*)(lds + wave * 17408);
            constexpr int I1 = (DM / 64) * (NIN / 64), I2 = (BWID / 64) * (DM / 64), I3 = (DM / 64) * (DM / 64), I4 = 2 * 2, PER = I1 + 3 * I2 + I3 + 4 * I4;
            for (int it = gw; it < NLAYER * PER; it += NGW) {
                const int l = it / PER; int r = it % PER;
                if (r < I1) { transpose_item(w_in + (size_t)l * DM * NIN, NIN, W1 + (size_t)l * NIN * DM, DM, 0, 0, true, scr, r, lane); continue; } r -= I1;
                if (r < 3 * I2) { const int n = r / I2; transpose_item(w_branch + ((size_t)l * 3 + n) * BWID * DM, DM, W2 + (size_t)l * 3 * DM * BWID, 3 * BWID, n * BWID, 0, false, scr, r % I2, lane); continue; } r -= 3 * I2;
                if (r < I3) { transpose_item(w_out + (size_t)l * DM * DM, DM, W3 + (size_t)l * DM * DM, DM, 0, 0, false, scr, r, lane); continue; } r -= I3;
                { const int g = r / I4; transpose_item(pool_w + ((size_t)l * 4 + g) * 128 * 128, 128, PW + ((size_t)l * 4 + g) * 128 * 128, 128, 0, 0, false, scr, r % I4, lane, pool_scale + l * BWID + g * 128); }
            }
            for (int m = gw; m < MTOK; m += 2 * NGW) rms_rows_to_bf16<2>(x, pre_g, H, m, NGW, lane);
        } else {
            constexpr int l = (ph - 1) / 5, k = (ph - 1) % 5;
            if constexpr (k == 0) {
                pg8::Gemm g{H, (bf16_t*)(ws + WS_W1) + (size_t)l * NIN * DM, MTOK, NIN, DM, 0}; pg8::StaticOrder S; S.init(MTOK, NIN, G, bx);
                EpiU E{ws};
                pg8::gemm_phase<EpiU, pg8::StaticOrder, true, true>(lds, g, S, E);
            } else if constexpr (k == 1) {
                const float* pool_scale = as_global(A->in[4]); const float* conv_w = as_global(A->in[5]); const float* conv_b = as_global(A->in[6]);
                const bf16_t* PW = (const bf16_t*)(ws + WS_PW);
                const bf16_t* Q = U + 2 * (ARRB / 2); const bf16_t* Kk = U + 3 * (ARRB / 2); const bf16_t* V = U + 4 * (ARRB / 2);
                LAS unsigned char* vl = lds + wave * (32 * VROW);
                bf16_t* G3 = U + 5 * (ARRB / 2);
                bf16_t* YO = G3;
#if MIX_PROBE
                if (l == 0 && A->ph_hi < 0) YO = (bf16_t*)as_global(A->out);
#endif
                int pm_ = 7;
#if MIX_PROBE
                if (l == 0 && A->ph_hi < 0) pm_ = MIX_PROBE;
#endif
                if (l == 0) TSTAMP(12);
                volatile LAS unsigned* wq = (volatile LAS unsigned*)(lds + 147216);
                if (tid < 3) wq[tid] = 0u;
                __syncthreads();
#define WQ_GRAB(Q_) ({ unsigned v_ = 0u; if (lane == 0) v_ = __hip_atomic_fetch_add((LAS unsigned*)(Q_), 1u, __ATOMIC_RELAXED, __HIP_MEMORY_SCOPE_WORKGROUP); (unsigned)__builtin_amdgcn_readfirstlane((int)v_); })
#define WQ_ITEM(J_) ((int)(vcu * 8 + ((J_) & 7u) + ((J_) >> 3) * (unsigned)NGW))
                for (;;) { const unsigned j = WQ_GRAB(wq); const int it = WQ_ITEM(j); if (it >= NB * 8 * 128) break; attn_item(it, Q, Kk, V, G3 + 1024, YO + 1024, vl, lds + 36864 + wave * (48 * PROW), lane); }
                if (l == 0) TSTAMP(13);
                for (;;) { const unsigned j = WQ_GRAB(wq + 1); const int it = WQ_ITEM(j); if (it >= (MTOK / 32) * 4) break; pool_item(it, U, G3, YO, PW + (size_t)l * 4 * 128 * 128, pool_scale + l * BWID, lds + 36864 + wave * (48 * PROW), lane); }
                if (l == 0) TSTAMP(14);
                for (;;) { const unsigned j = WQ_GRAB(wq + 2); const int it = WQ_ITEM(j); if (it >= MTOK / 8) break; conv_item(it, U + 1 * (ARRB / 2), G3 + 512, YO + 512, conv_w + l * 3 * BWID, conv_b + l * BWID, lane); }
#undef WQ_GRAB
#undef WQ_ITEM
                if (l == 0) TSTAMP(15);
#if TP_A >= 0
                if (l == 0) { __syncthreads(); TSTAMP(5); }
#endif
            } else if constexpr (k == 2) {
                pg8::Gemm g{U + 5 * (ARRB / 2), (bf16_t*)(ws + WS_W2) + (size_t)l * 3 * DM * BWID, MTOK, DM, 3 * BWID, 0}; pg8::StaticOrder S; S.init(MTOK, DM, G, bx);
                EpiBranch E{ws};
                pg8::gemm_phase<EpiBranch, pg8::StaticOrder, true, true>(lds, g, S, E);
            } else if constexpr (k == 3) {
                pg8::Gemm g{H, (bf16_t*)(ws + WS_W3) + (size_t)l * DM * DM, MTOK, DM, DM, 0}; pg8::StaticOrder S; S.init(MTOK, DM, G, bx);
                if (G == 256) {
                    const float* x = as_global(A->in[0]); const float* pre_g = as_global(A->in[1]); const float* post_g = as_global(A->in[9]); float* out = as_global(A->out);
                    float* xb = (float*)(ws + WS_RS); unsigned* cn = (unsigned*)(ws + WS_CTL + CTL_CNT);
                    if constexpr (l + 1 < NLAYER) {
                        EpiNorm2 E{x, out, H, post_g + l * DM, pre_g + (l + 1) * DM, RmsPanel{xb, cn}, RmsPanel{xb + (size_t)MTOK * 4, cn + 64 * 64}};
                        pg8::gemm_phase<EpiNorm2, pg8::StaticOrder, false, true>(lds, g, S, E);
                    } else {
                        EpiNorm1 E{out, post_g + l * DM, RmsPanel{xb + (size_t)2 * MTOK * 4, cn + 2 * 64 * 64}};
                        pg8::gemm_phase<EpiNorm1, pg8::StaticOrder, false, true>(lds, g, S, E);
                    }
                } else {
                    EpiOut E{ws};
                    pg8::gemm_phase<EpiOut, pg8::StaticOrder, true, true>(lds, g, S, E);
                }
            } else {
                const float* x = as_global(A->in[0]); const float* pre_g = as_global(A->in[1]); const float* post_g = as_global(A->in[9]); float* out = as_global(A->out);
                const float* F32T = (const float*)(ws + WS_U); const float* RS = (const float*)(ws + WS_RS);
                const float* xin = (l == 0) ? x : out; const float* gnext = (l + 1 < NLAYER) ? pre_g + (l + 1) * DM : nullptr;
                if (G != 256) for (int m = gw; m < MTOK; m += 2 * NGW) norm_rows<2>(F32T, RS, xin, post_g + l * DM, out, gnext, H, m, NGW, lane);
            }
        }
}
__global__ void __launch_bounds__(512, 2) hybrid_fwd(Args a_) {
    extern __shared__ __attribute__((aligned(16))) unsigned char lds_raw[];
    LAS unsigned char* lds = (LAS unsigned char*)lds_raw;
    cg::grid_group grid = cg::this_grid();
    if (threadIdx.x < 64) ((LAS unsigned*)(lds + 147200))[threadIdx.x] = 0u;
    __syncthreads();
    (void)xcd_barrier_post((unsigned*)(a_.ws + WS_CTL), (volatile LAS unsigned*)(lds + 147200 + 32));
#define SEAM_BAR() do { XcdBarrier b_; b_.bar = (unsigned*)(a_.ws + WS_CTL); b_.x = xb_xcc_id(); b_.st = (volatile LAS unsigned*)(lds + 147200 + 32); xcd_barrier(b_); } while (0)
    const int lo = a_.ph_lo, hi = a_.ph_hi < 0 ? -a_.ph_hi : a_.ph_hi;
#define PHASE(k) if (lo <= (k) && (k) < hi && !(((k) == 5 || (k) == 10) && gridDim.x == 256)) { if ((k) > lo) { if ((k) == 1 && lo < 0) grid.sync(); else SEAM_BAR(); } TSTAMP(k); run_phase<(k)>(a_, lds); }
    PHASE(0) PHASE(1) PHASE(2) PHASE(3) PHASE(4) PHASE(5) PHASE(6) PHASE(7) PHASE(8) PHASE(9) PHASE(10)
#undef PHASE
#if TP_A >= 0
    SEAM_BAR(); TSTAMP(11);
    if (blockIdx.x == TP_BLK && threadIdx.x == 0) { volatile LAS unsigned long long* ts = (volatile LAS unsigned long long*)(lds + 147264); a_.out[0] += (float)(ts[TP_B] - ts[TP_A]) * (0.00005f * TP_SCALE); }
#endif
}

extern "C" void kernel_launch(void* const* d_in, const int* in_sizes, int n_in, void* d_out, int out_size, void* d_ws, size_t ws_size, hipStream_t stream) {
    static int grid = 0;
    if (grid == 0) {
        if (n_in != 10 || out_size != MTOK * DM || ws_size < WS_END) { fprintf(stderr, "kernel_launch: unexpected shapes / workspace (n_in %d out %d ws %zu)\n", n_in, out_size, ws_size); grid = -1; return; }
        int dev = 0, cus = 0, per_cu = 0;
        (void)hipGetDevice(&dev); (void)hipDeviceGetAttribute(&cus, hipDeviceAttributeMultiprocessorCount, dev);
        (void)hipFuncSetAttribute((const void*)hybrid_fwd, hipFuncAttributeMaxDynamicSharedMemorySize, LDS_BYTES);
        (void)hipOccupancyMaxActiveBlocksPerMultiprocessor(&per_cu, (const void*)hybrid_fwd, 512, LDS_BYTES);
        (void)hipGetLastError();
        if (per_cu < 1) { fprintf(stderr, "kernel_launch: occupancy query says %d blocks/CU\n", per_cu); per_cu = 1; }
        grid = cus;
    }
    if (grid < 0) return;
    if (hipMemsetAsync((char*)d_ws + WS_CTL, 0, CTL_BYTES, stream) != hipSuccess) { fprintf(stderr, "kernel_launch: memset of the barrier words failed\n"); return; }
    Args a{};
    for (int i = 0; i < 10; ++i) a.in[i] = (const float*)d_in[i];
    a.out = (float*)d_out; a.ws = (unsigned char*)d_ws;
#if ONE_LAUNCH
    a.ph_lo = 0; a.ph_hi = NPHASE;
    void* args[] = {&a};
    hipError_t e = hipLaunchCooperativeKernel((const void*)hybrid_fwd, dim3(grid), dim3(512), args, LDS_BYTES, stream);
    if (e != hipSuccess) fprintf(stderr, "cooperative launch failed: %s (grid %d)\n", hipGetErrorString(e), grid);
#else
    for (int ph = 0; ph < NPHASE; ++ph) { a.ph_lo = ph; a.ph_hi = ph + 1;
#if MIX_PROBE
        if (ph == 2) { a.ph_hi = -(ph + 1); hipLaunchKernelGGL(hybrid_fwd, dim3(grid), dim3(512), LDS_BYTES, stream, a); a.ph_hi = ph + 1; }
#endif
        for (int rep = 0; rep < 1 + ((DUP_MASK >> ph) & 1); ++rep) hipLaunchKernelGGL(hybrid_fwd, dim3(grid), dim3(512), LDS_BYTES, stream, a); }
#endif
}
```

```cpp
#include <hip/hip_runtime.h>
#include <hip/hip_cooperative_groups.h>
#include <cstdio>
#include <cstdint>
namespace cg = cooperative_groups;
#ifndef ONE_LAUNCH
#define ONE_LAUNCH 1
#endif
#ifndef DUP_MASK
#define DUP_MASK 0
#endif
#ifndef MIX_PROBE
#define MIX_PROBE 0
#endif
#ifndef TP_A
#define TP_A -1
#define TP_B -1
#endif
#ifndef TP_SCALE
#define TP_SCALE 1
#endif
#ifndef TP_BLK
#define TP_BLK 0
#endif
namespace pg8 {
#define PG8_LAS __attribute__((address_space(3)))
typedef unsigned short bf16_t;
typedef short bf16x8 __attribute__((ext_vector_type(8)));
typedef float f32x4 __attribute__((ext_vector_type(4)));
typedef unsigned u32x4 __attribute__((ext_vector_type(4)));
constexpr int BM = 256, BK = 64, HALF = 128, HTB = HALF * BK * 2  , STAGE_BYTES = 8 * HTB, NXCD = 8, WGM = 8;

__host__ __device__ __forceinline__ int lds_byte(int r, int c) { const int st = (r >> 4) * 2 + (c >> 5), rr = r & 15, cc = c & 31, ob = rr * 64 + cc * 2; return st * 1024 + (ob ^ (((ob >> 9) & 1) << 5)); }
__host__ __device__ __forceinline__ void stage_rc(int b, int& R, int& C) { const int st = b / 1024, sb = b % 1024, swz = sb ^ (((sb >> 9) & 1) << 5); R = (st >> 1) * 16 + swz / 64; C = (st & 1) * 32 + (swz % 64) / 2; }
__host__ __device__ __forceinline__ int perm32(int rho) { const int n = rho >> 4, i = rho & 15; return 8 * (i >> 2) + 4 * n + (i & 3); }

struct Unit { int pm, pn, az; };
struct Gemm { const bf16_t* A; const bf16_t* Bt; int M, N, K; size_t azs; };

struct StaticOrder {
    int nM, nN, nwg, G, c;
    __host__ __device__ void init(int M, int N, int G_, int c_) { nM = M / BM; nN = N / BM; nwg = nM * nN; G = G_; c = c_; }
    __host__ __device__ bool next(int i, Unit& u) const {
        const long L = (long)i * G + c; if (L >= nwg) return false;
        int wgid = (int)L; { const int q = nwg / NXCD, r = nwg % NXCD, xcd = wgid % NXCD, off = wgid / NXCD; wgid = (xcd < r ? xcd * (q + 1) : r * (q + 1) + (xcd - r) * q) + off; }
        const int nig = WGM * nN, gid = wgid / nig, fm = gid * WGM, gsz = (nM - fm) < WGM ? (nM - fm) : WGM;
        u.pm = fm + ((wgid % nig) % gsz); u.pn = (wgid % nig) / gsz; u.az = 0; return true;
    }
    __device__ __forceinline__ void a_ready(const Unit&) const {}
    __device__ __forceinline__ void done(const Unit&) const {}
};

__device__ __forceinline__ unsigned cvt_pk_bf16(float lo, float hi) { unsigned r; asm volatile("v_cvt_pk_bf16_f32 %0, %1, %2" : "=v"(r) : "v"(lo), "v"(hi)); return r; }
template <class Epi, class Sched, bool ALIGN_EPI = false, bool SP2 = false>
__device__ __forceinline__ void gemm_phase(PG8_LAS unsigned char* lds, const Gemm g, const Sched& S, const Epi& E) {
    const int tid = threadIdx.x, wid = __builtin_amdgcn_readfirstlane(tid >> 6), lane = tid & 63, wr = wid >> 2, wc = wid & 3, fr = lane & 15, fq = lane >> 4;
    const int K = g.K, nt = K / BK;
    unsigned voffA[2], voffB[2];
#pragma unroll
    for (int i = 0; i < 2; ++i) { int R, C; stage_rc(tid * 16 + i * 8192, R, C); const int Rb = Epi::PERM ? ((R & ~31) + perm32(R & 31)) : R;
        voffA[i] = (unsigned)(R * K + C) * 2u; voffB[i] = (unsigned)(Rb * K + C) * 2u; }
    const size_t kstep = (size_t)(BK * 2);
    const size_t hstep = (size_t)HALF * K * 2;
    const size_t tstep = 2 * hstep;
    const unsigned ldsw = (unsigned)wid * 1024u;
    const int aoff = lds_byte(wr * 64 + fr, fq * 8), boff = lds_byte(wc * 32 + fr, fq * 8);
#define PG8_SA(b, h) (((b) * 2 + (h)) * HTB)
#define PG8_SB(b, h) ((4 + (b) * 2 + (h)) * HTB)
#define PG8_STAGE(bufoff, gbase, voff) do { _Pragma("unroll") for (int _i = 0; _i < 2; ++_i) \
        __builtin_amdgcn_global_load_lds((const unsigned*)((const char*)(gbase) + (voff)[_i]), (PG8_LAS unsigned*)(lds + (bufoff) + ldsw + _i * 8192), 16, 0, 0); } while (0)
#define PG8_LDA(dst, b, h) do { _Pragma("unroll") for (int m = 0; m < 4; ++m) _Pragma("unroll") for (int k = 0; k < 2; ++k) dst[m][k] = *(const PG8_LAS bf16x8*)(lds + PG8_SA(b, h) + aoff + m * 2048 + k * 1024); } while (0)
#define PG8_LDB(dst, b, h) do { _Pragma("unroll") for (int n = 0; n < 2; ++n) _Pragma("unroll") for (int k = 0; k < 2; ++k) dst[n][k] = *(const PG8_LAS bf16x8*)(lds + PG8_SB(b, h) + boff + n * 2048 + k * 1024); } while (0)
#define PG8_MMA(ai, bj, At, Bt) do { __builtin_amdgcn_s_setprio(1); _Pragma("unroll") for (int m = 0; m < 4; ++m) _Pragma("unroll") for (int n = 0; n < 2; ++n) _Pragma("unroll") for (int k = 0; k < 2; ++k) \
        acc[ai][bj][m][n] = __builtin_amdgcn_mfma_f32_16x16x32_bf16(Bt[n][k], At[m][k], acc[ai][bj][m][n], 0, 0, 0); __builtin_amdgcn_s_setprio(0); } while (0)
#define PG8_WAIT_V(n) asm volatile("s_waitcnt vmcnt(" #n ")" ::: "memory")
#define PG8_WAIT_L(n) asm volatile("s_waitcnt lgkmcnt(" #n ")" ::: "memory")
#define PG8_BAR __builtin_amdgcn_s_barrier()
#define PG8_SCHED __builtin_amdgcn_sched_barrier(0)
    Unit cur, nxt; int ui = 0;
    if (!S.next(0, cur)) return;
    f32x4 acc[2][2][4][2];
#pragma unroll
    for (int a = 0; a < 2; ++a)
#pragma unroll
        for (int b = 0; b < 2; ++b)
#pragma unroll
            for (int m = 0; m < 4; ++m)
#pragma unroll
                for (int n = 0; n < 2; ++n) acc[a][b][m][n] = (f32x4){0.f, 0.f, 0.f, 0.f};
    bf16x8 At[4][2], B0[2][2], B1[2][2];
    const char* cA = (const char*)g.A + (size_t)cur.pm * tstep + (size_t)cur.az * g.azs; const char* cB = (const char*)g.Bt + (size_t)cur.pn * tstep;
    S.a_ready(cur);
    if constexpr (SP2) {
        PG8_STAGE(PG8_SB(0, 0), cB, voffB); PG8_STAGE(PG8_SB(0, 1), cB + hstep, voffB); PG8_STAGE(PG8_SA(0, 0), cA, voffA); PG8_STAGE(PG8_SA(0, 1), cA + hstep, voffA);
        if (wr == 1) PG8_BAR;
        PG8_WAIT_V(2); PG8_BAR;
        PG8_STAGE(PG8_SB(1, 0), cB + kstep, voffB); PG8_STAGE(PG8_SA(1, 0), cA + kstep, voffA); PG8_STAGE(PG8_SB(1, 1), cB + hstep + kstep, voffB);
        PG8_WAIT_V(6); PG8_BAR;
    } else {
        PG8_STAGE(PG8_SB(0, 0), cB, voffB); PG8_STAGE(PG8_SA(0, 0), cA, voffA); PG8_STAGE(PG8_SB(0, 1), cB + hstep, voffB); PG8_STAGE(PG8_SA(0, 1), cA + hstep, voffA);
        if (wr == 1) PG8_BAR;
        PG8_WAIT_V(4); PG8_BAR;
        PG8_STAGE(PG8_SB(1, 0), cB + kstep, voffB); PG8_STAGE(PG8_SA(1, 0), cA + kstep, voffA); PG8_STAGE(PG8_SB(1, 1), cB + hstep + kstep, voffB);
        PG8_WAIT_V(6); PG8_BAR;
    }
    for (;;) {
        const bool has_next = S.next(ui + 1, nxt);
        const char* nA = has_next ? (const char*)g.A + (size_t)nxt.pm * tstep + (size_t)nxt.az * g.azs : cA; const char* nB = has_next ? (const char*)g.Bt + (size_t)nxt.pn * tstep : cB;
        for (int t = 0; t < nt; t += 2) {
            if constexpr (Epi::MIDK) { if (t == 8 || t == 16) E.mid(acc, cur, t >> 3, wr, wc, fr, fq); }
            const bool last = (t == nt - 2);
            const char* a1 = cA + (size_t)(t + 1) * kstep;
            const char* a2 = last ? nA : cA + (size_t)(t + 2) * kstep; const char* b2 = last ? nB : cB + (size_t)(t + 2) * kstep;
            const char* a3 = a2 + kstep; const char* b3 = b2 + kstep;
            if (last && has_next) S.a_ready(nxt);
            if constexpr (SP2) {
            PG8_LDB(B0, 0, 0); PG8_LDB(B1, 0, 1); PG8_SCHED; PG8_LDA(At, 0, 0); PG8_STAGE(PG8_SA(1, 1), a1 + hstep, voffA);
            PG8_WAIT_V(8); PG8_WAIT_L(0); PG8_BAR; PG8_MMA(0, 0, At, B0); PG8_MMA(0, 1, At, B1); PG8_BAR; PG8_SCHED;
            PG8_LDA(At, 0, 1); PG8_STAGE(PG8_SB(0, 0), b2, voffB); PG8_STAGE(PG8_SB(0, 1), b2 + hstep, voffB); PG8_STAGE(PG8_SA(0, 0), a2, voffA);
            PG8_WAIT_V(8); PG8_WAIT_L(0); PG8_BAR; PG8_MMA(1, 0, At, B0); PG8_MMA(1, 1, At, B1); PG8_BAR; PG8_SCHED;
            PG8_LDB(B0, 1, 0); PG8_LDB(B1, 1, 1); PG8_SCHED; PG8_LDA(At, 1, 0); PG8_STAGE(PG8_SA(0, 1), a2 + hstep, voffA);
            PG8_WAIT_V(8); PG8_WAIT_L(0); PG8_BAR; PG8_MMA(0, 0, At, B0); PG8_MMA(0, 1, At, B1); PG8_BAR; PG8_SCHED;
            PG8_LDA(At, 1, 1); PG8_STAGE(PG8_SB(1, 0), b3, voffB); PG8_STAGE(PG8_SB(1, 1), b3 + hstep, voffB); PG8_STAGE(PG8_SA(1, 0), a3, voffA);
            PG8_WAIT_V(8); PG8_WAIT_L(0); PG8_BAR; PG8_MMA(1, 0, At, B0); PG8_MMA(1, 1, At, B1); PG8_BAR; PG8_SCHED;
            } else {
            PG8_LDB(B0, 0, 0); PG8_SCHED; PG8_LDA(At, 0, 0); PG8_STAGE(PG8_SA(1, 1), a1 + hstep, voffA);
            PG8_WAIT_L(8); PG8_BAR; PG8_WAIT_L(0); PG8_MMA(0, 0, At, B0); PG8_BAR; PG8_SCHED;
            PG8_LDB(B1, 0, 1); PG8_STAGE(PG8_SB(0, 0), b2, voffB);
            PG8_BAR; PG8_WAIT_L(0); PG8_MMA(0, 1, At, B1); PG8_BAR;
            PG8_LDA(At, 0, 1); PG8_STAGE(PG8_SA(0, 0), a2, voffA);
            PG8_BAR; PG8_WAIT_L(0); PG8_MMA(1, 0, At, B0); PG8_BAR; PG8_SCHED;
            PG8_STAGE(PG8_SB(0, 1), b2 + hstep, voffB);
            PG8_WAIT_V(6); PG8_BAR; PG8_MMA(1, 1, At, B1); PG8_BAR;
            PG8_LDB(B0, 1, 0); PG8_SCHED; PG8_LDA(At, 1, 0); PG8_STAGE(PG8_SA(0, 1), a2 + hstep, voffA);
            PG8_WAIT_L(8); PG8_BAR; PG8_WAIT_L(0); PG8_MMA(0, 0, At, B0); PG8_BAR; PG8_SCHED;
            PG8_LDB(B1, 1, 1); PG8_STAGE(PG8_SB(1, 0), b3, voffB);
            PG8_BAR; PG8_WAIT_L(0); PG8_MMA(0, 1, At, B1); PG8_BAR;
            PG8_LDA(At, 1, 1); PG8_STAGE(PG8_SA(1, 0), a3, voffA);
            PG8_BAR; PG8_WAIT_L(0); PG8_MMA(1, 0, At, B0); PG8_BAR; PG8_SCHED;
            PG8_STAGE(PG8_SB(1, 1), b3 + hstep, voffB);
            PG8_WAIT_V(6); PG8_BAR; PG8_MMA(1, 1, At, B1); PG8_BAR;
            }
        }
        if constexpr (ALIGN_EPI) { if (wr == 0) PG8_BAR; }
        if constexpr (!Epi::AFTER_DRAIN) { E(acc, cur, wr, wc, fr, fq); S.done(cur); }
        if (!has_next) break;
#pragma unroll
        for (int a = 0; a < 2; ++a)
#pragma unroll
            for (int b = 0; b < 2; ++b)
#pragma unroll
                for (int m = 0; m < 4; ++m)
#pragma unroll
                    for (int n = 0; n < 2; ++n) acc[a][b][m][n] = (f32x4){0.f, 0.f, 0.f, 0.f};
        cur = nxt; cA = nA; cB = nB; ++ui;
        if constexpr (ALIGN_EPI) { if (wr == 1) PG8_BAR; }
    }
    PG8_WAIT_V(0);
    if constexpr (!ALIGN_EPI) { if (wr == 0) PG8_BAR; }
    PG8_BAR;
    if constexpr (Epi::AFTER_DRAIN) { E.fused(acc, cur, wr, wc, fr, fq, lds, wid, lane); S.done(cur); }
#undef PG8_SA
#undef PG8_SB
#undef PG8_STAGE
#undef PG8_LDA
#undef PG8_LDB
#undef PG8_MMA
#undef PG8_WAIT_V
#undef PG8_WAIT_L
#undef PG8_BAR
#undef PG8_SCHED
}
}

#define LAS __attribute__((address_space(3)))
typedef unsigned short bf16_t;
typedef short bf16x8 __attribute__((ext_vector_type(8)));
typedef short s16x4 __attribute__((ext_vector_type(4)));
typedef float f32x4 __attribute__((ext_vector_type(4)));
typedef float f32x16 __attribute__((ext_vector_type(16)));
typedef unsigned u32x4 __attribute__((ext_vector_type(4)));
typedef unsigned u32x2 __attribute__((ext_vector_type(2)));
constexpr int NB = 4, SEQ = 4096, DM = 1024, MTOK = NB * SEQ, NIN = 8192, BWID = 512, NLAYER = 2;
constexpr float RMS_EPS = 1e-6f;
constexpr size_t MiB = 1u << 20;
constexpr size_t WS_RS = 0;
constexpr size_t WS_W1 = 2 * MiB;
constexpr size_t WS_W2 = 34 * MiB;
constexpr size_t WS_W3 = 40 * MiB;
constexpr size_t WS_PW = 44 * MiB;
constexpr size_t WS_H = 45 * MiB;
constexpr size_t WS_U = 77 * MiB;
constexpr size_t ARRB = 16 * MiB;
constexpr size_t WS_MG = 205 * MiB;
constexpr size_t WS_END = 253 * MiB;
constexpr int LDS_BYTES = 147456;
constexpr int NPHASE = 1 + 5 * NLAYER;

__device__ __forceinline__ unsigned f2bf(float f) { unsigned u = __builtin_bit_cast(unsigned, f); return (u + 0x7fffu + ((u >> 16) & 1u)) >> 16; }
__device__ __forceinline__ unsigned pk2(float lo, float hi) { return f2bf(lo) | (f2bf(hi) << 16); }
__device__ __forceinline__ float bflo(unsigned u) { return __builtin_bit_cast(float, u << 16); }
__device__ __forceinline__ float bfhi(unsigned u) { return __builtin_bit_cast(float, u & 0xffff0000u); }
__device__ __forceinline__ float sigmoid_f(float x) { return __builtin_amdgcn_rcpf(1.f + __builtin_amdgcn_exp2f(-1.4426950408889634f * x)); }
__device__ __forceinline__ float silu_f(float x) { return x * sigmoid_f(x); }
__device__ __forceinline__ unsigned q8(float x) { const unsigned q = (unsigned)(sigmoid_f(x) * 255.f + 0.5f); return q < 1u ? 1u : q; }
__device__ __forceinline__ float wave_sum(float v) {
#pragma unroll
    for (int o = 1; o < 64; o <<= 1) v += __shfl_xor(v, o);
    return v;
}

constexpr size_t WS_CTL = 1 * MiB; constexpr size_t CTL_BYTES = 65536;
constexpr size_t CTL_CNT = 16384;
#define XB_TMO      128
#define XB_XCNT(j)  (256  + 64 * (j))
#define XB_XSUB(j)  (1280 + 64 * (j))
#define XB_XGEN(j)  (2304 + 64 * (j))
#define XB_TOP      3328
#define XB_TOPGEN   3392
#define XCD_BAR_WORDS 3456
#define XB_SPIN_CAP (1u << 18)

__device__ __forceinline__ unsigned xb_ld(unsigned* p)              { return __hip_atomic_load(p, __ATOMIC_RELAXED, __HIP_MEMORY_SCOPE_AGENT); }
__device__ __forceinline__ unsigned xb_add(unsigned* p, unsigned v) { return __hip_atomic_fetch_add(p, v, __ATOMIC_RELAXED, __HIP_MEMORY_SCOPE_AGENT); }
__device__ __forceinline__ unsigned xb_xcc_id() { return (unsigned)__builtin_amdgcn_s_getreg((3 << 11) | 20) & 0xFu; }
#define XB_SPIN(cond, bar) do { unsigned _sp = 0; while (cond) { __builtin_amdgcn_s_sleep(1); \
    if ((++_sp & 255u) == 0u) { if (xb_ld(&(bar)[XB_TMO])) break; if (_sp > XB_SPIN_CAP) { atomicAdd(&(bar)[XB_TMO], 1u); break; } } } } while (0)

struct XcdBarrier {
    unsigned* bar; unsigned x;
    volatile LAS unsigned* st;
};

__device__ __forceinline__ XcdBarrier xcd_barrier_post(unsigned* bar, volatile LAS unsigned* st) {
    XcdBarrier b; b.bar = bar; b.x = xb_xcc_id(); b.st = st;
    if (threadIdx.x == 0) (void)xb_add(&bar[XB_XCNT(b.x)], 1u);
    return b;
}
__device__ __forceinline__ void xcd_barrier_complete(unsigned* bar, unsigned x, unsigned& nloc, unsigned& nx) {
    const unsigned G = gridDim.x * gridDim.y * gridDim.z;
    unsigned sum, cnt, mine, sp = 0u;
    for (;;) {
        sum = 0u; cnt = 0u; mine = 0u;
#pragma unroll
        for (unsigned j = 0; j < 16; ++j) { const unsigned c = xb_ld(&bar[XB_XCNT(j)]); sum += c; cnt += (c > 0u) ? 1u : 0u; mine = (j == x) ? c : mine; }
        if (sum == G) break;
        __builtin_amdgcn_s_sleep(1);
        if ((++sp & 255u) == 0u) { if (xb_ld(&bar[XB_TMO])) break; if (sp > XB_SPIN_CAP) { atomicAdd(&bar[XB_TMO], 1u); break; } }
    }
    nloc = mine > 0u ? mine : 1u; nx = cnt > 0u ? cnt : 1u;
}

__device__ __forceinline__ void xcd_barrier(const XcdBarrier& b) {
    asm volatile("s_waitcnt vmcnt(0)" ::: "memory");
    __syncthreads();
    if (threadIdx.x == 0) {
        unsigned* bar = b.bar;
        __builtin_amdgcn_s_waitcnt(0);
        unsigned nloc = b.st[0], nx = b.st[1];
        if (nloc == 0u) { xcd_barrier_complete(bar, b.x, nloc, nx); b.st[0] = nloc; b.st[1] = nx; }
        const unsigned old = xb_add(&bar[XB_XSUB(b.x)], 1u);
        const unsigned gen = old / nloc;
        if (old + 1u == (gen + 1u) * nloc) {
            __builtin_amdgcn_fence(__ATOMIC_RELEASE, "agent");
            asm volatile("s_waitcnt vmcnt(0)" ::: "memory");
            const unsigned og = xb_add(&bar[XB_TOP], 1u);
            const unsigned tg = og / nx;
            if (og + 1u == (tg + 1u) * nx) xb_add(&bar[XB_TOPGEN], 1u);
            else XB_SPIN(xb_ld(&bar[XB_TOPGEN]) == tg, bar);
            __builtin_amdgcn_fence(__ATOMIC_ACQUIRE, "agent");
            xb_add(&bar[XB_XGEN(b.x)], 1u);
            asm volatile("s_waitcnt vmcnt(0)" ::: "memory");
        } else {
            XB_SPIN(xb_ld(&bar[XB_XGEN(b.x)]) == gen, bar);
            __builtin_amdgcn_fence(__ATOMIC_ACQUIRE, "agent");
            asm volatile("s_waitcnt vmcnt(0)" ::: "memory");
        }
    }
    __syncthreads();
}


using pg8::Unit;
struct EpiU {
    static constexpr bool PERM = true, AFTER_DRAIN = false, MIDK = false;
    unsigned char* ws;
    __device__ __forceinline__ void operator()(const f32x4 (&acc)[2][2][4][2], const Unit& u, int wr, int wc, int fr, int fq) const {
        bf16_t* U = (bf16_t*)(ws + WS_U); unsigned char* MG = ws + WS_MG;
        const int pn = u.pn; const int row0 = u.pm * 256 + wr * 64 + fr;
        if (pn >= 20) {
            const int mc0 = (pn - 20) * 256 + wc * 32 + 8 * fq;
#pragma unroll
            for (int ai = 0; ai < 2; ++ai)
#pragma unroll
                for (int m = 0; m < 4; ++m) { unsigned char* rp = MG + (size_t)(row0 + ai * 128 + m * 16) * 3072 + mc0;
#pragma unroll
                    for (int bj = 0; bj < 2; ++bj) { const f32x4 v0 = acc[ai][bj][m][0], v1 = acc[ai][bj][m][1]; u32x2 w;
                        w.x = q8(v0[0]) | (q8(v0[1]) << 8) | (q8(v0[2]) << 16) | (q8(v0[3]) << 24); w.y = q8(v1[0]) | (q8(v1[1]) << 8) | (q8(v1[2]) << 16) | (q8(v1[3]) << 24);
                        *(u32x2*)(rp + bj * 128) = w; } }
        } else if (pn >= 4 && pn < 12) {
            const int ch0 = (pn - 4) * 64 + (4 * wc + fq) * 4;
            bf16_t* Z = U + 1 * (ARRB / 2); bf16_t* W = U + 5 * (ARRB / 2) + 512;
#pragma unroll
            for (int ai = 0; ai < 2; ++ai)
#pragma unroll
                for (int m = 0; m < 4; ++m) { const size_t rr = (size_t)(row0 + ai * 128 + m * 16); const size_t ro = rr * 512 + ch0, rw = rr * 1536 + ch0;
                    const f32x4 z = acc[ai][0][m][0] * acc[ai][0][m][1]; const f32x4 gb = acc[ai][1][m][0], gg = acc[ai][1][m][1];
                    u32x2 zz, ww; zz.x = pg8::cvt_pk_bf16(z[0], z[1]); zz.y = pg8::cvt_pk_bf16(z[2], z[3]);
                    ww.x = pg8::cvt_pk_bf16(gb[0] * silu_f(gg[0]), gb[1] * silu_f(gg[1])); ww.y = pg8::cvt_pk_bf16(gb[2] * silu_f(gg[2]), gb[3] * silu_f(gg[3]));
                    *(u32x2*)(Z + ro) = zz; *(u32x2*)(W + rw) = ww; }
        } else {
            const int kind = pn >> 1; int arr = 0, pitch = 512, coff = 0; bool act = false;
            if (kind == 1) { arr = 5; act = true; pitch = 1536; } else if (kind == 6) arr = 2; else if (kind == 7) arr = 3; else if (kind == 8) arr = 4; else if (kind == 9) { arr = 5; act = true; pitch = 1536; coff = 1024; }
            bf16_t* O = U + (size_t)arr * (ARRB / 2) + coff; const int col0 = (pn & 1) * 256 + wc * 32 + 8 * fq;
#pragma unroll
            for (int ai = 0; ai < 2; ++ai)
#pragma unroll
                for (int m = 0; m < 4; ++m) { bf16_t* rp = O + (size_t)(row0 + ai * 128 + m * 16) * pitch + col0;
#pragma unroll
                    for (int bj = 0; bj < 2; ++bj) { f32x4 v0 = acc[ai][bj][m][0], v1 = acc[ai][bj][m][1];
                        if (act) {
#pragma unroll
                            for (int i = 0; i < 4; ++i) { v0[i] = silu_f(v0[i]); v1[i] = silu_f(v1[i]); } }
                        u32x4 w; w.x = pg8::cvt_pk_bf16(v0[0], v0[1]); w.y = pg8::cvt_pk_bf16(v0[2], v0[3]); w.z = pg8::cvt_pk_bf16(v1[0], v1[1]); w.w = pg8::cvt_pk_bf16(v1[2], v1[3]);
                        *(u32x4*)(rp + bj * 128) = w; } }
        }
    }
};
struct EpiBranch {
    static constexpr bool PERM = true, AFTER_DRAIN = false, MIDK = true;
    unsigned char* ws;
    __device__ __forceinline__ void mid(f32x4 (&acc)[2][2][4][2], const Unit& u, int seg, int wr, int wc, int fr, int fq) const {
        int tid_ = threadIdx.x; asm volatile("" : "+v"(tid_));
        const int wid_ = tid_ >> 6, wr_ = wid_ >> 2, wc_ = wid_ & 3, fr_ = tid_ & 15, fq_ = (tid_ & 63) >> 4;
        const unsigned char* MG = ws + WS_MG + (seg - 1) * 1024; const int row0 = u.pm * 256 + wr_ * 64 + fr_, col0 = u.pn * 256 + wc_ * 32 + 8 * fq_;
#pragma unroll
        for (int ai = 0; ai < 2; ++ai)
#pragma unroll
            for (int m = 0; m < 4; ++m) { const unsigned char* rp = MG + (size_t)(row0 + ai * 128 + m * 16) * 3072 + col0;
#pragma unroll
                for (int bj = 0; bj < 2; ++bj) { const u32x2 qa = *(const u32x2*)(rp + bj * 128), qb = *(const u32x2*)(rp + bj * 128 + 1024);
                    f32x4 r0, r1;
                    r0[0] = (float)(qa.x & 255u) * __builtin_amdgcn_rcpf((float)(qb.x & 255u)); r0[1] = (float)((qa.x >> 8) & 255u) * __builtin_amdgcn_rcpf((float)((qb.x >> 8) & 255u));
                    r0[2] = (float)((qa.x >> 16) & 255u) * __builtin_amdgcn_rcpf((float)((qb.x >> 16) & 255u)); r0[3] = (float)(qa.x >> 24) * __builtin_amdgcn_rcpf((float)(qb.x >> 24));
                    r1[0] = (float)(qa.y & 255u) * __builtin_amdgcn_rcpf((float)(qb.y & 255u)); r1[1] = (float)((qa.y >> 8) & 255u) * __builtin_amdgcn_rcpf((float)((qb.y >> 8) & 255u));
                    r1[2] = (float)((qa.y >> 16) & 255u) * __builtin_amdgcn_rcpf((float)((qb.y >> 16) & 255u)); r1[3] = (float)(qa.y >> 24) * __builtin_amdgcn_rcpf((float)(qb.y >> 24));
                    acc[ai][bj][m][0] *= r0; acc[ai][bj][m][1] *= r1; }
                if (m == 3) asm volatile("" ::: "memory"); }
    }
    __device__ __forceinline__ void operator()(const f32x4 (&acc)[2][2][4][2], const Unit& u, int wr, int wc, int fr, int fq) const {
        const unsigned char* MG = ws + WS_MG + 2 * 1024; bf16_t* merged = (bf16_t*)(ws + WS_H);
        const int row0 = u.pm * 256 + wr * 64 + fr, col0 = u.pn * 256 + wc * 32 + 8 * fq;
        u32x2 gq[2][4][2];
#pragma unroll
        for (int ai = 0; ai < 2; ++ai)
#pragma unroll
            for (int m = 0; m < 4; ++m)
#pragma unroll
                for (int bj = 0; bj < 2; ++bj) gq[ai][m][bj] = *(const u32x2*)(MG + (size_t)(row0 + ai * 128 + m * 16) * 3072 + col0 + bj * 128);
#pragma unroll
        for (int ai = 0; ai < 2; ++ai)
#pragma unroll
            for (int m = 0; m < 4; ++m) { const size_t row = (size_t)(row0 + ai * 128 + m * 16);
#pragma unroll
                for (int bj = 0; bj < 2; ++bj) { const int col = col0 + bj * 128; const u32x2 g = gq[ai][m][bj];
                    f32x4 g0, g1; const float k = 1.f / 255.f;
                    g0[0] = (float)(g.x & 255u) * k; g0[1] = (float)((g.x >> 8) & 255u) * k; g0[2] = (float)((g.x >> 16) & 255u) * k; g0[3] = (float)(g.x >> 24) * k;
                    g1[0] = (float)(g.y & 255u) * k; g1[1] = (float)((g.y >> 8) & 255u) * k; g1[2] = (float)((g.y >> 16) & 255u) * k; g1[3] = (float)(g.y >> 24) * k;
                    const f32x4 v0 = acc[ai][bj][m][0] * g0, v1 = acc[ai][bj][m][1] * g1;
                    u32x4 w; w.x = pg8::cvt_pk_bf16(v0[0], v0[1]); w.y = pg8::cvt_pk_bf16(v0[2], v0[3]); w.z = pg8::cvt_pk_bf16(v1[0], v1[1]); w.w = pg8::cvt_pk_bf16(v1[2], v1[3]);
                    *(u32x4*)(merged + row * 1024 + col) = w; } }
    }
};
struct EpiOut {
    static constexpr bool PERM = false, AFTER_DRAIN = false, MIDK = false;
    unsigned char* ws;
    __device__ __forceinline__ void operator()(const f32x4 (&acc)[2][2][4][2], const Unit& u, int wr, int wc, int fr, int fq) const {
        float* out = (float*)(ws + WS_U); float* rs = (float*)(ws + WS_RS);
        const int row0 = u.pm * 256 + wr * 64 + fr, col0 = u.pn * 256 + wc * 32 + 4 * fq;
#pragma unroll
        for (int ai = 0; ai < 2; ++ai)
#pragma unroll
            for (int m = 0; m < 4; ++m) { const size_t row = (size_t)(row0 + ai * 128 + m * 16); float ss = 0.f;
#pragma unroll
                for (int bj = 0; bj < 2; ++bj)
#pragma unroll
                    for (int n = 0; n < 2; ++n) { const f32x4 v = acc[ai][bj][m][n]; *(f32x4*)(out + row * 1024 + col0 + bj * 128 + n * 16) = v; ss += (v[0] * v[0] + v[1] * v[1]) + (v[2] * v[2] + v[3] * v[3]); }
                ss += __shfl_xor(ss, 16); ss += __shfl_xor(ss, 32);
                if (fq == 0) rs[row * 16 + u.pn * 4 + wc] = ss; }
    }
};

struct RmsPanel {
    float* xbuf;
    unsigned* cnt;
    __device__ __forceinline__ void run(const f32x4 (&v)[2][2][4][2], const Unit& u, int wr, int wc, int fr, int fq, LAS unsigned char* lds, int wid, int lane) const {
        LAS float* P = (LAS float*)lds; LAS float* S = (LAS float*)(lds + 8192);
#pragma unroll
        for (int ai = 0; ai < 2; ++ai)
#pragma unroll
            for (int m = 0; m < 4; ++m) { float s = 0.f;
#pragma unroll
                for (int bj = 0; bj < 2; ++bj)
#pragma unroll
                    for (int n = 0; n < 2; ++n) { const f32x4 x = v[ai][bj][m][n]; s += (x[0] * x[0] + x[1] * x[1]) + (x[2] * x[2] + x[3] * x[3]); }
                s += __shfl_xor(s, 16); s += __shfl_xor(s, 32);
                if (fq == 0) P[(ai * 128 + wr * 64 + m * 16 + fr) * 4 + wc] = s; }
        asm volatile("s_waitcnt lgkmcnt(0)" ::: "memory"); __builtin_amdgcn_s_barrier(); asm volatile("" ::: "memory");
        const int row = wid * 32 + (lane & 31);
        if (lane < 32) { const float t = (P[row * 4 + 0] + P[row * 4 + 1]) + (P[row * 4 + 2] + P[row * 4 + 3]);
            __hip_atomic_store(xbuf + (size_t)(u.pm * 256 + row) * 4 + u.pn, t, __ATOMIC_RELAXED, __HIP_MEMORY_SCOPE_AGENT); }
        asm volatile("s_waitcnt vmcnt(0)" ::: "memory");
        if (lane == 0) __hip_atomic_fetch_add(cnt + 64 * u.pm, 1u, __ATOMIC_RELAXED, __HIP_MEMORY_SCOPE_AGENT);
        if (wid == 0) {
            unsigned sp = 0;
            while ((unsigned)__builtin_amdgcn_readfirstlane(__hip_atomic_load(cnt + 64 * u.pm, __ATOMIC_RELAXED, __HIP_MEMORY_SCOPE_AGENT)) < 32u) { __builtin_amdgcn_s_sleep(2); if (++sp > (1u << 22)) break; }
            __builtin_amdgcn_fence(__ATOMIC_ACQUIRE, "agent");
        }
        asm volatile("s_waitcnt vmcnt(0) lgkmcnt(0)" ::: "memory"); __builtin_amdgcn_s_barrier(); asm volatile("" ::: "memory");
        if (lane < 32) { const float* slot = xbuf + (size_t)(u.pm * 256 + row) * 4; float t = 0.f;
#pragma unroll
            for (int k = 0; k < 4; ++k) t += __hip_atomic_load(slot + k, __ATOMIC_RELAXED, __HIP_MEMORY_SCOPE_AGENT);
            S[row] = 1.0f / sqrtf(t * (1.f / DM) + RMS_EPS); }
        asm volatile("s_waitcnt lgkmcnt(0)" ::: "memory"); __builtin_amdgcn_s_barrier(); asm volatile("" ::: "memory");
    }
};
struct EpiNorm1 {
    static constexpr bool PERM = false, AFTER_DRAIN = true, MIDK = false;
    float* out; const float* gpost; RmsPanel st;
    __device__ __forceinline__ void operator()(const f32x4 (&)[2][2][4][2], const Unit&, int, int, int, int) const {}
    __device__ __forceinline__ void fused(f32x4 (&acc)[2][2][4][2], const Unit& u, int wr, int wc, int fr, int fq, LAS unsigned char* lds, int wid, int lane) const {
        const LAS float* S = (const LAS float*)(lds + 8192);
        const int col0 = u.pn * 256 + wc * 32 + 4 * fq, jl0 = wc * 32 + 4 * fq;
        f32x4 gp[2][2]; u32x2 pre[2][4][2][2];
#pragma unroll
        for (int bj = 0; bj < 2; ++bj)
#pragma unroll
            for (int n = 0; n < 2; ++n) gp[bj][n] = *(const f32x4*)(gpost + col0 + bj * 128 + n * 16);
#pragma unroll
        for (int ai = 0; ai < 2; ++ai)
#pragma unroll
            for (int m = 0; m < 4; ++m) { const unsigned char* ob = (const unsigned char*)out + (size_t)(u.pm * 256 + ai * 128 + wr * 64 + m * 16 + fr) * 4096 + u.pn * 1024;
#pragma unroll
                for (int bj = 0; bj < 2; ++bj)
#pragma unroll
                    for (int n = 0; n < 2; ++n) pre[ai][m][bj][n] = *(const u32x2*)(ob + 2 * (jl0 + bj * 128 + n * 16)); }
        st.run(acc, u, wr, wc, fr, fq, lds, wid, lane);
#pragma unroll
        for (int ai = 0; ai < 2; ++ai)
#pragma unroll
            for (int m = 0; m < 4; ++m) { const int r = ai * 128 + wr * 64 + m * 16 + fr; const float rs = S[r]; const size_t off = (size_t)(u.pm * 256 + r) * DM + col0;
#pragma unroll
                for (int bj = 0; bj < 2; ++bj)
#pragma unroll
                    for (int n = 0; n < 2; ++n) { const u32x2 p = pre[ai][m][bj][n]; const f32x4 bs = (f32x4){bflo(p.x), bfhi(p.x), bflo(p.y), bfhi(p.y)};
                        *(f32x4*)(out + off + bj * 128 + n * 16) = bs + acc[ai][bj][m][n] * rs * gp[bj][n]; } }
    }
};
struct EpiNorm2 {
    static constexpr bool PERM = false, AFTER_DRAIN = true, MIDK = false;
    const float* base; float* out; bf16_t* hn; const float* gpost; const float* gnext; RmsPanel st1, st2;
    __device__ __forceinline__ void operator()(const f32x4 (&)[2][2][4][2], const Unit&, int, int, int, int) const {}
    __device__ __forceinline__ void fused(f32x4 (&acc)[2][2][4][2], const Unit& u, int wr, int wc, int fr, int fq, LAS unsigned char* lds, int wid, int lane) const {
        const LAS float* S = (const LAS float*)(lds + 8192);
        const int col0 = u.pn * 256 + wc * 32 + 4 * fq;
        f32x4 gp[2][2], pre[4][2][2];
#pragma unroll
        for (int bj = 0; bj < 2; ++bj)
#pragma unroll
            for (int n = 0; n < 2; ++n) gp[bj][n] = *(const f32x4*)(gpost + col0 + bj * 128 + n * 16);
#pragma unroll
        for (int m = 0; m < 4; ++m)
#pragma unroll
            for (int bj = 0; bj < 2; ++bj)
#pragma unroll
                for (int n = 0; n < 2; ++n) pre[m][bj][n] = *(const f32x4*)(base + (size_t)(u.pm * 256 + wr * 64 + m * 16 + fr) * DM + col0 + bj * 128 + n * 16);
        st1.run(acc, u, wr, wc, fr, fq, lds, wid, lane);
#pragma unroll
        for (int ai = 0; ai < 2; ++ai) {
            if (ai == 1) {
#pragma unroll
                for (int m = 0; m < 4; ++m)
#pragma unroll
                    for (int bj = 0; bj < 2; ++bj)
#pragma unroll
                        for (int n = 0; n < 2; ++n) pre[m][bj][n] = *(const f32x4*)(base + (size_t)(u.pm * 256 + 128 + wr * 64 + m * 16 + fr) * DM + col0 + bj * 128 + n * 16);
            }
#pragma unroll
            for (int m = 0; m < 4; ++m) { const int r = ai * 128 + wr * 64 + m * 16 + fr; const float rs = S[r]; const size_t off = (size_t)(u.pm * 256 + r) * DM + col0;
#pragma unroll
                for (int bj = 0; bj < 2; ++bj)
#pragma unroll
                    for (int n = 0; n < 2; ++n) { const f32x4 x1 = pre[m][bj][n] + acc[ai][bj][m][n] * rs * gp[bj][n]; acc[ai][bj][m][n] = x1;
                        u32x2 w; w.x = pg8::cvt_pk_bf16(x1[0], x1[1]); w.y = pg8::cvt_pk_bf16(x1[2], x1[3]);
                        *(u32x2*)((unsigned char*)out + (size_t)(u.pm * 256 + r) * 4096 + u.pn * 1024 + 2 * (wc * 32 + 4 * fq + bj * 128 + n * 16)) = w; } }
        }
#pragma unroll
        for (int bj = 0; bj < 2; ++bj)
#pragma unroll
            for (int n = 0; n < 2; ++n) gp[bj][n] = *(const f32x4*)(gnext + col0 + bj * 128 + n * 16);
        st2.run(acc, u, wr, wc, fr, fq, lds, wid, lane);
#pragma unroll
        for (int ai = 0; ai < 2; ++ai)
#pragma unroll
            for (int m = 0; m < 4; ++m) { const int r = ai * 128 + wr * 64 + m * 16 + fr; const float rs = S[r]; const size_t off = (size_t)(u.pm * 256 + r) * DM + col0;
#pragma unroll
                for (int bj = 0; bj < 2; ++bj)
#pragma unroll
                    for (int n = 0; n < 2; ++n) { const f32x4 o = acc[ai][bj][m][n] * rs * gp[bj][n];
                        u32x2 w; w.x = pg8::cvt_pk_bf16(o[0], o[1]); w.y = pg8::cvt_pk_bf16(o[2], o[3]); *(u32x2*)(hn + off + bj * 128 + n * 16) = w; } }
    }
};
__device__ __forceinline__ int win_row(int c) {
    if (c < 1024 || c >= 3072) return c;
    const int q = (c - 1024) >> 9, ch = (c - 1024) & 511, ct = ch >> 6, grp = (ch & 63) >> 2, e = ch & 3;
    return 1024 + ct * 256 + (q & 1) * 128 + grp * 8 + (q >> 1) * 4 + e;
}
__device__ __forceinline__ void transpose_item(const float* W, int N, bf16_t* WT, int ldt, int koff, int row_off, bool winmap, LAS float* scr, int item, int lane, const float* rscale = nullptr) {
    const int nblk = N / 64, kb = item / nblk, nb = item % nblk, k0 = 64 * kb, n0 = 64 * nb;
    const int kq = lane >> 4, nq = lane & 15;
    f32x4 v[16];
#pragma unroll
    for (int i = 0; i < 16; ++i) v[i] = *(const f32x4*)(W + (size_t)(k0 + 4 * i + kq) * N + n0 + 4 * nq);
#pragma unroll
    for (int i = 0; i < 16; ++i) { LAS float* s = scr + (4 * i + kq) * 65 + 4 * nq; s[0] = v[i][0]; s[1] = v[i][1]; s[2] = v[i][2]; s[3] = v[i][3]; }
    asm volatile("s_waitcnt lgkmcnt(0)" ::: "memory");
    const int c = lane & 7;
#pragma unroll
    for (int j = 0; j < 8; ++j) { const int n = (lane >> 3) + 8 * j;
        const LAS float* s = scr + (rscale ? (16 * (c >> 1) + 4 * (c & 1)) : 8 * c) * 65 + n; const int hs = rscale ? 8 * 65 : 4 * 65; const float f = rscale ? rscale[n0 + n] : 1.f;
        u32x4 o; o.x = pg8::cvt_pk_bf16(s[0 * 65] * f, s[1 * 65] * f); o.y = pg8::cvt_pk_bf16(s[2 * 65] * f, s[3 * 65] * f); o.z = pg8::cvt_pk_bf16(s[hs] * f, s[hs + 65] * f); o.w = pg8::cvt_pk_bf16(s[hs + 2 * 65] * f, s[hs + 3 * 65] * f);
        int dst = n0 + n; if (winmap) dst = win_row(dst);
        if (rscale) *(u32x4*)(WT + (size_t)((((dst >> 5) * 8 + ((k0 + 8 * c) >> 4)) * 64 + (c & 1) * 32 + (dst & 31)) * 8)) = o;
        else *(u32x4*)(WT + (size_t)(row_off + dst) * ldt + koff + k0 + 8 * c) = o; }
    asm volatile("s_waitcnt lgkmcnt(0)" ::: "memory");
}
template <int R> __device__ __forceinline__ void rms_rows_to_bf16(const float* x, const float* g, bf16_t* H, int m0, int mstride, int lane) {
    f32x4 v[R][4];
#pragma unroll
    for (int r = 0; r < R; ++r)
#pragma unroll
        for (int j = 0; j < 4; ++j) v[r][j] = ((const f32x4*)(x + (size_t)(m0 + r * mstride) * DM))[64 * j + lane];
    f32x4 gg[4];
#pragma unroll
    for (int j = 0; j < 4; ++j) gg[j] = ((const f32x4*)g)[64 * j + lane];
#pragma unroll
    for (int r = 0; r < R; ++r) { float s = 0.f;
#pragma unroll
        for (int j = 0; j < 4; ++j) s += (v[r][j][0] * v[r][j][0] + v[r][j][1] * v[r][j][1]) + (v[r][j][2] * v[r][j][2] + v[r][j][3] * v[r][j][3]);
        const float rstd = 1.f / sqrtf(wave_sum(s) * (1.f / DM) + RMS_EPS);
        u32x2* o8 = (u32x2*)(H + (size_t)(m0 + r * mstride) * DM) + lane;
#pragma unroll
        for (int j = 0; j < 4; ++j) { u32x2 w; w.x = pg8::cvt_pk_bf16(v[r][j][0] * rstd * gg[j][0], v[r][j][1] * rstd * gg[j][1]); w.y = pg8::cvt_pk_bf16(v[r][j][2] * rstd * gg[j][2], v[r][j][3] * rstd * gg[j][3]); o8[64 * j] = w; } }
}

__device__ __forceinline__ int crow(int r, int hi) { return (r & 3) + 8 * (r >> 2) + 4 * hi; }
constexpr int VROW = 144;
__device__ __forceinline__ void attn_item(int item, const bf16_t* Q, const bf16_t* K, const bf16_t* V, const bf16_t* SG, bf16_t* YO, LAS unsigned char* vl, LAS unsigned char* kl, int lane) {
    const int qg = item & 127, h = (item >> 7) & 7, b = item >> 10;
    const int r32 = lane & 31, hi = lane >> 5, t0 = qg * 32;
    const size_t tokq = (size_t)b * SEQ + t0 + r32;
    bf16x8 qf[4];
    { const size_t tq0 = (size_t)b * SEQ + t0;
#pragma unroll
      for (int p = 0; p < 4; ++p) { const int idx = p * 64 + lane; const u32x4 v = *(const u32x4*)(Q + (tq0 + (idx >> 3)) * 512 + h * 64 + (idx & 7) * 8); *(LAS u32x4*)(kl + (idx >> 3) * VROW + (idx & 7) * 16) = v; }
#pragma unroll
      for (int d0 = 0; d0 < 4; ++d0) qf[d0] = *(const LAS bf16x8*)(kl + r32 * VROW + d0 * 32 + hi * 16); }
    f32x16 o0, o1;
#pragma unroll
    for (int r = 0; r < 16; ++r) { o0[r] = 0.f; o1[r] = 0.f; }
    float P = 1.f;
    const int i16 = lane & 15, G4 = lane >> 4;
    const int vb = (4 * (G4 >> 1) + (i16 >> 2)) * VROW + (16 * (G4 & 1) + 4 * (i16 & 3)) * 2;
#define ATT_LOAD(KF, VR, S0) do { const size_t tk_ = (size_t)b * SEQ + ((S0) > 0 ? (S0) : 0); \
        _Pragma("unroll") for (int p = 0; p < 4; ++p) { const int idx = p * 64 + lane; KF[p] = *(const u32x4*)(K + (tk_ + (idx >> 3)) * 512 + h * 64 + (idx & 7) * 8); \
                                                         VR[p] = *(const u32x4*)(V + (tk_ + (idx >> 3)) * 512 + h * 64 + (idx & 7) * 8); } } while (0)
    u32x4 kf[4], kn[4]; u32x4 vr[4], vn[4];
    ATT_LOAD(kf, vr, t0); ATT_LOAD(kn, vn, t0 - 32);
    u32x4 sgr[4];
#pragma unroll
    for (int p = 0; p < 4; ++p) { const int idx = p * 64 + lane; sgr[p] = *(const u32x4*)(SG + ((size_t)b * SEQ + t0 + (idx >> 3)) * 1536 + h * 64 + (idx & 7) * 8); }
    for (int s0 = t0; s0 >= 0; s0 -= 32) {
#pragma unroll
        for (int p = 0; p < 4; ++p) { const int idx = p * 64 + lane, key = idx >> 3, ch = idx & 7; *(LAS u32x4*)(vl + key * VROW + ch * 16) = vr[p]; *(LAS u32x4*)(kl + key * VROW + ch * 16) = kf[p]; }
        f32x16 s;
#pragma unroll
        for (int r = 0; r < 16; ++r) s[r] = 0.f;
#pragma unroll
        for (int d0 = 0; d0 < 4; ++d0) s = __builtin_amdgcn_mfma_f32_32x32x16_bf16(*(const LAS bf16x8*)(kl + r32 * VROW + d0 * 32 + hi * 16), qf[d0], s, 0, 0, 0);
        const bool diag = (s0 == t0);
        float kp[16];
#pragma unroll
        for (int r = 0; r < 16; ++r) { const float e = __builtin_amdgcn_exp2f(s[r] * (0.125f * 1.4426950408889634f)); float k = __builtin_amdgcn_rcpf(1.f + e);
            if (diag && crow(r, hi) >= r32) k = 1.f; kp[r] = k; }
        float Gm[4], Go[4], T[4], R[4], C[4];
#pragma unroll
        for (int g = 0; g < 4; ++g) { Gm[g] = (kp[4 * g] * kp[4 * g + 1]) * (kp[4 * g + 2] * kp[4 * g + 3]); Go[g] = __shfl_xor(Gm[g], 32); T[g] = Gm[g] * Go[g]; }
        R[3] = P; R[2] = R[3] * T[3]; R[1] = R[2] * T[2]; R[0] = R[1] * T[1]; const float Cout = R[0] * T[0];
#pragma unroll
        for (int g = 0; g < 4; ++g) C[g] = hi ? R[g] : R[g] * Go[g];
        float w[16];
#pragma unroll
        for (int g = 0; g < 4; ++g) { const float p3 = C[g], p2 = p3 * kp[4 * g + 3], p1 = p2 * kp[4 * g + 2], p0 = p1 * kp[4 * g + 1], pe = p0 * kp[4 * g];
            w[4 * g + 3] = p3 - p2; w[4 * g + 2] = p2 - p1; w[4 * g + 1] = p1 - p0; w[4 * g] = p0 - pe; }
        bf16x8 wf[2];
#pragma unroll
        for (int st = 0; st < 2; ++st) { u32x4 t; t.x = pg8::cvt_pk_bf16(w[8 * st], w[8 * st + 1]); t.y = pg8::cvt_pk_bf16(w[8 * st + 2], w[8 * st + 3]); t.z = pg8::cvt_pk_bf16(w[8 * st + 4], w[8 * st + 5]); t.w = pg8::cvt_pk_bf16(w[8 * st + 6], w[8 * st + 7]); wf[st] = __builtin_bit_cast(bf16x8, t); }
#pragma unroll
        for (int dt = 0; dt < 2; ++dt)
#pragma unroll
            for (int st = 0; st < 2; ++st) {
                const s16x4 lo = __builtin_amdgcn_ds_read_tr16_b64_v4i16((LAS s16x4*)(vl + vb + (16 * st) * VROW + dt * 64));
                const s16x4 hh = __builtin_amdgcn_ds_read_tr16_b64_v4i16((LAS s16x4*)(vl + vb + (16 * st + 8) * VROW + dt * 64));
                const bf16x8 vf = (bf16x8){lo[0], lo[1], lo[2], lo[3], hh[0], hh[1], hh[2], hh[3]};
                if (dt == 0) o0 = __builtin_amdgcn_mfma_f32_32x32x16_bf16(vf, wf[st], o0, 0, 0, 0); else o1 = __builtin_amdgcn_mfma_f32_32x32x16_bf16(vf, wf[st], o1, 0, 0, 0); }
        P = Cout;
        if (__all(P < 1.17549435e-38f)) break;
#pragma unroll
        for (int i = 0; i < 4; ++i) { kf[i] = kn[i]; vr[i] = vn[i]; }
        ATT_LOAD(kn, vn, s0 - 64);
    }
#undef ATT_LOAD
#pragma unroll
    for (int p = 0; p < 4; ++p) { const int idx = p * 64 + lane; *(LAS u32x4*)(kl + (idx >> 3) * VROW + (idx & 7) * 16) = sgr[p]; }
#pragma unroll
    for (int dt = 0; dt < 2; ++dt)
#pragma unroll
        for (int g = 0; g < 4; ++g) { LAS u32x2* p = (LAS u32x2*)(kl + r32 * VROW + (dt * 32 + 8 * g + 4 * hi) * 2); const u32x2 sg = *p;
            const f32x16& o = dt ? o1 : o0; u32x2 y;
            y.x = pg8::cvt_pk_bf16(o[4 * g] * bflo(sg.x), o[4 * g + 1] * bfhi(sg.x)); y.y = pg8::cvt_pk_bf16(o[4 * g + 2] * bflo(sg.y), o[4 * g + 3] * bfhi(sg.y));
            *p = y; }
#pragma unroll
    for (int p = 0; p < 4; ++p) { const int idx = p * 64 + lane; const u32x4 v = *(const LAS u32x4*)(kl + (idx >> 3) * VROW + (idx & 7) * 16);
        *(u32x4*)(YO + ((size_t)b * SEQ + t0 + (idx >> 3)) * 1536 + h * 64 + (idx & 7) * 8) = v; }
}
constexpr int PROW = 272;
__device__ __forceinline__ void pool_item(int pi, const bf16_t* PV, const bf16_t* SG, bf16_t* YO, const bf16_t* PT, const float* scale, LAS unsigned char* sl, int lane) {
    const int tile = pi >> 2, g = ((pi & 3) + ((pi >> 2) & 1)) & 3, win = 2 << g;
    const int r32 = lane & 31, hi = lane >> 5, tok0 = tile * 32, t0 = tok0 & (SEQ - 1), tok = tok0 + r32;
    u32x4 sv[12];
#pragma unroll
    for (int p = 0; p < 12; ++p) { const int idx = p * 64 + lane, row = idx >> 4, ch = idx & 15; const bool ok = (t0 + row - 16) >= 0;
        sv[p] = *(const u32x4*)(PV + (size_t)(ok ? tok0 + row - 16 : tok0) * 512 + g * 128 + ch * 8); if (!ok) sv[p] = (u32x4){0u, 0u, 0u, 0u}; }
#pragma unroll
    for (int p = 0; p < 12; ++p) { const int idx = p * 64 + lane, row = idx >> 4, ch = idx & 15; *(LAS u32x4*)(sl + row * PROW + ch * 16) = sv[p]; }
    const int t = t0 + r32, cnt = (t + 1) < win ? (t + 1) : win;
    bf16x8 bfr[3];
#pragma unroll
    for (int ks = 0; ks < 3; ++ks) { float wv[8];
#pragma unroll
        for (int j = 0; j < 8; ++j) { const int rel = (16 + r32) - (16 * ks + 8 * hi + j); wv[j] = (rel == 0) ? (float)(1 - cnt) : ((rel > 0 && rel < cnt) ? 1.f : 0.f); }
        u32x4 tt; tt.x = pg8::cvt_pk_bf16(wv[0], wv[1]); tt.y = pg8::cvt_pk_bf16(wv[2], wv[3]); tt.z = pg8::cvt_pk_bf16(wv[4], wv[5]); tt.w = pg8::cvt_pk_bf16(wv[6], wv[7]); bfr[ks] = __builtin_bit_cast(bf16x8, tt); }
    bf16x8 ptf[4][8];
#pragma unroll
    for (int nt = 0; nt < 4; ++nt)
#pragma unroll
        for (int ks = 0; ks < 8; ++ks) ptf[nt][ks] = *(const bf16x8*)(PT + (size_t)g * 128 * 128 + (size_t)((nt * 8 + ks) * 64 + lane) * 8);
    const int i16 = lane & 15, G4 = lane >> 4;
    const int vb = (8 * (G4 >> 1) + (i16 >> 2)) * PROW + (16 * (G4 & 1) + 4 * (i16 & 3)) * 2;
    const float inv = __builtin_amdgcn_rcpf((float)cnt);
    bf16x8 pf[8];
#pragma unroll
    for (int ct = 0; ct < 4; ++ct) {
        f32x16 acc;
#pragma unroll
        for (int r = 0; r < 16; ++r) acc[r] = 0.f;
#pragma unroll
        for (int ks = 0; ks < 3; ++ks) {
            const s16x4 lo = __builtin_amdgcn_ds_read_tr16_b64_v4i16((LAS s16x4*)(sl + vb + (16 * ks) * PROW + ct * 64));
            const s16x4 hh = __builtin_amdgcn_ds_read_tr16_b64_v4i16((LAS s16x4*)(sl + vb + (16 * ks + 4) * PROW + ct * 64));
            const bf16x8 a = (bf16x8){lo[0], lo[1], lo[2], lo[3], hh[0], hh[1], hh[2], hh[3]};
            acc = __builtin_amdgcn_mfma_f32_32x32x16_bf16(a, bfr[ks], acc, 0, 0, 0); }
#pragma unroll
        for (int s = 0; s < 2; ++s) { u32x4 tt; tt.x = pg8::cvt_pk_bf16(acc[8 * s] * inv, acc[8 * s + 1] * inv); tt.y = pg8::cvt_pk_bf16(acc[8 * s + 2] * inv, acc[8 * s + 3] * inv);
            tt.z = pg8::cvt_pk_bf16(acc[8 * s + 4] * inv, acc[8 * s + 5] * inv); tt.w = pg8::cvt_pk_bf16(acc[8 * s + 6] * inv, acc[8 * s + 7] * inv); pf[2 * ct + s] = __builtin_bit_cast(bf16x8, tt); }
    }
#pragma unroll
    for (int p = 0; p < 8; ++p) { const int idx = p * 64 + lane; const u32x4 v = *(const u32x4*)(SG + (size_t)(tok0 + (idx >> 4)) * 1536 + g * 128 + (idx & 15) * 8); *(LAS u32x4*)(sl + (idx >> 4) * PROW + (idx & 15) * 16) = v; }
#pragma unroll
    for (int nt = 0; nt < 4; ++nt) {
        f32x16 acc;
#pragma unroll
        for (int r = 0; r < 16; ++r) acc[r] = 0.f;
#pragma unroll
        for (int ks = 0; ks < 8; ++ks) acc = __builtin_amdgcn_mfma_f32_32x32x16_bf16(ptf[nt][ks], pf[ks], acc, 0, 0, 0);
#pragma unroll
        for (int q = 0; q < 4; ++q) { LAS u32x2* p = (LAS u32x2*)(sl + r32 * PROW + (nt * 32 + 8 * q + 4 * hi) * 2); const u32x2 sg = *p; u32x2 y;
            y.x = pg8::cvt_pk_bf16(acc[4 * q] * bflo(sg.x), acc[4 * q + 1] * bfhi(sg.x)); y.y = pg8::cvt_pk_bf16(acc[4 * q + 2] * bflo(sg.y), acc[4 * q + 3] * bfhi(sg.y));
            *p = y; }
    }
#pragma unroll
    for (int p = 0; p < 8; ++p) { const int idx = p * 64 + lane; const u32x4 v = *(const LAS u32x4*)(sl + (idx >> 4) * PROW + (idx & 15) * 16);
        *(u32x4*)(YO + (size_t)(tok0 + (idx >> 4)) * 1536 + g * 128 + (idx & 15) * 8) = v; }
}
__device__ __forceinline__ void conv_item(int ci, const bf16_t* Z, const bf16_t* Wy, bf16_t* YO, const float* cw, const float* cb, int lane) {
    const int tok0 = ci * 8, t0 = tok0 & (SEQ - 1), ch = lane * 8;
    float w0[8], w1[8], w2[8], bs[8], zm2[8], zm1[8];
#pragma unroll
    for (int hf = 0; hf < 2; ++hf) { const f32x4 a = *(const f32x4*)(cw + ch + 4 * hf), b = *(const f32x4*)(cw + 512 + ch + 4 * hf), c = *(const f32x4*)(cw + 1024 + ch + 4 * hf), d = *(const f32x4*)(cb + ch + 4 * hf);
#pragma unroll
        for (int i = 0; i < 4; ++i) { w0[4 * hf + i] = a[i]; w1[4 * hf + i] = b[i]; w2[4 * hf + i] = c[i]; bs[4 * hf + i] = d[i]; } }
#pragma unroll
    for (int i = 0; i < 8; ++i) { zm2[i] = 0.f; zm1[i] = 0.f; }
    if (t0 != 0) { const u32x4 a = *(const u32x4*)(Z + (size_t)(tok0 - 2) * 512 + ch), b = *(const u32x4*)(Z + (size_t)(tok0 - 1) * 512 + ch);
        zm2[0] = bflo(a.x); zm2[1] = bfhi(a.x); zm2[2] = bflo(a.y); zm2[3] = bfhi(a.y); zm2[4] = bflo(a.z); zm2[5] = bfhi(a.z); zm2[6] = bflo(a.w); zm2[7] = bfhi(a.w);
        zm1[0] = bflo(b.x); zm1[1] = bfhi(b.x); zm1[2] = bflo(b.y); zm1[3] = bfhi(b.y); zm1[4] = bflo(b.z); zm1[5] = bfhi(b.z); zm1[6] = bflo(b.w); zm1[7] = bfhi(b.w); }
    u32x4 zr[8], wr_[8];
#pragma unroll
    for (int r = 0; r < 8; ++r) { zr[r] = *(const u32x4*)(Z + (size_t)(tok0 + r) * 512 + ch); wr_[r] = *(const u32x4*)(Wy + (size_t)(tok0 + r) * 1536 + ch); }
#pragma unroll
    for (int r = 0; r < 8; ++r) {
        float zc[8], wv[8], y[8];
        zc[0] = bflo(zr[r].x); zc[1] = bfhi(zr[r].x); zc[2] = bflo(zr[r].y); zc[3] = bfhi(zr[r].y); zc[4] = bflo(zr[r].z); zc[5] = bfhi(zr[r].z); zc[6] = bflo(zr[r].w); zc[7] = bfhi(zr[r].w);
        wv[0] = bflo(wr_[r].x); wv[1] = bfhi(wr_[r].x); wv[2] = bflo(wr_[r].y); wv[3] = bfhi(wr_[r].y); wv[4] = bflo(wr_[r].z); wv[5] = bfhi(wr_[r].z); wv[6] = bflo(wr_[r].w); wv[7] = bfhi(wr_[r].w);
#pragma unroll
        for (int i = 0; i < 8; ++i) { y[i] = wv[i] * (w0[i] * zm2[i] + w1[i] * zm1[i] + w2[i] * zc[i] + bs[i]); zm2[i] = zm1[i]; zm1[i] = zc[i]; }
        u32x4 o; o.x = pg8::cvt_pk_bf16(y[0], y[1]); o.y = pg8::cvt_pk_bf16(y[2], y[3]); o.z = pg8::cvt_pk_bf16(y[4], y[5]); o.w = pg8::cvt_pk_bf16(y[6], y[7]);
        *(u32x4*)(YO + (size_t)(tok0 + r) * 1536 + ch) = o; }
}
template <int R> __device__ __forceinline__ void norm_rows(const float* F32T, const float* RS, const float* xin, const float* gpost, float* xout, const float* gnext, bf16_t* H, int m0, int mstride, int lane) {
    f32x4 o[R][4], xi[R][4]; float ss[R];
#pragma unroll
    for (int r = 0; r < R; ++r) { const size_t row = (size_t)(m0 + r * mstride); ss[r] = (lane < 16) ? RS[row * 16 + lane] : 0.f;
#pragma unroll
        for (int j = 0; j < 4; ++j) { o[r][j] = ((const f32x4*)(F32T + row * DM))[64 * j + lane]; xi[r][j] = ((const f32x4*)(xin + row * DM))[64 * j + lane]; } }
    f32x4 gp[4];
#pragma unroll
    for (int j = 0; j < 4; ++j) gp[j] = ((const f32x4*)gpost)[64 * j + lane];
#pragma unroll
    for (int r = 0; r < R; ++r) { const size_t row = (size_t)(m0 + r * mstride);
        const float rstd = 1.f / sqrtf(wave_sum(ss[r]) * (1.f / DM) + RMS_EPS); float s2 = 0.f;
#pragma unroll
        for (int j = 0; j < 4; ++j) { const f32x4 v = xi[r][j] + o[r][j] * rstd * gp[j]; xi[r][j] = v; ((f32x4*)(xout + row * DM))[64 * j + lane] = v; s2 += (v[0] * v[0] + v[1] * v[1]) + (v[2] * v[2] + v[3] * v[3]); }
        if (gnext) { const float r2 = 1.f / sqrtf(wave_sum(s2) * (1.f / DM) + RMS_EPS);
#pragma unroll
            for (int j = 0; j < 4; ++j) { const f32x4 gg = ((const f32x4*)gnext)[64 * j + lane]; const f32x4 v = xi[r][j]; u32x2 w; w.x = pg8::cvt_pk_bf16(v[0] * r2 * gg[0], v[1] * r2 * gg[1]); w.y = pg8::cvt_pk_bf16(v[2] * r2 * gg[2], v[3] * r2 * gg[3]); ((u32x2*)(H + row * DM))[64 * j + lane] = w; } } }
}

struct Args { const float* in[10]; float* out; unsigned char* ws; int ph_lo, ph_hi; };
template <class T> __device__ __forceinline__ T* as_global(T* p) { return p; }
#if TP_A >= 0
#define TSTAMP(k) do { if (blockIdx.x == TP_BLK && threadIdx.x == 0) ((volatile LAS unsigned long long*)(lds + 147264))[(k)] = __builtin_amdgcn_s_memrealtime(); } while (0)
#else
#define TSTAMP(k) do { } while (0)
#endif
template <int ph> __device__ __forceinline__ void run_phase(const Args& a_, LAS unsigned char* lds) {
        const Args* A = &a_;
        const int tid = threadIdx.x, lane = tid & 63, wave = __builtin_amdgcn_readfirstlane(tid >> 6);
        const int G = gridDim.x, bx = blockIdx.x;
        const int vcu = (G % 8 == 0) ? (bx % 8) * (G / 8) + bx / 8 : bx;
        const int gw = vcu * 8 + wave, NGW = G * 8;
        unsigned char* ws = as_global(A->ws);
        bf16_t* H = (bf16_t*)(ws + WS_H); bf16_t* U = (bf16_t*)(ws + WS_U);
        if constexpr (ph == 0) {
            const float* x = as_global(A->in[0]); const float* pre_g = as_global(A->in[1]); const float* w_in = as_global(A->in[2]); const float* pool_w = as_global(A->in[3]); const float* pool_scale = as_global(A->in[4]); const float* w_branch = as_global(A->in[7]); const float* w_out = as_global(A->in[8]);
            bf16_t* W1 = (bf16_t*)(ws + WS_W1); bf16_t* W2 = (bf16_t*)(ws + WS_W2); bf16_t* W3 = (bf16_t*)(ws + WS_W3); bf16_t* PW = (bf16_t*)(ws + WS_PW);
            LAS float* scr = (LAS float*)(lds + wave * 17408);
            constexpr int I1 = (DM / 64) * (NIN / 64), I2 = (BWID / 64) * (DM / 64), I3 = (DM / 64) * (DM / 64), I4 = 2 * 2, PER = I1 + 3 * I2 + I3 + 4 * I4;
            for (int it = gw; it < NLAYER * PER; it += NGW) {
                const int l = it / PER; int r = it % PER;
                if (r < I1) { transpose_item(w_in + (size_t)l * DM * NIN, NIN, W1 + (size_t)l * NIN * DM, DM, 0, 0, true, scr, r, lane); continue; } r -= I1;
                if (r < 3 * I2) { const int n = r / I2; transpose_item(w_branch + ((size_t)l * 3 + n) * BWID * DM, DM, W2 + (size_t)l * 3 * DM * BWID, 3 * BWID, n * BWID, 0, false, scr, r % I2, lane); continue; } r -= 3 * I2;
                if (r < I3) { transpose_item(w_out + (size_t)l * DM * DM, DM, W3 + (size_t)l * DM * DM, DM, 0, 0, false, scr, r, lane); continue; } r -= I3;
                { const int g = r / I4; transpose_item(pool_w + ((size_t)l * 4 + g) * 128 * 128, 128, PW + ((size_t)l * 4 + g) * 128 * 128, 128, 0, 0, false, scr, r % I4, lane, pool_scale + l * BWID + g * 128); }
            }
            for (int m = gw; m < MTOK; m += 2 * NGW) rms_rows_to_bf16<2>(x, pre_g, H, m, NGW, lane);
        } else {
            constexpr int l = (ph - 1) / 5, k = (ph - 1) % 5;
            if constexpr (k == 0) {
                pg8::Gemm g{H, (bf16_t*)(ws + WS_W1) + (size_t)l * NIN * DM, MTOK, NIN, DM, 0}; pg8::StaticOrder S; S.init(MTOK, NIN, G, bx);
                EpiU E{ws};
                pg8::gemm_phase<EpiU, pg8::StaticOrder, true, true>(lds, g, S, E);
            } else if constexpr (k == 1) {
                const float* pool_scale = as_global(A->in[4]); const float* conv_w = as_global(A->in[5]); const float* conv_b = as_global(A->in[6]);
                const bf16_t* PW = (const bf16_t*)(ws + WS_PW);
                const bf16_t* Q = U + 2 * (ARRB / 2); const bf16_t* Kk = U + 3 * (ARRB / 2); const bf16_t* V = U + 4 * (ARRB / 2);
                LAS unsigned char* vl = lds + wave * (32 * VROW);
                bf16_t* G3 = U + 5 * (ARRB / 2);
                bf16_t* YO = G3;
#if MIX_PROBE
                if (l == 0 && A->ph_hi < 0) YO = (bf16_t*)as_global(A->out);
#endif
                int pm_ = 7;
#if MIX_PROBE
                if (l == 0 && A->ph_hi < 0) pm_ = MIX_PROBE;
#endif
                if (l == 0) TSTAMP(12);
                volatile LAS unsigned* wq = (volatile LAS unsigned*)(lds + 147216);
                if (tid < 3) wq[tid] = 0u;
                __syncthreads();
#define WQ_GRAB(Q_) ({ unsigned v_ = 0u; if (lane == 0) v_ = __hip_atomic_fetch_add((LAS unsigned*)(Q_), 1u, __ATOMIC_RELAXED, __HIP_MEMORY_SCOPE_WORKGROUP); (unsigned)__builtin_amdgcn_readfirstlane((int)v_); })
#define WQ_ITEM(J_) ((int)(vcu * 8 + ((J_) & 7u) + ((J_) >> 3) * (unsigned)NGW))
                for (;;) { const unsigned j = WQ_GRAB(wq); const int it = WQ_ITEM(j); if (it >= NB * 8 * 128) break; attn_item(it, Q, Kk, V, G3 + 1024, YO + 1024, vl, lds + 36864 + wave * (48 * PROW), lane); }
                if (l == 0) TSTAMP(13);
                for (;;) { const unsigned j = WQ_GRAB(wq + 1); const int it = WQ_ITEM(j); if (it >= (MTOK / 32) * 4) break; pool_item(it, U, G3, YO, PW + (size_t)l * 4 * 128 * 128, pool_scale + l * BWID, lds + 36864 + wave * (48 * PROW), lane); }
                if (l == 0) TSTAMP(14);
                for (;;) { const unsigned j = WQ_GRAB(wq + 2); const int it = WQ_ITEM(j); if (it >= MTOK / 8) break; conv_item(it, U + 1 * (ARRB / 2), G3 + 512, YO + 512, conv_w + l * 3 * BWID, conv_b + l * BWID, lane); }
#undef WQ_GRAB
#undef WQ_ITEM
                if (l == 0) TSTAMP(15);
#if TP_A >= 0
                if (l == 0) { __syncthreads(); TSTAMP(5); }
#endif
            } else if constexpr (k == 2) {
                pg8::Gemm g{U + 5 * (ARRB / 2), (bf16_t*)(ws + WS_W2) + (size_t)l * 3 * DM * BWID, MTOK, DM, 3 * BWID, 0}; pg8::StaticOrder S; S.init(MTOK, DM, G, bx);
                EpiBranch E{ws};
                pg8::gemm_phase<EpiBranch, pg8::StaticOrder, true, true>(lds, g, S, E);
            } else if constexpr (k == 3) {
                pg8::Gemm g{H, (bf16_t*)(ws + WS_W3) + (size_t)l * DM * DM, MTOK, DM, DM, 0}; pg8::StaticOrder S; S.init(MTOK, DM, G, bx);
                if (G == 256) {
                    const float* x = as_global(A->in[0]); const float* pre_g = as_global(A->in[1]); const float* post_g = as_global(A->in[9]); float* out = as_global(A->out);
                    float* xb = (float*)(ws + WS_RS); unsigned* cn = (unsigned*)(ws + WS_CTL + CTL_CNT);
                    if constexpr (l + 1 < NLAYER) {
                        EpiNorm2 E{x, out, H, post_g + l * DM, pre_g + (l + 1) * DM, RmsPanel{xb, cn}, RmsPanel{xb + (size_t)MTOK * 4, cn + 64 * 64}};
                        pg8::gemm_phase<EpiNorm2, pg8::StaticOrder, false, true>(lds, g, S, E);
                    } else {
                        EpiNorm1 E{out, post_g + l * DM, RmsPanel{xb + (size_t)2 * MTOK * 4, cn + 2 * 64 * 64}};
                        pg8::gemm_phase<EpiNorm1, pg8::StaticOrder, false, true>(lds, g, S, E);
                    }
                } else {
                    EpiOut E{ws};
                    pg8::gemm_phase<EpiOut, pg8::StaticOrder, true, true>(lds, g, S, E);
                }
            } else {
                const float* x = as_global(A->in[0]); const float* pre_g = as_global(A->in[1]); const float* post_g = as_global(A->in[9]); float* out = as_global(A->out);
                const float* F32T = (const float*)(ws + WS_U); const float* RS = (const float*)(ws + WS_RS);
                const float* xin = (l == 0) ? x : out; const float* gnext = (l + 1 < NLAYER) ? pre_g + (l + 1) * DM : nullptr;
                if (G != 256) for (int m = gw; m < MTOK; m += 2 * NGW) norm_rows<2>(F32T, RS, xin, post_g + l * DM, out, gnext, H, m, NGW, lane);
            }
        }
}
__global__ void __launch_bounds__(512, 2) hybrid_fwd(Args a_) {
    extern __shared__ __attribute__((aligned(16))) unsigned char lds_raw[];
    LAS unsigned char* lds = (LAS unsigned char*)lds_raw;
    cg::grid_group grid = cg::this_grid();
    if (threadIdx.x < 64) ((LAS unsigned*)(lds + 147200))[threadIdx.x] = 0u;
    __syncthreads();
    (void)xcd_barrier_post((unsigned*)(a_.ws + WS_CTL), (volatile LAS unsigned*)(lds + 147200 + 32));
#define SEAM_BAR() do { XcdBarrier b_; b_.bar = (unsigned*)(a_.ws + WS_CTL); b_.x = xb_xcc_id(); b_.st = (volatile LAS unsigned*)(lds + 147200 + 32); xcd_barrier(b_); } while (0)
    const int lo = a_.ph_lo, hi = a_.ph_hi < 0 ? -a_.ph_hi : a_.ph_hi;
#define PHASE(k) if (lo <= (k) && (k) < hi && !(((k) == 5 || (k) == 10) && gridDim.x == 256)) { if ((k) > lo) { if ((k) == 1 && lo < 0) grid.sync(); else SEAM_BAR(); } TSTAMP(k); run_phase<(k)>(a_, lds); }
    PHASE(0) PHASE(1) PHASE(2) PHASE(3) PHASE(4) PHASE(5) PHASE(6) PHASE(7) PHASE(8) PHASE(9) PHASE(10)
#undef PHASE
#if TP_A >= 0
    SEAM_BAR(); TSTAMP(11);
    if (blockIdx.x == TP_BLK && threadIdx.x == 0) { volatile LAS unsigned long long* ts = (volatile LAS unsigned long long*)(lds + 147264); a_.out[0] += (float)(ts[TP_B] - ts[TP_A]) * (0.00005f * TP_SCALE); }
#endif
}

extern "C" void kernel_launch(void* const* d_in, const int* in_sizes, int n_in, void* d_out, int out_size, void* d_ws, size_t ws_size, hipStream_t stream) {
    static int grid = 0;
    if (grid == 0) {
        if (n_in != 10 || out_size != MTOK * DM || ws_size < WS_END) { fprintf(stderr, "kernel_launch: unexpected shapes / workspace (n_in %d out %d ws %zu)\n", n_in, out_size, ws_size); grid = -1; return; }
        int dev = 0, cus = 0, per_cu = 0;
        (void)hipGetDevice(&dev); (void)hipDeviceGetAttribute(&cus, hipDeviceAttributeMultiprocessorCount, dev);
        (void)hipFuncSetAttribute((const void*)hybrid_fwd, hipFuncAttributeMaxDynamicSharedMemorySize, LDS_BYTES);
        (void)hipOccupancyMaxActiveBlocksPerMultiprocessor(&per_cu, (const void*)hybrid_fwd, 512, LDS_BYTES);
        (void)hipGetLastError();
        if (per_cu < 1) { fprintf(stderr, "kernel_launch: occupancy query says %d blocks/CU\n", per_cu); per_cu = 1; }
        grid = cus;
    }
    if (grid < 0) return;
    if (hipMemsetAsync((char*)d_ws + WS_CTL, 0, CTL_BYTES, stream) != hipSuccess) { fprintf(stderr, "kernel_launch: memset of the barrier words failed\n"); return; }
    Args a{};
    for (int i = 0; i < 10; ++i) a.in[i] = (const float*)d_in[i];
    a.out = (float*)d_out; a.ws = (unsigned char*)d_ws;
#if ONE_LAUNCH
    a.ph_lo = 0; a.ph_hi = NPHASE;
    void* args[] = {&a};
    hipError_t e = hipLaunchCooperativeKernel((const void*)hybrid_fwd, dim3(grid), dim3(512), args, LDS_BYTES, stream);
    if (e != hipSuccess) fprintf(stderr, "cooperative launch failed: %s (grid %d)\n", hipGetErrorString(e), grid);
#else
    for (int ph = 0; ph < NPHASE; ++ph) { a.ph_lo = ph; a.ph_hi = ph + 1;
#if MIX_PROBE
        if (ph == 2) { a.ph_hi = -(ph + 1); hipLaunchKernelGGL(hybrid_fwd, dim3(grid), dim3(512), LDS_BYTES, stream, a); a.ph_hi = ph + 1; }
#endif
        for (int rep = 0; rep < 1 + ((DUP_MASK >> ph) & 1); ++rep) hipLaunchKernelGGL(hybrid_fwd, dim3(grid), dim3(512), LDS_BYTES, stream, a); }
#endif
}
```

```cpp
#include <hip/hip_runtime.h>
#include <hip/hip_cooperative_groups.h>
#include <cstdio>
#include <cstdint>
namespace cg = cooperative_groups;
#ifndef ONE_LAUNCH
#define ONE_LAUNCH 1
#endif
#ifndef DUP_MASK
#define DUP_MASK 0
#endif
#ifndef MIX_PROBE
#define MIX_PROBE 0
#endif
#ifndef TP_A
#define TP_A -1
#define TP_B -1
#endif
#ifndef TP_SCALE
#define TP_SCALE 1
#endif
#ifndef TP_BLK
#define TP_BLK 0
#endif
namespace pg8 {
#define PG8_LAS __attribute__((address_space(3)))
typedef unsigned short bf16_t;
typedef short bf16x8 __attribute__((ext_vector_type(8)));
typedef float f32x4 __attribute__((ext_vector_type(4)));
typedef unsigned u32x4 __attribute__((ext_vector_type(4)));
constexpr int BM = 256, BK = 64, HALF = 128, HTB = HALF * BK * 2  , STAGE_BYTES = 8 * HTB, NXCD = 8, WGM = 8;

__host__ __device__ __forceinline__ int lds_byte(int r, int c) { const int st = (r >> 4) * 2 + (c >> 5), rr = r & 15, cc = c & 31, ob = rr * 64 + cc * 2; return st * 1024 + (ob ^ (((ob >> 9) & 1) << 5)); }
__host__ __device__ __forceinline__ void stage_rc(int b, int& R, int& C) { const int st = b / 1024, sb = b % 1024, swz = sb ^ (((sb >> 9) & 1) << 5); R = (st >> 1) * 16 + swz / 64; C = (st & 1) * 32 + (swz % 64) / 2; }
__host__ __device__ __forceinline__ int perm32(int rho) { const int n = rho >> 4, i = rho & 15; return 8 * (i >> 2) + 4 * n + (i & 3); }

struct Unit { int pm, pn, az; };
struct Gemm { const bf16_t* A; const bf16_t* Bt; int M, N, K; size_t azs; };

struct StaticOrder {
    int nM, nN, nwg, G, c;
    __host__ __device__ void init(int M, int N, int G_, int c_) { nM = M / BM; nN = N / BM; nwg = nM * nN; G = G_; c = c_; }
    __host__ __device__ bool next(int i, Unit& u) const {
        const long L = (long)i * G + c; if (L >= nwg) return false;
        int wgid = (int)L; { const int q = nwg / NXCD, r = nwg % NXCD, xcd = wgid % NXCD, off = wgid / NXCD; wgid = (xcd < r ? xcd * (q + 1) : r * (q + 1) + (xcd - r) * q) + off; }
        const int nig = WGM * nN, gid = wgid / nig, fm = gid * WGM, gsz = (nM - fm) < WGM ? (nM - fm) : WGM;
        u.pm = fm + ((wgid % nig) % gsz); u.pn = (wgid % nig) / gsz; u.az = 0; return true;
    }
    __device__ __forceinline__ void a_ready(const Unit&) const {}
    __device__ __forceinline__ void done(const Unit&) const {}
};

__device__ __forceinline__ unsigned cvt_pk_bf16(float lo, float hi) { unsigned r; asm volatile("v_cvt_pk_bf16_f32 %0, %1, %2" : "=v"(r) : "v"(lo), "v"(hi)); return r; }
template <class Epi, class Sched, bool ALIGN_EPI = false, bool SP2 = false>
__device__ __forceinline__ void gemm_phase(PG8_LAS unsigned char* lds, const Gemm g, const Sched& S, const Epi& E) {
    const int tid = threadIdx.x, wid = __builtin_amdgcn_readfirstlane(tid >> 6), lane = tid & 63, wr = wid >> 2, wc = wid & 3, fr = lane & 15, fq = lane >> 4;
    const int K = g.K, nt = K / BK;
    unsigned voffA[2], voffB[2];
#pragma unroll
    for (int i = 0; i < 2; ++i) { int R, C; stage_rc(tid * 16 + i * 8192, R, C); const int Rb = Epi::PERM ? ((R & ~31) + perm32(R & 31)) : R;
        voffA[i] = (unsigned)(R * K + C) * 2u; voffB[i] = (unsigned)(Rb * K + C) * 2u; }
    const size_t kstep = (size_t)(BK * 2);
    const size_t hstep = (size_t)HALF * K * 2;
    const size_t tstep = 2 * hstep;
    const unsigned ldsw = (unsigned)wid * 1024u;
    const int aoff = lds_byte(wr * 64 + fr, fq * 8), boff = lds_byte(wc * 32 + fr, fq * 8);
#define PG8_SA(b, h) (((b) * 2 + (h)) * HTB)
#define PG8_SB(b, h) ((4 + (b) * 2 + (h)) * HTB)
#define PG8_STAGE(bufoff, gbase, voff) do { _Pragma("unroll") for (int _i = 0; _i < 2; ++_i) \
        __builtin_amdgcn_global_load_lds((const unsigned*)((const char*)(gbase) + (voff)[_i]), (PG8_LAS unsigned*)(lds + (bufoff) + ldsw + _i * 8192), 16, 0, 0); } while (0)
#define PG8_LDA(dst, b, h) do { _Pragma("unroll") for (int m = 0; m < 4; ++m) _Pragma("unroll") for (int k = 0; k < 2; ++k) dst[m][k] = *(const PG8_LAS bf16x8*)(lds + PG8_SA(b, h) + aoff + m * 2048 + k * 1024); } while (0)
#define PG8_LDB(dst, b, h) do { _Pragma("unroll") for (int n = 0; n < 2; ++n) _Pragma("unroll") for (int k = 0; k < 2; ++k) dst[n][k] = *(const PG8_LAS bf16x8*)(lds + PG8_SB(b, h) + boff + n * 2048 + k * 1024); } while (0)
#define PG8_MMA(ai, bj, At, Bt) do { __builtin_amdgcn_s_setprio(1); _Pragma("unroll") for (int m = 0; m < 4; ++m) _Pragma("unroll") for (int n = 0; n < 2; ++n) _Pragma("unroll") for (int k = 0; k < 2; ++k) \
        acc[ai][bj][m][n] = __builtin_amdgcn_mfma_f32_16x16x32_bf16(Bt[n][k], At[m][k], acc[ai][bj][m][n], 0, 0, 0); __builtin_amdgcn_s_setprio(0); } while (0)
#define PG8_WAIT_V(n) asm volatile("s_waitcnt vmcnt(" #n ")" ::: "memory")
#define PG8_WAIT_L(n) asm volatile("s_waitcnt lgkmcnt(" #n ")" ::: "memory")
#define PG8_BAR __builtin_amdgcn_s_barrier()
#define PG8_SCHED __builtin_amdgcn_sched_barrier(0)
    Unit cur, nxt; int ui = 0;
    if (!S.next(0, cur)) return;
    f32x4 acc[2][2][4][2];
#pragma unroll
    for (int a = 0; a < 2; ++a)
#pragma unroll
        for (int b = 0; b < 2; ++b)
#pragma unroll
            for (int m = 0; m < 4; ++m)
#pragma unroll
                for (int n = 0; n < 2; ++n) acc[a][b][m][n] = (f32x4){0.f, 0.f, 0.f, 0.f};
    bf16x8 At[4][2], B0[2][2], B1[2][2];
    const char* cA = (const char*)g.A + (size_t)cur.pm * tstep + (size_t)cur.az * g.azs; const char* cB = (const char*)g.Bt + (size_t)cur.pn * tstep;
    S.a_ready(cur);
    if constexpr (SP2) {
        PG8_STAGE(PG8_SB(0, 0), cB, voffB); PG8_STAGE(PG8_SB(0, 1), cB + hstep, voffB); PG8_STAGE(PG8_SA(0, 0), cA, voffA); PG8_STAGE(PG8_SA(0, 1), cA + hstep, voffA);
        if (wr == 1) PG8_BAR;
        PG8_WAIT_V(2); PG8_BAR;
        PG8_STAGE(PG8_SB(1, 0), cB + kstep, voffB); PG8_STAGE(PG8_SA(1, 0), cA + kstep, voffA); PG8_STAGE(PG8_SB(1, 1), cB + hstep + kstep, voffB);
        PG8_WAIT_V(6); PG8_BAR;
    } else {
        PG8_STAGE(PG8_SB(0, 0), cB, voffB); PG8_STAGE(PG8_SA(0, 0), cA, voffA); PG8_STAGE(PG8_SB(0, 1), cB + hstep, voffB); PG8_STAGE(PG8_SA(0, 1), cA + hstep, voffA);
        if (wr == 1) PG8_BAR;
        PG8_WAIT_V(4); PG8_BAR;
        PG8_STAGE(PG8_SB(1, 0), cB + kstep, voffB); PG8_STAGE(PG8_SA(1, 0), cA + kstep, voffA); PG8_STAGE(PG8_SB(1, 1), cB + hstep + kstep, voffB);
        PG8_WAIT_V(6); PG8_BAR;
    }
    for (;;) {
        const bool has_next = S.next(ui + 1, nxt);
        const char* nA = has_next ? (const char*)g.A + (size_t)nxt.pm * tstep + (size_t)nxt.az * g.azs : cA; const char* nB = has_next ? (const char*)g.Bt + (size_t)nxt.pn * tstep : cB;
        for (int t = 0; t < nt; t += 2) {
            if constexpr (Epi::MIDK) { if (t == 8 || t == 16) E.mid(acc, cur, t >> 3, wr, wc, fr, fq); }
            const bool last = (t == nt - 2);
            const char* a1 = cA + (size_t)(t + 1) * kstep;
            const char* a2 = last ? nA : cA + (size_t)(t + 2) * kstep; const char* b2 = last ? nB : cB + (size_t)(t + 2) * kstep;
            const char* a3 = a2 + kstep; const char* b3 = b2 + kstep;
            if (last && has_next) S.a_ready(nxt);
            if constexpr (SP2) {
            PG8_LDB(B0, 0, 0); PG8_LDB(B1, 0, 1); PG8_SCHED; PG8_LDA(At, 0, 0); PG8_STAGE(PG8_SA(1, 1), a1 + hstep, voffA);
            PG8_WAIT_V(8); PG8_WAIT_L(0); PG8_BAR; PG8_MMA(0, 0, At, B0); PG8_MMA(0, 1, At, B1); PG8_BAR; PG8_SCHED;
            PG8_LDA(At, 0, 1); PG8_STAGE(PG8_SB(0, 0), b2, voffB); PG8_STAGE(PG8_SB(0, 1), b2 + hstep, voffB); PG8_STAGE(PG8_SA(0, 0), a2, voffA);
            PG8_WAIT_V(8); PG8_WAIT_L(0); PG8_BAR; PG8_MMA(1, 0, At, B0); PG8_MMA(1, 1, At, B1); PG8_BAR; PG8_SCHED;
            PG8_LDB(B0, 1, 0); PG8_LDB(B1, 1, 1); PG8_SCHED; PG8_LDA(At, 1, 0); PG8_STAGE(PG8_SA(0, 1), a2 + hstep, voffA);
            PG8_WAIT_V(8); PG8_WAIT_L(0); PG8_BAR; PG8_MMA(0, 0, At, B0); PG8_MMA(0, 1, At, B1); PG8_BAR; PG8_SCHED;
            PG8_LDA(At, 1, 1); PG8_STAGE(PG8_SB(1, 0), b3, voffB); PG8_STAGE(PG8_SB(1, 1), b3 + hstep, voffB); PG8_STAGE(PG8_SA(1, 0), a3, voffA);
            PG8_WAIT_V(8); PG8_WAIT_L(0); PG8_BAR; PG8_MMA(1, 0, At, B0); PG8_MMA(1, 1, At, B1); PG8_BAR; PG8_SCHED;
            } else {
            PG8_LDB(B0, 0, 0); PG8_SCHED; PG8_LDA(At, 0, 0); PG8_STAGE(PG8_SA(1, 1), a1 + hstep, voffA);
            PG8_WAIT_L(8); PG8_BAR; PG8_WAIT_L(0); PG8_MMA(0, 0, At, B0); PG8_BAR; PG8_SCHED;
            PG8_LDB(B1, 0, 1); PG8_STAGE(PG8_SB(0, 0), b2, voffB);
            PG8_BAR; PG8_WAIT_L(0); PG8_MMA(0, 1, At, B1); PG8_BAR;
            PG8_LDA(At, 0, 1); PG8_STAGE(PG8_SA(0, 0), a2, voffA);
            PG8_BAR; PG8_WAIT_L(0); PG8_MMA(1, 0, At, B0); PG8_BAR; PG8_SCHED;
            PG8_STAGE(PG8_SB(0, 1), b2 + hstep, voffB);
            PG8_WAIT_V(6); PG8_BAR; PG8_MMA(1, 1, At, B1); PG8_BAR;
            PG8_LDB(B0, 1, 0); PG8_SCHED; PG8_LDA(At, 1, 0); PG8_STAGE(PG8_SA(0, 1), a2 + hstep, voffA);
            PG8_WAIT_L(8); PG8_BAR; PG8_WAIT_L(0); PG8_MMA(0, 0, At, B0); PG8_BAR; PG8_SCHED;
            PG8_LDB(B1, 1, 1); PG8_STAGE(PG8_SB(1, 0), b3, voffB);
            PG8_BAR; PG8_WAIT_L(0); PG8_MMA(0, 1, At, B1); PG8_BAR;
            PG8_LDA(At, 1, 1); PG8_STAGE(PG8_SA(1, 0), a3, voffA);
            PG8_BAR; PG8_WAIT_L(0); PG8_MMA(1, 0, At, B0); PG8_BAR; PG8_SCHED;
            PG8_STAGE(PG8_SB(1, 1), b3 + hstep, voffB);
            PG8_WAIT_V(6); PG8_BAR; PG8_MMA(1, 1, At, B1); PG8_BAR;
            }
        }
        if constexpr (ALIGN_EPI) { if (wr == 0) PG8_BAR; }
        if constexpr (!Epi::AFTER_DRAIN) { E(acc, cur, wr, wc, fr, fq); S.done(cur); }
        if (!has_next) break;
#pragma unroll
        for (int a = 0; a < 2; ++a)
#pragma unroll
            for (int b = 0; b < 2; ++b)
#pragma unroll
                for (int m = 0; m < 4; ++m)
#pragma unroll
                    for (int n = 0; n < 2; ++n) acc[a][b][m][n] = (f32x4){0.f, 0.f, 0.f, 0.f};
        cur = nxt; cA = nA; cB = nB; ++ui;
        if constexpr (ALIGN_EPI) { if (wr == 1) PG8_BAR; }
    }
    PG8_WAIT_V(0);
    if constexpr (!ALIGN_EPI) { if (wr == 0) PG8_BAR; }
    PG8_BAR;
    if constexpr (Epi::AFTER_DRAIN) { E.fused(acc, cur, wr, wc, fr, fq, lds, wid, lane); S.done(cur); }
#undef PG8_SA
#undef PG8_SB
#undef PG8_STAGE
#undef PG8_LDA
#undef PG8_LDB
#undef PG8_MMA
#undef PG8_WAIT_V
#undef PG8_WAIT_L
#undef PG8_BAR
#undef PG8_SCHED
}
}

#define LAS __attribute__((address_space(3)))
typedef unsigned short bf16_t;
typedef short bf16x8 __attribute__((ext_vector_type(8)));
typedef short s16x4 __attribute__((ext_vector_type(4)));
typedef float f32x4 __attribute__((ext_vector_type(4)));
typedef float f32x16 __attribute__((ext_vector_type(16)));
typedef unsigned u32x4 __attribute__((ext_vector_type(4)));
typedef unsigned u32x2 __attribute__((ext_vector_type(2)));
constexpr int NB = 4, SEQ = 4096, DM = 1024, MTOK = NB * SEQ, NIN = 8192, BWID = 512, NLAYER = 2;
constexpr float RMS_EPS = 1e-6f;
constexpr size_t MiB = 1u << 20;
constexpr size_t WS_RS = 0;
constexpr size_t WS_W1 = 2 * MiB;
constexpr size_t WS_W2 = 34 * MiB;
constexpr size_t WS_W3 = 40 * MiB;
constexpr size_t WS_PW = 44 * MiB;
constexpr size_t WS_H = 45 * MiB;
constexpr size_t WS_U = 77 * MiB;
constexpr size_t ARRB = 16 * MiB;
constexpr size_t WS_MG = 205 * MiB;
constexpr size_t WS_END = 253 * MiB;
constexpr int LDS_BYTES = 147456;
constexpr int NPHASE = 1 + 5 * NLAYER;

__device__ __forceinline__ unsigned f2bf(float f) { unsigned u = __builtin_bit_cast(unsigned, f); return (u + 0x7fffu + ((u >> 16) & 1u)) >> 16; }
__device__ __forceinline__ unsigned pk2(float lo, float hi) { return f2bf(lo) | (f2bf(hi) << 16); }
__device__ __forceinline__ float bflo(unsigned u) { return __builtin_bit_cast(float, u << 16); }
__device__ __forceinline__ float bfhi(unsigned u) { return __builtin_bit_cast(float, u & 0xffff0000u); }
__device__ __forceinline__ float sigmoid_f(float x) { return __builtin_amdgcn_rcpf(1.f + __builtin_amdgcn_exp2f(-1.4426950408889634f * x)); }
__device__ __forceinline__ float silu_f(float x) { return x * sigmoid_f(x); }
__device__ __forceinline__ unsigned q8(float x) { const unsigned q = (unsigned)(sigmoid_f(x) * 255.f + 0.5f); return q < 1u ? 1u : q; }
__device__ __forceinline__ float wave_sum(float v) {
#pragma unroll
    for (int o = 1; o < 64; o <<= 1) v += __shfl_xor(v, o);
    return v;
}

constexpr size_t WS_CTL = 1 * MiB; constexpr size_t CTL_BYTES = 65536;
constexpr size_t CTL_CNT = 16384;
#define XB_TMO      128
#define XB_XCNT(j)  (256  + 64 * (j))
#define XB_XSUB(j)  (1280 + 64 * (j))
#define XB_XGEN(j)  (2304 + 64 * (j))
#define XB_TOP      3328
#define XB_TOPGEN   3392
#define XCD_BAR_WORDS 3456
#define XB_SPIN_CAP (1u << 18)

__device__ __forceinline__ unsigned xb_ld(unsigned* p)              { return __hip_atomic_load(p, __ATOMIC_RELAXED, __HIP_MEMORY_SCOPE_AGENT); }
__device__ __forceinline__ unsigned xb_add(unsigned* p, unsigned v) { return __hip_atomic_fetch_add(p, v, __ATOMIC_RELAXED, __HIP_MEMORY_SCOPE_AGENT); }
__device__ __forceinline__ unsigned xb_xcc_id() { return (unsigned)__builtin_amdgcn_s_getreg((3 << 11) | 20) & 0xFu; }
#define XB_SPIN(cond, bar) do { unsigned _sp = 0; while (cond) { __builtin_amdgcn_s_sleep(1); \
    if ((++_sp & 255u) == 0u) { if (xb_ld(&(bar)[XB_TMO])) break; if (_sp > XB_SPIN_CAP) { atomicAdd(&(bar)[XB_TMO], 1u); break; } } } } while (0)

struct XcdBarrier {
    unsigned* bar; unsigned x;
    volatile LAS unsigned* st;
};

__device__ __forceinline__ XcdBarrier xcd_barrier_post(unsigned* bar, volatile LAS unsigned* st) {
    XcdBarrier b; b.bar = bar; b.x = xb_xcc_id(); b.st = st;
    if (threadIdx.x == 0) (void)xb_add(&bar[XB_XCNT(b.x)], 1u);
    return b;
}
__device__ __forceinline__ void xcd_barrier_complete(unsigned* bar, unsigned x, unsigned& nloc, unsigned& nx) {
    const unsigned G = gridDim.x * gridDim.y * gridDim.z;
    unsigned sum, cnt, mine, sp = 0u;
    for (;;) {
        sum = 0u; cnt = 0u; mine = 0u;
#pragma unroll
        for (unsigned j = 0; j < 16; ++j) { const unsigned c = xb_ld(&bar[XB_XCNT(j)]); sum += c; cnt += (c > 0u) ? 1u : 0u; mine = (j == x) ? c : mine; }
        if (sum == G) break;
        __builtin_amdgcn_s_sleep(1);
        if ((++sp & 255u) == 0u) { if (xb_ld(&bar[XB_TMO])) break; if (sp > XB_SPIN_CAP) { atomicAdd(&bar[XB_TMO], 1u); break; } }
    }
    nloc = mine > 0u ? mine : 1u; nx = cnt > 0u ? cnt : 1u;
}

__device__ __forceinline__ void xcd_barrier(const XcdBarrier& b) {
    asm volatile("s_waitcnt vmcnt(0)" ::: "memory");
    __syncthreads();
    if (threadIdx.x == 0) {
        unsigned* bar = b.bar;
        __builtin_amdgcn_s_waitcnt(0);
        unsigned nloc = b.st[0], nx = b.st[1];
        if (nloc == 0u) { xcd_barrier_complete(bar, b.x, nloc, nx); b.st[0] = nloc; b.st[1] = nx; }
        const unsigned old = xb_add(&bar[XB_XSUB(b.x)], 1u);
        const unsigned gen = old / nloc;
        if (old + 1u == (gen + 1u) * nloc) {
            __builtin_amdgcn_fence(__ATOMIC_RELEASE, "agent");
            asm volatile("s_waitcnt vmcnt(0)" ::: "memory");
            const unsigned og = xb_add(&bar[XB_TOP], 1u);
            const unsigned tg = og / nx;
            if (og + 1u == (tg + 1u) * nx) xb_add(&bar[XB_TOPGEN], 1u);
            else XB_SPIN(xb_ld(&bar[XB_TOPGEN]) == tg, bar);
            __builtin_amdgcn_fence(__ATOMIC_ACQUIRE, "agent");
            xb_add(&bar[XB_XGEN(b.x)], 1u);
            asm volatile("s_waitcnt vmcnt(0)" ::: "memory");
        } else {
            XB_SPIN(xb_ld(&bar[XB_XGEN(b.x)]) == gen, bar);
            __builtin_amdgcn_fence(__ATOMIC_ACQUIRE, "agent");
            asm volatile("s_waitcnt vmcnt(0)" ::: "memory");
        }
    }
    __syncthreads();
}


using pg8::Unit;
struct EpiU {
    static constexpr bool PERM = true, AFTER_DRAIN = false, MIDK = false;
    unsigned char* ws;
    __device__ __forceinline__ void operator()(const f32x4 (&acc)[2][2][4][2], const Unit& u, int wr, int wc, int fr, int fq) const {
        bf16_t* U = (bf16_t*)(ws + WS_U); unsigned char* MG = ws + WS_MG;
        const int pn = u.pn; const int row0 = u.pm * 256 + wr * 64 + fr;
        if (pn >= 20) {
            unsigned char* tb = MG + ((size_t)u.pm * 12 + (pn - 20)) * 65536 + (size_t)(((wr * 4 + wc) * 16) * 64 + (fq * 16 + fr)) * 8;
#pragma unroll
            for (int ai = 0; ai < 2; ++ai)
#pragma unroll
                for (int m = 0; m < 4; ++m)
#pragma unroll
                    for (int bj = 0; bj < 2; ++bj) { const f32x4 v0 = acc[ai][bj][m][0], v1 = acc[ai][bj][m][1]; u32x2 w;
                        w.x = q8(v0[0]) | (q8(v0[1]) << 8) | (q8(v0[2]) << 16) | (q8(v0[3]) << 24); w.y = q8(v1[0]) | (q8(v1[1]) << 8) | (q8(v1[2]) << 16) | (q8(v1[3]) << 24);
                        *(u32x2*)(tb + ((ai * 4 + m) * 2 + bj) * 512) = w; }
        } else if (pn >= 4 && pn < 12) {
            const int ch0 = (pn - 4) * 64 + (4 * wc + fq) * 4;
            bf16_t* Z = U + 1 * (ARRB / 2); bf16_t* W = U + 5 * (ARRB / 2) + 512;
#pragma unroll
            for (int ai = 0; ai < 2; ++ai)
#pragma unroll
                for (int m = 0; m < 4; ++m) { const size_t rr = (size_t)(row0 + ai * 128 + m * 16); const size_t ro = rr * 512 + ch0, rw = rr * 1536 + ch0;
                    const f32x4 z = acc[ai][0][m][0] * acc[ai][0][m][1]; const f32x4 gb = acc[ai][1][m][0], gg = acc[ai][1][m][1];
                    u32x2 zz, ww; zz.x = pg8::cvt_pk_bf16(z[0], z[1]); zz.y = pg8::cvt_pk_bf16(z[2], z[3]);
                    ww.x = pg8::cvt_pk_bf16(gb[0] * silu_f(gg[0]), gb[1] * silu_f(gg[1])); ww.y = pg8::cvt_pk_bf16(gb[2] * silu_f(gg[2]), gb[3] * silu_f(gg[3]));
                    *(u32x2*)(Z + ro) = zz; *(u32x2*)(W + rw) = ww; }
        } else {
            const int kind = pn >> 1; int arr = 0, pitch = 512, coff = 0; bool act = false;
            if (kind == 1) { arr = 5; act = true; pitch = 1536; } else if (kind == 6) arr = 2; else if (kind == 7) arr = 3; else if (kind == 8) arr = 4; else if (kind == 9) { arr = 5; act = true; pitch = 1536; coff = 1024; }
            bf16_t* O = U + (size_t)arr * (ARRB / 2) + coff; const int col0 = (pn & 1) * 256 + wc * 32 + 8 * fq;
#pragma unroll
            for (int ai = 0; ai < 2; ++ai)
#pragma unroll
                for (int m = 0; m < 4; ++m) { bf16_t* rp = O + (size_t)(row0 + ai * 128 + m * 16) * pitch + col0;
#pragma unroll
                    for (int bj = 0; bj < 2; ++bj) { f32x4 v0 = acc[ai][bj][m][0], v1 = acc[ai][bj][m][1];
                        if (act) {
#pragma unroll
                            for (int i = 0; i < 4; ++i) { v0[i] = silu_f(v0[i]); v1[i] = silu_f(v1[i]); } }
                        u32x4 w; w.x = pg8::cvt_pk_bf16(v0[0], v0[1]); w.y = pg8::cvt_pk_bf16(v0[2], v0[3]); w.z = pg8::cvt_pk_bf16(v1[0], v1[1]); w.w = pg8::cvt_pk_bf16(v1[2], v1[3]);
                        *(u32x4*)(rp + bj * 128) = w; } }
        }
    }
};
struct EpiBranch {
    static constexpr bool PERM = true, AFTER_DRAIN = false, MIDK = true;
    unsigned char* ws;
    __device__ __forceinline__ void mid(f32x4 (&acc)[2][2][4][2], const Unit& u, int seg, int wr, int wc, int fr, int fq) const {
        int tid_ = threadIdx.x; asm volatile("" : "+v"(tid_));
        const int wid_ = tid_ >> 6, wr_ = wid_ >> 2, wc_ = wid_ & 3, fr_ = tid_ & 15, fq_ = (tid_ & 63) >> 4;
        const unsigned char* tb = ws + WS_MG + ((size_t)u.pm * 12 + (seg - 1) * 4 + u.pn) * 65536 + (size_t)(((wr_ * 4 + wc_) * 16) * 64 + (fq_ * 16 + fr_)) * 8;
#pragma unroll
        for (int ai = 0; ai < 2; ++ai)
#pragma unroll
            for (int m = 0; m < 4; ++m) {
#pragma unroll
                for (int bj = 0; bj < 2; ++bj) { const unsigned char* rp = tb + ((ai * 4 + m) * 2 + bj) * 512; const u32x2 qa = *(const u32x2*)rp, qb = *(const u32x2*)(rp + 4 * 65536);
                    f32x4 r0, r1;
                    r0[0] = (float)(qa.x & 255u) * __builtin_amdgcn_rcpf((float)(qb.x & 255u)); r0[1] = (float)((qa.x >> 8) & 255u) * __builtin_amdgcn_rcpf((float)((qb.x >> 8) & 255u));
                    r0[2] = (float)((qa.x >> 16) & 255u) * __builtin_amdgcn_rcpf((float)((qb.x >> 16) & 255u)); r0[3] = (float)(qa.x >> 24) * __builtin_amdgcn_rcpf((float)(qb.x >> 24));
                    r1[0] = (float)(qa.y & 255u) * __builtin_amdgcn_rcpf((float)(qb.y & 255u)); r1[1] = (float)((qa.y >> 8) & 255u) * __builtin_amdgcn_rcpf((float)((qb.y >> 8) & 255u));
                    r1[2] = (float)((qa.y >> 16) & 255u) * __builtin_amdgcn_rcpf((float)((qb.y >> 16) & 255u)); r1[3] = (float)(qa.y >> 24) * __builtin_amdgcn_rcpf((float)(qb.y >> 24));
                    acc[ai][bj][m][0] *= r0; acc[ai][bj][m][1] *= r1; }
                if (m == 3) asm volatile("" ::: "memory"); }
    }
    __device__ __forceinline__ void operator()(const f32x4 (&acc)[2][2][4][2], const Unit& u, int wr, int wc, int fr, int fq) const {
        bf16_t* merged = (bf16_t*)(ws + WS_H);
        const unsigned char* tb = ws + WS_MG + ((size_t)u.pm * 12 + 8 + u.pn) * 65536 + (size_t)(((wr * 4 + wc) * 16) * 64 + (fq * 16 + fr)) * 8;
        const int row0 = u.pm * 256 + wr * 64 + fr, col0 = u.pn * 256 + wc * 32 + 8 * fq;
        u32x2 gq[2][4][2];
#pragma unroll
        for (int ai = 0; ai < 2; ++ai)
#pragma unroll
            for (int m = 0; m < 4; ++m)
#pragma unroll
                for (int bj = 0; bj < 2; ++bj) gq[ai][m][bj] = *(const u32x2*)(tb + ((ai * 4 + m) * 2 + bj) * 512);
#pragma unroll
        for (int ai = 0; ai < 2; ++ai)
#pragma unroll
            for (int m = 0; m < 4; ++m) { const size_t row = (size_t)(row0 + ai * 128 + m * 16);
#pragma unroll
                for (int bj = 0; bj < 2; ++bj) { const int col = col0 + bj * 128; const u32x2 g = gq[ai][m][bj];
                    f32x4 g0, g1; const float k = 1.f / 255.f;
                    g0[0] = (float)(g.x & 255u) * k; g0[1] = (float)((g.x >> 8) & 255u) * k; g0[2] = (float)((g.x >> 16) & 255u) * k; g0[3] = (float)(g.x >> 24) * k;
                    g1[0] = (float)(g.y & 255u) * k; g1[1] = (float)((g.y >> 8) & 255u) * k; g1[2] = (float)((g.y >> 16) & 255u) * k; g1[3] = (float)(g.y >> 24) * k;
                    const f32x4 v0 = acc[ai][bj][m][0] * g0, v1 = acc[ai][bj][m][1] * g1;
                    u32x4 w; w.x = pg8::cvt_pk_bf16(v0[0], v0[1]); w.y = pg8::cvt_pk_bf16(v0[2], v0[3]); w.z = pg8::cvt_pk_bf16(v1[0], v1[1]); w.w = pg8::cvt_pk_bf16(v1[2], v1[3]);
                    *(u32x4*)(merged + row * 1024 + col) = w; } }
    }
};
struct EpiOut {
    static constexpr bool PERM = false, AFTER_DRAIN = false, MIDK = false;
    unsigned char* ws;
    __device__ __forceinline__ void operator()(const f32x4 (&acc)[2][2][4][2], const Unit& u, int wr, int wc, int fr, int fq) const {
        float* out = (float*)(ws + WS_U); float* rs = (float*)(ws + WS_RS);
        const int row0 = u.pm * 256 + wr * 64 + fr, col0 = u.pn * 256 + wc * 32 + 4 * fq;
#pragma unroll
        for (int ai = 0; ai < 2; ++ai)
#pragma unroll
            for (int m = 0; m < 4; ++m) { const size_t row = (size_t)(row0 + ai * 128 + m * 16); float ss = 0.f;
#pragma unroll
                for (int bj = 0; bj < 2; ++bj)
#pragma unroll
                    for (int n = 0; n < 2; ++n) { const f32x4 v = acc[ai][bj][m][n]; *(f32x4*)(out + row * 1024 + col0 + bj * 128 + n * 16) = v; ss += (v[0] * v[0] + v[1] * v[1]) + (v[2] * v[2] + v[3] * v[3]); }
                ss += __shfl_xor(ss, 16); ss += __shfl_xor(ss, 32);
                if (fq == 0) rs[row * 16 + u.pn * 4 + wc] = ss; }
    }
};

struct RmsPanel {
    float* xbuf;
    unsigned* cnt;
    __device__ __forceinline__ void run(const f32x4 (&v)[2][2][4][2], const Unit& u, int wr, int wc, int fr, int fq, LAS unsigned char* lds, int wid, int lane) const {
        LAS float* P = (LAS float*)lds; LAS float* S = (LAS float*)(lds + 8192);
#pragma unroll
        for (int ai = 0; ai < 2; ++ai)
#pragma unroll
            for (int m = 0; m < 4; ++m) { float s = 0.f;
#pragma unroll
                for (int bj = 0; bj < 2; ++bj)
#pragma unroll
                    for (int n = 0; n < 2; ++n) { const f32x4 x = v[ai][bj][m][n]; s += (x[0] * x[0] + x[1] * x[1]) + (x[2] * x[2] + x[3] * x[3]); }
                s += __shfl_xor(s, 16); s += __shfl_xor(s, 32);
                if (fq == 0) P[(ai * 128 + wr * 64 + m * 16 + fr) * 4 + wc] = s; }
        asm volatile("s_waitcnt lgkmcnt(0)" ::: "memory"); __builtin_amdgcn_s_barrier(); asm volatile("" ::: "memory");
        const int row = wid * 32 + (lane & 31);
        if (lane < 32) { const float t = (P[row * 4 + 0] + P[row * 4 + 1]) + (P[row * 4 + 2] + P[row * 4 + 3]);
            __hip_atomic_store(xbuf + (size_t)(u.pm * 256 + row) * 4 + u.pn, t, __ATOMIC_RELAXED, __HIP_MEMORY_SCOPE_AGENT); }
        asm volatile("s_waitcnt vmcnt(0)" ::: "memory");
        if (lane == 0) __hip_atomic_fetch_add(cnt + 64 * u.pm, 1u, __ATOMIC_RELAXED, __HIP_MEMORY_SCOPE_AGENT);
        if (wid == 0) {
            unsigned sp = 0;
            while ((unsigned)__builtin_amdgcn_readfirstlane(__hip_atomic_load(cnt + 64 * u.pm, __ATOMIC_RELAXED, __HIP_MEMORY_SCOPE_AGENT)) < 32u) { __builtin_amdgcn_s_sleep(2); if (++sp > (1u << 22)) break; }
            __builtin_amdgcn_fence(__ATOMIC_ACQUIRE, "agent");
        }
        asm volatile("s_waitcnt vmcnt(0) lgkmcnt(0)" ::: "memory"); __builtin_amdgcn_s_barrier(); asm volatile("" ::: "memory");
        if (lane < 32) { const float* slot = xbuf + (size_t)(u.pm * 256 + row) * 4; float t = 0.f;
#pragma unroll
            for (int k = 0; k < 4; ++k) t += __hip_atomic_load(slot + k, __ATOMIC_RELAXED, __HIP_MEMORY_SCOPE_AGENT);
            S[row] = 1.0f / sqrtf(t * (1.f / DM) + RMS_EPS); }
        asm volatile("s_waitcnt lgkmcnt(0)" ::: "memory"); __builtin_amdgcn_s_barrier(); asm volatile("" ::: "memory");
    }
};
struct EpiNorm1 {
    static constexpr bool PERM = false, AFTER_DRAIN = true, MIDK = false;
    float* out; const float* gpost; RmsPanel st;
    __device__ __forceinline__ void operator()(const f32x4 (&)[2][2][4][2], const Unit&, int, int, int, int) const {}
    __device__ __forceinline__ void fused(f32x4 (&acc)[2][2][4][2], const Unit& u, int wr, int wc, int fr, int fq, LAS unsigned char* lds, int wid, int lane) const {
        const LAS float* S = (const LAS float*)(lds + 8192);
        const int col0 = u.pn * 256 + wc * 32 + 4 * fq, jl0 = wc * 32 + 4 * fq;
        f32x4 gp[2][2]; u32x2 pre[2][4][2][2];
#pragma unroll
        for (int bj = 0; bj < 2; ++bj)
#pragma unroll
            for (int n = 0; n < 2; ++n) gp[bj][n] = *(const f32x4*)(gpost + col0 + bj * 128 + n * 16);
#pragma unroll
        for (int ai = 0; ai < 2; ++ai)
#pragma unroll
            for (int m = 0; m < 4; ++m) { const unsigned char* ob = (const unsigned char*)out + (size_t)(u.pm * 256 + ai * 128 + wr * 64 + m * 16 + fr) * 4096 + u.pn * 1024;
#pragma unroll
                for (int bj = 0; bj < 2; ++bj)
#pragma unroll
                    for (int n = 0; n < 2; ++n) pre[ai][m][bj][n] = *(const u32x2*)(ob + 2 * (jl0 + bj * 128 + n * 16)); }
        st.run(acc, u, wr, wc, fr, fq, lds, wid, lane);
#pragma unroll
        for (int ai = 0; ai < 2; ++ai)
#pragma unroll
            for (int m = 0; m < 4; ++m) { const int r = ai * 128 + wr * 64 + m * 16 + fr; const float rs = S[r]; const size_t off = (size_t)(u.pm * 256 + r) * DM + col0;
#pragma unroll
                for (int bj = 0; bj < 2; ++bj)
#pragma unroll
                    for (int n = 0; n < 2; ++n) { const u32x2 p = pre[ai][m][bj][n]; const f32x4 bs = (f32x4){bflo(p.x), bfhi(p.x), bflo(p.y), bfhi(p.y)};
                        *(f32x4*)(out + off + bj * 128 + n * 16) = bs + acc[ai][bj][m][n] * rs * gp[bj][n]; } }
    }
};
struct EpiNorm2 {
    static constexpr bool PERM = false, AFTER_DRAIN = true, MIDK = false;
    const float* base; float* out; bf16_t* hn; const float* gpost; const float* gnext; RmsPanel st1, st2;
    __device__ __forceinline__ void operator()(const f32x4 (&)[2][2][4][2], const Unit&, int, int, int, int) const {}
    __device__ __forceinline__ void fused(f32x4 (&acc)[2][2][4][2], const Unit& u, int wr, int wc, int fr, int fq, LAS unsigned char* lds, int wid, int lane) const {
        const LAS float* S = (const LAS float*)(lds + 8192);
        const int col0 = u.pn * 256 + wc * 32 + 4 * fq;
        f32x4 gp[2][2], pre[4][2][2];
#pragma unroll
        for (int bj = 0; bj < 2; ++bj)
#pragma unroll
            for (int n = 0; n < 2; ++n) gp[bj][n] = *(const f32x4*)(gpost + col0 + bj * 128 + n * 16);
#pragma unroll
        for (int m = 0; m < 4; ++m)
#pragma unroll
            for (int bj = 0; bj < 2; ++bj)
#pragma unroll
                for (int n = 0; n < 2; ++n) pre[m][bj][n] = *(const f32x4*)(base + (size_t)(u.pm * 256 + wr * 64 + m * 16 + fr) * DM + col0 + bj * 128 + n * 16);
        st1.run(acc, u, wr, wc, fr, fq, lds, wid, lane);
#pragma unroll
        for (int ai = 0; ai < 2; ++ai) {
            if (ai == 1) {
#pragma unroll
                for (int m = 0; m < 4; ++m)
#pragma unroll
                    for (int bj = 0; bj < 2; ++bj)
#pragma unroll
                        for (int n = 0; n < 2; ++n) pre[m][bj][n] = *(const f32x4*)(base + (size_t)(u.pm * 256 + 128 + wr * 64 + m * 16 + fr) * DM + col0 + bj * 128 + n * 16);
            }
#pragma unroll
            for (int m = 0; m < 4; ++m) { const int r = ai * 128 + wr * 64 + m * 16 + fr; const float rs = S[r]; const size_t off = (size_t)(u.pm * 256 + r) * DM + col0;
#pragma unroll
                for (int bj = 0; bj < 2; ++bj)
#pragma unroll
                    for (int n = 0; n < 2; ++n) { const f32x4 x1 = pre[m][bj][n] + acc[ai][bj][m][n] * rs * gp[bj][n]; acc[ai][bj][m][n] = x1;
                        u32x2 w; w.x = pg8::cvt_pk_bf16(x1[0], x1[1]); w.y = pg8::cvt_pk_bf16(x1[2], x1[3]);
                        *(u32x2*)((unsigned char*)out + (size_t)(u.pm * 256 + r) * 4096 + u.pn * 1024 + 2 * (wc * 32 + 4 * fq + bj * 128 + n * 16)) = w; } }
        }
#pragma unroll
        for (int bj = 0; bj < 2; ++bj)
#pragma unroll
            for (int n = 0; n < 2; ++n) gp[bj][n] = *(const f32x4*)(gnext + col0 + bj * 128 + n * 16);
        st2.run(acc, u, wr, wc, fr, fq, lds, wid, lane);
#pragma unroll
        for (int ai = 0; ai < 2; ++ai)
#pragma unroll
            for (int m = 0; m < 4; ++m) { const int r = ai * 128 + wr * 64 + m * 16 + fr; const float rs = S[r]; const size_t off = (size_t)(u.pm * 256 + r) * DM + col0;
#pragma unroll
                for (int bj = 0; bj < 2; ++bj)
#pragma unroll
                    for (int n = 0; n < 2; ++n) { const f32x4 o = acc[ai][bj][m][n] * rs * gp[bj][n];
                        u32x2 w; w.x = pg8::cvt_pk_bf16(o[0], o[1]); w.y = pg8::cvt_pk_bf16(o[2], o[3]); *(u32x2*)(hn + off + bj * 128 + n * 16) = w; } }
    }
};
__device__ __forceinline__ int win_row(int c) {
    if (c < 1024 || c >= 3072) return c;
    const int q = (c - 1024) >> 9, ch = (c - 1024) & 511, ct = ch >> 6, grp = (ch & 63) >> 2, e = ch & 3;
    return 1024 + ct * 256 + (q & 1) * 128 + grp * 8 + (q >> 1) * 4 + e;
}
__device__ __forceinline__ void transpose_item(const float* W, int N, bf16_t* WT, int ldt, int koff, int row_off, bool winmap, LAS float* scr, int item, int lane, const float* rscale = nullptr) {
    const int nblk = N / 64, kb = item / nblk, nb = item % nblk, k0 = 64 * kb, n0 = 64 * nb;
    const int kq = lane >> 4, nq = lane & 15;
    f32x4 v[16];
#pragma unroll
    for (int i = 0; i < 16; ++i) v[i] = *(const f32x4*)(W + (size_t)(k0 + 4 * i + kq) * N + n0 + 4 * nq);
#pragma unroll
    for (int i = 0; i < 16; ++i) { LAS float* s = scr + (4 * i + kq) * 65 + 4 * nq; s[0] = v[i][0]; s[1] = v[i][1]; s[2] = v[i][2]; s[3] = v[i][3]; }
    asm volatile("s_waitcnt lgkmcnt(0)" ::: "memory");
    const int c = lane & 7;
#pragma unroll
    for (int j = 0; j < 8; ++j) { const int n = (lane >> 3) + 8 * j;
        const LAS float* s = scr + (rscale ? (16 * (c >> 1) + 4 * (c & 1)) : 8 * c) * 65 + n; const int hs = rscale ? 8 * 65 : 4 * 65; const float f = rscale ? rscale[n0 + n] : 1.f;
        u32x4 o; o.x = pg8::cvt_pk_bf16(s[0 * 65] * f, s[1 * 65] * f); o.y = pg8::cvt_pk_bf16(s[2 * 65] * f, s[3 * 65] * f); o.z = pg8::cvt_pk_bf16(s[hs] * f, s[hs + 65] * f); o.w = pg8::cvt_pk_bf16(s[hs + 2 * 65] * f, s[hs + 3 * 65] * f);
        int dst = n0 + n; if (winmap) dst = win_row(dst);
        if (rscale) *(u32x4*)(WT + (size_t)((((dst >> 5) * 8 + ((k0 + 8 * c) >> 4)) * 64 + (c & 1) * 32 + (dst & 31)) * 8)) = o;
        else *(u32x4*)(WT + (size_t)(row_off + dst) * ldt + koff + k0 + 8 * c) = o; }
    asm volatile("s_waitcnt lgkmcnt(0)" ::: "memory");
}
template <int R> __device__ __forceinline__ void rms_rows_to_bf16(const float* x, const float* g, bf16_t* H, int m0, int mstride, int lane) {
    f32x4 v[R][4];
#pragma unroll
    for (int r = 0; r < R; ++r)
#pragma unroll
        for (int j = 0; j < 4; ++j) v[r][j] = ((const f32x4*)(x + (size_t)(m0 + r * mstride) * DM))[64 * j + lane];
    f32x4 gg[4];
#pragma unroll
    for (int j = 0; j < 4; ++j) gg[j] = ((const f32x4*)g)[64 * j + lane];
#pragma unroll
    for (int r = 0; r < R; ++r) { float s = 0.f;
#pragma unroll
        for (int j = 0; j < 4; ++j) s += (v[r][j][0] * v[r][j][0] + v[r][j][1] * v[r][j][1]) + (v[r][j][2] * v[r][j][2] + v[r][j][3] * v[r][j][3]);
        const float rstd = 1.f / sqrtf(wave_sum(s) * (1.f / DM) + RMS_EPS);
        u32x2* o8 = (u32x2*)(H + (size_t)(m0 + r * mstride) * DM) + lane;
#pragma unroll
        for (int j = 0; j < 4; ++j) { u32x2 w; w.x = pg8::cvt_pk_bf16(v[r][j][0] * rstd * gg[j][0], v[r][j][1] * rstd * gg[j][1]); w.y = pg8::cvt_pk_bf16(v[r][j][2] * rstd * gg[j][2], v[r][j][3] * rstd * gg[j][3]); o8[64 * j] = w; } }
}

__device__ __forceinline__ int crow(int r, int hi) { return (r & 3) + 8 * (r >> 2) + 4 * hi; }
constexpr int VROW = 144;
__device__ __forceinline__ void attn_item(int item, const bf16_t* Q, const bf16_t* K, const bf16_t* V, const bf16_t* SG, bf16_t* YO, LAS unsigned char* vl, LAS unsigned char* kl, int lane) {
    const int qg = item & 127, h = (item >> 7) & 7, b = item >> 10;
    const int r32 = lane & 31, hi = lane >> 5, t0 = qg * 32;
    const size_t tokq = (size_t)b * SEQ + t0 + r32;
    bf16x8 qf[4];
    { const size_t tq0 = (size_t)b * SEQ + t0;
#pragma unroll
      for (int p = 0; p < 4; ++p) { const int idx = p * 64 + lane; const u32x4 v = *(const u32x4*)(Q + (tq0 + (idx >> 3)) * 512 + h * 64 + (idx & 7) * 8); *(LAS u32x4*)(kl + (idx >> 3) * VROW + (idx & 7) * 16) = v; }
#pragma unroll
      for (int d0 = 0; d0 < 4; ++d0) qf[d0] = *(const LAS bf16x8*)(kl + r32 * VROW + d0 * 32 + hi * 16); }
    f32x16 o0, o1;
#pragma unroll
    for (int r = 0; r < 16; ++r) { o0[r] = 0.f; o1[r] = 0.f; }
    float P = 1.f;
    const int i16 = lane & 15, G4 = lane >> 4;
    const int vb = (4 * (G4 >> 1) + (i16 >> 2)) * VROW + (16 * (G4 & 1) + 4 * (i16 & 3)) * 2;
#define ATT_LOAD(KF, VR, S0) do { const size_t tk_ = (size_t)b * SEQ + ((S0) > 0 ? (S0) : 0); \
        _Pragma("unroll") for (int p = 0; p < 4; ++p) { const int idx = p * 64 + lane; KF[p] = *(const u32x4*)(K + (tk_ + (idx >> 3)) * 512 + h * 64 + (idx & 7) * 8); \
                                                         VR[p] = *(const u32x4*)(V + (tk_ + (idx >> 3)) * 512 + h * 64 + (idx & 7) * 8); } } while (0)
    u32x4 kf[4], kn[4]; u32x4 vr[4], vn[4];
    ATT_LOAD(kf, vr, t0); ATT_LOAD(kn, vn, t0 - 32);
    u32x4 sgr[4];
#pragma unroll
    for (int p = 0; p < 4; ++p) { const int idx = p * 64 + lane; sgr[p] = *(const u32x4*)(SG + ((size_t)b * SEQ + t0 + (idx >> 3)) * 1536 + h * 64 + (idx & 7) * 8); }
    for (int s0 = t0; s0 >= 0; s0 -= 32) {
#pragma unroll
        for (int p = 0; p < 4; ++p) { const int idx = p * 64 + lane, key = idx >> 3, ch = idx & 7; *(LAS u32x4*)(vl + key * VROW + ch * 16) = vr[p]; *(LAS u32x4*)(kl + key * VROW + ch * 16) = kf[p]; }
        f32x16 s;
#pragma unroll
        for (int r = 0; r < 16; ++r) s[r] = 0.f;
#pragma unroll
        for (int d0 = 0; d0 < 4; ++d0) s = __builtin_amdgcn_mfma_f32_32x32x16_bf16(*(const LAS bf16x8*)(kl + r32 * VROW + d0 * 32 + hi * 16), qf[d0], s, 0, 0, 0);
        const bool diag = (s0 == t0);
        float kp[16];
#pragma unroll
        for (int r = 0; r < 16; ++r) { const float e = __builtin_amdgcn_exp2f(s[r] * (0.125f * 1.4426950408889634f)); float k = __builtin_amdgcn_rcpf(1.f + e);
            if (diag && crow(r, hi) >= r32) k = 1.f; kp[r] = k; }
        float Gm[4], Go[4], T[4], R[4], C[4];
#pragma unroll
        for (int g = 0; g < 4; ++g) { Gm[g] = (kp[4 * g] * kp[4 * g + 1]) * (kp[4 * g + 2] * kp[4 * g + 3]); Go[g] = __shfl_xor(Gm[g], 32); T[g] = Gm[g] * Go[g]; }
        R[3] = P; R[2] = R[3] * T[3]; R[1] = R[2] * T[2]; R[0] = R[1] * T[1]; const float Cout = R[0] * T[0];
#pragma unroll
        for (int g = 0; g < 4; ++g) C[g] = hi ? R[g] : R[g] * Go[g];
        float w[16];
#pragma unroll
        for (int g = 0; g < 4; ++g) { const float p3 = C[g], p2 = p3 * kp[4 * g + 3], p1 = p2 * kp[4 * g + 2], p0 = p1 * kp[4 * g + 1], pe = p0 * kp[4 * g];
            w[4 * g + 3] = p3 - p2; w[4 * g + 2] = p2 - p1; w[4 * g + 1] = p1 - p0; w[4 * g] = p0 - pe; }
        bf16x8 wf[2];
#pragma unroll
        for (int st = 0; st < 2; ++st) { u32x4 t; t.x = pg8::cvt_pk_bf16(w[8 * st], w[8 * st + 1]); t.y = pg8::cvt_pk_bf16(w[8 * st + 2], w[8 * st + 3]); t.z = pg8::cvt_pk_bf16(w[8 * st + 4], w[8 * st + 5]); t.w = pg8::cvt_pk_bf16(w[8 * st + 6], w[8 * st + 7]); wf[st] = __builtin_bit_cast(bf16x8, t); }
#pragma unroll
        for (int dt = 0; dt < 2; ++dt)
#pragma unroll
            for (int st = 0; st < 2; ++st) {
                const s16x4 lo = __builtin_amdgcn_ds_read_tr16_b64_v4i16((LAS s16x4*)(vl + vb + (16 * st) * VROW + dt * 64));
                const s16x4 hh = __builtin_amdgcn_ds_read_tr16_b64_v4i16((LAS s16x4*)(vl + vb + (16 * st + 8) * VROW + dt * 64));
                const bf16x8 vf = (bf16x8){lo[0], lo[1], lo[2], lo[3], hh[0], hh[1], hh[2], hh[3]};
                if (dt == 0) o0 = __builtin_amdgcn_mfma_f32_32x32x16_bf16(vf, wf[st], o0, 0, 0, 0); else o1 = __builtin_amdgcn_mfma_f32_32x32x16_bf16(vf, wf[st], o1, 0, 0, 0); }
        P = Cout;
        if (__all(P < 1.17549435e-38f)) break;
#pragma unroll
        for (int i = 0; i < 4; ++i) { kf[i] = kn[i]; vr[i] = vn[i]; }
        ATT_LOAD(kn, vn, s0 - 64);
    }
#undef ATT_LOAD
#pragma unroll
    for (int p = 0; p < 4; ++p) { const int idx = p * 64 + lane; *(LAS u32x4*)(kl + (idx >> 3) * VROW + (idx & 7) * 16) = sgr[p]; }
#pragma unroll
    for (int dt = 0; dt < 2; ++dt)
#pragma unroll
        for (int g = 0; g < 4; ++g) { LAS u32x2* p = (LAS u32x2*)(kl + r32 * VROW + (dt * 32 + 8 * g + 4 * hi) * 2); const u32x2 sg = *p;
            const f32x16& o = dt ? o1 : o0; u32x2 y;
            y.x = pg8::cvt_pk_bf16(o[4 * g] * bflo(sg.x), o[4 * g + 1] * bfhi(sg.x)); y.y = pg8::cvt_pk_bf16(o[4 * g + 2] * bflo(sg.y), o[4 * g + 3] * bfhi(sg.y));
            *p = y; }
#pragma unroll
    for (int p = 0; p < 4; ++p) { const int idx = p * 64 + lane; const u32x4 v = *(const LAS u32x4*)(kl + (idx >> 3) * VROW + (idx & 7) * 16);
        *(u32x4*)(YO + ((size_t)b * SEQ + t0 + (idx >> 3)) * 1536 + h * 64 + (idx & 7) * 8) = v; }
}
constexpr int PROW = 272;
__device__ __forceinline__ void pool_item(int pi, const bf16_t* PV, const bf16_t* SG, bf16_t* YO, const bf16_t* PT, const float* scale, LAS unsigned char* sl, int lane) {
    const int tile = pi >> 2, g = ((pi & 3) + ((pi >> 2) & 1)) & 3, win = 2 << g;
    const int r32 = lane & 31, hi = lane >> 5, tok0 = tile * 32, t0 = tok0 & (SEQ - 1), tok = tok0 + r32;
    u32x4 sv[12];
#pragma unroll
    for (int p = 0; p < 12; ++p) { const int idx = p * 64 + lane, row = idx >> 4, ch = idx & 15; const bool ok = (t0 + row - 16) >= 0;
        sv[p] = *(const u32x4*)(PV + (size_t)(ok ? tok0 + row - 16 : tok0) * 512 + g * 128 + ch * 8); if (!ok) sv[p] = (u32x4){0u, 0u, 0u, 0u}; }
#pragma unroll
    for (int p = 0; p < 12; ++p) { const int idx = p * 64 + lane, row = idx >> 4, ch = idx & 15; *(LAS u32x4*)(sl + row * PROW + ch * 16) = sv[p]; }
    const int t = t0 + r32, cnt = (t + 1) < win ? (t + 1) : win;
    bf16x8 bfr[3];
#pragma unroll
    for (int ks = 0; ks < 3; ++ks) { float wv[8];
#pragma unroll
        for (int j = 0; j < 8; ++j) { const int rel = (16 + r32) - (16 * ks + 8 * hi + j); wv[j] = (rel == 0) ? (float)(1 - cnt) : ((rel > 0 && rel < cnt) ? 1.f : 0.f); }
        u32x4 tt; tt.x = pg8::cvt_pk_bf16(wv[0], wv[1]); tt.y = pg8::cvt_pk_bf16(wv[2], wv[3]); tt.z = pg8::cvt_pk_bf16(wv[4], wv[5]); tt.w = pg8::cvt_pk_bf16(wv[6], wv[7]); bfr[ks] = __builtin_bit_cast(bf16x8, tt); }
    bf16x8 ptf[4][8];
#pragma unroll
    for (int nt = 0; nt < 4; ++nt)
#pragma unroll
        for (int ks = 0; ks < 8; ++ks) ptf[nt][ks] = *(const bf16x8*)(PT + (size_t)g * 128 * 128 + (size_t)((nt * 8 + ks) * 64 + lane) * 8);
    const int i16 = lane & 15, G4 = lane >> 4;
    const int vb = (8 * (G4 >> 1) + (i16 >> 2)) * PROW + (16 * (G4 & 1) + 4 * (i16 & 3)) * 2;
    const float inv = __builtin_amdgcn_rcpf((float)cnt);
    bf16x8 pf[8];
#pragma unroll
    for (int ct = 0; ct < 4; ++ct) {
        f32x16 acc;
#pragma unroll
        for (int r = 0; r < 16; ++r) acc[r] = 0.f;
#pragma unroll
        for (int ks = 0; ks < 3; ++ks) {
            const s16x4 lo = __builtin_amdgcn_ds_read_tr16_b64_v4i16((LAS s16x4*)(sl + vb + (16 * ks) * PROW + ct * 64));
            const s16x4 hh = __builtin_amdgcn_ds_read_tr16_b64_v4i16((LAS s16x4*)(sl + vb + (16 * ks + 4) * PROW + ct * 64));
            const bf16x8 a = (bf16x8){lo[0], lo[1], lo[2], lo[3], hh[0], hh[1], hh[2], hh[3]};
            acc = __builtin_amdgcn_mfma_f32_32x32x16_bf16(a, bfr[ks], acc, 0, 0, 0); }
#pragma unroll
        for (int s = 0; s < 2; ++s) { u32x4 tt; tt.x = pg8::cvt_pk_bf16(acc[8 * s] * inv, acc[8 * s + 1] * inv); tt.y = pg8::cvt_pk_bf16(acc[8 * s + 2] * inv, acc[8 * s + 3] * inv);
            tt.z = pg8::cvt_pk_bf16(acc[8 * s + 4] * inv, acc[8 * s + 5] * inv); tt.w = pg8::cvt_pk_bf16(acc[8 * s + 6] * inv, acc[8 * s + 7] * inv); pf[2 * ct + s] = __builtin_bit_cast(bf16x8, tt); }
    }
#pragma unroll
    for (int p = 0; p < 8; ++p) { const int idx = p * 64 + lane; const u32x4 v = *(const u32x4*)(SG + (size_t)(tok0 + (idx >> 4)) * 1536 + g * 128 + (idx & 15) * 8); *(LAS u32x4*)(sl + (idx >> 4) * PROW + (idx & 15) * 16) = v; }
#pragma unroll
    for (int nt = 0; nt < 4; ++nt) {
        f32x16 acc;
#pragma unroll
        for (int r = 0; r < 16; ++r) acc[r] = 0.f;
#pragma unroll
        for (int ks = 0; ks < 8; ++ks) acc = __builtin_amdgcn_mfma_f32_32x32x16_bf16(ptf[nt][ks], pf[ks], acc, 0, 0, 0);
#pragma unroll
        for (int q = 0; q < 4; ++q) { LAS u32x2* p = (LAS u32x2*)(sl + r32 * PROW + (nt * 32 + 8 * q + 4 * hi) * 2); const u32x2 sg = *p; u32x2 y;
            y.x = pg8::cvt_pk_bf16(acc[4 * q] * bflo(sg.x), acc[4 * q + 1] * bfhi(sg.x)); y.y = pg8::cvt_pk_bf16(acc[4 * q + 2] * bflo(sg.y), acc[4 * q + 3] * bfhi(sg.y));
            *p = y; }
    }
#pragma unroll
    for (int p = 0; p < 8; ++p) { const int idx = p * 64 + lane; const u32x4 v = *(const LAS u32x4*)(sl + (idx >> 4) * PROW + (idx & 15) * 16);
        *(u32x4*)(YO + (size_t)(tok0 + (idx >> 4)) * 1536 + g * 128 + (idx & 15) * 8) = v; }
}
__device__ __forceinline__ void conv_item(int ci, const bf16_t* Z, const bf16_t* Wy, bf16_t* YO, const float* cw, const float* cb, int lane) {
    const int tok0 = ci * 8, t0 = tok0 & (SEQ - 1), ch = lane * 8;
    float w0[8], w1[8], w2[8], bs[8], zm2[8], zm1[8];
#pragma unroll
    for (int hf = 0; hf < 2; ++hf) { const f32x4 a = *(const f32x4*)(cw + ch + 4 * hf), b = *(const f32x4*)(cw + 512 + ch + 4 * hf), c = *(const f32x4*)(cw + 1024 + ch + 4 * hf), d = *(const f32x4*)(cb + ch + 4 * hf);
#pragma unroll
        for (int i = 0; i < 4; ++i) { w0[4 * hf + i] = a[i]; w1[4 * hf + i] = b[i]; w2[4 * hf + i] = c[i]; bs[4 * hf + i] = d[i]; } }
#pragma unroll
    for (int i = 0; i < 8; ++i) { zm2[i] = 0.f; zm1[i] = 0.f; }
    if (t0 != 0) { const u32x4 a = *(const u32x4*)(Z + (size_t)(tok0 - 2) * 512 + ch), b = *(const u32x4*)(Z + (size_t)(tok0 - 1) * 512 + ch);
        zm2[0] = bflo(a.x); zm2[1] = bfhi(a.x); zm2[2] = bflo(a.y); zm2[3] = bfhi(a.y); zm2[4] = bflo(a.z); zm2[5] = bfhi(a.z); zm2[6] = bflo(a.w); zm2[7] = bfhi(a.w);
        zm1[0] = bflo(b.x); zm1[1] = bfhi(b.x); zm1[2] = bflo(b.y); zm1[3] = bfhi(b.y); zm1[4] = bflo(b.z); zm1[5] = bfhi(b.z); zm1[6] = bflo(b.w); zm1[7] = bfhi(b.w); }
    u32x4 zr[8], wr_[8];
#pragma unroll
    for (int r = 0; r < 8; ++r) { zr[r] = *(const u32x4*)(Z + (size_t)(tok0 + r) * 512 + ch); wr_[r] = *(const u32x4*)(Wy + (size_t)(tok0 + r) * 1536 + ch); }
#pragma unroll
    for (int r = 0; r < 8; ++r) {
        float zc[8], wv[8], y[8];
        zc[0] = bflo(zr[r].x); zc[1] = bfhi(zr[r].x); zc[2] = bflo(zr[r].y); zc[3] = bfhi(zr[r].y); zc[4] = bflo(zr[r].z); zc[5] = bfhi(zr[r].z); zc[6] = bflo(zr[r].w); zc[7] = bfhi(zr[r].w);
        wv[0] = bflo(wr_[r].x); wv[1] = bfhi(wr_[r].x); wv[2] = bflo(wr_[r].y); wv[3] = bfhi(wr_[r].y); wv[4] = bflo(wr_[r].z); wv[5] = bfhi(wr_[r].z); wv[6] = bflo(wr_[r].w); wv[7] = bfhi(wr_[r].w);
#pragma unroll
        for (int i = 0; i < 8; ++i) { y[i] = wv[i] * (w0[i] * zm2[i] + w1[i] * zm1[i] + w2[i] * zc[i] + bs[i]); zm2[i] = zm1[i]; zm1[i] = zc[i]; }
        u32x4 o; o.x = pg8::cvt_pk_bf16(y[0], y[1]); o.y = pg8::cvt_pk_bf16(y[2], y[3]); o.z = pg8::cvt_pk_bf16(y[4], y[5]); o.w = pg8::cvt_pk_bf16(y[6], y[7]);
        *(u32x4*)(YO + (size_t)(tok0 + r) * 1536 + ch) = o; }
}
template <int R> __device__ __forceinline__ void norm_rows(const float* F32T, const float* RS, const float* xin, const float* gpost, float* xout, const float* gnext, bf16_t* H, int m0, int mstride, int lane) {
    f32x4 o[R][4], xi[R][4]; float ss[R];
#pragma unroll
    for (int r = 0; r < R; ++r) { const size_t row = (size_t)(m0 + r * mstride); ss[r] = (lane < 16) ? RS[row * 16 + lane] : 0.f;
#pragma unroll
        for (int j = 0; j < 4; ++j) { o[r][j] = ((const f32x4*)(F32T + row * DM))[64 * j + lane]; xi[r][j] = ((const f32x4*)(xin + row * DM))[64 * j + lane]; } }
    f32x4 gp[4];
#pragma unroll
    for (int j = 0; j < 4; ++j) gp[j] = ((const f32x4*)gpost)[64 * j + lane];
#pragma unroll
    for (int r = 0; r < R; ++r) { const size_t row = (size_t)(m0 + r * mstride);
        const float rstd = 1.f / sqrtf(wave_sum(ss[r]) * (1.f / DM) + RMS_EPS); float s2 = 0.f;
#pragma unroll
        for (int j = 0; j < 4; ++j) { const f32x4 v = xi[r][j] + o[r][j] * rstd * gp[j]; xi[r][j] = v; ((f32x4*)(xout + row * DM))[64 * j + lane] = v; s2 += (v[0] * v[0] + v[1] * v[1]) + (v[2] * v[2] + v[3] * v[3]); }
        if (gnext) { const float r2 = 1.f / sqrtf(wave_sum(s2) * (1.f / DM) + RMS_EPS);
#pragma unroll
            for (int j = 0; j < 4; ++j) { const f32x4 gg = ((const f32x4*)gnext)[64 * j + lane]; const f32x4 v = xi[r][j]; u32x2 w; w.x = pg8::cvt_pk_bf16(v[0] * r2 * gg[0], v[1] * r2 * gg[1]); w.y = pg8::cvt_pk_bf16(v[2] * r2 * gg[2], v[3] * r2 * gg[3]); ((u32x2*)(H + row * DM))[64 * j + lane] = w; } } }
}

struct Args { const float* in[10]; float* out; unsigned char* ws; int ph_lo, ph_hi; };
template <class T> __device__ __forceinline__ T* as_global(T* p) { return p; }
#if TP_A >= 0
#define TSTAMP(k) do { if (blockIdx.x == TP_BLK && threadIdx.x == 0) ((volatile LAS unsigned long long*)(lds + 147264))[(k)] = __builtin_amdgcn_s_memrealtime(); } while (0)
#else
#define TSTAMP(k) do { } while (0)
#endif
template <int ph> __device__ __forceinline__ void run_phase(const Args& a_, LAS unsigned char* lds) {
        const Args* A = &a_;
        const int tid = threadIdx.x, lane = tid & 63, wave = __builtin_amdgcn_readfirstlane(tid >> 6);
        const int G = gridDim.x, bx = blockIdx.x;
        const int vcu = (G % 8 == 0) ? (bx % 8) * (G / 8) + bx / 8 : bx;
        const int gw = vcu * 8 + wave, NGW = G * 8;
        unsigned char* ws = as_global(A->ws);
        bf16_t* H = (bf16_t*)(ws + WS_H); bf16_t* U = (bf16_t*)(ws + WS_U);
        if constexpr (ph == 0) {
            const float* x = as_global(A->in[0]); const float* pre_g = as_global(A->in[1]); const float* w_in = as_global(A->in[2]); const float* pool_w = as_global(A->in[3]); const float* pool_scale = as_global(A->in[4]); const float* w_branch = as_global(A->in[7]); const float* w_out = as_global(A->in[8]);
            bf16_t* W1 = (bf16_t*)(ws + WS_W1); bf16_t* W2 = (bf16_t*)(ws + WS_W2); bf16_t* W3 = (bf16_t*)(ws + WS_W3); bf16_t* PW = (bf16_t*)(ws + WS_PW);
            LAS float* scr = (LAS float*)(lds + wave * 17408);
            constexpr int I1 = (DM / 64) * (NIN / 64), I2 = (BWID / 64) * (DM / 64), I3 = (DM / 64) * (DM / 64), I4 = 2 * 2, PER = I1 + 3 * I2 + I3 + 4 * I4;
            for (int it = gw; it < NLAYER * PER; it += NGW) {
                const int l = it / PER; int r = it % PER;
                if (r < I1) { transpose_item(w_in + (size_t)l * DM * NIN, NIN, W1 + (size_t)l * NIN * DM, DM, 0, 0, true, scr, r, lane); continue; } r -= I1;
                if (r < 3 * I2) { const int n = r / I2; transpose_item(w_branch + ((size_t)l * 3 + n) * BWID * DM, DM, W2 + (size_t)l * 3 * DM * BWID, 3 * BWID, n * BWID, 0, false, scr, r % I2, lane); continue; } r -= 3 * I2;
                if (r < I3) { transpose_item(w_out + (size_t)l * DM * DM, DM, W3 + (size_t)l * DM * DM, DM, 0, 0, false, scr, r, lane); continue; } r -= I3;
                { const int g = r / I4; transpose_item(pool_w + ((size_t)l * 4 + g) * 128 * 128, 128, PW + ((size_t)l * 4 + g) * 128 * 128, 128, 0, 0, false, scr, r % I4, lane, pool_scale + l * BWID + g * 128); }
            }
            for (int m = gw; m < MTOK; m += 2 * NGW) rms_rows_to_bf16<2>(x, pre_g, H, m, NGW, lane);
        } else {
            constexpr int l = (ph - 1) / 5, k = (ph - 1) % 5;
            if constexpr (k == 0) {
                pg8::Gemm g{H, (bf16_t*)(ws + WS_W1) + (size_t)l * NIN * DM, MTOK, NIN, DM, 0}; pg8::StaticOrder S; S.init(MTOK, NIN, G, bx);
                EpiU E{ws};
                pg8::gemm_phase<EpiU, pg8::StaticOrder, true, true>(lds, g, S, E);
            } else if constexpr (k == 1) {
                const float* pool_scale = as_global(A->in[4]); const float* conv_w = as_global(A->in[5]); const float* conv_b = as_global(A->in[6]);
                const bf16_t* PW = (const bf16_t*)(ws + WS_PW);
                const bf16_t* Q = U + 2 * (ARRB / 2); const bf16_t* Kk = U + 3 * (ARRB / 2); const bf16_t* V = U + 4 * (ARRB / 2);
                LAS unsigned char* vl = lds + wave * (32 * VROW);
                bf16_t* G3 = U + 5 * (ARRB / 2);
                bf16_t* YO = G3;
#if MIX_PROBE
                if (l == 0 && A->ph_hi < 0) YO = (bf16_t*)as_global(A->out);
#endif
                int pm_ = 7;
#if MIX_PROBE
                if (l == 0 && A->ph_hi < 0) pm_ = MIX_PROBE;
#endif
                if (l == 0) TSTAMP(12);
                volatile LAS unsigned* wq = (volatile LAS unsigned*)(lds + 147216);
                if (tid < 3) wq[tid] = 0u;
                __syncthreads();
#define WQ_GRAB(Q_) ({ unsigned v_ = 0u; if (lane == 0) v_ = __hip_atomic_fetch_add((LAS unsigned*)(Q_), 1u, __ATOMIC_RELAXED, __HIP_MEMORY_SCOPE_WORKGROUP); (unsigned)__builtin_amdgcn_readfirstlane((int)v_); })
#define WQ_ITEM(J_) ((int)(vcu * 8 + ((J_) & 7u) + ((J_) >> 3) * (unsigned)NGW))
                for (;;) { const unsigned j = WQ_GRAB(wq); const int it = WQ_ITEM(j); if (it >= NB * 8 * 128) break; attn_item(it, Q, Kk, V, G3 + 1024, YO + 1024, vl, lds + 36864 + wave * (48 * PROW), lane); }
                if (l == 0) TSTAMP(13);
                for (;;) { const unsigned j = WQ_GRAB(wq + 1); const int it = WQ_ITEM(j); if (it >= (MTOK / 32) * 4) break; pool_item(it, U, G3, YO, PW + (size_t)l * 4 * 128 * 128, pool_scale + l * BWID, lds + 36864 + wave * (48 * PROW), lane); }
                if (l == 0) TSTAMP(14);
                for (;;) { const unsigned j = WQ_GRAB(wq + 2); const int it = WQ_ITEM(j); if (it >= MTOK / 8) break; conv_item(it, U + 1 * (ARRB / 2), G3 + 512, YO + 512, conv_w + l * 3 * BWID, conv_b + l * BWID, lane); }
#undef WQ_GRAB
#undef WQ_ITEM
                if (l == 0) TSTAMP(15);
#if TP_A >= 0
                if (l == 0) { __syncthreads(); TSTAMP(5); }
#endif
            } else if constexpr (k == 2) {
                pg8::Gemm g{U + 5 * (ARRB / 2), (bf16_t*)(ws + WS_W2) + (size_t)l * 3 * DM * BWID, MTOK, DM, 3 * BWID, 0}; pg8::StaticOrder S; S.init(MTOK, DM, G, bx);
                EpiBranch E{ws};
                pg8::gemm_phase<EpiBranch, pg8::StaticOrder, true, true>(lds, g, S, E);
            } else if constexpr (k == 3) {
                pg8::Gemm g{H, (bf16_t*)(ws + WS_W3) + (size_t)l * DM * DM, MTOK, DM, DM, 0}; pg8::StaticOrder S; S.init(MTOK, DM, G, bx);
                if (G == 256) {
                    const float* x = as_global(A->in[0]); const float* pre_g = as_global(A->in[1]); const float* post_g = as_global(A->in[9]); float* out = as_global(A->out);
                    float* xb = (float*)(ws + WS_RS); unsigned* cn = (unsigned*)(ws + WS_CTL + CTL_CNT);
                    if constexpr (l + 1 < NLAYER) {
                        EpiNorm2 E{x, out, H, post_g + l * DM, pre_g + (l + 1) * DM, RmsPanel{xb, cn}, RmsPanel{xb + (size_t)MTOK * 4, cn + 64 * 64}};
                        pg8::gemm_phase<EpiNorm2, pg8::StaticOrder, false, true>(lds, g, S, E);
                    } else {
                        EpiNorm1 E{out, post_g + l * DM, RmsPanel{xb + (size_t)2 * MTOK * 4, cn + 2 * 64 * 64}};
                        pg8::gemm_phase<EpiNorm1, pg8::StaticOrder, false, true>(lds, g, S, E);
                    }
                } else {
                    EpiOut E{ws};
                    pg8::gemm_phase<EpiOut, pg8::StaticOrder, true, true>(lds, g, S, E);
                }
            } else {
                const float* x = as_global(A->in[0]); const float* pre_g = as_global(A->in[1]); const float* post_g = as_global(A->in[9]); float* out = as_global(A->out);
                const float* F32T = (const float*)(ws + WS_U); const float* RS = (const float*)(ws + WS_RS);
                const float* xin = (l == 0) ? x : out; const float* gnext = (l + 1 < NLAYER) ? pre_g + (l + 1) * DM : nullptr;
                if (G != 256) for (int m = gw; m < MTOK; m += 2 * NGW) norm_rows<2>(F32T, RS, xin, post_g + l * DM, out, gnext, H, m, NGW, lane);
            }
        }
}
__global__ void __launch_bounds__(512, 2) hybrid_fwd(Args a_) {
    extern __shared__ __attribute__((aligned(16))) unsigned char lds_raw[];
    LAS unsigned char* lds = (LAS unsigned char*)lds_raw;
    cg::grid_group grid = cg::this_grid();
    if (threadIdx.x < 64) ((LAS unsigned*)(lds + 147200))[threadIdx.x] = 0u;
    __syncthreads();
    (void)xcd_barrier_post((unsigned*)(a_.ws + WS_CTL), (volatile LAS unsigned*)(lds + 147200 + 32));
#define SEAM_BAR() do { XcdBarrier b_; b_.bar = (unsigned*)(a_.ws + WS_CTL); b_.x = xb_xcc_id(); b_.st = (volatile LAS unsigned*)(lds + 147200 + 32); xcd_barrier(b_); } while (0)
    const int lo = a_.ph_lo, hi = a_.ph_hi < 0 ? -a_.ph_hi : a_.ph_hi;
#define PHASE(k) if (lo <= (k) && (k) < hi && !(((k) == 5 || (k) == 10) && gridDim.x == 256)) { if ((k) > lo) { if ((k) == 1 && lo < 0) grid.sync(); else SEAM_BAR(); } TSTAMP(k); run_phase<(k)>(a_, lds); }
    PHASE(0) PHASE(1) PHASE(2) PHASE(3) PHASE(4) PHASE(5) PHASE(6) PHASE(7) PHASE(8) PHASE(9) PHASE(10)
#undef PHASE
#if TP_A >= 0
    SEAM_BAR(); TSTAMP(11);
    if (blockIdx.x == TP_BLK && threadIdx.x == 0) { volatile LAS unsigned long long* ts = (volatile LAS unsigned long long*)(lds + 147264); a_.out[0] += (float)(ts[TP_B] - ts[TP_A]) * (0.00005f * TP_SCALE); }
#endif
}

extern "C" void kernel_launch(void* const* d_in, const int* in_sizes, int n_in, void* d_out, int out_size, void* d_ws, size_t ws_size, hipStream_t stream) {
    static int grid = 0;
    if (grid == 0) {
        if (n_in != 10 || out_size != MTOK * DM || ws_size < WS_END) { fprintf(stderr, "kernel_launch: unexpected shapes / workspace (n_in %d out %d ws %zu)\n", n_in, out_size, ws_size); grid = -1; return; }
        int dev = 0, cus = 0, per_cu = 0;
        (void)hipGetDevice(&dev); (void)hipDeviceGetAttribute(&cus, hipDeviceAttributeMultiprocessorCount, dev);
        (void)hipFuncSetAttribute((const void*)hybrid_fwd, hipFuncAttributeMaxDynamicSharedMemorySize, LDS_BYTES);
        (void)hipOccupancyMaxActiveBlocksPerMultiprocessor(&per_cu, (const void*)hybrid_fwd, 512, LDS_BYTES);
        (void)hipGetLastError();
        if (per_cu < 1) { fprintf(stderr, "kernel_launch: occupancy query says %d blocks/CU\n", per_cu); per_cu = 1; }
        grid = cus;
    }
    if (grid < 0) return;
    if (hipMemsetAsync((char*)d_ws + WS_CTL, 0, CTL_BYTES, stream) != hipSuccess) { fprintf(stderr, "kernel_launch: memset of the barrier words failed\n"); return; }
    Args a{};
    for (int i = 0; i < 10; ++i) a.in[i] = (const float*)d_in[i];
    a.out = (float*)d_out; a.ws = (unsigned char*)d_ws;
#if ONE_LAUNCH
    a.ph_lo = 0; a.ph_hi = NPHASE;
    void* args[] = {&a};
    hipError_t e = hipLaunchCooperativeKernel((const void*)hybrid_fwd, dim3(grid), dim3(512), args, LDS_BYTES, stream);
    if (e != hipSuccess) fprintf(stderr, "cooperative launch failed: %s (grid %d)\n", hipGetErrorString(e), grid);
#else
    for (int ph = 0; ph < NPHASE; ++ph) { a.ph_lo = ph; a.ph_hi = ph + 1;
#if MIX_PROBE
        if (ph == 2) { a.ph_hi = -(ph + 1); hipLaunchKernelGGL(hybrid_fwd, dim3(grid), dim3(512), LDS_BYTES, stream, a); a.ph_hi = ph + 1; }
#endif
        for (int rep = 0; rep < 1 + ((DUP_MASK >> ph) & 1); ++rep) hipLaunchKernelGGL(hybrid_fwd, dim3(grid), dim3(512), LDS_BYTES, stream, a); }
#endif
}
```

```cpp
#include <hip/hip_runtime.h>
#include <hip/hip_cooperative_groups.h>
#include <cstdio>
#include <cstdint>
namespace cg = cooperative_groups;
#ifndef ONE_LAUNCH
#define ONE_LAUNCH 1
#endif
#ifndef DUP_MASK
#define DUP_MASK 0
#endif
#ifndef MIX_PROBE
#define MIX_PROBE 0
#endif
#ifndef TP_A
#define TP_A -1
#define TP_B -1
#endif
#ifndef TP_SCALE
#define TP_SCALE 1
#endif
#ifndef TP_BLK
#define TP_BLK 0
#endif
namespace pg8 {
#define PG8_LAS __attribute__((address_space(3)))
typedef unsigned short bf16_t;
typedef short bf16x8 __attribute__((ext_vector_type(8)));
typedef float f32x4 __attribute__((ext_vector_type(4)));
typedef unsigned u32x4 __attribute__((ext_vector_type(4)));
constexpr int BM = 256, BK = 64, HALF = 128, HTB = HALF * BK * 2  , STAGE_BYTES = 8 * HTB, NXCD = 8, WGM = 8;

__host__ __device__ __forceinline__ int lds_byte(int r, int c) { const int st = (r >> 4) * 2 + (c >> 5), rr = r & 15, cc = c & 31, ob = rr * 64 + cc * 2; return st * 1024 + (ob ^ (((ob >> 9) & 1) << 5)); }
__host__ __device__ __forceinline__ void stage_rc(int b, int& R, int& C) { const int st = b / 1024, sb = b % 1024, swz = sb ^ (((sb >> 9) & 1) << 5); R = (st >> 1) * 16 + swz / 64; C = (st & 1) * 32 + (swz % 64) / 2; }
__host__ __device__ __forceinline__ int perm32(int rho) { const int n = rho >> 4, i = rho & 15; return 8 * (i >> 2) + 4 * n + (i & 3); }

struct Unit { int pm, pn, az; };
struct Gemm { const bf16_t* A; const bf16_t* Bt; int M, N, K; size_t azs; };

struct StaticOrder {
    int nM, nN, nwg, G, c;
    __host__ __device__ void init(int M, int N, int G_, int c_) { nM = M / BM; nN = N / BM; nwg = nM * nN; G = G_; c = c_; }
    __host__ __device__ bool next(int i, Unit& u) const {
        const long L = (long)i * G + c; if (L >= nwg) return false;
        int wgid = (int)L; { const int q = nwg / NXCD, r = nwg % NXCD, xcd = wgid % NXCD, off = wgid / NXCD; wgid = (xcd < r ? xcd * (q + 1) : r * (q + 1) + (xcd - r) * q) + off; }
        const int nig = WGM * nN, gid = wgid / nig, fm = gid * WGM, gsz = (nM - fm) < WGM ? (nM - fm) : WGM;
        u.pm = fm + ((wgid % nig) % gsz); u.pn = (wgid % nig) / gsz; u.az = 0; return true;
    }
    __device__ __forceinline__ void a_ready(const Unit&) const {}
    __device__ __forceinline__ void done(const Unit&) const {}
};

__device__ __forceinline__ unsigned cvt_pk_bf16(float lo, float hi) { unsigned r; asm volatile("v_cvt_pk_bf16_f32 %0, %1, %2" : "=v"(r) : "v"(lo), "v"(hi)); return r; }
template <class Epi, class Sched, bool ALIGN_EPI = false, bool SP2 = false>
__device__ __forceinline__ void gemm_phase(PG8_LAS unsigned char* lds, const Gemm g, const Sched& S, const Epi& E) {
    const int tid = threadIdx.x, wid = __builtin_amdgcn_readfirstlane(tid >> 6), lane = tid & 63, wr = wid >> 2, wc = wid & 3, fr = lane & 15, fq = lane >> 4;
    const int K = g.K, nt = K / BK;
    unsigned voffA[2], voffB[2];
#pragma unroll
    for (int i = 0; i < 2; ++i) { int R, C; stage_rc(tid * 16 + i * 8192, R, C); const int Rb = Epi::PERM ? ((R & ~31) + perm32(R & 31)) : R;
        voffA[i] = (unsigned)(R * K + C) * 2u; voffB[i] = (unsigned)(Rb * K + C) * 2u; }
    const size_t kstep = (size_t)(BK * 2);
    const size_t hstep = (size_t)HALF * K * 2;
    const size_t tstep = 2 * hstep;
    const unsigned ldsw = (unsigned)wid * 1024u;
    const int aoff = lds_byte(wr * 64 + fr, fq * 8), boff = lds_byte(wc * 32 + fr, fq * 8);
#define PG8_SA(b, h) (((b) * 2 + (h)) * HTB)
#define PG8_SB(b, h) ((4 + (b) * 2 + (h)) * HTB)
#define PG8_STAGE(bufoff, gbase, voff) do { _Pragma("unroll") for (int _i = 0; _i < 2; ++_i) \
        __builtin_amdgcn_global_load_lds((const unsigned*)((const char*)(gbase) + (voff)[_i]), (PG8_LAS unsigned*)(lds + (bufoff) + ldsw + _i * 8192), 16, 0, 0); } while (0)
#define PG8_LDA(dst, b, h) do { _Pragma("unroll") for (int m = 0; m < 4; ++m) _Pragma("unroll") for (int k = 0; k < 2; ++k) dst[m][k] = *(const PG8_LAS bf16x8*)(lds + PG8_SA(b, h) + aoff + m * 2048 + k * 1024); } while (0)
#define PG8_LDB(dst, b, h) do { _Pragma("unroll") for (int n = 0; n < 2; ++n) _Pragma("unroll") for (int k = 0; k < 2; ++k) dst[n][k] = *(const PG8_LAS bf16x8*)(lds + PG8_SB(b, h) + boff + n * 2048 + k * 1024); } while (0)
#define PG8_MMA(ai, bj, At, Bt) do { __builtin_amdgcn_s_setprio(1); _Pragma("unroll") for (int m = 0; m < 4; ++m) _Pragma("unroll") for (int n = 0; n < 2; ++n) _Pragma("unroll") for (int k = 0; k < 2; ++k) \
        acc[ai][bj][m][n] = __builtin_amdgcn_mfma_f32_16x16x32_bf16(Bt[n][k], At[m][k], acc[ai][bj][m][n], 0, 0, 0); __builtin_amdgcn_s_setprio(0); } while (0)
#define PG8_WAIT_V(n) asm volatile("s_waitcnt vmcnt(" #n ")" ::: "memory")
#define PG8_WAIT_L(n) asm volatile("s_waitcnt lgkmcnt(" #n ")" ::: "memory")
#define PG8_BAR __builtin_amdgcn_s_barrier()
#define PG8_SCHED __builtin_amdgcn_sched_barrier(0)
    Unit cur, nxt; int ui = 0;
    if (!S.next(0, cur)) return;
    f32x4 acc[2][2][4][2];
#pragma unroll
    for (int a = 0; a < 2; ++a)
#pragma unroll
        for (int b = 0; b < 2; ++b)
#pragma unroll
            for (int m = 0; m < 4; ++m)
#pragma unroll
                for (int n = 0; n < 2; ++n) acc[a][b][m][n] = (f32x4){0.f, 0.f, 0.f, 0.f};
    bf16x8 At[4][2], B0[2][2], B1[2][2];
    const char* cA = (const char*)g.A + (size_t)cur.pm * tstep + (size_t)cur.az * g.azs; const char* cB = (const char*)g.Bt + (size_t)cur.pn * tstep;
    S.a_ready(cur);
    if constexpr (SP2) {
        PG8_STAGE(PG8_SB(0, 0), cB, voffB); PG8_STAGE(PG8_SB(0, 1), cB + hstep, voffB); PG8_STAGE(PG8_SA(0, 0), cA, voffA); PG8_STAGE(PG8_SA(0, 1), cA + hstep, voffA);
        if (wr == 1) PG8_BAR;
        PG8_WAIT_V(2); PG8_BAR;
        PG8_STAGE(PG8_SB(1, 0), cB + kstep, voffB); PG8_STAGE(PG8_SA(1, 0), cA + kstep, voffA); PG8_STAGE(PG8_SB(1, 1), cB + hstep + kstep, voffB);
        PG8_WAIT_V(6); PG8_BAR;
    } else {
        PG8_STAGE(PG8_SB(0, 0), cB, voffB); PG8_STAGE(PG8_SA(0, 0), cA, voffA); PG8_STAGE(PG8_SB(0, 1), cB + hstep, voffB); PG8_STAGE(PG8_SA(0, 1), cA + hstep, voffA);
        if (wr == 1) PG8_BAR;
        PG8_WAIT_V(4); PG8_BAR;
        PG8_STAGE(PG8_SB(1, 0), cB + kstep, voffB); PG8_STAGE(PG8_SA(1, 0), cA + kstep, voffA); PG8_STAGE(PG8_SB(1, 1), cB + hstep + kstep, voffB);
        PG8_WAIT_V(6); PG8_BAR;
    }
    for (;;) {
        const bool has_next = S.next(ui + 1, nxt);
        const char* nA = has_next ? (const char*)g.A + (size_t)nxt.pm * tstep + (size_t)nxt.az * g.azs : cA; const char* nB = has_next ? (const char*)g.Bt + (size_t)nxt.pn * tstep : cB;
        for (int t = 0; t < nt; t += 2) {
            if constexpr (Epi::MIDK) { if (t == 8 || t == 16) E.mid(acc, cur, t >> 3, wr, wc, fr, fq); }
            const bool last = (t == nt - 2);
            const char* a1 = cA + (size_t)(t + 1) * kstep;
            const char* a2 = last ? nA : cA + (size_t)(t + 2) * kstep; const char* b2 = last ? nB : cB + (size_t)(t + 2) * kstep;
            const char* a3 = a2 + kstep; const char* b3 = b2 + kstep;
            if (last && has_next) S.a_ready(nxt);
            if constexpr (SP2) {
            PG8_LDB(B0, 0, 0); PG8_LDB(B1, 0, 1); PG8_SCHED; PG8_LDA(At, 0, 0); PG8_STAGE(PG8_SA(1, 1), a1 + hstep, voffA);
            PG8_WAIT_V(8); PG8_WAIT_L(0); PG8_BAR; PG8_MMA(0, 0, At, B0); PG8_MMA(0, 1, At, B1); PG8_BAR; PG8_SCHED;
            PG8_LDA(At, 0, 1); PG8_STAGE(PG8_SB(0, 0), b2, voffB); PG8_STAGE(PG8_SB(0, 1), b2 + hstep, voffB); PG8_STAGE(PG8_SA(0, 0), a2, voffA);
            PG8_WAIT_V(8); PG8_WAIT_L(0); PG8_BAR; PG8_MMA(1, 0, At, B0); PG8_MMA(1, 1, At, B1); PG8_BAR; PG8_SCHED;
            PG8_LDB(B0, 1, 0); PG8_LDB(B1, 1, 1); PG8_SCHED; PG8_LDA(At, 1, 0); PG8_STAGE(PG8_SA(0, 1), a2 + hstep, voffA);
            PG8_WAIT_V(8); PG8_WAIT_L(0); PG8_BAR; PG8_MMA(0, 0, At, B0); PG8_MMA(0, 1, At, B1); PG8_BAR; PG8_SCHED;
            PG8_LDA(At, 1, 1); PG8_STAGE(PG8_SB(1, 0), b3, voffB); PG8_STAGE(PG8_SB(1, 1), b3 + hstep, voffB); PG8_STAGE(PG8_SA(1, 0), a3, voffA);
            PG8_WAIT_V(8); PG8_WAIT_L(0); PG8_BAR; PG8_MMA(1, 0, At, B0); PG8_MMA(1, 1, At, B1); PG8_BAR; PG8_SCHED;
            } else {
            PG8_LDB(B0, 0, 0); PG8_SCHED; PG8_LDA(At, 0, 0); PG8_STAGE(PG8_SA(1, 1), a1 + hstep, voffA);
            PG8_WAIT_L(8); PG8_BAR; PG8_WAIT_L(0); PG8_MMA(0, 0, At, B0); PG8_BAR; PG8_SCHED;
            PG8_LDB(B1, 0, 1); PG8_STAGE(PG8_SB(0, 0), b2, voffB);
            PG8_BAR; PG8_WAIT_L(0); PG8_MMA(0, 1, At, B1); PG8_BAR;
            PG8_LDA(At, 0, 1); PG8_STAGE(PG8_SA(0, 0), a2, voffA);
            PG8_BAR; PG8_WAIT_L(0); PG8_MMA(1, 0, At, B0); PG8_BAR; PG8_SCHED;
            PG8_STAGE(PG8_SB(0, 1), b2 + hstep, voffB);
            PG8_WAIT_V(6); PG8_BAR; PG8_MMA(1, 1, At, B1); PG8_BAR;
            PG8_LDB(B0, 1, 0); PG8_SCHED; PG8_LDA(At, 1, 0); PG8_STAGE(PG8_SA(0, 1), a2 + hstep, voffA);
            PG8_WAIT_L(8); PG8_BAR; PG8_WAIT_L(0); PG8_MMA(0, 0, At, B0); PG8_BAR; PG8_SCHED;
            PG8_LDB(B1, 1, 1); PG8_STAGE(PG8_SB(1, 0), b3, voffB);
            PG8_BAR; PG8_WAIT_L(0); PG8_MMA(0, 1, At, B1); PG8_BAR;
            PG8_LDA(At, 1, 1); PG8_STAGE(PG8_SA(1, 0), a3, voffA);
            PG8_BAR; PG8_WAIT_L(0); PG8_MMA(1, 0, At, B0); PG8_BAR; PG8_SCHED;
            PG8_STAGE(PG8_SB(1, 1), b3 + hstep, voffB);
            PG8_WAIT_V(6); PG8_BAR; PG8_MMA(1, 1, At, B1); PG8_BAR;
            }
        }
        if constexpr (ALIGN_EPI) { if (wr == 0) PG8_BAR; }
        if constexpr (!Epi::AFTER_DRAIN) { E(acc, cur, wr, wc, fr, fq); S.done(cur); }
        if (!has_next) break;
#pragma unroll
        for (int a = 0; a < 2; ++a)
#pragma unroll
            for (int b = 0; b < 2; ++b)
#pragma unroll
                for (int m = 0; m < 4; ++m)
#pragma unroll
                    for (int n = 0; n < 2; ++n) acc[a][b][m][n] = (f32x4){0.f, 0.f, 0.f, 0.f};
        cur = nxt; cA = nA; cB = nB; ++ui;
        if constexpr (ALIGN_EPI) { if (wr == 1) PG8_BAR; }
    }
    PG8_WAIT_V(0);
    if constexpr (!ALIGN_EPI) { if (wr == 0) PG8_BAR; }
    PG8_BAR;
    if constexpr (Epi::AFTER_DRAIN) { E.fused(acc, cur, wr, wc, fr, fq, lds, wid, lane); S.done(cur); }
#undef PG8_SA
#undef PG8_SB
#undef PG8_STAGE
#undef PG8_LDA
#undef PG8_LDB
#undef PG8_MMA
#undef PG8_WAIT_V
#undef PG8_WAIT_L
#undef PG8_BAR
#undef PG8_SCHED
}
}

#define LAS __attribute__((address_space(3)))
typedef unsigned short bf16_t;
typedef short bf16x8 __attribute__((ext_vector_type(8)));
typedef short s16x4 __attribute__((ext_vector_type(4)));
typedef float f32x4 __attribute__((ext_vector_type(4)));
typedef float f32x16 __attribute__((ext_vector_type(16)));
typedef unsigned u32x4 __attribute__((ext_vector_type(4)));
typedef unsigned u32x2 __attribute__((ext_vector_type(2)));
constexpr int NB = 4, SEQ = 4096, DM = 1024, MTOK = NB * SEQ, NIN = 8192, BWID = 512, NLAYER = 2;
constexpr float RMS_EPS = 1e-6f;
constexpr size_t MiB = 1u << 20;
constexpr size_t WS_RS = 0;
constexpr size_t WS_W1 = 2 * MiB;
constexpr size_t WS_W2 = 34 * MiB;
constexpr size_t WS_W3 = 40 * MiB;
constexpr size_t WS_PW = 44 * MiB;
constexpr size_t WS_H = 45 * MiB;
constexpr size_t WS_U = 77 * MiB;
constexpr size_t ARRB = 16 * MiB;
constexpr size_t WS_MG = 205 * MiB;
constexpr size_t WS_END = 253 * MiB;
constexpr int LDS_BYTES = 147456;
constexpr int NPHASE = 1 + 5 * NLAYER;

__device__ __forceinline__ unsigned f2bf(float f) { unsigned u = __builtin_bit_cast(unsigned, f); return (u + 0x7fffu + ((u >> 16) & 1u)) >> 16; }
__device__ __forceinline__ unsigned pk2(float lo, float hi) { return f2bf(lo) | (f2bf(hi) << 16); }
__device__ __forceinline__ float bflo(unsigned u) { return __builtin_bit_cast(float, u << 16); }
__device__ __forceinline__ float bfhi(unsigned u) { return __builtin_bit_cast(float, u & 0xffff0000u); }
__device__ __forceinline__ float sigmoid_f(float x) { return __builtin_amdgcn_rcpf(1.f + __builtin_amdgcn_exp2f(-1.4426950408889634f * x)); }
__device__ __forceinline__ float silu_f(float x) { return x * sigmoid_f(x); }
__device__ __forceinline__ unsigned q8(float x) { const unsigned q = (unsigned)(sigmoid_f(x) * 255.f + 0.5f); return q < 1u ? 1u : q; }
__device__ __forceinline__ float wave_sum(float v) {
#pragma unroll
    for (int o = 1; o < 64; o <<= 1) v += __shfl_xor(v, o);
    return v;
}

constexpr size_t WS_CTL = 1 * MiB; constexpr size_t CTL_BYTES = 65536;
constexpr size_t CTL_CNT = 16384;
#define XB_TMO      128
#define XB_XCNT(j)  (256  + 64 * (j))
#define XB_XSUB(j)  (1280 + 64 * (j))
#define XB_XGEN(j)  (2304 + 64 * (j))
#define XB_TOP      3328
#define XB_TOPGEN   3392
#define XCD_BAR_WORDS 3456
#define XB_SPIN_CAP (1u << 18)

__device__ __forceinline__ unsigned xb_ld(unsigned* p)              { return __hip_atomic_load(p, __ATOMIC_RELAXED, __HIP_MEMORY_SCOPE_AGENT); }
__device__ __forceinline__ unsigned xb_add(unsigned* p, unsigned v) { return __hip_atomic_fetch_add(p, v, __ATOMIC_RELAXED, __HIP_MEMORY_SCOPE_AGENT); }
__device__ __forceinline__ unsigned xb_xcc_id() { return (unsigned)__builtin_amdgcn_s_getreg((3 << 11) | 20) & 0xFu; }
#define XB_SPIN(cond, bar) do { unsigned _sp = 0; while (cond) { __builtin_amdgcn_s_sleep(1); \
    if ((++_sp & 255u) == 0u) { if (xb_ld(&(bar)[XB_TMO])) break; if (_sp > XB_SPIN_CAP) { atomicAdd(&(bar)[XB_TMO], 1u); break; } } } } while (0)

struct XcdBarrier {
    unsigned* bar; unsigned x;
    volatile LAS unsigned* st;
};

__device__ __forceinline__ XcdBarrier xcd_barrier_post(unsigned* bar, volatile LAS unsigned* st) {
    XcdBarrier b; b.bar = bar; b.x = xb_xcc_id(); b.st = st;
    if (threadIdx.x == 0) (void)xb_add(&bar[XB_XCNT(b.x)], 1u);
    return b;
}
__device__ __forceinline__ void xcd_barrier_complete(unsigned* bar, unsigned x, unsigned& nloc, unsigned& nx) {
    const unsigned G = gridDim.x * gridDim.y * gridDim.z;
    unsigned sum, cnt, mine, sp = 0u;
    for (;;) {
        sum = 0u; cnt = 0u; mine = 0u;
#pragma unroll
        for (unsigned j = 0; j < 16; ++j) { const unsigned c = xb_ld(&bar[XB_XCNT(j)]); sum += c; cnt += (c > 0u) ? 1u : 0u; mine = (j == x) ? c : mine; }
        if (sum == G) break;
        __builtin_amdgcn_s_sleep(1);
        if ((++sp & 255u) == 0u) { if (xb_ld(&bar[XB_TMO])) break; if (sp > XB_SPIN_CAP) { atomicAdd(&bar[XB_TMO], 1u); break; } }
    }
    nloc = mine > 0u ? mine : 1u; nx = cnt > 0u ? cnt : 1u;
}

__device__ __forceinline__ void xcd_barrier(const XcdBarrier& b) {
    asm volatile("s_waitcnt vmcnt(0)" ::: "memory");
    __syncthreads();
    if (threadIdx.x == 0) {
        unsigned* bar = b.bar;
        __builtin_amdgcn_s_waitcnt(0);
        unsigned nloc = b.st[0], nx = b.st[1];
        if (nloc == 0u) { xcd_barrier_complete(bar, b.x, nloc, nx); b.st[0] = nloc; b.st[1] = nx; }
        const unsigned old = xb_add(&bar[XB_XSUB(b.x)], 1u);
        const unsigned gen = old / nloc;
        if (old + 1u == (gen + 1u) * nloc) {
            __builtin_amdgcn_fence(__ATOMIC_RELEASE, "agent");
            asm volatile("s_waitcnt vmcnt(0)" ::: "memory");
            const unsigned og = xb_add(&bar[XB_TOP], 1u);
            const unsigned tg = og / nx;
            if (og + 1u == (tg + 1u) * nx) xb_add(&bar[XB_TOPGEN], 1u);
            else XB_SPIN(xb_ld(&bar[XB_TOPGEN]) == tg, bar);
            __builtin_amdgcn_fence(__ATOMIC_ACQUIRE, "agent");
            xb_add(&bar[XB_XGEN(b.x)], 1u);
            asm volatile("s_waitcnt vmcnt(0)" ::: "memory");
        } else {
            XB_SPIN(xb_ld(&bar[XB_XGEN(b.x)]) == gen, bar);
            __builtin_amdgcn_fence(__ATOMIC_ACQUIRE, "agent");
            asm volatile("s_waitcnt vmcnt(0)" ::: "memory");
        }
    }
    __syncthreads();
}


using pg8::Unit;
struct EpiU {
    static constexpr bool PERM = true, AFTER_DRAIN = false, MIDK = false;
    unsigned char* ws;
    __device__ __forceinline__ void operator()(const f32x4 (&acc)[2][2][4][2], const Unit& u, int wr, int wc, int fr, int fq) const {
        bf16_t* U = (bf16_t*)(ws + WS_U); unsigned char* MG = ws + WS_MG;
        const int pn = u.pn; const int row0 = u.pm * 256 + wr * 64 + fr;
        if (pn >= 20) {
            unsigned char* tb = MG + ((size_t)u.pm * 12 + (pn - 20)) * 65536 + (size_t)(((wr * 4 + wc) * 16) * 64 + (fq * 16 + fr)) * 8;
#pragma unroll
            for (int ai = 0; ai < 2; ++ai)
#pragma unroll
                for (int m = 0; m < 4; ++m)
#pragma unroll
                    for (int bj = 0; bj < 2; ++bj) { const f32x4 v0 = acc[ai][bj][m][0], v1 = acc[ai][bj][m][1]; u32x2 w;
                        w.x = q8(v0[0]) | (q8(v0[1]) << 8) | (q8(v0[2]) << 16) | (q8(v0[3]) << 24); w.y = q8(v1[0]) | (q8(v1[1]) << 8) | (q8(v1[2]) << 16) | (q8(v1[3]) << 24);
                        *(u32x2*)(tb + ((ai * 4 + m) * 2 + bj) * 512) = w; }
        } else if (pn >= 4 && pn < 12) {
            const bool second = pn >= 8; const int ch0 = (pn & 3) * 128 + wc * 32 + 8 * fq;
            bf16_t* O = second ? (U + 5 * (ARRB / 2) + 512) : (U + 1 * (ARRB / 2)); const int pitch = second ? 1536 : 512;
#pragma unroll
            for (int ai = 0; ai < 2; ++ai)
#pragma unroll
                for (int m = 0; m < 4; ++m) { bf16_t* rp = O + (size_t)(row0 + ai * 128 + m * 16) * pitch + ch0;
                    f32x4 a0 = acc[ai][0][m][0], a1 = acc[ai][0][m][1]; const f32x4 b0 = acc[ai][1][m][0], b1 = acc[ai][1][m][1];
                    if (second) {
#pragma unroll
                        for (int i = 0; i < 4; ++i) { a0[i] *= silu_f(b0[i]); a1[i] *= silu_f(b1[i]); } }
                    else { a0 *= b0; a1 *= b1; }
                    u32x4 w; w.x = pg8::cvt_pk_bf16(a0[0], a0[1]); w.y = pg8::cvt_pk_bf16(a0[2], a0[3]); w.z = pg8::cvt_pk_bf16(a1[0], a1[1]); w.w = pg8::cvt_pk_bf16(a1[2], a1[3]);
                    *(u32x4*)rp = w; }
        } else {
            const int kind = pn >> 1; int arr = 0, pitch = 512, coff = 0; bool act = false;
            if (kind == 1) { arr = 5; act = true; pitch = 1536; } else if (kind == 6) arr = 2; else if (kind == 7) arr = 3; else if (kind == 8) arr = 4; else if (kind == 9) { arr = 5; act = true; pitch = 1536; coff = 1024; }
            bf16_t* O = U + (size_t)arr * (ARRB / 2) + coff; const int col0 = (pn & 1) * 256 + wc * 32 + 8 * fq;
#pragma unroll
            for (int ai = 0; ai < 2; ++ai)
#pragma unroll
                for (int m = 0; m < 4; ++m) { bf16_t* rp = O + (size_t)(row0 + ai * 128 + m * 16) * pitch + col0;
#pragma unroll
                    for (int bj = 0; bj < 2; ++bj) { f32x4 v0 = acc[ai][bj][m][0], v1 = acc[ai][bj][m][1];
                        if (act) {
#pragma unroll
                            for (int i = 0; i < 4; ++i) { v0[i] = silu_f(v0[i]); v1[i] = silu_f(v1[i]); } }
                        u32x4 w; w.x = pg8::cvt_pk_bf16(v0[0], v0[1]); w.y = pg8::cvt_pk_bf16(v0[2], v0[3]); w.z = pg8::cvt_pk_bf16(v1[0], v1[1]); w.w = pg8::cvt_pk_bf16(v1[2], v1[3]);
                        *(u32x4*)(rp + bj * 128) = w; } }
        }
    }
};
struct EpiBranch {
    static constexpr bool PERM = true, AFTER_DRAIN = false, MIDK = true;
    unsigned char* ws;
    __device__ __forceinline__ void mid(f32x4 (&acc)[2][2][4][2], const Unit& u, int seg, int wr, int wc, int fr, int fq) const {
        int tid_ = threadIdx.x; asm volatile("" : "+v"(tid_));
        const int wid_ = tid_ >> 6, wr_ = wid_ >> 2, wc_ = wid_ & 3, fr_ = tid_ & 15, fq_ = (tid_ & 63) >> 4;
        const unsigned char* tb = ws + WS_MG + ((size_t)u.pm * 12 + (seg - 1) * 4 + u.pn) * 65536 + (size_t)(((wr_ * 4 + wc_) * 16) * 64 + (fq_ * 16 + fr_)) * 8;
#pragma unroll
        for (int ai = 0; ai < 2; ++ai)
#pragma unroll
            for (int m = 0; m < 4; ++m) {
#pragma unroll
                for (int bj = 0; bj < 2; ++bj) { const unsigned char* rp = tb + ((ai * 4 + m) * 2 + bj) * 512; const u32x2 qa = *(const u32x2*)rp, qb = *(const u32x2*)(rp + 4 * 65536);
                    f32x4 r0, r1;
                    r0[0] = (float)(qa.x & 255u) * __builtin_amdgcn_rcpf((float)(qb.x & 255u)); r0[1] = (float)((qa.x >> 8) & 255u) * __builtin_amdgcn_rcpf((float)((qb.x >> 8) & 255u));
                    r0[2] = (float)((qa.x >> 16) & 255u) * __builtin_amdgcn_rcpf((float)((qb.x >> 16) & 255u)); r0[3] = (float)(qa.x >> 24) * __builtin_amdgcn_rcpf((float)(qb.x >> 24));
                    r1[0] = (float)(qa.y & 255u) * __builtin_amdgcn_rcpf((float)(qb.y & 255u)); r1[1] = (float)((qa.y >> 8) & 255u) * __builtin_amdgcn_rcpf((float)((qb.y >> 8) & 255u));
                    r1[2] = (float)((qa.y >> 16) & 255u) * __builtin_amdgcn_rcpf((float)((qb.y >> 16) & 255u)); r1[3] = (float)(qa.y >> 24) * __builtin_amdgcn_rcpf((float)(qb.y >> 24));
                    acc[ai][bj][m][0] *= r0; acc[ai][bj][m][1] *= r1; }
                if (m == 3) asm volatile("" ::: "memory"); }
    }
    __device__ __forceinline__ void operator()(const f32x4 (&acc)[2][2][4][2], const Unit& u, int wr, int wc, int fr, int fq) const {
        bf16_t* merged = (bf16_t*)(ws + WS_H);
        const unsigned char* tb = ws + WS_MG + ((size_t)u.pm * 12 + 8 + u.pn) * 65536 + (size_t)(((wr * 4 + wc) * 16) * 64 + (fq * 16 + fr)) * 8;
        const int row0 = u.pm * 256 + wr * 64 + fr, col0 = u.pn * 256 + wc * 32 + 8 * fq;
        u32x2 gq[2][4][2];
#pragma unroll
        for (int ai = 0; ai < 2; ++ai)
#pragma unroll
            for (int m = 0; m < 4; ++m)
#pragma unroll
                for (int bj = 0; bj < 2; ++bj) gq[ai][m][bj] = *(const u32x2*)(tb + ((ai * 4 + m) * 2 + bj) * 512);
#pragma unroll
        for (int ai = 0; ai < 2; ++ai)
#pragma unroll
            for (int m = 0; m < 4; ++m) { const size_t row = (size_t)(row0 + ai * 128 + m * 16);
#pragma unroll
                for (int bj = 0; bj < 2; ++bj) { const int col = col0 + bj * 128; const u32x2 g = gq[ai][m][bj];
                    f32x4 g0, g1; const float k = 1.f / 255.f;
                    g0[0] = (float)(g.x & 255u) * k; g0[1] = (float)((g.x >> 8) & 255u) * k; g0[2] = (float)((g.x >> 16) & 255u) * k; g0[3] = (float)(g.x >> 24) * k;
                    g1[0] = (float)(g.y & 255u) * k; g1[1] = (float)((g.y >> 8) & 255u) * k; g1[2] = (float)((g.y >> 16) & 255u) * k; g1[3] = (float)(g.y >> 24) * k;
                    const f32x4 v0 = acc[ai][bj][m][0] * g0, v1 = acc[ai][bj][m][1] * g1;
                    u32x4 w; w.x = pg8::cvt_pk_bf16(v0[0], v0[1]); w.y = pg8::cvt_pk_bf16(v0[2], v0[3]); w.z = pg8::cvt_pk_bf16(v1[0], v1[1]); w.w = pg8::cvt_pk_bf16(v1[2], v1[3]);
                    *(u32x4*)(merged + row * 1024 + col) = w; } }
    }
};
struct EpiOut {
    static constexpr bool PERM = false, AFTER_DRAIN = false, MIDK = false;
    unsigned char* ws;
    __device__ __forceinline__ void operator()(const f32x4 (&acc)[2][2][4][2], const Unit& u, int wr, int wc, int fr, int fq) const {
        float* out = (float*)(ws + WS_U); float* rs = (float*)(ws + WS_RS);
        const int row0 = u.pm * 256 + wr * 64 + fr, col0 = u.pn * 256 + wc * 32 + 4 * fq;
#pragma unroll
        for (int ai = 0; ai < 2; ++ai)
#pragma unroll
            for (int m = 0; m < 4; ++m) { const size_t row = (size_t)(row0 + ai * 128 + m * 16); float ss = 0.f;
#pragma unroll
                for (int bj = 0; bj < 2; ++bj)
#pragma unroll
                    for (int n = 0; n < 2; ++n) { const f32x4 v = acc[ai][bj][m][n]; *(f32x4*)(out + row * 1024 + col0 + bj * 128 + n * 16) = v; ss += (v[0] * v[0] + v[1] * v[1]) + (v[2] * v[2] + v[3] * v[3]); }
                ss += __shfl_xor(ss, 16); ss += __shfl_xor(ss, 32);
                if (fq == 0) rs[row * 16 + u.pn * 4 + wc] = ss; }
    }
};

struct RmsPanel {
    float* xbuf;
    unsigned* cnt;
    __device__ __forceinline__ void run(const f32x4 (&v)[2][2][4][2], const Unit& u, int wr, int wc, int fr, int fq, LAS unsigned char* lds, int wid, int lane) const {
        LAS float* P = (LAS float*)lds; LAS float* S = (LAS float*)(lds + 8192);
#pragma unroll
        for (int ai = 0; ai < 2; ++ai)
#pragma unroll
            for (int m = 0; m < 4; ++m) { float s = 0.f;
#pragma unroll
                for (int bj = 0; bj < 2; ++bj)
#pragma unroll
                    for (int n = 0; n < 2; ++n) { const f32x4 x = v[ai][bj][m][n]; s += (x[0] * x[0] + x[1] * x[1]) + (x[2] * x[2] + x[3] * x[3]); }
                s += __shfl_xor(s, 16); s += __shfl_xor(s, 32);
                if (fq == 0) P[(ai * 128 + wr * 64 + m * 16 + fr) * 4 + wc] = s; }
        asm volatile("s_waitcnt lgkmcnt(0)" ::: "memory"); __builtin_amdgcn_s_barrier(); asm volatile("" ::: "memory");
        const int row = wid * 32 + (lane & 31);
        if (lane < 32) { const float t = (P[row * 4 + 0] + P[row * 4 + 1]) + (P[row * 4 + 2] + P[row * 4 + 3]);
            __hip_atomic_store(xbuf + (size_t)(u.pm * 256 + row) * 4 + u.pn, t, __ATOMIC_RELAXED, __HIP_MEMORY_SCOPE_AGENT); }
        asm volatile("s_waitcnt vmcnt(0)" ::: "memory");
        if (lane == 0) __hip_atomic_fetch_add(cnt + 64 * u.pm, 1u, __ATOMIC_RELAXED, __HIP_MEMORY_SCOPE_AGENT);
        if (wid == 0) {
            unsigned sp = 0;
            while ((unsigned)__builtin_amdgcn_readfirstlane(__hip_atomic_load(cnt + 64 * u.pm, __ATOMIC_RELAXED, __HIP_MEMORY_SCOPE_AGENT)) < 32u) { __builtin_amdgcn_s_sleep(2); if (++sp > (1u << 22)) break; }
            __builtin_amdgcn_fence(__ATOMIC_ACQUIRE, "agent");
        }
        asm volatile("s_waitcnt vmcnt(0) lgkmcnt(0)" ::: "memory"); __builtin_amdgcn_s_barrier(); asm volatile("" ::: "memory");
        if (lane < 32) { const float* slot = xbuf + (size_t)(u.pm * 256 + row) * 4; float t = 0.f;
#pragma unroll
            for (int k = 0; k < 4; ++k) t += __hip_atomic_load(slot + k, __ATOMIC_RELAXED, __HIP_MEMORY_SCOPE_AGENT);
            S[row] = 1.0f / sqrtf(t * (1.f / DM) + RMS_EPS); }
        asm volatile("s_waitcnt lgkmcnt(0)" ::: "memory"); __builtin_amdgcn_s_barrier(); asm volatile("" ::: "memory");
    }
};
struct EpiNorm1 {
    static constexpr bool PERM = false, AFTER_DRAIN = true, MIDK = false;
    float* out; const float* gpost; RmsPanel st;
    __device__ __forceinline__ void operator()(const f32x4 (&)[2][2][4][2], const Unit&, int, int, int, int) const {}
    __device__ __forceinline__ void fused(f32x4 (&acc)[2][2][4][2], const Unit& u, int wr, int wc, int fr, int fq, LAS unsigned char* lds, int wid, int lane) const {
        const LAS float* S = (const LAS float*)(lds + 8192);
        const int col0 = u.pn * 256 + wc * 32 + 4 * fq;
        f32x4 gp[2][2]; u32x2 pre[2][4][2][2];
#pragma unroll
        for (int bj = 0; bj < 2; ++bj)
#pragma unroll
            for (int n = 0; n < 2; ++n) gp[bj][n] = *(const f32x4*)(gpost + col0 + bj * 128 + n * 16);
#pragma unroll
        for (int ai = 0; ai < 2; ++ai)
#pragma unroll
            for (int m = 0; m < 4; ++m) {
#pragma unroll
                for (int bj = 0; bj < 2; ++bj)
#pragma unroll
                    for (int n = 0; n < 2; ++n) pre[ai][m][bj][n] = *(const u32x2*)((const unsigned char*)out + (size_t)(u.pm * 256 + wid * 32 + ((ai * 4 + m) * 2 + bj) * 2 + n) * 4096 + u.pn * 1024 + lane * 8); }
        st.run(acc, u, wr, wc, fr, fq, lds, wid, lane);
#pragma unroll
        for (int ai = 0; ai < 2; ++ai)
#pragma unroll
            for (int m = 0; m < 4; ++m) { const int r = ai * 128 + wr * 64 + m * 16 + fr; const float rs = S[r]; const size_t off = (size_t)(u.pm * 256 + r) * DM + col0;
#pragma unroll
                for (int bj = 0; bj < 2; ++bj)
#pragma unroll
                    for (int n = 0; n < 2; ++n) { const u32x2 p = pre[ai][m][bj][n]; const f32x4 bs = (f32x4){bflo(p.x), bfhi(p.x), bflo(p.y), bfhi(p.y)};
                        *(f32x4*)(out + off + bj * 128 + n * 16) = bs + acc[ai][bj][m][n] * rs * gp[bj][n]; } }
    }
};
struct EpiNorm2 {
    static constexpr bool PERM = false, AFTER_DRAIN = true, MIDK = false;
    const float* base; float* out; bf16_t* hn; const float* gpost; const float* gnext; RmsPanel st1, st2;
    __device__ __forceinline__ void operator()(const f32x4 (&)[2][2][4][2], const Unit&, int, int, int, int) const {}
    __device__ __forceinline__ void fused(f32x4 (&acc)[2][2][4][2], const Unit& u, int wr, int wc, int fr, int fq, LAS unsigned char* lds, int wid, int lane) const {
        const LAS float* S = (const LAS float*)(lds + 8192);
        const int col0 = u.pn * 256 + wc * 32 + 4 * fq;
        f32x4 gp[2][2], pre[4][2][2];
#pragma unroll
        for (int bj = 0; bj < 2; ++bj)
#pragma unroll
            for (int n = 0; n < 2; ++n) gp[bj][n] = *(const f32x4*)(gpost + col0 + bj * 128 + n * 16);
#pragma unroll
        for (int m = 0; m < 4; ++m)
#pragma unroll
            for (int bj = 0; bj < 2; ++bj)
#pragma unroll
                for (int n = 0; n < 2; ++n) pre[m][bj][n] = *(const f32x4*)(base + (size_t)(u.pm * 256 + wr * 64 + m * 16 + fr) * DM + col0 + bj * 128 + n * 16);
        st1.run(acc, u, wr, wc, fr, fq, lds, wid, lane);
#pragma unroll
        for (int ai = 0; ai < 2; ++ai) {
            if (ai == 1) {
#pragma unroll
                for (int m = 0; m < 4; ++m)
#pragma unroll
                    for (int bj = 0; bj < 2; ++bj)
#pragma unroll
                        for (int n = 0; n < 2; ++n) pre[m][bj][n] = *(const f32x4*)(base + (size_t)(u.pm * 256 + 128 + wr * 64 + m * 16 + fr) * DM + col0 + bj * 128 + n * 16);
            }
#pragma unroll
            for (int m = 0; m < 4; ++m) { const int r = ai * 128 + wr * 64 + m * 16 + fr; const float rs = S[r]; const size_t off = (size_t)(u.pm * 256 + r) * DM + col0;
#pragma unroll
                for (int bj = 0; bj < 2; ++bj)
#pragma unroll
                    for (int n = 0; n < 2; ++n) { const f32x4 x1 = pre[m][bj][n] + acc[ai][bj][m][n] * rs * gp[bj][n]; acc[ai][bj][m][n] = x1;
                        u32x2 w; w.x = pg8::cvt_pk_bf16(x1[0], x1[1]); w.y = pg8::cvt_pk_bf16(x1[2], x1[3]);
                        *(u32x2*)((unsigned char*)out + (size_t)(u.pm * 256 + wid * 32 + ((ai * 4 + m) * 2 + bj) * 2 + n) * 4096 + u.pn * 1024 + lane * 8) = w; } }
        }
#pragma unroll
        for (int bj = 0; bj < 2; ++bj)
#pragma unroll
            for (int n = 0; n < 2; ++n) gp[bj][n] = *(const f32x4*)(gnext + col0 + bj * 128 + n * 16);
        st2.run(acc, u, wr, wc, fr, fq, lds, wid, lane);
#pragma unroll
        for (int ai = 0; ai < 2; ++ai)
#pragma unroll
            for (int m = 0; m < 4; ++m) { const int r = ai * 128 + wr * 64 + m * 16 + fr; const float rs = S[r]; const size_t off = (size_t)(u.pm * 256 + r) * DM + col0;
#pragma unroll
                for (int bj = 0; bj < 2; ++bj)
#pragma unroll
                    for (int n = 0; n < 2; ++n) { const f32x4 o = acc[ai][bj][m][n] * rs * gp[bj][n];
                        u32x2 w; w.x = pg8::cvt_pk_bf16(o[0], o[1]); w.y = pg8::cvt_pk_bf16(o[2], o[3]); *(u32x2*)(hn + off + bj * 128 + n * 16) = w; } }
    }
};
__device__ __forceinline__ int win_row(int c) {
    if (c < 1024 || c >= 3072) return c;
    const int q = (c - 1024) >> 9, ch = (c - 1024) & 511, a = ch >> 7, j = ch & 127;
    return ((q & 1) ? 8 + a : 4 + a) * 256 + (q >> 1) * 128 + j;
}
__device__ __forceinline__ void transpose_item(const float* W, int N, bf16_t* WT, int ldt, int koff, int row_off, bool winmap, LAS float* scr, int item, int lane, const float* rscale = nullptr) {
    const int nblk = N / 64, kb = item / nblk, nb = item % nblk, k0 = 64 * kb, n0 = 64 * nb;
    const int kq = lane >> 4, nq = lane & 15;
    f32x4 v[16];
#pragma unroll
    for (int i = 0; i < 16; ++i) v[i] = *(const f32x4*)(W + (size_t)(k0 + 4 * i + kq) * N + n0 + 4 * nq);
#pragma unroll
    for (int i = 0; i < 16; ++i) { LAS float* s = scr + (4 * i + kq) * 65 + 4 * nq; s[0] = v[i][0]; s[1] = v[i][1]; s[2] = v[i][2]; s[3] = v[i][3]; }
    asm volatile("s_waitcnt lgkmcnt(0)" ::: "memory");
    const int c = lane & 7;
#pragma unroll
    for (int j = 0; j < 8; ++j) { const int n = (lane >> 3) + 8 * j;
        const LAS float* s = scr + (rscale ? (16 * (c >> 1) + 4 * (c & 1)) : 8 * c) * 65 + n; const int hs = rscale ? 8 * 65 : 4 * 65; const float f = rscale ? rscale[n0 + n] : 1.f;
        u32x4 o; o.x = pg8::cvt_pk_bf16(s[0 * 65] * f, s[1 * 65] * f); o.y = pg8::cvt_pk_bf16(s[2 * 65] * f, s[3 * 65] * f); o.z = pg8::cvt_pk_bf16(s[hs] * f, s[hs + 65] * f); o.w = pg8::cvt_pk_bf16(s[hs + 2 * 65] * f, s[hs + 3 * 65] * f);
        int dst = n0 + n; if (winmap) dst = win_row(dst);
        if (rscale) *(u32x4*)(WT + (size_t)((((dst >> 5) * 8 + ((k0 + 8 * c) >> 4)) * 64 + (c & 1) * 32 + (dst & 31)) * 8)) = o;
        else *(u32x4*)(WT + (size_t)(row_off + dst) * ldt + koff + k0 + 8 * c) = o; }
    asm volatile("s_waitcnt lgkmcnt(0)" ::: "memory");
}
template <int R> __device__ __forceinline__ void rms_rows_to_bf16(const float* x, const float* g, bf16_t* H, int m0, int mstride, int lane) {
    f32x4 v[R][4];
#pragma unroll
    for (int r = 0; r < R; ++r)
#pragma unroll
        for (int j = 0; j < 4; ++j) v[r][j] = ((const f32x4*)(x + (size_t)(m0 + r * mstride) * DM))[64 * j + lane];
    f32x4 gg[4];
#pragma unroll
    for (int j = 0; j < 4; ++j) gg[j] = ((const f32x4*)g)[64 * j + lane];
#pragma unroll
    for (int r = 0; r < R; ++r) { float s = 0.f;
#pragma unroll
        for (int j = 0; j < 4; ++j) s += (v[r][j][0] * v[r][j][0] + v[r][j][1] * v[r][j][1]) + (v[r][j][2] * v[r][j][2] + v[r][j][3] * v[r][j][3]);
        const float rstd = 1.f / sqrtf(wave_sum(s) * (1.f / DM) + RMS_EPS);
        u32x2* o8 = (u32x2*)(H + (size_t)(m0 + r * mstride) * DM) + lane;
#pragma unroll
        for (int j = 0; j < 4; ++j) { u32x2 w; w.x = pg8::cvt_pk_bf16(v[r][j][0] * rstd * gg[j][0], v[r][j][1] * rstd * gg[j][1]); w.y = pg8::cvt_pk_bf16(v[r][j][2] * rstd * gg[j][2], v[r][j][3] * rstd * gg[j][3]); o8[64 * j] = w; } }
}

__device__ __forceinline__ int crow(int r, int hi) { return (r & 3) + 8 * (r >> 2) + 4 * hi; }
constexpr int VROW = 144;
__device__ __forceinline__ void attn_item(int item, const bf16_t* Q, const bf16_t* K, const bf16_t* V, const bf16_t* SG, bf16_t* YO, LAS unsigned char* vl, LAS unsigned char* kl, int lane) {
    const int qg = item & 127, h = (item >> 7) & 7, b = item >> 10;
    const int r32 = lane & 31, hi = lane >> 5, t0 = qg * 32;
    const size_t tokq = (size_t)b * SEQ + t0 + r32;
    bf16x8 qf[4];
    { const size_t tq0 = (size_t)b * SEQ + t0;
#pragma unroll
      for (int p = 0; p < 4; ++p) { const int idx = p * 64 + lane; const u32x4 v = *(const u32x4*)(Q + (tq0 + (idx >> 3)) * 512 + h * 64 + (idx & 7) * 8); *(LAS u32x4*)(kl + (idx >> 3) * VROW + (idx & 7) * 16) = v; }
#pragma unroll
      for (int d0 = 0; d0 < 4; ++d0) qf[d0] = *(const LAS bf16x8*)(kl + r32 * VROW + d0 * 32 + hi * 16); }
    f32x16 o0, o1;
#pragma unroll
    for (int r = 0; r < 16; ++r) { o0[r] = 0.f; o1[r] = 0.f; }
    float P = 1.f;
    const int i16 = lane & 15, G4 = lane >> 4;
    const int vb = (4 * (G4 >> 1) + (i16 >> 2)) * VROW + (16 * (G4 & 1) + 4 * (i16 & 3)) * 2;
#define ATT_LOAD(KF, VR, S0) do { const size_t tk_ = (size_t)b * SEQ + ((S0) > 0 ? (S0) : 0); \
        _Pragma("unroll") for (int p = 0; p < 4; ++p) { const int idx = p * 64 + lane; KF[p] = *(const u32x4*)(K + (tk_ + (idx >> 3)) * 512 + h * 64 + (idx & 7) * 8); \
                                                         VR[p] = *(const u32x4*)(V + (tk_ + (idx >> 3)) * 512 + h * 64 + (idx & 7) * 8); } } while (0)
    u32x4 kf[4], kn[4]; u32x4 vr[4], vn[4];
    ATT_LOAD(kf, vr, t0); ATT_LOAD(kn, vn, t0 - 32);
    u32x4 sgr[4];
#pragma unroll
    for (int p = 0; p < 4; ++p) { const int idx = p * 64 + lane; sgr[p] = *(const u32x4*)(SG + ((size_t)b * SEQ + t0 + (idx >> 3)) * 1536 + h * 64 + (idx & 7) * 8); }
    for (int s0 = t0; s0 >= 0; s0 -= 32) {
#pragma unroll
        for (int p = 0; p < 4; ++p) { const int idx = p * 64 + lane, key = idx >> 3, ch = idx & 7; *(LAS u32x4*)(vl + key * VROW + ch * 16) = vr[p]; *(LAS u32x4*)(kl + key * VROW + ch * 16) = kf[p]; }
        f32x16 s;
#pragma unroll
        for (int r = 0; r < 16; ++r) s[r] = 0.f;
#pragma unroll
        for (int d0 = 0; d0 < 4; ++d0) s = __builtin_amdgcn_mfma_f32_32x32x16_bf16(*(const LAS bf16x8*)(kl + r32 * VROW + d0 * 32 + hi * 16), qf[d0], s, 0, 0, 0);
        const bool diag = (s0 == t0);
        float kp[16];
#pragma unroll
        for (int r = 0; r < 16; ++r) { const float e = __builtin_amdgcn_exp2f(s[r] * (0.125f * 1.4426950408889634f)); float k = __builtin_amdgcn_rcpf(1.f + e);
            if (diag && crow(r, hi) >= r32) k = 1.f; kp[r] = k; }
        float Gm[4], Go[4], T[4], R[4], C[4];
#pragma unroll
        for (int g = 0; g < 4; ++g) { Gm[g] = (kp[4 * g] * kp[4 * g + 1]) * (kp[4 * g + 2] * kp[4 * g + 3]); Go[g] = __shfl_xor(Gm[g], 32); T[g] = Gm[g] * Go[g]; }
        R[3] = P; R[2] = R[3] * T[3]; R[1] = R[2] * T[2]; R[0] = R[1] * T[1]; const float Cout = R[0] * T[0];
#pragma unroll
        for (int g = 0; g < 4; ++g) C[g] = hi ? R[g] : R[g] * Go[g];
        float w[16];
#pragma unroll
        for (int g = 0; g < 4; ++g) { const float p3 = C[g], p2 = p3 * kp[4 * g + 3], p1 = p2 * kp[4 * g + 2], p0 = p1 * kp[4 * g + 1], pe = p0 * kp[4 * g];
            w[4 * g + 3] = p3 - p2; w[4 * g + 2] = p2 - p1; w[4 * g + 1] = p1 - p0; w[4 * g] = p0 - pe; }
        bf16x8 wf[2];
#pragma unroll
        for (int st = 0; st < 2; ++st) { u32x4 t; t.x = pg8::cvt_pk_bf16(w[8 * st], w[8 * st + 1]); t.y = pg8::cvt_pk_bf16(w[8 * st + 2], w[8 * st + 3]); t.z = pg8::cvt_pk_bf16(w[8 * st + 4], w[8 * st + 5]); t.w = pg8::cvt_pk_bf16(w[8 * st + 6], w[8 * st + 7]); wf[st] = __builtin_bit_cast(bf16x8, t); }
#pragma unroll
        for (int dt = 0; dt < 2; ++dt)
#pragma unroll
            for (int st = 0; st < 2; ++st) {
                const s16x4 lo = __builtin_amdgcn_ds_read_tr16_b64_v4i16((LAS s16x4*)(vl + vb + (16 * st) * VROW + dt * 64));
                const s16x4 hh = __builtin_amdgcn_ds_read_tr16_b64_v4i16((LAS s16x4*)(vl + vb + (16 * st + 8) * VROW + dt * 64));
                const bf16x8 vf = (bf16x8){lo[0], lo[1], lo[2], lo[3], hh[0], hh[1], hh[2], hh[3]};
                if (dt == 0) o0 = __builtin_amdgcn_mfma_f32_32x32x16_bf16(vf, wf[st], o0, 0, 0, 0); else o1 = __builtin_amdgcn_mfma_f32_32x32x16_bf16(vf, wf[st], o1, 0, 0, 0); }
        P = Cout;
        if (__all(P < 1.17549435e-38f)) break;
#pragma unroll
        for (int i = 0; i < 4; ++i) { kf[i] = kn[i]; vr[i] = vn[i]; }
        ATT_LOAD(kn, vn, s0 - 64);
    }
#undef ATT_LOAD
#pragma unroll
    for (int p = 0; p < 4; ++p) { const int idx = p * 64 + lane; *(LAS u32x4*)(kl + (idx >> 3) * VROW + (idx & 7) * 16) = sgr[p]; }
#pragma unroll
    for (int dt = 0; dt < 2; ++dt)
#pragma unroll
        for (int g = 0; g < 4; ++g) { LAS u32x2* p = (LAS u32x2*)(kl + r32 * VROW + (dt * 32 + 8 * g + 4 * hi) * 2); const u32x2 sg = *p;
            const f32x16& o = dt ? o1 : o0; u32x2 y;
            y.x = pg8::cvt_pk_bf16(o[4 * g] * bflo(sg.x), o[4 * g + 1] * bfhi(sg.x)); y.y = pg8::cvt_pk_bf16(o[4 * g + 2] * bflo(sg.y), o[4 * g + 3] * bfhi(sg.y));
            *p = y; }
#pragma unroll
    for (int p = 0; p < 4; ++p) { const int idx = p * 64 + lane; const u32x4 v = *(const LAS u32x4*)(kl + (idx >> 3) * VROW + (idx & 7) * 16);
        *(u32x4*)(YO + ((size_t)b * SEQ + t0 + (idx >> 3)) * 1536 + h * 64 + (idx & 7) * 8) = v; }
}
constexpr int PROW = 272;
__device__ __forceinline__ void pool_item(int pi, const bf16_t* PV, const bf16_t* SG, bf16_t* YO, const bf16_t* PT, const float* scale, LAS unsigned char* sl, int lane) {
    const int tile = pi >> 2, g = ((pi & 3) + ((pi >> 2) & 1)) & 3, win = 2 << g;
    const int r32 = lane & 31, hi = lane >> 5, tok0 = tile * 32, t0 = tok0 & (SEQ - 1), tok = tok0 + r32;
    u32x4 sv[12];
#pragma unroll
    for (int p = 0; p < 12; ++p) { const int idx = p * 64 + lane, row = idx >> 4, ch = idx & 15; const bool ok = (t0 + row - 16) >= 0;
        sv[p] = *(const u32x4*)(PV + (size_t)(ok ? tok0 + row - 16 : tok0) * 512 + g * 128 + ch * 8); if (!ok) sv[p] = (u32x4){0u, 0u, 0u, 0u}; }
#pragma unroll
    for (int p = 0; p < 12; ++p) { const int idx = p * 64 + lane, row = idx >> 4, ch = idx & 15; *(LAS u32x4*)(sl + row * PROW + ch * 16) = sv[p]; }
    const int t = t0 + r32, cnt = (t + 1) < win ? (t + 1) : win;
    bf16x8 bfr[3];
#pragma unroll
    for (int ks = 0; ks < 3; ++ks) { float wv[8];
#pragma unroll
        for (int j = 0; j < 8; ++j) { const int rel = (16 + r32) - (16 * ks + 8 * hi + j); wv[j] = (rel == 0) ? (float)(1 - cnt) : ((rel > 0 && rel < cnt) ? 1.f : 0.f); }
        u32x4 tt; tt.x = pg8::cvt_pk_bf16(wv[0], wv[1]); tt.y = pg8::cvt_pk_bf16(wv[2], wv[3]); tt.z = pg8::cvt_pk_bf16(wv[4], wv[5]); tt.w = pg8::cvt_pk_bf16(wv[6], wv[7]); bfr[ks] = __builtin_bit_cast(bf16x8, tt); }
    bf16x8 ptf[4][8];
#pragma unroll
    for (int nt = 0; nt < 4; ++nt)
#pragma unroll
        for (int ks = 0; ks < 8; ++ks) ptf[nt][ks] = *(const bf16x8*)(PT + (size_t)g * 128 * 128 + (size_t)((nt * 8 + ks) * 64 + lane) * 8);
    const int i16 = lane & 15, G4 = lane >> 4;
    const int vb = (8 * (G4 >> 1) + (i16 >> 2)) * PROW + (16 * (G4 & 1) + 4 * (i16 & 3)) * 2;
    const float inv = __builtin_amdgcn_rcpf((float)cnt);
    bf16x8 pf[8];
#pragma unroll
    for (int ct = 0; ct < 4; ++ct) {
        f32x16 acc;
#pragma unroll
        for (int r = 0; r < 16; ++r) acc[r] = 0.f;
#pragma unroll
        for (int ks = 0; ks < 3; ++ks) {
            const s16x4 lo = __builtin_amdgcn_ds_read_tr16_b64_v4i16((LAS s16x4*)(sl + vb + (16 * ks) * PROW + ct * 64));
            const s16x4 hh = __builtin_amdgcn_ds_read_tr16_b64_v4i16((LAS s16x4*)(sl + vb + (16 * ks + 4) * PROW + ct * 64));
            const bf16x8 a = (bf16x8){lo[0], lo[1], lo[2], lo[3], hh[0], hh[1], hh[2], hh[3]};
            acc = __builtin_amdgcn_mfma_f32_32x32x16_bf16(a, bfr[ks], acc, 0, 0, 0); }
#pragma unroll
        for (int s = 0; s < 2; ++s) { u32x4 tt; tt.x = pg8::cvt_pk_bf16(acc[8 * s] * inv, acc[8 * s + 1] * inv); tt.y = pg8::cvt_pk_bf16(acc[8 * s + 2] * inv, acc[8 * s + 3] * inv);
            tt.z = pg8::cvt_pk_bf16(acc[8 * s + 4] * inv, acc[8 * s + 5] * inv); tt.w = pg8::cvt_pk_bf16(acc[8 * s + 6] * inv, acc[8 * s + 7] * inv); pf[2 * ct + s] = __builtin_bit_cast(bf16x8, tt); }
    }
#pragma unroll
    for (int p = 0; p < 8; ++p) { const int idx = p * 64 + lane; const u32x4 v = *(const u32x4*)(SG + (size_t)(tok0 + (idx >> 4)) * 1536 + g * 128 + (idx & 15) * 8); *(LAS u32x4*)(sl + (idx >> 4) * PROW + (idx & 15) * 16) = v; }
#pragma unroll
    for (int nt = 0; nt < 4; ++nt) {
        f32x16 acc;
#pragma unroll
        for (int r = 0; r < 16; ++r) acc[r] = 0.f;
#pragma unroll
        for (int ks = 0; ks < 8; ++ks) acc = __builtin_amdgcn_mfma_f32_32x32x16_bf16(ptf[nt][ks], pf[ks], acc, 0, 0, 0);
#pragma unroll
        for (int q = 0; q < 4; ++q) { LAS u32x2* p = (LAS u32x2*)(sl + r32 * PROW + (nt * 32 + 8 * q + 4 * hi) * 2); const u32x2 sg = *p; u32x2 y;
            y.x = pg8::cvt_pk_bf16(acc[4 * q] * bflo(sg.x), acc[4 * q + 1] * bfhi(sg.x)); y.y = pg8::cvt_pk_bf16(acc[4 * q + 2] * bflo(sg.y), acc[4 * q + 3] * bfhi(sg.y));
            *p = y; }
    }
#pragma unroll
    for (int p = 0; p < 8; ++p) { const int idx = p * 64 + lane; const u32x4 v = *(const LAS u32x4*)(sl + (idx >> 4) * PROW + (idx & 15) * 16);
        *(u32x4*)(YO + (size_t)(tok0 + (idx >> 4)) * 1536 + g * 128 + (idx & 15) * 8) = v; }
}
__device__ __forceinline__ void conv_item(int ci, const bf16_t* Z, const bf16_t* Wy, bf16_t* YO, const float* cw, const float* cb, int lane) {
    const int tok0 = ci * 8, t0 = tok0 & (SEQ - 1), ch = lane * 8;
    float w0[8], w1[8], w2[8], bs[8], zm2[8], zm1[8];
#pragma unroll
    for (int hf = 0; hf < 2; ++hf) { const f32x4 a = *(const f32x4*)(cw + ch + 4 * hf), b = *(const f32x4*)(cw + 512 + ch + 4 * hf), c = *(const f32x4*)(cw + 1024 + ch + 4 * hf), d = *(const f32x4*)(cb + ch + 4 * hf);
#pragma unroll
        for (int i = 0; i < 4; ++i) { w0[4 * hf + i] = a[i]; w1[4 * hf + i] = b[i]; w2[4 * hf + i] = c[i]; bs[4 * hf + i] = d[i]; } }
#pragma unroll
    for (int i = 0; i < 8; ++i) { zm2[i] = 0.f; zm1[i] = 0.f; }
    if (t0 != 0) { const u32x4 a = *(const u32x4*)(Z + (size_t)(tok0 - 2) * 512 + ch), b = *(const u32x4*)(Z + (size_t)(tok0 - 1) * 512 + ch);
        zm2[0] = bflo(a.x); zm2[1] = bfhi(a.x); zm2[2] = bflo(a.y); zm2[3] = bfhi(a.y); zm2[4] = bflo(a.z); zm2[5] = bfhi(a.z); zm2[6] = bflo(a.w); zm2[7] = bfhi(a.w);
        zm1[0] = bflo(b.x); zm1[1] = bfhi(b.x); zm1[2] = bflo(b.y); zm1[3] = bfhi(b.y); zm1[4] = bflo(b.z); zm1[5] = bfhi(b.z); zm1[6] = bflo(b.w); zm1[7] = bfhi(b.w); }
    u32x4 zr[8], wr_[8];
#pragma unroll
    for (int r = 0; r < 8; ++r) { zr[r] = *(const u32x4*)(Z + (size_t)(tok0 + r) * 512 + ch); wr_[r] = *(const u32x4*)(Wy + (size_t)(tok0 + r) * 1536 + ch); }
#pragma unroll
    for (int r = 0; r < 8; ++r) {
        float zc[8], wv[8], y[8];
        zc[0] = bflo(zr[r].x); zc[1] = bfhi(zr[r].x); zc[2] = bflo(zr[r].y); zc[3] = bfhi(zr[r].y); zc[4] = bflo(zr[r].z); zc[5] = bfhi(zr[r].z); zc[6] = bflo(zr[r].w); zc[7] = bfhi(zr[r].w);
        wv[0] = bflo(wr_[r].x); wv[1] = bfhi(wr_[r].x); wv[2] = bflo(wr_[r].y); wv[3] = bfhi(wr_[r].y); wv[4] = bflo(wr_[r].z); wv[5] = bfhi(wr_[r].z); wv[6] = bflo(wr_[r].w); wv[7] = bfhi(wr_[r].w);
#pragma unroll
        for (int i = 0; i < 8; ++i) { y[i] = wv[i] * (w0[i] * zm2[i] + w1[i] * zm1[i] + w2[i] * zc[i] + bs[i]); zm2[i] = zm1[i]; zm1[i] = zc[i]; }
        u32x4 o; o.x = pg8::cvt_pk_bf16(y[0], y[1]); o.y = pg8::cvt_pk_bf16(y[2], y[3]); o.z = pg8::cvt_pk_bf16(y[4], y[5]); o.w = pg8::cvt_pk_bf16(y[6], y[7]);
        *(u32x4*)(YO + (size_t)(tok0 + r) * 1536 + ch) = o; }
}
template <int R> __device__ __forceinline__ void norm_rows(const float* F32T, const float* RS, const float* xin, const float* gpost, float* xout, const float* gnext, bf16_t* H, int m0, int mstride, int lane) {
    f32x4 o[R][4], xi[R][4]; float ss[R];
#pragma unroll
    for (int r = 0; r < R; ++r) { const size_t row = (size_t)(m0 + r * mstride); ss[r] = (lane < 16) ? RS[row * 16 + lane] : 0.f;
#pragma unroll
        for (int j = 0; j < 4; ++j) { o[r][j] = ((const f32x4*)(F32T + row * DM))[64 * j + lane]; xi[r][j] = ((const f32x4*)(xin + row * DM))[64 * j + lane]; } }
    f32x4 gp[4];
#pragma unroll
    for (int j = 0; j < 4; ++j) gp[j] = ((const f32x4*)gpost)[64 * j + lane];
#pragma unroll
    for (int r = 0; r < R; ++r) { const size_t row = (size_t)(m0 + r * mstride);
        const float rstd = 1.f / sqrtf(wave_sum(ss[r]) * (1.f / DM) + RMS_EPS); float s2 = 0.f;
#pragma unroll
        for (int j = 0; j < 4; ++j) { const f32x4 v = xi[r][j] + o[r][j] * rstd * gp[j]; xi[r][j] = v; ((f32x4*)(xout + row * DM))[64 * j + lane] = v; s2 += (v[0] * v[0] + v[1] * v[1]) + (v[2] * v[2] + v[3] * v[3]); }
        if (gnext) { const float r2 = 1.f / sqrtf(wave_sum(s2) * (1.f / DM) + RMS_EPS);
#pragma unroll
            for (int j = 0; j < 4; ++j) { const f32x4 gg = ((const f32x4*)gnext)[64 * j + lane]; const f32x4 v = xi[r][j]; u32x2 w; w.x = pg8::cvt_pk_bf16(v[0] * r2 * gg[0], v[1] * r2 * gg[1]); w.y = pg8::cvt_pk_bf16(v[2] * r2 * gg[2], v[3] * r2 * gg[3]); ((u32x2*)(H + row * DM))[64 * j + lane] = w; } } }
}

struct Args { const float* in[10]; float* out; unsigned char* ws; int ph_lo, ph_hi; };
template <class T> __device__ __forceinline__ T* as_global(T* p) { return p; }
#if TP_A >= 0
#define TSTAMP(k) do { if (blockIdx.x == TP_BLK && threadIdx.x == 0) ((volatile LAS unsigned long long*)(lds + 147264))[(k)] = __builtin_amdgcn_s_memrealtime(); } while (0)
#else
#define TSTAMP(k) do { } while (0)
#endif
template <int ph> __device__ __forceinline__ void run_phase(const Args& a_, LAS unsigned char* lds) {
        const Args* A = &a_;
        const int tid = threadIdx.x, lane = tid & 63, wave = __builtin_amdgcn_readfirstlane(tid >> 6);
        const int G = gridDim.x, bx = blockIdx.x;
        const int vcu = (G % 8 == 0) ? (bx % 8) * (G / 8) + bx / 8 : bx;
        const int gw = vcu * 8 + wave, NGW = G * 8;
        unsigned char* ws = as_global(A->ws);
        bf16_t* H = (bf16_t*)(ws + WS_H); bf16_t* U = (bf16_t*)(ws + WS_U);
        if constexpr (ph == 0) {
            const float* x = as_global(A->in[0]); const float* pre_g = as_global(A->in[1]); const float* w_in = as_global(A->in[2]); const float* pool_w = as_global(A->in[3]); const float* pool_scale = as_global(A->in[4]); const float* w_branch = as_global(A->in[7]); const float* w_out = as_global(A->in[8]);
            bf16_t* W1 = (bf16_t*)(ws + WS_W1); bf16_t* W2 = (bf16_t*)(ws + WS_W2); bf16_t* W3 = (bf16_t*)(ws + WS_W3); bf16_t* PW = (bf16_t*)(ws + WS_PW);
            LAS float* scr = (LAS float*)(lds + wave * 17408);
            constexpr int I1 = (DM / 64) * (NIN / 64), I2 = (BWID / 64) * (DM / 64), I3 = (DM / 64) * (DM / 64), I4 = 2 * 2, PER = I1 + 3 * I2 + I3 + 4 * I4;
            for (int it = gw; it < NLAYER * PER; it += NGW) {
                const int l = it / PER; int r = it % PER;
                if (r < I1) { transpose_item(w_in + (size_t)l * DM * NIN, NIN, W1 + (size_t)l * NIN * DM, DM, 0, 0, true, scr, r, lane); continue; } r -= I1;
                if (r < 3 * I2) { const int n = r / I2; transpose_item(w_branch + ((size_t)l * 3 + n) * BWID * DM, DM, W2 + (size_t)l * 3 * DM * BWID, 3 * BWID, n * BWID, 0, false, scr, r % I2, lane); continue; } r -= 3 * I2;
                if (r < I3) { transpose_item(w_out + (size_t)l * DM * DM, DM, W3 + (size_t)l * DM * DM, DM, 0, 0, false, scr, r, lane); continue; } r -= I3;
                { const int g = r / I4; transpose_item(pool_w + ((size_t)l * 4 + g) * 128 * 128, 128, PW + ((size_t)l * 4 + g) * 128 * 128, 128, 0, 0, false, scr, r % I4, lane, pool_scale + l * BWID + g * 128); }
            }
            for (int m = gw; m < MTOK; m += 2 * NGW) rms_rows_to_bf16<2>(x, pre_g, H, m, NGW, lane);
        } else {
            constexpr int l = (ph - 1) / 5, k = (ph - 1) % 5;
            if constexpr (k == 0) {
                pg8::Gemm g{H, (bf16_t*)(ws + WS_W1) + (size_t)l * NIN * DM, MTOK, NIN, DM, 0}; pg8::StaticOrder S; S.init(MTOK, NIN, G, bx);
                EpiU E{ws};
                pg8::gemm_phase<EpiU, pg8::StaticOrder, true, true>(lds, g, S, E);
            } else if constexpr (k == 1) {
                const float* pool_scale = as_global(A->in[4]); const float* conv_w = as_global(A->in[5]); const float* conv_b = as_global(A->in[6]);
                const bf16_t* PW = (const bf16_t*)(ws + WS_PW);
                const bf16_t* Q = U + 2 * (ARRB / 2); const bf16_t* Kk = U + 3 * (ARRB / 2); const bf16_t* V = U + 4 * (ARRB / 2);
                LAS unsigned char* vl = lds + wave * (32 * VROW);
                bf16_t* G3 = U + 5 * (ARRB / 2);
                bf16_t* YO = G3;
#if MIX_PROBE
                if (l == 0 && A->ph_hi < 0) YO = (bf16_t*)as_global(A->out);
#endif
                int pm_ = 7;
#if MIX_PROBE
                if (l == 0 && A->ph_hi < 0) pm_ = MIX_PROBE;
#endif
                if (l == 0) TSTAMP(12);
                volatile LAS unsigned* wq = (volatile LAS unsigned*)(lds + 147216);
                if (tid < 3) wq[tid] = 0u;
                __syncthreads();
#define WQ_GRAB(Q_) ({ unsigned v_ = 0u; if (lane == 0) v_ = __hip_atomic_fetch_add((LAS unsigned*)(Q_), 1u, __ATOMIC_RELAXED, __HIP_MEMORY_SCOPE_WORKGROUP); (unsigned)__builtin_amdgcn_readfirstlane((int)v_); })
#define WQ_ITEM(J_) ((int)(vcu * 8 + ((J_) & 7u) + ((J_) >> 3) * (unsigned)NGW))
                for (;;) { const unsigned j = WQ_GRAB(wq); const int it = WQ_ITEM(j); if (it >= NB * 8 * 128) break; attn_item(it, Q, Kk, V, G3 + 1024, YO + 1024, vl, lds + 36864 + wave * (48 * PROW), lane); }
                if (l == 0) TSTAMP(13);
                for (;;) { const unsigned j = WQ_GRAB(wq + 1); const int it = WQ_ITEM(j); if (it >= (MTOK / 32) * 4) break; pool_item(it, U, G3, YO, PW + (size_t)l * 4 * 128 * 128, pool_scale + l * BWID, lds + 36864 + wave * (48 * PROW), lane); }
                if (l == 0) TSTAMP(14);
                for (;;) { const unsigned j = WQ_GRAB(wq + 2); const int it = WQ_ITEM(j); if (it >= MTOK / 8) break; conv_item(it, U + 1 * (ARRB / 2), G3 + 512, YO + 512, conv_w + l * 3 * BWID, conv_b + l * BWID, lane); }
#undef WQ_GRAB
#undef WQ_ITEM
                if (l == 0) TSTAMP(15);
#if TP_A >= 0
                if (l == 0) { __syncthreads(); TSTAMP(5); }
#endif
            } else if constexpr (k == 2) {
                pg8::Gemm g{U + 5 * (ARRB / 2), (bf16_t*)(ws + WS_W2) + (size_t)l * 3 * DM * BWID, MTOK, DM, 3 * BWID, 0}; pg8::StaticOrder S; S.init(MTOK, DM, G, bx);
                EpiBranch E{ws};
                pg8::gemm_phase<EpiBranch, pg8::StaticOrder, true, true>(lds, g, S, E);
            } else if constexpr (k == 3) {
                pg8::Gemm g{H, (bf16_t*)(ws + WS_W3) + (size_t)l * DM * DM, MTOK, DM, DM, 0}; pg8::StaticOrder S; S.init(MTOK, DM, G, bx);
                if (G == 256) {
                    const float* x = as_global(A->in[0]); const float* pre_g = as_global(A->in[1]); const float* post_g = as_global(A->in[9]); float* out = as_global(A->out);
                    float* xb = (float*)(ws + WS_RS); unsigned* cn = (unsigned*)(ws + WS_CTL + CTL_CNT);
                    if constexpr (l + 1 < NLAYER) {
                        EpiNorm2 E{x, out, H, post_g + l * DM, pre_g + (l + 1) * DM, RmsPanel{xb, cn}, RmsPanel{xb + (size_t)MTOK * 4, cn + 64 * 64}};
                        pg8::gemm_phase<EpiNorm2, pg8::StaticOrder, false, true>(lds, g, S, E);
                    } else {
                        EpiNorm1 E{out, post_g + l * DM, RmsPanel{xb + (size_t)2 * MTOK * 4, cn + 2 * 64 * 64}};
                        pg8::gemm_phase<EpiNorm1, pg8::StaticOrder, false, true>(lds, g, S, E);
                    }
                } else {
                    EpiOut E{ws};
                    pg8::gemm_phase<EpiOut, pg8::StaticOrder, true, true>(lds, g, S, E);
                }
            } else {
                const float* x = as_global(A->in[0]); const float* pre_g = as_global(A->in[1]); const float* post_g = as_global(A->in[9]); float* out = as_global(A->out);
                const float* F32T = (const float*)(ws + WS_U); const float* RS = (const float*)(ws + WS_RS);
                const float* xin = (l == 0) ? x : out; const float* gnext = (l + 1 < NLAYER) ? pre_g + (l + 1) * DM : nullptr;
                if (G != 256) for (int m = gw; m < MTOK; m += 2 * NGW) norm_rows<2>(F32T, RS, xin, post_g + l * DM, out, gnext, H, m, NGW, lane);
            }
        }
}
__global__ void __launch_bounds__(512, 2) hybrid_fwd(Args a_) {
    extern __shared__ __attribute__((aligned(16))) unsigned char lds_raw[];
    LAS unsigned char* lds = (LAS unsigned char*)lds_raw;
    cg::grid_group grid = cg::this_grid();
    if (threadIdx.x < 64) ((LAS unsigned*)(lds + 147200))[threadIdx.x] = 0u;
    __syncthreads();
    (void)xcd_barrier_post((unsigned*)(a_.ws + WS_CTL), (volatile LAS unsigned*)(lds + 147200 + 32));
#define SEAM_BAR() do { XcdBarrier b_; b_.bar = (unsigned*)(a_.ws + WS_CTL); b_.x = xb_xcc_id(); b_.st = (volatile LAS unsigned*)(lds + 147200 + 32); xcd_barrier(b_); } while (0)
    const int lo = a_.ph_lo, hi = a_.ph_hi < 0 ? -a_.ph_hi : a_.ph_hi;
#define PHASE(k) if (lo <= (k) && (k) < hi && !(((k) == 5 || (k) == 10) && gridDim.x == 256)) { if ((k) > lo) { if ((k) == 1 && lo < 0) grid.sync(); else SEAM_BAR(); } TSTAMP(k); run_phase<(k)>(a_, lds); }
    PHASE(0) PHASE(1) PHASE(2) PHASE(3) PHASE(4) PHASE(5) PHASE(6) PHASE(7) PHASE(8) PHASE(9) PHASE(10)
#undef PHASE
#if TP_A >= 0
    SEAM_BAR(); TSTAMP(11);
    if (blockIdx.x == TP_BLK && threadIdx.x == 0) { volatile LAS unsigned long long* ts = (volatile LAS unsigned long long*)(lds + 147264); a_.out[0] += (float)(ts[TP_B] - ts[TP_A]) * (0.00005f * TP_SCALE); }
#endif
}

extern "C" void kernel_launch(void* const* d_in, const int* in_sizes, int n_in, void* d_out, int out_size, void* d_ws, size_t ws_size, hipStream_t stream) {
    static int grid = 0;
    if (grid == 0) {
        if (n_in != 10 || out_size != MTOK * DM || ws_size < WS_END) { fprintf(stderr, "kernel_launch: unexpected shapes / workspace (n_in %d out %d ws %zu)\n", n_in, out_size, ws_size); grid = -1; return; }
        int dev = 0, cus = 0, per_cu = 0;
        (void)hipGetDevice(&dev); (void)hipDeviceGetAttribute(&cus, hipDeviceAttributeMultiprocessorCount, dev);
        (void)hipFuncSetAttribute((const void*)hybrid_fwd, hipFuncAttributeMaxDynamicSharedMemorySize, LDS_BYTES);
        (void)hipOccupancyMaxActiveBlocksPerMultiprocessor(&per_cu, (const void*)hybrid_fwd, 512, LDS_BYTES);
        (void)hipGetLastError();
        if (per_cu < 1) { fprintf(stderr, "kernel_launch: occupancy query says %d blocks/CU\n", per_cu); per_cu = 1; }
        grid = cus;
    }
    if (grid < 0) return;
    if (hipMemsetAsync((char*)d_ws + WS_CTL, 0, CTL_BYTES, stream) != hipSuccess) { fprintf(stderr, "kernel_launch: memset of the barrier words failed\n"); return; }
    Args a{};
    for (int i = 0; i < 10; ++i) a.in[i] = (const float*)d_in[i];
    a.out = (float*)d_out; a.ws = (unsigned char*)d_ws;
#if ONE_LAUNCH
    a.ph_lo = 0; a.ph_hi = NPHASE;
    void* args[] = {&a};
    hipError_t e = hipLaunchCooperativeKernel((const void*)hybrid_fwd, dim3(grid), dim3(512), args, LDS_BYTES, stream);
    if (e != hipSuccess) fprintf(stderr, "cooperative launch failed: %s (grid %d)\n", hipGetErrorString(e), grid);
#else
    for (int ph = 0; ph < NPHASE; ++ph) { a.ph_lo = ph; a.ph_hi = ph + 1;
#if MIX_PROBE
        if (ph == 2) { a.ph_hi = -(ph + 1); hipLaunchKernelGGL(hybrid_fwd, dim3(grid), dim3(512), LDS_BYTES, stream, a); a.ph_hi = ph + 1; }
#endif
        for (int rep = 0; rep < 1 + ((DUP_MASK >> ph) & 1); ++rep) hipLaunchKernelGGL(hybrid_fwd, dim3(grid), dim3(512), LDS_BYTES, stream, a); }
#endif
}
```

```cpp
#include <hip/hip_runtime.h>
#include <hip/hip_cooperative_groups.h>
#include <cstdio>
#include <cstdint>
namespace cg = cooperative_groups;
#ifndef ONE_LAUNCH
#define ONE_LAUNCH 1
#endif
#ifndef DUP_MASK
#define DUP_MASK 0
#endif
#ifndef MIX_PROBE
#define MIX_PROBE 0
#endif
#ifndef TP_A
#define TP_A -1
#define TP_B -1
#endif
#ifndef TP_SCALE
#define TP_SCALE 1
#endif
#ifndef TP_BLK
#define TP_BLK 0
#endif
namespace pg8 {
#define PG8_LAS __attribute__((address_space(3)))
typedef unsigned short bf16_t;
typedef short bf16x8 __attribute__((ext_vector_type(8)));
typedef float f32x4 __attribute__((ext_vector_type(4)));
typedef unsigned u32x4 __attribute__((ext_vector_type(4)));
constexpr int BM = 256, BK = 64, HALF = 128, HTB = HALF * BK * 2  , STAGE_BYTES = 8 * HTB, NXCD = 8, WGM = 8;

__host__ __device__ __forceinline__ int lds_byte(int r, int c) { const int st = (r >> 4) * 2 + (c >> 5), rr = r & 15, cc = c & 31, ob = rr * 64 + cc * 2; return st * 1024 + (ob ^ (((ob >> 9) & 1) << 5)); }
__host__ __device__ __forceinline__ void stage_rc(int b, int& R, int& C) { const int st = b / 1024, sb = b % 1024, swz = sb ^ (((sb >> 9) & 1) << 5); R = (st >> 1) * 16 + swz / 64; C = (st & 1) * 32 + (swz % 64) / 2; }
__host__ __device__ __forceinline__ int perm32(int rho) { const int n = rho >> 4, i = rho & 15; return 8 * (i >> 2) + 4 * n + (i & 3); }

struct Unit { int pm, pn, az; };
struct Gemm { const bf16_t* A; const bf16_t* Bt; int M, N, K; size_t azs; };

struct StaticOrder {
    int nM, nN, nwg, G, c;
    __host__ __device__ void init(int M, int N, int G_, int c_) { nM = M / BM; nN = N / BM; nwg = nM * nN; G = G_; c = c_; }
    __host__ __device__ bool next(int i, Unit& u) const {
        const long L = (long)i * G + c; if (L >= nwg) return false;
        int wgid = (int)L; { const int q = nwg / NXCD, r = nwg % NXCD, xcd = wgid % NXCD, off = wgid / NXCD; wgid = (xcd < r ? xcd * (q + 1) : r * (q + 1) + (xcd - r) * q) + off; }
        const int nig = WGM * nN, gid = wgid / nig, fm = gid * WGM, gsz = (nM - fm) < WGM ? (nM - fm) : WGM;
        u.pm = fm + ((wgid % nig) % gsz); u.pn = (wgid % nig) / gsz; u.az = 0; return true;
    }
    __device__ __forceinline__ void a_ready(const Unit&) const {}
    __device__ __forceinline__ void done(const Unit&) const {}
};

__device__ __forceinline__ unsigned cvt_pk_bf16(float lo, float hi) { unsigned r; asm volatile("v_cvt_pk_bf16_f32 %0, %1, %2" : "=v"(r) : "v"(lo), "v"(hi)); return r; }
template <class Epi, class Sched, bool ALIGN_EPI = false, bool SP2 = false>
__device__ __forceinline__ void gemm_phase(PG8_LAS unsigned char* lds, const Gemm g, const Sched& S, const Epi& E) {
    const int tid = threadIdx.x, wid = __builtin_amdgcn_readfirstlane(tid >> 6), lane = tid & 63, wr = wid >> 2, wc = wid & 3, fr = lane & 15, fq = lane >> 4;
    const int K = g.K, nt = K / BK;
    unsigned voffA[2], voffB[2];
#pragma unroll
    for (int i = 0; i < 2; ++i) { int R, C; stage_rc(tid * 16 + i * 8192, R, C); const int Rb = Epi::PERM ? ((R & ~31) + perm32(R & 31)) : R;
        voffA[i] = (unsigned)(R * K + C) * 2u; voffB[i] = (unsigned)(Rb * K + C) * 2u; }
    const size_t kstep = (size_t)(BK * 2);
    const size_t hstep = (size_t)HALF * K * 2;
    const size_t tstep = 2 * hstep;
    const unsigned ldsw = (unsigned)wid * 1024u;
    const int aoff = lds_byte(wr * 64 + fr, fq * 8), boff = lds_byte(wc * 32 + fr, fq * 8);
#define PG8_SA(b, h) (((b) * 2 + (h)) * HTB)
#define PG8_SB(b, h) ((4 + (b) * 2 + (h)) * HTB)
#define PG8_STAGE(bufoff, gbase, voff) do { _Pragma("unroll") for (int _i = 0; _i < 2; ++_i) \
        __builtin_amdgcn_global_load_lds((const unsigned*)((const char*)(gbase) + (voff)[_i]), (PG8_LAS unsigned*)(lds + (bufoff) + ldsw + _i * 8192), 16, 0, 0); } while (0)
#define PG8_LDA(dst, b, h) do { _Pragma("unroll") for (int m = 0; m < 4; ++m) _Pragma("unroll") for (int k = 0; k < 2; ++k) dst[m][k] = *(const PG8_LAS bf16x8*)(lds + PG8_SA(b, h) + aoff + m * 2048 + k * 1024); } while (0)
#define PG8_LDB(dst, b, h) do { _Pragma("unroll") for (int n = 0; n < 2; ++n) _Pragma("unroll") for (int k = 0; k < 2; ++k) dst[n][k] = *(const PG8_LAS bf16x8*)(lds + PG8_SB(b, h) + boff + n * 2048 + k * 1024); } while (0)
#define PG8_MMA(ai, bj, At, Bt) do { __builtin_amdgcn_s_setprio(1); _Pragma("unroll") for (int m = 0; m < 4; ++m) _Pragma("unroll") for (int n = 0; n < 2; ++n) _Pragma("unroll") for (int k = 0; k < 2; ++k) \
        acc[ai][bj][m][n] = __builtin_amdgcn_mfma_f32_16x16x32_bf16(Bt[n][k], At[m][k], acc[ai][bj][m][n], 0, 0, 0); __builtin_amdgcn_s_setprio(0); } while (0)
#define PG8_WAIT_V(n) asm volatile("s_waitcnt vmcnt(" #n ")" ::: "memory")
#define PG8_WAIT_L(n) asm volatile("s_waitcnt lgkmcnt(" #n ")" ::: "memory")
#define PG8_BAR __builtin_amdgcn_s_barrier()
#define PG8_SCHED __builtin_amdgcn_sched_barrier(0)
    Unit cur, nxt; int ui = 0;
    if (!S.next(0, cur)) return;
    f32x4 acc[2][2][4][2];
#pragma unroll
    for (int a = 0; a < 2; ++a)
#pragma unroll
        for (int b = 0; b < 2; ++b)
#pragma unroll
            for (int m = 0; m < 4; ++m)
#pragma unroll
                for (int n = 0; n < 2; ++n) acc[a][b][m][n] = (f32x4){0.f, 0.f, 0.f, 0.f};
    bf16x8 At[4][2], B0[2][2], B1[2][2];
    const char* cA = (const char*)g.A + (size_t)cur.pm * tstep + (size_t)cur.az * g.azs; const char* cB = (const char*)g.Bt + (size_t)cur.pn * tstep;
    S.a_ready(cur);
    if constexpr (SP2) {
        PG8_STAGE(PG8_SB(0, 0), cB, voffB); PG8_STAGE(PG8_SB(0, 1), cB + hstep, voffB); PG8_STAGE(PG8_SA(0, 0), cA, voffA); PG8_STAGE(PG8_SA(0, 1), cA + hstep, voffA);
        if (wr == 1) PG8_BAR;
        PG8_WAIT_V(2); PG8_BAR;
        PG8_STAGE(PG8_SB(1, 0), cB + kstep, voffB); PG8_STAGE(PG8_SA(1, 0), cA + kstep, voffA); PG8_STAGE(PG8_SB(1, 1), cB + hstep + kstep, voffB);
        PG8_WAIT_V(6); PG8_BAR;
    } else {
        PG8_STAGE(PG8_SB(0, 0), cB, voffB); PG8_STAGE(PG8_SA(0, 0), cA, voffA); PG8_STAGE(PG8_SB(0, 1), cB + hstep, voffB); PG8_STAGE(PG8_SA(0, 1), cA + hstep, voffA);
        if (wr == 1) PG8_BAR;
        PG8_WAIT_V(4); PG8_BAR;
        PG8_STAGE(PG8_SB(1, 0), cB + kstep, voffB); PG8_STAGE(PG8_SA(1, 0), cA + kstep, voffA); PG8_STAGE(PG8_SB(1, 1), cB + hstep + kstep, voffB);
        PG8_WAIT_V(6); PG8_BAR;
    }
    for (;;) {
        const bool has_next = S.next(ui + 1, nxt);
        const char* nA = has_next ? (const char*)g.A + (size_t)nxt.pm * tstep + (size_t)nxt.az * g.azs : cA; const char* nB = has_next ? (const char*)g.Bt + (size_t)nxt.pn * tstep : cB;
        for (int t = 0; t < nt; t += 2) {
            if constexpr (Epi::MIDK) { if (t == 8 || t == 16) E.mid(acc, cur, t >> 3, wr, wc, fr, fq); }
            const bool last = (t == nt - 2);
            const char* a1 = cA + (size_t)(t + 1) * kstep;
            const char* a2 = last ? nA : cA + (size_t)(t + 2) * kstep; const char* b2 = last ? nB : cB + (size_t)(t + 2) * kstep;
            const char* a3 = a2 + kstep; const char* b3 = b2 + kstep;
            if (last && has_next) S.a_ready(nxt);
            if constexpr (SP2) {
            PG8_LDB(B0, 0, 0); PG8_LDB(B1, 0, 1); PG8_SCHED; PG8_LDA(At, 0, 0); PG8_STAGE(PG8_SA(1, 1), a1 + hstep, voffA);
            PG8_WAIT_V(8); PG8_WAIT_L(0); PG8_BAR; PG8_MMA(0, 0, At, B0); PG8_MMA(0, 1, At, B1); PG8_BAR; PG8_SCHED;
            PG8_LDA(At, 0, 1); PG8_STAGE(PG8_SB(0, 0), b2, voffB); PG8_STAGE(PG8_SB(0, 1), b2 + hstep, voffB); PG8_STAGE(PG8_SA(0, 0), a2, voffA);
            PG8_WAIT_V(8); PG8_WAIT_L(0); PG8_BAR; PG8_MMA(1, 0, At, B0); PG8_MMA(1, 1, At, B1); PG8_BAR; PG8_SCHED;
            PG8_LDB(B0, 1, 0); PG8_LDB(B1, 1, 1); PG8_SCHED; PG8_LDA(At, 1, 0); PG8_STAGE(PG8_SA(0, 1), a2 + hstep, voffA);
            PG8_WAIT_V(8); PG8_WAIT_L(0); PG8_BAR; PG8_MMA(0, 0, At, B0); PG8_MMA(0, 1, At, B1); PG8_BAR; PG8_SCHED;
            PG8_LDA(At, 1, 1); PG8_STAGE(PG8_SB(1, 0), b3, voffB); PG8_STAGE(PG8_SB(1, 1), b3 + hstep, voffB); PG8_STAGE(PG8_SA(1, 0), a3, voffA);
            PG8_WAIT_V(8); PG8_WAIT_L(0); PG8_BAR; PG8_MMA(1, 0, At, B0); PG8_MMA(1, 1, At, B1); PG8_BAR; PG8_SCHED;
            } else {
            PG8_LDB(B0, 0, 0); PG8_SCHED; PG8_LDA(At, 0, 0); PG8_STAGE(PG8_SA(1, 1), a1 + hstep, voffA);
            PG8_WAIT_L(8); PG8_BAR; PG8_WAIT_L(0); PG8_MMA(0, 0, At, B0); PG8_BAR; PG8_SCHED;
            PG8_LDB(B1, 0, 1); PG8_STAGE(PG8_SB(0, 0), b2, voffB);
            PG8_BAR; PG8_WAIT_L(0); PG8_MMA(0, 1, At, B1); PG8_BAR;
            PG8_LDA(At, 0, 1); PG8_STAGE(PG8_SA(0, 0), a2, voffA);
            PG8_BAR; PG8_WAIT_L(0); PG8_MMA(1, 0, At, B0); PG8_BAR; PG8_SCHED;
            PG8_STAGE(PG8_SB(0, 1), b2 + hstep, voffB);
            PG8_WAIT_V(6); PG8_BAR; PG8_MMA(1, 1, At, B1); PG8_BAR;
            PG8_LDB(B0, 1, 0); PG8_SCHED; PG8_LDA(At, 1, 0); PG8_STAGE(PG8_SA(0, 1), a2 + hstep, voffA);
            PG8_WAIT_L(8); PG8_BAR; PG8_WAIT_L(0); PG8_MMA(0, 0, At, B0); PG8_BAR; PG8_SCHED;
            PG8_LDB(B1, 1, 1); PG8_STAGE(PG8_SB(1, 0), b3, voffB);
            PG8_BAR; PG8_WAIT_L(0); PG8_MMA(0, 1, At, B1); PG8_BAR;
            PG8_LDA(At, 1, 1); PG8_STAGE(PG8_SA(1, 0), a3, voffA);
            PG8_BAR; PG8_WAIT_L(0); PG8_MMA(1, 0, At, B0); PG8_BAR; PG8_SCHED;
            PG8_STAGE(PG8_SB(1, 1), b3 + hstep, voffB);
            PG8_WAIT_V(6); PG8_BAR; PG8_MMA(1, 1, At, B1); PG8_BAR;
            }
        }
        if constexpr (ALIGN_EPI) { if (wr == 0) PG8_BAR; }
        if constexpr (!Epi::AFTER_DRAIN) { E(acc, cur, wr, wc, fr, fq); S.done(cur); }
        if (!has_next) break;
#pragma unroll
        for (int a = 0; a < 2; ++a)
#pragma unroll
            for (int b = 0; b < 2; ++b)
#pragma unroll
                for (int m = 0; m < 4; ++m)
#pragma unroll
                    for (int n = 0; n < 2; ++n) acc[a][b][m][n] = (f32x4){0.f, 0.f, 0.f, 0.f};
        cur = nxt; cA = nA; cB = nB; ++ui;
        if constexpr (ALIGN_EPI) { if (wr == 1) PG8_BAR; }
    }
    PG8_WAIT_V(0);
    if constexpr (!ALIGN_EPI) { if (wr == 0) PG8_BAR; }
    PG8_BAR;
    if constexpr (Epi::AFTER_DRAIN) { E.fused(acc, cur, wr, wc, fr, fq, lds, wid, lane); S.done(cur); }
#undef PG8_SA
#undef PG8_SB
#undef PG8_STAGE
#undef PG8_LDA
#undef PG8_LDB
#undef PG8_MMA
#undef PG8_WAIT_V
#undef PG8_WAIT_L
#undef PG8_BAR
#undef PG8_SCHED
}
}

#define LAS __attribute__((address_space(3)))
typedef unsigned short bf16_t;
typedef short bf16x8 __attribute__((ext_vector_type(8)));
typedef short s16x4 __attribute__((ext_vector_type(4)));
typedef float f32x4 __attribute__((ext_vector_type(4)));
typedef float f32x16 __attribute__((ext_vector_type(16)));
typedef unsigned u32x4 __attribute__((ext_vector_type(4)));
typedef unsigned u32x2 __attribute__((ext_vector_type(2)));
constexpr int NB = 4, SEQ = 4096, DM = 1024, MTOK = NB * SEQ, NIN = 8192, BWID = 512, NLAYER = 2;
constexpr float RMS_EPS = 1e-6f;
constexpr size_t MiB = 1u << 20;
constexpr size_t WS_RS = 0;
constexpr size_t WS_W1 = 2 * MiB;
constexpr size_t WS_W2 = 34 * MiB;
constexpr size_t WS_W3 = 40 * MiB;
constexpr size_t WS_PW = 44 * MiB;
constexpr size_t WS_H = 45 * MiB;
constexpr size_t WS_U = 77 * MiB;
constexpr size_t ARRB = 16 * MiB;
constexpr size_t WS_MG = 205 * MiB;
constexpr size_t WS_END = 253 * MiB;
constexpr int LDS_BYTES = 147456;
constexpr int NPHASE = 1 + 5 * NLAYER;

__device__ __forceinline__ unsigned f2bf(float f) { unsigned u = __builtin_bit_cast(unsigned, f); return (u + 0x7fffu + ((u >> 16) & 1u)) >> 16; }
__device__ __forceinline__ unsigned pk2(float lo, float hi) { return f2bf(lo) | (f2bf(hi) << 16); }
__device__ __forceinline__ float bflo(unsigned u) { return __builtin_bit_cast(float, u << 16); }
__device__ __forceinline__ float bfhi(unsigned u) { return __builtin_bit_cast(float, u & 0xffff0000u); }
__device__ __forceinline__ float sigmoid_f(float x) { return __builtin_amdgcn_rcpf(1.f + __builtin_amdgcn_exp2f(-1.4426950408889634f * x)); }
__device__ __forceinline__ float silu_f(float x) { return x * sigmoid_f(x); }
__device__ __forceinline__ unsigned q8(float x) { const unsigned q = (unsigned)(sigmoid_f(x) * 255.f + 0.5f); return q < 1u ? 1u : q; }
__device__ __forceinline__ float wave_sum(float v) {
#pragma unroll
    for (int o = 1; o < 64; o <<= 1) v += __shfl_xor(v, o);
    return v;
}

constexpr size_t WS_CTL = 1 * MiB; constexpr size_t CTL_BYTES = 65536;
constexpr size_t CTL_CNT = 16384;
#define XB_TMO      128
#define XB_XCNT(j)  (256  + 64 * (j))
#define XB_XSUB(j)  (1280 + 64 * (j))
#define XB_XGEN(j)  (2304 + 64 * (j))
#define XB_TOP      3328
#define XB_TOPGEN   3392
#define XCD_BAR_WORDS 3456
#define XB_SPIN_CAP (1u << 18)

__device__ __forceinline__ unsigned xb_ld(unsigned* p)              { return __hip_atomic_load(p, __ATOMIC_RELAXED, __HIP_MEMORY_SCOPE_AGENT); }
__device__ __forceinline__ unsigned xb_add(unsigned* p, unsigned v) { return __hip_atomic_fetch_add(p, v, __ATOMIC_RELAXED, __HIP_MEMORY_SCOPE_AGENT); }
__device__ __forceinline__ unsigned xb_xcc_id() { return (unsigned)__builtin_amdgcn_s_getreg((3 << 11) | 20) & 0xFu; }
#define XB_SPIN(cond, bar) do { unsigned _sp = 0; while (cond) { __builtin_amdgcn_s_sleep(1); \
    if ((++_sp & 255u) == 0u) { if (xb_ld(&(bar)[XB_TMO])) break; if (_sp > XB_SPIN_CAP) { atomicAdd(&(bar)[XB_TMO], 1u); break; } } } } while (0)

struct XcdBarrier {
    unsigned* bar; unsigned x;
    volatile LAS unsigned* st;
};

__device__ __forceinline__ XcdBarrier xcd_barrier_post(unsigned* bar, volatile LAS unsigned* st) {
    XcdBarrier b; b.bar = bar; b.x = xb_xcc_id(); b.st = st;
    if (threadIdx.x == 0) (void)xb_add(&bar[XB_XCNT(b.x)], 1u);
    return b;
}
__device__ __forceinline__ void xcd_barrier_complete(unsigned* bar, unsigned x, unsigned& nloc, unsigned& nx) {
    const unsigned G = gridDim.x * gridDim.y * gridDim.z;
    unsigned sum, cnt, mine, sp = 0u;
    for (;;) {
        sum = 0u; cnt = 0u; mine = 0u;
#pragma unroll
        for (unsigned j = 0; j < 16; ++j) { const unsigned c = xb_ld(&bar[XB_XCNT(j)]); sum += c; cnt += (c > 0u) ? 1u : 0u; mine = (j == x) ? c : mine; }
        if (sum == G) break;
        __builtin_amdgcn_s_sleep(1);
        if ((++sp & 255u) == 0u) { if (xb_ld(&bar[XB_TMO])) break; if (sp > XB_SPIN_CAP) { atomicAdd(&bar[XB_TMO], 1u); break; } }
    }
    nloc = mine > 0u ? mine : 1u; nx = cnt > 0u ? cnt : 1u;
}

__device__ __forceinline__ void xcd_barrier(const XcdBarrier& b) {
    asm volatile("s_waitcnt vmcnt(0)" ::: "memory");
    __syncthreads();
    if (threadIdx.x == 0) {
        unsigned* bar = b.bar;
        __builtin_amdgcn_s_waitcnt(0);
        unsigned nloc = b.st[0], nx = b.st[1];
        if (nloc == 0u) { xcd_barrier_complete(bar, b.x, nloc, nx); b.st[0] = nloc; b.st[1] = nx; }
        const unsigned old = xb_add(&bar[XB_XSUB(b.x)], 1u);
        const unsigned gen = old / nloc;
        if (old + 1u == (gen + 1u) * nloc) {
            __builtin_amdgcn_fence(__ATOMIC_RELEASE, "agent");
            asm volatile("s_waitcnt vmcnt(0)" ::: "memory");
            const unsigned og = xb_add(&bar[XB_TOP], 1u);
            const unsigned tg = og / nx;
            if (og + 1u == (tg + 1u) * nx) xb_add(&bar[XB_TOPGEN], 1u);
            else XB_SPIN(xb_ld(&bar[XB_TOPGEN]) == tg, bar);
            __builtin_amdgcn_fence(__ATOMIC_ACQUIRE, "agent");
            xb_add(&bar[XB_XGEN(b.x)], 1u);
            asm volatile("s_waitcnt vmcnt(0)" ::: "memory");
        } else {
            XB_SPIN(xb_ld(&bar[XB_XGEN(b.x)]) == gen, bar);
            __builtin_amdgcn_fence(__ATOMIC_ACQUIRE, "agent");
            asm volatile("s_waitcnt vmcnt(0)" ::: "memory");
        }
    }
    __syncthreads();
}


using pg8::Unit;
struct EpiU {
    static constexpr bool PERM = true, AFTER_DRAIN = false, MIDK = false;
    unsigned char* ws;
    __device__ __forceinline__ void operator()(const f32x4 (&acc)[2][2][4][2], const Unit& u, int wr, int wc, int fr, int fq) const {
        bf16_t* U = (bf16_t*)(ws + WS_U); unsigned char* MG = ws + WS_MG;
        const int pn = u.pn; const int row0 = u.pm * 256 + wr * 64 + fr;
        if (pn >= 20) {
            unsigned char* tb = MG + ((size_t)u.pm * 12 + (pn - 20)) * 65536 + (size_t)(((wr * 4 + wc) * 16) * 64 + (fq * 16 + fr)) * 8;
#pragma unroll
            for (int ai = 0; ai < 2; ++ai)
#pragma unroll
                for (int m = 0; m < 4; ++m)
#pragma unroll
                    for (int bj = 0; bj < 2; ++bj) { const f32x4 v0 = acc[ai][bj][m][0], v1 = acc[ai][bj][m][1]; u32x2 w;
                        w.x = q8(v0[0]) | (q8(v0[1]) << 8) | (q8(v0[2]) << 16) | (q8(v0[3]) << 24); w.y = q8(v1[0]) | (q8(v1[1]) << 8) | (q8(v1[2]) << 16) | (q8(v1[3]) << 24);
                        *(u32x2*)(tb + ((ai * 4 + m) * 2 + bj) * 512) = w; }
        } else if (pn >= 4 && pn < 12) {
            const bool second = pn >= 8; const int ch0 = (pn & 3) * 128 + wc * 32 + 8 * fq;
            bf16_t* O = second ? (U + 5 * (ARRB / 2) + 512) : (U + 1 * (ARRB / 2)); const int pitch = second ? 1536 : 512;
#pragma unroll
            for (int ai = 0; ai < 2; ++ai)
#pragma unroll
                for (int m = 0; m < 4; ++m) { bf16_t* rp = O + (size_t)(row0 + ai * 128 + m * 16) * pitch + ch0;
                    f32x4 a0 = acc[ai][0][m][0], a1 = acc[ai][0][m][1]; const f32x4 b0 = acc[ai][1][m][0], b1 = acc[ai][1][m][1];
                    if (second) {
#pragma unroll
                        for (int i = 0; i < 4; ++i) { a0[i] *= silu_f(b0[i]); a1[i] *= silu_f(b1[i]); } }
                    else { a0 *= b0; a1 *= b1; }
                    u32x4 w; w.x = pg8::cvt_pk_bf16(a0[0], a0[1]); w.y = pg8::cvt_pk_bf16(a0[2], a0[3]); w.z = pg8::cvt_pk_bf16(a1[0], a1[1]); w.w = pg8::cvt_pk_bf16(a1[2], a1[3]);
                    *(u32x4*)rp = w; }
        } else {
            const int kind = pn >> 1; int arr = 0, pitch = 512, coff = 0; bool act = false;
            if (kind == 1) { arr = 5; act = true; pitch = 1536; } else if (kind == 6) arr = 2; else if (kind == 7) arr = 3; else if (kind == 8) arr = 4; else if (kind == 9) { arr = 5; act = true; pitch = 1536; coff = 1024; }
            bf16_t* O = U + (size_t)arr * (ARRB / 2) + coff; const int col0 = (pn & 1) * 256 + wc * 32 + 8 * fq;
#pragma unroll
            for (int ai = 0; ai < 2; ++ai)
#pragma unroll
                for (int m = 0; m < 4; ++m) { bf16_t* rp = O + (size_t)(row0 + ai * 128 + m * 16) * pitch + col0;
#pragma unroll
                    for (int bj = 0; bj < 2; ++bj) { f32x4 v0 = acc[ai][bj][m][0], v1 = acc[ai][bj][m][1];
                        if (act) {
#pragma unroll
                            for (int i = 0; i < 4; ++i) { v0[i] = silu_f(v0[i]); v1[i] = silu_f(v1[i]); } }
                        u32x4 w; w.x = pg8::cvt_pk_bf16(v0[0], v0[1]); w.y = pg8::cvt_pk_bf16(v0[2], v0[3]); w.z = pg8::cvt_pk_bf16(v1[0], v1[1]); w.w = pg8::cvt_pk_bf16(v1[2], v1[3]);
                        *(u32x4*)(rp + bj * 128) = w; } }
        }
    }
};
struct EpiBranch {
    static constexpr bool PERM = true, AFTER_DRAIN = false, MIDK = true;
    unsigned char* ws;
    __device__ __forceinline__ void mid(f32x4 (&acc)[2][2][4][2], const Unit& u, int seg, int wr, int wc, int fr, int fq) const {
        int tid_ = threadIdx.x; asm volatile("" : "+v"(tid_));
        const int wid_ = tid_ >> 6, wr_ = wid_ >> 2, wc_ = wid_ & 3, fr_ = tid_ & 15, fq_ = (tid_ & 63) >> 4;
        const unsigned char* tb = ws + WS_MG + ((size_t)u.pm * 12 + (seg - 1) * 4 + u.pn) * 65536 + (size_t)(((wr_ * 4 + wc_) * 16) * 64 + (fq_ * 16 + fr_)) * 8;
#pragma unroll
        for (int ai = 0; ai < 2; ++ai)
#pragma unroll
            for (int m = 0; m < 4; ++m) {
#pragma unroll
                for (int bj = 0; bj < 2; ++bj) { const unsigned char* rp = tb + ((ai * 4 + m) * 2 + bj) * 512; const u32x2 qa = *(const u32x2*)rp, qb = *(const u32x2*)(rp + 4 * 65536);
                    f32x4 r0, r1;
                    r0[0] = (float)(qa.x & 255u) * __builtin_amdgcn_rcpf((float)(qb.x & 255u)); r0[1] = (float)((qa.x >> 8) & 255u) * __builtin_amdgcn_rcpf((float)((qb.x >> 8) & 255u));
                    r0[2] = (float)((qa.x >> 16) & 255u) * __builtin_amdgcn_rcpf((float)((qb.x >> 16) & 255u)); r0[3] = (float)(qa.x >> 24) * __builtin_amdgcn_rcpf((float)(qb.x >> 24));
                    r1[0] = (float)(qa.y & 255u) * __builtin_amdgcn_rcpf((float)(qb.y & 255u)); r1[1] = (float)((qa.y >> 8) & 255u) * __builtin_amdgcn_rcpf((float)((qb.y >> 8) & 255u));
                    r1[2] = (float)((qa.y >> 16) & 255u) * __builtin_amdgcn_rcpf((float)((qb.y >> 16) & 255u)); r1[3] = (float)(qa.y >> 24) * __builtin_amdgcn_rcpf((float)(qb.y >> 24));
                    acc[ai][bj][m][0] *= r0; acc[ai][bj][m][1] *= r1; }
                if (m == 3) asm volatile("" ::: "memory"); }
    }
    __device__ __forceinline__ void operator()(const f32x4 (&acc)[2][2][4][2], const Unit& u, int wr, int wc, int fr, int fq) const {
        bf16_t* merged = (bf16_t*)(ws + WS_H);
        const unsigned char* tb = ws + WS_MG + ((size_t)u.pm * 12 + 8 + u.pn) * 65536 + (size_t)(((wr * 4 + wc) * 16) * 64 + (fq * 16 + fr)) * 8;
        const int row0 = u.pm * 256 + wr * 64 + fr, col0 = u.pn * 256 + wc * 32 + 8 * fq;
        u32x2 gq[2][4][2];
#pragma unroll
        for (int ai = 0; ai < 2; ++ai)
#pragma unroll
            for (int m = 0; m < 4; ++m)
#pragma unroll
                for (int bj = 0; bj < 2; ++bj) gq[ai][m][bj] = *(const u32x2*)(tb + ((ai * 4 + m) * 2 + bj) * 512);
#pragma unroll
        for (int ai = 0; ai < 2; ++ai)
#pragma unroll
            for (int m = 0; m < 4; ++m) { const size_t row = (size_t)(row0 + ai * 128 + m * 16);
#pragma unroll
                for (int bj = 0; bj < 2; ++bj) { const int col = col0 + bj * 128; const u32x2 g = gq[ai][m][bj];
                    f32x4 g0, g1; const float k = 1.f / 255.f;
                    g0[0] = (float)(g.x & 255u) * k; g0[1] = (float)((g.x >> 8) & 255u) * k; g0[2] = (float)((g.x >> 16) & 255u) * k; g0[3] = (float)(g.x >> 24) * k;
                    g1[0] = (float)(g.y & 255u) * k; g1[1] = (float)((g.y >> 8) & 255u) * k; g1[2] = (float)((g.y >> 16) & 255u) * k; g1[3] = (float)(g.y >> 24) * k;
                    const f32x4 v0 = acc[ai][bj][m][0] * g0, v1 = acc[ai][bj][m][1] * g1;
                    u32x4 w; w.x = pg8::cvt_pk_bf16(v0[0], v0[1]); w.y = pg8::cvt_pk_bf16(v0[2], v0[3]); w.z = pg8::cvt_pk_bf16(v1[0], v1[1]); w.w = pg8::cvt_pk_bf16(v1[2], v1[3]);
                    *(u32x4*)(merged + row * 1024 + col) = w; } }
    }
};
struct EpiOut {
    static constexpr bool PERM = false, AFTER_DRAIN = false, MIDK = false;
    unsigned char* ws;
    __device__ __forceinline__ void operator()(const f32x4 (&acc)[2][2][4][2], const Unit& u, int wr, int wc, int fr, int fq) const {
        float* out = (float*)(ws + WS_U); float* rs = (float*)(ws + WS_RS);
        const int row0 = u.pm * 256 + wr * 64 + fr, col0 = u.pn * 256 + wc * 32 + 4 * fq;
#pragma unroll
        for (int ai = 0; ai < 2; ++ai)
#pragma unroll
            for (int m = 0; m < 4; ++m) { const size_t row = (size_t)(row0 + ai * 128 + m * 16); float ss = 0.f;
#pragma unroll
                for (int bj = 0; bj < 2; ++bj)
#pragma unroll
                    for (int n = 0; n < 2; ++n) { const f32x4 v = acc[ai][bj][m][n]; *(f32x4*)(out + row * 1024 + col0 + bj * 128 + n * 16) = v; ss += (v[0] * v[0] + v[1] * v[1]) + (v[2] * v[2] + v[3] * v[3]); }
                ss += __shfl_xor(ss, 16); ss += __shfl_xor(ss, 32);
                if (fq == 0) rs[row * 16 + u.pn * 4 + wc] = ss; }
    }
};

struct RmsPanel {
    float* xbuf;
    unsigned* cnt;
    __device__ __forceinline__ void run(const f32x4 (&v)[2][2][4][2], const Unit& u, int wr, int wc, int fr, int fq, LAS unsigned char* lds, int wid, int lane) const {
        LAS float* P = (LAS float*)lds; LAS float* S = (LAS float*)(lds + 8192);
#pragma unroll
        for (int ai = 0; ai < 2; ++ai)
#pragma unroll
            for (int m = 0; m < 4; ++m) { float s = 0.f;
#pragma unroll
                for (int bj = 0; bj < 2; ++bj)
#pragma unroll
                    for (int n = 0; n < 2; ++n) { const f32x4 x = v[ai][bj][m][n]; s += (x[0] * x[0] + x[1] * x[1]) + (x[2] * x[2] + x[3] * x[3]); }
                s += __shfl_xor(s, 16); s += __shfl_xor(s, 32);
                if (fq == 0) P[(ai * 128 + wr * 64 + m * 16 + fr) * 4 + wc] = s; }
        asm volatile("s_waitcnt lgkmcnt(0)" ::: "memory"); __builtin_amdgcn_s_barrier(); asm volatile("" ::: "memory");
        const int row = wid * 32 + (lane & 31);
        if (lane < 32) { const float t = (P[row * 4 + 0] + P[row * 4 + 1]) + (P[row * 4 + 2] + P[row * 4 + 3]);
            __hip_atomic_store(xbuf + (size_t)(u.pm * 256 + row) * 4 + u.pn, t, __ATOMIC_RELAXED, __HIP_MEMORY_SCOPE_AGENT); }
        asm volatile("s_waitcnt vmcnt(0)" ::: "memory");
        if (lane == 0) __hip_atomic_fetch_add(cnt + 64 * u.pm, 1u, __ATOMIC_RELAXED, __HIP_MEMORY_SCOPE_AGENT);
        if (wid == 0) {
            unsigned sp = 0;
            while ((unsigned)__builtin_amdgcn_readfirstlane(__hip_atomic_load(cnt + 64 * u.pm, __ATOMIC_RELAXED, __HIP_MEMORY_SCOPE_AGENT)) < 32u) { __builtin_amdgcn_s_sleep(2); if (++sp > (1u << 22)) break; }
            __builtin_amdgcn_fence(__ATOMIC_ACQUIRE, "agent");
        }
        asm volatile("s_waitcnt vmcnt(0) lgkmcnt(0)" ::: "memory"); __builtin_amdgcn_s_barrier(); asm volatile("" ::: "memory");
        if (lane < 32) { const float* slot = xbuf + (size_t)(u.pm * 256 + row) * 4; float t = 0.f;
#pragma unroll
            for (int k = 0; k < 4; ++k) t += __hip_atomic_load(slot + k, __ATOMIC_RELAXED, __HIP_MEMORY_SCOPE_AGENT);
            S[row] = 1.0f / sqrtf(t * (1.f / DM) + RMS_EPS); }
        asm volatile("s_waitcnt lgkmcnt(0)" ::: "memory"); __builtin_amdgcn_s_barrier(); asm volatile("" ::: "memory");
    }
};
struct EpiNorm1 {
    static constexpr bool PERM = false, AFTER_DRAIN = true, MIDK = false;
    float* out; const float* gpost; RmsPanel st;
    __device__ __forceinline__ void operator()(const f32x4 (&)[2][2][4][2], const Unit&, int, int, int, int) const {}
    __device__ __forceinline__ void fused(f32x4 (&acc)[2][2][4][2], const Unit& u, int wr, int wc, int fr, int fq, LAS unsigned char* lds, int wid, int lane) const {
        const LAS float* S = (const LAS float*)(lds + 8192);
        const int col0 = u.pn * 256 + wc * 32 + 4 * fq;
        f32x4 gp[2][2]; u32x2 pre[2][4][2][2];
#pragma unroll
        for (int bj = 0; bj < 2; ++bj)
#pragma unroll
            for (int n = 0; n < 2; ++n) gp[bj][n] = *(const f32x4*)(gpost + col0 + bj * 128 + n * 16);
#pragma unroll
        for (int ai = 0; ai < 2; ++ai)
#pragma unroll
            for (int m = 0; m < 4; ++m) {
#pragma unroll
                for (int bj = 0; bj < 2; ++bj)
#pragma unroll
                    for (int n = 0; n < 2; ++n) pre[ai][m][bj][n] = *(const u32x2*)((const unsigned char*)out + (size_t)(u.pm * 256 + wid * 32 + ((ai * 4 + m) * 2 + bj) * 2 + n) * 4096 + u.pn * 1024 + lane * 8); }
        st.run(acc, u, wr, wc, fr, fq, lds, wid, lane);
#pragma unroll
        for (int ai = 0; ai < 2; ++ai)
#pragma unroll
            for (int m = 0; m < 4; ++m) { const int r = ai * 128 + wr * 64 + m * 16 + fr; const float rs = S[r]; const size_t off = (size_t)(u.pm * 256 + r) * DM + col0;
#pragma unroll
                for (int bj = 0; bj < 2; ++bj)
#pragma unroll
                    for (int n = 0; n < 2; ++n) { const u32x2 p = pre[ai][m][bj][n]; const f32x4 bs = (f32x4){bflo(p.x), bfhi(p.x), bflo(p.y), bfhi(p.y)};
                        *(f32x4*)(out + off + bj * 128 + n * 16) = bs + acc[ai][bj][m][n] * rs * gp[bj][n]; } }
    }
};
struct EpiNorm2 {
    static constexpr bool PERM = false, AFTER_DRAIN = true, MIDK = false;
    const float* base; float* out; bf16_t* hn; const float* gpost; const float* gnext; RmsPanel st1, st2;
    __device__ __forceinline__ void operator()(const f32x4 (&)[2][2][4][2], const Unit&, int, int, int, int) const {}
    __device__ __forceinline__ void fused(f32x4 (&acc)[2][2][4][2], const Unit& u, int wr, int wc, int fr, int fq, LAS unsigned char* lds, int wid, int lane) const {
        const LAS float* S = (const LAS float*)(lds + 8192);
        const int col0 = u.pn * 256 + wc * 32 + 4 * fq;
        f32x4 gp[2][2], pre[4][2][2];
#pragma unroll
        for (int bj = 0; bj < 2; ++bj)
#pragma unroll
            for (int n = 0; n < 2; ++n) gp[bj][n] = *(const f32x4*)(gpost + col0 + bj * 128 + n * 16);
#pragma unroll
        for (int m = 0; m < 4; ++m)
#pragma unroll
            for (int bj = 0; bj < 2; ++bj)
#pragma unroll
                for (int n = 0; n < 2; ++n) pre[m][bj][n] = *(const f32x4*)(base + (size_t)(u.pm * 256 + wr * 64 + m * 16 + fr) * DM + col0 + bj * 128 + n * 16);
        st1.run(acc, u, wr, wc, fr, fq, lds, wid, lane);
#pragma unroll
        for (int ai = 0; ai < 2; ++ai) {
            if (ai == 1) {
#pragma unroll
                for (int m = 0; m < 4; ++m)
#pragma unroll
                    for (int bj = 0; bj < 2; ++bj)
#pragma unroll
                        for (int n = 0; n < 2; ++n) pre[m][bj][n] = *(const f32x4*)(base + (size_t)(u.pm * 256 + 128 + wr * 64 + m * 16 + fr) * DM + col0 + bj * 128 + n * 16);
            }
#pragma unroll
            for (int m = 0; m < 4; ++m) { const int r = ai * 128 + wr * 64 + m * 16 + fr; const float rs = S[r]; const size_t off = (size_t)(u.pm * 256 + r) * DM + col0;
#pragma unroll
                for (int bj = 0; bj < 2; ++bj)
#pragma unroll
                    for (int n = 0; n < 2; ++n) { const f32x4 x1 = pre[m][bj][n] + acc[ai][bj][m][n] * rs * gp[bj][n]; acc[ai][bj][m][n] = x1;
                        u32x2 w; w.x = pg8::cvt_pk_bf16(x1[0], x1[1]); w.y = pg8::cvt_pk_bf16(x1[2], x1[3]);
                        *(u32x2*)((unsigned char*)out + (size_t)(u.pm * 256 + wid * 32 + ((ai * 4 + m) * 2 + bj) * 2 + n) * 4096 + u.pn * 1024 + lane * 8) = w; } }
        }
#pragma unroll
        for (int bj = 0; bj < 2; ++bj)
#pragma unroll
            for (int n = 0; n < 2; ++n) gp[bj][n] = *(const f32x4*)(gnext + col0 + bj * 128 + n * 16);
        st2.run(acc, u, wr, wc, fr, fq, lds, wid, lane);
#pragma unroll
        for (int ai = 0; ai < 2; ++ai)
#pragma unroll
            for (int m = 0; m < 4; ++m) { const int r = ai * 128 + wr * 64 + m * 16 + fr; const float rs = S[r]; const size_t off = (size_t)(u.pm * 256 + r) * DM + col0;
#pragma unroll
                for (int bj = 0; bj < 2; ++bj)
#pragma unroll
                    for (int n = 0; n < 2; ++n) { const f32x4 o = acc[ai][bj][m][n] * rs * gp[bj][n];
                        u32x2 w; w.x = pg8::cvt_pk_bf16(o[0], o[1]); w.y = pg8::cvt_pk_bf16(o[2], o[3]); *(u32x2*)(hn + off + bj * 128 + n * 16) = w; } }
    }
};
__device__ __forceinline__ int win_row(int c) {
    if (c < 1024 || c >= 3072) return c;
    const int q = (c - 1024) >> 9, ch = (c - 1024) & 511, a = ch >> 7, j = ch & 127;
    return ((q & 1) ? 8 + a : 4 + a) * 256 + (q >> 1) * 128 + j;
}
__device__ __forceinline__ void transpose_item(const float* W, int N, bf16_t* WT, int ldt, int koff, int row_off, bool winmap, LAS float* scr, int item, int lane, const float* rscale = nullptr) {
    const int nblk = N / 64, kb = item / nblk, nb = item % nblk, k0 = 64 * kb, n0 = 64 * nb;
    const int kq = lane >> 4, nq = lane & 15;
    f32x4 v[16];
#pragma unroll
    for (int i = 0; i < 16; ++i) v[i] = *(const f32x4*)(W + (size_t)(k0 + 4 * i + kq) * N + n0 + 4 * nq);
#pragma unroll
    for (int i = 0; i < 16; ++i) { LAS float* s = scr + (4 * i + kq) * 65 + 4 * nq; s[0] = v[i][0]; s[1] = v[i][1]; s[2] = v[i][2]; s[3] = v[i][3]; }
    asm volatile("s_waitcnt lgkmcnt(0)" ::: "memory");
    const int c = lane & 7;
#pragma unroll
    for (int j = 0; j < 8; ++j) { const int n = (lane >> 3) + 8 * j;
        const LAS float* s = scr + (rscale ? (16 * (c >> 1) + 4 * (c & 1)) : 8 * c) * 65 + n; const int hs = rscale ? 8 * 65 : 4 * 65; const float f = rscale ? rscale[n0 + n] : 1.f;
        u32x4 o; o.x = pg8::cvt_pk_bf16(s[0 * 65] * f, s[1 * 65] * f); o.y = pg8::cvt_pk_bf16(s[2 * 65] * f, s[3 * 65] * f); o.z = pg8::cvt_pk_bf16(s[hs] * f, s[hs + 65] * f); o.w = pg8::cvt_pk_bf16(s[hs + 2 * 65] * f, s[hs + 3 * 65] * f);
        int dst = n0 + n; if (winmap) dst = win_row(dst);
        if (rscale) *(u32x4*)(WT + (size_t)((((dst >> 5) * 8 + ((k0 + 8 * c) >> 4)) * 64 + (c & 1) * 32 + (dst & 31)) * 8)) = o;
        else *(u32x4*)(WT + (size_t)(row_off + dst) * ldt + koff + k0 + 8 * c) = o; }
    asm volatile("s_waitcnt lgkmcnt(0)" ::: "memory");
}
template <int R> __device__ __forceinline__ void rms_rows_to_bf16(const float* x, const float* g, bf16_t* H, int m0, int mstride, int lane) {
    f32x4 v[R][4];
#pragma unroll
    for (int r = 0; r < R; ++r)
#pragma unroll
        for (int j = 0; j < 4; ++j) v[r][j] = ((const f32x4*)(x + (size_t)(m0 + r * mstride) * DM))[64 * j + lane];
    f32x4 gg[4];
#pragma unroll
    for (int j = 0; j < 4; ++j) gg[j] = ((const f32x4*)g)[64 * j + lane];
#pragma unroll
    for (int r = 0; r < R; ++r) { float s = 0.f;
#pragma unroll
        for (int j = 0; j < 4; ++j) s += (v[r][j][0] * v[r][j][0] + v[r][j][1] * v[r][j][1]) + (v[r][j][2] * v[r][j][2] + v[r][j][3] * v[r][j][3]);
        const float rstd = 1.f / sqrtf(wave_sum(s) * (1.f / DM) + RMS_EPS);
        u32x2* o8 = (u32x2*)(H + (size_t)(m0 + r * mstride) * DM) + lane;
#pragma unroll
        for (int j = 0; j < 4; ++j) { u32x2 w; w.x = pg8::cvt_pk_bf16(v[r][j][0] * rstd * gg[j][0], v[r][j][1] * rstd * gg[j][1]); w.y = pg8::cvt_pk_bf16(v[r][j][2] * rstd * gg[j][2], v[r][j][3] * rstd * gg[j][3]); o8[64 * j] = w; } }
}

__device__ __forceinline__ int crow(int r, int hi) { return (r & 3) + 8 * (r >> 2) + 4 * hi; }
constexpr int VROW = 144;
__device__ __forceinline__ void attn_item(int item, const bf16_t* Q, const bf16_t* K, const bf16_t* V, const bf16_t* SG, bf16_t* YO, LAS unsigned char* vl, LAS unsigned char* kl, int lane) {
    const int qg = item & 127, h = (item >> 7) & 7, b = item >> 10;
    const int r32 = lane & 31, hi = lane >> 5, t0 = qg * 32;
    const size_t tokq = (size_t)b * SEQ + t0 + r32;
    bf16x8 qf[4];
    { const size_t tq0 = (size_t)b * SEQ + t0;
#pragma unroll
      for (int p = 0; p < 4; ++p) { const int idx = p * 64 + lane; const u32x4 v = *(const u32x4*)(Q + (tq0 + (idx >> 3)) * 512 + h * 64 + (idx & 7) * 8); *(LAS u32x4*)(kl + (idx >> 3) * VROW + (idx & 7) * 16) = v; }
#pragma unroll
      for (int d0 = 0; d0 < 4; ++d0) qf[d0] = *(const LAS bf16x8*)(kl + r32 * VROW + d0 * 32 + hi * 16); }
    f32x16 o0, o1;
#pragma unroll
    for (int r = 0; r < 16; ++r) { o0[r] = 0.f; o1[r] = 0.f; }
    float P = 1.f;
    const int i16 = lane & 15, G4 = lane >> 4;
    const int vb = (4 * (G4 >> 1) + (i16 >> 2)) * VROW + (16 * (G4 & 1) + 4 * (i16 & 3)) * 2;
#define ATT_LOAD(KF, VR, S0) do { const size_t tk_ = (size_t)b * SEQ + ((S0) > 0 ? (S0) : 0); \
        _Pragma("unroll") for (int p = 0; p < 4; ++p) { const int idx = p * 64 + lane; KF[p] = *(const u32x4*)(K + (tk_ + (idx >> 3)) * 512 + h * 64 + (idx & 7) * 8); \
                                                         VR[p] = *(const u32x4*)(V + (tk_ + (idx >> 3)) * 512 + h * 64 + (idx & 7) * 8); } } while (0)
    u32x4 kf[4], kn[4]; u32x4 vr[4], vn[4];
    ATT_LOAD(kf, vr, t0); ATT_LOAD(kn, vn, t0 - 32);
    u32x4 sgr[4];
#pragma unroll
    for (int p = 0; p < 4; ++p) { const int idx = p * 64 + lane; sgr[p] = *(const u32x4*)(SG + ((size_t)b * SEQ + t0 + (idx >> 3)) * 1536 + h * 64 + (idx & 7) * 8); }
    for (int s0 = t0; s0 >= 0; s0 -= 32) {
#pragma unroll
        for (int p = 0; p < 4; ++p) { const int idx = p * 64 + lane, key = idx >> 3, ch = idx & 7; *(LAS u32x4*)(vl + key * VROW + ch * 16) = vr[p]; *(LAS u32x4*)(kl + key * VROW + ch * 16) = kf[p]; }
        f32x16 s;
#pragma unroll
        for (int r = 0; r < 16; ++r) s[r] = 0.f;
#pragma unroll
        for (int d0 = 0; d0 < 4; ++d0) s = __builtin_amdgcn_mfma_f32_32x32x16_bf16(*(const LAS bf16x8*)(kl + r32 * VROW + d0 * 32 + hi * 16), qf[d0], s, 0, 0, 0);
        const bool diag = (s0 == t0);
        float kp[16];
#pragma unroll
        for (int r = 0; r < 16; ++r) { const float e = __builtin_amdgcn_exp2f(s[r] * (0.125f * 1.4426950408889634f)); float k = __builtin_amdgcn_rcpf(1.f + e);
            if (diag && crow(r, hi) >= r32) k = 1.f; kp[r] = k; }
        float Gm[4], Go[4], T[4], R[4], C[4];
#pragma unroll
        for (int g = 0; g < 4; ++g) { Gm[g] = (kp[4 * g] * kp[4 * g + 1]) * (kp[4 * g + 2] * kp[4 * g + 3]); Go[g] = __shfl_xor(Gm[g], 32); T[g] = Gm[g] * Go[g]; }
        R[3] = P; R[2] = R[3] * T[3]; R[1] = R[2] * T[2]; R[0] = R[1] * T[1]; const float Cout = R[0] * T[0];
#pragma unroll
        for (int g = 0; g < 4; ++g) C[g] = hi ? R[g] : R[g] * Go[g];
        float w[16];
#pragma unroll
        for (int g = 0; g < 4; ++g) { const float p3 = C[g], p2 = p3 * kp[4 * g + 3], p1 = p2 * kp[4 * g + 2], p0 = p1 * kp[4 * g + 1], pe = p0 * kp[4 * g];
            w[4 * g + 3] = p3 - p2; w[4 * g + 2] = p2 - p1; w[4 * g + 1] = p1 - p0; w[4 * g] = p0 - pe; }
        bf16x8 wf[2];
#pragma unroll
        for (int st = 0; st < 2; ++st) { u32x4 t; t.x = pg8::cvt_pk_bf16(w[8 * st], w[8 * st + 1]); t.y = pg8::cvt_pk_bf16(w[8 * st + 2], w[8 * st + 3]); t.z = pg8::cvt_pk_bf16(w[8 * st + 4], w[8 * st + 5]); t.w = pg8::cvt_pk_bf16(w[8 * st + 6], w[8 * st + 7]); wf[st] = __builtin_bit_cast(bf16x8, t); }
#pragma unroll
        for (int dt = 0; dt < 2; ++dt)
#pragma unroll
            for (int st = 0; st < 2; ++st) {
                const s16x4 lo = __builtin_amdgcn_ds_read_tr16_b64_v4i16((LAS s16x4*)(vl + vb + (16 * st) * VROW + dt * 64));
                const s16x4 hh = __builtin_amdgcn_ds_read_tr16_b64_v4i16((LAS s16x4*)(vl + vb + (16 * st + 8) * VROW + dt * 64));
                const bf16x8 vf = (bf16x8){lo[0], lo[1], lo[2], lo[3], hh[0], hh[1], hh[2], hh[3]};
                if (dt == 0) o0 = __builtin_amdgcn_mfma_f32_32x32x16_bf16(vf, wf[st], o0, 0, 0, 0); else o1 = __builtin_amdgcn_mfma_f32_32x32x16_bf16(vf, wf[st], o1, 0, 0, 0); }
        P = Cout;
        if (__all(P < 1.17549435e-38f)) break;
#pragma unroll
        for (int i = 0; i < 4; ++i) { kf[i] = kn[i]; vr[i] = vn[i]; }
        ATT_LOAD(kn, vn, s0 - 64);
    }
#undef ATT_LOAD
#pragma unroll
    for (int p = 0; p < 4; ++p) { const int idx = p * 64 + lane; *(LAS u32x4*)(kl + (idx >> 3) * VROW + (idx & 7) * 16) = sgr[p]; }
#pragma unroll
    for (int dt = 0; dt < 2; ++dt)
#pragma unroll
        for (int g = 0; g < 4; ++g) { LAS u32x2* p = (LAS u32x2*)(kl + r32 * VROW + (dt * 32 + 8 * g + 4 * hi) * 2); const u32x2 sg = *p;
            const f32x16& o = dt ? o1 : o0; u32x2 y;
            y.x = pg8::cvt_pk_bf16(o[4 * g] * bflo(sg.x), o[4 * g + 1] * bfhi(sg.x)); y.y = pg8::cvt_pk_bf16(o[4 * g + 2] * bflo(sg.y), o[4 * g + 3] * bfhi(sg.y));
            *p = y; }
#pragma unroll
    for (int p = 0; p < 4; ++p) { const int idx = p * 64 + lane; const u32x4 v = *(const LAS u32x4*)(kl + (idx >> 3) * VROW + (idx & 7) * 16);
        *(u32x4*)(YO + ((size_t)b * SEQ + t0 + (idx >> 3)) * 1536 + h * 64 + (idx & 7) * 8) = v; }
}
constexpr int PROW = 272;
__device__ __forceinline__ void pool_item(int pi, const bf16_t* PV, const bf16_t* SG, bf16_t* YO, const bf16_t* PT, const float* scale, LAS unsigned char* sl, int lane) {
    const int tile = pi >> 2, g = ((pi & 3) + ((pi >> 2) & 1)) & 3, win = 2 << g;
    const int r32 = lane & 31, hi = lane >> 5, tok0 = tile * 32, t0 = tok0 & (SEQ - 1), tok = tok0 + r32;
    u32x4 sv[12];
#pragma unroll
    for (int p = 0; p < 12; ++p) { const int idx = p * 64 + lane, row = idx >> 4, ch = idx & 15; const bool ok = (t0 + row - 16) >= 0;
        sv[p] = *(const u32x4*)(PV + (size_t)(ok ? tok0 + row - 16 : tok0) * 512 + g * 128 + ch * 8); if (!ok) sv[p] = (u32x4){0u, 0u, 0u, 0u}; }
#pragma unroll
    for (int p = 0; p < 12; ++p) { const int idx = p * 64 + lane, row = idx >> 4, ch = idx & 15; *(LAS u32x4*)(sl + row * PROW + ch * 16) = sv[p]; }
    const int t = t0 + r32, cnt = (t + 1) < win ? (t + 1) : win;
    bf16x8 bfr[3];
#pragma unroll
    for (int ks = 0; ks < 3; ++ks) { float wv[8];
#pragma unroll
        for (int j = 0; j < 8; ++j) { const int rel = (16 + r32) - (16 * ks + 8 * hi + j); wv[j] = (rel == 0) ? (float)(1 - cnt) : ((rel > 0 && rel < cnt) ? 1.f : 0.f); }
        u32x4 tt; tt.x = pg8::cvt_pk_bf16(wv[0], wv[1]); tt.y = pg8::cvt_pk_bf16(wv[2], wv[3]); tt.z = pg8::cvt_pk_bf16(wv[4], wv[5]); tt.w = pg8::cvt_pk_bf16(wv[6], wv[7]); bfr[ks] = __builtin_bit_cast(bf16x8, tt); }
    bf16x8 ptf[4][8];
#pragma unroll
    for (int nt = 0; nt < 4; ++nt)
#pragma unroll
        for (int ks = 0; ks < 8; ++ks) ptf[nt][ks] = *(const bf16x8*)(PT + (size_t)g * 128 * 128 + (size_t)((nt * 8 + ks) * 64 + lane) * 8);
    const int i16 = lane & 15, G4 = lane >> 4;
    const int vb = (8 * (G4 >> 1) + (i16 >> 2)) * PROW + (16 * (G4 & 1) + 4 * (i16 & 3)) * 2;
    const float inv = __builtin_amdgcn_rcpf((float)cnt);
    bf16x8 pf[8];
#pragma unroll
    for (int ct = 0; ct < 4; ++ct) {
        f32x16 acc;
#pragma unroll
        for (int r = 0; r < 16; ++r) acc[r] = 0.f;
#pragma unroll
        for (int ks = 0; ks < 3; ++ks) {
            const s16x4 lo = __builtin_amdgcn_ds_read_tr16_b64_v4i16((LAS s16x4*)(sl + vb + (16 * ks) * PROW + ct * 64));
            const s16x4 hh = __builtin_amdgcn_ds_read_tr16_b64_v4i16((LAS s16x4*)(sl + vb + (16 * ks + 4) * PROW + ct * 64));
            const bf16x8 a = (bf16x8){lo[0], lo[1], lo[2], lo[3], hh[0], hh[1], hh[2], hh[3]};
            acc = __builtin_amdgcn_mfma_f32_32x32x16_bf16(a, bfr[ks], acc, 0, 0, 0); }
#pragma unroll
        for (int s = 0; s < 2; ++s) { u32x4 tt; tt.x = pg8::cvt_pk_bf16(acc[8 * s] * inv, acc[8 * s + 1] * inv); tt.y = pg8::cvt_pk_bf16(acc[8 * s + 2] * inv, acc[8 * s + 3] * inv);
            tt.z = pg8::cvt_pk_bf16(acc[8 * s + 4] * inv, acc[8 * s + 5] * inv); tt.w = pg8::cvt_pk_bf16(acc[8 * s + 6] * inv, acc[8 * s + 7] * inv); pf[2 * ct + s] = __builtin_bit_cast(bf16x8, tt); }
    }
#pragma unroll
    for (int p = 0; p < 8; ++p) { const int idx = p * 64 + lane; const u32x4 v = *(const u32x4*)(SG + (size_t)(tok0 + (idx >> 4)) * 1536 + g * 128 + (idx & 15) * 8); *(LAS u32x4*)(sl + (idx >> 4) * PROW + (idx & 15) * 16) = v; }
#pragma unroll
    for (int nt = 0; nt < 4; ++nt) {
        f32x16 acc;
#pragma unroll
        for (int r = 0; r < 16; ++r) acc[r] = 0.f;
#pragma unroll
        for (int ks = 0; ks < 8; ++ks) acc = __builtin_amdgcn_mfma_f32_32x32x16_bf16(ptf[nt][ks], pf[ks], acc, 0, 0, 0);
#pragma unroll
        for (int q = 0; q < 4; ++q) { LAS u32x2* p = (LAS u32x2*)(sl + r32 * PROW + (nt * 32 + 8 * q + 4 * hi) * 2); const u32x2 sg = *p; u32x2 y;
            y.x = pg8::cvt_pk_bf16(acc[4 * q] * bflo(sg.x), acc[4 * q + 1] * bfhi(sg.x)); y.y = pg8::cvt_pk_bf16(acc[4 * q + 2] * bflo(sg.y), acc[4 * q + 3] * bfhi(sg.y));
            *p = y; }
    }
#pragma unroll
    for (int p = 0; p < 8; ++p) { const int idx = p * 64 + lane; const u32x4 v = *(const LAS u32x4*)(sl + (idx >> 4) * PROW + (idx & 15) * 16);
        *(u32x4*)(YO + (size_t)(tok0 + (idx >> 4)) * 1536 + g * 128 + (idx & 15) * 8) = v; }
}
__device__ __forceinline__ void conv_item(int ci, const bf16_t* Z, const bf16_t* Wy, bf16_t* YO, const float* cw, const float* cb, int lane) {
    const int tok0 = ci * 8, t0 = tok0 & (SEQ - 1), ch = lane * 8;
    float w0[8], w1[8], w2[8], bs[8], zm2[8], zm1[8];
#pragma unroll
    for (int hf = 0; hf < 2; ++hf) { const f32x4 a = *(const f32x4*)(cw + ch + 4 * hf), b = *(const f32x4*)(cw + 512 + ch + 4 * hf), c = *(const f32x4*)(cw + 1024 + ch + 4 * hf), d = *(const f32x4*)(cb + ch + 4 * hf);
#pragma unroll
        for (int i = 0; i < 4; ++i) { w0[4 * hf + i] = a[i]; w1[4 * hf + i] = b[i]; w2[4 * hf + i] = c[i]; bs[4 * hf + i] = d[i]; } }
#pragma unroll
    for (int i = 0; i < 8; ++i) { zm2[i] = 0.f; zm1[i] = 0.f; }
    if (t0 != 0) { const u32x4 a = *(const u32x4*)(Z + (size_t)(tok0 - 2) * 512 + ch), b = *(const u32x4*)(Z + (size_t)(tok0 - 1) * 512 + ch);
        zm2[0] = bflo(a.x); zm2[1] = bfhi(a.x); zm2[2] = bflo(a.y); zm2[3] = bfhi(a.y); zm2[4] = bflo(a.z); zm2[5] = bfhi(a.z); zm2[6] = bflo(a.w); zm2[7] = bfhi(a.w);
        zm1[0] = bflo(b.x); zm1[1] = bfhi(b.x); zm1[2] = bflo(b.y); zm1[3] = bfhi(b.y); zm1[4] = bflo(b.z); zm1[5] = bfhi(b.z); zm1[6] = bflo(b.w); zm1[7] = bfhi(b.w); }
    u32x4 zr[8], wr_[8];
#pragma unroll
    for (int r = 0; r < 8; ++r) { zr[r] = *(const u32x4*)(Z + (size_t)(tok0 + r) * 512 + ch); wr_[r] = *(const u32x4*)(Wy + (size_t)(tok0 + r) * 1536 + ch); }
#pragma unroll
    for (int r = 0; r < 8; ++r) {
        float zc[8], wv[8], y[8];
        zc[0] = bflo(zr[r].x); zc[1] = bfhi(zr[r].x); zc[2] = bflo(zr[r].y); zc[3] = bfhi(zr[r].y); zc[4] = bflo(zr[r].z); zc[5] = bfhi(zr[r].z); zc[6] = bflo(zr[r].w); zc[7] = bfhi(zr[r].w);
        wv[0] = bflo(wr_[r].x); wv[1] = bfhi(wr_[r].x); wv[2] = bflo(wr_[r].y); wv[3] = bfhi(wr_[r].y); wv[4] = bflo(wr_[r].z); wv[5] = bfhi(wr_[r].z); wv[6] = bflo(wr_[r].w); wv[7] = bfhi(wr_[r].w);
#pragma unroll
        for (int i = 0; i < 8; ++i) { y[i] = wv[i] * (w0[i] * zm2[i] + w1[i] * zm1[i] + w2[i] * zc[i] + bs[i]); zm2[i] = zm1[i]; zm1[i] = zc[i]; }
        u32x4 o; o.x = pg8::cvt_pk_bf16(y[0], y[1]); o.y = pg8::cvt_pk_bf16(y[2], y[3]); o.z = pg8::cvt_pk_bf16(y[4], y[5]); o.w = pg8::cvt_pk_bf16(y[6], y[7]);
        *(u32x4*)(YO + (size_t)(tok0 + r) * 1536 + ch) = o; }
}
template <int R> __device__ __forceinline__ void norm_rows(const float* F32T, const float* RS, const float* xin, const float* gpost, float* xout, const float* gnext, bf16_t* H, int m0, int mstride, int lane) {
    f32x4 o[R][4], xi[R][4]; float ss[R];
#pragma unroll
    for (int r = 0; r < R; ++r) { const size_t row = (size_t)(m0 + r * mstride); ss[r] = (lane < 16) ? RS[row * 16 + lane] : 0.f;
#pragma unroll
        for (int j = 0; j < 4; ++j) { o[r][j] = ((const f32x4*)(F32T + row * DM))[64 * j + lane]; xi[r][j] = ((const f32x4*)(xin + row * DM))[64 * j + lane]; } }
    f32x4 gp[4];
#pragma unroll
    for (int j = 0; j < 4; ++j) gp[j] = ((const f32x4*)gpost)[64 * j + lane];
#pragma unroll
    for (int r = 0; r < R; ++r) { const size_t row = (size_t)(m0 + r * mstride);
        const float rstd = 1.f / sqrtf(wave_sum(ss[r]) * (1.f / DM) + RMS_EPS); float s2 = 0.f;
#pragma unroll
        for (int j = 0; j < 4; ++j) { const f32x4 v = xi[r][j] + o[r][j] * rstd * gp[j]; xi[r][j] = v; ((f32x4*)(xout + row * DM))[64 * j + lane] = v; s2 += (v[0] * v[0] + v[1] * v[1]) + (v[2] * v[2] + v[3] * v[3]); }
        if (gnext) { const float r2 = 1.f / sqrtf(wave_sum(s2) * (1.f / DM) + RMS_EPS);
#pragma unroll
            for (int j = 0; j < 4; ++j) { const f32x4 gg = ((const f32x4*)gnext)[64 * j + lane]; const f32x4 v = xi[r][j]; u32x2 w; w.x = pg8::cvt_pk_bf16(v[0] * r2 * gg[0], v[1] * r2 * gg[1]); w.y = pg8::cvt_pk_bf16(v[2] * r2 * gg[2], v[3] * r2 * gg[3]); ((u32x2*)(H + row * DM))[64 * j + lane] = w; } } }
}

struct Args { const float* in[10]; float* out; unsigned char* ws; int ph_lo, ph_hi; };
template <class T> __device__ __forceinline__ T* as_global(T* p) { return p; }
#if TP_A >= 0
#define TSTAMP(k) do { if (blockIdx.x == TP_BLK && threadIdx.x == 0) ((volatile LAS unsigned long long*)(lds + 147264))[(k)] = __builtin_amdgcn_s_memrealtime(); } while (0)
#else
#define TSTAMP(k) do { } while (0)
#endif
template <int ph> __device__ __forceinline__ void run_phase(const Args& a_, LAS unsigned char* lds) {
        const Args* A = &a_;
        const int tid = threadIdx.x, lane = tid & 63, wave = __builtin_amdgcn_readfirstlane(tid >> 6);
        const int G = gridDim.x, bx = blockIdx.x;
        const int vcu = (G % 8 == 0) ? (bx % 8) * (G / 8) + bx / 8 : bx;
        const int gw = vcu * 8 + wave, NGW = G * 8;
        unsigned char* ws = as_global(A->ws);
        bf16_t* H = (bf16_t*)(ws + WS_H); bf16_t* U = (bf16_t*)(ws + WS_U);
        if constexpr (ph == 0) {
            const float* x = as_global(A->in[0]); const float* pre_g = as_global(A->in[1]); const float* w_in = as_global(A->in[2]); const float* pool_w = as_global(A->in[3]); const float* pool_scale = as_global(A->in[4]); const float* w_branch = as_global(A->in[7]); const float* w_out = as_global(A->in[8]);
            bf16_t* W1 = (bf16_t*)(ws + WS_W1); bf16_t* W2 = (bf16_t*)(ws + WS_W2); bf16_t* W3 = (bf16_t*)(ws + WS_W3); bf16_t* PW = (bf16_t*)(ws + WS_PW);
            LAS float* scr = (LAS float*)(lds + wave * 17408);
            constexpr int I1 = (DM / 64) * (NIN / 64), I4 = 2 * 2;
            for (int it = gw; it < I1 + 8 * I4; it += NGW) {
                if (it < I1) transpose_item(w_in, NIN, W1, DM, 0, 0, true, scr, it, lane);
                else { const int r = it - I1, lg = r / I4; transpose_item(pool_w + (size_t)lg * 128 * 128, 128, PW + (size_t)lg * 128 * 128, 128, 0, 0, false, scr, r % I4, lane, pool_scale + lg * 128); }
            }
            for (int m = gw; m < MTOK; m += 2 * NGW) rms_rows_to_bf16<2>(x, pre_g, H, m, NGW, lane);
        } else {
            constexpr int l = (ph - 1) / 5, k = (ph - 1) % 5;
            if constexpr (k == 0) {
                pg8::Gemm g{H, (bf16_t*)(ws + WS_W1) + (size_t)l * NIN * DM, MTOK, NIN, DM, 0}; pg8::StaticOrder S; S.init(MTOK, NIN, G, bx);
                EpiU E{ws};
                pg8::gemm_phase<EpiU, pg8::StaticOrder, true, true>(lds, g, S, E);
            } else if constexpr (k == 1) {
                const float* pool_scale = as_global(A->in[4]); const float* conv_w = as_global(A->in[5]); const float* conv_b = as_global(A->in[6]);
                const bf16_t* PW = (const bf16_t*)(ws + WS_PW);
                const bf16_t* Q = U + 2 * (ARRB / 2); const bf16_t* Kk = U + 3 * (ARRB / 2); const bf16_t* V = U + 4 * (ARRB / 2);
                LAS unsigned char* vl = lds + wave * (32 * VROW + 48 * PROW);
                LAS unsigned char* sl_ = vl + 32 * VROW;
                bf16_t* G3 = U + 5 * (ARRB / 2);
                bf16_t* YO = G3;
#if MIX_PROBE
                if (l == 0 && A->ph_hi < 0) YO = (bf16_t*)as_global(A->out);
#endif
                int pm_ = 7;
#if MIX_PROBE
                if (l == 0 && A->ph_hi < 0) pm_ = MIX_PROBE;
#endif
                if (l == 0) TSTAMP(12);
                volatile LAS unsigned* wq = (volatile LAS unsigned*)(lds + 147216);
                if (tid < 4) wq[tid] = 0u;
                __syncthreads();
#define WQ_GRAB(Q_) ({ unsigned v_ = 0u; if (lane == 0) v_ = __hip_atomic_fetch_add((LAS unsigned*)(Q_), 1u, __ATOMIC_RELAXED, __HIP_MEMORY_SCOPE_WORKGROUP); (unsigned)__builtin_amdgcn_readfirstlane((int)v_); })
#define WQ_ITEM(J_) ((int)(vcu * 8 + ((J_) & 7u) + ((J_) >> 3) * (unsigned)NGW))
                for (;;) { const unsigned j = WQ_GRAB(wq); const int it = WQ_ITEM(j); if (it >= NB * 8 * 128) break; attn_item(it, Q, Kk, V, G3 + 1024, YO + 1024, vl, sl_, lane); }
                if (l == 0) TSTAMP(13);
                for (;;) { const unsigned j = WQ_GRAB(wq + 1); const int it = WQ_ITEM(j); if (it >= (MTOK / 32) * 4) break; pool_item(it, U, G3, YO, PW + (size_t)l * 4 * 128 * 128, pool_scale + l * BWID, sl_, lane); }
                if (l == 0) TSTAMP(14);
                for (;;) { const unsigned j = WQ_GRAB(wq + 2); const int it = WQ_ITEM(j); if (it >= MTOK / 8) break; conv_item(it, U + 1 * (ARRB / 2), G3 + 512, YO + 512, conv_w + l * 3 * BWID, conv_b + l * BWID, lane); }
                if constexpr (l == 0) {
                    const float* w_in = as_global(A->in[2]); const float* w_branch = as_global(A->in[7]); const float* w_out = as_global(A->in[8]);
                    bf16_t* W1 = (bf16_t*)(ws + WS_W1); bf16_t* W2 = (bf16_t*)(ws + WS_W2); bf16_t* W3 = (bf16_t*)(ws + WS_W3);
                    constexpr int I1 = (DM / 64) * (NIN / 64), I2 = (BWID / 64) * (DM / 64), I3 = (DM / 64) * (DM / 64), NDEF = I1 + 6 * I2 + 2 * I3;
                    for (;;) { const unsigned j = WQ_GRAB(wq + 3); int r = WQ_ITEM(j); if (r >= NDEF) break;
                        if (r < I1) { transpose_item(w_in + (size_t)DM * NIN, NIN, W1 + (size_t)NIN * DM, DM, 0, 0, true, (LAS float*)vl, r, lane); continue; } r -= I1;
                        if (r < 6 * I2) { const int ln = r / I2, ll = ln / 3, n = ln % 3; transpose_item(w_branch + (size_t)ln * BWID * DM, DM, W2 + (size_t)ll * 3 * DM * BWID, 3 * BWID, n * BWID, 0, false, (LAS float*)vl, r % I2, lane); continue; } r -= 6 * I2;
                        { const int ll = r / I3; transpose_item(w_out + (size_t)ll * DM * DM, DM, W3 + (size_t)ll * DM * DM, DM, 0, 0, false, (LAS float*)vl, r % I3, lane); }
                    }
                }
#undef WQ_GRAB
#undef WQ_ITEM
                if (l == 0) TSTAMP(15);
#if TP_A >= 0
                if (l == 0) { __syncthreads(); TSTAMP(5); }
#endif
            } else if constexpr (k == 2) {
                pg8::Gemm g{U + 5 * (ARRB / 2), (bf16_t*)(ws + WS_W2) + (size_t)l * 3 * DM * BWID, MTOK, DM, 3 * BWID, 0}; pg8::StaticOrder S; S.init(MTOK, DM, G, bx);
                EpiBranch E{ws};
                pg8::gemm_phase<EpiBranch, pg8::StaticOrder, true, true>(lds, g, S, E);
            } else if constexpr (k == 3) {
                pg8::Gemm g{H, (bf16_t*)(ws + WS_W3) + (size_t)l * DM * DM, MTOK, DM, DM, 0}; pg8::StaticOrder S; S.init(MTOK, DM, G, bx);
                if (G == 256) {
                    const float* x = as_global(A->in[0]); const float* pre_g = as_global(A->in[1]); const float* post_g = as_global(A->in[9]); float* out = as_global(A->out);
                    float* xb = (float*)(ws + WS_RS); unsigned* cn = (unsigned*)(ws + WS_CTL + CTL_CNT);
                    if constexpr (l + 1 < NLAYER) {
                        EpiNorm2 E{x, out, H, post_g + l * DM, pre_g + (l + 1) * DM, RmsPanel{xb, cn}, RmsPanel{xb + (size_t)MTOK * 4, cn + 64 * 64}};
                        pg8::gemm_phase<EpiNorm2, pg8::StaticOrder, false, true>(lds, g, S, E);
                    } else {
                        EpiNorm1 E{out, post_g + l * DM, RmsPanel{xb + (size_t)2 * MTOK * 4, cn + 2 * 64 * 64}};
                        pg8::gemm_phase<EpiNorm1, pg8::StaticOrder, false, true>(lds, g, S, E);
                    }
                } else {
                    EpiOut E{ws};
                    pg8::gemm_phase<EpiOut, pg8::StaticOrder, true, true>(lds, g, S, E);
                }
            } else {
                const float* x = as_global(A->in[0]); const float* pre_g = as_global(A->in[1]); const float* post_g = as_global(A->in[9]); float* out = as_global(A->out);
                const float* F32T = (const float*)(ws + WS_U); const float* RS = (const float*)(ws + WS_RS);
                const float* xin = (l == 0) ? x : out; const float* gnext = (l + 1 < NLAYER) ? pre_g + (l + 1) * DM : nullptr;
                if (G != 256) for (int m = gw; m < MTOK; m += 2 * NGW) norm_rows<2>(F32T, RS, xin, post_g + l * DM, out, gnext, H, m, NGW, lane);
            }
        }
}
__global__ void __launch_bounds__(512, 2) hybrid_fwd(Args a_) {
    extern __shared__ __attribute__((aligned(16))) unsigned char lds_raw[];
    LAS unsigned char* lds = (LAS unsigned char*)lds_raw;
    cg::grid_group grid = cg::this_grid();
    if (threadIdx.x < 64) ((LAS unsigned*)(lds + 147200))[threadIdx.x] = 0u;
    __syncthreads();
    (void)xcd_barrier_post((unsigned*)(a_.ws + WS_CTL), (volatile LAS unsigned*)(lds + 147200 + 32));
#define SEAM_BAR() do { XcdBarrier b_; b_.bar = (unsigned*)(a_.ws + WS_CTL); b_.x = xb_xcc_id(); b_.st = (volatile LAS unsigned*)(lds + 147200 + 32); xcd_barrier(b_); } while (0)
    const int lo = a_.ph_lo, hi = a_.ph_hi < 0 ? -a_.ph_hi : a_.ph_hi;
#define PHASE(k) if (lo <= (k) && (k) < hi && !(((k) == 5 || (k) == 10) && gridDim.x == 256)) { if ((k) > lo) { if ((k) == 1 && lo < 0) grid.sync(); else SEAM_BAR(); } TSTAMP(k); run_phase<(k)>(a_, lds); }
    PHASE(0) PHASE(1) PHASE(2) PHASE(3) PHASE(4) PHASE(5) PHASE(6) PHASE(7) PHASE(8) PHASE(9) PHASE(10)
#undef PHASE
#if TP_A >= 0
    SEAM_BAR(); TSTAMP(11);
    if (blockIdx.x == TP_BLK && threadIdx.x == 0) { volatile LAS unsigned long long* ts = (volatile LAS unsigned long long*)(lds + 147264); a_.out[0] += (float)(ts[TP_B] - ts[TP_A]) * (0.00005f * TP_SCALE); }
#endif
}

extern "C" void kernel_launch(void* const* d_in, const int* in_sizes, int n_in, void* d_out, int out_size, void* d_ws, size_t ws_size, hipStream_t stream) {
    static int grid = 0;
    if (grid == 0) {
        if (n_in != 10 || out_size != MTOK * DM || ws_size < WS_END) { fprintf(stderr, "kernel_launch: unexpected shapes / workspace (n_in %d out %d ws %zu)\n", n_in, out_size, ws_size); grid = -1; return; }
        int dev = 0, cus = 0, per_cu = 0;
        (void)hipGetDevice(&dev); (void)hipDeviceGetAttribute(&cus, hipDeviceAttributeMultiprocessorCount, dev);
        (void)hipFuncSetAttribute((const void*)hybrid_fwd, hipFuncAttributeMaxDynamicSharedMemorySize, LDS_BYTES);
        (void)hipOccupancyMaxActiveBlocksPerMultiprocessor(&per_cu, (const void*)hybrid_fwd, 512, LDS_BYTES);
        (void)hipGetLastError();
        if (per_cu < 1) { fprintf(stderr, "kernel_launch: occupancy query says %d blocks/CU\n", per_cu); per_cu = 1; }
        grid = cus;
    }
    if (grid < 0) return;
    if (hipMemsetAsync((char*)d_ws + WS_CTL, 0, CTL_BYTES, stream) != hipSuccess) { fprintf(stderr, "kernel_launch: memset of the barrier words failed\n"); return; }
    Args a{};
    for (int i = 0; i < 10; ++i) a.in[i] = (const float*)d_in[i];
    a.out = (float*)d_out; a.ws = (unsigned char*)d_ws;
#if ONE_LAUNCH
    a.ph_lo = 0; a.ph_hi = NPHASE;
    void* args[] = {&a};
    hipError_t e = hipLaunchCooperativeKernel((const void*)hybrid_fwd, dim3(grid), dim3(512), args, LDS_BYTES, stream);
    if (e != hipSuccess) fprintf(stderr, "cooperative launch failed: %s (grid %d)\n", hipGetErrorString(e), grid);
#else
    for (int ph = 0; ph < NPHASE; ++ph) { a.ph_lo = ph; a.ph_hi = ph + 1;
#if MIX_PROBE
        if (ph == 2) { a.ph_hi = -(ph + 1); hipLaunchKernelGGL(hybrid_fwd, dim3(grid), dim3(512), LDS_BYTES, stream, a); a.ph_hi = ph + 1; }
#endif
        for (int rep = 0; rep < 1 + ((DUP_MASK >> ph) & 1); ++rep) hipLaunchKernelGGL(hybrid_fwd, dim3(grid), dim3(512), LDS_BYTES, stream, a); }
#endif
}
```

```cpp
#include <hip/hip_runtime.h>
#include <hip/hip_cooperative_groups.h>
#include <cstdio>
#include <cstdint>
namespace cg = cooperative_groups;
#ifndef ONE_LAUNCH
#define ONE_LAUNCH 1
#endif
#ifndef DUP_MASK
#define DUP_MASK 0
#endif
#ifndef MIX_PROBE
#define MIX_PROBE 0
#endif
#ifndef TP_A
#define TP_A -1
#define TP_B -1
#endif
#ifndef TP_SCALE
#define TP_SCALE 1
#endif
#ifndef TP_BLK
#define TP_BLK 0
#endif
namespace pg8 {
#define PG8_LAS __attribute__((address_space(3)))
typedef unsigned short bf16_t;
typedef short bf16x8 __attribute__((ext_vector_type(8)));
typedef float f32x4 __attribute__((ext_vector_type(4)));
typedef unsigned u32x4 __attribute__((ext_vector_type(4)));
constexpr int BM = 256, BK = 64, HALF = 128, HTB = HALF * BK * 2  , STAGE_BYTES = 8 * HTB, NXCD = 8, WGM = 8;

__host__ __device__ __forceinline__ int lds_byte(int r, int c) { const int st = (r >> 4) * 2 + (c >> 5), rr = r & 15, cc = c & 31, ob = rr * 64 + cc * 2; return st * 1024 + (ob ^ (((ob >> 9) & 1) << 5)); }
__host__ __device__ __forceinline__ void stage_rc(int b, int& R, int& C) { const int st = b / 1024, sb = b % 1024, swz = sb ^ (((sb >> 9) & 1) << 5); R = (st >> 1) * 16 + swz / 64; C = (st & 1) * 32 + (swz % 64) / 2; }
__host__ __device__ __forceinline__ int perm32(int rho) { const int n = rho >> 4, i = rho & 15; return 8 * (i >> 2) + 4 * n + (i & 3); }

struct Unit { int pm, pn, az; };
struct Gemm { const bf16_t* A; const bf16_t* Bt; int M, N, K; size_t azs; };

struct StaticOrder {
    int nM, nN, nwg, G, c;
    __host__ __device__ void init(int M, int N, int G_, int c_) { nM = M / BM; nN = N / BM; nwg = nM * nN; G = G_; c = c_; }
    __host__ __device__ bool next(int i, Unit& u) const {
        const long L = (long)i * G + c; if (L >= nwg) return false;
        int wgid = (int)L; { const int q = nwg / NXCD, r = nwg % NXCD, xcd = wgid % NXCD, off = wgid / NXCD; wgid = (xcd < r ? xcd * (q + 1) : r * (q + 1) + (xcd - r) * q) + off; }
        const int nig = WGM * nN, gid = wgid / nig, fm = gid * WGM, gsz = (nM - fm) < WGM ? (nM - fm) : WGM;
        u.pm = fm + ((wgid % nig) % gsz); u.pn = (wgid % nig) / gsz; u.az = 0; return true;
    }
    __device__ __forceinline__ void a_ready(const Unit&) const {}
    __device__ __forceinline__ void done(const Unit&) const {}
};

__device__ __forceinline__ unsigned cvt_pk_bf16(float lo, float hi) { unsigned r; asm volatile("v_cvt_pk_bf16_f32 %0, %1, %2" : "=v"(r) : "v"(lo), "v"(hi)); return r; }
template <class Epi, class Sched, bool ALIGN_EPI = false, bool SP2 = false>
__device__ __forceinline__ void gemm_phase(PG8_LAS unsigned char* lds, const Gemm g, const Sched& S, const Epi& E) {
    const int tid = threadIdx.x, wid = __builtin_amdgcn_readfirstlane(tid >> 6), lane = tid & 63, wr = wid >> 2, wc = wid & 3, fr = lane & 15, fq = lane >> 4;
    const int K = g.K, nt = K / BK;
    unsigned voffA[2], voffB[2];
#pragma unroll
    for (int i = 0; i < 2; ++i) { int R, C; stage_rc(tid * 16 + i * 8192, R, C); const int Rb = Epi::PERM ? ((R & ~31) + perm32(R & 31)) : R;
        voffA[i] = (unsigned)(R * K + C) * 2u; voffB[i] = (unsigned)(Rb * K + C) * 2u; }
    const size_t kstep = (size_t)(BK * 2);
    const size_t hstep = (size_t)HALF * K * 2;
    const size_t tstep = 2 * hstep;
    const unsigned ldsw = (unsigned)wid * 1024u;
    const int aoff = lds_byte(wr * 64 + fr, fq * 8), boff = lds_byte(wc * 32 + fr, fq * 8);
#define PG8_SA(b, h) (((b) * 2 + (h)) * HTB)
#define PG8_SB(b, h) ((4 + (b) * 2 + (h)) * HTB)
#define PG8_STAGE(bufoff, gbase, voff) do { _Pragma("unroll") for (int _i = 0; _i < 2; ++_i) \
        __builtin_amdgcn_global_load_lds((const unsigned*)((const char*)(gbase) + (voff)[_i]), (PG8_LAS unsigned*)(lds + (bufoff) + ldsw + _i * 8192), 16, 0, 0); } while (0)
#define PG8_LDA(dst, b, h) do { _Pragma("unroll") for (int m = 0; m < 4; ++m) _Pragma("unroll") for (int k = 0; k < 2; ++k) dst[m][k] = *(const PG8_LAS bf16x8*)(lds + PG8_SA(b, h) + aoff + m * 2048 + k * 1024); } while (0)
#define PG8_LDB(dst, b, h) do { _Pragma("unroll") for (int n = 0; n < 2; ++n) _Pragma("unroll") for (int k = 0; k < 2; ++k) dst[n][k] = *(const PG8_LAS bf16x8*)(lds + PG8_SB(b, h) + boff + n * 2048 + k * 1024); } while (0)
#define PG8_MMA(ai, bj, At, Bt) do { __builtin_amdgcn_s_setprio(1); _Pragma("unroll") for (int m = 0; m < 4; ++m) _Pragma("unroll") for (int n = 0; n < 2; ++n) _Pragma("unroll") for (int k = 0; k < 2; ++k) \
        acc[ai][bj][m][n] = __builtin_amdgcn_mfma_f32_16x16x32_bf16(Bt[n][k], At[m][k], acc[ai][bj][m][n], 0, 0, 0); __builtin_amdgcn_s_setprio(0); } while (0)
#define PG8_WAIT_V(n) asm volatile("s_waitcnt vmcnt(" #n ")" ::: "memory")
#define PG8_WAIT_L(n) asm volatile("s_waitcnt lgkmcnt(" #n ")" ::: "memory")
#define PG8_BAR __builtin_amdgcn_s_barrier()
#define PG8_SCHED __builtin_amdgcn_sched_barrier(0)
    Unit cur, nxt; int ui = 0;
    if (!S.next(0, cur)) return;
    f32x4 acc[2][2][4][2];
#pragma unroll
    for (int a = 0; a < 2; ++a)
#pragma unroll
        for (int b = 0; b < 2; ++b)
#pragma unroll
            for (int m = 0; m < 4; ++m)
#pragma unroll
                for (int n = 0; n < 2; ++n) acc[a][b][m][n] = (f32x4){0.f, 0.f, 0.f, 0.f};
    bf16x8 At[4][2], B0[2][2], B1[2][2];
    const char* cA = (const char*)g.A + (size_t)cur.pm * tstep + (size_t)cur.az * g.azs; const char* cB = (const char*)g.Bt + (size_t)cur.pn * tstep;
    S.a_ready(cur);
    if constexpr (SP2) {
        PG8_STAGE(PG8_SB(0, 0), cB, voffB); PG8_STAGE(PG8_SB(0, 1), cB + hstep, voffB); PG8_STAGE(PG8_SA(0, 0), cA, voffA); PG8_STAGE(PG8_SA(0, 1), cA + hstep, voffA);
        if (wr == 1) PG8_BAR;
        PG8_WAIT_V(2); PG8_BAR;
        PG8_STAGE(PG8_SB(1, 0), cB + kstep, voffB); PG8_STAGE(PG8_SA(1, 0), cA + kstep, voffA); PG8_STAGE(PG8_SB(1, 1), cB + hstep + kstep, voffB);
        PG8_WAIT_V(6); PG8_BAR;
    } else {
        PG8_STAGE(PG8_SB(0, 0), cB, voffB); PG8_STAGE(PG8_SA(0, 0), cA, voffA); PG8_STAGE(PG8_SB(0, 1), cB + hstep, voffB); PG8_STAGE(PG8_SA(0, 1), cA + hstep, voffA);
        if (wr == 1) PG8_BAR;
        PG8_WAIT_V(4); PG8_BAR;
        PG8_STAGE(PG8_SB(1, 0), cB + kstep, voffB); PG8_STAGE(PG8_SA(1, 0), cA + kstep, voffA); PG8_STAGE(PG8_SB(1, 1), cB + hstep + kstep, voffB);
        PG8_WAIT_V(6); PG8_BAR;
    }
    for (;;) {
        const bool has_next = S.next(ui + 1, nxt);
        const char* nA = has_next ? (const char*)g.A + (size_t)nxt.pm * tstep + (size_t)nxt.az * g.azs : cA; const char* nB = has_next ? (const char*)g.Bt + (size_t)nxt.pn * tstep : cB;
        for (int t = 0; t < nt; t += 2) {
            if constexpr (Epi::MIDK) { if (t == 8 || t == 16) E.mid(acc, cur, t >> 3, wr, wc, fr, fq); }
            const bool last = (t == nt - 2);
            const char* a1 = cA + (size_t)(t + 1) * kstep;
            const char* a2 = last ? nA : cA + (size_t)(t + 2) * kstep; const char* b2 = last ? nB : cB + (size_t)(t + 2) * kstep;
            const char* a3 = a2 + kstep; const char* b3 = b2 + kstep;
            if (last && has_next) S.a_ready(nxt);
            if constexpr (SP2) {
            PG8_LDB(B0, 0, 0); PG8_LDB(B1, 0, 1); PG8_SCHED; PG8_LDA(At, 0, 0); PG8_STAGE(PG8_SA(1, 1), a1 + hstep, voffA);
            PG8_WAIT_V(8); PG8_WAIT_L(0); PG8_BAR; PG8_MMA(0, 0, At, B0); PG8_MMA(0, 1, At, B1); PG8_BAR; PG8_SCHED;
            PG8_LDA(At, 0, 1); PG8_STAGE(PG8_SB(0, 0), b2, voffB); PG8_STAGE(PG8_SB(0, 1), b2 + hstep, voffB); PG8_STAGE(PG8_SA(0, 0), a2, voffA);
            PG8_WAIT_V(8); PG8_WAIT_L(0); PG8_BAR; PG8_MMA(1, 0, At, B0); PG8_MMA(1, 1, At, B1); PG8_BAR; PG8_SCHED;
            PG8_LDB(B0, 1, 0); PG8_LDB(B1, 1, 1); PG8_SCHED; PG8_LDA(At, 1, 0); PG8_STAGE(PG8_SA(0, 1), a2 + hstep, voffA);
            PG8_WAIT_V(8); PG8_WAIT_L(0); PG8_BAR; PG8_MMA(0, 0, At, B0); PG8_MMA(0, 1, At, B1); PG8_BAR; PG8_SCHED;
            PG8_LDA(At, 1, 1); PG8_STAGE(PG8_SB(1, 0), b3, voffB); PG8_STAGE(PG8_SB(1, 1), b3 + hstep, voffB); PG8_STAGE(PG8_SA(1, 0), a3, voffA);
            PG8_WAIT_V(8); PG8_WAIT_L(0); PG8_BAR; PG8_MMA(1, 0, At, B0); PG8_MMA(1, 1, At, B1); PG8_BAR; PG8_SCHED;
            } else {
            PG8_LDB(B0, 0, 0); PG8_SCHED; PG8_LDA(At, 0, 0); PG8_STAGE(PG8_SA(1, 1), a1 + hstep, voffA);
            PG8_WAIT_L(8); PG8_BAR; PG8_WAIT_L(0); PG8_MMA(0, 0, At, B0); PG8_BAR; PG8_SCHED;
            PG8_LDB(B1, 0, 1); PG8_STAGE(PG8_SB(0, 0), b2, voffB);
            PG8_BAR; PG8_WAIT_L(0); PG8_MMA(0, 1, At, B1); PG8_BAR;
            PG8_LDA(At, 0, 1); PG8_STAGE(PG8_SA(0, 0), a2, voffA);
            PG8_BAR; PG8_WAIT_L(0); PG8_MMA(1, 0, At, B0); PG8_BAR; PG8_SCHED;
            PG8_STAGE(PG8_SB(0, 1), b2 + hstep, voffB);
            PG8_WAIT_V(6); PG8_BAR; PG8_MMA(1, 1, At, B1); PG8_BAR;
            PG8_LDB(B0, 1, 0); PG8_SCHED; PG8_LDA(At, 1, 0); PG8_STAGE(PG8_SA(0, 1), a2 + hstep, voffA);
            PG8_WAIT_L(8); PG8_BAR; PG8_WAIT_L(0); PG8_MMA(0, 0, At, B0); PG8_BAR; PG8_SCHED;
            PG8_LDB(B1, 1, 1); PG8_STAGE(PG8_SB(1, 0), b3, voffB);
            PG8_BAR; PG8_WAIT_L(0); PG8_MMA(0, 1, At, B1); PG8_BAR;
            PG8_LDA(At, 1, 1); PG8_STAGE(PG8_SA(1, 0), a3, voffA);
            PG8_BAR; PG8_WAIT_L(0); PG8_MMA(1, 0, At, B0); PG8_BAR; PG8_SCHED;
            PG8_STAGE(PG8_SB(1, 1), b3 + hstep, voffB);
            PG8_WAIT_V(6); PG8_BAR; PG8_MMA(1, 1, At, B1); PG8_BAR;
            }
        }
        if constexpr (ALIGN_EPI) { if (wr == 0) PG8_BAR; }
        if constexpr (!Epi::AFTER_DRAIN) { E(acc, cur, wr, wc, fr, fq); S.done(cur); }
        if (!has_next) break;
#pragma unroll
        for (int a = 0; a < 2; ++a)
#pragma unroll
            for (int b = 0; b < 2; ++b)
#pragma unroll
                for (int m = 0; m < 4; ++m)
#pragma unroll
                    for (int n = 0; n < 2; ++n) acc[a][b][m][n] = (f32x4){0.f, 0.f, 0.f, 0.f};
        cur = nxt; cA = nA; cB = nB; ++ui;
        if constexpr (ALIGN_EPI) { if (wr == 1) PG8_BAR; }
    }
    PG8_WAIT_V(0);
    if constexpr (!ALIGN_EPI) { if (wr == 0) PG8_BAR; }
    PG8_BAR;
    if constexpr (Epi::AFTER_DRAIN) { E.fused(acc, cur, wr, wc, fr, fq, lds, wid, lane); S.done(cur); }
#undef PG8_SA
#undef PG8_SB
#undef PG8_STAGE
#undef PG8_LDA
#undef PG8_LDB
#undef PG8_MMA
#undef PG8_WAIT_V
#undef PG8_WAIT_L
#undef PG8_BAR
#undef PG8_SCHED
}
}

#define LAS __attribute__((address_space(3)))
typedef unsigned short bf16_t;
typedef short bf16x8 __attribute__((ext_vector_type(8)));
typedef short s16x4 __attribute__((ext_vector_type(4)));
typedef float f32x4 __attribute__((ext_vector_type(4)));
typedef float f32x16 __attribute__((ext_vector_type(16)));
typedef unsigned u32x4 __attribute__((ext_vector_type(4)));
typedef unsigned u32x2 __attribute__((ext_vector_type(2)));
constexpr int NB = 4, SEQ = 4096, DM = 1024, MTOK = NB * SEQ, NIN = 8192, BWID = 512, NLAYER = 2;
constexpr float RMS_EPS = 1e-6f;
constexpr size_t MiB = 1u << 20;
constexpr size_t WS_RS = 0;
constexpr size_t WS_W1 = 2 * MiB;
constexpr size_t WS_W2 = 34 * MiB;
constexpr size_t WS_W3 = 40 * MiB;
constexpr size_t WS_PW = 44 * MiB;
constexpr size_t WS_H = 45 * MiB;
constexpr size_t WS_U = 77 * MiB;
constexpr size_t ARRB = 16 * MiB;
constexpr size_t WS_MG = 205 * MiB;
constexpr size_t WS_END = 253 * MiB;
constexpr int LDS_BYTES = 147456;
constexpr int NPHASE = 1 + 5 * NLAYER;

__device__ __forceinline__ unsigned f2bf(float f) { unsigned u = __builtin_bit_cast(unsigned, f); return (u + 0x7fffu + ((u >> 16) & 1u)) >> 16; }
__device__ __forceinline__ unsigned pk2(float lo, float hi) { return f2bf(lo) | (f2bf(hi) << 16); }
__device__ __forceinline__ float bflo(unsigned u) { return __builtin_bit_cast(float, u << 16); }
__device__ __forceinline__ float bfhi(unsigned u) { return __builtin_bit_cast(float, u & 0xffff0000u); }
__device__ __forceinline__ float sigmoid_f(float x) { return __builtin_amdgcn_rcpf(1.f + __builtin_amdgcn_exp2f(-1.4426950408889634f * x)); }
__device__ __forceinline__ float silu_f(float x) { return x * sigmoid_f(x); }
__device__ __forceinline__ unsigned q8(float x) { const unsigned q = (unsigned)(sigmoid_f(x) * 255.f + 0.5f); return q < 1u ? 1u : q; }
__device__ __forceinline__ float wave_sum(float v) {
#pragma unroll
    for (int o = 1; o < 64; o <<= 1) v += __shfl_xor(v, o);
    return v;
}

constexpr size_t WS_CTL = 1 * MiB; constexpr size_t CTL_BYTES = 65536;
constexpr size_t CTL_CNT = 16384;
#define XB_TMO      128
#define XB_XCNT(j)  (256  + 64 * (j))
#define XB_XSUB(j)  (1280 + 64 * (j))
#define XB_XGEN(j)  (2304 + 64 * (j))
#define XB_TOP      3328
#define XB_TOPGEN   3392
#define XCD_BAR_WORDS 3456
#define XB_SPIN_CAP (1u << 18)

__device__ __forceinline__ unsigned xb_ld(unsigned* p)              { return __hip_atomic_load(p, __ATOMIC_RELAXED, __HIP_MEMORY_SCOPE_AGENT); }
__device__ __forceinline__ unsigned xb_add(unsigned* p, unsigned v) { return __hip_atomic_fetch_add(p, v, __ATOMIC_RELAXED, __HIP_MEMORY_SCOPE_AGENT); }
__device__ __forceinline__ unsigned xb_xcc_id() { return (unsigned)__builtin_amdgcn_s_getreg((3 << 11) | 20) & 0xFu; }
#define XB_SPIN(cond, bar) do { unsigned _sp = 0; while (cond) { __builtin_amdgcn_s_sleep(1); \
    if ((++_sp & 255u) == 0u) { if (xb_ld(&(bar)[XB_TMO])) break; if (_sp > XB_SPIN_CAP) { atomicAdd(&(bar)[XB_TMO], 1u); break; } } } } while (0)

struct XcdBarrier {
    unsigned* bar; unsigned x;
    volatile LAS unsigned* st;
};

__device__ __forceinline__ XcdBarrier xcd_barrier_post(unsigned* bar, volatile LAS unsigned* st) {
    XcdBarrier b; b.bar = bar; b.x = xb_xcc_id(); b.st = st;
    if (threadIdx.x == 0) (void)xb_add(&bar[XB_XCNT(b.x)], 1u);
    return b;
}
__device__ __forceinline__ void xcd_barrier_complete(unsigned* bar, unsigned x, unsigned& nloc, unsigned& nx) {
    const unsigned G = gridDim.x * gridDim.y * gridDim.z;
    unsigned sum, cnt, mine, sp = 0u;
    for (;;) {
        sum = 0u; cnt = 0u; mine = 0u;
#pragma unroll
        for (unsigned j = 0; j < 16; ++j) { const unsigned c = xb_ld(&bar[XB_XCNT(j)]); sum += c; cnt += (c > 0u) ? 1u : 0u; mine = (j == x) ? c : mine; }
        if (sum == G) break;
        __builtin_amdgcn_s_sleep(1);
        if ((++sp & 255u) == 0u) { if (xb_ld(&bar[XB_TMO])) break; if (sp > XB_SPIN_CAP) { atomicAdd(&bar[XB_TMO], 1u); break; } }
    }
    nloc = mine > 0u ? mine : 1u; nx = cnt > 0u ? cnt : 1u;
}

__device__ __forceinline__ void xcd_barrier(const XcdBarrier& b) {
    asm volatile("s_waitcnt vmcnt(0)" ::: "memory");
    __syncthreads();
    if (threadIdx.x == 0) {
        unsigned* bar = b.bar;
        __builtin_amdgcn_s_waitcnt(0);
        unsigned nloc = b.st[0], nx = b.st[1];
        if (nloc == 0u) { xcd_barrier_complete(bar, b.x, nloc, nx); b.st[0] = nloc; b.st[1] = nx; }
        const unsigned old = xb_add(&bar[XB_XSUB(b.x)], 1u);
        const unsigned gen = old / nloc;
        if (old + 1u == (gen + 1u) * nloc) {
            __builtin_amdgcn_fence(__ATOMIC_RELEASE, "agent");
            asm volatile("s_waitcnt vmcnt(0)" ::: "memory");
            const unsigned og = xb_add(&bar[XB_TOP], 1u);
            const unsigned tg = og / nx;
            if (og + 1u == (tg + 1u) * nx) xb_add(&bar[XB_TOPGEN], 1u);
            else XB_SPIN(xb_ld(&bar[XB_TOPGEN]) == tg, bar);
            __builtin_amdgcn_fence(__ATOMIC_ACQUIRE, "agent");
            xb_add(&bar[XB_XGEN(b.x)], 1u);
            asm volatile("s_waitcnt vmcnt(0)" ::: "memory");
        } else {
            XB_SPIN(xb_ld(&bar[XB_XGEN(b.x)]) == gen, bar);
            __builtin_amdgcn_fence(__ATOMIC_ACQUIRE, "agent");
            asm volatile("s_waitcnt vmcnt(0)" ::: "memory");
        }
    }
    __syncthreads();
}


using pg8::Unit;
struct EpiU {
    static constexpr bool PERM = true, AFTER_DRAIN = false, MIDK = false;
    unsigned char* ws;
    __device__ __forceinline__ void operator()(const f32x4 (&acc)[2][2][4][2], const Unit& u, int wr, int wc, int fr, int fq) const {
        bf16_t* U = (bf16_t*)(ws + WS_U); unsigned char* MG = ws + WS_MG;
        const int pn = u.pn; const int row0 = u.pm * 256 + wr * 64 + fr;
        if (pn >= 20) {
            unsigned char* tb = MG + ((size_t)u.pm * 12 + (pn - 20)) * 65536 + (size_t)(((wr * 4 + wc) * 16) * 64 + (fq * 16 + fr)) * 8;
#pragma unroll
            for (int ai = 0; ai < 2; ++ai)
#pragma unroll
                for (int m = 0; m < 4; ++m)
#pragma unroll
                    for (int bj = 0; bj < 2; ++bj) { const f32x4 v0 = acc[ai][bj][m][0], v1 = acc[ai][bj][m][1]; u32x2 w;
                        w.x = q8(v0[0]) | (q8(v0[1]) << 8) | (q8(v0[2]) << 16) | (q8(v0[3]) << 24); w.y = q8(v1[0]) | (q8(v1[1]) << 8) | (q8(v1[2]) << 16) | (q8(v1[3]) << 24);
                        *(u32x2*)(tb + ((ai * 4 + m) * 2 + bj) * 512) = w; }
        } else if (pn >= 4 && pn < 12) {
            const bool second = pn >= 8; const int ch0 = (pn & 3) * 128 + wc * 32 + 8 * fq;
            bf16_t* O = second ? (U + 5 * (ARRB / 2) + 512) : (U + 1 * (ARRB / 2)); const int pitch = second ? 1536 : 512;
#pragma unroll
            for (int ai = 0; ai < 2; ++ai)
#pragma unroll
                for (int m = 0; m < 4; ++m) { bf16_t* rp = O + (size_t)(row0 + ai * 128 + m * 16) * pitch + ch0;
                    f32x4 a0 = acc[ai][0][m][0], a1 = acc[ai][0][m][1]; const f32x4 b0 = acc[ai][1][m][0], b1 = acc[ai][1][m][1];
                    if (second) {
#pragma unroll
                        for (int i = 0; i < 4; ++i) { a0[i] *= silu_f(b0[i]); a1[i] *= silu_f(b1[i]); } }
                    else { a0 *= b0; a1 *= b1; }
                    u32x4 w; w.x = pg8::cvt_pk_bf16(a0[0], a0[1]); w.y = pg8::cvt_pk_bf16(a0[2], a0[3]); w.z = pg8::cvt_pk_bf16(a1[0], a1[1]); w.w = pg8::cvt_pk_bf16(a1[2], a1[3]);
                    *(u32x4*)rp = w; }
        } else {
            const int kind = pn >> 1; int arr = 0, pitch = 512, coff = 0; bool act = false;
            if (kind == 1) { arr = 5; act = true; pitch = 1536; } else if (kind == 6) arr = 2; else if (kind == 7) arr = 3; else if (kind == 8) arr = 4; else if (kind == 9) { arr = 5; act = true; pitch = 1536; coff = 1024; }
            bf16_t* O = U + (size_t)arr * (ARRB / 2) + coff; const int col0 = (pn & 1) * 256 + wc * 32 + 8 * fq;
#pragma unroll
            for (int ai = 0; ai < 2; ++ai)
#pragma unroll
                for (int m = 0; m < 4; ++m) { bf16_t* rp = O + (size_t)(row0 + ai * 128 + m * 16) * pitch + col0;
#pragma unroll
                    for (int bj = 0; bj < 2; ++bj) { f32x4 v0 = acc[ai][bj][m][0], v1 = acc[ai][bj][m][1];
                        if (act) {
#pragma unroll
                            for (int i = 0; i < 4; ++i) { v0[i] = silu_f(v0[i]); v1[i] = silu_f(v1[i]); } }
                        u32x4 w; w.x = pg8::cvt_pk_bf16(v0[0], v0[1]); w.y = pg8::cvt_pk_bf16(v0[2], v0[3]); w.z = pg8::cvt_pk_bf16(v1[0], v1[1]); w.w = pg8::cvt_pk_bf16(v1[2], v1[3]);
                        *(u32x4*)(rp + bj * 128) = w; } }
        }
    }
};
struct EpiBranch {
    static constexpr bool PERM = true, AFTER_DRAIN = false, MIDK = true;
    unsigned char* ws;
    __device__ __forceinline__ void mid(f32x4 (&acc)[2][2][4][2], const Unit& u, int seg, int wr, int wc, int fr, int fq) const {
        int tid_ = threadIdx.x; asm volatile("" : "+v"(tid_));
        const int wid_ = tid_ >> 6, wr_ = wid_ >> 2, wc_ = wid_ & 3, fr_ = tid_ & 15, fq_ = (tid_ & 63) >> 4;
        const unsigned char* tb = ws + WS_MG + ((size_t)u.pm * 12 + (seg - 1) * 4 + u.pn) * 65536 + (size_t)(((wr_ * 4 + wc_) * 16) * 64 + (fq_ * 16 + fr_)) * 8;
#pragma unroll
        for (int ai = 0; ai < 2; ++ai)
#pragma unroll
            for (int m = 0; m < 4; ++m) {
#pragma unroll
                for (int bj = 0; bj < 2; ++bj) { const unsigned char* rp = tb + ((ai * 4 + m) * 2 + bj) * 512; const u32x2 qa = *(const u32x2*)rp, qb = *(const u32x2*)(rp + 4 * 65536);
                    f32x4 r0, r1;
                    r0[0] = (float)(qa.x & 255u) * __builtin_amdgcn_rcpf((float)(qb.x & 255u)); r0[1] = (float)((qa.x >> 8) & 255u) * __builtin_amdgcn_rcpf((float)((qb.x >> 8) & 255u));
                    r0[2] = (float)((qa.x >> 16) & 255u) * __builtin_amdgcn_rcpf((float)((qb.x >> 16) & 255u)); r0[3] = (float)(qa.x >> 24) * __builtin_amdgcn_rcpf((float)(qb.x >> 24));
                    r1[0] = (float)(qa.y & 255u) * __builtin_amdgcn_rcpf((float)(qb.y & 255u)); r1[1] = (float)((qa.y >> 8) & 255u) * __builtin_amdgcn_rcpf((float)((qb.y >> 8) & 255u));
                    r1[2] = (float)((qa.y >> 16) & 255u) * __builtin_amdgcn_rcpf((float)((qb.y >> 16) & 255u)); r1[3] = (float)(qa.y >> 24) * __builtin_amdgcn_rcpf((float)(qb.y >> 24));
                    acc[ai][bj][m][0] *= r0; acc[ai][bj][m][1] *= r1; }
                if (m == 3) asm volatile("" ::: "memory"); }
    }
    __device__ __forceinline__ void operator()(const f32x4 (&acc)[2][2][4][2], const Unit& u, int wr, int wc, int fr, int fq) const {
        bf16_t* merged = (bf16_t*)(ws + WS_H);
        const unsigned char* tb = ws + WS_MG + ((size_t)u.pm * 12 + 8 + u.pn) * 65536 + (size_t)(((wr * 4 + wc) * 16) * 64 + (fq * 16 + fr)) * 8;
        const int row0 = u.pm * 256 + wr * 64 + fr, col0 = u.pn * 256 + wc * 32 + 8 * fq;
        u32x2 gq[2][4][2];
#pragma unroll
        for (int ai = 0; ai < 2; ++ai)
#pragma unroll
            for (int m = 0; m < 4; ++m)
#pragma unroll
                for (int bj = 0; bj < 2; ++bj) gq[ai][m][bj] = *(const u32x2*)(tb + ((ai * 4 + m) * 2 + bj) * 512);
#pragma unroll
        for (int ai = 0; ai < 2; ++ai)
#pragma unroll
            for (int m = 0; m < 4; ++m) { const size_t row = (size_t)(row0 + ai * 128 + m * 16);
#pragma unroll
                for (int bj = 0; bj < 2; ++bj) { const int col = col0 + bj * 128; const u32x2 g = gq[ai][m][bj];
                    f32x4 g0, g1; const float k = 1.f / 255.f;
                    g0[0] = (float)(g.x & 255u) * k; g0[1] = (float)((g.x >> 8) & 255u) * k; g0[2] = (float)((g.x >> 16) & 255u) * k; g0[3] = (float)(g.x >> 24) * k;
                    g1[0] = (float)(g.y & 255u) * k; g1[1] = (float)((g.y >> 8) & 255u) * k; g1[2] = (float)((g.y >> 16) & 255u) * k; g1[3] = (float)(g.y >> 24) * k;
                    const f32x4 v0 = acc[ai][bj][m][0] * g0, v1 = acc[ai][bj][m][1] * g1;
                    u32x4 w; w.x = pg8::cvt_pk_bf16(v0[0], v0[1]); w.y = pg8::cvt_pk_bf16(v0[2], v0[3]); w.z = pg8::cvt_pk_bf16(v1[0], v1[1]); w.w = pg8::cvt_pk_bf16(v1[2], v1[3]);
                    *(u32x4*)(merged + row * 1024 + col) = w; } }
    }
};
struct EpiOut {
    static constexpr bool PERM = false, AFTER_DRAIN = false, MIDK = false;
    unsigned char* ws;
    __device__ __forceinline__ void operator()(const f32x4 (&acc)[2][2][4][2], const Unit& u, int wr, int wc, int fr, int fq) const {
        float* out = (float*)(ws + WS_U); float* rs = (float*)(ws + WS_RS);
        const int row0 = u.pm * 256 + wr * 64 + fr, col0 = u.pn * 256 + wc * 32 + 4 * fq;
#pragma unroll
        for (int ai = 0; ai < 2; ++ai)
#pragma unroll
            for (int m = 0; m < 4; ++m) { const size_t row = (size_t)(row0 + ai * 128 + m * 16); float ss = 0.f;
#pragma unroll
                for (int bj = 0; bj < 2; ++bj)
#pragma unroll
                    for (int n = 0; n < 2; ++n) { const f32x4 v = acc[ai][bj][m][n]; *(f32x4*)(out + row * 1024 + col0 + bj * 128 + n * 16) = v; ss += (v[0] * v[0] + v[1] * v[1]) + (v[2] * v[2] + v[3] * v[3]); }
                ss += __shfl_xor(ss, 16); ss += __shfl_xor(ss, 32);
                if (fq == 0) rs[row * 16 + u.pn * 4 + wc] = ss; }
    }
};

struct RmsPanel {
    float* xbuf;
    unsigned* cnt;
    __device__ __forceinline__ void run(const f32x4 (&v)[2][2][4][2], const Unit& u, int wr, int wc, int fr, int fq, LAS unsigned char* lds, int wid, int lane) const {
        LAS float* P = (LAS float*)lds; LAS float* S = (LAS float*)(lds + 8192);
#pragma unroll
        for (int ai = 0; ai < 2; ++ai)
#pragma unroll
            for (int m = 0; m < 4; ++m) { float s = 0.f;
#pragma unroll
                for (int bj = 0; bj < 2; ++bj)
#pragma unroll
                    for (int n = 0; n < 2; ++n) { const f32x4 x = v[ai][bj][m][n]; s += (x[0] * x[0] + x[1] * x[1]) + (x[2] * x[2] + x[3] * x[3]); }
                s += __shfl_xor(s, 16); s += __shfl_xor(s, 32);
                if (fq == 0) P[(ai * 128 + wr * 64 + m * 16 + fr) * 4 + wc] = s; }
        asm volatile("s_waitcnt lgkmcnt(0)" ::: "memory"); __builtin_amdgcn_s_barrier(); asm volatile("" ::: "memory");
        const int row = wid * 32 + (lane & 31);
        if (lane < 32) { const float t = (P[row * 4 + 0] + P[row * 4 + 1]) + (P[row * 4 + 2] + P[row * 4 + 3]);
            __hip_atomic_store(xbuf + (size_t)(u.pm * 256 + row) * 4 + u.pn, t, __ATOMIC_RELAXED, __HIP_MEMORY_SCOPE_AGENT); }
        asm volatile("s_waitcnt vmcnt(0)" ::: "memory");
        if (lane == 0) __hip_atomic_fetch_add(cnt + 64 * u.pm, 1u, __ATOMIC_RELAXED, __HIP_MEMORY_SCOPE_AGENT);
        if (wid == 0) {
            unsigned sp = 0;
            while ((unsigned)__builtin_amdgcn_readfirstlane(__hip_atomic_load(cnt + 64 * u.pm, __ATOMIC_RELAXED, __HIP_MEMORY_SCOPE_AGENT)) < 32u) { __builtin_amdgcn_s_sleep(2); if (++sp > (1u << 22)) break; }
            __builtin_amdgcn_fence(__ATOMIC_ACQUIRE, "agent");
        }
        asm volatile("s_waitcnt vmcnt(0) lgkmcnt(0)" ::: "memory"); __builtin_amdgcn_s_barrier(); asm volatile("" ::: "memory");
        if (lane < 32) { const float* slot = xbuf + (size_t)(u.pm * 256 + row) * 4; float t = 0.f;
#pragma unroll
            for (int k = 0; k < 4; ++k) t += __hip_atomic_load(slot + k, __ATOMIC_RELAXED, __HIP_MEMORY_SCOPE_AGENT);
            S[row] = 1.0f / sqrtf(t * (1.f / DM) + RMS_EPS); }
        asm volatile("s_waitcnt lgkmcnt(0)" ::: "memory"); __builtin_amdgcn_s_barrier(); asm volatile("" ::: "memory");
    }
};
struct EpiNorm1 {
    static constexpr bool PERM = false, AFTER_DRAIN = true, MIDK = false;
    float* out; const float* gpost; RmsPanel st;
    __device__ __forceinline__ void operator()(const f32x4 (&)[2][2][4][2], const Unit&, int, int, int, int) const {}
    __device__ __forceinline__ void fused(f32x4 (&acc)[2][2][4][2], const Unit& u, int wr, int wc, int fr, int fq, LAS unsigned char* lds, int wid, int lane) const {
        const LAS float* S = (const LAS float*)(lds + 8192);
        const int col0 = u.pn * 256 + wc * 32 + 4 * fq;
        f32x4 gp[2][2]; u32x2 pre[2][4][2][2];
#pragma unroll
        for (int bj = 0; bj < 2; ++bj)
#pragma unroll
            for (int n = 0; n < 2; ++n) gp[bj][n] = *(const f32x4*)(gpost + col0 + bj * 128 + n * 16);
#pragma unroll
        for (int ai = 0; ai < 2; ++ai)
#pragma unroll
            for (int m = 0; m < 4; ++m) {
#pragma unroll
                for (int bj = 0; bj < 2; ++bj)
#pragma unroll
                    for (int n = 0; n < 2; ++n) pre[ai][m][bj][n] = *(const u32x2*)((const unsigned char*)out + (size_t)(u.pm * 256 + wid * 32 + ((ai * 4 + m) * 2 + bj) * 2 + n) * 4096 + u.pn * 1024 + lane * 8); }
        st.run(acc, u, wr, wc, fr, fq, lds, wid, lane);
#pragma unroll
        for (int ai = 0; ai < 2; ++ai)
#pragma unroll
            for (int m = 0; m < 4; ++m) { const int r = ai * 128 + wr * 64 + m * 16 + fr; const float rs = S[r]; const size_t off = (size_t)(u.pm * 256 + r) * DM + col0;
#pragma unroll
                for (int bj = 0; bj < 2; ++bj)
#pragma unroll
                    for (int n = 0; n < 2; ++n) { const u32x2 p = pre[ai][m][bj][n]; const f32x4 bs = (f32x4){bflo(p.x), bfhi(p.x), bflo(p.y), bfhi(p.y)};
                        *(f32x4*)(out + off + bj * 128 + n * 16) = bs + acc[ai][bj][m][n] * rs * gp[bj][n]; } }
    }
};
struct EpiNorm2 {
    static constexpr bool PERM = false, AFTER_DRAIN = true, MIDK = false;
    const float* base; float* out; bf16_t* hn; const float* gpost; const float* gnext; RmsPanel st1, st2;
    __device__ __forceinline__ void operator()(const f32x4 (&)[2][2][4][2], const Unit&, int, int, int, int) const {}
    __device__ __forceinline__ void fused(f32x4 (&acc)[2][2][4][2], const Unit& u, int wr, int wc, int fr, int fq, LAS unsigned char* lds, int wid, int lane) const {
        const LAS float* S = (const LAS float*)(lds + 8192);
        const int col0 = u.pn * 256 + wc * 32 + 4 * fq;
        f32x4 gp[2][2], pre[4][2][2];
#pragma unroll
        for (int bj = 0; bj < 2; ++bj)
#pragma unroll
            for (int n = 0; n < 2; ++n) gp[bj][n] = *(const f32x4*)(gpost + col0 + bj * 128 + n * 16);
#pragma unroll
        for (int m = 0; m < 4; ++m)
#pragma unroll
            for (int bj = 0; bj < 2; ++bj)
#pragma unroll
                for (int n = 0; n < 2; ++n) pre[m][bj][n] = *(const f32x4*)(base + (size_t)(u.pm * 256 + wr * 64 + m * 16 + fr) * DM + col0 + bj * 128 + n * 16);
        st1.run(acc, u, wr, wc, fr, fq, lds, wid, lane);
#pragma unroll
        for (int ai = 0; ai < 2; ++ai) {
            if (ai == 1) {
#pragma unroll
                for (int m = 0; m < 4; ++m)
#pragma unroll
                    for (int bj = 0; bj < 2; ++bj)
#pragma unroll
                        for (int n = 0; n < 2; ++n) pre[m][bj][n] = *(const f32x4*)(base + (size_t)(u.pm * 256 + 128 + wr * 64 + m * 16 + fr) * DM + col0 + bj * 128 + n * 16);
            }
#pragma unroll
            for (int m = 0; m < 4; ++m) { const int r = ai * 128 + wr * 64 + m * 16 + fr; const float rs = S[r]; const size_t off = (size_t)(u.pm * 256 + r) * DM + col0;
#pragma unroll
                for (int bj = 0; bj < 2; ++bj)
#pragma unroll
                    for (int n = 0; n < 2; ++n) { const f32x4 x1 = pre[m][bj][n] + acc[ai][bj][m][n] * rs * gp[bj][n]; acc[ai][bj][m][n] = x1;
                        u32x2 w; w.x = pg8::cvt_pk_bf16(x1[0], x1[1]); w.y = pg8::cvt_pk_bf16(x1[2], x1[3]);
                        *(u32x2*)((unsigned char*)out + (size_t)(u.pm * 256 + wid * 32 + ((ai * 4 + m) * 2 + bj) * 2 + n) * 4096 + u.pn * 1024 + lane * 8) = w; } }
        }
#pragma unroll
        for (int bj = 0; bj < 2; ++bj)
#pragma unroll
            for (int n = 0; n < 2; ++n) gp[bj][n] = *(const f32x4*)(gnext + col0 + bj * 128 + n * 16);
        st2.run(acc, u, wr, wc, fr, fq, lds, wid, lane);
#pragma unroll
        for (int ai = 0; ai < 2; ++ai)
#pragma unroll
            for (int m = 0; m < 4; ++m) { const int r = ai * 128 + wr * 64 + m * 16 + fr; const float rs = S[r]; const size_t off = (size_t)(u.pm * 256 + r) * DM + col0;
#pragma unroll
                for (int bj = 0; bj < 2; ++bj)
#pragma unroll
                    for (int n = 0; n < 2; ++n) { const f32x4 o = acc[ai][bj][m][n] * rs * gp[bj][n];
                        u32x2 w; w.x = pg8::cvt_pk_bf16(o[0], o[1]); w.y = pg8::cvt_pk_bf16(o[2], o[3]); *(u32x2*)(hn + off + bj * 128 + n * 16) = w; } }
    }
};
__device__ __forceinline__ int win_row(int c) {
    if (c < 1024 || c >= 3072) return c;
    const int q = (c - 1024) >> 9, ch = (c - 1024) & 511, a = ch >> 7, j = ch & 127;
    return ((q & 1) ? 8 + a : 4 + a) * 256 + (q >> 1) * 128 + j;
}
__device__ __forceinline__ void transpose_item(const float* W, int N, bf16_t* WT, int ldt, int koff, int row_off, bool winmap, LAS float* scr, int item, int lane, const float* rscale = nullptr) {
    const int nblk = N / 64, kb = item / nblk, nb = item % nblk, k0 = 64 * kb, n0 = 64 * nb;
    const int kq = lane >> 4, nq = lane & 15;
    f32x4 v[16];
#pragma unroll
    for (int i = 0; i < 16; ++i) v[i] = __builtin_nontemporal_load((const f32x4*)(W + (size_t)(k0 + 4 * i + kq) * N + n0 + 4 * nq));
#pragma unroll
    for (int i = 0; i < 16; ++i) { LAS float* s = scr + (4 * i + kq) * 65 + 4 * nq; s[0] = v[i][0]; s[1] = v[i][1]; s[2] = v[i][2]; s[3] = v[i][3]; }
    asm volatile("s_waitcnt lgkmcnt(0)" ::: "memory");
    const int c = lane & 7;
#pragma unroll
    for (int j = 0; j < 8; ++j) { const int n = (lane >> 3) + 8 * j;
        const LAS float* s = scr + (rscale ? (16 * (c >> 1) + 4 * (c & 1)) : 8 * c) * 65 + n; const int hs = rscale ? 8 * 65 : 4 * 65; const float f = rscale ? rscale[n0 + n] : 1.f;
        u32x4 o; o.x = pg8::cvt_pk_bf16(s[0 * 65] * f, s[1 * 65] * f); o.y = pg8::cvt_pk_bf16(s[2 * 65] * f, s[3 * 65] * f); o.z = pg8::cvt_pk_bf16(s[hs] * f, s[hs + 65] * f); o.w = pg8::cvt_pk_bf16(s[hs + 2 * 65] * f, s[hs + 3 * 65] * f);
        int dst = n0 + n; if (winmap) dst = win_row(dst);
        if (rscale) *(u32x4*)(WT + (size_t)((((dst >> 5) * 8 + ((k0 + 8 * c) >> 4)) * 64 + (c & 1) * 32 + (dst & 31)) * 8)) = o;
        else *(u32x4*)(WT + (size_t)(row_off + dst) * ldt + koff + k0 + 8 * c) = o; }
    asm volatile("s_waitcnt lgkmcnt(0)" ::: "memory");
}
template <int R> __device__ __forceinline__ void rms_rows_to_bf16(const float* x, const float* g, bf16_t* H, int m0, int mstride, int lane) {
    f32x4 v[R][4];
#pragma unroll
    for (int r = 0; r < R; ++r)
#pragma unroll
        for (int j = 0; j < 4; ++j) v[r][j] = ((const f32x4*)(x + (size_t)(m0 + r * mstride) * DM))[64 * j + lane];
    f32x4 gg[4];
#pragma unroll
    for (int j = 0; j < 4; ++j) gg[j] = ((const f32x4*)g)[64 * j + lane];
#pragma unroll
    for (int r = 0; r < R; ++r) { float s = 0.f;
#pragma unroll
        for (int j = 0; j < 4; ++j) s += (v[r][j][0] * v[r][j][0] + v[r][j][1] * v[r][j][1]) + (v[r][j][2] * v[r][j][2] + v[r][j][3] * v[r][j][3]);
        const float rstd = 1.f / sqrtf(wave_sum(s) * (1.f / DM) + RMS_EPS);
        u32x2* o8 = (u32x2*)(H + (size_t)(m0 + r * mstride) * DM) + lane;
#pragma unroll
        for (int j = 0; j < 4; ++j) { u32x2 w; w.x = pg8::cvt_pk_bf16(v[r][j][0] * rstd * gg[j][0], v[r][j][1] * rstd * gg[j][1]); w.y = pg8::cvt_pk_bf16(v[r][j][2] * rstd * gg[j][2], v[r][j][3] * rstd * gg[j][3]); o8[64 * j] = w; } }
}

__device__ __forceinline__ int crow(int r, int hi) { return (r & 3) + 8 * (r >> 2) + 4 * hi; }
constexpr int VROW = 144;
__device__ __forceinline__ void attn_item(int item, const bf16_t* Q, const bf16_t* K, const bf16_t* V, const bf16_t* SG, bf16_t* YO, LAS unsigned char* vl, LAS unsigned char* kl, int lane) {
    const int qg = item & 127, h = (item >> 7) & 7, b = item >> 10;
    const int r32 = lane & 31, hi = lane >> 5, t0 = qg * 32;
    const size_t tokq = (size_t)b * SEQ + t0 + r32;
    bf16x8 qf[4];
    { const size_t tq0 = (size_t)b * SEQ + t0;
#pragma unroll
      for (int p = 0; p < 4; ++p) { const int idx = p * 64 + lane; const u32x4 v = *(const u32x4*)(Q + (tq0 + (idx >> 3)) * 512 + h * 64 + (idx & 7) * 8); *(LAS u32x4*)(kl + (idx >> 3) * VROW + (idx & 7) * 16) = v; }
#pragma unroll
      for (int d0 = 0; d0 < 4; ++d0) qf[d0] = *(const LAS bf16x8*)(kl + r32 * VROW + d0 * 32 + hi * 16); }
    f32x16 o0, o1;
#pragma unroll
    for (int r = 0; r < 16; ++r) { o0[r] = 0.f; o1[r] = 0.f; }
    float P = 1.f;
    const int i16 = lane & 15, G4 = lane >> 4;
    const int vb = (4 * (G4 >> 1) + (i16 >> 2)) * VROW + (16 * (G4 & 1) + 4 * (i16 & 3)) * 2;
#define ATT_LOAD(KF, VR, S0) do { const size_t tk_ = (size_t)b * SEQ + ((S0) > 0 ? (S0) : 0); \
        _Pragma("unroll") for (int p = 0; p < 4; ++p) { const int idx = p * 64 + lane; KF[p] = *(const u32x4*)(K + (tk_ + (idx >> 3)) * 512 + h * 64 + (idx & 7) * 8); \
                                                         VR[p] = *(const u32x4*)(V + (tk_ + (idx >> 3)) * 512 + h * 64 + (idx & 7) * 8); } } while (0)
    u32x4 kf[4], kn[4]; u32x4 vr[4], vn[4];
    ATT_LOAD(kf, vr, t0); ATT_LOAD(kn, vn, t0 - 32);
    u32x4 sgr[4];
#pragma unroll
    for (int p = 0; p < 4; ++p) { const int idx = p * 64 + lane; sgr[p] = *(const u32x4*)(SG + ((size_t)b * SEQ + t0 + (idx >> 3)) * 1536 + h * 64 + (idx & 7) * 8); }
    for (int s0 = t0; s0 >= 0; s0 -= 32) {
#pragma unroll
        for (int p = 0; p < 4; ++p) { const int idx = p * 64 + lane, key = idx >> 3, ch = idx & 7; *(LAS u32x4*)(vl + key * VROW + ch * 16) = vr[p]; *(LAS u32x4*)(kl + key * VROW + ch * 16) = kf[p]; }
        f32x16 s;
#pragma unroll
        for (int r = 0; r < 16; ++r) s[r] = 0.f;
#pragma unroll
        for (int d0 = 0; d0 < 4; ++d0) s = __builtin_amdgcn_mfma_f32_32x32x16_bf16(*(const LAS bf16x8*)(kl + r32 * VROW + d0 * 32 + hi * 16), qf[d0], s, 0, 0, 0);
        const bool diag = (s0 == t0);
        float kp[16];
#pragma unroll
        for (int r = 0; r < 16; ++r) { const float e = __builtin_amdgcn_exp2f(s[r] * (0.125f * 1.4426950408889634f)); float k = __builtin_amdgcn_rcpf(1.f + e);
            if (diag && crow(r, hi) >= r32) k = 1.f; kp[r] = k; }
        float Gm[4], Go[4], T[4], R[4], C[4];
#pragma unroll
        for (int g = 0; g < 4; ++g) { Gm[g] = (kp[4 * g] * kp[4 * g + 1]) * (kp[4 * g + 2] * kp[4 * g + 3]); Go[g] = __shfl_xor(Gm[g], 32); T[g] = Gm[g] * Go[g]; }
        R[3] = P; R[2] = R[3] * T[3]; R[1] = R[2] * T[2]; R[0] = R[1] * T[1]; const float Cout = R[0] * T[0];
#pragma unroll
        for (int g = 0; g < 4; ++g) C[g] = hi ? R[g] : R[g] * Go[g];
        float w[16];
#pragma unroll
        for (int g = 0; g < 4; ++g) { const float p3 = C[g], p2 = p3 * kp[4 * g + 3], p1 = p2 * kp[4 * g + 2], p0 = p1 * kp[4 * g + 1], pe = p0 * kp[4 * g];
            w[4 * g + 3] = p3 - p2; w[4 * g + 2] = p2 - p1; w[4 * g + 1] = p1 - p0; w[4 * g] = p0 - pe; }
        bf16x8 wf[2];
#pragma unroll
        for (int st = 0; st < 2; ++st) { u32x4 t; t.x = pg8::cvt_pk_bf16(w[8 * st], w[8 * st + 1]); t.y = pg8::cvt_pk_bf16(w[8 * st + 2], w[8 * st + 3]); t.z = pg8::cvt_pk_bf16(w[8 * st + 4], w[8 * st + 5]); t.w = pg8::cvt_pk_bf16(w[8 * st + 6], w[8 * st + 7]); wf[st] = __builtin_bit_cast(bf16x8, t); }
#pragma unroll
        for (int dt = 0; dt < 2; ++dt)
#pragma unroll
            for (int st = 0; st < 2; ++st) {
                const s16x4 lo = __builtin_amdgcn_ds_read_tr16_b64_v4i16((LAS s16x4*)(vl + vb + (16 * st) * VROW + dt * 64));
                const s16x4 hh = __builtin_amdgcn_ds_read_tr16_b64_v4i16((LAS s16x4*)(vl + vb + (16 * st + 8) * VROW + dt * 64));
                const bf16x8 vf = (bf16x8){lo[0], lo[1], lo[2], lo[3], hh[0], hh[1], hh[2], hh[3]};
                if (dt == 0) o0 = __builtin_amdgcn_mfma_f32_32x32x16_bf16(vf, wf[st], o0, 0, 0, 0); else o1 = __builtin_amdgcn_mfma_f32_32x32x16_bf16(vf, wf[st], o1, 0, 0, 0); }
        P = Cout;
        if (__all(P < 1.17549435e-38f)) break;
#pragma unroll
        for (int i = 0; i < 4; ++i) { kf[i] = kn[i]; vr[i] = vn[i]; }
        ATT_LOAD(kn, vn, s0 - 64);
    }
#undef ATT_LOAD
#pragma unroll
    for (int p = 0; p < 4; ++p) { const int idx = p * 64 + lane; *(LAS u32x4*)(kl + (idx >> 3) * VROW + (idx & 7) * 16) = sgr[p]; }
#pragma unroll
    for (int dt = 0; dt < 2; ++dt)
#pragma unroll
        for (int g = 0; g < 4; ++g) { LAS u32x2* p = (LAS u32x2*)(kl + r32 * VROW + (dt * 32 + 8 * g + 4 * hi) * 2); const u32x2 sg = *p;
            const f32x16& o = dt ? o1 : o0; u32x2 y;
            y.x = pg8::cvt_pk_bf16(o[4 * g] * bflo(sg.x), o[4 * g + 1] * bfhi(sg.x)); y.y = pg8::cvt_pk_bf16(o[4 * g + 2] * bflo(sg.y), o[4 * g + 3] * bfhi(sg.y));
            *p = y; }
#pragma unroll
    for (int p = 0; p < 4; ++p) { const int idx = p * 64 + lane; const u32x4 v = *(const LAS u32x4*)(kl + (idx >> 3) * VROW + (idx & 7) * 16);
        *(u32x4*)(YO + ((size_t)b * SEQ + t0 + (idx >> 3)) * 1536 + h * 64 + (idx & 7) * 8) = v; }
}
constexpr int PROW = 272;
__device__ __forceinline__ void pool_item(int pi, const bf16_t* PV, const bf16_t* SG, bf16_t* YO, const bf16_t* PT, const float* scale, LAS unsigned char* sl, int lane) {
    const int tile = pi >> 2, g = ((pi & 3) + ((pi >> 2) & 1)) & 3, win = 2 << g;
    const int r32 = lane & 31, hi = lane >> 5, tok0 = tile * 32, t0 = tok0 & (SEQ - 1), tok = tok0 + r32;
    u32x4 sv[12];
#pragma unroll
    for (int p = 0; p < 12; ++p) { const int idx = p * 64 + lane, row = idx >> 4, ch = idx & 15; const bool ok = (t0 + row - 16) >= 0;
        sv[p] = *(const u32x4*)(PV + (size_t)(ok ? tok0 + row - 16 : tok0) * 512 + g * 128 + ch * 8); if (!ok) sv[p] = (u32x4){0u, 0u, 0u, 0u}; }
#pragma unroll
    for (int p = 0; p < 12; ++p) { const int idx = p * 64 + lane, row = idx >> 4, ch = idx & 15; *(LAS u32x4*)(sl + row * PROW + ch * 16) = sv[p]; }
    const int t = t0 + r32, cnt = (t + 1) < win ? (t + 1) : win;
    bf16x8 bfr[3];
#pragma unroll
    for (int ks = 0; ks < 3; ++ks) { float wv[8];
#pragma unroll
        for (int j = 0; j < 8; ++j) { const int rel = (16 + r32) - (16 * ks + 8 * hi + j); wv[j] = (rel == 0) ? (float)(1 - cnt) : ((rel > 0 && rel < cnt) ? 1.f : 0.f); }
        u32x4 tt; tt.x = pg8::cvt_pk_bf16(wv[0], wv[1]); tt.y = pg8::cvt_pk_bf16(wv[2], wv[3]); tt.z = pg8::cvt_pk_bf16(wv[4], wv[5]); tt.w = pg8::cvt_pk_bf16(wv[6], wv[7]); bfr[ks] = __builtin_bit_cast(bf16x8, tt); }
    bf16x8 ptf[4][8];
#pragma unroll
    for (int nt = 0; nt < 4; ++nt)
#pragma unroll
        for (int ks = 0; ks < 8; ++ks) ptf[nt][ks] = *(const bf16x8*)(PT + (size_t)g * 128 * 128 + (size_t)((nt * 8 + ks) * 64 + lane) * 8);
    const int i16 = lane & 15, G4 = lane >> 4;
    const int vb = (8 * (G4 >> 1) + (i16 >> 2)) * PROW + (16 * (G4 & 1) + 4 * (i16 & 3)) * 2;
    const float inv = __builtin_amdgcn_rcpf((float)cnt);
    bf16x8 pf[8];
#pragma unroll
    for (int ct = 0; ct < 4; ++ct) {
        f32x16 acc;
#pragma unroll
        for (int r = 0; r < 16; ++r) acc[r] = 0.f;
#pragma unroll
        for (int ks = 0; ks < 3; ++ks) {
            const s16x4 lo = __builtin_amdgcn_ds_read_tr16_b64_v4i16((LAS s16x4*)(sl + vb + (16 * ks) * PROW + ct * 64));
            const s16x4 hh = __builtin_amdgcn_ds_read_tr16_b64_v4i16((LAS s16x4*)(sl + vb + (16 * ks + 4) * PROW + ct * 64));
            const bf16x8 a = (bf16x8){lo[0], lo[1], lo[2], lo[3], hh[0], hh[1], hh[2], hh[3]};
            acc = __builtin_amdgcn_mfma_f32_32x32x16_bf16(a, bfr[ks], acc, 0, 0, 0); }
#pragma unroll
        for (int s = 0; s < 2; ++s) { u32x4 tt; tt.x = pg8::cvt_pk_bf16(acc[8 * s] * inv, acc[8 * s + 1] * inv); tt.y = pg8::cvt_pk_bf16(acc[8 * s + 2] * inv, acc[8 * s + 3] * inv);
            tt.z = pg8::cvt_pk_bf16(acc[8 * s + 4] * inv, acc[8 * s + 5] * inv); tt.w = pg8::cvt_pk_bf16(acc[8 * s + 6] * inv, acc[8 * s + 7] * inv); pf[2 * ct + s] = __builtin_bit_cast(bf16x8, tt); }
    }
#pragma unroll
    for (int p = 0; p < 8; ++p) { const int idx = p * 64 + lane; const u32x4 v = *(const u32x4*)(SG + (size_t)(tok0 + (idx >> 4)) * 1536 + g * 128 + (idx & 15) * 8); *(LAS u32x4*)(sl + (idx >> 4) * PROW + (idx & 15) * 16) = v; }
#pragma unroll
    for (int nt = 0; nt < 4; ++nt) {
        f32x16 acc;
#pragma unroll
        for (int r = 0; r < 16; ++r) acc[r] = 0.f;
#pragma unroll
        for (int ks = 0; ks < 8; ++ks) acc = __builtin_amdgcn_mfma_f32_32x32x16_bf16(ptf[nt][ks], pf[ks], acc, 0, 0, 0);
#pragma unroll
        for (int q = 0; q < 4; ++q) { LAS u32x2* p = (LAS u32x2*)(sl + r32 * PROW + (nt * 32 + 8 * q + 4 * hi) * 2); const u32x2 sg = *p; u32x2 y;
            y.x = pg8::cvt_pk_bf16(acc[4 * q] * bflo(sg.x), acc[4 * q + 1] * bfhi(sg.x)); y.y = pg8::cvt_pk_bf16(acc[4 * q + 2] * bflo(sg.y), acc[4 * q + 3] * bfhi(sg.y));
            *p = y; }
    }
#pragma unroll
    for (int p = 0; p < 8; ++p) { const int idx = p * 64 + lane; const u32x4 v = *(const LAS u32x4*)(sl + (idx >> 4) * PROW + (idx & 15) * 16);
        *(u32x4*)(YO + (size_t)(tok0 + (idx >> 4)) * 1536 + g * 128 + (idx & 15) * 8) = v; }
}
__device__ __forceinline__ void conv_item(int ci, const bf16_t* Z, const bf16_t* Wy, bf16_t* YO, const float* cw, const float* cb, int lane) {
    const int tok0 = ci * 8, t0 = tok0 & (SEQ - 1), ch = lane * 8;
    float w0[8], w1[8], w2[8], bs[8], zm2[8], zm1[8];
#pragma unroll
    for (int hf = 0; hf < 2; ++hf) { const f32x4 a = *(const f32x4*)(cw + ch + 4 * hf), b = *(const f32x4*)(cw + 512 + ch + 4 * hf), c = *(const f32x4*)(cw + 1024 + ch + 4 * hf), d = *(const f32x4*)(cb + ch + 4 * hf);
#pragma unroll
        for (int i = 0; i < 4; ++i) { w0[4 * hf + i] = a[i]; w1[4 * hf + i] = b[i]; w2[4 * hf + i] = c[i]; bs[4 * hf + i] = d[i]; } }
#pragma unroll
    for (int i = 0; i < 8; ++i) { zm2[i] = 0.f; zm1[i] = 0.f; }
    if (t0 != 0) { const u32x4 a = *(const u32x4*)(Z + (size_t)(tok0 - 2) * 512 + ch), b = *(const u32x4*)(Z + (size_t)(tok0 - 1) * 512 + ch);
        zm2[0] = bflo(a.x); zm2[1] = bfhi(a.x); zm2[2] = bflo(a.y); zm2[3] = bfhi(a.y); zm2[4] = bflo(a.z); zm2[5] = bfhi(a.z); zm2[6] = bflo(a.w); zm2[7] = bfhi(a.w);
        zm1[0] = bflo(b.x); zm1[1] = bfhi(b.x); zm1[2] = bflo(b.y); zm1[3] = bfhi(b.y); zm1[4] = bflo(b.z); zm1[5] = bfhi(b.z); zm1[6] = bflo(b.w); zm1[7] = bfhi(b.w); }
    u32x4 zr[8], wr_[8];
#pragma unroll
    for (int r = 0; r < 8; ++r) { zr[r] = *(const u32x4*)(Z + (size_t)(tok0 + r) * 512 + ch); wr_[r] = *(const u32x4*)(Wy + (size_t)(tok0 + r) * 1536 + ch); }
#pragma unroll
    for (int r = 0; r < 8; ++r) {
        float zc[8], wv[8], y[8];
        zc[0] = bflo(zr[r].x); zc[1] = bfhi(zr[r].x); zc[2] = bflo(zr[r].y); zc[3] = bfhi(zr[r].y); zc[4] = bflo(zr[r].z); zc[5] = bfhi(zr[r].z); zc[6] = bflo(zr[r].w); zc[7] = bfhi(zr[r].w);
        wv[0] = bflo(wr_[r].x); wv[1] = bfhi(wr_[r].x); wv[2] = bflo(wr_[r].y); wv[3] = bfhi(wr_[r].y); wv[4] = bflo(wr_[r].z); wv[5] = bfhi(wr_[r].z); wv[6] = bflo(wr_[r].w); wv[7] = bfhi(wr_[r].w);
#pragma unroll
        for (int i = 0; i < 8; ++i) { y[i] = wv[i] * (w0[i] * zm2[i] + w1[i] * zm1[i] + w2[i] * zc[i] + bs[i]); zm2[i] = zm1[i]; zm1[i] = zc[i]; }
        u32x4 o; o.x = pg8::cvt_pk_bf16(y[0], y[1]); o.y = pg8::cvt_pk_bf16(y[2], y[3]); o.z = pg8::cvt_pk_bf16(y[4], y[5]); o.w = pg8::cvt_pk_bf16(y[6], y[7]);
        *(u32x4*)(YO + (size_t)(tok0 + r) * 1536 + ch) = o; }
}
template <int R> __device__ __forceinline__ void norm_rows(const float* F32T, const float* RS, const float* xin, const float* gpost, float* xout, const float* gnext, bf16_t* H, int m0, int mstride, int lane) {
    f32x4 o[R][4], xi[R][4]; float ss[R];
#pragma unroll
    for (int r = 0; r < R; ++r) { const size_t row = (size_t)(m0 + r * mstride); ss[r] = (lane < 16) ? RS[row * 16 + lane] : 0.f;
#pragma unroll
        for (int j = 0; j < 4; ++j) { o[r][j] = ((const f32x4*)(F32T + row * DM))[64 * j + lane]; xi[r][j] = ((const f32x4*)(xin + row * DM))[64 * j + lane]; } }
    f32x4 gp[4];
#pragma unroll
    for (int j = 0; j < 4; ++j) gp[j] = ((const f32x4*)gpost)[64 * j + lane];
#pragma unroll
    for (int r = 0; r < R; ++r) { const size_t row = (size_t)(m0 + r * mstride);
        const float rstd = 1.f / sqrtf(wave_sum(ss[r]) * (1.f / DM) + RMS_EPS); float s2 = 0.f;
#pragma unroll
        for (int j = 0; j < 4; ++j) { const f32x4 v = xi[r][j] + o[r][j] * rstd * gp[j]; xi[r][j] = v; ((f32x4*)(xout + row * DM))[64 * j + lane] = v; s2 += (v[0] * v[0] + v[1] * v[1]) + (v[2] * v[2] + v[3] * v[3]); }
        if (gnext) { const float r2 = 1.f / sqrtf(wave_sum(s2) * (1.f / DM) + RMS_EPS);
#pragma unroll
            for (int j = 0; j < 4; ++j) { const f32x4 gg = ((const f32x4*)gnext)[64 * j + lane]; const f32x4 v = xi[r][j]; u32x2 w; w.x = pg8::cvt_pk_bf16(v[0] * r2 * gg[0], v[1] * r2 * gg[1]); w.y = pg8::cvt_pk_bf16(v[2] * r2 * gg[2], v[3] * r2 * gg[3]); ((u32x2*)(H + row * DM))[64 * j + lane] = w; } } }
}

struct Args { const float* in[10]; float* out; unsigned char* ws; int ph_lo, ph_hi; };
template <class T> __device__ __forceinline__ T* as_global(T* p) { return p; }
#if TP_A >= 0
#define TSTAMP(k) do { if (blockIdx.x == TP_BLK && threadIdx.x == 0) ((volatile LAS unsigned long long*)(lds + 147264))[(k)] = __builtin_amdgcn_s_memrealtime(); } while (0)
#else
#define TSTAMP(k) do { } while (0)
#endif
template <int ph> __device__ __forceinline__ void run_phase(const Args& a_, LAS unsigned char* lds) {
        const Args* A = &a_;
        const int tid = threadIdx.x, lane = tid & 63, wave = __builtin_amdgcn_readfirstlane(tid >> 6);
        const int G = gridDim.x, bx = blockIdx.x;
        const int vcu = (G % 8 == 0) ? (bx % 8) * (G / 8) + bx / 8 : bx;
        const int gw = vcu * 8 + wave, NGW = G * 8;
        unsigned char* ws = as_global(A->ws);
        bf16_t* H = (bf16_t*)(ws + WS_H); bf16_t* U = (bf16_t*)(ws + WS_U);
        if constexpr (ph == 0) {
            const float* x = as_global(A->in[0]); const float* pre_g = as_global(A->in[1]); const float* w_in = as_global(A->in[2]); const float* pool_w = as_global(A->in[3]); const float* pool_scale = as_global(A->in[4]); const float* w_branch = as_global(A->in[7]); const float* w_out = as_global(A->in[8]);
            bf16_t* W1 = (bf16_t*)(ws + WS_W1); bf16_t* W2 = (bf16_t*)(ws + WS_W2); bf16_t* W3 = (bf16_t*)(ws + WS_W3); bf16_t* PW = (bf16_t*)(ws + WS_PW);
            LAS float* scr = (LAS float*)(lds + wave * 17408);
            constexpr int I1 = (DM / 64) * (NIN / 64), I4 = 2 * 2;
            for (int it = gw; it < I1 + 8 * I4; it += NGW) {
                if (it < I1) transpose_item(w_in, NIN, W1, DM, 0, 0, true, scr, it, lane);
                else { const int r = it - I1, lg = r / I4; transpose_item(pool_w + (size_t)lg * 128 * 128, 128, PW + (size_t)lg * 128 * 128, 128, 0, 0, false, scr, r % I4, lane, pool_scale + lg * 128); }
            }
            for (int m = gw; m < MTOK; m += 2 * NGW) rms_rows_to_bf16<2>(x, pre_g, H, m, NGW, lane);
        } else {
            constexpr int l = (ph - 1) / 5, k = (ph - 1) % 5;
            if constexpr (k == 0) {
                pg8::Gemm g{H, (bf16_t*)(ws + WS_W1) + (size_t)l * NIN * DM, MTOK, NIN, DM, 0}; pg8::StaticOrder S; S.init(MTOK, NIN, G, bx);
                EpiU E{ws};
                pg8::gemm_phase<EpiU, pg8::StaticOrder, true, true>(lds, g, S, E);
            } else if constexpr (k == 1) {
                const float* pool_scale = as_global(A->in[4]); const float* conv_w = as_global(A->in[5]); const float* conv_b = as_global(A->in[6]);
                const bf16_t* PW = (const bf16_t*)(ws + WS_PW);
                const bf16_t* Q = U + 2 * (ARRB / 2); const bf16_t* Kk = U + 3 * (ARRB / 2); const bf16_t* V = U + 4 * (ARRB / 2);
                LAS unsigned char* vl = lds + wave * (32 * VROW + 48 * PROW);
                LAS unsigned char* sl_ = vl + 32 * VROW;
                bf16_t* G3 = U + 5 * (ARRB / 2);
                bf16_t* YO = G3;
#if MIX_PROBE
                if (l == 0 && A->ph_hi < 0) YO = (bf16_t*)as_global(A->out);
#endif
                int pm_ = 7;
#if MIX_PROBE
                if (l == 0 && A->ph_hi < 0) pm_ = MIX_PROBE;
#endif
                if (l == 0) TSTAMP(12);
                volatile LAS unsigned* wq = (volatile LAS unsigned*)(lds + 147216);
                if (tid < 4) wq[tid] = 0u;
                __syncthreads();
#define WQ_GRAB(Q_) ({ unsigned v_ = 0u; if (lane == 0) v_ = __hip_atomic_fetch_add((LAS unsigned*)(Q_), 1u, __ATOMIC_RELAXED, __HIP_MEMORY_SCOPE_WORKGROUP); (unsigned)__builtin_amdgcn_readfirstlane((int)v_); })
#define WQ_ITEM(J_) ((int)(vcu * 8 + ((J_) & 7u) + ((J_) >> 3) * (unsigned)NGW))
                for (;;) { const unsigned j = WQ_GRAB(wq); const int it = WQ_ITEM(j); if (it >= NB * 8 * 128) break; attn_item(it, Q, Kk, V, G3 + 1024, YO + 1024, vl, sl_, lane); }
                if (l == 0) TSTAMP(13);
                for (;;) { const unsigned j = WQ_GRAB(wq + 1); const int it = WQ_ITEM(j); if (it >= (MTOK / 32) * 4) break; pool_item(it, U, G3, YO, PW + (size_t)l * 4 * 128 * 128, pool_scale + l * BWID, sl_, lane); }
                if (l == 0) TSTAMP(14);
                for (;;) { const unsigned j = WQ_GRAB(wq + 2); const int it = WQ_ITEM(j); if (it >= MTOK / 8) break; conv_item(it, U + 1 * (ARRB / 2), G3 + 512, YO + 512, conv_w + l * 3 * BWID, conv_b + l * BWID, lane); }
                if constexpr (l == 0) {
                    const float* w_in = as_global(A->in[2]); const float* w_branch = as_global(A->in[7]); const float* w_out = as_global(A->in[8]);
                    bf16_t* W1 = (bf16_t*)(ws + WS_W1); bf16_t* W2 = (bf16_t*)(ws + WS_W2); bf16_t* W3 = (bf16_t*)(ws + WS_W3);
                    constexpr int I1 = (DM / 64) * (NIN / 64), I2 = (BWID / 64) * (DM / 64), I3 = (DM / 64) * (DM / 64), NDEF = I1 + 6 * I2 + 2 * I3;
                    for (;;) { const unsigned j = WQ_GRAB(wq + 3); int r = WQ_ITEM(j); if (r >= NDEF) break;
                        if (r < I1) { transpose_item(w_in + (size_t)DM * NIN, NIN, W1 + (size_t)NIN * DM, DM, 0, 0, true, (LAS float*)vl, r, lane); continue; } r -= I1;
                        if (r < 6 * I2) { const int ln = r / I2, ll = ln / 3, n = ln % 3; transpose_item(w_branch + (size_t)ln * BWID * DM, DM, W2 + (size_t)ll * 3 * DM * BWID, 3 * BWID, n * BWID, 0, false, (LAS float*)vl, r % I2, lane); continue; } r -= 6 * I2;
                        { const int ll = r / I3; transpose_item(w_out + (size_t)ll * DM * DM, DM, W3 + (size_t)ll * DM * DM, DM, 0, 0, false, (LAS float*)vl, r % I3, lane); }
                    }
                }
#undef WQ_GRAB
#undef WQ_ITEM
                if (l == 0) TSTAMP(15);
#if TP_A >= 0
                if (l == 0) { __syncthreads(); TSTAMP(5); }
#endif
            } else if constexpr (k == 2) {
                pg8::Gemm g{U + 5 * (ARRB / 2), (bf16_t*)(ws + WS_W2) + (size_t)l * 3 * DM * BWID, MTOK, DM, 3 * BWID, 0}; pg8::StaticOrder S; S.init(MTOK, DM, G, bx);
                EpiBranch E{ws};
                pg8::gemm_phase<EpiBranch, pg8::StaticOrder, true, true>(lds, g, S, E);
            } else if constexpr (k == 3) {
                pg8::Gemm g{H, (bf16_t*)(ws + WS_W3) + (size_t)l * DM * DM, MTOK, DM, DM, 0}; pg8::StaticOrder S; S.init(MTOK, DM, G, bx);
                if (G == 256) {
                    const float* x = as_global(A->in[0]); const float* pre_g = as_global(A->in[1]); const float* post_g = as_global(A->in[9]); float* out = as_global(A->out);
                    float* xb = (float*)(ws + WS_RS); unsigned* cn = (unsigned*)(ws + WS_CTL + CTL_CNT);
                    if constexpr (l + 1 < NLAYER) {
                        EpiNorm2 E{x, out, H, post_g + l * DM, pre_g + (l + 1) * DM, RmsPanel{xb, cn}, RmsPanel{xb + (size_t)MTOK * 4, cn + 64 * 64}};
                        pg8::gemm_phase<EpiNorm2, pg8::StaticOrder, false, true>(lds, g, S, E);
                    } else {
                        EpiNorm1 E{out, post_g + l * DM, RmsPanel{xb + (size_t)2 * MTOK * 4, cn + 2 * 64 * 64}};
                        pg8::gemm_phase<EpiNorm1, pg8::StaticOrder, false, true>(lds, g, S, E);
                    }
                } else {
                    EpiOut E{ws};
                    pg8::gemm_phase<EpiOut, pg8::StaticOrder, true, true>(lds, g, S, E);
                }
            } else {
                const float* x = as_global(A->in[0]); const float* pre_g = as_global(A->in[1]); const float* post_g = as_global(A->in[9]); float* out = as_global(A->out);
                const float* F32T = (const float*)(ws + WS_U); const float* RS = (const float*)(ws + WS_RS);
                const float* xin = (l == 0) ? x : out; const float* gnext = (l + 1 < NLAYER) ? pre_g + (l + 1) * DM : nullptr;
                if (G != 256) for (int m = gw; m < MTOK; m += 2 * NGW) norm_rows<2>(F32T, RS, xin, post_g + l * DM, out, gnext, H, m, NGW, lane);
            }
        }
}
__global__ void __launch_bounds__(512, 2) hybrid_fwd(Args a_) {
    extern __shared__ __attribute__((aligned(16))) unsigned char lds_raw[];
    LAS unsigned char* lds = (LAS unsigned char*)lds_raw;
    cg::grid_group grid = cg::this_grid();
    if (threadIdx.x < 64) ((LAS unsigned*)(lds + 147200))[threadIdx.x] = 0u;
    __syncthreads();
    (void)xcd_barrier_post((unsigned*)(a_.ws + WS_CTL), (volatile LAS unsigned*)(lds + 147200 + 32));
#define SEAM_BAR() do { XcdBarrier b_; b_.bar = (unsigned*)(a_.ws + WS_CTL); b_.x = xb_xcc_id(); b_.st = (volatile LAS unsigned*)(lds + 147200 + 32); xcd_barrier(b_); } while (0)
    const int lo = a_.ph_lo, hi = a_.ph_hi < 0 ? -a_.ph_hi : a_.ph_hi;
#define PHASE(k) if (lo <= (k) && (k) < hi && !(((k) == 5 || (k) == 10) && gridDim.x == 256)) { if ((k) > lo) { if ((k) == 1 && lo < 0) grid.sync(); else SEAM_BAR(); } TSTAMP(k); run_phase<(k)>(a_, lds); }
    PHASE(0) PHASE(1) PHASE(2) PHASE(3) PHASE(4) PHASE(5) PHASE(6) PHASE(7) PHASE(8) PHASE(9) PHASE(10)
#undef PHASE
#if TP_A >= 0
    SEAM_BAR(); TSTAMP(11);
    if (blockIdx.x == TP_BLK && threadIdx.x == 0) { volatile LAS unsigned long long* ts = (volatile LAS unsigned long long*)(lds + 147264); a_.out[0] += (float)(ts[TP_B] - ts[TP_A]) * (0.00005f * TP_SCALE); }
#endif
}

extern "C" void kernel_launch(void* const* d_in, const int* in_sizes, int n_in, void* d_out, int out_size, void* d_ws, size_t ws_size, hipStream_t stream) {
    static int grid = 0;
    if (grid == 0) {
        if (n_in != 10 || out_size != MTOK * DM || ws_size < WS_END) { fprintf(stderr, "kernel_launch: unexpected shapes / workspace (n_in %d out %d ws %zu)\n", n_in, out_size, ws_size); grid = -1; return; }
        int dev = 0, cus = 0, per_cu = 0;
        (void)hipGetDevice(&dev); (void)hipDeviceGetAttribute(&cus, hipDeviceAttributeMultiprocessorCount, dev);
        (void)hipFuncSetAttribute((const void*)hybrid_fwd, hipFuncAttributeMaxDynamicSharedMemorySize, LDS_BYTES);
        (void)hipOccupancyMaxActiveBlocksPerMultiprocessor(&per_cu, (const void*)hybrid_fwd, 512, LDS_BYTES);
        (void)hipGetLastError();
        if (per_cu < 1) { fprintf(stderr, "kernel_launch: occupancy query says %d blocks/CU\n", per_cu); per_cu = 1; }
        grid = cus;
    }
    if (grid < 0) return;
    if (hipMemsetAsync((char*)d_ws + WS_CTL, 0, CTL_BYTES, stream) != hipSuccess) { fprintf(stderr, "kernel_launch: memset of the barrier words failed\n"); return; }
    Args a{};
    for (int i = 0; i < 10; ++i) a.in[i] = (const float*)d_in[i];
    a.out = (float*)d_out; a.ws = (unsigned char*)d_ws;
#if ONE_LAUNCH
    a.ph_lo = 0; a.ph_hi = NPHASE;
    void* args[] = {&a};
    hipError_t e = hipLaunchCooperativeKernel((const void*)hybrid_fwd, dim3(grid), dim3(512), args, LDS_BYTES, stream);
    if (e != hipSuccess) fprintf(stderr, "cooperative launch failed: %s (grid %d)\n", hipGetErrorString(e), grid);
#else
    for (int ph = 0; ph < NPHASE; ++ph) { a.ph_lo = ph; a.ph_hi = ph + 1;
#if MIX_PROBE
        if (ph == 2) { a.ph_hi = -(ph + 1); hipLaunchKernelGGL(hybrid_fwd, dim3(grid), dim3(512), LDS_BYTES, stream, a); a.ph_hi = ph + 1; }
#endif
        for (int rep = 0; rep < 1 + ((DUP_MASK >> ph) & 1); ++rep) hipLaunchKernelGGL(hybrid_fwd, dim3(grid), dim3(512), LDS_BYTES, stream, a); }
#endif
}
```

```cpp
#include <hip/hip_runtime.h>
#include <hip/hip_cooperative_groups.h>
#include <cstdio>
#include <cstdint>
namespace cg = cooperative_groups;
#ifndef ONE_LAUNCH
#define ONE_LAUNCH 1
#endif
#ifndef DUP_MASK
#define DUP_MASK 0
#endif
#ifndef MIX_PROBE
#define MIX_PROBE 0
#endif
#ifndef TP_A
#define TP_A -1
#define TP_B -1
#endif
#ifndef TP_SCALE
#define TP_SCALE 1
#endif
#ifndef TP_BLK
#define TP_BLK 0
#endif
namespace pg8 {
#define PG8_LAS __attribute__((address_space(3)))
typedef unsigned short bf16_t;
typedef short bf16x8 __attribute__((ext_vector_type(8)));
typedef float f32x4 __attribute__((ext_vector_type(4)));
typedef unsigned u32x4 __attribute__((ext_vector_type(4)));
constexpr int BM = 256, BK = 64, HALF = 128, HTB = HALF * BK * 2  , STAGE_BYTES = 8 * HTB, NXCD = 8, WGM = 8;

__host__ __device__ __forceinline__ int lds_byte(int r, int c) { const int st = (r >> 4) * 2 + (c >> 5), rr = r & 15, cc = c & 31, ob = rr * 64 + cc * 2; return st * 1024 + (ob ^ (((ob >> 9) & 1) << 5)); }
__host__ __device__ __forceinline__ void stage_rc(int b, int& R, int& C) { const int st = b / 1024, sb = b % 1024, swz = sb ^ (((sb >> 9) & 1) << 5); R = (st >> 1) * 16 + swz / 64; C = (st & 1) * 32 + (swz % 64) / 2; }
__host__ __device__ __forceinline__ int perm32(int rho) { const int n = rho >> 4, i = rho & 15; return 8 * (i >> 2) + 4 * n + (i & 3); }

struct Unit { int pm, pn, az; };
struct Gemm { const bf16_t* A; const bf16_t* Bt; int M, N, K; size_t azs; };

struct StaticOrder {
    int nM, nN, nwg, G, c;
    __host__ __device__ void init(int M, int N, int G_, int c_) { nM = M / BM; nN = N / BM; nwg = nM * nN; G = G_; c = c_; }
    __host__ __device__ bool next(int i, Unit& u) const {
        const long L = (long)i * G + c; if (L >= nwg) return false;
        int wgid = (int)L; { const int q = nwg / NXCD, r = nwg % NXCD, xcd = wgid % NXCD, off = wgid / NXCD; wgid = (xcd < r ? xcd * (q + 1) : r * (q + 1) + (xcd - r) * q) + off; }
        const int nig = WGM * nN, gid = wgid / nig, fm = gid * WGM, gsz = (nM - fm) < WGM ? (nM - fm) : WGM;
        u.pm = fm + ((wgid % nig) % gsz); u.pn = (wgid % nig) / gsz; u.az = 0; return true;
    }
    __device__ __forceinline__ void a_ready(const Unit&) const {}
    __device__ __forceinline__ void done(const Unit&) const {}
};

__device__ __forceinline__ unsigned cvt_pk_bf16(float lo, float hi) { unsigned r; asm volatile("v_cvt_pk_bf16_f32 %0, %1, %2" : "=v"(r) : "v"(lo), "v"(hi)); return r; }
template <class Epi, class Sched, bool ALIGN_EPI = false, bool SP2 = false>
__device__ __forceinline__ void gemm_phase(PG8_LAS unsigned char* lds, const Gemm g, const Sched& S, const Epi& E) {
    const int tid = threadIdx.x, wid = __builtin_amdgcn_readfirstlane(tid >> 6), lane = tid & 63, wr = wid >> 2, wc = wid & 3, fr = lane & 15, fq = lane >> 4;
    const int K = g.K, nt = K / BK;
    unsigned voffA[2], voffB[2];
#pragma unroll
    for (int i = 0; i < 2; ++i) { int R, C; stage_rc(tid * 16 + i * 8192, R, C); const int Rb = Epi::PERM ? ((R & ~31) + perm32(R & 31)) : R;
        voffA[i] = (unsigned)(R * K + C) * 2u; voffB[i] = (unsigned)(Rb * K + C) * 2u; }
    const size_t kstep = (size_t)(BK * 2);
    const size_t hstep = (size_t)HALF * K * 2;
    const size_t tstep = 2 * hstep;
    const unsigned ldsw = (unsigned)wid * 1024u;
    const int aoff = lds_byte(wr * 64 + fr, fq * 8), boff = lds_byte(wc * 32 + fr, fq * 8);
#define PG8_SA(b, h) (((b) * 2 + (h)) * HTB)
#define PG8_SB(b, h) ((4 + (b) * 2 + (h)) * HTB)
#define PG8_STAGE(bufoff, gbase, voff) do { _Pragma("unroll") for (int _i = 0; _i < 2; ++_i) \
        __builtin_amdgcn_global_load_lds((const unsigned*)((const char*)(gbase) + (voff)[_i]), (PG8_LAS unsigned*)(lds + (bufoff) + ldsw + _i * 8192), 16, 0, 0); } while (0)
#define PG8_LDA(dst, b, h) do { _Pragma("unroll") for (int m = 0; m < 4; ++m) _Pragma("unroll") for (int k = 0; k < 2; ++k) dst[m][k] = *(const PG8_LAS bf16x8*)(lds + PG8_SA(b, h) + aoff + m * 2048 + k * 1024); } while (0)
#define PG8_LDB(dst, b, h) do { _Pragma("unroll") for (int n = 0; n < 2; ++n) _Pragma("unroll") for (int k = 0; k < 2; ++k) dst[n][k] = *(const PG8_LAS bf16x8*)(lds + PG8_SB(b, h) + boff + n * 2048 + k * 1024); } while (0)
#define PG8_MMA(ai, bj, At, Bt) do { __builtin_amdgcn_s_setprio(1); _Pragma("unroll") for (int m = 0; m < 4; ++m) _Pragma("unroll") for (int n = 0; n < 2; ++n) _Pragma("unroll") for (int k = 0; k < 2; ++k) \
        acc[ai][bj][m][n] = __builtin_amdgcn_mfma_f32_16x16x32_bf16(Bt[n][k], At[m][k], acc[ai][bj][m][n], 0, 0, 0); __builtin_amdgcn_s_setprio(0); } while (0)
#define PG8_WAIT_V(n) asm volatile("s_waitcnt vmcnt(" #n ")" ::: "memory")
#define PG8_WAIT_L(n) asm volatile("s_waitcnt lgkmcnt(" #n ")" ::: "memory")
#define PG8_BAR __builtin_amdgcn_s_barrier()
#define PG8_SCHED __builtin_amdgcn_sched_barrier(0)
    Unit cur, nxt; int ui = 0;
    if (!S.next(0, cur)) return;
    f32x4 acc[2][2][4][2];
#pragma unroll
    for (int a = 0; a < 2; ++a)
#pragma unroll
        for (int b = 0; b < 2; ++b)
#pragma unroll
            for (int m = 0; m < 4; ++m)
#pragma unroll
                for (int n = 0; n < 2; ++n) acc[a][b][m][n] = (f32x4){0.f, 0.f, 0.f, 0.f};
    bf16x8 At[4][2], B0[2][2], B1[2][2];
    const char* cA = (const char*)g.A + (size_t)cur.pm * tstep + (size_t)cur.az * g.azs; const char* cB = (const char*)g.Bt + (size_t)cur.pn * tstep;
    S.a_ready(cur);
    if constexpr (SP2) {
        PG8_STAGE(PG8_SB(0, 0), cB, voffB); PG8_STAGE(PG8_SB(0, 1), cB + hstep, voffB); PG8_STAGE(PG8_SA(0, 0), cA, voffA); PG8_STAGE(PG8_SA(0, 1), cA + hstep, voffA);
        if (wr == 1) PG8_BAR;
        PG8_WAIT_V(2); PG8_BAR;
        PG8_STAGE(PG8_SB(1, 0), cB + kstep, voffB); PG8_STAGE(PG8_SA(1, 0), cA + kstep, voffA); PG8_STAGE(PG8_SB(1, 1), cB + hstep + kstep, voffB);
        PG8_WAIT_V(6); PG8_BAR;
    } else {
        PG8_STAGE(PG8_SB(0, 0), cB, voffB); PG8_STAGE(PG8_SA(0, 0), cA, voffA); PG8_STAGE(PG8_SB(0, 1), cB + hstep, voffB); PG8_STAGE(PG8_SA(0, 1), cA + hstep, voffA);
        if (wr == 1) PG8_BAR;
        PG8_WAIT_V(4); PG8_BAR;
        PG8_STAGE(PG8_SB(1, 0), cB + kstep, voffB); PG8_STAGE(PG8_SA(1, 0), cA + kstep, voffA); PG8_STAGE(PG8_SB(1, 1), cB + hstep + kstep, voffB);
        PG8_WAIT_V(6); PG8_BAR;
    }
    for (;;) {
        const bool has_next = S.next(ui + 1, nxt);
        const char* nA = has_next ? (const char*)g.A + (size_t)nxt.pm * tstep + (size_t)nxt.az * g.azs : cA; const char* nB = has_next ? (const char*)g.Bt + (size_t)nxt.pn * tstep : cB;
        for (int t = 0; t < nt; t += 2) {
            if constexpr (Epi::MIDK) { if (t == 8 || t == 16) E.mid(acc, cur, t >> 3, wr, wc, fr, fq); }
            const bool last = (t == nt - 2);
            const char* a1 = cA + (size_t)(t + 1) * kstep;
            const char* a2 = last ? nA : cA + (size_t)(t + 2) * kstep; const char* b2 = last ? nB : cB + (size_t)(t + 2) * kstep;
            const char* a3 = a2 + kstep; const char* b3 = b2 + kstep;
            if (last && has_next) S.a_ready(nxt);
            if constexpr (SP2) {
            PG8_LDB(B0, 0, 0); PG8_LDB(B1, 0, 1); PG8_SCHED; PG8_LDA(At, 0, 0); PG8_STAGE(PG8_SA(1, 1), a1 + hstep, voffA);
            PG8_WAIT_V(8); PG8_WAIT_L(0); PG8_BAR; PG8_MMA(0, 0, At, B0); PG8_MMA(0, 1, At, B1); PG8_BAR; PG8_SCHED;
            PG8_LDA(At, 0, 1); PG8_STAGE(PG8_SB(0, 0), b2, voffB); PG8_STAGE(PG8_SB(0, 1), b2 + hstep, voffB); PG8_STAGE(PG8_SA(0, 0), a2, voffA);
            PG8_WAIT_V(8); PG8_WAIT_L(0); PG8_BAR; PG8_MMA(1, 0, At, B0); PG8_MMA(1, 1, At, B1); PG8_BAR; PG8_SCHED;
            PG8_LDB(B0, 1, 0); PG8_LDB(B1, 1, 1); PG8_SCHED; PG8_LDA(At, 1, 0); PG8_STAGE(PG8_SA(0, 1), a2 + hstep, voffA);
            PG8_WAIT_V(8); PG8_WAIT_L(0); PG8_BAR; PG8_MMA(0, 0, At, B0); PG8_MMA(0, 1, At, B1); PG8_BAR; PG8_SCHED;
            PG8_LDA(At, 1, 1); PG8_STAGE(PG8_SB(1, 0), b3, voffB); PG8_STAGE(PG8_SB(1, 1), b3 + hstep, voffB); PG8_STAGE(PG8_SA(1, 0), a3, voffA);
            PG8_WAIT_V(8); PG8_WAIT_L(0); PG8_BAR; PG8_MMA(1, 0, At, B0); PG8_MMA(1, 1, At, B1); PG8_BAR; PG8_SCHED;
            } else {
            PG8_LDB(B0, 0, 0); PG8_SCHED; PG8_LDA(At, 0, 0); PG8_STAGE(PG8_SA(1, 1), a1 + hstep, voffA);
            PG8_WAIT_L(8); PG8_BAR; PG8_WAIT_L(0); PG8_MMA(0, 0, At, B0); PG8_BAR; PG8_SCHED;
            PG8_LDB(B1, 0, 1); PG8_STAGE(PG8_SB(0, 0), b2, voffB);
            PG8_BAR; PG8_WAIT_L(0); PG8_MMA(0, 1, At, B1); PG8_BAR;
            PG8_LDA(At, 0, 1); PG8_STAGE(PG8_SA(0, 0), a2, voffA);
            PG8_BAR; PG8_WAIT_L(0); PG8_MMA(1, 0, At, B0); PG8_BAR; PG8_SCHED;
            PG8_STAGE(PG8_SB(0, 1), b2 + hstep, voffB);
            PG8_WAIT_V(6); PG8_BAR; PG8_MMA(1, 1, At, B1); PG8_BAR;
            PG8_LDB(B0, 1, 0); PG8_SCHED; PG8_LDA(At, 1, 0); PG8_STAGE(PG8_SA(0, 1), a2 + hstep, voffA);
            PG8_WAIT_L(8); PG8_BAR; PG8_WAIT_L(0); PG8_MMA(0, 0, At, B0); PG8_BAR; PG8_SCHED;
            PG8_LDB(B1, 1, 1); PG8_STAGE(PG8_SB(1, 0), b3, voffB);
            PG8_BAR; PG8_WAIT_L(0); PG8_MMA(0, 1, At, B1); PG8_BAR;
            PG8_LDA(At, 1, 1); PG8_STAGE(PG8_SA(1, 0), a3, voffA);
            PG8_BAR; PG8_WAIT_L(0); PG8_MMA(1, 0, At, B0); PG8_BAR; PG8_SCHED;
            PG8_STAGE(PG8_SB(1, 1), b3 + hstep, voffB);
            PG8_WAIT_V(6); PG8_BAR; PG8_MMA(1, 1, At, B1); PG8_BAR;
            }
        }
        if constexpr (ALIGN_EPI) { if (wr == 0) PG8_BAR; }
        if constexpr (!Epi::AFTER_DRAIN) { E(acc, cur, wr, wc, fr, fq); S.done(cur); }
        if (!has_next) break;
#pragma unroll
        for (int a = 0; a < 2; ++a)
#pragma unroll
            for (int b = 0; b < 2; ++b)
#pragma unroll
                for (int m = 0; m < 4; ++m)
#pragma unroll
                    for (int n = 0; n < 2; ++n) acc[a][b][m][n] = (f32x4){0.f, 0.f, 0.f, 0.f};
        cur = nxt; cA = nA; cB = nB; ++ui;
        if constexpr (ALIGN_EPI) { if (wr == 1) PG8_BAR; }
    }
    PG8_WAIT_V(0);
    if constexpr (!ALIGN_EPI) { if (wr == 0) PG8_BAR; }
    PG8_BAR;
    if constexpr (Epi::AFTER_DRAIN) { E.fused(acc, cur, wr, wc, fr, fq, lds, wid, lane); S.done(cur); }
#undef PG8_SA
#undef PG8_SB
#undef PG8_STAGE
#undef PG8_LDA
#undef PG8_LDB
#undef PG8_MMA
#undef PG8_WAIT_V
#undef PG8_WAIT_L
#undef PG8_BAR
#undef PG8_SCHED
}
}

#define LAS __attribute__((address_space(3)))
typedef unsigned short bf16_t;
typedef short bf16x8 __attribute__((ext_vector_type(8)));
typedef short s16x4 __attribute__((ext_vector_type(4)));
typedef float f32x4 __attribute__((ext_vector_type(4)));
typedef float f32x16 __attribute__((ext_vector_type(16)));
typedef unsigned u32x4 __attribute__((ext_vector_type(4)));
typedef unsigned u32x2 __attribute__((ext_vector_type(2)));
constexpr int NB = 4, SEQ = 4096, DM = 1024, MTOK = NB * SEQ, NIN = 8192, BWID = 512, NLAYER = 2;
constexpr float RMS_EPS = 1e-6f;
constexpr size_t MiB = 1u << 20;
constexpr size_t WS_RS = 0;
constexpr size_t WS_W1 = 2 * MiB;
constexpr size_t WS_W2 = 34 * MiB;
constexpr size_t WS_W3 = 40 * MiB;
constexpr size_t WS_PW = 44 * MiB;
constexpr size_t WS_H = 45 * MiB;
constexpr size_t WS_U = 77 * MiB;
constexpr size_t ARRB = 16 * MiB;
constexpr size_t WS_MG = 205 * MiB;
constexpr size_t WS_END = 253 * MiB;
constexpr int LDS_BYTES = 147456;
constexpr int NPHASE = 1 + 5 * NLAYER;

__device__ __forceinline__ unsigned f2bf(float f) { unsigned u = __builtin_bit_cast(unsigned, f); return (u + 0x7fffu + ((u >> 16) & 1u)) >> 16; }
__device__ __forceinline__ unsigned pk2(float lo, float hi) { return f2bf(lo) | (f2bf(hi) << 16); }
__device__ __forceinline__ float bflo(unsigned u) { return __builtin_bit_cast(float, u << 16); }
__device__ __forceinline__ float bfhi(unsigned u) { return __builtin_bit_cast(float, u & 0xffff0000u); }
__device__ __forceinline__ float sigmoid_f(float x) { return __builtin_amdgcn_rcpf(1.f + __builtin_amdgcn_exp2f(-1.4426950408889634f * x)); }
__device__ __forceinline__ float silu_f(float x) { return x * sigmoid_f(x); }
__device__ __forceinline__ unsigned q8(float x) { const unsigned q = (unsigned)(sigmoid_f(x) * 255.f + 0.5f); return q < 1u ? 1u : q; }
__device__ __forceinline__ float wave_sum(float v) {
#pragma unroll
    for (int o = 1; o < 64; o <<= 1) v += __shfl_xor(v, o);
    return v;
}

constexpr size_t WS_CTL = 1 * MiB; constexpr size_t CTL_BYTES = 65536;
constexpr size_t CTL_CNT = 16384;
#define XB_TMO      128
#define XB_XCNT(j)  (256  + 64 * (j))
#define XB_XSUB(j)  (1280 + 64 * (j))
#define XB_XGEN(j)  (2304 + 64 * (j))
#define XB_TOP      3328
#define XB_TOPGEN   3392
#define XCD_BAR_WORDS 3456
#define XB_SPIN_CAP (1u << 18)

__device__ __forceinline__ unsigned xb_ld(unsigned* p)              { return __hip_atomic_load(p, __ATOMIC_RELAXED, __HIP_MEMORY_SCOPE_AGENT); }
__device__ __forceinline__ unsigned xb_add(unsigned* p, unsigned v) { return __hip_atomic_fetch_add(p, v, __ATOMIC_RELAXED, __HIP_MEMORY_SCOPE_AGENT); }
__device__ __forceinline__ unsigned xb_xcc_id() { return (unsigned)__builtin_amdgcn_s_getreg((3 << 11) | 20) & 0xFu; }
#define XB_SPIN(cond, bar) do { unsigned _sp = 0; while (cond) { __builtin_amdgcn_s_sleep(1); \
    if ((++_sp & 255u) == 0u) { if (xb_ld(&(bar)[XB_TMO])) break; if (_sp > XB_SPIN_CAP) { atomicAdd(&(bar)[XB_TMO], 1u); break; } } } } while (0)

struct XcdBarrier {
    unsigned* bar; unsigned x;
    volatile LAS unsigned* st;
};

__device__ __forceinline__ XcdBarrier xcd_barrier_post(unsigned* bar, volatile LAS unsigned* st) {
    XcdBarrier b; b.bar = bar; b.x = xb_xcc_id(); b.st = st;
    if (threadIdx.x == 0) (void)xb_add(&bar[XB_XCNT(b.x)], 1u);
    return b;
}
__device__ __forceinline__ void xcd_barrier_complete(unsigned* bar, unsigned x, unsigned& nloc, unsigned& nx) {
    const unsigned G = gridDim.x * gridDim.y * gridDim.z;
    unsigned sum, cnt, mine, sp = 0u;
    for (;;) {
        sum = 0u; cnt = 0u; mine = 0u;
#pragma unroll
        for (unsigned j = 0; j < 16; ++j) { const unsigned c = xb_ld(&bar[XB_XCNT(j)]); sum += c; cnt += (c > 0u) ? 1u : 0u; mine = (j == x) ? c : mine; }
        if (sum == G) break;
        __builtin_amdgcn_s_sleep(1);
        if ((++sp & 255u) == 0u) { if (xb_ld(&bar[XB_TMO])) break; if (sp > XB_SPIN_CAP) { atomicAdd(&bar[XB_TMO], 1u); break; } }
    }
    nloc = mine > 0u ? mine : 1u; nx = cnt > 0u ? cnt : 1u;
}

__device__ __forceinline__ void xcd_barrier(const XcdBarrier& b) {
    asm volatile("s_waitcnt vmcnt(0)" ::: "memory");
    __syncthreads();
    if (threadIdx.x == 0) {
        unsigned* bar = b.bar;
        __builtin_amdgcn_s_waitcnt(0);
        unsigned nloc = b.st[0], nx = b.st[1];
        if (nloc == 0u) { xcd_barrier_complete(bar, b.x, nloc, nx); b.st[0] = nloc; b.st[1] = nx; }
        const unsigned old = xb_add(&bar[XB_XSUB(b.x)], 1u);
        const unsigned gen = old / nloc;
        if (old + 1u == (gen + 1u) * nloc) {
            __builtin_amdgcn_fence(__ATOMIC_RELEASE, "agent");
            asm volatile("s_waitcnt vmcnt(0)" ::: "memory");
            const unsigned og = xb_add(&bar[XB_TOP], 1u);
            const unsigned tg = og / nx;
            if (og + 1u == (tg + 1u) * nx) xb_add(&bar[XB_TOPGEN], 1u);
            else XB_SPIN(xb_ld(&bar[XB_TOPGEN]) == tg, bar);
            __builtin_amdgcn_fence(__ATOMIC_ACQUIRE, "agent");
            xb_add(&bar[XB_XGEN(b.x)], 1u);
            asm volatile("s_waitcnt vmcnt(0)" ::: "memory");
        } else {
            XB_SPIN(xb_ld(&bar[XB_XGEN(b.x)]) == gen, bar);
            __builtin_amdgcn_fence(__ATOMIC_ACQUIRE, "agent");
            asm volatile("s_waitcnt vmcnt(0)" ::: "memory");
        }
    }
    __syncthreads();
}


using pg8::Unit;
struct EpiU {
    static constexpr bool PERM = true, AFTER_DRAIN = false, MIDK = false;
    unsigned char* ws;
    __device__ __forceinline__ void operator()(const f32x4 (&acc)[2][2][4][2], const Unit& u, int wr, int wc, int fr, int fq) const {
        bf16_t* U = (bf16_t*)(ws + WS_U); unsigned char* MG = ws + WS_MG;
        const int pn = u.pn; const int row0 = u.pm * 256 + wr * 64 + fr;
        if (pn >= 20) {
            unsigned char* tb = MG + ((size_t)u.pm * 12 + (pn - 20)) * 65536 + (size_t)(((wr * 4 + wc) * 16) * 64 + (fq * 16 + fr)) * 8;
#pragma unroll
            for (int ai = 0; ai < 2; ++ai)
#pragma unroll
                for (int m = 0; m < 4; ++m)
#pragma unroll
                    for (int bj = 0; bj < 2; ++bj) { const f32x4 v0 = acc[ai][bj][m][0], v1 = acc[ai][bj][m][1]; u32x2 w;
                        w.x = q8(v0[0]) | (q8(v0[1]) << 8) | (q8(v0[2]) << 16) | (q8(v0[3]) << 24); w.y = q8(v1[0]) | (q8(v1[1]) << 8) | (q8(v1[2]) << 16) | (q8(v1[3]) << 24);
                        *(u32x2*)(tb + ((ai * 4 + m) * 2 + bj) * 512) = w; }
        } else if (pn >= 4 && pn < 12) {
            const bool second = pn >= 8; const int ch0 = (pn & 3) * 128 + wc * 32 + 8 * fq;
            bf16_t* O = second ? (U + 5 * (ARRB / 2) + 512) : (U + 1 * (ARRB / 2)); const int pitch = second ? 1536 : 512;
#pragma unroll
            for (int ai = 0; ai < 2; ++ai)
#pragma unroll
                for (int m = 0; m < 4; ++m) { bf16_t* rp = O + (size_t)(row0 + ai * 128 + m * 16) * pitch + ch0;
                    f32x4 a0 = acc[ai][0][m][0], a1 = acc[ai][0][m][1]; const f32x4 b0 = acc[ai][1][m][0], b1 = acc[ai][1][m][1];
                    if (second) {
#pragma unroll
                        for (int i = 0; i < 4; ++i) { a0[i] *= silu_f(b0[i]); a1[i] *= silu_f(b1[i]); } }
                    else { a0 *= b0; a1 *= b1; }
                    u32x4 w; w.x = pg8::cvt_pk_bf16(a0[0], a0[1]); w.y = pg8::cvt_pk_bf16(a0[2], a0[3]); w.z = pg8::cvt_pk_bf16(a1[0], a1[1]); w.w = pg8::cvt_pk_bf16(a1[2], a1[3]);
                    *(u32x4*)rp = w; }
        } else {
            const int kind = pn >> 1; int arr = 0, pitch = 512, coff = 0; bool act = false;
            if (kind == 1) { arr = 5; act = true; pitch = 1536; } else if (kind == 6) arr = 2; else if (kind == 7) arr = 3; else if (kind == 8) arr = 4; else if (kind == 9) { arr = 5; act = true; pitch = 1536; coff = 1024; }
            bf16_t* O = U + (size_t)arr * (ARRB / 2) + coff; const int col0 = (pn & 1) * 256 + wc * 32 + 8 * fq;
#pragma unroll
            for (int ai = 0; ai < 2; ++ai)
#pragma unroll
                for (int m = 0; m < 4; ++m) { bf16_t* rp = O + (size_t)(row0 + ai * 128 + m * 16) * pitch + col0;
#pragma unroll
                    for (int bj = 0; bj < 2; ++bj) { f32x4 v0 = acc[ai][bj][m][0], v1 = acc[ai][bj][m][1];
                        if (act) {
#pragma unroll
                            for (int i = 0; i < 4; ++i) { v0[i] = silu_f(v0[i]); v1[i] = silu_f(v1[i]); } }
                        u32x4 w; w.x = pg8::cvt_pk_bf16(v0[0], v0[1]); w.y = pg8::cvt_pk_bf16(v0[2], v0[3]); w.z = pg8::cvt_pk_bf16(v1[0], v1[1]); w.w = pg8::cvt_pk_bf16(v1[2], v1[3]);
                        *(u32x4*)(rp + bj * 128) = w; } }
        }
    }
};
struct EpiBranch {
    static constexpr bool PERM = true, AFTER_DRAIN = false, MIDK = true;
    unsigned char* ws;
    __device__ __forceinline__ void mid(f32x4 (&acc)[2][2][4][2], const Unit& u, int seg, int wr, int wc, int fr, int fq) const {
        int tid_ = threadIdx.x; asm volatile("" : "+v"(tid_));
        const int wid_ = tid_ >> 6, wr_ = wid_ >> 2, wc_ = wid_ & 3, fr_ = tid_ & 15, fq_ = (tid_ & 63) >> 4;
        const unsigned char* tb = ws + WS_MG + ((size_t)u.pm * 12 + (seg - 1) * 4 + u.pn) * 65536 + (size_t)(((wr_ * 4 + wc_) * 16) * 64 + (fq_ * 16 + fr_)) * 8;
#pragma unroll
        for (int ai = 0; ai < 2; ++ai)
#pragma unroll
            for (int m = 0; m < 4; ++m) {
#pragma unroll
                for (int bj = 0; bj < 2; ++bj) { const unsigned char* rp = tb + ((ai * 4 + m) * 2 + bj) * 512; const u32x2 qa = *(const u32x2*)rp, qb = *(const u32x2*)(rp + 4 * 65536);
                    f32x4 r0, r1;
                    r0[0] = (float)(qa.x & 255u) * __builtin_amdgcn_rcpf((float)(qb.x & 255u)); r0[1] = (float)((qa.x >> 8) & 255u) * __builtin_amdgcn_rcpf((float)((qb.x >> 8) & 255u));
                    r0[2] = (float)((qa.x >> 16) & 255u) * __builtin_amdgcn_rcpf((float)((qb.x >> 16) & 255u)); r0[3] = (float)(qa.x >> 24) * __builtin_amdgcn_rcpf((float)(qb.x >> 24));
                    r1[0] = (float)(qa.y & 255u) * __builtin_amdgcn_rcpf((float)(qb.y & 255u)); r1[1] = (float)((qa.y >> 8) & 255u) * __builtin_amdgcn_rcpf((float)((qb.y >> 8) & 255u));
                    r1[2] = (float)((qa.y >> 16) & 255u) * __builtin_amdgcn_rcpf((float)((qb.y >> 16) & 255u)); r1[3] = (float)(qa.y >> 24) * __builtin_amdgcn_rcpf((float)(qb.y >> 24));
                    acc[ai][bj][m][0] *= r0; acc[ai][bj][m][1] *= r1; }
                if (m == 3) asm volatile("" ::: "memory"); }
    }
    __device__ __forceinline__ void operator()(const f32x4 (&acc)[2][2][4][2], const Unit& u, int wr, int wc, int fr, int fq) const {
        bf16_t* merged = (bf16_t*)(ws + WS_H);
        const unsigned char* tb = ws + WS_MG + ((size_t)u.pm * 12 + 8 + u.pn) * 65536 + (size_t)(((wr * 4 + wc) * 16) * 64 + (fq * 16 + fr)) * 8;
        const int row0 = u.pm * 256 + wr * 64 + fr, col0 = u.pn * 256 + wc * 32 + 8 * fq;
        u32x2 gq[2][4][2];
#pragma unroll
        for (int ai = 0; ai < 2; ++ai)
#pragma unroll
            for (int m = 0; m < 4; ++m)
#pragma unroll
                for (int bj = 0; bj < 2; ++bj) gq[ai][m][bj] = *(const u32x2*)(tb + ((ai * 4 + m) * 2 + bj) * 512);
#pragma unroll
        for (int ai = 0; ai < 2; ++ai)
#pragma unroll
            for (int m = 0; m < 4; ++m) { const size_t row = (size_t)(row0 + ai * 128 + m * 16);
#pragma unroll
                for (int bj = 0; bj < 2; ++bj) { const int col = col0 + bj * 128; const u32x2 g = gq[ai][m][bj];
                    f32x4 g0, g1; const float k = 1.f / 255.f;
                    g0[0] = (float)(g.x & 255u) * k; g0[1] = (float)((g.x >> 8) & 255u) * k; g0[2] = (float)((g.x >> 16) & 255u) * k; g0[3] = (float)(g.x >> 24) * k;
                    g1[0] = (float)(g.y & 255u) * k; g1[1] = (float)((g.y >> 8) & 255u) * k; g1[2] = (float)((g.y >> 16) & 255u) * k; g1[3] = (float)(g.y >> 24) * k;
                    const f32x4 v0 = acc[ai][bj][m][0] * g0, v1 = acc[ai][bj][m][1] * g1;
                    u32x4 w; w.x = pg8::cvt_pk_bf16(v0[0], v0[1]); w.y = pg8::cvt_pk_bf16(v0[2], v0[3]); w.z = pg8::cvt_pk_bf16(v1[0], v1[1]); w.w = pg8::cvt_pk_bf16(v1[2], v1[3]);
                    *(u32x4*)(merged + row * 1024 + col) = w; } }
    }
};
struct EpiOut {
    static constexpr bool PERM = false, AFTER_DRAIN = false, MIDK = false;
    unsigned char* ws;
    __device__ __forceinline__ void operator()(const f32x4 (&acc)[2][2][4][2], const Unit& u, int wr, int wc, int fr, int fq) const {
        float* out = (float*)(ws + WS_U); float* rs = (float*)(ws + WS_RS);
        const int row0 = u.pm * 256 + wr * 64 + fr, col0 = u.pn * 256 + wc * 32 + 4 * fq;
#pragma unroll
        for (int ai = 0; ai < 2; ++ai)
#pragma unroll
            for (int m = 0; m < 4; ++m) { const size_t row = (size_t)(row0 + ai * 128 + m * 16); float ss = 0.f;
#pragma unroll
                for (int bj = 0; bj < 2; ++bj)
#pragma unroll
                    for (int n = 0; n < 2; ++n) { const f32x4 v = acc[ai][bj][m][n]; *(f32x4*)(out + row * 1024 + col0 + bj * 128 + n * 16) = v; ss += (v[0] * v[0] + v[1] * v[1]) + (v[2] * v[2] + v[3] * v[3]); }
                ss += __shfl_xor(ss, 16); ss += __shfl_xor(ss, 32);
                if (fq == 0) rs[row * 16 + u.pn * 4 + wc] = ss; }
    }
};

struct RmsPanel {
    float* xbuf;
    unsigned* cnt;
    __device__ __forceinline__ void run(const f32x4 (&v)[2][2][4][2], const Unit& u, int wr, int wc, int fr, int fq, LAS unsigned char* lds, int wid, int lane) const {
        LAS float* P = (LAS float*)lds; LAS float* S = (LAS float*)(lds + 8192);
#pragma unroll
        for (int ai = 0; ai < 2; ++ai)
#pragma unroll
            for (int m = 0; m < 4; ++m) { float s = 0.f;
#pragma unroll
                for (int bj = 0; bj < 2; ++bj)
#pragma unroll
                    for (int n = 0; n < 2; ++n) { const f32x4 x = v[ai][bj][m][n]; s += (x[0] * x[0] + x[1] * x[1]) + (x[2] * x[2] + x[3] * x[3]); }
                s += __shfl_xor(s, 16); s += __shfl_xor(s, 32);
                if (fq == 0) P[(ai * 128 + wr * 64 + m * 16 + fr) * 4 + wc] = s; }
        asm volatile("s_waitcnt lgkmcnt(0)" ::: "memory"); __builtin_amdgcn_s_barrier(); asm volatile("" ::: "memory");
        const int row = wid * 32 + (lane & 31);
        if (lane < 32) { const float t = (P[row * 4 + 0] + P[row * 4 + 1]) + (P[row * 4 + 2] + P[row * 4 + 3]);
            __hip_atomic_store(xbuf + (size_t)(u.pm * 256 + row) * 4 + u.pn, t, __ATOMIC_RELAXED, __HIP_MEMORY_SCOPE_AGENT); }
        asm volatile("s_waitcnt vmcnt(0)" ::: "memory");
        if (lane == 0) __hip_atomic_fetch_add(cnt + 64 * u.pm, 1u, __ATOMIC_RELAXED, __HIP_MEMORY_SCOPE_AGENT);
        if (wid == 0) {
            unsigned sp = 0;
            while ((unsigned)__builtin_amdgcn_readfirstlane(__hip_atomic_load(cnt + 64 * u.pm, __ATOMIC_RELAXED, __HIP_MEMORY_SCOPE_AGENT)) < 32u) { __builtin_amdgcn_s_sleep(2); if (++sp > (1u << 22)) break; }
            __builtin_amdgcn_fence(__ATOMIC_ACQUIRE, "agent");
        }
        asm volatile("s_waitcnt vmcnt(0) lgkmcnt(0)" ::: "memory"); __builtin_amdgcn_s_barrier(); asm volatile("" ::: "memory");
        if (lane < 32) { const float* slot = xbuf + (size_t)(u.pm * 256 + row) * 4; float t = 0.f;
#pragma unroll
            for (int k = 0; k < 4; ++k) t += __hip_atomic_load(slot + k, __ATOMIC_RELAXED, __HIP_MEMORY_SCOPE_AGENT);
            S[row] = 1.0f / sqrtf(t * (1.f / DM) + RMS_EPS); }
        asm volatile("s_waitcnt lgkmcnt(0)" ::: "memory"); __builtin_amdgcn_s_barrier(); asm volatile("" ::: "memory");
    }
};
struct EpiNorm1 {
    static constexpr bool PERM = false, AFTER_DRAIN = true, MIDK = false;
    float* out; const float* gpost; RmsPanel st;
    __device__ __forceinline__ void operator()(const f32x4 (&)[2][2][4][2], const Unit&, int, int, int, int) const {}
    __device__ __forceinline__ void fused(f32x4 (&acc)[2][2][4][2], const Unit& u, int wr, int wc, int fr, int fq, LAS unsigned char* lds, int wid, int lane) const {
        const LAS float* S = (const LAS float*)(lds + 8192);
        const int col0 = u.pn * 256 + wc * 32 + 4 * fq;
        f32x4 gp[2][2]; u32x2 pre[2][4][2][2];
#pragma unroll
        for (int bj = 0; bj < 2; ++bj)
#pragma unroll
            for (int n = 0; n < 2; ++n) gp[bj][n] = *(const f32x4*)(gpost + col0 + bj * 128 + n * 16);
#pragma unroll
        for (int ai = 0; ai < 2; ++ai)
#pragma unroll
            for (int m = 0; m < 4; ++m) {
#pragma unroll
                for (int bj = 0; bj < 2; ++bj)
#pragma unroll
                    for (int n = 0; n < 2; ++n) pre[ai][m][bj][n] = __builtin_nontemporal_load((const u32x2*)((const unsigned char*)out + (size_t)(u.pm * 256 + wid * 32 + ((ai * 4 + m) * 2 + bj) * 2 + n) * 4096 + u.pn * 1024 + lane * 8)); }
        st.run(acc, u, wr, wc, fr, fq, lds, wid, lane);
#pragma unroll
        for (int ai = 0; ai < 2; ++ai)
#pragma unroll
            for (int m = 0; m < 4; ++m) { const int r = ai * 128 + wr * 64 + m * 16 + fr; const float rs = S[r]; const size_t off = (size_t)(u.pm * 256 + r) * DM + col0;
#pragma unroll
                for (int bj = 0; bj < 2; ++bj)
#pragma unroll
                    for (int n = 0; n < 2; ++n) { const u32x2 p = pre[ai][m][bj][n]; const f32x4 bs = (f32x4){bflo(p.x), bfhi(p.x), bflo(p.y), bfhi(p.y)};
                        *(f32x4*)(out + off + bj * 128 + n * 16) = bs + acc[ai][bj][m][n] * rs * gp[bj][n]; } }
    }
};
struct EpiNorm2 {
    static constexpr bool PERM = false, AFTER_DRAIN = true, MIDK = false;
    const float* base; float* out; bf16_t* hn; const float* gpost; const float* gnext; RmsPanel st1, st2;
    __device__ __forceinline__ void operator()(const f32x4 (&)[2][2][4][2], const Unit&, int, int, int, int) const {}
    __device__ __forceinline__ void fused(f32x4 (&acc)[2][2][4][2], const Unit& u, int wr, int wc, int fr, int fq, LAS unsigned char* lds, int wid, int lane) const {
        const LAS float* S = (const LAS float*)(lds + 8192);
        const int col0 = u.pn * 256 + wc * 32 + 4 * fq;
        f32x4 gp[2][2], pre[4][2][2];
#pragma unroll
        for (int bj = 0; bj < 2; ++bj)
#pragma unroll
            for (int n = 0; n < 2; ++n) gp[bj][n] = *(const f32x4*)(gpost + col0 + bj * 128 + n * 16);
#pragma unroll
        for (int m = 0; m < 4; ++m)
#pragma unroll
            for (int bj = 0; bj < 2; ++bj)
#pragma unroll
                for (int n = 0; n < 2; ++n) pre[m][bj][n] = __builtin_nontemporal_load((const f32x4*)(base + (size_t)(u.pm * 256 + wr * 64 + m * 16 + fr) * DM + col0 + bj * 128 + n * 16));
        st1.run(acc, u, wr, wc, fr, fq, lds, wid, lane);
#pragma unroll
        for (int ai = 0; ai < 2; ++ai) {
            if (ai == 1) {
#pragma unroll
                for (int m = 0; m < 4; ++m)
#pragma unroll
                    for (int bj = 0; bj < 2; ++bj)
#pragma unroll
                        for (int n = 0; n < 2; ++n) pre[m][bj][n] = __builtin_nontemporal_load((const f32x4*)(base + (size_t)(u.pm * 256 + 128 + wr * 64 + m * 16 + fr) * DM + col0 + bj * 128 + n * 16));
            }
#pragma unroll
            for (int m = 0; m < 4; ++m) { const int r = ai * 128 + wr * 64 + m * 16 + fr; const float rs = S[r]; const size_t off = (size_t)(u.pm * 256 + r) * DM + col0;
#pragma unroll
                for (int bj = 0; bj < 2; ++bj)
#pragma unroll
                    for (int n = 0; n < 2; ++n) { const f32x4 x1 = pre[m][bj][n] + acc[ai][bj][m][n] * rs * gp[bj][n]; acc[ai][bj][m][n] = x1;
                        u32x2 w; w.x = pg8::cvt_pk_bf16(x1[0], x1[1]); w.y = pg8::cvt_pk_bf16(x1[2], x1[3]);
                        *(u32x2*)((unsigned char*)out + (size_t)(u.pm * 256 + wid * 32 + ((ai * 4 + m) * 2 + bj) * 2 + n) * 4096 + u.pn * 1024 + lane * 8) = w; } }
        }
#pragma unroll
        for (int bj = 0; bj < 2; ++bj)
#pragma unroll
            for (int n = 0; n < 2; ++n) gp[bj][n] = *(const f32x4*)(gnext + col0 + bj * 128 + n * 16);
        st2.run(acc, u, wr, wc, fr, fq, lds, wid, lane);
#pragma unroll
        for (int ai = 0; ai < 2; ++ai)
#pragma unroll
            for (int m = 0; m < 4; ++m) { const int r = ai * 128 + wr * 64 + m * 16 + fr; const float rs = S[r]; const size_t off = (size_t)(u.pm * 256 + r) * DM + col0;
#pragma unroll
                for (int bj = 0; bj < 2; ++bj)
#pragma unroll
                    for (int n = 0; n < 2; ++n) { const f32x4 o = acc[ai][bj][m][n] * rs * gp[bj][n];
                        u32x2 w; w.x = pg8::cvt_pk_bf16(o[0], o[1]); w.y = pg8::cvt_pk_bf16(o[2], o[3]); *(u32x2*)(hn + off + bj * 128 + n * 16) = w; } }
    }
};
__device__ __forceinline__ int win_row(int c) {
    if (c < 1024 || c >= 3072) return c;
    const int q = (c - 1024) >> 9, ch = (c - 1024) & 511, a = ch >> 7, j = ch & 127;
    return ((q & 1) ? 8 + a : 4 + a) * 256 + (q >> 1) * 128 + j;
}
__device__ __forceinline__ void transpose_item(const float* W, int N, bf16_t* WT, int ldt, int koff, int row_off, bool winmap, LAS float* scr, int item, int lane, const float* rscale = nullptr) {
    const int nblk = N / 64, kb = item / nblk, nb = item % nblk, k0 = 64 * kb, n0 = 64 * nb;
    const int kq = lane >> 4, nq = lane & 15;
    f32x4 v[16];
#pragma unroll
    for (int i = 0; i < 16; ++i) v[i] = __builtin_nontemporal_load((const f32x4*)(W + (size_t)(k0 + 4 * i + kq) * N + n0 + 4 * nq));
#pragma unroll
    for (int i = 0; i < 16; ++i) { LAS float* s = scr + (4 * i + kq) * 65 + 4 * nq; s[0] = v[i][0]; s[1] = v[i][1]; s[2] = v[i][2]; s[3] = v[i][3]; }
    asm volatile("s_waitcnt lgkmcnt(0)" ::: "memory");
    const int c = lane & 7;
#pragma unroll
    for (int j = 0; j < 8; ++j) { const int n = (lane >> 3) + 8 * j;
        const LAS float* s = scr + (rscale ? (16 * (c >> 1) + 4 * (c & 1)) : 8 * c) * 65 + n; const int hs = rscale ? 8 * 65 : 4 * 65; const float f = rscale ? rscale[n0 + n] : 1.f;
        u32x4 o; o.x = pg8::cvt_pk_bf16(s[0 * 65] * f, s[1 * 65] * f); o.y = pg8::cvt_pk_bf16(s[2 * 65] * f, s[3 * 65] * f); o.z = pg8::cvt_pk_bf16(s[hs] * f, s[hs + 65] * f); o.w = pg8::cvt_pk_bf16(s[hs + 2 * 65] * f, s[hs + 3 * 65] * f);
        int dst = n0 + n; if (winmap) dst = win_row(dst);
        if (rscale) *(u32x4*)(WT + (size_t)((((dst >> 5) * 8 + ((k0 + 8 * c) >> 4)) * 64 + (c & 1) * 32 + (dst & 31)) * 8)) = o;
        else *(u32x4*)(WT + (size_t)(row_off + dst) * ldt + koff + k0 + 8 * c) = o; }
    asm volatile("s_waitcnt lgkmcnt(0)" ::: "memory");
}
template <int R> __device__ __forceinline__ void rms_rows_to_bf16(const float* x, const float* g, bf16_t* H, int m0, int mstride, int lane) {
    f32x4 v[R][4];
#pragma unroll
    for (int r = 0; r < R; ++r)
#pragma unroll
        for (int j = 0; j < 4; ++j) v[r][j] = __builtin_nontemporal_load((const f32x4*)(x + (size_t)(m0 + r * mstride) * DM) + 64 * j + lane);
    f32x4 gg[4];
#pragma unroll
    for (int j = 0; j < 4; ++j) gg[j] = ((const f32x4*)g)[64 * j + lane];
#pragma unroll
    for (int r = 0; r < R; ++r) { float s = 0.f;
#pragma unroll
        for (int j = 0; j < 4; ++j) s += (v[r][j][0] * v[r][j][0] + v[r][j][1] * v[r][j][1]) + (v[r][j][2] * v[r][j][2] + v[r][j][3] * v[r][j][3]);
        const float rstd = 1.f / sqrtf(wave_sum(s) * (1.f / DM) + RMS_EPS);
        u32x2* o8 = (u32x2*)(H + (size_t)(m0 + r * mstride) * DM) + lane;
#pragma unroll
        for (int j = 0; j < 4; ++j) { u32x2 w; w.x = pg8::cvt_pk_bf16(v[r][j][0] * rstd * gg[j][0], v[r][j][1] * rstd * gg[j][1]); w.y = pg8::cvt_pk_bf16(v[r][j][2] * rstd * gg[j][2], v[r][j][3] * rstd * gg[j][3]); o8[64 * j] = w; } }
}

__device__ __forceinline__ int crow(int r, int hi) { return (r & 3) + 8 * (r >> 2) + 4 * hi; }
constexpr int VROW = 144;
__device__ __forceinline__ void attn_item(int item, const bf16_t* Q, const bf16_t* K, const bf16_t* V, const bf16_t* SG, bf16_t* YO, LAS unsigned char* vl, LAS unsigned char* kl, int lane) {
    const int qg = item & 127, h = (item >> 7) & 7, b = item >> 10;
    const int r32 = lane & 31, hi = lane >> 5, t0 = qg * 32;
    const size_t tokq = (size_t)b * SEQ + t0 + r32;
    bf16x8 qf[4];
    { const size_t tq0 = (size_t)b * SEQ + t0;
#pragma unroll
      for (int p = 0; p < 4; ++p) { const int idx = p * 64 + lane; const u32x4 v = *(const u32x4*)(Q + (tq0 + (idx >> 3)) * 512 + h * 64 + (idx & 7) * 8); *(LAS u32x4*)(kl + (idx >> 3) * VROW + (idx & 7) * 16) = v; }
#pragma unroll
      for (int d0 = 0; d0 < 4; ++d0) qf[d0] = *(const LAS bf16x8*)(kl + r32 * VROW + d0 * 32 + hi * 16); }
    f32x16 o0, o1;
#pragma unroll
    for (int r = 0; r < 16; ++r) { o0[r] = 0.f; o1[r] = 0.f; }
    float P = 1.f;
    const int i16 = lane & 15, G4 = lane >> 4;
    const int vb = (4 * (G4 >> 1) + (i16 >> 2)) * VROW + (16 * (G4 & 1) + 4 * (i16 & 3)) * 2;
#define ATT_LOAD(KF, VR, S0) do { const size_t tk_ = (size_t)b * SEQ + ((S0) > 0 ? (S0) : 0); \
        _Pragma("unroll") for (int p = 0; p < 4; ++p) { const int idx = p * 64 + lane; KF[p] = *(const u32x4*)(K + (tk_ + (idx >> 3)) * 512 + h * 64 + (idx & 7) * 8); \
                                                         VR[p] = *(const u32x4*)(V + (tk_ + (idx >> 3)) * 512 + h * 64 + (idx & 7) * 8); } } while (0)
    u32x4 kf[4], kn[4]; u32x4 vr[4], vn[4];
    ATT_LOAD(kf, vr, t0); ATT_LOAD(kn, vn, t0 - 32);
    u32x4 sgr[4];
#pragma unroll
    for (int p = 0; p < 4; ++p) { const int idx = p * 64 + lane; sgr[p] = *(const u32x4*)(SG + ((size_t)b * SEQ + t0 + (idx >> 3)) * 1536 + h * 64 + (idx & 7) * 8); }
    for (int s0 = t0; s0 >= 0; s0 -= 32) {
#pragma unroll
        for (int p = 0; p < 4; ++p) { const int idx = p * 64 + lane, key = idx >> 3, ch = idx & 7; *(LAS u32x4*)(vl + key * VROW + ch * 16) = vr[p]; *(LAS u32x4*)(kl + key * VROW + ch * 16) = kf[p]; }
        f32x16 s;
#pragma unroll
        for (int r = 0; r < 16; ++r) s[r] = 0.f;
#pragma unroll
        for (int d0 = 0; d0 < 4; ++d0) s = __builtin_amdgcn_mfma_f32_32x32x16_bf16(*(const LAS bf16x8*)(kl + r32 * VROW + d0 * 32 + hi * 16), qf[d0], s, 0, 0, 0);
        const bool diag = (s0 == t0);
        float kp[16];
#pragma unroll
        for (int r = 0; r < 16; ++r) { const float e = __builtin_amdgcn_exp2f(s[r] * (0.125f * 1.4426950408889634f)); float k = __builtin_amdgcn_rcpf(1.f + e);
            if (diag && crow(r, hi) >= r32) k = 1.f; kp[r] = k; }
        float Gm[4], Go[4], T[4], R[4], C[4];
#pragma unroll
        for (int g = 0; g < 4; ++g) { Gm[g] = (kp[4 * g] * kp[4 * g + 1]) * (kp[4 * g + 2] * kp[4 * g + 3]); Go[g] = __shfl_xor(Gm[g], 32); T[g] = Gm[g] * Go[g]; }
        R[3] = P; R[2] = R[3] * T[3]; R[1] = R[2] * T[2]; R[0] = R[1] * T[1]; const float Cout = R[0] * T[0];
#pragma unroll
        for (int g = 0; g < 4; ++g) C[g] = hi ? R[g] : R[g] * Go[g];
        float w[16];
#pragma unroll
        for (int g = 0; g < 4; ++g) { const float p3 = C[g], p2 = p3 * kp[4 * g + 3], p1 = p2 * kp[4 * g + 2], p0 = p1 * kp[4 * g + 1], pe = p0 * kp[4 * g];
            w[4 * g + 3] = p3 - p2; w[4 * g + 2] = p2 - p1; w[4 * g + 1] = p1 - p0; w[4 * g] = p0 - pe; }
        bf16x8 wf[2];
#pragma unroll
        for (int st = 0; st < 2; ++st) { u32x4 t; t.x = pg8::cvt_pk_bf16(w[8 * st], w[8 * st + 1]); t.y = pg8::cvt_pk_bf16(w[8 * st + 2], w[8 * st + 3]); t.z = pg8::cvt_pk_bf16(w[8 * st + 4], w[8 * st + 5]); t.w = pg8::cvt_pk_bf16(w[8 * st + 6], w[8 * st + 7]); wf[st] = __builtin_bit_cast(bf16x8, t); }
#pragma unroll
        for (int dt = 0; dt < 2; ++dt)
#pragma unroll
            for (int st = 0; st < 2; ++st) {
                const s16x4 lo = __builtin_amdgcn_ds_read_tr16_b64_v4i16((LAS s16x4*)(vl + vb + (16 * st) * VROW + dt * 64));
                const s16x4 hh = __builtin_amdgcn_ds_read_tr16_b64_v4i16((LAS s16x4*)(vl + vb + (16 * st + 8) * VROW + dt * 64));
                const bf16x8 vf = (bf16x8){lo[0], lo[1], lo[2], lo[3], hh[0], hh[1], hh[2], hh[3]};
                if (dt == 0) o0 = __builtin_amdgcn_mfma_f32_32x32x16_bf16(vf, wf[st], o0, 0, 0, 0); else o1 = __builtin_amdgcn_mfma_f32_32x32x16_bf16(vf, wf[st], o1, 0, 0, 0); }
        P = Cout;
        if (__all(P < 1.17549435e-38f)) break;
#pragma unroll
        for (int i = 0; i < 4; ++i) { kf[i] = kn[i]; vr[i] = vn[i]; }
        ATT_LOAD(kn, vn, s0 - 64);
    }
#undef ATT_LOAD
#pragma unroll
    for (int p = 0; p < 4; ++p) { const int idx = p * 64 + lane; *(LAS u32x4*)(kl + (idx >> 3) * VROW + (idx & 7) * 16) = sgr[p]; }
#pragma unroll
    for (int dt = 0; dt < 2; ++dt)
#pragma unroll
        for (int g = 0; g < 4; ++g) { LAS u32x2* p = (LAS u32x2*)(kl + r32 * VROW + (dt * 32 + 8 * g + 4 * hi) * 2); const u32x2 sg = *p;
            const f32x16& o = dt ? o1 : o0; u32x2 y;
            y.x = pg8::cvt_pk_bf16(o[4 * g] * bflo(sg.x), o[4 * g + 1] * bfhi(sg.x)); y.y = pg8::cvt_pk_bf16(o[4 * g + 2] * bflo(sg.y), o[4 * g + 3] * bfhi(sg.y));
            *p = y; }
#pragma unroll
    for (int p = 0; p < 4; ++p) { const int idx = p * 64 + lane; const u32x4 v = *(const LAS u32x4*)(kl + (idx >> 3) * VROW + (idx & 7) * 16);
        *(u32x4*)(YO + ((size_t)b * SEQ + t0 + (idx >> 3)) * 1536 + h * 64 + (idx & 7) * 8) = v; }
}
constexpr int PROW = 272;
__device__ __forceinline__ void pool_item(int pi, const bf16_t* PV, const bf16_t* SG, bf16_t* YO, const bf16_t* PT, const float* scale, LAS unsigned char* sl, int lane) {
    const int tile = pi >> 2, g = ((pi & 3) + ((pi >> 2) & 1)) & 3, win = 2 << g;
    const int r32 = lane & 31, hi = lane >> 5, tok0 = tile * 32, t0 = tok0 & (SEQ - 1), tok = tok0 + r32;
    u32x4 sv[12];
#pragma unroll
    for (int p = 0; p < 12; ++p) { const int idx = p * 64 + lane, row = idx >> 4, ch = idx & 15; const bool ok = (t0 + row - 16) >= 0;
        sv[p] = *(const u32x4*)(PV + (size_t)(ok ? tok0 + row - 16 : tok0) * 512 + g * 128 + ch * 8); if (!ok) sv[p] = (u32x4){0u, 0u, 0u, 0u}; }
#pragma unroll
    for (int p = 0; p < 12; ++p) { const int idx = p * 64 + lane, row = idx >> 4, ch = idx & 15; *(LAS u32x4*)(sl + row * PROW + ch * 16) = sv[p]; }
    const int t = t0 + r32, cnt = (t + 1) < win ? (t + 1) : win;
    bf16x8 bfr[3];
#pragma unroll
    for (int ks = 0; ks < 3; ++ks) { float wv[8];
#pragma unroll
        for (int j = 0; j < 8; ++j) { const int rel = (16 + r32) - (16 * ks + 8 * hi + j); wv[j] = (rel == 0) ? (float)(1 - cnt) : ((rel > 0 && rel < cnt) ? 1.f : 0.f); }
        u32x4 tt; tt.x = pg8::cvt_pk_bf16(wv[0], wv[1]); tt.y = pg8::cvt_pk_bf16(wv[2], wv[3]); tt.z = pg8::cvt_pk_bf16(wv[4], wv[5]); tt.w = pg8::cvt_pk_bf16(wv[6], wv[7]); bfr[ks] = __builtin_bit_cast(bf16x8, tt); }
    bf16x8 ptf[4][8];
#pragma unroll
    for (int nt = 0; nt < 4; ++nt)
#pragma unroll
        for (int ks = 0; ks < 8; ++ks) ptf[nt][ks] = *(const bf16x8*)(PT + (size_t)g * 128 * 128 + (size_t)((nt * 8 + ks) * 64 + lane) * 8);
    const int i16 = lane & 15, G4 = lane >> 4;
    const int vb = (8 * (G4 >> 1) + (i16 >> 2)) * PROW + (16 * (G4 & 1) + 4 * (i16 & 3)) * 2;
    const float inv = __builtin_amdgcn_rcpf((float)cnt);
    bf16x8 pf[8];
#pragma unroll
    for (int ct = 0; ct < 4; ++ct) {
        f32x16 acc;
#pragma unroll
        for (int r = 0; r < 16; ++r) acc[r] = 0.f;
#pragma unroll
        for (int ks = 0; ks < 3; ++ks) {
            const s16x4 lo = __builtin_amdgcn_ds_read_tr16_b64_v4i16((LAS s16x4*)(sl + vb + (16 * ks) * PROW + ct * 64));
            const s16x4 hh = __builtin_amdgcn_ds_read_tr16_b64_v4i16((LAS s16x4*)(sl + vb + (16 * ks + 4) * PROW + ct * 64));
            const bf16x8 a = (bf16x8){lo[0], lo[1], lo[2], lo[3], hh[0], hh[1], hh[2], hh[3]};
            acc = __builtin_amdgcn_mfma_f32_32x32x16_bf16(a, bfr[ks], acc, 0, 0, 0); }
#pragma unroll
        for (int s = 0; s < 2; ++s) { u32x4 tt; tt.x = pg8::cvt_pk_bf16(acc[8 * s] * inv, acc[8 * s + 1] * inv); tt.y = pg8::cvt_pk_bf16(acc[8 * s + 2] * inv, acc[8 * s + 3] * inv);
            tt.z = pg8::cvt_pk_bf16(acc[8 * s + 4] * inv, acc[8 * s + 5] * inv); tt.w = pg8::cvt_pk_bf16(acc[8 * s + 6] * inv, acc[8 * s + 7] * inv); pf[2 * ct + s] = __builtin_bit_cast(bf16x8, tt); }
    }
#pragma unroll
    for (int p = 0; p < 8; ++p) { const int idx = p * 64 + lane; const u32x4 v = *(const u32x4*)(SG + (size_t)(tok0 + (idx >> 4)) * 1536 + g * 128 + (idx & 15) * 8); *(LAS u32x4*)(sl + (idx >> 4) * PROW + (idx & 15) * 16) = v; }
#pragma unroll
    for (int nt = 0; nt < 4; ++nt) {
        f32x16 acc;
#pragma unroll
        for (int r = 0; r < 16; ++r) acc[r] = 0.f;
#pragma unroll
        for (int ks = 0; ks < 8; ++ks) acc = __builtin_amdgcn_mfma_f32_32x32x16_bf16(ptf[nt][ks], pf[ks], acc, 0, 0, 0);
#pragma unroll
        for (int q = 0; q < 4; ++q) { LAS u32x2* p = (LAS u32x2*)(sl + r32 * PROW + (nt * 32 + 8 * q + 4 * hi) * 2); const u32x2 sg = *p; u32x2 y;
            y.x = pg8::cvt_pk_bf16(acc[4 * q] * bflo(sg.x), acc[4 * q + 1] * bfhi(sg.x)); y.y = pg8::cvt_pk_bf16(acc[4 * q + 2] * bflo(sg.y), acc[4 * q + 3] * bfhi(sg.y));
            *p = y; }
    }
#pragma unroll
    for (int p = 0; p < 8; ++p) { const int idx = p * 64 + lane; const u32x4 v = *(const LAS u32x4*)(sl + (idx >> 4) * PROW + (idx & 15) * 16);
        *(u32x4*)(YO + (size_t)(tok0 + (idx >> 4)) * 1536 + g * 128 + (idx & 15) * 8) = v; }
}
__device__ __forceinline__ void conv_item(int ci, const bf16_t* Z, const bf16_t* Wy, bf16_t* YO, const float* cw, const float* cb, int lane) {
    const int tok0 = ci * 8, t0 = tok0 & (SEQ - 1), ch = lane * 8;
    float w0[8], w1[8], w2[8], bs[8], zm2[8], zm1[8];
#pragma unroll
    for (int hf = 0; hf < 2; ++hf) { const f32x4 a = *(const f32x4*)(cw + ch + 4 * hf), b = *(const f32x4*)(cw + 512 + ch + 4 * hf), c = *(const f32x4*)(cw + 1024 + ch + 4 * hf), d = *(const f32x4*)(cb + ch + 4 * hf);
#pragma unroll
        for (int i = 0; i < 4; ++i) { w0[4 * hf + i] = a[i]; w1[4 * hf + i] = b[i]; w2[4 * hf + i] = c[i]; bs[4 * hf + i] = d[i]; } }
#pragma unroll
    for (int i = 0; i < 8; ++i) { zm2[i] = 0.f; zm1[i] = 0.f; }
    if (t0 != 0) { const u32x4 a = *(const u32x4*)(Z + (size_t)(tok0 - 2) * 512 + ch), b = *(const u32x4*)(Z + (size_t)(tok0 - 1) * 512 + ch);
        zm2[0] = bflo(a.x); zm2[1] = bfhi(a.x); zm2[2] = bflo(a.y); zm2[3] = bfhi(a.y); zm2[4] = bflo(a.z); zm2[5] = bfhi(a.z); zm2[6] = bflo(a.w); zm2[7] = bfhi(a.w);
        zm1[0] = bflo(b.x); zm1[1] = bfhi(b.x); zm1[2] = bflo(b.y); zm1[3] = bfhi(b.y); zm1[4] = bflo(b.z); zm1[5] = bfhi(b.z); zm1[6] = bflo(b.w); zm1[7] = bfhi(b.w); }
    u32x4 zr[8], wr_[8];
#pragma unroll
    for (int r = 0; r < 8; ++r) { zr[r] = *(const u32x4*)(Z + (size_t)(tok0 + r) * 512 + ch); wr_[r] = *(const u32x4*)(Wy + (size_t)(tok0 + r) * 1536 + ch); }
#pragma unroll
    for (int r = 0; r < 8; ++r) {
        float zc[8], wv[8], y[8];
        zc[0] = bflo(zr[r].x); zc[1] = bfhi(zr[r].x); zc[2] = bflo(zr[r].y); zc[3] = bfhi(zr[r].y); zc[4] = bflo(zr[r].z); zc[5] = bfhi(zr[r].z); zc[6] = bflo(zr[r].w); zc[7] = bfhi(zr[r].w);
        wv[0] = bflo(wr_[r].x); wv[1] = bfhi(wr_[r].x); wv[2] = bflo(wr_[r].y); wv[3] = bfhi(wr_[r].y); wv[4] = bflo(wr_[r].z); wv[5] = bfhi(wr_[r].z); wv[6] = bflo(wr_[r].w); wv[7] = bfhi(wr_[r].w);
#pragma unroll
        for (int i = 0; i < 8; ++i) { y[i] = wv[i] * (w0[i] * zm2[i] + w1[i] * zm1[i] + w2[i] * zc[i] + bs[i]); zm2[i] = zm1[i]; zm1[i] = zc[i]; }
        u32x4 o; o.x = pg8::cvt_pk_bf16(y[0], y[1]); o.y = pg8::cvt_pk_bf16(y[2], y[3]); o.z = pg8::cvt_pk_bf16(y[4], y[5]); o.w = pg8::cvt_pk_bf16(y[6], y[7]);
        *(u32x4*)(YO + (size_t)(tok0 + r) * 1536 + ch) = o; }
}
template <int R> __device__ __forceinline__ void norm_rows(const float* F32T, const float* RS, const float* xin, const float* gpost, float* xout, const float* gnext, bf16_t* H, int m0, int mstride, int lane) {
    f32x4 o[R][4], xi[R][4]; float ss[R];
#pragma unroll
    for (int r = 0; r < R; ++r) { const size_t row = (size_t)(m0 + r * mstride); ss[r] = (lane < 16) ? RS[row * 16 + lane] : 0.f;
#pragma unroll
        for (int j = 0; j < 4; ++j) { o[r][j] = ((const f32x4*)(F32T + row * DM))[64 * j + lane]; xi[r][j] = ((const f32x4*)(xin + row * DM))[64 * j + lane]; } }
    f32x4 gp[4];
#pragma unroll
    for (int j = 0; j < 4; ++j) gp[j] = ((const f32x4*)gpost)[64 * j + lane];
#pragma unroll
    for (int r = 0; r < R; ++r) { const size_t row = (size_t)(m0 + r * mstride);
        const float rstd = 1.f / sqrtf(wave_sum(ss[r]) * (1.f / DM) + RMS_EPS); float s2 = 0.f;
#pragma unroll
        for (int j = 0; j < 4; ++j) { const f32x4 v = xi[r][j] + o[r][j] * rstd * gp[j]; xi[r][j] = v; ((f32x4*)(xout + row * DM))[64 * j + lane] = v; s2 += (v[0] * v[0] + v[1] * v[1]) + (v[2] * v[2] + v[3] * v[3]); }
        if (gnext) { const float r2 = 1.f / sqrtf(wave_sum(s2) * (1.f / DM) + RMS_EPS);
#pragma unroll
            for (int j = 0; j < 4; ++j) { const f32x4 gg = ((const f32x4*)gnext)[64 * j + lane]; const f32x4 v = xi[r][j]; u32x2 w; w.x = pg8::cvt_pk_bf16(v[0] * r2 * gg[0], v[1] * r2 * gg[1]); w.y = pg8::cvt_pk_bf16(v[2] * r2 * gg[2], v[3] * r2 * gg[3]); ((u32x2*)(H + row * DM))[64 * j + lane] = w; } } }
}

struct Args { const float* in[10]; float* out; unsigned char* ws; int ph_lo, ph_hi; };
template <class T> __device__ __forceinline__ T* as_global(T* p) { return p; }
#if TP_A >= 0
#define TSTAMP(k) do { if (blockIdx.x == TP_BLK && threadIdx.x == 0) ((volatile LAS unsigned long long*)(lds + 147264))[(k)] = __builtin_amdgcn_s_memrealtime(); } while (0)
#else
#define TSTAMP(k) do { } while (0)
#endif
template <int ph> __device__ __forceinline__ void run_phase(const Args& a_, LAS unsigned char* lds) {
        const Args* A = &a_;
        const int tid = threadIdx.x, lane = tid & 63, wave = __builtin_amdgcn_readfirstlane(tid >> 6);
        const int G = gridDim.x, bx = blockIdx.x;
        const int vcu = (G % 8 == 0) ? (bx % 8) * (G / 8) + bx / 8 : bx;
        const int gw = vcu * 8 + wave, NGW = G * 8;
        unsigned char* ws = as_global(A->ws);
        bf16_t* H = (bf16_t*)(ws + WS_H); bf16_t* U = (bf16_t*)(ws + WS_U);
        if constexpr (ph == 0) {
            const float* x = as_global(A->in[0]); const float* pre_g = as_global(A->in[1]); const float* w_in = as_global(A->in[2]); const float* pool_w = as_global(A->in[3]); const float* pool_scale = as_global(A->in[4]); const float* w_branch = as_global(A->in[7]); const float* w_out = as_global(A->in[8]);
            bf16_t* W1 = (bf16_t*)(ws + WS_W1); bf16_t* W2 = (bf16_t*)(ws + WS_W2); bf16_t* W3 = (bf16_t*)(ws + WS_W3); bf16_t* PW = (bf16_t*)(ws + WS_PW);
            LAS float* scr = (LAS float*)(lds + wave * 17408);
            constexpr int I1 = (DM / 64) * (NIN / 64), I4 = 2 * 2;
            for (int it = gw; it < I1 + 8 * I4; it += NGW) {
                if (it < I1) transpose_item(w_in, NIN, W1, DM, 0, 0, true, scr, it, lane);
                else { const int r = it - I1, lg = r / I4; transpose_item(pool_w + (size_t)lg * 128 * 128, 128, PW + (size_t)lg * 128 * 128, 128, 0, 0, false, scr, r % I4, lane, pool_scale + lg * 128); }
            }
            for (int m = gw; m < MTOK; m += 2 * NGW) rms_rows_to_bf16<2>(x, pre_g, H, m, NGW, lane);
        } else {
            constexpr int l = (ph - 1) / 5, k = (ph - 1) % 5;
            if constexpr (k == 0) {
                pg8::Gemm g{H, (bf16_t*)(ws + WS_W1) + (size_t)l * NIN * DM, MTOK, NIN, DM, 0}; pg8::StaticOrder S; S.init(MTOK, NIN, G, bx);
                EpiU E{ws};
                pg8::gemm_phase<EpiU, pg8::StaticOrder, true, true>(lds, g, S, E);
            } else if constexpr (k == 1) {
                const float* pool_scale = as_global(A->in[4]); const float* conv_w = as_global(A->in[5]); const float* conv_b = as_global(A->in[6]);
                const bf16_t* PW = (const bf16_t*)(ws + WS_PW);
                const bf16_t* Q = U + 2 * (ARRB / 2); const bf16_t* Kk = U + 3 * (ARRB / 2); const bf16_t* V = U + 4 * (ARRB / 2);
                LAS unsigned char* vl = lds + wave * (32 * VROW + 48 * PROW);
                LAS unsigned char* sl_ = vl + 32 * VROW;
                bf16_t* G3 = U + 5 * (ARRB / 2);
                bf16_t* YO = G3;
#if MIX_PROBE
                if (l == 0 && A->ph_hi < 0) YO = (bf16_t*)as_global(A->out);
#endif
                int pm_ = 7;
#if MIX_PROBE
                if (l == 0 && A->ph_hi < 0) pm_ = MIX_PROBE;
#endif
                if (l == 0) TSTAMP(12);
                volatile LAS unsigned* wq = (volatile LAS unsigned*)(lds + 147216);
                if (tid < 4) wq[tid] = 0u;
                __syncthreads();
#define WQ_GRAB(Q_) ({ unsigned v_ = 0u; if (lane == 0) v_ = __hip_atomic_fetch_add((LAS unsigned*)(Q_), 1u, __ATOMIC_RELAXED, __HIP_MEMORY_SCOPE_WORKGROUP); (unsigned)__builtin_amdgcn_readfirstlane((int)v_); })
#define WQ_ITEM(J_) ((int)(vcu * 8 + ((J_) & 7u) + ((J_) >> 3) * (unsigned)NGW))
                for (;;) { const unsigned j = WQ_GRAB(wq); const int it = WQ_ITEM(j); if (it >= NB * 8 * 128) break; attn_item(it, Q, Kk, V, G3 + 1024, YO + 1024, vl, sl_, lane); }
                if (l == 0) TSTAMP(13);
                for (;;) { const unsigned j = WQ_GRAB(wq + 1); const int it = WQ_ITEM(j); if (it >= (MTOK / 32) * 4) break; pool_item(it, U, G3, YO, PW + (size_t)l * 4 * 128 * 128, pool_scale + l * BWID, sl_, lane); }
                if (l == 0) TSTAMP(14);
                for (;;) { const unsigned j = WQ_GRAB(wq + 2); const int it = WQ_ITEM(j); if (it >= MTOK / 8) break; conv_item(it, U + 1 * (ARRB / 2), G3 + 512, YO + 512, conv_w + l * 3 * BWID, conv_b + l * BWID, lane); }
                if constexpr (l == 0) {
                    const float* w_in = as_global(A->in[2]); const float* w_branch = as_global(A->in[7]); const float* w_out = as_global(A->in[8]);
                    bf16_t* W1 = (bf16_t*)(ws + WS_W1); bf16_t* W2 = (bf16_t*)(ws + WS_W2); bf16_t* W3 = (bf16_t*)(ws + WS_W3);
                    constexpr int I1 = (DM / 64) * (NIN / 64), I2 = (BWID / 64) * (DM / 64), I3 = (DM / 64) * (DM / 64), NDEF = I1 + 6 * I2 + 2 * I3;
                    for (;;) { const unsigned j = WQ_GRAB(wq + 3); int r = WQ_ITEM(j); if (r >= NDEF) break;
                        if (r < I1) { transpose_item(w_in + (size_t)DM * NIN, NIN, W1 + (size_t)NIN * DM, DM, 0, 0, true, (LAS float*)vl, r, lane); continue; } r -= I1;
                        if (r < 6 * I2) { const int ln = r / I2, ll = ln / 3, n = ln % 3; transpose_item(w_branch + (size_t)ln * BWID * DM, DM, W2 + (size_t)ll * 3 * DM * BWID, 3 * BWID, n * BWID, 0, false, (LAS float*)vl, r % I2, lane); continue; } r -= 6 * I2;
                        { const int ll = r / I3; transpose_item(w_out + (size_t)ll * DM * DM, DM, W3 + (size_t)ll * DM * DM, DM, 0, 0, false, (LAS float*)vl, r % I3, lane); }
                    }
                }
#undef WQ_GRAB
#undef WQ_ITEM
                if (l == 0) TSTAMP(15);
#if TP_A >= 0
                if (l == 0) { __syncthreads(); TSTAMP(5); }
#endif
            } else if constexpr (k == 2) {
                pg8::Gemm g{U + 5 * (ARRB / 2), (bf16_t*)(ws + WS_W2) + (size_t)l * 3 * DM * BWID, MTOK, DM, 3 * BWID, 0}; pg8::StaticOrder S; S.init(MTOK, DM, G, bx);
                EpiBranch E{ws};
                pg8::gemm_phase<EpiBranch, pg8::StaticOrder, true, true>(lds, g, S, E);
            } else if constexpr (k == 3) {
                pg8::Gemm g{H, (bf16_t*)(ws + WS_W3) + (size_t)l * DM * DM, MTOK, DM, DM, 0}; pg8::StaticOrder S; S.init(MTOK, DM, G, bx);
                if (G == 256) {
                    const float* x = as_global(A->in[0]); const float* pre_g = as_global(A->in[1]); const float* post_g = as_global(A->in[9]); float* out = as_global(A->out);
                    float* xb = (float*)(ws + WS_RS); unsigned* cn = (unsigned*)(ws + WS_CTL + CTL_CNT);
                    if constexpr (l + 1 < NLAYER) {
                        EpiNorm2 E{x, out, H, post_g + l * DM, pre_g + (l + 1) * DM, RmsPanel{xb, cn}, RmsPanel{xb + (size_t)MTOK * 4, cn + 64 * 64}};
                        pg8::gemm_phase<EpiNorm2, pg8::StaticOrder, false, true>(lds, g, S, E);
                    } else {
                        EpiNorm1 E{out, post_g + l * DM, RmsPanel{xb + (size_t)2 * MTOK * 4, cn + 2 * 64 * 64}};
                        pg8::gemm_phase<EpiNorm1, pg8::StaticOrder, false, true>(lds, g, S, E);
                    }
                } else {
                    EpiOut E{ws};
                    pg8::gemm_phase<EpiOut, pg8::StaticOrder, true, true>(lds, g, S, E);
                }
            } else {
                const float* x = as_global(A->in[0]); const float* pre_g = as_global(A->in[1]); const float* post_g = as_global(A->in[9]); float* out = as_global(A->out);
                const float* F32T = (const float*)(ws + WS_U); const float* RS = (const float*)(ws + WS_RS);
                const float* xin = (l == 0) ? x : out; const float* gnext = (l + 1 < NLAYER) ? pre_g + (l + 1) * DM : nullptr;
                if (G != 256) for (int m = gw; m < MTOK; m += 2 * NGW) norm_rows<2>(F32T, RS, xin, post_g + l * DM, out, gnext, H, m, NGW, lane);
            }
        }
}
__global__ void __launch_bounds__(512, 2) hybrid_fwd(Args a_) {
    extern __shared__ __attribute__((aligned(16))) unsigned char lds_raw[];
    LAS unsigned char* lds = (LAS unsigned char*)lds_raw;
    cg::grid_group grid = cg::this_grid();
    if (threadIdx.x < 64) ((LAS unsigned*)(lds + 147200))[threadIdx.x] = 0u;
    __syncthreads();
    (void)xcd_barrier_post((unsigned*)(a_.ws + WS_CTL), (volatile LAS unsigned*)(lds + 147200 + 32));
#define SEAM_BAR() do { XcdBarrier b_; b_.bar = (unsigned*)(a_.ws + WS_CTL); b_.x = xb_xcc_id(); b_.st = (volatile LAS unsigned*)(lds + 147200 + 32); xcd_barrier(b_); } while (0)
    const int lo = a_.ph_lo, hi = a_.ph_hi < 0 ? -a_.ph_hi : a_.ph_hi;
#define PHASE(k) if (lo <= (k) && (k) < hi && !(((k) == 5 || (k) == 10) && gridDim.x == 256)) { if ((k) > lo) { if ((k) == 1 && lo < 0) grid.sync(); else SEAM_BAR(); } TSTAMP(k); run_phase<(k)>(a_, lds); }
    PHASE(0) PHASE(1) PHASE(2) PHASE(3) PHASE(4) PHASE(5) PHASE(6) PHASE(7) PHASE(8) PHASE(9) PHASE(10)
#undef PHASE
#if TP_A >= 0
    SEAM_BAR(); TSTAMP(11);
    if (blockIdx.x == TP_BLK && threadIdx.x == 0) { volatile LAS unsigned long long* ts = (volatile LAS unsigned long long*)(lds + 147264); a_.out[0] += (float)(ts[TP_B] - ts[TP_A]) * (0.00005f * TP_SCALE); }
#endif
}

extern "C" void kernel_launch(void* const* d_in, const int* in_sizes, int n_in, void* d_out, int out_size, void* d_ws, size_t ws_size, hipStream_t stream) {
    static int grid = 0;
    if (grid == 0) {
        if (n_in != 10 || out_size != MTOK * DM || ws_size < WS_END) { fprintf(stderr, "kernel_launch: unexpected shapes / workspace (n_in %d out %d ws %zu)\n", n_in, out_size, ws_size); grid = -1; return; }
        int dev = 0, cus = 0, per_cu = 0;
        (void)hipGetDevice(&dev); (void)hipDeviceGetAttribute(&cus, hipDeviceAttributeMultiprocessorCount, dev);
        (void)hipFuncSetAttribute((const void*)hybrid_fwd, hipFuncAttributeMaxDynamicSharedMemorySize, LDS_BYTES);
        (void)hipOccupancyMaxActiveBlocksPerMultiprocessor(&per_cu, (const void*)hybrid_fwd, 512, LDS_BYTES);
        (void)hipGetLastError();
        if (per_cu < 1) { fprintf(stderr, "kernel_launch: occupancy query says %d blocks/CU\n", per_cu); per_cu = 1; }
        grid = cus;
    }
    if (grid < 0) return;
    if (hipMemsetAsync((char*)d_ws + WS_CTL, 0, CTL_BYTES, stream) != hipSuccess) { fprintf(stderr, "kernel_launch: memset of the barrier words failed\n"); return; }
    Args a{};
    for (int i = 0; i < 10; ++i) a.in[i] = (const float*)d_in[i];
    a.out = (float*)d_out; a.ws = (unsigned char*)d_ws;
#if ONE_LAUNCH
    a.ph_lo = 0; a.ph_hi = NPHASE;
    void* args[] = {&a};
    hipError_t e = hipLaunchCooperativeKernel((const void*)hybrid_fwd, dim3(grid), dim3(512), args, LDS_BYTES, stream);
    if (e != hipSuccess) fprintf(stderr, "cooperative launch failed: %s (grid %d)\n", hipGetErrorString(e), grid);
#else
    for (int ph = 0; ph < NPHASE; ++ph) { a.ph_lo = ph; a.ph_hi = ph + 1;
#if MIX_PROBE
        if (ph == 2) { a.ph_hi = -(ph + 1); hipLaunchKernelGGL(hybrid_fwd, dim3(grid), dim3(512), LDS_BYTES, stream, a); a.ph_hi = ph + 1; }
#endif
        for (int rep = 0; rep < 1 + ((DUP_MASK >> ph) & 1); ++rep) hipLaunchKernelGGL(hybrid_fwd, dim3(grid), dim3(512), LDS_BYTES, stream, a); }
#endif
}
```

```cpp
#include <hip/hip_runtime.h>
#include <hip/hip_cooperative_groups.h>
#include <cstdio>
#include <cstdint>
namespace cg = cooperative_groups;
#ifndef ONE_LAUNCH
#define ONE_LAUNCH 1
#endif
#ifndef DUP_MASK
#define DUP_MASK 0
#endif
#ifndef MIX_PROBE
#define MIX_PROBE 0
#endif
#ifndef TP_A
#define TP_A -1
#define TP_B -1
#endif
#ifndef TP_SCALE
#define TP_SCALE 1
#endif
#ifndef TP_BLK
#define TP_BLK 0
#endif
namespace pg8 {
#define PG8_LAS __attribute__((address_space(3)))
typedef unsigned short bf16_t;
typedef short bf16x8 __attribute__((ext_vector_type(8)));
typedef float f32x4 __attribute__((ext_vector_type(4)));
typedef unsigned u32x4 __attribute__((ext_vector_type(4)));
constexpr int BM = 256, BK = 64, HALF = 128, HTB = HALF * BK * 2  , STAGE_BYTES = 8 * HTB, NXCD = 8, WGM = 8;

__host__ __device__ __forceinline__ int lds_byte(int r, int c) { const int st = (r >> 4) * 2 + (c >> 5), rr = r & 15, cc = c & 31, ob = rr * 64 + cc * 2; return st * 1024 + (ob ^ (((ob >> 9) & 1) << 5)); }
__host__ __device__ __forceinline__ void stage_rc(int b, int& R, int& C) { const int st = b / 1024, sb = b % 1024, swz = sb ^ (((sb >> 9) & 1) << 5); R = (st >> 1) * 16 + swz / 64; C = (st & 1) * 32 + (swz % 64) / 2; }
__host__ __device__ __forceinline__ int perm32(int rho) { const int n = rho >> 4, i = rho & 15; return 8 * (i >> 2) + 4 * n + (i & 3); }

struct Unit { int pm, pn, az; };
struct Gemm { const bf16_t* A; const bf16_t* Bt; int M, N, K; size_t azs; };

struct StaticOrder {
    int nM, nN, nwg, G, c;
    __host__ __device__ void init(int M, int N, int G_, int c_) { nM = M / BM; nN = N / BM; nwg = nM * nN; G = G_; c = c_; }
    __host__ __device__ bool next(int i, Unit& u) const {
        const long L = (long)i * G + c; if (L >= nwg) return false;
        int wgid = (int)L; { const int q = nwg / NXCD, r = nwg % NXCD, xcd = wgid % NXCD, off = wgid / NXCD; wgid = (xcd < r ? xcd * (q + 1) : r * (q + 1) + (xcd - r) * q) + off; }
        const int nig = WGM * nN, gid = wgid / nig, fm = gid * WGM, gsz = (nM - fm) < WGM ? (nM - fm) : WGM;
        u.pm = fm + ((wgid % nig) % gsz); u.pn = (wgid % nig) / gsz; u.az = 0; return true;
    }
    __device__ __forceinline__ void a_ready(const Unit&) const {}
    __device__ __forceinline__ void done(const Unit&) const {}
};

__device__ __forceinline__ unsigned cvt_pk_bf16(float lo, float hi) { unsigned r; asm volatile("v_cvt_pk_bf16_f32 %0, %1, %2" : "=v"(r) : "v"(lo), "v"(hi)); return r; }
template <class Epi, class Sched, bool ALIGN_EPI = false, bool SP2 = false>
__device__ __forceinline__ void gemm_phase(PG8_LAS unsigned char* lds, const Gemm g, const Sched& S, const Epi& E) {
    const int tid = threadIdx.x, wid = __builtin_amdgcn_readfirstlane(tid >> 6), lane = tid & 63, wr = wid >> 2, wc = wid & 3, fr = lane & 15, fq = lane >> 4;
    const int K = g.K, nt = K / BK;
    unsigned voffA[2], voffB[2];
#pragma unroll
    for (int i = 0; i < 2; ++i) { int R, C; stage_rc(tid * 16 + i * 8192, R, C); const int Rb = Epi::PERM ? ((R & ~31) + perm32(R & 31)) : R;
        voffA[i] = (unsigned)(R * K + C) * 2u; voffB[i] = (unsigned)(Rb * K + C) * 2u; }
    const size_t kstep = (size_t)(BK * 2);
    const size_t hstep = (size_t)HALF * K * 2;
    const size_t tstep = 2 * hstep;
    const unsigned ldsw = (unsigned)wid * 1024u;
    const int aoff = lds_byte(wr * 64 + fr, fq * 8), boff = lds_byte(wc * 32 + fr, fq * 8);
#define PG8_SA(b, h) (((b) * 2 + (h)) * HTB)
#define PG8_SB(b, h) ((4 + (b) * 2 + (h)) * HTB)
#define PG8_STAGE(bufoff, gbase, voff) do { _Pragma("unroll") for (int _i = 0; _i < 2; ++_i) \
        __builtin_amdgcn_global_load_lds((const unsigned*)((const char*)(gbase) + (voff)[_i]), (PG8_LAS unsigned*)(lds + (bufoff) + ldsw + _i * 8192), 16, 0, 0); } while (0)
#define PG8_LDA(dst, b, h) do { _Pragma("unroll") for (int m = 0; m < 4; ++m) _Pragma("unroll") for (int k = 0; k < 2; ++k) dst[m][k] = *(const PG8_LAS bf16x8*)(lds + PG8_SA(b, h) + aoff + m * 2048 + k * 1024); } while (0)
#define PG8_LDB(dst, b, h) do { _Pragma("unroll") for (int n = 0; n < 2; ++n) _Pragma("unroll") for (int k = 0; k < 2; ++k) dst[n][k] = *(const PG8_LAS bf16x8*)(lds + PG8_SB(b, h) + boff + n * 2048 + k * 1024); } while (0)
#define PG8_MMA(ai, bj, At, Bt) do { __builtin_amdgcn_s_setprio(1); _Pragma("unroll") for (int m = 0; m < 4; ++m) _Pragma("unroll") for (int n = 0; n < 2; ++n) _Pragma("unroll") for (int k = 0; k < 2; ++k) \
        acc[ai][bj][m][n] = __builtin_amdgcn_mfma_f32_16x16x32_bf16(Bt[n][k], At[m][k], acc[ai][bj][m][n], 0, 0, 0); __builtin_amdgcn_s_setprio(0); } while (0)
#define PG8_WAIT_V(n) asm volatile("s_waitcnt vmcnt(" #n ")" ::: "memory")
#define PG8_WAIT_L(n) asm volatile("s_waitcnt lgkmcnt(" #n ")" ::: "memory")
#define PG8_BAR __builtin_amdgcn_s_barrier()
#define PG8_SCHED __builtin_amdgcn_sched_barrier(0)
    Unit cur, nxt; int ui = 0;
    if (!S.next(0, cur)) return;
    f32x4 acc[2][2][4][2];
#pragma unroll
    for (int a = 0; a < 2; ++a)
#pragma unroll
        for (int b = 0; b < 2; ++b)
#pragma unroll
            for (int m = 0; m < 4; ++m)
#pragma unroll
                for (int n = 0; n < 2; ++n) acc[a][b][m][n] = (f32x4){0.f, 0.f, 0.f, 0.f};
    bf16x8 At[4][2], B0[2][2], B1[2][2];
    const char* cA = (const char*)g.A + (size_t)cur.pm * tstep + (size_t)cur.az * g.azs; const char* cB = (const char*)g.Bt + (size_t)cur.pn * tstep;
    S.a_ready(cur);
    if constexpr (SP2) {
        PG8_STAGE(PG8_SB(0, 0), cB, voffB); PG8_STAGE(PG8_SB(0, 1), cB + hstep, voffB); PG8_STAGE(PG8_SA(0, 0), cA, voffA); PG8_STAGE(PG8_SA(0, 1), cA + hstep, voffA);
        if (wr == 1) PG8_BAR;
        PG8_WAIT_V(2); PG8_BAR;
        PG8_STAGE(PG8_SB(1, 0), cB + kstep, voffB); PG8_STAGE(PG8_SA(1, 0), cA + kstep, voffA); PG8_STAGE(PG8_SB(1, 1), cB + hstep + kstep, voffB);
        PG8_WAIT_V(6); PG8_BAR;
    } else {
        PG8_STAGE(PG8_SB(0, 0), cB, voffB); PG8_STAGE(PG8_SA(0, 0), cA, voffA); PG8_STAGE(PG8_SB(0, 1), cB + hstep, voffB); PG8_STAGE(PG8_SA(0, 1), cA + hstep, voffA);
        if (wr == 1) PG8_BAR;
        PG8_WAIT_V(4); PG8_BAR;
        PG8_STAGE(PG8_SB(1, 0), cB + kstep, voffB); PG8_STAGE(PG8_SA(1, 0), cA + kstep, voffA); PG8_STAGE(PG8_SB(1, 1), cB + hstep + kstep, voffB);
        PG8_WAIT_V(6); PG8_BAR;
    }
    for (;;) {
        const bool has_next = S.next(ui + 1, nxt);
        const char* nA = has_next ? (const char*)g.A + (size_t)nxt.pm * tstep + (size_t)nxt.az * g.azs : cA; const char* nB = has_next ? (const char*)g.Bt + (size_t)nxt.pn * tstep : cB;
        for (int t = 0; t < nt; t += 2) {
            if constexpr (Epi::MIDK) { if (t == 8 || t == 16) E.mid(acc, cur, t >> 3, wr, wc, fr, fq); }
            const bool last = (t == nt - 2);
            const char* a1 = cA + (size_t)(t + 1) * kstep;
            const char* a2 = last ? nA : cA + (size_t)(t + 2) * kstep; const char* b2 = last ? nB : cB + (size_t)(t + 2) * kstep;
            const char* a3 = a2 + kstep; const char* b3 = b2 + kstep;
            if (last && has_next) S.a_ready(nxt);
            if constexpr (SP2) {
            PG8_LDB(B0, 0, 0); PG8_LDB(B1, 0, 1); PG8_SCHED; PG8_LDA(At, 0, 0); PG8_STAGE(PG8_SA(1, 1), a1 + hstep, voffA);
            PG8_WAIT_V(8); PG8_WAIT_L(0); PG8_BAR; PG8_MMA(0, 0, At, B0); PG8_MMA(0, 1, At, B1); PG8_BAR; PG8_SCHED;
            PG8_LDA(At, 0, 1); PG8_STAGE(PG8_SB(0, 0), b2, voffB); PG8_STAGE(PG8_SB(0, 1), b2 + hstep, voffB); PG8_STAGE(PG8_SA(0, 0), a2, voffA);
            PG8_WAIT_V(8); PG8_WAIT_L(0); PG8_BAR; PG8_MMA(1, 0, At, B0); PG8_MMA(1, 1, At, B1); PG8_BAR; PG8_SCHED;
            PG8_LDB(B0, 1, 0); PG8_LDB(B1, 1, 1); PG8_SCHED; PG8_LDA(At, 1, 0); PG8_STAGE(PG8_SA(0, 1), a2 + hstep, voffA);
            PG8_WAIT_V(8); PG8_WAIT_L(0); PG8_BAR; PG8_MMA(0, 0, At, B0); PG8_MMA(0, 1, At, B1); PG8_BAR; PG8_SCHED;
            PG8_LDA(At, 1, 1); PG8_STAGE(PG8_SB(1, 0), b3, voffB); PG8_STAGE(PG8_SB(1, 1), b3 + hstep, voffB); PG8_STAGE(PG8_SA(1, 0), a3, voffA);
            PG8_WAIT_V(8); PG8_WAIT_L(0); PG8_BAR; PG8_MMA(1, 0, At, B0); PG8_MMA(1, 1, At, B1); PG8_BAR; PG8_SCHED;
            } else {
            PG8_LDB(B0, 0, 0); PG8_SCHED; PG8_LDA(At, 0, 0); PG8_STAGE(PG8_SA(1, 1), a1 + hstep, voffA);
            PG8_WAIT_L(8); PG8_BAR; PG8_WAIT_L(0); PG8_MMA(0, 0, At, B0); PG8_BAR; PG8_SCHED;
            PG8_LDB(B1, 0, 1); PG8_STAGE(PG8_SB(0, 0), b2, voffB);
            PG8_BAR; PG8_WAIT_L(0); PG8_MMA(0, 1, At, B1); PG8_BAR;
            PG8_LDA(At, 0, 1); PG8_STAGE(PG8_SA(0, 0), a2, voffA);
            PG8_BAR; PG8_WAIT_L(0); PG8_MMA(1, 0, At, B0); PG8_BAR; PG8_SCHED;
            PG8_STAGE(PG8_SB(0, 1), b2 + hstep, voffB);
            PG8_WAIT_V(6); PG8_BAR; PG8_MMA(1, 1, At, B1); PG8_BAR;
            PG8_LDB(B0, 1, 0); PG8_SCHED; PG8_LDA(At, 1, 0); PG8_STAGE(PG8_SA(0, 1), a2 + hstep, voffA);
            PG8_WAIT_L(8); PG8_BAR; PG8_WAIT_L(0); PG8_MMA(0, 0, At, B0); PG8_BAR; PG8_SCHED;
            PG8_LDB(B1, 1, 1); PG8_STAGE(PG8_SB(1, 0), b3, voffB);
            PG8_BAR; PG8_WAIT_L(0); PG8_MMA(0, 1, At, B1); PG8_BAR;
            PG8_LDA(At, 1, 1); PG8_STAGE(PG8_SA(1, 0), a3, voffA);
            PG8_BAR; PG8_WAIT_L(0); PG8_MMA(1, 0, At, B0); PG8_BAR; PG8_SCHED;
            PG8_STAGE(PG8_SB(1, 1), b3 + hstep, voffB);
            PG8_WAIT_V(6); PG8_BAR; PG8_MMA(1, 1, At, B1); PG8_BAR;
            }
        }
        if constexpr (ALIGN_EPI) { if (wr == 0) PG8_BAR; }
        if constexpr (!Epi::AFTER_DRAIN) { E(acc, cur, wr, wc, fr, fq); S.done(cur); }
        if (!has_next) break;
#pragma unroll
        for (int a = 0; a < 2; ++a)
#pragma unroll
            for (int b = 0; b < 2; ++b)
#pragma unroll
                for (int m = 0; m < 4; ++m)
#pragma unroll
                    for (int n = 0; n < 2; ++n) acc[a][b][m][n] = (f32x4){0.f, 0.f, 0.f, 0.f};
        cur = nxt; cA = nA; cB = nB; ++ui;
        if constexpr (ALIGN_EPI) { if (wr == 1) PG8_BAR; }
    }
    PG8_WAIT_V(0);
    if constexpr (!ALIGN_EPI) { if (wr == 0) PG8_BAR; }
    PG8_BAR;
    if constexpr (Epi::AFTER_DRAIN) { E.fused(acc, cur, wr, wc, fr, fq, lds, wid, lane); S.done(cur); }
#undef PG8_SA
#undef PG8_SB
#undef PG8_STAGE
#undef PG8_LDA
#undef PG8_LDB
#undef PG8_MMA
#undef PG8_WAIT_V
#undef PG8_WAIT_L
#undef PG8_BAR
#undef PG8_SCHED
}
}

#define LAS __attribute__((address_space(3)))
typedef unsigned short bf16_t;
typedef short bf16x8 __attribute__((ext_vector_type(8)));
typedef short s16x4 __attribute__((ext_vector_type(4)));
typedef float f32x4 __attribute__((ext_vector_type(4)));
typedef float f32x16 __attribute__((ext_vector_type(16)));
typedef unsigned u32x4 __attribute__((ext_vector_type(4)));
typedef unsigned u32x2 __attribute__((ext_vector_type(2)));
constexpr int NB = 4, SEQ = 4096, DM = 1024, MTOK = NB * SEQ, NIN = 8192, BWID = 512, NLAYER = 2;
constexpr float RMS_EPS = 1e-6f;
constexpr size_t MiB = 1u << 20;
constexpr size_t WS_RS = 0;
constexpr size_t WS_W1 = 2 * MiB;
constexpr size_t WS_W2 = 34 * MiB;
constexpr size_t WS_W3 = 40 * MiB;
constexpr size_t WS_PW = 44 * MiB;
constexpr size_t WS_H = 45 * MiB;
constexpr size_t WS_U = 77 * MiB;
constexpr size_t ARRB = 16 * MiB;
constexpr size_t WS_MG = 205 * MiB;
constexpr size_t WS_END = 253 * MiB;
constexpr int LDS_BYTES = 147456;
constexpr int NPHASE = 1 + 5 * NLAYER;

__device__ __forceinline__ unsigned f2bf(float f) { unsigned u = __builtin_bit_cast(unsigned, f); return (u + 0x7fffu + ((u >> 16) & 1u)) >> 16; }
__device__ __forceinline__ unsigned pk2(float lo, float hi) { return f2bf(lo) | (f2bf(hi) << 16); }
__device__ __forceinline__ float bflo(unsigned u) { return __builtin_bit_cast(float, u << 16); }
__device__ __forceinline__ float bfhi(unsigned u) { return __builtin_bit_cast(float, u & 0xffff0000u); }
__device__ __forceinline__ float sigmoid_f(float x) { return __builtin_amdgcn_rcpf(1.f + __builtin_amdgcn_exp2f(-1.4426950408889634f * x)); }
__device__ __forceinline__ float silu_f(float x) { return x * sigmoid_f(x); }
__device__ __forceinline__ unsigned q8(float x) { const unsigned q = (unsigned)(sigmoid_f(x) * 255.f + 0.5f); return q < 1u ? 1u : q; }
__device__ __forceinline__ float wave_sum(float v) {
#pragma unroll
    for (int o = 1; o < 64; o <<= 1) v += __shfl_xor(v, o);
    return v;
}

constexpr size_t WS_CTL = 1 * MiB; constexpr size_t CTL_BYTES = 65536;
constexpr size_t CTL_CNT = 16384;
#define XB_TMO      128
#define XB_XCNT(j)  (256  + 64 * (j))
#define XB_XSUB(j)  (1280 + 64 * (j))
#define XB_XGEN(j)  (2304 + 64 * (j))
#define XB_TOP      3328
#define XB_TOPGEN   3392
#define XCD_BAR_WORDS 3456
#define XB_SPIN_CAP (1u << 18)

__device__ __forceinline__ unsigned xb_ld(unsigned* p)              { return __hip_atomic_load(p, __ATOMIC_RELAXED, __HIP_MEMORY_SCOPE_AGENT); }
__device__ __forceinline__ unsigned xb_add(unsigned* p, unsigned v) { return __hip_atomic_fetch_add(p, v, __ATOMIC_RELAXED, __HIP_MEMORY_SCOPE_AGENT); }
__device__ __forceinline__ unsigned xb_xcc_id() { return (unsigned)__builtin_amdgcn_s_getreg((3 << 11) | 20) & 0xFu; }
#define XB_SPIN(cond, bar) do { unsigned _sp = 0; while (cond) { __builtin_amdgcn_s_sleep(1); \
    if ((++_sp & 255u) == 0u) { if (xb_ld(&(bar)[XB_TMO])) break; if (_sp > XB_SPIN_CAP) { atomicAdd(&(bar)[XB_TMO], 1u); break; } } } } while (0)

struct XcdBarrier {
    unsigned* bar; unsigned x;
    volatile LAS unsigned* st;
};

__device__ __forceinline__ XcdBarrier xcd_barrier_post(unsigned* bar, volatile LAS unsigned* st) {
    XcdBarrier b; b.bar = bar; b.x = xb_xcc_id(); b.st = st;
    if (threadIdx.x == 0) (void)xb_add(&bar[XB_XCNT(b.x)], 1u);
    return b;
}
__device__ __forceinline__ void xcd_barrier_complete(unsigned* bar, unsigned x, unsigned& nloc, unsigned& nx) {
    const unsigned G = gridDim.x * gridDim.y * gridDim.z;
    unsigned sum, cnt, mine, sp = 0u;
    for (;;) {
        sum = 0u; cnt = 0u; mine = 0u;
#pragma unroll
        for (unsigned j = 0; j < 16; ++j) { const unsigned c = xb_ld(&bar[XB_XCNT(j)]); sum += c; cnt += (c > 0u) ? 1u : 0u; mine = (j == x) ? c : mine; }
        if (sum == G) break;
        __builtin_amdgcn_s_sleep(1);
        if ((++sp & 255u) == 0u) { if (xb_ld(&bar[XB_TMO])) break; if (sp > XB_SPIN_CAP) { atomicAdd(&bar[XB_TMO], 1u); break; } }
    }
    nloc = mine > 0u ? mine : 1u; nx = cnt > 0u ? cnt : 1u;
}

__device__ __forceinline__ void xcd_barrier(const XcdBarrier& b) {
    asm volatile("s_waitcnt vmcnt(0)" ::: "memory");
    __syncthreads();
    if (threadIdx.x == 0) {
        unsigned* bar = b.bar;
        __builtin_amdgcn_s_waitcnt(0);
        unsigned nloc = b.st[0], nx = b.st[1];
        if (nloc == 0u) { xcd_barrier_complete(bar, b.x, nloc, nx); b.st[0] = nloc; b.st[1] = nx; }
        const unsigned old = xb_add(&bar[XB_XSUB(b.x)], 1u);
        const unsigned gen = old / nloc;
        if (old + 1u == (gen + 1u) * nloc) {
            __builtin_amdgcn_fence(__ATOMIC_RELEASE, "agent");
            asm volatile("s_waitcnt vmcnt(0)" ::: "memory");
            const unsigned og = xb_add(&bar[XB_TOP], 1u);
            const unsigned tg = og / nx;
            if (og + 1u == (tg + 1u) * nx) xb_add(&bar[XB_TOPGEN], 1u);
            else XB_SPIN(xb_ld(&bar[XB_TOPGEN]) == tg, bar);
            __builtin_amdgcn_fence(__ATOMIC_ACQUIRE, "agent");
            xb_add(&bar[XB_XGEN(b.x)], 1u);
            asm volatile("s_waitcnt vmcnt(0)" ::: "memory");
        } else {
            XB_SPIN(xb_ld(&bar[XB_XGEN(b.x)]) == gen, bar);
            __builtin_amdgcn_fence(__ATOMIC_ACQUIRE, "agent");
            asm volatile("s_waitcnt vmcnt(0)" ::: "memory");
        }
    }
    __syncthreads();
}


using pg8::Unit;
struct EpiU {
    static constexpr bool PERM = true, AFTER_DRAIN = false, MIDK = false;
    unsigned char* ws;
    __device__ __forceinline__ void operator()(const f32x4 (&acc)[2][2][4][2], const Unit& u, int wr, int wc, int fr, int fq) const {
        bf16_t* U = (bf16_t*)(ws + WS_U); unsigned char* MG = ws + WS_MG;
        const int pn = u.pn; const int row0 = u.pm * 256 + wr * 64 + fr;
        if (pn >= 20) {
            unsigned char* tb = MG + ((size_t)u.pm * 12 + (pn - 20)) * 65536 + (size_t)(((wr * 4 + wc) * 16) * 64 + (fq * 16 + fr)) * 8;
#pragma unroll
            for (int ai = 0; ai < 2; ++ai)
#pragma unroll
                for (int m = 0; m < 4; ++m)
#pragma unroll
                    for (int bj = 0; bj < 2; ++bj) { const f32x4 v0 = acc[ai][bj][m][0], v1 = acc[ai][bj][m][1]; u32x2 w;
                        w.x = q8(v0[0]) | (q8(v0[1]) << 8) | (q8(v0[2]) << 16) | (q8(v0[3]) << 24); w.y = q8(v1[0]) | (q8(v1[1]) << 8) | (q8(v1[2]) << 16) | (q8(v1[3]) << 24);
                        *(u32x2*)(tb + ((ai * 4 + m) * 2 + bj) * 512) = w; }
        } else if (pn >= 4 && pn < 12) {
            const bool second = pn >= 8; const int ch0 = (pn & 3) * 128 + wc * 32 + 8 * fq;
            bf16_t* O = second ? (U + 5 * (ARRB / 2) + 512) : (U + 1 * (ARRB / 2)); const int pitch = second ? 1536 : 512;
#pragma unroll
            for (int ai = 0; ai < 2; ++ai)
#pragma unroll
                for (int m = 0; m < 4; ++m) { bf16_t* rp = O + (size_t)(row0 + ai * 128 + m * 16) * pitch + ch0;
                    f32x4 a0 = acc[ai][0][m][0], a1 = acc[ai][0][m][1]; const f32x4 b0 = acc[ai][1][m][0], b1 = acc[ai][1][m][1];
                    if (second) {
#pragma unroll
                        for (int i = 0; i < 4; ++i) { a0[i] *= silu_f(b0[i]); a1[i] *= silu_f(b1[i]); } }
                    else { a0 *= b0; a1 *= b1; }
                    u32x4 w; w.x = pg8::cvt_pk_bf16(a0[0], a0[1]); w.y = pg8::cvt_pk_bf16(a0[2], a0[3]); w.z = pg8::cvt_pk_bf16(a1[0], a1[1]); w.w = pg8::cvt_pk_bf16(a1[2], a1[3]);
                    *(u32x4*)rp = w; }
        } else {
            const int kind = pn >> 1; int arr = 0, pitch = 512, coff = 0; bool act = false;
            if (kind == 1) { arr = 5; act = true; pitch = 1536; } else if (kind == 6) arr = 2; else if (kind == 7) arr = 3; else if (kind == 8) arr = 4; else if (kind == 9) { arr = 5; act = true; pitch = 1536; coff = 1024; }
            bf16_t* O = U + (size_t)arr * (ARRB / 2) + coff; const int col0 = (pn & 1) * 256 + wc * 32 + 8 * fq;
#pragma unroll
            for (int ai = 0; ai < 2; ++ai)
#pragma unroll
                for (int m = 0; m < 4; ++m) { bf16_t* rp = O + (size_t)(row0 + ai * 128 + m * 16) * pitch + col0;
#pragma unroll
                    for (int bj = 0; bj < 2; ++bj) { f32x4 v0 = acc[ai][bj][m][0], v1 = acc[ai][bj][m][1];
                        if (act) {
#pragma unroll
                            for (int i = 0; i < 4; ++i) { v0[i] = silu_f(v0[i]); v1[i] = silu_f(v1[i]); } }
                        u32x4 w; w.x = pg8::cvt_pk_bf16(v0[0], v0[1]); w.y = pg8::cvt_pk_bf16(v0[2], v0[3]); w.z = pg8::cvt_pk_bf16(v1[0], v1[1]); w.w = pg8::cvt_pk_bf16(v1[2], v1[3]);
                        *(u32x4*)(rp + bj * 128) = w; } }
        }
    }
};
struct EpiBranch {
    static constexpr bool PERM = true, AFTER_DRAIN = false, MIDK = true;
    unsigned char* ws;
    __device__ __forceinline__ void mid(f32x4 (&acc)[2][2][4][2], const Unit& u, int seg, int wr, int wc, int fr, int fq) const {
        int tid_ = threadIdx.x; asm volatile("" : "+v"(tid_));
        const int wid_ = tid_ >> 6, wr_ = wid_ >> 2, wc_ = wid_ & 3, fr_ = tid_ & 15, fq_ = (tid_ & 63) >> 4;
        const unsigned char* tb = ws + WS_MG + ((size_t)u.pm * 12 + (seg - 1) * 4 + u.pn) * 65536 + (size_t)(((wr_ * 4 + wc_) * 16) * 64 + (fq_ * 16 + fr_)) * 8;
#pragma unroll
        for (int ai = 0; ai < 2; ++ai)
#pragma unroll
            for (int m = 0; m < 4; ++m) {
#pragma unroll
                for (int bj = 0; bj < 2; ++bj) { const unsigned char* rp = tb + ((ai * 4 + m) * 2 + bj) * 512; const u32x2 qa = *(const u32x2*)rp, qb = *(const u32x2*)(rp + 4 * 65536);
                    f32x4 r0, r1;
                    r0[0] = (float)(qa.x & 255u) * __builtin_amdgcn_rcpf((float)(qb.x & 255u)); r0[1] = (float)((qa.x >> 8) & 255u) * __builtin_amdgcn_rcpf((float)((qb.x >> 8) & 255u));
                    r0[2] = (float)((qa.x >> 16) & 255u) * __builtin_amdgcn_rcpf((float)((qb.x >> 16) & 255u)); r0[3] = (float)(qa.x >> 24) * __builtin_amdgcn_rcpf((float)(qb.x >> 24));
                    r1[0] = (float)(qa.y & 255u) * __builtin_amdgcn_rcpf((float)(qb.y & 255u)); r1[1] = (float)((qa.y >> 8) & 255u) * __builtin_amdgcn_rcpf((float)((qb.y >> 8) & 255u));
                    r1[2] = (float)((qa.y >> 16) & 255u) * __builtin_amdgcn_rcpf((float)((qb.y >> 16) & 255u)); r1[3] = (float)(qa.y >> 24) * __builtin_amdgcn_rcpf((float)(qb.y >> 24));
                    acc[ai][bj][m][0] *= r0; acc[ai][bj][m][1] *= r1; }
                if (m == 3) asm volatile("" ::: "memory"); }
    }
    __device__ __forceinline__ void operator()(const f32x4 (&acc)[2][2][4][2], const Unit& u, int wr, int wc, int fr, int fq) const {
        bf16_t* merged = (bf16_t*)(ws + WS_H);
        const unsigned char* tb = ws + WS_MG + ((size_t)u.pm * 12 + 8 + u.pn) * 65536 + (size_t)(((wr * 4 + wc) * 16) * 64 + (fq * 16 + fr)) * 8;
        const int row0 = u.pm * 256 + wr * 64 + fr, col0 = u.pn * 256 + wc * 32 + 8 * fq;
        u32x2 gq[2][4][2];
#pragma unroll
        for (int ai = 0; ai < 2; ++ai)
#pragma unroll
            for (int m = 0; m < 4; ++m)
#pragma unroll
                for (int bj = 0; bj < 2; ++bj) gq[ai][m][bj] = *(const u32x2*)(tb + ((ai * 4 + m) * 2 + bj) * 512);
#pragma unroll
        for (int ai = 0; ai < 2; ++ai)
#pragma unroll
            for (int m = 0; m < 4; ++m) { const size_t row = (size_t)(row0 + ai * 128 + m * 16);
#pragma unroll
                for (int bj = 0; bj < 2; ++bj) { const int col = col0 + bj * 128; const u32x2 g = gq[ai][m][bj];
                    f32x4 g0, g1; const float k = 1.f / 255.f;
                    g0[0] = (float)(g.x & 255u) * k; g0[1] = (float)((g.x >> 8) & 255u) * k; g0[2] = (float)((g.x >> 16) & 255u) * k; g0[3] = (float)(g.x >> 24) * k;
                    g1[0] = (float)(g.y & 255u) * k; g1[1] = (float)((g.y >> 8) & 255u) * k; g1[2] = (float)((g.y >> 16) & 255u) * k; g1[3] = (float)(g.y >> 24) * k;
                    const f32x4 v0 = acc[ai][bj][m][0] * g0, v1 = acc[ai][bj][m][1] * g1;
                    u32x4 w; w.x = pg8::cvt_pk_bf16(v0[0], v0[1]); w.y = pg8::cvt_pk_bf16(v0[2], v0[3]); w.z = pg8::cvt_pk_bf16(v1[0], v1[1]); w.w = pg8::cvt_pk_bf16(v1[2], v1[3]);
                    *(u32x4*)(merged + row * 1024 + col) = w; } }
    }
};
struct EpiOut {
    static constexpr bool PERM = false, AFTER_DRAIN = false, MIDK = false;
    unsigned char* ws;
    __device__ __forceinline__ void operator()(const f32x4 (&acc)[2][2][4][2], const Unit& u, int wr, int wc, int fr, int fq) const {
        float* out = (float*)(ws + WS_U); float* rs = (float*)(ws + WS_RS);
        const int row0 = u.pm * 256 + wr * 64 + fr, col0 = u.pn * 256 + wc * 32 + 4 * fq;
#pragma unroll
        for (int ai = 0; ai < 2; ++ai)
#pragma unroll
            for (int m = 0; m < 4; ++m) { const size_t row = (size_t)(row0 + ai * 128 + m * 16); float ss = 0.f;
#pragma unroll
                for (int bj = 0; bj < 2; ++bj)
#pragma unroll
                    for (int n = 0; n < 2; ++n) { const f32x4 v = acc[ai][bj][m][n]; *(f32x4*)(out + row * 1024 + col0 + bj * 128 + n * 16) = v; ss += (v[0] * v[0] + v[1] * v[1]) + (v[2] * v[2] + v[3] * v[3]); }
                ss += __shfl_xor(ss, 16); ss += __shfl_xor(ss, 32);
                if (fq == 0) rs[row * 16 + u.pn * 4 + wc] = ss; }
    }
};

struct RmsPanel {
    float* xbuf;
    unsigned* cnt;
    __device__ __forceinline__ void run(const f32x4 (&v)[2][2][4][2], const Unit& u, int wr, int wc, int fr, int fq, LAS unsigned char* lds, int wid, int lane) const {
        LAS float* P = (LAS float*)lds; LAS float* S = (LAS float*)(lds + 8192);
#pragma unroll
        for (int ai = 0; ai < 2; ++ai)
#pragma unroll
            for (int m = 0; m < 4; ++m) { float s = 0.f;
#pragma unroll
                for (int bj = 0; bj < 2; ++bj)
#pragma unroll
                    for (int n = 0; n < 2; ++n) { const f32x4 x = v[ai][bj][m][n]; s += (x[0] * x[0] + x[1] * x[1]) + (x[2] * x[2] + x[3] * x[3]); }
                s += __shfl_xor(s, 16); s += __shfl_xor(s, 32);
                if (fq == 0) P[(ai * 128 + wr * 64 + m * 16 + fr) * 4 + wc] = s; }
        asm volatile("s_waitcnt lgkmcnt(0)" ::: "memory"); __builtin_amdgcn_s_barrier(); asm volatile("" ::: "memory");
        const int row = wid * 32 + (lane & 31);
        if (lane < 32) { const float t = (P[row * 4 + 0] + P[row * 4 + 1]) + (P[row * 4 + 2] + P[row * 4 + 3]);
            __hip_atomic_store(xbuf + (size_t)(u.pm * 256 + row) * 4 + u.pn, t, __ATOMIC_RELAXED, __HIP_MEMORY_SCOPE_AGENT); }
        asm volatile("s_waitcnt vmcnt(0)" ::: "memory");
        if (lane == 0) __hip_atomic_fetch_add(cnt + 64 * u.pm, 1u, __ATOMIC_RELAXED, __HIP_MEMORY_SCOPE_AGENT);
        if (wid == 0) {
            unsigned sp = 0;
            while ((unsigned)__builtin_amdgcn_readfirstlane(__hip_atomic_load(cnt + 64 * u.pm, __ATOMIC_RELAXED, __HIP_MEMORY_SCOPE_AGENT)) < 32u) { __builtin_amdgcn_s_sleep(2); if (++sp > (1u << 22)) break; }
            __builtin_amdgcn_fence(__ATOMIC_ACQUIRE, "agent");
        }
        asm volatile("s_waitcnt vmcnt(0) lgkmcnt(0)" ::: "memory"); __builtin_amdgcn_s_barrier(); asm volatile("" ::: "memory");
        if (lane < 32) { const float* slot = xbuf + (size_t)(u.pm * 256 + row) * 4; float t = 0.f;
#pragma unroll
            for (int k = 0; k < 4; ++k) t += __hip_atomic_load(slot + k, __ATOMIC_RELAXED, __HIP_MEMORY_SCOPE_AGENT);
            S[row] = 1.0f / sqrtf(t * (1.f / DM) + RMS_EPS); }
        asm volatile("s_waitcnt lgkmcnt(0)" ::: "memory"); __builtin_amdgcn_s_barrier(); asm volatile("" ::: "memory");
    }
};
struct EpiNorm1 {
    static constexpr bool PERM = false, AFTER_DRAIN = true, MIDK = false;
    float* out; const float* gpost; RmsPanel st;
    __device__ __forceinline__ void operator()(const f32x4 (&)[2][2][4][2], const Unit&, int, int, int, int) const {}
    __device__ __forceinline__ void fused(f32x4 (&acc)[2][2][4][2], const Unit& u, int wr, int wc, int fr, int fq, LAS unsigned char* lds, int wid, int lane) const {
        const LAS float* S = (const LAS float*)(lds + 8192);
        const int col0 = u.pn * 256 + wc * 32 + 4 * fq;
        f32x4 gp[2][2]; u32x2 pre[2][4][2][2];
#pragma unroll
        for (int bj = 0; bj < 2; ++bj)
#pragma unroll
            for (int n = 0; n < 2; ++n) gp[bj][n] = *(const f32x4*)(gpost + col0 + bj * 128 + n * 16);
#pragma unroll
        for (int ai = 0; ai < 2; ++ai)
#pragma unroll
            for (int m = 0; m < 4; ++m) {
#pragma unroll
                for (int bj = 0; bj < 2; ++bj)
#pragma unroll
                    for (int n = 0; n < 2; ++n) pre[ai][m][bj][n] = __builtin_nontemporal_load((const u32x2*)((const unsigned char*)out + (size_t)(u.pm * 256 + wid * 32 + ((ai * 4 + m) * 2 + bj) * 2 + n) * 4096 + u.pn * 1024 + lane * 8)); }
        st.run(acc, u, wr, wc, fr, fq, lds, wid, lane);
#pragma unroll
        for (int ai = 0; ai < 2; ++ai)
#pragma unroll
            for (int m = 0; m < 4; ++m) { const int r = ai * 128 + wr * 64 + m * 16 + fr; const float rs = S[r]; const size_t off = (size_t)(u.pm * 256 + r) * DM + col0;
#pragma unroll
                for (int bj = 0; bj < 2; ++bj)
#pragma unroll
                    for (int n = 0; n < 2; ++n) { const u32x2 p = pre[ai][m][bj][n]; const f32x4 bs = (f32x4){bflo(p.x), bfhi(p.x), bflo(p.y), bfhi(p.y)};
                        *(f32x4*)(out + off + bj * 128 + n * 16) = bs + acc[ai][bj][m][n] * rs * gp[bj][n]; } }
    }
};
struct EpiNorm2 {
    static constexpr bool PERM = false, AFTER_DRAIN = true, MIDK = false;
    const float* base; float* out; bf16_t* hn; const float* gpost; const float* gnext; RmsPanel st1, st2;
    __device__ __forceinline__ void operator()(const f32x4 (&)[2][2][4][2], const Unit&, int, int, int, int) const {}
    __device__ __forceinline__ void fused(f32x4 (&acc)[2][2][4][2], const Unit& u, int wr, int wc, int fr, int fq, LAS unsigned char* lds, int wid, int lane) const {
        const LAS float* S = (const LAS float*)(lds + 8192);
        const int col0 = u.pn * 256 + wc * 32 + 4 * fq;
        f32x4 gp[2][2], pre[4][2][2];
#pragma unroll
        for (int bj = 0; bj < 2; ++bj)
#pragma unroll
            for (int n = 0; n < 2; ++n) gp[bj][n] = *(const f32x4*)(gpost + col0 + bj * 128 + n * 16);
#pragma unroll
        for (int m = 0; m < 4; ++m)
#pragma unroll
            for (int bj = 0; bj < 2; ++bj)
#pragma unroll
                for (int n = 0; n < 2; ++n) pre[m][bj][n] = __builtin_nontemporal_load((const f32x4*)(base + (size_t)(u.pm * 256 + wr * 64 + m * 16 + fr) * DM + col0 + bj * 128 + n * 16));
        st1.run(acc, u, wr, wc, fr, fq, lds, wid, lane);
#pragma unroll
        for (int ai = 0; ai < 2; ++ai) {
            if (ai == 1) {
#pragma unroll
                for (int m = 0; m < 4; ++m)
#pragma unroll
                    for (int bj = 0; bj < 2; ++bj)
#pragma unroll
                        for (int n = 0; n < 2; ++n) pre[m][bj][n] = __builtin_nontemporal_load((const f32x4*)(base + (size_t)(u.pm * 256 + 128 + wr * 64 + m * 16 + fr) * DM + col0 + bj * 128 + n * 16));
            }
#pragma unroll
            for (int m = 0; m < 4; ++m) { const int r = ai * 128 + wr * 64 + m * 16 + fr; const float rs = S[r]; const size_t off = (size_t)(u.pm * 256 + r) * DM + col0;
#pragma unroll
                for (int bj = 0; bj < 2; ++bj)
#pragma unroll
                    for (int n = 0; n < 2; ++n) { const f32x4 x1 = pre[m][bj][n] + acc[ai][bj][m][n] * rs * gp[bj][n]; acc[ai][bj][m][n] = x1;
                        u32x2 w; w.x = pg8::cvt_pk_bf16(x1[0], x1[1]); w.y = pg8::cvt_pk_bf16(x1[2], x1[3]);
                        *(u32x2*)((unsigned char*)out + (size_t)(u.pm * 256 + wid * 32 + ((ai * 4 + m) * 2 + bj) * 2 + n) * 4096 + u.pn * 1024 + lane * 8) = w; } }
        }
#pragma unroll
        for (int bj = 0; bj < 2; ++bj)
#pragma unroll
            for (int n = 0; n < 2; ++n) gp[bj][n] = *(const f32x4*)(gnext + col0 + bj * 128 + n * 16);
        st2.run(acc, u, wr, wc, fr, fq, lds, wid, lane);
#pragma unroll
        for (int ai = 0; ai < 2; ++ai)
#pragma unroll
            for (int m = 0; m < 4; ++m) { const int r = ai * 128 + wr * 64 + m * 16 + fr; const float rs = S[r]; const size_t off = (size_t)(u.pm * 256 + r) * DM + col0;
#pragma unroll
                for (int bj = 0; bj < 2; ++bj)
#pragma unroll
                    for (int n = 0; n < 2; ++n) { const f32x4 o = acc[ai][bj][m][n] * rs * gp[bj][n];
                        u32x2 w; w.x = pg8::cvt_pk_bf16(o[0], o[1]); w.y = pg8::cvt_pk_bf16(o[2], o[3]); *(u32x2*)(hn + off + bj * 128 + n * 16) = w; } }
    }
};
__device__ __forceinline__ int win_row(int c) {
    if (c < 1024 || c >= 3072) return c;
    const int q = (c - 1024) >> 9, ch = (c - 1024) & 511, a = ch >> 7, j = ch & 127;
    return ((q & 1) ? 8 + a : 4 + a) * 256 + (q >> 1) * 128 + j;
}
__device__ __forceinline__ void transpose_item(const float* W, int N, bf16_t* WT, int ldt, int koff, int row_off, bool winmap, LAS float* scr, int item, int lane, const float* rscale = nullptr) {
    const int nblk = N / 64, kb = item / nblk, nb = item % nblk, k0 = 64 * kb, n0 = 64 * nb;
    const int kq = lane >> 4, nq = lane & 15;
    f32x4 v[16];
#pragma unroll
    for (int i = 0; i < 16; ++i) v[i] = __builtin_nontemporal_load((const f32x4*)(W + (size_t)(k0 + 4 * i + kq) * N + n0 + 4 * nq));
#pragma unroll
    for (int i = 0; i < 16; ++i) { LAS float* s = scr + (4 * i + kq) * 65 + 4 * nq; s[0] = v[i][0]; s[1] = v[i][1]; s[2] = v[i][2]; s[3] = v[i][3]; }
    asm volatile("s_waitcnt lgkmcnt(0)" ::: "memory");
    const int c = lane & 7;
#pragma unroll
    for (int j = 0; j < 8; ++j) { const int n = (lane >> 3) + 8 * j;
        const LAS float* s = scr + (rscale ? (16 * (c >> 1) + 4 * (c & 1)) : 8 * c) * 65 + n; const int hs = rscale ? 8 * 65 : 4 * 65; const float f = rscale ? rscale[n0 + n] : 1.f;
        u32x4 o; o.x = pg8::cvt_pk_bf16(s[0 * 65] * f, s[1 * 65] * f); o.y = pg8::cvt_pk_bf16(s[2 * 65] * f, s[3 * 65] * f); o.z = pg8::cvt_pk_bf16(s[hs] * f, s[hs + 65] * f); o.w = pg8::cvt_pk_bf16(s[hs + 2 * 65] * f, s[hs + 3 * 65] * f);
        int dst = n0 + n; if (winmap) dst = win_row(dst);
        if (rscale) *(u32x4*)(WT + (size_t)((((dst >> 5) * 8 + ((k0 + 8 * c) >> 4)) * 64 + (c & 1) * 32 + (dst & 31)) * 8)) = o;
        else *(u32x4*)(WT + (size_t)(row_off + dst) * ldt + koff + k0 + 8 * c) = o; }
    asm volatile("s_waitcnt lgkmcnt(0)" ::: "memory");
}
template <int R> __device__ __forceinline__ void rms_rows_to_bf16(const float* x, const float* g, bf16_t* H, int m0, int mstride, int lane) {
    f32x4 v[R][4];
#pragma unroll
    for (int r = 0; r < R; ++r)
#pragma unroll
        for (int j = 0; j < 4; ++j) v[r][j] = __builtin_nontemporal_load((const f32x4*)(x + (size_t)(m0 + r * mstride) * DM) + 64 * j + lane);
    f32x4 gg[4];
#pragma unroll
    for (int j = 0; j < 4; ++j) gg[j] = ((const f32x4*)g)[64 * j + lane];
#pragma unroll
    for (int r = 0; r < R; ++r) { float s = 0.f;
#pragma unroll
        for (int j = 0; j < 4; ++j) s += (v[r][j][0] * v[r][j][0] + v[r][j][1] * v[r][j][1]) + (v[r][j][2] * v[r][j][2] + v[r][j][3] * v[r][j][3]);
        const float rstd = 1.f / sqrtf(wave_sum(s) * (1.f / DM) + RMS_EPS);
        u32x2* o8 = (u32x2*)(H + (size_t)(m0 + r * mstride) * DM) + lane;
#pragma unroll
        for (int j = 0; j < 4; ++j) { u32x2 w; w.x = pg8::cvt_pk_bf16(v[r][j][0] * rstd * gg[j][0], v[r][j][1] * rstd * gg[j][1]); w.y = pg8::cvt_pk_bf16(v[r][j][2] * rstd * gg[j][2], v[r][j][3] * rstd * gg[j][3]); o8[64 * j] = w; } }
}

__device__ __forceinline__ int crow(int r, int hi) { return (r & 3) + 8 * (r >> 2) + 4 * hi; }
constexpr int VROW = 144;
__device__ __forceinline__ void attn_item(int item, const bf16_t* Q, const bf16_t* K, const bf16_t* V, const bf16_t* SG, bf16_t* YO, LAS unsigned char* vl, LAS unsigned char* kl, int lane) {
    const int qg = item & 127, h = (item >> 7) & 7, b = item >> 10;
    const int r32 = lane & 31, hi = lane >> 5, t0 = qg * 32;
    const size_t tokq = (size_t)b * SEQ + t0 + r32;
    bf16x8 qf[4];
    { const size_t tq0 = (size_t)b * SEQ + t0;
#pragma unroll
      for (int p = 0; p < 4; ++p) { const int idx = p * 64 + lane; const u32x4 v = *(const u32x4*)(Q + (tq0 + (idx >> 3)) * 512 + h * 64 + (idx & 7) * 8); *(LAS u32x4*)(kl + (idx >> 3) * VROW + (idx & 7) * 16) = v; }
#pragma unroll
      for (int d0 = 0; d0 < 4; ++d0) qf[d0] = *(const LAS bf16x8*)(kl + r32 * VROW + d0 * 32 + hi * 16); }
    f32x16 o0, o1;
#pragma unroll
    for (int r = 0; r < 16; ++r) { o0[r] = 0.f; o1[r] = 0.f; }
    float P = 1.f;
    const int i16 = lane & 15, G4 = lane >> 4;
    const int vb = (4 * (G4 >> 1) + (i16 >> 2)) * VROW + (16 * (G4 & 1) + 4 * (i16 & 3)) * 2;
#define ATT_LOAD(KF, VR, S0) do { const size_t tk_ = (size_t)b * SEQ + ((S0) > 0 ? (S0) : 0); \
        _Pragma("unroll") for (int p = 0; p < 4; ++p) { const int idx = p * 64 + lane; KF[p] = *(const u32x4*)(K + (tk_ + (idx >> 3)) * 512 + h * 64 + (idx & 7) * 8); \
                                                         VR[p] = *(const u32x4*)(V + (tk_ + (idx >> 3)) * 512 + h * 64 + (idx & 7) * 8); } } while (0)
    u32x4 kf[4], kn[4]; u32x4 vr[4], vn[4];
    ATT_LOAD(kf, vr, t0); ATT_LOAD(kn, vn, t0 - 32);
    u32x4 sgr[4];
#pragma unroll
    for (int p = 0; p < 4; ++p) { const int idx = p * 64 + lane; sgr[p] = *(const u32x4*)(SG + ((size_t)b * SEQ + t0 + (idx >> 3)) * 1536 + h * 64 + (idx & 7) * 8); }
    for (int s0 = t0; s0 >= 0; s0 -= 32) {
#pragma unroll
        for (int p = 0; p < 4; ++p) { const int idx = p * 64 + lane, key = idx >> 3, ch = idx & 7; *(LAS u32x4*)(vl + key * VROW + ch * 16) = vr[p]; *(LAS u32x4*)(kl + key * VROW + ch * 16) = kf[p]; }
        f32x16 s;
#pragma unroll
        for (int r = 0; r < 16; ++r) s[r] = 0.f;
#pragma unroll
        for (int d0 = 0; d0 < 4; ++d0) s = __builtin_amdgcn_mfma_f32_32x32x16_bf16(*(const LAS bf16x8*)(kl + r32 * VROW + d0 * 32 + hi * 16), qf[d0], s, 0, 0, 0);
        const bool diag = (s0 == t0);
        float kp[16];
#pragma unroll
        for (int r = 0; r < 16; ++r) { const float e = __builtin_amdgcn_exp2f(s[r] * (0.125f * 1.4426950408889634f)); float k = __builtin_amdgcn_rcpf(1.f + e);
            if (diag && crow(r, hi) >= r32) k = 1.f; kp[r] = k; }
        float Gm[4], Go[4], T[4], R[4], C[4];
#pragma unroll
        for (int g = 0; g < 4; ++g) { Gm[g] = (kp[4 * g] * kp[4 * g + 1]) * (kp[4 * g + 2] * kp[4 * g + 3]); Go[g] = __shfl_xor(Gm[g], 32); T[g] = Gm[g] * Go[g]; }
        R[3] = P; R[2] = R[3] * T[3]; R[1] = R[2] * T[2]; R[0] = R[1] * T[1]; const float Cout = R[0] * T[0];
#pragma unroll
        for (int g = 0; g < 4; ++g) C[g] = hi ? R[g] : R[g] * Go[g];
        float w[16];
#pragma unroll
        for (int g = 0; g < 4; ++g) { const float p3 = C[g], p2 = p3 * kp[4 * g + 3], p1 = p2 * kp[4 * g + 2], p0 = p1 * kp[4 * g + 1], pe = p0 * kp[4 * g];
            w[4 * g + 3] = p3 - p2; w[4 * g + 2] = p2 - p1; w[4 * g + 1] = p1 - p0; w[4 * g] = p0 - pe; }
        bf16x8 wf[2];
#pragma unroll
        for (int st = 0; st < 2; ++st) { u32x4 t; t.x = pg8::cvt_pk_bf16(w[8 * st], w[8 * st + 1]); t.y = pg8::cvt_pk_bf16(w[8 * st + 2], w[8 * st + 3]); t.z = pg8::cvt_pk_bf16(w[8 * st + 4], w[8 * st + 5]); t.w = pg8::cvt_pk_bf16(w[8 * st + 6], w[8 * st + 7]); wf[st] = __builtin_bit_cast(bf16x8, t); }
#pragma unroll
        for (int dt = 0; dt < 2; ++dt)
#pragma unroll
            for (int st = 0; st < 2; ++st) {
                const s16x4 lo = __builtin_amdgcn_ds_read_tr16_b64_v4i16((LAS s16x4*)(vl + vb + (16 * st) * VROW + dt * 64));
                const s16x4 hh = __builtin_amdgcn_ds_read_tr16_b64_v4i16((LAS s16x4*)(vl + vb + (16 * st + 8) * VROW + dt * 64));
                const bf16x8 vf = (bf16x8){lo[0], lo[1], lo[2], lo[3], hh[0], hh[1], hh[2], hh[3]};
                if (dt == 0) o0 = __builtin_amdgcn_mfma_f32_32x32x16_bf16(vf, wf[st], o0, 0, 0, 0); else o1 = __builtin_amdgcn_mfma_f32_32x32x16_bf16(vf, wf[st], o1, 0, 0, 0); }
        P = Cout;
        if (__all(P < 1.17549435e-38f)) break;
#pragma unroll
        for (int i = 0; i < 4; ++i) { kf[i] = kn[i]; vr[i] = vn[i]; }
        ATT_LOAD(kn, vn, s0 - 64);
    }
#undef ATT_LOAD
#pragma unroll
    for (int p = 0; p < 4; ++p) { const int idx = p * 64 + lane; *(LAS u32x4*)(kl + (idx >> 3) * VROW + (idx & 7) * 16) = sgr[p]; }
#pragma unroll
    for (int dt = 0; dt < 2; ++dt)
#pragma unroll
        for (int g = 0; g < 4; ++g) { LAS u32x2* p = (LAS u32x2*)(kl + r32 * VROW + (dt * 32 + 8 * g + 4 * hi) * 2); const u32x2 sg = *p;
            const f32x16& o = dt ? o1 : o0; u32x2 y;
            y.x = pg8::cvt_pk_bf16(o[4 * g] * bflo(sg.x), o[4 * g + 1] * bfhi(sg.x)); y.y = pg8::cvt_pk_bf16(o[4 * g + 2] * bflo(sg.y), o[4 * g + 3] * bfhi(sg.y));
            *p = y; }
#pragma unroll
    for (int p = 0; p < 4; ++p) { const int idx = p * 64 + lane; const u32x4 v = *(const LAS u32x4*)(kl + (idx >> 3) * VROW + (idx & 7) * 16);
        *(u32x4*)(YO + ((size_t)b * SEQ + t0 + (idx >> 3)) * 1536 + h * 64 + (idx & 7) * 8) = v; }
}
constexpr int PROW = 272;
__device__ __forceinline__ void pool_item(int pi, const bf16_t* PV, const bf16_t* SG, bf16_t* YO, const bf16_t* PT, const float* scale, LAS unsigned char* sl, int lane) {
    const int tile = pi >> 2, g = ((pi & 3) + ((pi >> 2) & 1)) & 3, win = 2 << g;
    const int r32 = lane & 31, hi = lane >> 5, tok0 = tile * 32, t0 = tok0 & (SEQ - 1), tok = tok0 + r32;
    u32x4 sv[12];
#pragma unroll
    for (int p = 0; p < 12; ++p) { const int idx = p * 64 + lane, row = idx >> 4, ch = idx & 15; const bool ok = (t0 + row - 16) >= 0;
        if (4 * p + 3 >= 17 - win) { sv[p] = *(const u32x4*)(PV + (size_t)(ok ? tok0 + row - 16 : tok0) * 512 + g * 128 + ch * 8); if (!ok) sv[p] = (u32x4){0u, 0u, 0u, 0u}; }
        else sv[p] = (u32x4){0u, 0u, 0u, 0u}; }
#pragma unroll
    for (int p = 0; p < 12; ++p) { const int idx = p * 64 + lane, row = idx >> 4, ch = idx & 15; *(LAS u32x4*)(sl + row * PROW + ch * 16) = sv[p]; }
    const int t = t0 + r32, cnt = (t + 1) < win ? (t + 1) : win;
    bf16x8 bfr[3];
#pragma unroll
    for (int ks = 0; ks < 3; ++ks) { float wv[8];
#pragma unroll
        for (int j = 0; j < 8; ++j) { const int rel = (16 + r32) - (16 * ks + 8 * hi + j); wv[j] = (rel == 0) ? (float)(1 - cnt) : ((rel > 0 && rel < cnt) ? 1.f : 0.f); }
        u32x4 tt; tt.x = pg8::cvt_pk_bf16(wv[0], wv[1]); tt.y = pg8::cvt_pk_bf16(wv[2], wv[3]); tt.z = pg8::cvt_pk_bf16(wv[4], wv[5]); tt.w = pg8::cvt_pk_bf16(wv[6], wv[7]); bfr[ks] = __builtin_bit_cast(bf16x8, tt); }
    bf16x8 ptf[4][8];
#pragma unroll
    for (int nt = 0; nt < 4; ++nt)
#pragma unroll
        for (int ks = 0; ks < 8; ++ks) ptf[nt][ks] = *(const bf16x8*)(PT + (size_t)g * 128 * 128 + (size_t)((nt * 8 + ks) * 64 + lane) * 8);
    const int i16 = lane & 15, G4 = lane >> 4;
    const int vb = (8 * (G4 >> 1) + (i16 >> 2)) * PROW + (16 * (G4 & 1) + 4 * (i16 & 3)) * 2;
    const float inv = __builtin_amdgcn_rcpf((float)cnt);
    bf16x8 pf[8];
#pragma unroll
    for (int ct = 0; ct < 4; ++ct) {
        f32x16 acc;
#pragma unroll
        for (int r = 0; r < 16; ++r) acc[r] = 0.f;
#pragma unroll
        for (int ks = 0; ks < 3; ++ks) {
            const s16x4 lo = __builtin_amdgcn_ds_read_tr16_b64_v4i16((LAS s16x4*)(sl + vb + (16 * ks) * PROW + ct * 64));
            const s16x4 hh = __builtin_amdgcn_ds_read_tr16_b64_v4i16((LAS s16x4*)(sl + vb + (16 * ks + 4) * PROW + ct * 64));
            const bf16x8 a = (bf16x8){lo[0], lo[1], lo[2], lo[3], hh[0], hh[1], hh[2], hh[3]};
            acc = __builtin_amdgcn_mfma_f32_32x32x16_bf16(a, bfr[ks], acc, 0, 0, 0); }
#pragma unroll
        for (int s = 0; s < 2; ++s) { u32x4 tt; tt.x = pg8::cvt_pk_bf16(acc[8 * s] * inv, acc[8 * s + 1] * inv); tt.y = pg8::cvt_pk_bf16(acc[8 * s + 2] * inv, acc[8 * s + 3] * inv);
            tt.z = pg8::cvt_pk_bf16(acc[8 * s + 4] * inv, acc[8 * s + 5] * inv); tt.w = pg8::cvt_pk_bf16(acc[8 * s + 6] * inv, acc[8 * s + 7] * inv); pf[2 * ct + s] = __builtin_bit_cast(bf16x8, tt); }
    }
#pragma unroll
    for (int p = 0; p < 8; ++p) { const int idx = p * 64 + lane; const u32x4 v = *(const u32x4*)(SG + (size_t)(tok0 + (idx >> 4)) * 1536 + g * 128 + (idx & 15) * 8); *(LAS u32x4*)(sl + (idx >> 4) * PROW + (idx & 15) * 16) = v; }
#pragma unroll
    for (int nt = 0; nt < 4; ++nt) {
        f32x16 acc;
#pragma unroll
        for (int r = 0; r < 16; ++r) acc[r] = 0.f;
#pragma unroll
        for (int ks = 0; ks < 8; ++ks) acc = __builtin_amdgcn_mfma_f32_32x32x16_bf16(ptf[nt][ks], pf[ks], acc, 0, 0, 0);
#pragma unroll
        for (int q = 0; q < 4; ++q) { LAS u32x2* p = (LAS u32x2*)(sl + r32 * PROW + (nt * 32 + 8 * q + 4 * hi) * 2); const u32x2 sg = *p; u32x2 y;
            y.x = pg8::cvt_pk_bf16(acc[4 * q] * bflo(sg.x), acc[4 * q + 1] * bfhi(sg.x)); y.y = pg8::cvt_pk_bf16(acc[4 * q + 2] * bflo(sg.y), acc[4 * q + 3] * bfhi(sg.y));
            *p = y; }
    }
#pragma unroll
    for (int p = 0; p < 8; ++p) { const int idx = p * 64 + lane; const u32x4 v = *(const LAS u32x4*)(sl + (idx >> 4) * PROW + (idx & 15) * 16);
        *(u32x4*)(YO + (size_t)(tok0 + (idx >> 4)) * 1536 + g * 128 + (idx & 15) * 8) = v; }
}
__device__ __forceinline__ void conv_item(int ci, const bf16_t* Z, const bf16_t* Wy, bf16_t* YO, const float* cw, const float* cb, int lane) {
    const int tok0 = ci * 8, t0 = tok0 & (SEQ - 1), ch = lane * 8;
    float w0[8], w1[8], w2[8], bs[8], zm2[8], zm1[8];
#pragma unroll
    for (int hf = 0; hf < 2; ++hf) { const f32x4 a = *(const f32x4*)(cw + ch + 4 * hf), b = *(const f32x4*)(cw + 512 + ch + 4 * hf), c = *(const f32x4*)(cw + 1024 + ch + 4 * hf), d = *(const f32x4*)(cb + ch + 4 * hf);
#pragma unroll
        for (int i = 0; i < 4; ++i) { w0[4 * hf + i] = a[i]; w1[4 * hf + i] = b[i]; w2[4 * hf + i] = c[i]; bs[4 * hf + i] = d[i]; } }
#pragma unroll
    for (int i = 0; i < 8; ++i) { zm2[i] = 0.f; zm1[i] = 0.f; }
    if (t0 != 0) { const u32x4 a = *(const u32x4*)(Z + (size_t)(tok0 - 2) * 512 + ch), b = *(const u32x4*)(Z + (size_t)(tok0 - 1) * 512 + ch);
        zm2[0] = bflo(a.x); zm2[1] = bfhi(a.x); zm2[2] = bflo(a.y); zm2[3] = bfhi(a.y); zm2[4] = bflo(a.z); zm2[5] = bfhi(a.z); zm2[6] = bflo(a.w); zm2[7] = bfhi(a.w);
        zm1[0] = bflo(b.x); zm1[1] = bfhi(b.x); zm1[2] = bflo(b.y); zm1[3] = bfhi(b.y); zm1[4] = bflo(b.z); zm1[5] = bfhi(b.z); zm1[6] = bflo(b.w); zm1[7] = bfhi(b.w); }
    u32x4 zr[8], wr_[8];
#pragma unroll
    for (int r = 0; r < 8; ++r) { zr[r] = *(const u32x4*)(Z + (size_t)(tok0 + r) * 512 + ch); wr_[r] = *(const u32x4*)(Wy + (size_t)(tok0 + r) * 1536 + ch); }
#pragma unroll
    for (int r = 0; r < 8; ++r) {
        float zc[8], wv[8], y[8];
        zc[0] = bflo(zr[r].x); zc[1] = bfhi(zr[r].x); zc[2] = bflo(zr[r].y); zc[3] = bfhi(zr[r].y); zc[4] = bflo(zr[r].z); zc[5] = bfhi(zr[r].z); zc[6] = bflo(zr[r].w); zc[7] = bfhi(zr[r].w);
        wv[0] = bflo(wr_[r].x); wv[1] = bfhi(wr_[r].x); wv[2] = bflo(wr_[r].y); wv[3] = bfhi(wr_[r].y); wv[4] = bflo(wr_[r].z); wv[5] = bfhi(wr_[r].z); wv[6] = bflo(wr_[r].w); wv[7] = bfhi(wr_[r].w);
#pragma unroll
        for (int i = 0; i < 8; ++i) { y[i] = wv[i] * (w0[i] * zm2[i] + w1[i] * zm1[i] + w2[i] * zc[i] + bs[i]); zm2[i] = zm1[i]; zm1[i] = zc[i]; }
        u32x4 o; o.x = pg8::cvt_pk_bf16(y[0], y[1]); o.y = pg8::cvt_pk_bf16(y[2], y[3]); o.z = pg8::cvt_pk_bf16(y[4], y[5]); o.w = pg8::cvt_pk_bf16(y[6], y[7]);
        *(u32x4*)(YO + (size_t)(tok0 + r) * 1536 + ch) = o; }
}
template <int R> __device__ __forceinline__ void norm_rows(const float* F32T, const float* RS, const float* xin, const float* gpost, float* xout, const float* gnext, bf16_t* H, int m0, int mstride, int lane) {
    f32x4 o[R][4], xi[R][4]; float ss[R];
#pragma unroll
    for (int r = 0; r < R; ++r) { const size_t row = (size_t)(m0 + r * mstride); ss[r] = (lane < 16) ? RS[row * 16 + lane] : 0.f;
#pragma unroll
        for (int j = 0; j < 4; ++j) { o[r][j] = ((const f32x4*)(F32T + row * DM))[64 * j + lane]; xi[r][j] = ((const f32x4*)(xin + row * DM))[64 * j + lane]; } }
    f32x4 gp[4];
#pragma unroll
    for (int j = 0; j < 4; ++j) gp[j] = ((const f32x4*)gpost)[64 * j + lane];
#pragma unroll
    for (int r = 0; r < R; ++r) { const size_t row = (size_t)(m0 + r * mstride);
        const float rstd = 1.f / sqrtf(wave_sum(ss[r]) * (1.f / DM) + RMS_EPS); float s2 = 0.f;
#pragma unroll
        for (int j = 0; j < 4; ++j) { const f32x4 v = xi[r][j] + o[r][j] * rstd * gp[j]; xi[r][j] = v; ((f32x4*)(xout + row * DM))[64 * j + lane] = v; s2 += (v[0] * v[0] + v[1] * v[1]) + (v[2] * v[2] + v[3] * v[3]); }
        if (gnext) { const float r2 = 1.f / sqrtf(wave_sum(s2) * (1.f / DM) + RMS_EPS);
#pragma unroll
            for (int j = 0; j < 4; ++j) { const f32x4 gg = ((const f32x4*)gnext)[64 * j + lane]; const f32x4 v = xi[r][j]; u32x2 w; w.x = pg8::cvt_pk_bf16(v[0] * r2 * gg[0], v[1] * r2 * gg[1]); w.y = pg8::cvt_pk_bf16(v[2] * r2 * gg[2], v[3] * r2 * gg[3]); ((u32x2*)(H + row * DM))[64 * j + lane] = w; } } }
}

struct Args { const float* in[10]; float* out; unsigned char* ws; int ph_lo, ph_hi; };
template <class T> __device__ __forceinline__ T* as_global(T* p) { return p; }
#if TP_A >= 0
#define TSTAMP(k) do { if (blockIdx.x == TP_BLK && threadIdx.x == 0) ((volatile LAS unsigned long long*)(lds + 147264))[(k)] = __builtin_amdgcn_s_memrealtime(); } while (0)
#else
#define TSTAMP(k) do { } while (0)
#endif
template <int ph> __device__ __forceinline__ void run_phase(const Args& a_, LAS unsigned char* lds) {
        const Args* A = &a_;
        const int tid = threadIdx.x, lane = tid & 63, wave = __builtin_amdgcn_readfirstlane(tid >> 6);
        const int G = gridDim.x, bx = blockIdx.x;
        const int vcu = (G % 8 == 0) ? (bx % 8) * (G / 8) + bx / 8 : bx;
        const int gw = vcu * 8 + wave, NGW = G * 8;
        unsigned char* ws = as_global(A->ws);
        bf16_t* H = (bf16_t*)(ws + WS_H); bf16_t* U = (bf16_t*)(ws + WS_U);
        if constexpr (ph == 0) {
            const float* x = as_global(A->in[0]); const float* pre_g = as_global(A->in[1]); const float* w_in = as_global(A->in[2]); const float* pool_w = as_global(A->in[3]); const float* pool_scale = as_global(A->in[4]); const float* w_branch = as_global(A->in[7]); const float* w_out = as_global(A->in[8]);
            bf16_t* W1 = (bf16_t*)(ws + WS_W1); bf16_t* W2 = (bf16_t*)(ws + WS_W2); bf16_t* W3 = (bf16_t*)(ws + WS_W3); bf16_t* PW = (bf16_t*)(ws + WS_PW);
            LAS float* scr = (LAS float*)(lds + wave * 17408);
            constexpr int I1 = (DM / 64) * (NIN / 64), I4 = 2 * 2;
            for (int it = gw; it < I1 + 8 * I4; it += NGW) {
                if (it < I1) transpose_item(w_in, NIN, W1, DM, 0, 0, true, scr, it, lane);
                else { const int r = it - I1, lg = r / I4; transpose_item(pool_w + (size_t)lg * 128 * 128, 128, PW + (size_t)lg * 128 * 128, 128, 0, 0, false, scr, r % I4, lane, pool_scale + lg * 128); }
            }
            for (int m = gw; m < MTOK; m += 2 * NGW) rms_rows_to_bf16<2>(x, pre_g, H, m, NGW, lane);
        } else {
            constexpr int l = (ph - 1) / 5, k = (ph - 1) % 5;
            if constexpr (k == 0) {
                pg8::Gemm g{H, (bf16_t*)(ws + WS_W1) + (size_t)l * NIN * DM, MTOK, NIN, DM, 0}; pg8::StaticOrder S; S.init(MTOK, NIN, G, bx);
                EpiU E{ws};
                pg8::gemm_phase<EpiU, pg8::StaticOrder, true, true>(lds, g, S, E);
            } else if constexpr (k == 1) {
                const float* pool_scale = as_global(A->in[4]); const float* conv_w = as_global(A->in[5]); const float* conv_b = as_global(A->in[6]);
                const bf16_t* PW = (const bf16_t*)(ws + WS_PW);
                const bf16_t* Q = U + 2 * (ARRB / 2); const bf16_t* Kk = U + 3 * (ARRB / 2); const bf16_t* V = U + 4 * (ARRB / 2);
                LAS unsigned char* vl = lds + wave * (32 * VROW + 48 * PROW);
                LAS unsigned char* sl_ = vl + 32 * VROW;
                bf16_t* G3 = U + 5 * (ARRB / 2);
                bf16_t* YO = G3;
#if MIX_PROBE
                if (l == 0 && A->ph_hi < 0) YO = (bf16_t*)as_global(A->out);
#endif
                int pm_ = 7;
#if MIX_PROBE
                if (l == 0 && A->ph_hi < 0) pm_ = MIX_PROBE;
#endif
                if (l == 0) TSTAMP(12);
                volatile LAS unsigned* wq = (volatile LAS unsigned*)(lds + 147216);
                if (tid < 4) wq[tid] = 0u;
                __syncthreads();
#define WQ_GRAB(Q_) ({ unsigned v_ = 0u; if (lane == 0) v_ = __hip_atomic_fetch_add((LAS unsigned*)(Q_), 1u, __ATOMIC_RELAXED, __HIP_MEMORY_SCOPE_WORKGROUP); (unsigned)__builtin_amdgcn_readfirstlane((int)v_); })
#define WQ_ITEM(J_) ((int)(vcu * 8 + ((J_) & 7u) + ((J_) >> 3) * (unsigned)NGW))
                for (;;) { const unsigned j = WQ_GRAB(wq); const int it = WQ_ITEM(j); if (it >= NB * 8 * 128) break; attn_item(it, Q, Kk, V, G3 + 1024, YO + 1024, vl, sl_, lane); }
                if (l == 0) TSTAMP(13);
                for (;;) { const unsigned j = WQ_GRAB(wq + 1); const int it = WQ_ITEM(j); if (it >= (MTOK / 32) * 4) break; pool_item(it, U, G3, YO, PW + (size_t)l * 4 * 128 * 128, pool_scale + l * BWID, sl_, lane); }
                if (l == 0) TSTAMP(14);
                for (;;) { const unsigned j = WQ_GRAB(wq + 2); const int it = WQ_ITEM(j); if (it >= MTOK / 8) break; conv_item(it, U + 1 * (ARRB / 2), G3 + 512, YO + 512, conv_w + l * 3 * BWID, conv_b + l * BWID, lane); }
                if constexpr (l == 0) {
                    const float* w_in = as_global(A->in[2]); const float* w_branch = as_global(A->in[7]); const float* w_out = as_global(A->in[8]);
                    bf16_t* W1 = (bf16_t*)(ws + WS_W1); bf16_t* W2 = (bf16_t*)(ws + WS_W2); bf16_t* W3 = (bf16_t*)(ws + WS_W3);
                    constexpr int I1 = (DM / 64) * (NIN / 64), I2 = (BWID / 64) * (DM / 64), I3 = (DM / 64) * (DM / 64), NDEF = I1 + 6 * I2 + 2 * I3;
                    for (;;) { const unsigned j = WQ_GRAB(wq + 3); int r = WQ_ITEM(j); if (r >= NDEF) break;
                        if (r < I1) { transpose_item(w_in + (size_t)DM * NIN, NIN, W1 + (size_t)NIN * DM, DM, 0, 0, true, (LAS float*)vl, r, lane); continue; } r -= I1;
                        if (r < 6 * I2) { const int ln = r / I2, ll = ln / 3, n = ln % 3; transpose_item(w_branch + (size_t)ln * BWID * DM, DM, W2 + (size_t)ll * 3 * DM * BWID, 3 * BWID, n * BWID, 0, false, (LAS float*)vl, r % I2, lane); continue; } r -= 6 * I2;
                        { const int ll = r / I3; transpose_item(w_out + (size_t)ll * DM * DM, DM, W3 + (size_t)ll * DM * DM, DM, 0, 0, false, (LAS float*)vl, r % I3, lane); }
                    }
                }
#undef WQ_GRAB
#undef WQ_ITEM
                if (l == 0) TSTAMP(15);
#if TP_A >= 0
                if (l == 0) { __syncthreads(); TSTAMP(5); }
#endif
            } else if constexpr (k == 2) {
                pg8::Gemm g{U + 5 * (ARRB / 2), (bf16_t*)(ws + WS_W2) + (size_t)l * 3 * DM * BWID, MTOK, DM, 3 * BWID, 0}; pg8::StaticOrder S; S.init(MTOK, DM, G, bx);
                EpiBranch E{ws};
                pg8::gemm_phase<EpiBranch, pg8::StaticOrder, true, true>(lds, g, S, E);
            } else if constexpr (k == 3) {
                pg8::Gemm g{H, (bf16_t*)(ws + WS_W3) + (size_t)l * DM * DM, MTOK, DM, DM, 0}; pg8::StaticOrder S; S.init(MTOK, DM, G, bx);
                if (G == 256) {
                    const float* x = as_global(A->in[0]); const float* pre_g = as_global(A->in[1]); const float* post_g = as_global(A->in[9]); float* out = as_global(A->out);
                    float* xb = (float*)(ws + WS_RS); unsigned* cn = (unsigned*)(ws + WS_CTL + CTL_CNT);
                    if constexpr (l + 1 < NLAYER) {
                        EpiNorm2 E{x, out, H, post_g + l * DM, pre_g + (l + 1) * DM, RmsPanel{xb, cn}, RmsPanel{xb + (size_t)MTOK * 4, cn + 64 * 64}};
                        pg8::gemm_phase<EpiNorm2, pg8::StaticOrder, false, true>(lds, g, S, E);
                    } else {
                        EpiNorm1 E{out, post_g + l * DM, RmsPanel{xb + (size_t)2 * MTOK * 4, cn + 2 * 64 * 64}};
                        pg8::gemm_phase<EpiNorm1, pg8::StaticOrder, false, true>(lds, g, S, E);
                    }
                } else {
                    EpiOut E{ws};
                    pg8::gemm_phase<EpiOut, pg8::StaticOrder, true, true>(lds, g, S, E);
                }
            } else {
                const float* x = as_global(A->in[0]); const float* pre_g = as_global(A->in[1]); const float* post_g = as_global(A->in[9]); float* out = as_global(A->out);
                const float* F32T = (const float*)(ws + WS_U); const float* RS = (const float*)(ws + WS_RS);
                const float* xin = (l == 0) ? x : out; const float* gnext = (l + 1 < NLAYER) ? pre_g + (l + 1) * DM : nullptr;
                if (G != 256) for (int m = gw; m < MTOK; m += 2 * NGW) norm_rows<2>(F32T, RS, xin, post_g + l * DM, out, gnext, H, m, NGW, lane);
            }
        }
}
__global__ void __launch_bounds__(512, 2) hybrid_fwd(Args a_) {
    extern __shared__ __attribute__((aligned(16))) unsigned char lds_raw[];
    LAS unsigned char* lds = (LAS unsigned char*)lds_raw;
    cg::grid_group grid = cg::this_grid();
    if (threadIdx.x < 64) ((LAS unsigned*)(lds + 147200))[threadIdx.x] = 0u;
    __syncthreads();
    (void)xcd_barrier_post((unsigned*)(a_.ws + WS_CTL), (volatile LAS unsigned*)(lds + 147200 + 32));
#define SEAM_BAR() do { XcdBarrier b_; b_.bar = (unsigned*)(a_.ws + WS_CTL); b_.x = xb_xcc_id(); b_.st = (volatile LAS unsigned*)(lds + 147200 + 32); xcd_barrier(b_); } while (0)
    const int lo = a_.ph_lo, hi = a_.ph_hi < 0 ? -a_.ph_hi : a_.ph_hi;
#define PHASE(k) if (lo <= (k) && (k) < hi && !(((k) == 5 || (k) == 10) && gridDim.x == 256)) { if ((k) > lo) { if ((k) == 1 && lo < 0) grid.sync(); else SEAM_BAR(); } TSTAMP(k); run_phase<(k)>(a_, lds); }
    PHASE(0) PHASE(1) PHASE(2) PHASE(3) PHASE(4) PHASE(5) PHASE(6) PHASE(7) PHASE(8) PHASE(9) PHASE(10)
#undef PHASE
#if TP_A >= 0
    SEAM_BAR(); TSTAMP(11);
    if (blockIdx.x == TP_BLK && threadIdx.x == 0) { volatile LAS unsigned long long* ts = (volatile LAS unsigned long long*)(lds + 147264); a_.out[0] += (float)(ts[TP_B] - ts[TP_A]) * (0.00005f * TP_SCALE); }
#endif
}

extern "C" void kernel_launch(void* const* d_in, const int* in_sizes, int n_in, void* d_out, int out_size, void* d_ws, size_t ws_size, hipStream_t stream) {
    static int grid = 0;
    if (grid == 0) {
        if (n_in != 10 || out_size != MTOK * DM || ws_size < WS_END) { fprintf(stderr, "kernel_launch: unexpected shapes / workspace (n_in %d out %d ws %zu)\n", n_in, out_size, ws_size); grid = -1; return; }
        int dev = 0, cus = 0, per_cu = 0;
        (void)hipGetDevice(&dev); (void)hipDeviceGetAttribute(&cus, hipDeviceAttributeMultiprocessorCount, dev);
        (void)hipFuncSetAttribute((const void*)hybrid_fwd, hipFuncAttributeMaxDynamicSharedMemorySize, LDS_BYTES);
        (void)hipOccupancyMaxActiveBlocksPerMultiprocessor(&per_cu, (const void*)hybrid_fwd, 512, LDS_BYTES);
        (void)hipGetLastError();
        if (per_cu < 1) { fprintf(stderr, "kernel_launch: occupancy query says %d blocks/CU\n", per_cu); per_cu = 1; }
        grid = cus;
    }
    if (grid < 0) return;
    if (hipMemsetAsync((char*)d_ws + WS_CTL, 0, CTL_BYTES, stream) != hipSuccess) { fprintf(stderr, "kernel_launch: memset of the barrier words failed\n"); return; }
    Args a{};
    for (int i = 0; i < 10; ++i) a.in[i] = (const float*)d_in[i];
    a.out = (float*)d_out; a.ws = (unsigned char*)d_ws;
#if ONE_LAUNCH
    a.ph_lo = 0; a.ph_hi = NPHASE;
    void* args[] = {&a};
    hipError_t e = hipLaunchCooperativeKernel((const void*)hybrid_fwd, dim3(grid), dim3(512), args, LDS_BYTES, stream);
    if (e != hipSuccess) fprintf(stderr, "cooperative launch failed: %s (grid %d)\n", hipGetErrorString(e), grid);
#else
    for (int ph = 0; ph < NPHASE; ++ph) { a.ph_lo = ph; a.ph_hi = ph + 1;
#if MIX_PROBE
        if (ph == 2) { a.ph_hi = -(ph + 1); hipLaunchKernelGGL(hybrid_fwd, dim3(grid), dim3(512), LDS_BYTES, stream, a); a.ph_hi = ph + 1; }
#endif
        for (int rep = 0; rep < 1 + ((DUP_MASK >> ph) & 1); ++rep) hipLaunchKernelGGL(hybrid_fwd, dim3(grid), dim3(512), LDS_BYTES, stream, a); }
#endif
}
```
